# Optimizing an MI355X kernel written in HIP

```python
import math
import jax, jax.numpy as jnp
from jax import lax
import numpy as np

D_MODEL = 2048
BATCH = 2
SEQ = 4096
DEPTH = 2

RET_HEADS = 4
RET_QK_DIM = 64
RET_V_DIM = 128
RET_WIDTH = RET_HEADS * RET_V_DIM
RET_CHUNK = 128
RET_COLS = 2 * RET_HEADS * RET_QK_DIM + 2 * RET_WIDTH

RWKV_HEADS = 8
RWKV_HEAD_DIM = 64
RWKV_WIDTH = RWKV_HEADS * RWKV_HEAD_DIM
RWKV_DECAY_RANK = 96
RWKV_A_RANK = 96
RWKV_GATE_RANK = 256
RWKV_GN_EPS = 64e-5
RWKV_COLS = 3 * RWKV_WIDTH + RWKV_DECAY_RANK + RWKV_A_RANK + RWKV_GATE_RANK

MOBA_HEADS = 8
MOBA_HEAD_DIM = 128
MOBA_WIDTH = MOBA_HEADS * MOBA_HEAD_DIM
MOBA_BLOCK = 256
MOBA_TOPK = 3
MOBA_Q_CHUNK = 32
MOBA_COLS = 3 * MOBA_WIDTH
NEG_INF = -1e30

MIX_WIDTH = RET_WIDTH + RWKV_WIDTH + MOBA_WIDTH
IN_COLS = RET_COLS + RWKV_COLS + MOBA_COLS

D_FF = 5632
CONV_WIDTH = 3
NORM_EPS = 1e-6

kernel_name = "hybrid_retention_rwkv7_moba_convffn_trunk"


def rms_norm(x, g):
    xf = x.astype(jnp.float32)
    y = xf * lax.rsqrt(jnp.mean(xf * xf, axis=-1, keepdims=True) + NORM_EPS)
    return (y * g.astype(jnp.float32)).astype(x.dtype)


def token_shift(x):
    return jnp.pad(x, ((0, 0), (1, 0), (0, 0)))[:, :-1]


def retention_chunkwise(q, k, v):
    B, S, H, Dk = q.shape
    Dv = v.shape[-1]
    C = RET_CHUNK
    N = S // C
    f32 = jnp.float32
    log_g = jnp.log1p(-jnp.exp2(-5.0 - jnp.arange(H, dtype=f32)))

    def chunks(a, d):
        return a.astype(f32).reshape(B, N, C, H, d).transpose(1, 0, 3, 2, 4)

    qc_all = chunks(q, Dk)
    kc_all = chunks(k, Dk) * (Dk ** -0.5)
    vc_all = chunks(v, Dv)
    idx = jnp.arange(C, dtype=f32)
    diff = idx[:, None] - idx[None, :]
    inner_decay = jnp.where(diff >= 0, jnp.exp(log_g[:, None, None] * jnp.maximum(diff, 0.0)), 0.0)
    q_decay = jnp.exp(log_g[:, None] * (idx + 1.0))[..., None]
    k_decay = jnp.exp(log_g[:, None] * (C - 1.0 - idx))[..., None]
    chunk_decay = jnp.exp(log_g * C)[:, None, None]

    def step(R, inp):
        qc, kc, vc = inp
        inner = jnp.einsum('bhid,bhjd->bhij', qc, kc) * inner_decay
        o = jnp.einsum('bhij,bhjv->bhiv', inner, vc) + jnp.einsum('bhid,bhdv->bhiv', qc, R) * q_decay
        R = R * chunk_decay + jnp.einsum('bhjd,bhjv->bhdv', kc * k_decay, vc)
        return R, o

    R0 = jnp.zeros((B, H, Dk, Dv), f32)
    _, o = lax.scan(step, R0, (qc_all, kc_all, vc_all))
    return o.transpose(1, 0, 3, 2, 4).reshape(B, S, H, Dv)


def rwkv7_time_mix(r, k, v, wd, wa, wg, w0, w_up, a0, a_up, g_up, k_k, k_a, r_k, ln_w, ln_b):
    B, S, C = r.shape
    H, N = RWKV_HEADS, RWKV_HEAD_DIM
    f32 = jnp.float32
    r, k, v = r.astype(f32), k.astype(f32), v.astype(f32)
    w_log = -jax.nn.softplus(-(w0 + jnp.tanh(wd.astype(f32)) @ w_up)) - 0.5
    decay = jnp.exp(-jnp.exp(w_log))
    a = jax.nn.sigmoid(a0 + wa.astype(f32) @ a_up)
    g = jax.nn.sigmoid(wg.astype(f32)) @ g_up
    kk = (k * k_k).reshape(B, S, H, N)
    kk = kk / jnp.maximum(jnp.sqrt(jnp.sum(kk * kk, axis=-1, keepdims=True)), 1e-12)
    k = k * (1.0 + (a - 1.0) * k_a)

    def heads_tm(z):
        return jnp.moveaxis(z.reshape(B, S, H, N), 1, 0)

    def step(state, inp):
        r_t, w_t, k_t, v_t, kk_t, a_t = inp
        sa = jnp.einsum('bhij,bhj->bhi', state, -kk_t)
        state = (state * w_t[:, :, None, :]
                 + sa[..., None] * (kk_t * a_t)[:, :, None, :]
                 + v_t[..., None] * k_t[:, :, None, :])
        y = jnp.einsum('bhij,bhj->bhi', state, r_t)
        return state, y

    s0 = jnp.zeros((B, H, N, N), f32)
    _, y = lax.scan(step, s0, (heads_tm(r), heads_tm(decay), heads_tm(k), heads_tm(v),
                               jnp.moveaxis(kk, 1, 0), heads_tm(a)))
    y = jnp.moveaxis(y, 0, 1)
    mean = jnp.mean(y, axis=-1, keepdims=True)
    var = jnp.mean((y - mean) ** 2, axis=-1, keepdims=True)
    y = ((y - mean) * lax.rsqrt(var + RWKV_GN_EPS)).reshape(B, S, C) * ln_w + ln_b
    rh, kh, vh = r.reshape(B, S, H, N), k.reshape(B, S, H, N), v.reshape(B, S, H, N)
    bonus = (jnp.sum(rh * kh * r_k, axis=-1, keepdims=True) * vh).reshape(B, S, C)
    return (y + bonus) * g


def moba_attention(q, k, v):
    B, S, H, D = q.shape
    L = MOBA_BLOCK
    NB = -(-S // L)
    P = NB * L
    topk = min(MOBA_TOPK, NB)
    QC = MOBA_Q_CHUNK
    f32 = jnp.float32
    slopes = jnp.exp2(-8.0 * jnp.arange(1, H + 1, dtype=f32) / H)
    qh = q.astype(f32).transpose(0, 2, 1, 3) * (D ** -0.5)
    pad = ((0, 0), (0, 0), (0, P - S), (0, 0))
    kh = jnp.pad(k.astype(f32).transpose(0, 2, 1, 3), pad)
    vh = jnp.pad(v.astype(f32).transpose(0, 2, 1, 3), pad)
    kb = kh.reshape(B, H, NB, L, D)
    vb = vh.reshape(B, H, NB, L, D)
    k_mean = jnp.mean(kb, axis=3)
    gate = jnp.einsum('bhsd,bhnd->bhsn', qh, k_mean)
    q_block = jnp.arange(S) // L
    fully_past = jnp.arange(NB)[None, :] < q_block[:, None]
    gate = jnp.where(fully_past, gate, -jnp.inf)
    _, sel = lax.top_k(gate, topk)
    b_ix = jnp.arange(B)[:, None, None, None]
    h_ix = jnp.arange(H)[None, :, None, None]
    offs = jnp.arange(L)

    def chunk(ci):
        q0 = ci * QC
        qc = lax.dynamic_slice_in_dim(qh, q0, QC, axis=2)
        sc = lax.dynamic_slice_in_dim(sel, q0, QC, axis=2)
        t = q0 + jnp.arange(QC)
        bq = q0 // L
        kg = kb[b_ix, h_ix, sc]
        vg = vb[b_ix, h_ix, sc]
        s_sel = jnp.einsum('bhqd,bhqnld->bhqnl', qc, kg)
        dist_sel = (t[:, None, None] - (sc[..., None] * L + offs)).astype(f32)
        s_sel = jnp.where((sc < bq)[..., None],
                          s_sel - slopes[:, None, None, None] * dist_sel, NEG_INF)
        ko = lax.dynamic_slice_in_dim(kh, bq * L, L, axis=2)
        vo = lax.dynamic_slice_in_dim(vh, bq * L, L, axis=2)
        s_own = jnp.einsum('bhqd,bhld->bhql', qc, ko)
        dist_own = t[:, None] - (bq * L + offs)[None, :]
        s_own = jnp.where(dist_own >= 0,
                          s_own - slopes[:, None, None] * dist_own.astype(f32), NEG_INF)
        scores = jnp.concatenate([s_sel.reshape(B, H, QC, topk * L), s_own], axis=-1)
        p = jax.nn.softmax(scores, axis=-1)
        p_sel = p[..., :topk * L].reshape(B, H, QC, topk, L)
        p_own = p[..., topk * L:]
        return (jnp.einsum('bhqnl,bhqnld->bhqd', p_sel, vg)
                + jnp.einsum('bhql,bhld->bhqd', p_own, vo))

    out = lax.map(chunk, jnp.arange(S // QC))
    return out.transpose(1, 0, 3, 2, 4).reshape(B, S, H * D)


def hybrid_mixer(h, w_in, w_out, mu, w0, w_up, a0, a_up, g_up, k_k, k_a, r_k, ln_w, ln_b):
    B, S, _ = h.shape
    proj = h @ w_in
    o0 = 0
    qk = RET_HEADS * RET_QK_DIM
    rq = proj[..., o0:o0 + qk].reshape(B, S, RET_HEADS, RET_QK_DIM)
    rk = proj[..., o0 + qk:o0 + 2 * qk].reshape(B, S, RET_HEADS, RET_QK_DIM)
    rv = proj[..., o0 + 2 * qk:o0 + 2 * qk + RET_WIDTH].reshape(B, S, RET_HEADS, RET_V_DIM)
    rg = proj[..., o0 + 2 * qk + RET_WIDTH:o0 + RET_COLS].astype(jnp.float32)
    ro = retention_chunkwise(rq, rk, rv)
    ro = ro * lax.rsqrt(jnp.mean(ro * ro, axis=-1, keepdims=True) + NORM_EPS)
    ret_out = ro.reshape(B, S, RET_WIDTH) * jax.nn.silu(rg)
    rw = proj[..., RET_COLS:RET_COLS + RWKV_COLS]
    rw = rw + (token_shift(rw) - rw) * mu
    c1 = RWKV_WIDTH
    c2 = 2 * RWKV_WIDTH
    c3 = 3 * RWKV_WIDTH
    c4 = c3 + RWKV_DECAY_RANK
    c5 = c4 + RWKV_A_RANK
    rwkv_out = rwkv7_time_mix(rw[..., :c1], rw[..., c1:c2], rw[..., c2:c3],
                              rw[..., c3:c4], rw[..., c4:c5], rw[..., c5:],
                              w0, w_up, a0, a_up, g_up, k_k, k_a, r_k, ln_w, ln_b)
    m0 = RET_COLS + RWKV_COLS
    mq = proj[..., m0:m0 + MOBA_WIDTH].reshape(B, S, MOBA_HEADS, MOBA_HEAD_DIM)
    mk = proj[..., m0 + MOBA_WIDTH:m0 + 2 * MOBA_WIDTH].reshape(B, S, MOBA_HEADS, MOBA_HEAD_DIM)
    mv = proj[..., m0 + 2 * MOBA_WIDTH:m0 + 3 * MOBA_WIDTH].reshape(B, S, MOBA_HEADS, MOBA_HEAD_DIM)
    moba_out = moba_attention(mq, mk, mv)
    mixed = jnp.concatenate([ret_out.astype(h.dtype), rwkv_out.astype(h.dtype),
                             moba_out.astype(h.dtype)], axis=-1)
    return mixed @ w_out


def conv_glu_ffn(h, w_up, conv_w, conv_b, w_down):
    S = h.shape[1]
    u = h @ w_up
    up = jnp.pad(u, ((0, 0), (CONV_WIDTH - 1, 0), (0, 0)))
    u = sum(conv_w[j] * up[:, j:j + S] for j in range(CONV_WIDTH)) + conv_b
    val, gate = jnp.split(u, 2, axis=-1)
    return (jax.nn.silu(gate) * val) @ w_down


def setup_inputs(seed: int = 0) -> dict:
    key = jax.random.key(seed)
    ks = jax.random.split(key, 24)
    D, L = D_MODEL, DEPTH
    f32 = jnp.float32

    def nrm(k, shape, scale):
        return jax.random.normal(k, shape, f32) * scale

    ratio = (jnp.arange(RWKV_WIDTH, dtype=f32) / (RWKV_WIDTH - 1)) ** 0.85
    return {
        "x": nrm(ks[0], (BATCH, SEQ, D), 1.0),
        "c": nrm(ks[1], (BATCH, D), 1.0),
        "w_in": nrm(ks[2], (L, D, IN_COLS), D ** -0.5),
        "w_out": nrm(ks[3], (L, MIX_WIDTH, D), MIX_WIDTH ** -0.5),
        "rwkv_mu": jax.random.uniform(ks[4], (L, RWKV_COLS), f32),
        "rwkv_w0": (-6.5 + 5.0 * ratio)[None, :] + nrm(ks[5], (L, RWKV_WIDTH), 0.1),
        "rwkv_w_up": nrm(ks[6], (L, RWKV_DECAY_RANK, RWKV_WIDTH), 0.1 * RWKV_DECAY_RANK ** -0.5),
        "rwkv_a0": nrm(ks[7], (L, RWKV_WIDTH), 0.1),
        "rwkv_a_up": nrm(ks[8], (L, RWKV_A_RANK, RWKV_WIDTH), RWKV_A_RANK ** -0.5),
        "rwkv_g_up": nrm(ks[9], (L, RWKV_GATE_RANK, RWKV_WIDTH), RWKV_GATE_RANK ** -0.5),
        "rwkv_k_k": 0.85 + nrm(ks[10], (L, RWKV_WIDTH), 0.05),
        "rwkv_k_a": 1.0 + nrm(ks[11], (L, RWKV_WIDTH), 0.05),
        "rwkv_r_k": -0.04 + nrm(ks[12], (L, RWKV_HEADS, RWKV_HEAD_DIM), 0.1),
        "rwkv_ln_w": 1.0 + nrm(ks[13], (L, RWKV_WIDTH), 0.05),
        "rwkv_ln_b": nrm(ks[14], (L, RWKV_WIDTH), 0.02),
        "w_ffn_up": nrm(ks[15], (L, D, 2 * D_FF), D ** -0.5),
        "ffn_conv_w": nrm(ks[16], (L, CONV_WIDTH, 2 * D_FF), CONV_WIDTH ** -0.5),
        "ffn_conv_b": nrm(ks[17], (L, 2 * D_FF), 0.02),
        "w_ffn_down": nrm(ks[18], (L, D_FF, D), D_FF ** -0.5),
        "w_ada": nrm(ks[19], (L, D, 6 * D), 0.5 * D ** -0.5),
        "b_ada": nrm(ks[20], (L, 6 * D), 0.02),
        "norm_mix": 1.0 + nrm(ks[21], (L, D), 0.05),
        "norm_ffn": 1.0 + nrm(ks[22], (L, D), 0.05),
        "norm_final": 1.0 + nrm(ks[23], (D,), 0.05),
    }


def reference(x, c, w_in, w_out, rwkv_mu, rwkv_w0, rwkv_w_up, rwkv_a0, rwkv_a_up, rwkv_g_up,
              rwkv_k_k, rwkv_k_a, rwkv_r_k, rwkv_ln_w, rwkv_ln_b, w_ffn_up, ffn_conv_w,
              ffn_conv_b, w_ffn_down, w_ada, b_ada, norm_mix, norm_ffn, norm_final):
    c_act = jax.nn.silu(c)
    for l in range(DEPTH):
        mod = (c_act @ w_ada[l] + b_ada[l])[:, None, :]
        sh1, sc1, g1, sh2, sc2, g2 = jnp.split(mod, 6, axis=-1)
        h = rms_norm(x, norm_mix[l]) * (1.0 + sc1) + sh1
        x = x + g1 * hybrid_mixer(h, w_in[l], w_out[l], rwkv_mu[l], rwkv_w0[l], rwkv_w_up[l],
                                  rwkv_a0[l], rwkv_a_up[l], rwkv_g_up[l], rwkv_k_k[l],
                                  rwkv_k_a[l], rwkv_r_k[l], rwkv_ln_w[l], rwkv_ln_b[l])
        h = rms_norm(x, norm_ffn[l]) * (1.0 + sc2) + sh2
        x = x + g2 * conv_glu_ffn(h, w_ffn_up[l], ffn_conv_w[l], ffn_conv_b[l], w_ffn_down[l])
    return rms_norm(x, norm_final)
```

```cpp
#include <hip/hip_runtime.h>
#include <cstdio>
#include <cstdint>
#ifndef MOBA_NP
#define MOBA_NP 2
#endif
#ifndef MOBA_CHECK
#define MOBA_CHECK 0
#endif
__device__ __forceinline__ int tid_from_wave(int wave) { int l = (int)__builtin_amdgcn_mbcnt_hi(~0u, __builtin_amdgcn_mbcnt_lo(~0u, 0u)); asm volatile("" : "+v"(l)); return wave * 64 + l; }
namespace pg8 {
#define PG8_LAS __attribute__((address_space(3)))
typedef unsigned short bf16_t;
typedef short bf16x8 __attribute__((ext_vector_type(8)));
typedef float f32x4 __attribute__((ext_vector_type(4)));
typedef unsigned u32x4 __attribute__((ext_vector_type(4)));
constexpr int BM = 256, BK = 64, HALF = 128, HTB = HALF * BK * 2  , STAGE_BYTES = 8 * HTB, NXCD = 8, WGM = 8;

__host__ __device__ __forceinline__ int lds_byte(int r, int c) { const int st = (r >> 4) * 2 + (c >> 5), rr = r & 15, cc = c & 31, ob = rr * 64 + cc * 2; return st * 1024 + (ob ^ (((ob >> 9) & 1) << 5)); }
__host__ __device__ __forceinline__ void stage_rc(int b, int& R, int& C) { const int st = b / 1024, sb = b % 1024, swz = sb ^ (((sb >> 9) & 1) << 5); R = (st >> 1) * 16 + swz / 64; C = (st & 1) * 32 + (swz % 64) / 2; }
__host__ __device__ __forceinline__ int perm32(int rho) { const int n = rho >> 4, i = rho & 15; return 8 * (i >> 2) + 4 * n + (i & 3); }

struct Unit { int pm, pn; };
struct Gemm { const bf16_t* A; const bf16_t* Bt; int M, N, K; };

struct StaticOrder {
    int nM, nN, nwg, G, c;
    __host__ __device__ void init(int M, int N, int G_, int c_) { nM = M / BM; nN = N / BM; nwg = nM * nN; G = G_; c = c_; }
    __host__ __device__ bool next(int i, Unit& u) const {
        const long L = (long)i * G + c; if (L >= nwg) return false;
        int wgid = (int)L; { const int q = nwg / NXCD, r = nwg % NXCD, xcd = wgid % NXCD, off = wgid / NXCD; wgid = (xcd < r ? xcd * (q + 1) : r * (q + 1) + (xcd - r) * q) + off; }
        const int nig = WGM * nN, gid = wgid / nig, fm = gid * WGM, gsz = (nM - fm) < WGM ? (nM - fm) : WGM;
        u.pm = fm + ((wgid % nig) % gsz); u.pn = (wgid % nig) / gsz; return true;
    }
    __device__ __forceinline__ void a_ready(const Unit&) const {}
    __device__ __forceinline__ void done(const Unit&) const {}
};

__device__ __forceinline__ unsigned cvt_pk_bf16(float lo, float hi) { unsigned r; asm volatile("v_cvt_pk_bf16_f32 %0, %1, %2" : "=v"(r) : "v"(lo), "v"(hi)); return r; }

struct EpiBf16 {
    static constexpr bool PERM = true, AFTER_DRAIN = false;
    bf16_t* O; int ldc;
    __device__ __forceinline__ void operator()(const f32x4 (&acc)[2][2][4][2], const Unit& u, int wr, int wc, int fr, int fq) const {
        const int row0 = u.pm * BM + wr * 64 + fr; const int col0 = u.pn * BM + wc * 32 + 8 * fq;
#pragma unroll
        for (int ai = 0; ai < 2; ++ai)
#pragma unroll
            for (int m = 0; m < 4; ++m) { bf16_t* rowp = O + (size_t)(row0 + ai * HALF + m * 16) * ldc + col0;
#pragma unroll
                for (int bj = 0; bj < 2; ++bj) { const f32x4 v0 = acc[ai][bj][m][0], v1 = acc[ai][bj][m][1];
                    u32x4 w; w.x = cvt_pk_bf16(v0[0], v0[1]); w.y = cvt_pk_bf16(v0[2], v0[3]); w.z = cvt_pk_bf16(v1[0], v1[1]); w.w = cvt_pk_bf16(v1[2], v1[3]);
                    *(u32x4*)(rowp + bj * HALF) = w; } }
    }
};

template <int CTRL> __device__ __forceinline__ float dpp_ror(float v) { return __builtin_bit_cast(float, __builtin_amdgcn_update_dpp(0, __builtin_bit_cast(int, v), CTRL, 0xF, 0xF, true)); }
struct EpiConvGate {
    static constexpr bool PERM = true, AFTER_DRAIN = false;
    bf16_t* A; int lda; float* halo; const float* cw; const float* cb; int nup, dff;
    __device__ __forceinline__ void operator()(const f32x4 (&acc)[2][2][4][2], const Unit& u, int wr, int wc, int fr, int fq) const {
        const int chl = wc * 32 + 8 * fq;
#pragma unroll
        for (int n = 0; n < 2; ++n) {
            const int c = u.pn * 128 + chl + 4 * n, colp = u.pn * 256 + chl + 4 * n;
            const f32x4 wv0 = *(const f32x4*)(cw + c), wv1 = *(const f32x4*)(cw + nup + c), wv2 = *(const f32x4*)(cw + 2 * nup + c), bv = *(const f32x4*)(cb + c);
            const f32x4 wg0 = *(const f32x4*)(cw + dff + c), wg1 = *(const f32x4*)(cw + nup + dff + c), wg2 = *(const f32x4*)(cw + 2 * nup + dff + c), bg = *(const f32x4*)(cb + dff + c);
#pragma unroll
            for (int ai = 0; ai < 2; ++ai) {
                const int grow = u.pm * BM + ai * HALF + wr * 64;
                float* hb = halo + (size_t)(grow >> 6) * 4 * nup + colp;
                if (fr < 2) { *(f32x4*)(hb + (size_t)fr * nup) = acc[ai][0][0][n]; *(f32x4*)(hb + (size_t)fr * nup + 128) = acc[ai][1][0][n]; }
                if (fr >= 14) { *(f32x4*)(hb + (size_t)(fr - 12) * nup) = acc[ai][0][3][n]; *(f32x4*)(hb + (size_t)(fr - 12) * nup + 128) = acc[ai][1][3][n]; }
                f32x4 cv[4];
                {   f32x4 P1 = {0.f, 0.f, 0.f, 0.f}, P2 = P1;
#pragma unroll
                    for (int m = 0; m < 4; ++m) { f32x4 R1, R2;
#pragma unroll
                        for (int e = 0; e < 4; ++e) { R1[e] = dpp_ror<0x121>(acc[ai][0][m][n][e]); R2[e] = dpp_ror<0x122>(acc[ai][0][m][n][e]); }
                        const f32x4 p1 = (fr >= 1) ? R1 : P1, p2 = (fr >= 2) ? R2 : P2; P1 = R1; P2 = R2;
                        cv[m] = wv0 * p2 + wv1 * p1 + wv2 * acc[ai][0][m][n] + bv; } }
                {   f32x4 P1 = {0.f, 0.f, 0.f, 0.f}, P2 = P1;
#pragma unroll
                    for (int m = 0; m < 4; ++m) { f32x4 R1, R2;
#pragma unroll
                        for (int e = 0; e < 4; ++e) { R1[e] = dpp_ror<0x121>(acc[ai][1][m][n][e]); R2[e] = dpp_ror<0x122>(acc[ai][1][m][n][e]); }
                        const f32x4 p1 = (fr >= 1) ? R1 : P1, p2 = (fr >= 2) ? R2 : P2; P1 = R1; P2 = R2;
                        const f32x4 cg = wg0 * p2 + wg1 * p1 + wg2 * acc[ai][1][m][n] + bg;
                        f32x4 o;
#pragma unroll
                        for (int e = 0; e < 4; ++e) o[e] = cg[e] * __builtin_amdgcn_rcpf(1.0f + __expf(-cg[e])) * cv[m][e];
                        unsigned w0 = cvt_pk_bf16(o[0], o[1]), w1 = cvt_pk_bf16(o[2], o[3]);
                        *(unsigned long long*)(A + (size_t)(grow + m * 16 + fr) * lda + c) = (unsigned long long)w0 | ((unsigned long long)w1 << 32); } }
            }
        }
    }
};

template <bool BASE_F32>
struct EpiResGate {
    static constexpr bool PERM = true, AFTER_DRAIN = false;
    const void* base; bf16_t* out; int ldc; const float* gate; int gstride; int rows_per_batch;
    __device__ __forceinline__ void operator()(const f32x4 (&acc)[2][2][4][2], const Unit& u, int wr, int wc, int fr, int fq) const {
        const int col0 = u.pn * BM + wc * 32 + 8 * fq;
        const int b = (u.pm * BM) / rows_per_batch;
        f32x4 gv[2][2];
#pragma unroll
        for (int bj = 0; bj < 2; ++bj)
#pragma unroll
            for (int n = 0; n < 2; ++n) gv[bj][n] = *(const f32x4*)(gate + (size_t)b * gstride + col0 + bj * HALF + n * 4);
#pragma unroll
        for (int ai = 0; ai < 2; ++ai)
#pragma unroll
            for (int m = 0; m < 4; ++m) { const size_t off = (size_t)(u.pm * BM + ai * HALF + wr * 64 + m * 16 + fr) * ldc + col0;
#pragma unroll
                for (int bj = 0; bj < 2; ++bj) { f32x4 b0, b1;
                    if (BASE_F32) { b0 = *(const f32x4*)((const float*)base + off + bj * HALF); b1 = *(const f32x4*)((const float*)base + off + bj * HALF + 4); }
                    else { const u32x4 w = *(const u32x4*)((const bf16_t*)base + off + bj * HALF);
                        b0 = (f32x4){__builtin_bit_cast(float, w.x << 16), __builtin_bit_cast(float, w.x & 0xffff0000u), __builtin_bit_cast(float, w.y << 16), __builtin_bit_cast(float, w.y & 0xffff0000u)};
                        b1 = (f32x4){__builtin_bit_cast(float, w.z << 16), __builtin_bit_cast(float, w.z & 0xffff0000u), __builtin_bit_cast(float, w.w << 16), __builtin_bit_cast(float, w.w & 0xffff0000u)}; }
                    const f32x4 o0 = b0 + gv[bj][0] * acc[ai][bj][m][0], o1 = b1 + gv[bj][1] * acc[ai][bj][m][1];
                    u32x4 w; w.x = cvt_pk_bf16(o0[0], o0[1]); w.y = cvt_pk_bf16(o0[2], o0[3]); w.z = cvt_pk_bf16(o1[0], o1[1]); w.w = cvt_pk_bf16(o1[2], o1[3]);
                    *(u32x4*)(out + off + bj * HALF) = w; }
                if (m & 1) asm volatile("" ::: "memory"); }
    }
};

template <class Epi, class Sched, bool ALIGN_EPI = false, bool SP2 = false>
__device__ __forceinline__ void gemm_phase(PG8_LAS unsigned char* lds, const Gemm g, const Sched& S, const Epi& E, int wave_) {
    const int tid_ = tid_from_wave(wave_);
    const int tid = tid_, wid = __builtin_amdgcn_readfirstlane(tid >> 6), lane = tid & 63, wr = wid >> 2, wc = wid & 3, fr = lane & 15, fq = lane >> 4;
    const int K = g.K, nt = K / BK;
    unsigned voffA[2], voffB[2];
#pragma unroll
    for (int i = 0; i < 2; ++i) { int R, C; stage_rc(tid * 16 + i * 8192, R, C); const int Rb = Epi::PERM ? ((R & ~31) + perm32(R & 31)) : R;
        voffA[i] = (unsigned)(R * K + C) * 2u; voffB[i] = (unsigned)(Rb * K + C) * 2u; }
    const size_t kstep = (size_t)(BK * 2);
    const size_t hstep = (size_t)HALF * K * 2;
    const size_t tstep = 2 * hstep;
    const unsigned ldsw = (unsigned)wid * 1024u;
    const int aoff = lds_byte(wr * 64 + fr, fq * 8), boff = lds_byte(wc * 32 + fr, fq * 8);
#define PG8_SA(b, h) (((b) * 2 + (h)) * HTB)
#define PG8_SB(b, h) ((4 + (b) * 2 + (h)) * HTB)
#define PG8_STAGE(bufoff, gbase, voff) do { _Pragma("unroll") for (int _i = 0; _i < 2; ++_i) \
        __builtin_amdgcn_global_load_lds((const unsigned*)((const char*)(gbase) + (voff)[_i]), (PG8_LAS unsigned*)(lds + (bufoff) + ldsw + _i * 8192), 16, 0, 0); } while (0)
#define PG8_LDA(dst, b, h) do { _Pragma("unroll") for (int m = 0; m < 4; ++m) _Pragma("unroll") for (int k = 0; k < 2; ++k) dst[m][k] = *(const PG8_LAS bf16x8*)(lds + PG8_SA(b, h) + aoff + m * 2048 + k * 1024); } while (0)
#define PG8_LDB(dst, b, h) do { _Pragma("unroll") for (int n = 0; n < 2; ++n) _Pragma("unroll") for (int k = 0; k < 2; ++k) dst[n][k] = *(const PG8_LAS bf16x8*)(lds + PG8_SB(b, h) + boff + n * 2048 + k * 1024); } while (0)
#define PG8_MMA(ai, bj, At, Bt) do { __builtin_amdgcn_s_setprio(1); _Pragma("unroll") for (int m = 0; m < 4; ++m) _Pragma("unroll") for (int n = 0; n < 2; ++n) _Pragma("unroll") for (int k = 0; k < 2; ++k) \
        acc[ai][bj][m][n] = __builtin_amdgcn_mfma_f32_16x16x32_bf16(Bt[n][k], At[m][k], acc[ai][bj][m][n], 0, 0, 0); __builtin_amdgcn_s_setprio(0); } while (0)
#define PG8_WAIT_V(n) asm volatile("s_waitcnt vmcnt(" #n ")" ::: "memory")
#define PG8_WAIT_L(n) asm volatile("s_waitcnt lgkmcnt(" #n ")" ::: "memory")
#define PG8_BAR __builtin_amdgcn_s_barrier()
#define PG8_SCHED __builtin_amdgcn_sched_barrier(0)
    Unit cur, nxt; int ui = 0;
    if (!S.next(0, cur)) return;
    f32x4 acc[2][2][4][2];
#pragma unroll
    for (int a = 0; a < 2; ++a)
#pragma unroll
        for (int b = 0; b < 2; ++b)
#pragma unroll
            for (int m = 0; m < 4; ++m)
#pragma unroll
                for (int n = 0; n < 2; ++n) acc[a][b][m][n] = (f32x4){0.f, 0.f, 0.f, 0.f};
    bf16x8 At[4][2], B0[2][2], B1[2][2];
    const char* cA = (const char*)g.A + (size_t)cur.pm * tstep; const char* cB = (const char*)g.Bt + (size_t)cur.pn * tstep;
    S.a_ready(cur);
    if constexpr (SP2) {
        PG8_STAGE(PG8_SB(0, 0), cB, voffB); PG8_STAGE(PG8_SB(0, 1), cB + hstep, voffB); PG8_STAGE(PG8_SA(0, 0), cA, voffA); PG8_STAGE(PG8_SA(0, 1), cA + hstep, voffA);
        if (wr == 1) PG8_BAR;
        PG8_WAIT_V(2); PG8_BAR;
        PG8_STAGE(PG8_SB(1, 0), cB + kstep, voffB); PG8_STAGE(PG8_SA(1, 0), cA + kstep, voffA); PG8_STAGE(PG8_SB(1, 1), cB + hstep + kstep, voffB);
        PG8_WAIT_V(6); PG8_BAR;
    } else {
        PG8_STAGE(PG8_SB(0, 0), cB, voffB); PG8_STAGE(PG8_SA(0, 0), cA, voffA); PG8_STAGE(PG8_SB(0, 1), cB + hstep, voffB); PG8_STAGE(PG8_SA(0, 1), cA + hstep, voffA);
        if (wr == 1) PG8_BAR;
        PG8_WAIT_V(4); PG8_BAR;
        PG8_STAGE(PG8_SB(1, 0), cB + kstep, voffB); PG8_STAGE(PG8_SA(1, 0), cA + kstep, voffA); PG8_STAGE(PG8_SB(1, 1), cB + hstep + kstep, voffB);
        PG8_WAIT_V(6); PG8_BAR;
    }
    for (;;) {
        const bool has_next = S.next(ui + 1, nxt);
        const char* nA = has_next ? (const char*)g.A + (size_t)nxt.pm * tstep : cA; const char* nB = has_next ? (const char*)g.Bt + (size_t)nxt.pn * tstep : cB;
        for (int t = 0; t < nt; t += 2) {
            const bool last = (t == nt - 2);
            const char* a1 = cA + (size_t)(t + 1) * kstep;
            const char* a2 = last ? nA : cA + (size_t)(t + 2) * kstep; const char* b2 = last ? nB : cB + (size_t)(t + 2) * kstep;
            const char* a3 = a2 + kstep; const char* b3 = b2 + kstep;
            if (last && has_next) S.a_ready(nxt);
            if constexpr (SP2) {
            PG8_LDB(B0, 0, 0); PG8_LDB(B1, 0, 1); PG8_SCHED; PG8_LDA(At, 0, 0); PG8_STAGE(PG8_SA(1, 1), a1 + hstep, voffA);
            PG8_WAIT_V(8); PG8_WAIT_L(0); PG8_BAR; PG8_MMA(0, 0, At, B0); PG8_MMA(0, 1, At, B1); PG8_BAR; PG8_SCHED;
            PG8_LDA(At, 0, 1); PG8_STAGE(PG8_SB(0, 0), b2, voffB); PG8_STAGE(PG8_SB(0, 1), b2 + hstep, voffB); PG8_STAGE(PG8_SA(0, 0), a2, voffA);
            PG8_WAIT_V(8); PG8_WAIT_L(0); PG8_BAR; PG8_MMA(1, 0, At, B0); PG8_MMA(1, 1, At, B1); PG8_BAR; PG8_SCHED;
            PG8_LDB(B0, 1, 0); PG8_LDB(B1, 1, 1); PG8_SCHED; PG8_LDA(At, 1, 0); PG8_STAGE(PG8_SA(0, 1), a2 + hstep, voffA);
            PG8_WAIT_V(8); PG8_WAIT_L(0); PG8_BAR; PG8_MMA(0, 0, At, B0); PG8_MMA(0, 1, At, B1); PG8_BAR; PG8_SCHED;
            PG8_LDA(At, 1, 1); PG8_STAGE(PG8_SB(1, 0), b3, voffB); PG8_STAGE(PG8_SB(1, 1), b3 + hstep, voffB); PG8_STAGE(PG8_SA(1, 0), a3, voffA);
            PG8_WAIT_V(8); PG8_WAIT_L(0); PG8_BAR; PG8_MMA(1, 0, At, B0); PG8_MMA(1, 1, At, B1); PG8_BAR; PG8_SCHED;
            } else {
            PG8_LDB(B0, 0, 0); PG8_SCHED; PG8_LDA(At, 0, 0); PG8_STAGE(PG8_SA(1, 1), a1 + hstep, voffA);
            PG8_WAIT_L(8); PG8_BAR; PG8_WAIT_L(0); PG8_MMA(0, 0, At, B0); PG8_BAR; PG8_SCHED;
            PG8_LDB(B1, 0, 1); PG8_STAGE(PG8_SB(0, 0), b2, voffB);
            PG8_BAR; PG8_WAIT_L(0); PG8_MMA(0, 1, At, B1); PG8_BAR;
            PG8_LDA(At, 0, 1); PG8_STAGE(PG8_SA(0, 0), a2, voffA);
            PG8_BAR; PG8_WAIT_L(0); PG8_MMA(1, 0, At, B0); PG8_BAR; PG8_SCHED;
            PG8_STAGE(PG8_SB(0, 1), b2 + hstep, voffB);
            PG8_WAIT_V(6); PG8_BAR; PG8_MMA(1, 1, At, B1); PG8_BAR;
            PG8_LDB(B0, 1, 0); PG8_SCHED; PG8_LDA(At, 1, 0); PG8_STAGE(PG8_SA(0, 1), a2 + hstep, voffA);
            PG8_WAIT_L(8); PG8_BAR; PG8_WAIT_L(0); PG8_MMA(0, 0, At, B0); PG8_BAR; PG8_SCHED;
            PG8_LDB(B1, 1, 1); PG8_STAGE(PG8_SB(1, 0), b3, voffB);
            PG8_BAR; PG8_WAIT_L(0); PG8_MMA(0, 1, At, B1); PG8_BAR;
            PG8_LDA(At, 1, 1); PG8_STAGE(PG8_SA(1, 0), a3, voffA);
            PG8_BAR; PG8_WAIT_L(0); PG8_MMA(1, 0, At, B0); PG8_BAR; PG8_SCHED;
            PG8_STAGE(PG8_SB(1, 1), b3 + hstep, voffB);
            PG8_WAIT_V(6); PG8_BAR; PG8_MMA(1, 1, At, B1); PG8_BAR;
            }
        }
        if constexpr (ALIGN_EPI) { if (wr == 0) PG8_BAR; }
        if constexpr (!Epi::AFTER_DRAIN) { E(acc, cur, wr, wc, fr, fq); S.done(cur); }
        if (!has_next) break;
#pragma unroll
        for (int a = 0; a < 2; ++a)
#pragma unroll
            for (int b = 0; b < 2; ++b)
#pragma unroll
                for (int m = 0; m < 4; ++m)
#pragma unroll
                    for (int n = 0; n < 2; ++n) acc[a][b][m][n] = (f32x4){0.f, 0.f, 0.f, 0.f};
        cur = nxt; cA = nA; cB = nB; ++ui;
        if constexpr (ALIGN_EPI) { if (wr == 1) PG8_BAR; }
    }
    PG8_WAIT_V(0);
    if constexpr (!ALIGN_EPI) { if (wr == 0) PG8_BAR; }
    PG8_BAR;
    if constexpr (Epi::AFTER_DRAIN) { E.fused(acc, cur, wr, wc, fr, fq, lds, wid, lane); S.done(cur); }
#undef PG8_SA
#undef PG8_SB
#undef PG8_STAGE
#undef PG8_LDA
#undef PG8_LDB
#undef PG8_MMA
#undef PG8_WAIT_V
#undef PG8_WAIT_L
#undef PG8_BAR
#undef PG8_SCHED
}
}

namespace moba {
using bf16 = unsigned short;
typedef short bf16x8 __attribute__((ext_vector_type(8)));
typedef short s16x4 __attribute__((ext_vector_type(4)));
typedef float f32x16 __attribute__((ext_vector_type(16)));
typedef float f32x4 __attribute__((ext_vector_type(4)));
typedef unsigned u32x4 __attribute__((ext_vector_type(4)));
#define MLAS __attribute__((address_space(3)))
typedef MLAS char lchar; typedef MLAS float lfloat; typedef MLAS bf16x8 lbf16x8;
template <class A, class Bt> struct same_t { static constexpr bool v = false; };
template <class A> struct same_t<A, A> { static constexpr bool v = true; };
constexpr int D = 128, LDI = 6656, LDO = 2048;
constexpr float THR = 8.f;
constexpr bool WSKIP = false;
constexpr float SCALE = 0.08838834764831845f;
constexpr int NW = 8, QBLK = 32, KVBLK = 64, QB = NW * QBLK;
constexpr int SHM_V = KVBLK * D * 2, SHM_K = KVBLK * D * 2;
constexpr int LDS_BYTES = 2 * SHM_V + 2 * SHM_K + NW * 64 * 4;
#define KSWZ(row, colB) ((row) * 256 + ((colB) ^ (((row) & 7) << 4)))
#define SBAR() __builtin_amdgcn_sched_barrier(0)
__device__ __forceinline__ int v_st(int k, int c) { const int kk = (k & ~0xC) | ((k & 4) << 1) | ((k & 8) >> 1); return ((kk >> 3) * 4 + (c >> 5)) * 512 + ((kk & 7) * 32 + (c & 31)) * 2; }
__device__ __forceinline__ int v_rd_base(int lane) { return ((lane & 3) << 3) | (((lane >> 2) & 3) << 6) | (((lane >> 4) & 1) << 5) | (((lane >> 5) & 1) << 8); }
constexpr int v_rd_off(int d0, int ks, int half) { return d0 * 512 + ks * 4096 + half * 2048; }
__device__ __forceinline__ int crow(int r, int hi) { return (r & 3) + 8 * (r >> 2) + 4 * hi; }
__device__ __forceinline__ unsigned cvtpk(float lo, float hi) {
    unsigned r; asm volatile("v_cvt_pk_bf16_f32 %0, %1, %2" : "=v"(r) : "v"(lo), "v"(hi)); return r;
}
__device__ __forceinline__ bf16x8 pack8(f32x4 a, f32x4 b) {
    u32x4 w = {cvtpk(a[0], a[1]), cvtpk(a[2], a[3]), cvtpk(b[0], b[1]), cvtpk(b[2], b[3])};
    return *reinterpret_cast<bf16x8*>(&w);
}
template <class T> __device__ __forceinline__ bf16x8 load8(const T* p) {
    if constexpr (same_t<T, float>::v) { return pack8(*(const f32x4*)p, *(const f32x4*)(p + 4)); }
    else { return *reinterpret_cast<const bf16x8*>(p); }
}
__device__ __forceinline__ void mask_tile(f32x16& p0, f32x16& p1, int dq, unsigned W) {
    const float NEG = -__builtin_inff();
#pragma unroll
    for (int r = 0; r < 16; ++r) {
        const int c = (r & 3) + 8 * (r >> 2);
        if ((unsigned)(dq - c) >= W) p0[r] = NEG;
        if ((unsigned)(dq - c - 32) >= W) p1[r] = NEG;
    }
}
__device__ __forceinline__ void partialSM(f32x16& p0, f32x16& p1, float& m_reg, float& mn, float& alpha) {
    float pmax = p0[0]; for (int r = 1; r < 16; ++r) pmax = fmaxf(pmax, p0[r]); for (int r = 0; r < 16; ++r) pmax = fmaxf(pmax, p1[r]);
    { auto rr = __builtin_amdgcn_permlane32_swap(__float_as_uint(pmax), __float_as_uint(pmax), false, false);
      pmax = fmaxf(__uint_as_float(rr[0]), __uint_as_float(rr[1])); }
    constexpr float C2 = 1.4426950408889634f * SCALE;
    if (__builtin_expect(__all((pmax - m_reg) * SCALE <= THR), 1)) { mn = m_reg; alpha = 1.f; }
    else { mn = fmaxf(m_reg, pmax); alpha = __builtin_amdgcn_exp2f((m_reg - mn) * C2); m_reg = mn; }
    const float mnL = -mn * C2;
    for (int r = 0; r < 16; ++r) p0[r] = fmaf(p0[r], C2, mnL); for (int r = 0; r < 16; ++r) p1[r] = fmaf(p1[r], C2, mnL);
    for (int r = 0; r < 16; ++r) p0[r] = __builtin_amdgcn_exp2f(p0[r]);
}
__device__ __forceinline__ void finishSM(f32x16& p0, f32x16& p1, float alpha, float& l_reg, bf16x8& pa0, bf16x8& pa1, bf16x8& pa2, bf16x8& pa3) {
    for (int r = 0; r < 16; ++r) p1[r] = __builtin_amdgcn_exp2f(p1[r]);
    float ps = 0; for (int r = 0; r < 16; ++r) ps += p0[r]; for (int r = 0; r < 16; ++r) ps += p1[r];
    { auto rr = __builtin_amdgcn_permlane32_swap(__float_as_uint(ps), __float_as_uint(ps), false, false);
      ps = __uint_as_float(rr[0]) + __uint_as_float(rr[1]); }
    l_reg = l_reg * alpha + ps;
#define PK4(P, B_, OUT) do { unsigned a0 = cvtpk(P[B_+0], P[B_+1]), a1 = cvtpk(P[B_+2], P[B_+3]);                          \
        unsigned b0 = cvtpk(P[B_+4], P[B_+5]), b1 = cvtpk(P[B_+6], P[B_+7]);                                             \
        auto r0 = __builtin_amdgcn_permlane32_swap(a0, b0, false, false); auto r1 = __builtin_amdgcn_permlane32_swap(a1, b1, false, false); \
        u32x4 w = {r0[0], r1[0], r0[1], r1[1]}; OUT = *reinterpret_cast<bf16x8*>(&w); } while (0)
    PK4(p0, 0, pa0); PK4(p0, 8, pa1); PK4(p1, 0, pa2); PK4(p1, 8, pa3);
#undef PK4
}
template <int KB, bool SK>
__device__ __forceinline__ void qkt(f32x16& p0, f32x16& p1, const lchar* K_lds, int r32, int hi, const bf16x8* qr, bool act, float slopeR, float lb) {
    if (SK && !act) { const float NEG = -__builtin_inff();
#pragma unroll
        for (int r = 0; r < 16; ++r) { p0[r] = NEG; p1[r] = NEG; } return; }
#pragma unroll
    for (int r = 0; r < 16; ++r) { const int c = (r & 3) + 8 * (r >> 2); p0[r] = __builtin_fmaf(slopeR, (float)c, lb); p1[r] = __builtin_fmaf(slopeR, (float)(c + 32), lb); }
    const lchar* kb[4];
#pragma unroll
    for (int dd = 0; dd < 4; ++dd) kb[dd] = K_lds + KB * SHM_K + KSWZ(r32, (dd * 16 + hi * 8) * 2);
#pragma unroll
    for (int d0 = 0; d0 < 8; ++d0) { const lchar* a = kb[d0 & 3] + (d0 >> 2) * 128;
        bf16x8 b0 = *(const lbf16x8*)(a);
        bf16x8 b1 = *(const lbf16x8*)(a + 32 * 256);
        p0 = __builtin_amdgcn_mfma_f32_32x32x16_bf16(b0, qr[d0], p0, 0, 0, 0);
        p1 = __builtin_amdgcn_mfma_f32_32x32x16_bf16(b1, qr[d0], p1, 0, 0, 0); }
}
template <int VB, bool SK>
__device__ __forceinline__ void pv_tile(f32x16* o, int vb0, bf16x8 pa0, bf16x8 pa1, bf16x8 pa2, bf16x8 pa3, bool act) {
    if (SK && !act) return;
#define TRRD(dst, off) asm volatile("ds_read_b64_tr_b16 %0, %1 offset:%2" : "=&v"(dst) : "v"(vb0), "i"(off) : "memory")
#define PV_D0(d0) do { s16x4 l0, l1, l2, l3, h0, h1, h2, h3; constexpr int b_ = VB * SHM_V + v_rd_off(d0, 0, 0);     \
        TRRD(l0, b_); TRRD(h0, b_ + 2048); TRRD(l1, b_ + 4096); TRRD(h1, b_ + 6144); TRRD(l2, b_ + 8192); TRRD(h2, b_ + 10240); TRRD(l3, b_ + 12288); TRRD(h3, b_ + 14336); \
        asm volatile("s_waitcnt lgkmcnt(0)" ::: "memory"); SBAR();                 \
        o[d0] = __builtin_amdgcn_mfma_f32_32x32x16_bf16(pa0, (bf16x8){l0[0], l0[1], l0[2], l0[3], h0[0], h0[1], h0[2], h0[3]}, o[d0], 0, 0, 0);   \
        o[d0] = __builtin_amdgcn_mfma_f32_32x32x16_bf16(pa1, (bf16x8){l1[0], l1[1], l1[2], l1[3], h1[0], h1[1], h1[2], h1[3]}, o[d0], 0, 0, 0);   \
        o[d0] = __builtin_amdgcn_mfma_f32_32x32x16_bf16(pa2, (bf16x8){l2[0], l2[1], l2[2], l2[3], h2[0], h2[1], h2[2], h2[3]}, o[d0], 0, 0, 0);   \
        o[d0] = __builtin_amdgcn_mfma_f32_32x32x16_bf16(pa3, (bf16x8){l3[0], l3[1], l3[2], l3[3], h3[0], h3[1], h3[2], h3[3]}, o[d0], 0, 0, 0); } while (0)
    PV_D0(0); PV_D0(1); PV_D0(2); PV_D0(3);
#undef PV_D0
#undef TRRD
}

typedef __attribute__((address_space(1))) char gchar; typedef __attribute__((address_space(1))) bf16x8 gbf16x8;
__device__ __forceinline__ const gchar* uni_ptr(const char* p) { const unsigned long long v = (unsigned long long)p;
    const unsigned lo = __builtin_amdgcn_readfirstlane((unsigned)v), hi = __builtin_amdgcn_readfirstlane((unsigned)(v >> 32)); return (const gchar*)(((unsigned long long)hi << 32) | lo); }
template <class TIn, class TOut> struct BlockRef { const TIn* Q; const TIn* K; const TIn* V; TOut* O; int P0; const __attribute__((address_space(3))) unsigned* sel; float slopeR; };
template <class TIn> struct Seam {
    bf16x8 qr[8];
    bf16x8 st_v0, st_v1, st_k0, st_k1; f32x4 sf0, sf1, sf2, sf3;
    f32x4 tq[16];
};
__device__ __forceinline__ int swa_jlo(int P0, int W) { const int lowk = P0 - W + 1; return lowk > 0 ? lowk / KVBLK : 0; }
#define ROW(p, k0, rr) ((const TIn*)((const char*)(p) + (size_t)(k0) * (LDI * sizeof(TIn)) + (unsigned)(((rr) * LDI + sc) * (int)sizeof(TIn))))
#define VMW() asm volatile("s_waitcnt vmcnt(0)" ::: "memory")
#define VMWN(n) asm volatile("s_waitcnt vmcnt(%0)" :: "i"(n) : "memory")
#define SLOAD_H(Kp, Vp, k0) do { const gchar* kb__ = uni_ptr((const char*)(Kp) + (size_t)(k0) * (LDI * sizeof(TIn))); const gchar* vb__ = uni_ptr((const char*)(Vp) + (size_t)(k0) * (LDI * sizeof(TIn))); \
                         S.st_v0 = *(const gbf16x8*)(vb__ + roff0); S.st_v1 = *(const gbf16x8*)(vb__ + roff1);              \
                         S.st_k0 = *(const gbf16x8*)(kb__ + roff0); S.st_k1 = *(const gbf16x8*)(kb__ + roff1); } while (0)
#define SWRITE_HK(bf) do { *(lbf16x8*)(K_lds + (bf) * SHM_K + kws) = S.st_k0; *(lbf16x8*)(K_lds + (bf) * SHM_K + kws + 32 * 256) = S.st_k1; } while (0)
#define SWRITE_HV(bf) do { *(lbf16x8*)(V_lds + (bf) * SHM_V + vst0) = S.st_v0; *(lbf16x8*)(V_lds + (bf) * SHM_V + vst1) = S.st_v1; } while (0)
#define SWRITE_H(bf) do { SWRITE_HV(bf); SWRITE_HK(bf); } while (0)
#define SLOAD_F(p, k0) do { S.sf0 = *(const f32x4*)ROW(p, k0, sr); S.sf1 = *(const f32x4*)(ROW(p, k0, sr) + 4);                \
                            S.sf2 = *(const f32x4*)ROW(p, k0, 32 + sr); S.sf3 = *(const f32x4*)(ROW(p, k0, 32 + sr) + 4); } while (0)
#define SWRITE_KF(bf) do { *(lbf16x8*)(K_lds + (bf) * SHM_K + kws) = pack8(S.sf0, S.sf1); *(lbf16x8*)(K_lds + (bf) * SHM_K + kws + 32 * 256) = pack8(S.sf2, S.sf3); } while (0)
#define SWRITE_VF(bf) do { *(lbf16x8*)(V_lds + (bf) * SHM_V + vst0) = pack8(S.sf0, S.sf1); *(lbf16x8*)(V_lds + (bf) * SHM_V + vst1) = pack8(S.sf2, S.sf3); } while (0)
template <class TIn, class TOut>
__device__ __forceinline__ void causal_swa_prime(const BlockRef<TIn, TOut>& cur, int W, lchar* lds, Seam<TIn>& S, int wave_) {
    constexpr bool F32 = same_t<TIn, float>::v;
    const int tid_ = tid_from_wave(wave_);
    const int tid = tid_, wid = __builtin_amdgcn_readfirstlane(tid >> 6), lane = tid & 63, r32 = lane & 31, hi = lane >> 5;
    const int sr = tid >> 4, sc = (tid & 15) * 8, kws = KSWZ(sr, sc * 2); lchar* K_lds = lds + 2 * SHM_V;
    const unsigned roff0 = (unsigned)((sr * LDI + sc) * (int)sizeof(TIn)), roff1 = (unsigned)(((32 + sr) * LDI + sc) * (int)sizeof(TIn));
    const int kb0 = ((cur.P0 + QB - 1) / KVBLK) * KVBLK;
    for (int d0 = 0; d0 < 8; ++d0) S.qr[d0] = *(const gbf16x8*)(uni_ptr((const char*)cur.Q) + (unsigned)(((wid * QBLK + r32) * LDI + hi * 8) * (int)sizeof(TIn)) + d0 * 16 * sizeof(TIn));
    if constexpr (F32) { SLOAD_F((const float*)cur.K, kb0); VMW(); SWRITE_KF(0); SBAR(); SLOAD_F((const float*)cur.V, kb0); }
    else { SLOAD_H(cur.K, cur.V, kb0); VMW(); SWRITE_HK(0); }
    __syncthreads();
}
template <class TIn, class TOut>
__device__ __forceinline__ void causal_swa_block(const BlockRef<TIn, TOut>& cur, const BlockRef<TIn, TOut>& nxt, int skv, int W, lchar* lds, Seam<TIn>& S, int wave_) {
    constexpr bool F32 = same_t<TIn, float>::v;
    const int tid_ = tid_from_wave(wave_);
    const int tid = tid_, wid = __builtin_amdgcn_readfirstlane(tid >> 6), lane = tid & 63, r32 = lane & 31, hi = lane >> 5;
    const int j_lo = swa_jlo(cur.P0, W);
    int j_hi = (cur.P0 + QB - 1) / KVBLK + 1; if (j_hi > skv / KVBLK) j_hi = skv / KVBLK;
    const int NT = j_hi - j_lo;
    const int kbn = ((nxt.P0 + QB - 1) / KVBLK) * KVBLK;
    const unsigned selm = cur.sel[wid * QBLK + r32] | (1u << (cur.P0 >> 8)); const float slopeR = __builtin_bit_cast(float, __builtin_amdgcn_readfirstlane(__builtin_bit_cast(unsigned, cur.slopeR))); const int tqm = cur.P0 + wid * QBLK + r32 - 4 * hi;
#define LB(t) (((selm >> (KBASE(t) >> 8)) & 1u) ? slopeR * (float)(KBASE(t) - tqm) : -__builtin_inff())
    const int qlo = cur.P0 + wid * QBLK, qm = qlo + r32 - 4 * hi;
    lchar* V_lds = lds; lchar* K_lds = lds + 2 * SHM_V;
    lfloat* ws = (lfloat*)(lds + 2 * SHM_V + 2 * SHM_K) + wid * 64; lfloat* li_l = ws; lfloat* al_l = ws + 32;
    float m_reg = -1e30f, l_reg = 0; f32x16 o[4] = {};
    const unsigned roff0 = (unsigned)(((tid >> 4) * LDI + (tid & 15) * 8) * (int)sizeof(TIn)), roff1 = (unsigned)(((32 + (tid >> 4)) * LDI + (tid & 15) * 8) * (int)sizeof(TIn));
    const int sr = tid >> 4, sc = (tid & 15) * 8, vst0 = v_st(sr, sc), vst1 = v_st(32 + sr, sc), kws = KSWZ(sr, sc * 2);
    const int vb0 = (int)(unsigned)(uintptr_t)V_lds + v_rd_base(lane);
    const TIn* Kh = cur.K; const TIn* Vh = cur.V;
#define RESC(a) do { if (__any((a) < 1.f)) { if (hi == 0) al_l[r32] = (a); asm volatile("s_waitcnt lgkmcnt(0)" ::: "memory");              \
                     for (int d_ = 0; d_ < 4; ++d_) for (int r = 0; r < 16; ++r) o[d_][r] *= al_l[crow(r, hi)]; } } while (0)
#define KBASE(t) ((j_hi - 1 - (t)) * KVBLK)
#define ACT(t) (KBASE(t) <= qlo + QBLK - 1 && KBASE(t) + KVBLK - 1 >= qlo - W + 1)
#define MASKT(P0_, P1_, t) do { const int kb_ = KBASE(t); if ((!SK || ACT(t)) && (kb_ + KVBLK - 1 > qlo || kb_ <= qlo + QBLK - 1 - W)) mask_tile(P0_, P1_, qm - kb_, (unsigned)W); } while (0)
    constexpr int NQL = F32 ? 16 : 8;
    constexpr bool SK = WSKIP && !F32;
#define SEAM_K0() do { VMWN(NQL); if constexpr (F32) { SWRITE_KF(0); SBAR(); SLOAD_F((const float*)nxt.V, kbn); } else { SWRITE_HK(0); } SBAR(); } while (0)
    unsigned touch_reg = 0u; const int tl_ = wid * 32 + (lane & 31);
    const unsigned toff = (unsigned)(((tl_ & 127) >> 1) * LDI * (int)sizeof(TIn) + (tl_ & 1) * 128);
    const gchar* tbase = uni_ptr((const char*)((tl_ >> 7) ? (const void*)Vh : (const void*)Kh));
#if MOBA_CHECK
#define TOUCH(k0) do {} while (0)
#else
#define TOUCH(k0) do { const gchar* tp_ = tbase + (size_t)(k0) * (LDI * sizeof(TIn)) + toff; asm volatile("global_load_dword %0, %1, off" : "+v"(touch_reg) : "v"(tp_) : "memory"); } while (0)
#endif
    f32x16 pA0, pA1, pB0, pB1; float mnA, mnB, alA, alB; bf16x8 pa0, pa1, pa2, pa3;
    if constexpr (F32) { VMW(); SWRITE_VF(0); SBAR(); } else { SWRITE_HV(0); SBAR(); }
    if (NT > 1) { if constexpr (F32) SLOAD_F((const float*)Kh, KBASE(1)); else SLOAD_H(Kh, Vh, KBASE(1)); }
    SBAR(); qkt<0, SK>(pA0, pA1, K_lds, r32, hi, S.qr, ACT(0), slopeR, LB(0));
    if constexpr (F32) { if (NT > 1) { VMW(); SWRITE_KF(1); SBAR(); SLOAD_F((const float*)Vh, KBASE(1)); } }
    MASKT(pA0, pA1, 0); partialSM(pA0, pA1, m_reg, mnA, alA);
    if (NT > 1) { VMW(); if constexpr (F32) { SWRITE_VF(1); SBAR(); if (NT > 2) SLOAD_F((const float*)Kh, KBASE(2)); } else SWRITE_H(1); }
    __syncthreads();
#define HALF_STEP(PX0, PX1, mnX, alX, PY0, PY1, alY, t, KB, VB, SB) do {                                                      \
        SBAR(); qkt<KB, SK>(PX0, PX1, K_lds, r32, hi, S.qr, ACT(t), slopeR, LB(t));                                             \
        finishSM(PY0, PY1, alY, l_reg, pa0, pa1, pa2, pa3); SBAR();                                                           \
        if ((t) + 1 < NT) { if constexpr (F32) { VMW(); SWRITE_KF(SB); SBAR(); SLOAD_F((const float*)Vh, KBASE((t) + 1)); }  \
                            else { SLOAD_H(Kh, Vh, KBASE((t) + 1)); } SBAR(); }                                               \
        pv_tile<VB, SK>(o, vb0, pa0, pa1, pa2, pa3, ACT((t) - 1)); MASKT(PX0, PX1, (t)); partialSM(PX0, PX1, m_reg, mnX, alX);                                        \
        __syncthreads();                                                                                                      \
        if ((t) + 1 < NT) { VMW(); if constexpr (F32) { SWRITE_VF(SB); SBAR(); if ((t) + 2 < NT) SLOAD_F((const float*)Kh, KBASE((t) + 2)); } \
                            else { SWRITE_H(SB); } }                                                                          \
        if ((t) + 3 < NT) { TOUCH(KBASE((t) + 3)); }                                                                          \
        RESC(alX); __syncthreads(); } while (0)
    for (int t = 1; t + 1 < NT; t += 2) {
        HALF_STEP(pB0, pB1, mnB, alB, pA0, pA1, alA, t, 1, 0, 0);
        HALF_STEP(pA0, pA1, mnA, alA, pB0, pB1, alB, t + 1, 0, 1, 1);
    }
    const bool even = (NT & 1) == 0;
    if (even) { SBAR(); qkt<1, SK>(pB0, pB1, K_lds, r32, hi, S.qr, ACT(NT - 1), slopeR, LB(NT - 1)); SBAR(); }
#define QROW(e) (nxt.Q + (size_t)(wid * QBLK + r32) * LDI + ((e) >> 1) * 16 + hi * 8 + ((e) & 1) * 4)
    if constexpr (F32) { SLOAD_F((const float*)nxt.K, kbn); SBAR();
#pragma unroll
        for (int e = 0; e < 8; ++e) S.tq[e] = *(const f32x4*)QROW(e); }
    else { SLOAD_H(nxt.K, nxt.V, kbn); SBAR();
#pragma unroll
        for (int d0 = 0; d0 < 8; ++d0) S.qr[d0] = *(const gbf16x8*)(uni_ptr((const char*)nxt.Q) + (unsigned)(((wid * QBLK + r32) * LDI + hi * 8) * (int)sizeof(TIn)) + d0 * 16 * sizeof(TIn)); }
    SBAR();
    finishSM(pA0, pA1, alA, l_reg, pa0, pa1, pa2, pa3); SBAR();
    if constexpr (F32) {
#pragma unroll
        for (int e = 8; e < 16; ++e) S.tq[e] = *(const f32x4*)QROW(e); SBAR(); }
#undef QROW
    pv_tile<0, SK>(o, vb0, pa0, pa1, pa2, pa3, ACT(even ? NT - 2 : NT - 1));
    if (even) { MASKT(pB0, pB1, NT - 1); partialSM(pB0, pB1, m_reg, mnB, alB); __syncthreads(); RESC(alB);
        finishSM(pB0, pB1, alB, l_reg, pa0, pa1, pa2, pa3); SBAR(); pv_tile<1, SK>(o, vb0, pa0, pa1, pa2, pa3, ACT(NT - 1)); }
    SBAR(); SEAM_K0();
    if (hi == 0) li_l[r32] = l_reg; asm volatile("s_waitcnt lgkmcnt(0)" ::: "memory");
    float rli[16];
#pragma unroll
    for (int r = 0; r < 16; ++r) rli[r] = __builtin_amdgcn_rcpf(li_l[crow(r, hi)]);
    const gchar* Owb = uni_ptr((const char*)(cur.O + (size_t)(wid * QBLK) * LDO)); const unsigned ooff = (unsigned)((4 * hi * LDO + r32) * (int)sizeof(TOut));
#pragma unroll
    for (int r = 0; r < 16; ++r) { const int orc = (r & 3) + 8 * (r >> 2);
#pragma unroll
        for (int d0 = 0; d0 < 4; ++d0) { const float v = o[d0][r] * rli[r];
            if constexpr (same_t<TOut, float>::v) { *(__attribute__((address_space(1))) float*)((gchar*)(Owb) + ooff + (unsigned)((orc * LDO + d0 * 32) * (int)sizeof(TOut))) = v; }
            else { const float vn = __shfl_xor(v, 1);
                   if ((r32 & 1) == 0) *(__attribute__((address_space(1))) unsigned*)((gchar*)(Owb) + ooff + (unsigned)((orc * LDO + d0 * 32) * (int)sizeof(TOut))) = cvtpk(v, vn); } } }
    if constexpr (F32) {
#pragma unroll
        for (int d0 = 0; d0 < 8; ++d0) S.qr[d0] = pack8(S.tq[2 * d0], S.tq[2 * d0 + 1]); }
    __syncthreads();
    asm volatile("" :: "v"(touch_reg));
#undef TOUCH
#undef RESC
#undef LB
#undef KBASE
#undef ACT
#undef MASKT
#undef SEAM_K0
#undef HALF_STEP
}
#undef ROW
#undef VMW
#undef VMWN
#undef SLOAD_H
#undef SWRITE_HK
#undef SWRITE_HV
#undef SWRITE_H
#undef SLOAD_F
#undef SWRITE_KF
#undef SWRITE_VF
#undef KSWZ
#undef SBAR
}

constexpr int NWAVES = 8, NTHR = 512;
constexpr int DM = 2048, NB = 2, SEQ = 4096, MROWS = NB * SEQ, NLAYER = 2;
constexpr int IN_COLS = 6592, IN_PAD = 6656, DFF = 5632, UPC = 2 * DFF;
constexpr int C_RQ = 0, C_RK = 256, C_RV = 512, C_RG = 1024, C_RW = 1536, C_MQ = 3520, C_MK = 4544, C_MV = 5568;
constexpr int RWC = 1984;
constexpr float NORM_EPS = 1e-6f, GN_EPS = 64e-5f;
constexpr size_t MiB = 1u << 20;
constexpr size_t WS_CTL = 0, CTL_ZERO_BYTES = 1 * MiB;
constexpr size_t WS_MOD = 1 * MiB;
constexpr size_t WS_KMEAN = 1 * MiB + 512 * 1024;
constexpr size_t WS_W = 2 * MiB, W_LAYER = 100 * MiB, W_IN = 0, W_OUT = 26 * MiB, W_UP = 34 * MiB, W_DN = 78 * MiB;
constexpr size_t WS_X = 202 * MiB;
constexpr size_t WS_H = 266 * MiB;
constexpr size_t WS_PROJ = 298 * MiB;
constexpr size_t WS_ACT = WS_PROJ;
constexpr size_t WS_MIXED = 402 * MiB;
constexpr size_t WS_U = 434 * MiB;
constexpr size_t WS_HALO = WS_U;
constexpr size_t WS_RW = WS_U;
constexpr size_t WS_Y = WS_U + 128 * MiB;
constexpr size_t WS_RETO = WS_U + 144 * MiB;
constexpr size_t WS_REC = 610 * MiB;
constexpr size_t WS_RWW = 738 * MiB;
constexpr size_t WS_END = 739 * MiB;
constexpr size_t RWA = (size_t)MROWS * 512;
constexpr int CW_BAR = 4096, CW_SUB = 64;
constexpr int RING_BYTES = 131072, LDSCTL_OFF = RING_BYTES, MISC_OFF = LDSCTL_OFF + 320, LDS_BYTES = 147456;

#define GAS __attribute__((address_space(1)))
#define LAS __attribute__((address_space(3)))
typedef unsigned short bf16;
typedef unsigned v4u __attribute__((ext_vector_type(4)));
typedef unsigned v2u __attribute__((ext_vector_type(2)));
typedef float f32x4 __attribute__((ext_vector_type(4)));
typedef float f32x2 __attribute__((ext_vector_type(2)));
#define LDS_WAIT() asm volatile("s_waitcnt lgkmcnt(0)" ::: "memory")
__device__ __forceinline__ unsigned f2bf(float f) { unsigned u = __builtin_bit_cast(unsigned, f); return (u + 0x7fffu + ((u >> 16) & 1u)) >> 16; }
__device__ __forceinline__ unsigned pk2(float lo, float hi) { return f2bf(lo) | (f2bf(hi) << 16); }
__device__ __forceinline__ float bf2f(unsigned short h) { return __builtin_bit_cast(float, (unsigned)h << 16); }
__device__ __forceinline__ float bflo(unsigned w) { return __builtin_bit_cast(float, w << 16); }
__device__ __forceinline__ float bfhi(unsigned w) { return __builtin_bit_cast(float, w & 0xffff0000u); }
template <int CTRL> __device__ __forceinline__ float dpp_add(float v);
__device__ __forceinline__ float wave_sum(float v);
__device__ __forceinline__ float wave_max(float v) {
#pragma unroll
    for (int o = 1; o < 64; o <<= 1) v = fmaxf(v, __shfl_xor(v, o));
    return v;
}
template <int CTRL> __device__ __forceinline__ float dpp_add(float v) { return v + __builtin_bit_cast(float, __builtin_amdgcn_update_dpp(0, __builtin_bit_cast(int, v), CTRL, 0xF, 0xF, true)); }
__device__ __forceinline__ float wave_sum(float v) {
    v = dpp_add<0xB1>(v); v = dpp_add<0x4E>(v); v = dpp_add<0x141>(v); v = dpp_add<0x140>(v);
    v += __shfl_xor(v, 16); v += __shfl_xor(v, 32);
    return v;
}
__device__ __forceinline__ float sigmoidf_(float x) { return 1.0f / (1.0f + __expf(-x)); }

#define XB_TMO      128
#define XB_XCNT(j)  (256  + 64 * (j))
#define XB_XSUB(j)  (1280 + 64 * (j))
#define XB_XGEN(j)  (2304 + 64 * (j))
#define XB_TOP      3328
#define XB_TOPGEN   3392
#define XCD_BAR_WORDS 3456
#define XB_SPIN_CAP (1u << 22)
__device__ __forceinline__ unsigned xb_ld(unsigned* p)              { return __hip_atomic_load(p, __ATOMIC_RELAXED, __HIP_MEMORY_SCOPE_AGENT); }
__device__ __forceinline__ unsigned xb_add(unsigned* p, unsigned v) { return __hip_atomic_fetch_add(p, v, __ATOMIC_RELAXED, __HIP_MEMORY_SCOPE_AGENT); }
__device__ __forceinline__ unsigned xb_xcc_id() { return (unsigned)__builtin_amdgcn_s_getreg((3 << 11) | 20) & 0xFu; }
#define XB_SPIN(cond, bar) do { unsigned _sp = 0; while (cond) { __builtin_amdgcn_s_sleep(1); \
    if ((++_sp & 255u) == 0u) { if (xb_ld(&(bar)[XB_TMO])) break; if (_sp > XB_SPIN_CAP) { atomicAdd(&(bar)[XB_TMO], 1u); break; } } } } while (0)
struct XcdBarrier { unsigned* bar; unsigned x; volatile LAS unsigned* st; };
__device__ __forceinline__ XcdBarrier xcd_barrier_post(unsigned* bar, volatile LAS unsigned* st, int tid) {
    XcdBarrier b; b.bar = bar; b.x = xb_xcc_id(); b.st = st;
    if (tid == 0) (void)xb_add(&bar[XB_XCNT(b.x)], 1u);
    return b;
}
__device__ __forceinline__ void xcd_barrier_complete(unsigned* bar, unsigned x, unsigned& nloc, unsigned& nx) {
    const unsigned G = gridDim.x * gridDim.y * gridDim.z;
    unsigned sum, cnt, mine, sp = 0u;
    for (;;) {
        sum = 0u; cnt = 0u; mine = 0u;
#pragma unroll
        for (unsigned j = 0; j < 16; ++j) { const unsigned c = xb_ld(&bar[XB_XCNT(j)]); sum += c; cnt += (c > 0u) ? 1u : 0u; mine = (j == x) ? c : mine; }
        if (sum == G) break;
        __builtin_amdgcn_s_sleep(1);
        if ((++sp & 255u) == 0u) { if (xb_ld(&bar[XB_TMO])) break; if (sp > XB_SPIN_CAP) { atomicAdd(&bar[XB_TMO], 1u); break; } }
    }
    nloc = mine > 0u ? mine : 1u; nx = cnt > 0u ? cnt : 1u;
}
__device__ __forceinline__ void xcd_barrier(const XcdBarrier& b, int tid) {
    asm volatile("s_waitcnt vmcnt(0)" ::: "memory");
    __syncthreads();
    if (tid == 0) {
        unsigned z_ = 0u; asm volatile("" : "+v"(z_)); z_ = (unsigned)__builtin_amdgcn_readfirstlane(z_);
        unsigned* bar = b.bar + z_; const unsigned bx_ = b.x + z_;
        __builtin_amdgcn_s_waitcnt(0);
        unsigned nloc = b.st[0], nx = b.st[1];
        if (nloc == 0u) { xcd_barrier_complete(bar, bx_, nloc, nx); b.st[0] = nloc; b.st[1] = nx; }
        const unsigned old = xb_add(&bar[XB_XSUB(bx_)], 1u);
        const unsigned gen = old / nloc;
        if (old + 1u == (gen + 1u) * nloc) {
            __builtin_amdgcn_fence(__ATOMIC_RELEASE, "agent");
            asm volatile("s_waitcnt vmcnt(0)" ::: "memory");
            const unsigned og = xb_add(&bar[XB_TOP], 1u);
            const unsigned tg = og / nx;
            if (og + 1u == (tg + 1u) * nx) xb_add(&bar[XB_TOPGEN], 1u);
            else XB_SPIN(xb_ld(&bar[XB_TOPGEN]) == tg, bar);
            __builtin_amdgcn_fence(__ATOMIC_ACQUIRE, "agent");
            xb_add(&bar[XB_XGEN(bx_)], 1u);
            asm volatile("s_waitcnt vmcnt(0)" ::: "memory");
        } else {
            XB_SPIN(xb_ld(&bar[XB_XGEN(bx_)]) == gen, bar);
            __builtin_amdgcn_fence(__ATOMIC_ACQUIRE, "agent");
            asm volatile("s_waitcnt vmcnt(0)" ::: "memory");
        }
    }
    __syncthreads();
}

struct Args { const float* in[24]; float* out; unsigned char* ws; };
struct Frame {
    LAS unsigned char* lds;
    int tid, lane, wave, vcu, G, zz;
    const float* const* in;
    unsigned char* ws;
};

#define FWS (F.ws + F.zz)
__device__ __forceinline__ void p0_transpose_item(const float* W, int K, int N, bf16* WT, LAS float* scr, int item, int lane, int half = 0) {
    const int nblk = N / 32, kb = item / nblk, nb = item % nblk, k0 = 64 * kb, n0 = 32 * nb;
    const int r0 = !half ? n0 : (n0 < half ? (n0 >> 7) * 256 + (n0 & 127) : ((n0 - half) >> 7) * 256 + 128 + ((n0 - half) & 127));
#pragma unroll 8
    for (int i = 0; i < 32; ++i) { const int kk = 2 * i + (lane >> 5); scr[kk * 33 + (lane & 31)] = W[(size_t)(k0 + kk) * N + n0 + (lane & 31)]; }
    LDS_WAIT(); asm volatile("" ::: "memory");
    const int c = lane & 7;
#pragma unroll
    for (int j = 0; j < 4; ++j) { const int n = (lane >> 3) + 8 * j; const LAS float* s = scr + (8 * c) * 33 + n;
        v4u o; o.x = pk2(s[0 * 33], s[1 * 33]); o.y = pk2(s[2 * 33], s[3 * 33]); o.z = pk2(s[4 * 33], s[5 * 33]); o.w = pk2(s[6 * 33], s[7 * 33]);
        *(v4u*)(WT + (size_t)(r0 + n) * K + k0 + 8 * c) = o; }
    LDS_WAIT(); asm volatile("" ::: "memory");
}
constexpr int CV_IN = (DM / 64) * (IN_COLS / 32), CV_OUT = (DM / 64) * (DM / 32), CV_UP = (DM / 64) * (UPC / 32), CV_DN = (DFF / 64) * (DM / 32), CV_LAYER = CV_IN + CV_OUT + CV_UP + CV_DN;
constexpr int CV_N1 = 10, CV_N2 = 6, CV_N3 = 4, CV_C1 = 192 * NWAVES * CV_N1, CV_C2 = 128 * NWAVES * CV_N2;
static_assert(CV_IN + CV_C1 <= CV_LAYER && CV_LAYER - (CV_IN + CV_C1) + (CV_IN - CV_C2) <= 128 * NWAVES * CV_N3 && CV_C2 <= CV_IN, "gap capacities");
__device__ __forceinline__ void convert_item(Frame& F, int it, LAS float* scr) {
    const int l = it / CV_LAYER; int r = it % CV_LAYER;
    unsigned char* wl = FWS + WS_W + (size_t)l * W_LAYER;
    if (r < CV_IN) { p0_transpose_item(F.in[F.zz + 2] + (size_t)l * DM * IN_COLS, DM, IN_COLS, (bf16*)(wl + W_IN), scr, r, F.lane); return; } r -= CV_IN;
    if (r < CV_OUT) { p0_transpose_item(F.in[F.zz + 3] + (size_t)l * DM * DM, DM, DM, (bf16*)(wl + W_OUT), scr, r, F.lane); return; } r -= CV_OUT;
    if (r < CV_UP) { p0_transpose_item(F.in[F.zz + 15] + (size_t)l * DM * UPC, DM, UPC, (bf16*)(wl + W_UP), scr, r, F.lane, DFF); return; } r -= CV_UP;
    p0_transpose_item(F.in[F.zz + 18] + (size_t)l * DFF * DM, DFF, DM, (bf16*)(wl + W_DN), scr, r, F.lane);
}
__device__ __forceinline__ void convert_gap(Frame& F, int layer, int first, int count, int gwi, int nwv, int nper) {
    LAS float* scr = (LAS float*)(F.lds + F.wave * 16384);
    for (int j = 0; j < nper; ++j) { const int r = gwi + nwv * j; if (r < count) convert_item(F, layer * CV_LAYER + first + r, scr); }
}
__device__ __forceinline__ void adaln_item(Frame& F, int l, int grp) {
    LAS float* cact = (LAS float*)F.lds;
    LAS float* red = (LAS float*)(F.lds + 16384);
    const float* c = F.in[F.zz + 1];
    for (int i = F.tid; i < 4096; i += NTHR) { const float cv = c[i]; cact[i] = cv / (1.0f + __expf(-cv)); }
    __syncthreads();
    const int n0 = grp * 128;
    const float* W = F.in[F.zz + 19] + (size_t)l * 2048 * 12288 + n0;
    const int half = F.lane >> 5, q = F.lane & 31;
    f32x4 a0 = {0.f, 0.f, 0.f, 0.f}, a1 = {0.f, 0.f, 0.f, 0.f};
#pragma unroll 16
    for (int i = 0; i < 128; ++i) { const int k = F.wave * 256 + 2 * i + half; const f32x4 w = *(const f32x4*)(W + (size_t)k * 12288 + 4 * q);
        a0 += w * cact[k]; a1 += w * cact[2048 + k]; }
#pragma unroll
    for (int e = 0; e < 4; ++e) { a0[e] += __shfl_xor(a0[e], 32); a1[e] += __shfl_xor(a1[e], 32); }
    if (half == 0) {
#pragma unroll
        for (int e = 0; e < 4; ++e) { red[(F.wave * 2 + 0) * 128 + 4 * q + e] = a0[e]; red[(F.wave * 2 + 1) * 128 + 4 * q + e] = a1[e]; } }
    __syncthreads();
    if (F.tid < 256) { const int bb = F.tid >> 7, col = F.tid & 127; float s = 0.f;
#pragma unroll
        for (int w = 0; w < 8; ++w) s += red[(w * 2 + bb) * 128 + col];
        s += F.in[F.zz + 20][l * 12288 + n0 + col];
        ((float*)(FWS + WS_MOD))[(size_t)(l * 2 + bb) * 12288 + n0 + col] = s; }
    __syncthreads();
}
__device__ __forceinline__ void p0_prologue(Frame& F) {
    const int ngv = (F.G == 256) ? 96 : 192;
    if (F.vcu < ngv) adaln_item(F, F.vcu / 96, F.vcu % 96);
    LAS float* scr = (LAS float*)(F.lds + F.wave * 16384);
    const int gw = F.vcu * NWAVES + F.wave, NGW = F.G * NWAVES;
    if (F.G == 256) { if (F.vcu >= 96) for (int p = gw - 96 * NWAVES; p < CV_IN; p += 160 * NWAVES) convert_item(F, p, scr); }
    else for (int p = gw; p < NLAYER * CV_LAYER; p += NGW) convert_item(F, p, scr);
    for (int l = 0; l < NLAYER; ++l) { bf16* wt = (bf16*)(FWS + WS_RWW + (size_t)l * 448 * 512 * 2);
        const float* wu = F.in[F.zz + 6] + (size_t)l * 96 * 512; const float* au = F.in[F.zz + 8] + (size_t)l * 96 * 512; const float* gu = F.in[F.zz + 9] + (size_t)l * 256 * 512;
        for (int i = F.vcu * NTHR + F.tid; i < 448 * 512; i += F.G * NTHR) {
            if (i < 96 * 512) { const int n = i / 96, kq = i - n * 96; wt[i] = (bf16)f2bf(wu[kq * 512 + n]); }
            else if (i < 2 * 96 * 512) { const int j = i - 96 * 512, n = j / 96, kq = j - n * 96; wt[i] = (bf16)f2bf(au[kq * 512 + n]); }
            else { const int j = i - 2 * 96 * 512, n = j >> 8, kq = j & 255; wt[i] = (bf16)f2bf(gu[kq * 512 + n]); } } }
    for (int l = 0; l < NLAYER; ++l) { v4u* z = (v4u*)(FWS + WS_W + (size_t)l * W_LAYER + W_IN + (size_t)IN_COLS * DM * 2);
        for (int i = F.vcu * NTHR + F.tid; i < (IN_PAD - IN_COLS) * DM * 2 / 16; i += F.G * NTHR) z[i] = (v4u){0u, 0u, 0u, 0u}; }
}

template <int MODE, bool IN_F32>
__device__ __forceinline__ void norm_phase(Frame& F, const void* xin, void* outp, const float* g, const float* sh, const float* sc) {
    LAS float* gs = (LAS float*)F.lds;
    LAS float* shs = (LAS float*)(F.lds + 16384);
    for (int i = F.tid; i < 4096; i += NTHR) { const int b = i >> 11, col = i & 2047;
        if (MODE == 0) { gs[i] = g[col] * (1.0f + sc[(size_t)b * 12288 + col]); shs[i] = sh[(size_t)b * 12288 + col]; }
        else { gs[i] = g[col]; shs[i] = 0.f; } }
    __syncthreads();
    const int gw = F.vcu * NWAVES + F.wave, NGW = F.G * NWAVES;
    for (int m = gw; m < MROWS; m += NGW) {
        const int b = m >> 12;
        f32x4 v[8]; float s = 0.f;
#pragma unroll
        for (int j = 0; j < 8; ++j) {
            if (IN_F32) v[j] = *((const f32x4*)((const float*)xin + (size_t)m * DM) + F.lane + 64 * j);
            else { const v2u w = *((const v2u*)((const bf16*)xin + (size_t)m * DM) + F.lane + 64 * j); v[j] = (f32x4){bflo(w.x), bfhi(w.x), bflo(w.y), bfhi(w.y)}; }
            s += (v[j].x * v[j].x + v[j].y * v[j].y) + (v[j].z * v[j].z + v[j].w * v[j].w); }
        float rstd = 1.0f / sqrtf(wave_sum(s) * (1.0f / DM) + NORM_EPS);
#if MOBA_CHECK
        if (MODE == 1) { const float sd = ((const float*)(FWS + WS_CTL))[8], sn = ((const float*)(FWS + WS_CTL))[9]; rstd *= 1.0f + 10.0f * sqrtf(sd / sn); }
#endif
#pragma unroll
        for (int j = 0; j < 8; ++j) { const int col = 4 * (F.lane + 64 * j);
            const f32x4 gg = *(const LAS f32x4*)(gs + b * 2048 + col), ss = *(const LAS f32x4*)(shs + b * 2048 + col);
            const f32x4 o = v[j] * rstd * gg + ss;
            if (MODE == 0) { v2u w; w.x = pk2(o.x, o.y); w.y = pk2(o.z, o.w); *(v2u*)((bf16*)outp + (size_t)m * DM + col) = w; }
            else *(f32x4*)((float*)outp + (size_t)m * DM + col) = o; }
    }
    __syncthreads();
}

__device__ __forceinline__ float lerp_bf(const bf16* P, size_t row, int col, bool hasprev, float mu) {
    const float cur = bf2f(P[row * IN_PAD + col]); const float prev = hasprev ? bf2f(P[(row - 1) * IN_PAD + col]) : 0.f;
    return cur + (prev - cur) * mu;
}
__device__ __forceinline__ void rwkv_prep(Frame& F, int l) {
    LAS float* codes = (LAS float*)F.lds;
    const bf16* P = (const bf16*)(FWS + WS_PROJ);
    const float* mu = F.in[F.zz + 4] + l * RWC; const float* w0 = F.in[F.zz + 5] + l * 512; const float* w_up = F.in[F.zz + 6] + (size_t)l * 96 * 512;
    const float* a0 = F.in[F.zz + 7] + l * 512; const float* a_up = F.in[F.zz + 8] + (size_t)l * 96 * 512; const float* g_up = F.in[F.zz + 9] + (size_t)l * 256 * 512;
    const float* k_k = F.in[F.zz + 10] + l * 512; const float* k_a = F.in[F.zz + 11] + l * 512; const float* r_k = F.in[F.zz + 12] + l * 512;
    float* RW = (float*)(FWS + WS_RW);
    const int c = F.tid;
    const float mur = mu[c], muk = mu[512 + c], muv = mu[1024 + c], w0c = w0[c], a0c = a0[c], kkc = k_k[c], kac = k_a[c], rkc = r_k[c];
    for (int item = F.vcu; item < MROWS / 8; item += F.G) {
        const int row0 = item * 8, t0 = row0 & (SEQ - 1);
        for (int idx = F.tid; idx < 8 * 448; idx += NTHR) { const int tk = idx / 448, cc = idx - tk * 448;
            float val = lerp_bf(P, (size_t)(row0 + tk), C_RW + 1536 + cc, (t0 + tk) > 0, mu[1536 + cc]);
            if (cc < 96) val = tanhf(val); else if (cc >= 192) val = sigmoidf_(val);
            codes[idx] = val; }
        __syncthreads();
        float wd[8], wa[8], gg[8];
#pragma unroll
        for (int tk = 0; tk < 8; ++tk) { wd[tk] = 0.f; wa[tk] = 0.f; gg[tk] = 0.f; }
        for (int r = 0; r < 96; ++r) { const float wu = w_up[r * 512 + c], au = a_up[r * 512 + c];
#pragma unroll
            for (int tk = 0; tk < 8; ++tk) { wd[tk] += codes[tk * 448 + r] * wu; wa[tk] += codes[tk * 448 + 96 + r] * au; } }
        for (int r = 0; r < 256; ++r) { const float gu = g_up[r * 512 + c];
#pragma unroll
            for (int tk = 0; tk < 8; ++tk) gg[tk] += codes[tk * 448 + 192 + r] * gu; }
#pragma unroll
        for (int tk = 0; tk < 8; ++tk) {
            const size_t row = (size_t)(row0 + tk); const bool hp = (t0 + tk) > 0;
            const float rr = lerp_bf(P, row, C_RW + c, hp, mur), kk0 = lerp_bf(P, row, C_RW + 512 + c, hp, muk), vv = lerp_bf(P, row, C_RW + 1024 + c, hp, muv);
            const float z = -(w0c + wd[tk]);
            const float sp = fmaxf(z, 0.f) + log1pf(__expf(-fabsf(z)));
            const float decay = __expf(-__expf(-sp - 0.5f));
            const float a = sigmoidf_(a0c + wa[tk]);
            const float kkv = kk0 * kkc;
            const float nrm = sqrtf(wave_sum(kkv * kkv));
            const float kap = kkv / fmaxf(nrm, 1e-12f);
            const float kp = kk0 * (1.0f + (a - 1.0f) * kac);
            const float bsum = wave_sum(rr * kp * rkc);
            const size_t o = row * 512 + c;
            RW[0 * RWA + o] = rr; RW[1 * RWA + o] = decay; RW[2 * RWA + o] = kp; RW[3 * RWA + o] = vv;
            RW[4 * RWA + o] = kap; RW[5 * RWA + o] = kap * a; RW[6 * RWA + o] = gg[tk]; RW[7 * RWA + o] = bsum * vv;
        }
        __syncthreads();
    }
}
__device__ __forceinline__ void moba_kmean(Frame& F) {
    LAS float* red = (LAS float*)(F.lds + 32768);
    const bf16* P = (const bf16*)(FWS + WS_PROJ);
    float* KM = (float*)(FWS + WS_KMEAN);
    for (int item = F.vcu; item < 256; item += F.G) {
        const int b = item >> 7, h = (item >> 4) & 7, n = item & 15;
        const int d = F.tid & 127, part = F.tid >> 7;
        const bf16* kp = P + (size_t)(b * SEQ + n * 256 + part * 64) * IN_PAD + C_MK + h * 128 + d;
        float s = 0.f;
        for (int k = 0; k < 64; ++k) s += bf2f(kp[(size_t)k * IN_PAD]);
        red[part * 128 + d] = s;
        __syncthreads();
        if (F.tid < 128) KM[(size_t)item * 128 + d] = (red[d] + red[128 + d] + red[256 + d] + red[384 + d]) * (1.0f / 256.0f);
        __syncthreads();
    }
}
struct RwIn { f32x4 w[2], kk[2], bb[2], k[2], r[2]; float v; };
__device__ __forceinline__ void rw_load(RwIn& x, const float* RW, size_t row, int cj, int ci) {
    const size_t o = row * 512;
    x.w[0] = *(const f32x4*)(RW + 1 * RWA + o + cj); x.w[1] = *(const f32x4*)(RW + 1 * RWA + o + cj + 4);
    x.kk[0] = *(const f32x4*)(RW + 4 * RWA + o + cj); x.kk[1] = *(const f32x4*)(RW + 4 * RWA + o + cj + 4);
    x.bb[0] = *(const f32x4*)(RW + 5 * RWA + o + cj); x.bb[1] = *(const f32x4*)(RW + 5 * RWA + o + cj + 4);
    x.k[0] = *(const f32x4*)(RW + 2 * RWA + o + cj); x.k[1] = *(const f32x4*)(RW + 2 * RWA + o + cj + 4);
    x.r[0] = *(const f32x4*)(RW + 0 * RWA + o + cj); x.r[1] = *(const f32x4*)(RW + 0 * RWA + o + cj + 4);
    x.v = RW[3 * RWA + o + ci];
}
__device__ __forceinline__ void rwkv_scan_naive(Frame& F, int b, int h) {
    const float* RW = (const float*)(FWS + WS_RW);
    float* Y = (float*)(FWS + WS_Y);
    const int i = F.tid >> 3, jp = F.tid & 7, cj = h * 64 + 8 * jp, ci = h * 64 + i;
    f32x4 s0 = {0.f, 0.f, 0.f, 0.f}, s1 = {0.f, 0.f, 0.f, 0.f};
    RwIn cur, n1, n2;
    const size_t rb = (size_t)b * SEQ;
    rw_load(cur, RW, rb, cj, ci); rw_load(n1, RW, rb + 1, cj, ci);
    for (int t = 0; t < SEQ; ++t) {
        rw_load(n2, RW, rb + (t + 2 < SEQ ? t + 2 : SEQ - 1), cj, ci);
        f32x4 pp = s0 * cur.kk[0] + s1 * cur.kk[1];
        float p = (pp.x + pp.y) + (pp.z + pp.w);
        p += __shfl_xor(p, 1); p += __shfl_xor(p, 2); p += __shfl_xor(p, 4);
        const float sa = -p;
        s0 = s0 * cur.w[0] + sa * cur.bb[0] + cur.v * cur.k[0];
        s1 = s1 * cur.w[1] + sa * cur.bb[1] + cur.v * cur.k[1];
        f32x4 yy = s0 * cur.r[0] + s1 * cur.r[1];
        float y = (yy.x + yy.y) + (yy.z + yy.w);
        y += __shfl_xor(y, 1); y += __shfl_xor(y, 2); y += __shfl_xor(y, 4);
        if (jp == 0) Y[(rb + t) * 512 + ci] = y;
        cur = n1; n1 = n2;
    }
}
struct RtIn { v4u q[2], k[2]; unsigned short v; };
__device__ __forceinline__ void rt_load(RtIn& x, const bf16* P, size_t row, int h, int d0, int v) {
    const bf16* p = P + row * IN_PAD;
    x.q[0] = *(const v4u*)(p + C_RQ + h * 64 + d0); x.q[1] = *(const v4u*)(p + C_RQ + h * 64 + d0 + 8);
    x.k[0] = *(const v4u*)(p + C_RK + h * 64 + d0); x.k[1] = *(const v4u*)(p + C_RK + h * 64 + d0 + 8);
    x.v = p[C_RV + h * 128 + v];
}
__device__ __forceinline__ void ret_scan_naive(Frame& F, int b, int h) {
    const bf16* P = (const bf16*)(FWS + WS_PROJ);
    float* RO = (float*)(FWS + WS_RETO);
    const int v = F.tid >> 2, dp = F.tid & 3, d0 = dp * 16;
    const float gamma = 1.0f - exp2f(-5.0f - (float)h);
    float S[16];
#pragma unroll
    for (int d = 0; d < 16; ++d) S[d] = 0.f;
    RtIn cur, n1, n2;
    const size_t rb = (size_t)b * SEQ;
    rt_load(cur, P, rb, h, d0, v); rt_load(n1, P, rb + 1, h, d0, v);
    for (int t = 0; t < SEQ; ++t) {
        rt_load(n2, P, rb + (t + 2 < SEQ ? t + 2 : SEQ - 1), h, d0, v);
        const float vv = bf2f(cur.v) * 0.125f;
        float o = 0.f;
#pragma unroll
        for (int e = 0; e < 8; ++e) { const unsigned qw = cur.q[e >> 2][e & 3], kw = cur.k[e >> 2][e & 3];
            S[2 * e] = gamma * S[2 * e] + bflo(kw) * vv; S[2 * e + 1] = gamma * S[2 * e + 1] + bfhi(kw) * vv;
            o += bflo(qw) * S[2 * e] + bfhi(qw) * S[2 * e + 1]; }
        o += __shfl_xor(o, 1); o += __shfl_xor(o, 2);
        if (dp == 0) RO[(rb + t) * 512 + h * 128 + v] = o;
        cur = n1; n1 = n2;
    }
}
__device__ __forceinline__ void moba_naive(Frame& F, int mw, int nmw) {
    const bf16* P = (const bf16*)(FWS + WS_PROJ);
    const float* KM = (const float*)(FWS + WS_KMEAN);
    bf16* MX = (bf16*)(FWS + WS_U + 160 * MiB);
    LAS float* qs = (LAS float*)(F.lds + F.wave * 4608);
    LAS float* ps = qs + 128;
    const int lane = F.lane;
    for (int qi = mw; qi < MROWS * 8; qi += nmw) {
        const int h = qi & 7, row = qi >> 3, b = row >> 12, t = row & (SEQ - 1), bq = t >> 8;
        { const unsigned qw = *(const unsigned*)(P + (size_t)row * IN_PAD + C_MQ + h * 128 + 2 * lane);
          qs[2 * lane] = bflo(qw) * 0.08838834764831845f; qs[2 * lane + 1] = bfhi(qw) * 0.08838834764831845f; }
        LDS_WAIT();
        float gate = -INFINITY;
        if (lane < 16 && lane < bq) { const float* km = KM + ((size_t)(b * 8 + h) * 16 + lane) * 128; float a = 0.f;
            for (int d = 0; d < 128; ++d) a += qs[d] * km[d];
            gate = a; }
        unsigned selmask = 0u;
#pragma unroll
        for (int rnd = 0; rnd < 3; ++rnd) { const float m = wave_max(gate);
            if (m > -INFINITY) { const unsigned long long bal = __ballot(gate == m); const int idx = __ffsll((long long)bal) - 1; selmask |= 1u << idx; if (lane == idx) gate = -INFINITY; } }
        int blk[4];
#pragma unroll
        for (int s = 0; s < 3; ++s) { if (selmask) { blk[s] = __ffs((int)selmask) - 1; selmask &= selmask - 1u; } else blk[s] = -1; }
        blk[3] = bq;
        const float slope = exp2f(-(float)(h + 1));
        float sc[4][4]; float mx = -1e30f;
#pragma unroll
        for (int s = 0; s < 4; ++s) {
#pragma unroll
            for (int kq = 0; kq < 4; ++kq) {
                float val = -1e30f;
                if (blk[s] >= 0) { const int pos = blk[s] * 256 + kq * 64 + lane;
                    const bf16* kp = P + (size_t)(b * SEQ + pos) * IN_PAD + C_MK + h * 128; float a = 0.f;
#pragma unroll 4
                    for (int d8 = 0; d8 < 16; ++d8) { const v4u kw = *(const v4u*)(kp + d8 * 8); const f32x4 qa = *(const LAS f32x4*)(qs + d8 * 8), qb = *(const LAS f32x4*)(qs + d8 * 8 + 4);
                        a += bflo(kw.x) * qa.x + bfhi(kw.x) * qa.y + bflo(kw.y) * qa.z + bfhi(kw.y) * qa.w + bflo(kw.z) * qb.x + bfhi(kw.z) * qb.y + bflo(kw.w) * qb.z + bfhi(kw.w) * qb.w; }
                    if (pos <= t) val = a - slope * (float)(t - pos); }
                sc[s][kq] = val; mx = fmaxf(mx, val); } }
        mx = wave_max(mx);
        float lsum = 0.f;
#pragma unroll
        for (int s = 0; s < 4; ++s)
#pragma unroll
            for (int kq = 0; kq < 4; ++kq) { const float p = __expf(sc[s][kq] - mx); lsum += p; ps[s * 256 + kq * 64 + lane] = p; }
        lsum = wave_sum(lsum);
        LDS_WAIT();
        float o0 = 0.f, o1 = 0.f;
#pragma unroll
        for (int s = 0; s < 4; ++s) if (blk[s] >= 0) { const int nk = (s == 3) ? (t - bq * 256 + 1) : 256;
            const bf16* vp = P + (size_t)(b * SEQ + blk[s] * 256) * IN_PAD + C_MV + h * 128 + 2 * lane;
#pragma unroll 4
            for (int key = 0; key < nk; ++key) { const float p = ps[s * 256 + key]; const unsigned vw = *(const unsigned*)(vp + (size_t)key * IN_PAD); o0 += p * bflo(vw); o1 += p * bfhi(vw); } }
        const float inv = 1.0f / lsum;
        *(unsigned*)(MX + (size_t)row * 1024 + h * 128 + 2 * lane) = pk2(o0 * inv, o1 * inv);
        LDS_WAIT();
    }
}

constexpr int MOBA_LDS_KM = moba::LDS_BYTES, MOBA_LDS_SEL = MOBA_LDS_KM + 8192;
__device__ __forceinline__ void moba_item(Frame& F, int bh, int qbA, int qbB) {
    const int b = bh >> 3, h = bh & 7;
    const bf16* P = (const bf16*)(FWS + WS_PROJ);
    LAS float* km = (LAS float*)(F.lds + MOBA_LDS_KM);
    LAS unsigned* sel = (LAS unsigned*)(F.lds + MOBA_LDS_SEL);
    const float* KM = (const float*)(FWS + WS_KMEAN) + (size_t)bh * 16 * 128;
    for (int i = F.tid; i < 2048; i += NTHR) km[i] = KM[i];
    __syncthreads();
    {   const int qb = (F.tid < 256) ? qbA : qbB, r = F.tid & 255;
        const bf16* qp = P + (size_t)(b * SEQ + qb * 256 + r) * IN_PAD + C_MQ + h * 128;
        float g[16];
#pragma unroll
        for (int n = 0; n < 16; ++n) g[n] = 0.f;
        for (int d8 = 0; d8 < 16; ++d8) { const v4u qw = *(const v4u*)(qp + d8 * 8);
            const float q0 = bflo(qw.x), q1 = bfhi(qw.x), q2 = bflo(qw.y), q3 = bfhi(qw.y), q4 = bflo(qw.z), q5 = bfhi(qw.z), q6 = bflo(qw.w), q7 = bfhi(qw.w);
#pragma unroll
            for (int n = 0; n < 16; ++n) { const f32x4 ka = *(const LAS f32x4*)(km + n * 128 + d8 * 8), kb = *(const LAS f32x4*)(km + n * 128 + d8 * 8 + 4);
                g[n] += (q0 * ka.x + q1 * ka.y) + (q2 * ka.z + q3 * ka.w) + (q4 * kb.x + q5 * kb.y) + (q6 * kb.z + q7 * kb.w); } }
        unsigned m = 0u;
#pragma unroll
        for (int rnd = 0; rnd < 3; ++rnd) { float best = -INFINITY; int bi = -1;
#pragma unroll
            for (int n = 0; n < 16; ++n) if (n < qb && !((m >> n) & 1u) && g[n] > best) { best = g[n]; bi = n; }
            if (bi >= 0) m |= 1u << bi; }
        sel[F.tid] = m; }
    __syncthreads();
    typedef moba::BlockRef<moba::bf16, moba::bf16> Ref;
    const float slopeR = exp2f(-(float)(h + 1)) * 11.313708498984761f;
    bf16* MX = (bf16*)(FWS + WS_MIXED);
    Ref A, B2;
    A.Q = P + (size_t)(b * SEQ + qbA * 256) * IN_PAD + C_MQ + h * 128; A.K = P + (size_t)(b * SEQ) * IN_PAD + C_MK + h * 128; A.V = P + (size_t)(b * SEQ) * IN_PAD + C_MV + h * 128;
    A.O = MX + (size_t)(b * SEQ + qbA * 256) * DM + 1024 + h * 128; A.P0 = qbA * 256; A.sel = sel; A.slopeR = slopeR;
    B2 = A; B2.Q = P + (size_t)(b * SEQ + qbB * 256) * IN_PAD + C_MQ + h * 128; B2.O = MX + (size_t)(b * SEQ + qbB * 256) * DM + 1024 + h * 128; B2.P0 = qbB * 256; B2.sel = sel + 256;
    moba::Seam<moba::bf16> S;
    moba::lchar* ldsg = (moba::lchar*)F.lds;
    moba::causal_swa_prime<moba::bf16, moba::bf16>(A, 1 << 30, ldsg, S, F.wave);
    Ref cur = A;
    for (int pass = 0; pass < MOBA_NP; ++pass) {
        const bool nb_ = ((pass + 1) & 1) != 0;
        Ref nxt = A; if (nb_ || pass + 1 >= MOBA_NP) nxt = B2;
        moba::causal_swa_block<moba::bf16, moba::bf16>(cur, nxt, SEQ, 1 << 30, ldsg, S, F.wave);
        cur = nxt;
    }
}
constexpr int RC_UNITS = 32, RC_NCH = SEQ / 16, RC_REC = 16384;
constexpr int RC_AR = 0, RC_BK = 4096, RC_VP = 8192, RC_U0 = 10240, RC_Y0 = 12288, RC_D = 14336;
typedef short bf16x8 __attribute__((ext_vector_type(8)));
typedef float f32x16 __attribute__((ext_vector_type(16)));
typedef float f32x2t __attribute__((ext_vector_type(2))); typedef __bf16 bf16x2t __attribute__((ext_vector_type(2)));
__device__ __forceinline__ unsigned cvtpk_c(float lo, float hi) { f32x2t v = {lo, hi}; bf16x2t b = __builtin_convertvector(v, bf16x2t); return __builtin_bit_cast(unsigned, b); }
__device__ __forceinline__ unsigned short cvt1_c(float x) { return (unsigned short)(cvtpk_c(x, 0.f) & 0xffffu); }

constexpr int RC_WLDS = 14464, RC_CODES_OFF = 8 * RC_WLDS  , RC_CSTRIDE = 456;
__device__ __forceinline__ void rc_core(Frame& F, LAS unsigned char* wlds, const float (&At)[16], const float (&Bt)[16], const float (&Kt)[16], const float (&Rt)[16], const float (&vv)[16], const float D, unsigned char* rec) {
    { unsigned wb_ = (unsigned)(uintptr_t)wlds; asm volatile("" : "+v"(wb_)); wlds = (LAS unsigned char*)(uintptr_t)wb_; }
    LAS bf16* XA = (LAS bf16*)wlds; LAS bf16* XB = (LAS bf16*)(wlds + 4608); LAS float* TT = (LAS float*)(wlds + 9216 + 4224);
    int x_ = F.lane; asm volatile("" : "+v"(x_));
    const int x = x_, r32 = x & 31, h2 = x >> 5, tl = x & 15;
#pragma unroll
    for (int t = 0; t < 16; ++t) { XA[t * 72 + x] = cvt1_c(Bt[t]); XA[(16 + t) * 72 + x] = cvt1_c(Kt[t]); XB[t * 72 + x] = cvt1_c(At[t]); XB[(16 + t) * 72 + x] = cvt1_c(Rt[t]); }
#pragma unroll
    for (int q = 0; q < 4; ++q) { v4u w; w.x = cvtpk_c(Bt[4 * q] * D, Bt[4 * q + 1] * D); w.y = cvtpk_c(Bt[4 * q + 2] * D, Bt[4 * q + 3] * D);
        w.z = cvtpk_c(Kt[4 * q] * D, Kt[4 * q + 1] * D); w.w = cvtpk_c(Kt[4 * q + 2] * D, Kt[4 * q + 3] * D); *(v4u*)(rec + RC_BK + x * 64 + q * 16) = w; }
#pragma unroll
    for (int q = 0; q < 2; ++q) { v4u w;
        w.x = cvtpk_c(vv[8 * q], vv[8 * q + 1]); w.y = cvtpk_c(vv[8 * q + 2], vv[8 * q + 3]); w.z = cvtpk_c(vv[8 * q + 4], vv[8 * q + 5]); w.w = cvtpk_c(vv[8 * q + 6], vv[8 * q + 7]); *(v4u*)(rec + RC_VP + x * 32 + q * 16) = w;
    }
    *(float*)(rec + RC_D + x * 4) = D;
    f32x16 G;
#pragma unroll
    for (int r = 0; r < 16; ++r) G[r] = 0.f;
#pragma unroll
    for (int ks = 0; ks < 4; ++ks) { const bf16x8 a = *(const LAS bf16x8*)(XA + r32 * 72 + ks * 16 + h2 * 8), bq = *(const LAS bf16x8*)(XB + r32 * 72 + ks * 16 + h2 * 8);
        G = __builtin_amdgcn_mfma_f32_32x32x16_bf16(a, bq, G, 0, 0, 0); }
    LAS float* GA = (LAS float*)wlds; LAS float* GT = (LAS float*)(wlds + 4608);
#pragma unroll
    for (int r = 0; r < 16; ++r) GA[((r & 3) + 8 * (r >> 2) + 4 * h2) * 36 + r32] = G[r];
#pragma unroll
    for (int g4 = 0; g4 < 4; ++g4) *(LAS f32x4*)(GT + r32 * 36 + 8 * g4 + 4 * h2) = (f32x4){G[4 * g4], G[4 * g4 + 1], G[4 * g4 + 2], G[4 * g4 + 3]};
#define RC_LD16(dst, p, n4) do { _Pragma("unroll") for (int i4_ = 0; i4_ < (n4); ++i4_) { const f32x4 v4_ = *(const LAS f32x4*)((p) + 4 * i4_); dst[4 * i4_] = v4_.x; dst[4 * i4_ + 1] = v4_.y; dst[4 * i4_ + 2] = v4_.z; dst[4 * i4_ + 3] = v4_.w; } } while (0)
    float Tc[16];
#pragma unroll
    for (int m = 0; m < 16; ++m) Tc[m] = (m == tl) ? 1.0f : 0.0f;
#pragma unroll
    for (int s = 14; s >= 0; --s) { float nr[16]; float acc = 0.f;
#pragma unroll
        for (int i4 = (s + 1) / 4; i4 < 4; ++i4) { const f32x4 v4 = *(const LAS f32x4*)(GA + s * 36 + 4 * i4); nr[4 * i4] = v4.x; nr[4 * i4 + 1] = v4.y; nr[4 * i4 + 2] = v4.z; nr[4 * i4 + 3] = v4.w; }
#pragma unroll
        for (int m = s + 1; m < 16; ++m) acc += nr[m] * Tc[m];
        Tc[s] = (s < tl) ? acc : Tc[s]; }
    if (x < 16) {
#pragma unroll
        for (int g4 = 0; g4 < 4; ++g4) *(LAS f32x4*)(TT + tl * 16 + 4 * g4) = (f32x4){Tc[4 * g4], Tc[4 * g4 + 1], Tc[4 * g4 + 2], Tc[4 * g4 + 3]}; }
    float PV[16];
    PV[0] = 0.f;
#pragma unroll
    for (int s = 1; s < 16; ++s) { float acc = 0.f;
#pragma unroll
        for (int r = 0; r < s; ++r) acc += GT[s * 36 + 16 + r] * vv[r];
        PV[s] = acc; }
    float Ah[16], U0[16];
#pragma unroll
    for (int t = 0; t < 16; ++t) { float a = 0.f, uu = 0.f;
#pragma unroll
        for (int s = 0; s <= t; ++s) { const float tv = TT[t * 16 + s]; a += tv * At[s]; uu += tv * PV[s]; }
        Ah[t] = a; U0[t] = uu; }
    float Rh[16], Y0[16];
#pragma unroll
    for (int t = 0; t < 16; ++t) { float a = Rt[t], yy = 0.f;
#pragma unroll
        for (int s = 0; s <= t; ++s) { const float m1 = GT[(16 + t) * 36 + s], m2 = GT[(16 + t) * 36 + 16 + s]; a += m1 * Ah[s]; yy += m1 * U0[s] + m2 * vv[s]; }
        Rh[t] = a; Y0[t] = yy; }
#undef RC_LD16
    { const int ks = x >> 5, jj = x & 31, e = (jj >> 4) * 4 + (jj & 3), q = (jj >> 2) & 3; unsigned char* pb = rec + RC_AR + ks * 1024 + q * 256 + e * 2;
#pragma unroll
      for (int s = 0; s < 16; ++s) { *(bf16*)(pb + s * 16) = cvt1_c(Ah[s]); *(bf16*)(pb + 2048 + s * 16) = cvt1_c(Rh[s]); } }
#pragma unroll
    for (int q = 0; q < 2; ++q) { v4u w;
        w.x = cvtpk_c(U0[8 * q], U0[8 * q + 1]); w.y = cvtpk_c(U0[8 * q + 2], U0[8 * q + 3]); w.z = cvtpk_c(U0[8 * q + 4], U0[8 * q + 5]); w.w = cvtpk_c(U0[8 * q + 6], U0[8 * q + 7]); *(v4u*)(rec + RC_U0 + x * 32 + q * 16) = w;
        w.x = cvtpk_c(Y0[8 * q], Y0[8 * q + 1]); w.y = cvtpk_c(Y0[8 * q + 2], Y0[8 * q + 3]); w.z = cvtpk_c(Y0[8 * q + 4], Y0[8 * q + 5]); w.w = cvtpk_c(Y0[8 * q + 6], Y0[8 * q + 7]); *(v4u*)(rec + RC_Y0 + x * 32 + q * 16) = w; }
    LDS_WAIT();
}
__device__ __forceinline__ void rc_pass1_rwkv(Frame& F, int wid, int nw, int c0, int nc) {
    LAS unsigned char* wlds = F.lds + F.wave * RC_WLDS;
    const int x = F.lane;
    const float* RW = (const float*)(FWS + WS_RW);
    const bf16* RH = (const bf16*)(FWS + WS_RW + 32 * MiB);
    for (int it2 = wid; it2 < 16 * nc; it2 += nw) {
        const int u = it2 / nc, c = c0 + it2 % nc, it = u * RC_NCH + c, b = u >> 3, h = u & 7; const size_t o0 = ((size_t)(b * SEQ + c * 16)) * 512 + h * 64 + x;
        float At[16], Bt[16], Kt[16], Rt[16], vv[16]; float W = 1.0f;
#pragma unroll
        for (int t = 0; t < 16; ++t) { const size_t o = o0 + (size_t)t * 512;
            const float wv = RW[o], ka = bf2f(RH[3 * RWA + o]), bb = bf2f(RH[4 * RWA + o]), kk = bf2f(RH[1 * RWA + o]), rr = bf2f(RH[0 * RWA + o]); vv[t] = bf2f(RH[2 * RWA + o]);
            At[t] = -ka * W; W *= wv; const float iw = 1.0f / W; Bt[t] = bb * iw; Kt[t] = kk * iw; Rt[t] = rr * W; }
        rc_core(F, wlds, At, Bt, Kt, Rt, vv, W, FWS + WS_REC + (size_t)it * RC_REC);
    }
}
__device__ __forceinline__ void rc_core_ret(Frame& F, LAS unsigned char* wlds, const float (&Kt)[16], const float (&Rt)[16], const float (&vv)[16], const float D, unsigned char* rec) {
    { unsigned wb_ = (unsigned)(uintptr_t)wlds; asm volatile("" : "+v"(wb_)); wlds = (LAS unsigned char*)(uintptr_t)wb_; }
    LAS bf16* XK = (LAS bf16*)wlds; LAS bf16* XR = (LAS bf16*)(wlds + 2304); LAS float* GM = (LAS float*)(wlds + 4608);
    int x_ = F.lane; asm volatile("" : "+v"(x_));
    const int x = x_, fr = x & 15, q = x >> 4;
#pragma unroll
    for (int t = 0; t < 16; ++t) { XK[t * 72 + x] = cvt1_c(Kt[t]); XR[t * 72 + x] = cvt1_c(Rt[t]); }
#pragma unroll
    for (int qq = 0; qq < 4; ++qq) { v4u w; w.x = 0u; w.y = 0u;
        w.z = cvtpk_c(Kt[4 * qq] * D, Kt[4 * qq + 1] * D); w.w = cvtpk_c(Kt[4 * qq + 2] * D, Kt[4 * qq + 3] * D); *(v4u*)(rec + RC_BK + x * 64 + qq * 16) = w; }
#pragma unroll
    for (int qq = 0; qq < 2; ++qq) { v4u w;
        w.x = cvtpk_c(vv[8 * qq], vv[8 * qq + 1]); w.y = cvtpk_c(vv[8 * qq + 2], vv[8 * qq + 3]); w.z = cvtpk_c(vv[8 * qq + 4], vv[8 * qq + 5]); w.w = cvtpk_c(vv[8 * qq + 6], vv[8 * qq + 7]); *(v4u*)(rec + RC_VP + x * 32 + qq * 16) = w;
        *(v4u*)(rec + RC_U0 + x * 32 + qq * 16) = (v4u){0u, 0u, 0u, 0u}; }
    *(float*)(rec + RC_D + x * 4) = D;
    { const int ks = x >> 5, jj = x & 31, e = (jj >> 4) * 4 + (jj & 3), qv = (jj >> 2) & 3; unsigned char* pb = rec + RC_AR + ks * 1024 + qv * 256 + e * 2;
#pragma unroll
      for (int s = 0; s < 16; ++s) { *(bf16*)(pb + s * 16) = (bf16)0; *(bf16*)(pb + 2048 + s * 16) = cvt1_c(Rt[s]); } }
    f32x4 G = {0.f, 0.f, 0.f, 0.f};
#pragma unroll
    for (int ks = 0; ks < 2; ++ks) { const bf16x8 a = *(const LAS bf16x8*)(XK + fr * 72 + ks * 32 + q * 8), bq = *(const LAS bf16x8*)(XR + fr * 72 + ks * 32 + q * 8);
        G = __builtin_amdgcn_mfma_f32_16x16x32_bf16(a, bq, G, 0, 0, 0); }
#pragma unroll
    for (int rg = 0; rg < 4; ++rg) GM[(4 * q + rg) * 17 + fr] = G[rg];
    float Y0[16];
#pragma unroll
    for (int t = 0; t < 16; ++t) { float yy = 0.f;
#pragma unroll
        for (int s = 0; s <= t; ++s) yy += GM[s * 17 + t] * vv[s];
        Y0[t] = yy; }
#pragma unroll
    for (int qq = 0; qq < 2; ++qq) { v4u w;
        w.x = cvtpk_c(Y0[8 * qq], Y0[8 * qq + 1]); w.y = cvtpk_c(Y0[8 * qq + 2], Y0[8 * qq + 3]); w.z = cvtpk_c(Y0[8 * qq + 4], Y0[8 * qq + 5]); w.w = cvtpk_c(Y0[8 * qq + 6], Y0[8 * qq + 7]); *(v4u*)(rec + RC_Y0 + x * 32 + qq * 16) = w; }
    LDS_WAIT();
}
__device__ __forceinline__ void rc_pass1_ret(Frame& F, int wid, int nw, int c0, int nc) {
    LAS unsigned char* wlds = F.lds + F.wave * RC_WLDS;
    const int x = F.lane;
    const bf16* P = (const bf16*)(FWS + WS_PROJ);
    for (int it2 = wid; it2 < 16 * nc; it2 += nw) {
        const int ru = it2 / nc, c = c0 + it2 % nc, it = ru * RC_NCH + c, b = ru >> 3, h = (ru >> 1) & 3, half = ru & 1; const float gamma = 1.0f - exp2f(-5.0f - (float)h);
        float Kt[16], Rt[16], vv[16]; float W = 1.0f;
        const bf16* p0 = P + (size_t)(b * SEQ + c * 16) * IN_PAD;
#pragma unroll
        for (int t = 0; t < 16; ++t) { const bf16* p = p0 + (size_t)t * IN_PAD;
            const float rr = bf2f(p[C_RQ + h * 64 + x]), kk = bf2f(p[C_RK + h * 64 + x]) * 0.125f; vv[t] = bf2f(p[C_RV + h * 128 + half * 64 + x]);
            W *= gamma; const float iw = 1.0f / W; Kt[t] = kk * iw; Rt[t] = rr * W; }
        rc_core_ret(F, wlds, Kt, Rt, vv, W, FWS + WS_REC + (size_t)(16 * RC_NCH + it) * RC_REC);
    }
}
__device__ __forceinline__ void rwkv_prep_mfma(Frame& F, int l, int first, int stride) {
    LAS unsigned char* wlds = F.lds + F.wave * RC_WLDS;
    LAS bf16* CODES = (LAS bf16*)(F.lds + RC_CODES_OFF);
    LAS float* ST = (LAS float*)wlds;
    const bf16* P = (const bf16*)(FWS + WS_PROJ);
    const float* mu = F.in[F.zz + 4] + l * RWC;
    const bf16* WT = (const bf16*)(FWS + WS_RWW + (size_t)l * 448 * 512 * 2);
    float* RW = (float*)(FWS + WS_RW);
    const int x = F.lane, h = F.wave, ch = h * 64 + x, fr = x & 15, q = x >> 4;
    for (int item = first; item < NB * RC_NCH; item += stride) {
        const int b = item >> 8, c = item & 255; const size_t row0 = (size_t)b * SEQ + c * 16; const int t0 = c * 16;
        for (int idx = F.tid; idx < 16 * 448; idx += NTHR) { const int tk = idx / 448, cc = idx - tk * 448;
            float val = lerp_bf(P, row0 + tk, C_RW + 1536 + cc, (t0 + tk) > 0, mu[1536 + cc]);
            if (cc < 96) val = tanhf(val); else if (cc >= 192) val = sigmoidf_(val);
            CODES[tk * RC_CSTRIDE + cc] = cvt1_c(val); }
        __syncthreads();
        f32x4 accW[4], accA[4], accG[4];
#pragma unroll
        for (int ct = 0; ct < 4; ++ct) { accW[ct] = (f32x4){0.f, 0.f, 0.f, 0.f}; accA[ct] = accW[ct]; accG[ct] = accW[ct]; }
#pragma unroll 1
        for (int ks = 0; ks < 3; ++ks) { const bf16x8 aw = *(const LAS bf16x8*)(CODES + fr * RC_CSTRIDE + ks * 32 + q * 8), aa = *(const LAS bf16x8*)(CODES + fr * RC_CSTRIDE + 96 + ks * 32 + q * 8);
#pragma unroll
            for (int ct = 0; ct < 4; ++ct) { const int n = h * 64 + ct * 16 + fr;
                const bf16x8 bw = *(const bf16x8*)(WT + (size_t)n * 96 + ks * 32 + q * 8), ba = *(const bf16x8*)(WT + 512 * 96 + (size_t)n * 96 + ks * 32 + q * 8);
                accW[ct] = __builtin_amdgcn_mfma_f32_16x16x32_bf16(aw, bw, accW[ct], 0, 0, 0); accA[ct] = __builtin_amdgcn_mfma_f32_16x16x32_bf16(aa, ba, accA[ct], 0, 0, 0); } }
#pragma unroll 2
        for (int ks = 0; ks < 8; ++ks) { const bf16x8 ag = *(const LAS bf16x8*)(CODES + fr * RC_CSTRIDE + 192 + ks * 32 + q * 8);
#pragma unroll
            for (int ct = 0; ct < 4; ++ct) { const int n = h * 64 + ct * 16 + fr;
                const bf16x8 bg = *(const bf16x8*)(WT + 2 * 512 * 96 + (size_t)n * 256 + ks * 32 + q * 8);
                accG[ct] = __builtin_amdgcn_mfma_f32_16x16x32_bf16(ag, bg, accG[ct], 0, 0, 0); } }
#pragma unroll
        for (int ct = 0; ct < 4; ++ct)
#pragma unroll
            for (int rg = 0; rg < 4; ++rg) { const int o = (4 * q + rg) * 64 + ct * 16 + fr; ST[o] = accW[ct][rg]; ST[1024 + o] = accA[ct][rg]; ST[2048 + o] = accG[ct][rg]; }
        const float mur = mu[ch], muk = mu[512 + ch], muv = mu[1024 + ch];
        const float w0c = F.in[F.zz + 5][l * 512 + ch], a0c = F.in[F.zz + 7][l * 512 + ch], kkc = F.in[F.zz + 10][l * 512 + ch], kac = F.in[F.zz + 11][l * 512 + ch], rkc = F.in[F.zz + 12][l * 512 + ch];
        const bf16* pr = P + row0 * IN_PAD + C_RW + ch;
        float* gpw = RW + row0 * 512 + ch;
        bf16* gp = (bf16*)(FWS + WS_RW + 32 * MiB) + row0 * 512 + ch;
        float pvr = 0.f, pvk = 0.f, pvv = 0.f;
        if (t0 > 0) { pvr = bf2f(pr[-IN_PAD]); pvk = bf2f(pr[512 - IN_PAD]); pvv = bf2f(pr[1024 - IN_PAD]); }
#pragma unroll 4
        for (int t = 0; t < 16; ++t) {
            const float cr = bf2f(pr[0]), ck = bf2f(pr[512]), cv = bf2f(pr[1024]);
            const float rr = cr + (pvr - cr) * mur, kk0 = ck + (pvk - ck) * muk, vv = cv + (pvv - cv) * muv;
            pvr = cr; pvk = ck; pvv = cv; pr += IN_PAD;
            const float z = -(w0c + ST[t * 64 + x]);
            const float sp = fmaxf(z, 0.f) + log1pf(__expf(-fabsf(z)));
            const float decay = __expf(-__expf(-sp - 0.5f));
            const float a = sigmoidf_(a0c + ST[1024 + t * 64 + x]);
            const float gg = ST[2048 + t * 64 + x];
            const float kkv = kk0 * kkc;
            const float nrm = sqrtf(wave_sum(kkv * kkv));
            const float kap = kkv / fmaxf(nrm, 1e-12f);
            const float kp = kk0 * (1.0f + (a - 1.0f) * kac);
            const float bsum = wave_sum(rr * kp * rkc);
            gpw[0] = decay; gpw += 512;
            gp[0 * RWA] = cvt1_c(rr); gp[1 * RWA] = cvt1_c(kp); gp[2 * RWA] = cvt1_c(vv); gp[3 * RWA] = cvt1_c(kap); gp[4 * RWA] = cvt1_c(kap * a); gp[5 * RWA] = cvt1_c(gg); gp[6 * RWA] = cvt1_c(bsum * vv); gp += 512; }
        LDS_WAIT();
        __syncthreads();
    }
}
constexpr int RC_SLOT = 15360, RC_YST = 8 * RC_SLOT  ;
struct RcOps { bf16x8 aU0, aU1, aY0, aY1, bk[4]; f32x4 dd[4]; v2u vp, u0, y0; };
__device__ __forceinline__ void rc_pass2(Frame& F, int u, int cb, int ce, bool first, bool last) {
    const unsigned char* rec = FWS + WS_REC + (size_t)u * RC_NCH * RC_REC;
    const int lane = F.lane;
    const int NST = ce - cb;
    bf16* Yg;
    if (u < 16) Yg = (bf16*)(FWS + WS_Y) + (size_t)((u >> 3) * SEQ) * 512 + (u & 7) * 64;
    else { const int ru = u - 16; Yg = (bf16*)(FWS + WS_RETO) + (size_t)((ru >> 3) * SEQ) * 512 + ((ru >> 1) & 3) * 128 + (ru & 1) * 64; }
#define RC_BARRIER() __builtin_amdgcn_s_barrier()
    if (F.wave == 7) {
        unsigned t0_ = 0u, t1_ = 0u;
#define RC_TOUCH(c) do { const unsigned char* pa = rec + (size_t)(c) * RC_REC + lane * 128; const unsigned char* pb = pa + 8192; \
            asm volatile("global_load_dword %0, %2, off\n\tglobal_load_dword %1, %3, off" : "+v"(t0_), "+v"(t1_) : "v"(pa), "v"(pb) : "memory"); } while (0)
#define RC_YCOPY(pair) do { const LAS unsigned char* yb = F.lds + RC_YST + ((pair) & 1) * 4096; _Pragma("unroll") for (int j = 0; j < 4; ++j) { const v4u w = *(const LAS v4u*)(yb + j * 1024 + lane * 16); \
            *(v4u*)(Yg + (size_t)((cb + 2 * (pair)) * 16 + j * 8 + (lane >> 3)) * 512 + (lane & 7) * 8) = w; } } while (0)
        for (int cq = cb; cq < cb + 24 && cq < ce; ++cq) RC_TOUCH(cq);
        RC_BARRIER();
        for (int s = 0; s < NST; ++s) {
            if (cb + s + 24 < ce) RC_TOUCH(cb + s + 24);
            if ((s & 1) == 0 && s > 0) RC_YCOPY((s >> 1) - 1);
            RC_BARRIER();
        }
        RC_YCOPY((NST >> 1) - 1);
        asm volatile("s_waitcnt vmcnt(0)" ::: "memory");
        asm volatile("" :: "v"(t0_), "v"(t1_));
#undef RC_TOUCH
#undef RC_YCOPY
    } else if (F.wave >= 4) {
        const int lw = F.wave - 4;
#define RC_ISSUE(c) do { _Pragma("unroll") for (int i_ = 0; i_ < 4; ++i_) { if (4 + lw * 4 + i_ < 15) \
            __builtin_amdgcn_global_load_lds((const unsigned*)(rec + (size_t)(c) * RC_REC + (4 + lw * 4 + i_) * 1024 + lane * 16), (LAS unsigned*)(F.lds + ((c) & 7) * RC_SLOT + (4 + lw * 4 + i_) * 1024), 16, 0, 0); } } while (0)
#define RC_WAIT5() do { if (lw == 2) asm volatile("s_waitcnt vmcnt(15)" ::: "memory"); else asm volatile("s_waitcnt vmcnt(20)" ::: "memory"); } while (0)
        for (int c = cb; c < cb + 7; ++c) RC_ISSUE(c);
        RC_WAIT5();
        RC_BARRIER();
        for (int s = 0; s < NST; ++s) { const int c = cb + s;
            if (c + 7 < ce) { RC_ISSUE(c + 7); RC_WAIT5(); }
            else asm volatile("s_waitcnt vmcnt(0)" ::: "memory");
            RC_BARRIER();
        }
#undef RC_ISSUE
#undef RC_WAIT5
    } else {
        const int ib = F.wave, fr = lane & 15, q = lane >> 4;
#define RC_ISSUE1(c) __builtin_amdgcn_global_load_lds((const unsigned*)(rec + (size_t)(c) * RC_REC + ib * 1024 + lane * 16), (LAS unsigned*)(F.lds + ((c) & 7) * RC_SLOT + ib * 1024), 16, 0, 0)
#define RC_LOADOPS(O, c) do { const LAS unsigned char* slot = F.lds + ((c) & 7) * RC_SLOT; \
            O.aU0 = *(const LAS bf16x8*)(slot + RC_AR + q * 256 + fr * 16); O.aU1 = *(const LAS bf16x8*)(slot + RC_AR + 1024 + q * 256 + fr * 16); \
            O.u0 = *(const LAS v2u*)(slot + RC_U0 + (16 * ib + fr) * 32 + q * 8); O.vp = *(const LAS v2u*)(slot + RC_VP + (16 * ib + fr) * 32 + q * 8); \
            _Pragma("unroll") for (int jb = 0; jb < 4; ++jb) { O.bk[jb] = *(const LAS bf16x8*)(slot + RC_BK + (16 * jb + fr) * 64 + q * 16); O.dd[jb] = *(const LAS f32x4*)(slot + RC_D + (16 * jb + 4 * q) * 4); } \
            O.aY0 = *(const LAS bf16x8*)(slot + RC_AR + 2048 + q * 256 + fr * 16); O.aY1 = *(const LAS bf16x8*)(slot + RC_AR + 3072 + q * 256 + fr * 16); \
            O.y0 = *(const LAS v2u*)(slot + RC_Y0 + (16 * ib + fr) * 32 + q * 8); } while (0)
#define RC_COMPUTE(O, yp) do { v4u s0, s1; \
            s0.x = cvtpk_c(sT[0][0], sT[0][1]); s0.y = cvtpk_c(sT[0][2], sT[0][3]); s0.z = cvtpk_c(sT[1][0], sT[1][1]); s0.w = cvtpk_c(sT[1][2], sT[1][3]); \
            s1.x = cvtpk_c(sT[2][0], sT[2][1]); s1.y = cvtpk_c(sT[2][2], sT[2][3]); s1.z = cvtpk_c(sT[3][0], sT[3][1]); s1.w = cvtpk_c(sT[3][2], sT[3][3]); \
            const bf16x8 sb0 = __builtin_bit_cast(bf16x8, s0), sb1 = __builtin_bit_cast(bf16x8, s1); \
            f32x4 zU = (f32x4){0.f, 0.f, 0.f, 0.f}, zY = (f32x4){0.f, 0.f, 0.f, 0.f}; \
            zU = __builtin_amdgcn_mfma_f32_16x16x32_bf16(O.aU0, sb0, zU, 0, 0, 0); zU = __builtin_amdgcn_mfma_f32_16x16x32_bf16(O.aU1, sb1, zU, 0, 0, 0); \
            const float U0_ = zU[0] + bflo(O.u0.x), U1_ = zU[1] + bfhi(O.u0.x), U2_ = zU[2] + bflo(O.u0.y), U3_ = zU[3] + bfhi(O.u0.y); \
            v4u ubw; ubw.x = cvtpk_c(U0_, U1_); ubw.y = cvtpk_c(U2_, U3_); ubw.z = O.vp.x; ubw.w = O.vp.y; \
            const bf16x8 ub = __builtin_bit_cast(bf16x8, ubw); \
            _Pragma("unroll") for (int jb = 0; jb < 4; ++jb) sT[jb] = __builtin_amdgcn_mfma_f32_16x16x32_bf16(O.bk[jb], ub, sT[jb] * O.dd[jb], 0, 0, 0); \
            zY = __builtin_amdgcn_mfma_f32_16x16x32_bf16(O.aY0, sb0, zY, 0, 0, 0); zY = __builtin_amdgcn_mfma_f32_16x16x32_bf16(O.aY1, sb1, zY, 0, 0, 0); \
            (yp)[0] = cvt1_c(zY[0] + bflo(O.y0.x)); (yp)[64] = cvt1_c(zY[1] + bfhi(O.y0.x)); (yp)[128] = cvt1_c(zY[2] + bflo(O.y0.y)); (yp)[192] = cvt1_c(zY[3] + bfhi(O.y0.y)); } while (0)
#define RC_STEP_END(c) do { if ((c) + 7 < ce) { RC_ISSUE1((c) + 7); asm volatile("s_waitcnt vmcnt(5) lgkmcnt(0)" ::: "memory"); } else asm volatile("s_waitcnt vmcnt(0) lgkmcnt(0)" ::: "memory"); RC_BARRIER(); } while (0)
        f32x4* sv = (f32x4*)(FWS + WS_CTL + 262144) + (size_t)((u * 4 + ib) * 4 + 0) * 64 + lane;
        f32x4 sT[4];
#pragma unroll
        for (int jb = 0; jb < 4; ++jb) sT[jb] = first ? (f32x4){0.f, 0.f, 0.f, 0.f} : sv[jb * 64];
        asm volatile("s_waitcnt vmcnt(0)" ::: "memory");
        for (int c = cb; c < cb + 7; ++c) RC_ISSUE1(c);
        asm volatile("s_waitcnt vmcnt(5)" ::: "memory");
        RC_BARRIER();
        RcOps opA, opB;
        RC_LOADOPS(opA, cb);
        for (int s = 0; s < NST; s += 2) { const int c = cb + s;
            LAS bf16* yst = (LAS bf16*)(F.lds + RC_YST + ((s >> 1) & 1) * 4096) + (4 * q) * 64 + 16 * ib + fr;
            RC_LOADOPS(opB, c + 1);
            RC_COMPUTE(opA, yst);
            RC_STEP_END(c);
            RC_LOADOPS(opA, (c + 2 < ce) ? c + 2 : c);
            RC_COMPUTE(opB, yst + 1024);
            RC_STEP_END(c + 1);
        }
        if (!last) {
#pragma unroll
            for (int jb = 0; jb < 4; ++jb) sv[jb * 64] = sT[jb]; }
#undef RC_ISSUE1
#undef RC_LOADOPS
#undef RC_COMPUTE
#undef RC_STEP_END
    }
#undef RC_BARRIER
    asm volatile("s_waitcnt vmcnt(0) lgkmcnt(0)" ::: "memory");
    __syncthreads();
}
__device__ __forceinline__ void sub_arrive(Frame& F, unsigned* cnt) {
    asm volatile("s_waitcnt vmcnt(0)" ::: "memory");
    __syncthreads();
    if (F.tid == 0) { __builtin_amdgcn_fence(__ATOMIC_RELEASE, "agent"); asm volatile("s_waitcnt vmcnt(0)" ::: "memory"); __hip_atomic_fetch_add(cnt, 1u, __ATOMIC_RELAXED, __HIP_MEMORY_SCOPE_AGENT); }
}
__device__ __forceinline__ void sub_wait(Frame& F, unsigned* cnt, unsigned target) {
    if (F.tid == 0) { unsigned sp = 0u;
        while (__hip_atomic_load(cnt, __ATOMIC_RELAXED, __HIP_MEMORY_SCOPE_AGENT) < target) { __builtin_amdgcn_s_sleep(2); if (++sp > (1u << 24)) break; }
        __builtin_amdgcn_fence(__ATOMIC_ACQUIRE, "agent"); asm volatile("s_waitcnt vmcnt(0)" ::: "memory"); }
    __syncthreads();
}
__device__ __forceinline__ void sub_barrier(Frame& F, unsigned* cnt, unsigned target) {
    asm volatile("s_waitcnt vmcnt(0)" ::: "memory");
    __syncthreads();
    if (F.tid == 0) {
        __builtin_amdgcn_fence(__ATOMIC_RELEASE, "agent");
        asm volatile("s_waitcnt vmcnt(0)" ::: "memory");
        __hip_atomic_fetch_add(cnt, 1u, __ATOMIC_RELAXED, __HIP_MEMORY_SCOPE_AGENT);
        unsigned sp = 0u;
        while (__hip_atomic_load(cnt, __ATOMIC_RELAXED, __HIP_MEMORY_SCOPE_AGENT) < target) { __builtin_amdgcn_s_sleep(2); if (++sp > (1u << 24)) break; }
        __builtin_amdgcn_fence(__ATOMIC_ACQUIRE, "agent");
        asm volatile("s_waitcnt vmcnt(0)" ::: "memory");
    }
    __syncthreads();
}
__device__ __forceinline__ void mixer_post(Frame& F, int l, int gw, int NGW) {
    const bf16* P = (const bf16*)(FWS + WS_PROJ);
    const bf16* RH = (const bf16*)(FWS + WS_RW + 32 * MiB);
    const float* RW = (const float*)(FWS + WS_RW);
    const bf16* Y = (const bf16*)(FWS + WS_Y);
    const bf16* RO = (const bf16*)(FWS + WS_RETO);
    bf16* MX = (bf16*)(FWS + WS_MIXED);
    const float* ln_w = F.in[F.zz + 13] + l * 512; const float* ln_b = F.in[F.zz + 14] + l * 512;
    const int lane = F.lane;
    for (int m = gw; m < MROWS; m += NGW) {
        const size_t o = (size_t)m * 512;
        float y[8], s1[8], s2[8], bon[8], gat[8]; f32x2 ov[4]; float s3[4]; unsigned gw2[4];
#pragma unroll
        for (int h = 0; h < 8; ++h) { const int c = h * 64 + lane; y[h] = bf2f(Y[o + c]); bon[h] = bf2f(RH[6 * RWA + o + c]); gat[h] = bf2f(RH[5 * RWA + o + c]); s1[h] = y[h]; }
#pragma unroll
        for (int h = 0; h < 4; ++h) { const int c = h * 128 + 2 * lane; { const unsigned rw_ = *(const unsigned*)(RO + o + c); ov[h].x = bflo(rw_); ov[h].y = bfhi(rw_); } gw2[h] = *(const unsigned*)(P + (size_t)m * IN_PAD + C_RG + c); s3[h] = ov[h].x * ov[h].x + ov[h].y * ov[h].y; }
#pragma unroll
        for (int h = 0; h < 8; ++h) { s1[h] = dpp_add<0xB1>(s1[h]); s1[h] = dpp_add<0x4E>(s1[h]); s1[h] = dpp_add<0x141>(s1[h]); s1[h] = dpp_add<0x140>(s1[h]); }
#pragma unroll
        for (int h = 0; h < 4; ++h) { s3[h] = dpp_add<0xB1>(s3[h]); s3[h] = dpp_add<0x4E>(s3[h]); s3[h] = dpp_add<0x141>(s3[h]); s3[h] = dpp_add<0x140>(s3[h]); }
#pragma unroll
        for (int of = 16; of < 64; of <<= 1) {
#pragma unroll
            for (int h = 0; h < 8; ++h) s1[h] += __shfl_xor(s1[h], of);
#pragma unroll
            for (int h = 0; h < 4; ++h) s3[h] += __shfl_xor(s3[h], of); }
#pragma unroll
        for (int h = 0; h < 8; ++h) { const float d = y[h] - s1[h] * (1.0f / 64.0f); y[h] = d; s2[h] = d * d; }
#pragma unroll
        for (int h = 0; h < 8; ++h) { s2[h] = dpp_add<0xB1>(s2[h]); s2[h] = dpp_add<0x4E>(s2[h]); s2[h] = dpp_add<0x141>(s2[h]); s2[h] = dpp_add<0x140>(s2[h]); }
#pragma unroll
        for (int of = 16; of < 64; of <<= 1) {
#pragma unroll
            for (int h = 0; h < 8; ++h) s2[h] += __shfl_xor(s2[h], of); }
#pragma unroll
        for (int h = 0; h < 8; ++h) { const int c = h * 64 + lane;
            const float yn = y[h] * (1.0f / sqrtf(s2[h] * (1.0f / 64.0f) + GN_EPS)) * ln_w[c] + ln_b[c];
            MX[(size_t)m * DM + 512 + c] = (bf16)f2bf((yn + bon[h]) * gat[h]); }
#pragma unroll
        for (int h = 0; h < 4; ++h) { const int c = h * 128 + 2 * lane;
            const float rn = 1.0f / sqrtf(s3[h] * (1.0f / 128.0f) + NORM_EPS);
            const float g0 = bflo(gw2[h]), g1 = bfhi(gw2[h]);
            *(unsigned*)(MX + (size_t)m * DM + c) = pk2(ov[h].x * rn * g0 * sigmoidf_(g0), ov[h].y * rn * g1 * sigmoidf_(g1)); }
    }
}
__device__ __forceinline__ void conv_gate_phase(Frame& F, int l) {
    const bf16* U = (const bf16*)(FWS + WS_U);
    bf16* A = (bf16*)(FWS + WS_ACT);
    const float* cw = F.in[F.zz + 16] + (size_t)l * 3 * UPC; const float* cb = F.in[F.zz + 17] + (size_t)l * UPC;
    constexpr int NCG = DFF / 8, NRC = MROWS / 16;
    for (int it = F.vcu * NTHR + F.tid; it < NCG * NRC; it += F.G * NTHR) {
        const int cg = it % NCG, rc = it / NCG, c0 = cg * 8, row0 = rc * 16, t0 = row0 & (SEQ - 1);
        float wv[3][8], wg[3][8], bv[8], bg[8];
#pragma unroll
        for (int j = 0; j < 3; ++j)
#pragma unroll
            for (int e = 0; e < 8; ++e) { wv[j][e] = cw[j * UPC + c0 + e]; wg[j][e] = cw[j * UPC + DFF + c0 + e]; }
#pragma unroll
        for (int e = 0; e < 8; ++e) { bv[e] = cb[c0 + e]; bg[e] = cb[DFF + c0 + e]; }
        v4u v0 = {0u, 0u, 0u, 0u}, v1 = v0, g0 = v0, g1 = v0;
        if (t0 > 0) { v0 = *(const v4u*)(U + (size_t)(row0 - 2) * UPC + c0); v1 = *(const v4u*)(U + (size_t)(row0 - 1) * UPC + c0);
                      g0 = *(const v4u*)(U + (size_t)(row0 - 2) * UPC + DFF + c0); g1 = *(const v4u*)(U + (size_t)(row0 - 1) * UPC + DFF + c0); }
        for (int r = 0; r < 16; ++r) {
            const v4u v2 = *(const v4u*)(U + (size_t)(row0 + r) * UPC + c0), g2 = *(const v4u*)(U + (size_t)(row0 + r) * UPC + DFF + c0);
            float ov[8];
#pragma unroll
            for (int e = 0; e < 4; ++e) {
                const float va = wv[0][2 * e] * bflo(v0[e]) + wv[1][2 * e] * bflo(v1[e]) + wv[2][2 * e] * bflo(v2[e]) + bv[2 * e];
                const float vb = wv[0][2 * e + 1] * bfhi(v0[e]) + wv[1][2 * e + 1] * bfhi(v1[e]) + wv[2][2 * e + 1] * bfhi(v2[e]) + bv[2 * e + 1];
                const float ga = wg[0][2 * e] * bflo(g0[e]) + wg[1][2 * e] * bflo(g1[e]) + wg[2][2 * e] * bflo(g2[e]) + bg[2 * e];
                const float gb = wg[0][2 * e + 1] * bfhi(g0[e]) + wg[1][2 * e + 1] * bfhi(g1[e]) + wg[2][2 * e + 1] * bfhi(g2[e]) + bg[2 * e + 1];
                ov[2 * e] = ga * sigmoidf_(ga) * va; ov[2 * e + 1] = gb * sigmoidf_(gb) * vb; }
            v4u w; w.x = pk2(ov[0], ov[1]); w.y = pk2(ov[2], ov[3]); w.z = pk2(ov[4], ov[5]); w.w = pk2(ov[6], ov[7]);
            *(v4u*)(A + (size_t)(row0 + r) * DFF + c0) = w;
            v0 = v1; v1 = v2; g0 = g1; g1 = g2;
        }
    }
}

__device__ __forceinline__ void conv_fixup_phase(Frame& F, int l) {
    const float* H = (const float*)(FWS + WS_HALO);
    bf16* A = (bf16*)(FWS + WS_ACT);
    const float* cw = F.in[F.zz + 16] + (size_t)l * 3 * UPC; const float* cb = F.in[F.zz + 17] + (size_t)l * UPC;
    constexpr int NQ = DFF / 4;
    for (int it = F.vcu * NTHR + F.tid; it < (MROWS / 64) * 2 * NQ; it += F.G * NTHR) {
        const int c = (it % NQ) * 4, gr = it / NQ, r = gr & 1, g = gr >> 1, colp = (c >> 7) * 256 + (c & 127);
        const bool hasprev = (g & 63) != 0;
        const float* hg = H + (size_t)g * 4 * UPC + colp; const float* hp = hg - (size_t)4 * UPC;
        const f32x4 z = {0.f, 0.f, 0.f, 0.f};
        f32x4 v0, v1, v2, g0, g1, g2;
        v0 = *(const f32x4*)(hg + (size_t)r * UPC); g0 = *(const f32x4*)(hg + (size_t)r * UPC + 128);
        if (r == 1) { v1 = *(const f32x4*)hg; g1 = *(const f32x4*)(hg + 128); v2 = hasprev ? *(const f32x4*)(hp + (size_t)3 * UPC) : z; g2 = hasprev ? *(const f32x4*)(hp + (size_t)3 * UPC + 128) : z; }
        else { v1 = hasprev ? *(const f32x4*)(hp + (size_t)3 * UPC) : z; g1 = hasprev ? *(const f32x4*)(hp + (size_t)3 * UPC + 128) : z; v2 = hasprev ? *(const f32x4*)(hp + (size_t)2 * UPC) : z; g2 = hasprev ? *(const f32x4*)(hp + (size_t)2 * UPC + 128) : z; }
        const f32x4 cv = *(const f32x4*)(cw + c) * v2 + *(const f32x4*)(cw + UPC + c) * v1 + *(const f32x4*)(cw + 2 * UPC + c) * v0 + *(const f32x4*)(cb + c);
        const f32x4 cg = *(const f32x4*)(cw + DFF + c) * g2 + *(const f32x4*)(cw + UPC + DFF + c) * g1 + *(const f32x4*)(cw + 2 * UPC + DFF + c) * g0 + *(const f32x4*)(cb + DFF + c);
        v2u w; w.x = pk2(cg[0] * sigmoidf_(cg[0]) * cv[0], cg[1] * sigmoidf_(cg[1]) * cv[1]); w.y = pk2(cg[2] * sigmoidf_(cg[2]) * cv[2], cg[3] * sigmoidf_(cg[3]) * cv[3]);
        *(v2u*)(A + (size_t)(64 * g + r) * DFF + c) = w;
    }
}

#define GRID_BAR() do { xcd_barrier(bar, tid_from_wave(F.wave)); asm volatile("" : "+s"(F.wave), "+s"(F.vcu), "+s"(F.G)); F.tid = tid_from_wave(F.wave); F.lane = F.tid & 63; { unsigned z_ = 0u; asm volatile("" : "+v"(z_)); F.zz = __builtin_amdgcn_readfirstlane(z_); } } while (0)
#define XB ((bf16*)(FWS + WS_X))
#define HB ((bf16*)(FWS + WS_H))
#define PROJ ((bf16*)(FWS + WS_PROJ))
#define MIXED ((bf16*)(FWS + WS_MIXED))
#define UB ((bf16*)(FWS + WS_U))
#define ACT ((bf16*)(FWS + WS_ACT))
#define MOD ((const float*)(FWS + WS_MOD))
template <int l>
__device__ __forceinline__ void layer_fwd(Frame& F, const XcdBarrier& bar) {
#define modl (MOD + (size_t)l * 2 * 12288)
#define wl (FWS + WS_W + (size_t)l * W_LAYER)
        if (l == 0) norm_phase<0, true>(F, F.in[F.zz + 0], HB, F.in[F.zz + 21] + l * DM, modl + 0 * DM, modl + 1 * DM);
        else norm_phase<0, false>(F, XB, HB, F.in[F.zz + 21] + l * DM, modl + 0 * DM, modl + 1 * DM);
        GRID_BAR();
        { pg8::Gemm g{HB, (const bf16*)(wl + W_IN), MROWS, IN_PAD, DM}; pg8::StaticOrder S; S.init(MROWS, IN_PAD, F.G, (int)blockIdx.x);
          pg8::EpiBf16 E{PROJ, IN_PAD};
          pg8::gemm_phase<pg8::EpiBf16, pg8::StaticOrder, true, true>(F.lds, g, S, E, F.wave); }
        if (F.G == 256 && blockIdx.x >= 64) convert_gap(F, l, CV_IN, l == 0 ? CV_C1 : CV_OUT + CV_UP, ((int)blockIdx.x - 64) * NWAVES + F.wave, 192 * NWAVES, CV_N1);
        GRID_BAR();
        rwkv_prep_mfma(F, l, F.vcu, F.G);
        moba_kmean(F);
        GRID_BAR();
        const int xg_ = F.vcu >> 5, xj_ = F.vcu & 31, mi_ = xg_ * 16 + xj_;
        if (xj_ < 16) { moba_item(F, mi_ >> 3, 15 - (mi_ & 7), mi_ & 7);
            if (F.G == 256 && l == 0) { constexpr int nr_ = CV_LAYER - (CV_IN + CV_C1); LAS float* scr_ = (LAS float*)(F.lds + F.wave * 16384);
                for (int j = 0; j < CV_N3; ++j) { const int s_ = mi_ * NWAVES + F.wave + 128 * NWAVES * j;
                    if (s_ < nr_) convert_item(F, l * CV_LAYER + CV_IN + CV_C1 + s_, scr_);
                    else if (l == 0 && s_ - nr_ < CV_IN - CV_C2) convert_item(F, CV_LAYER + CV_C2 + (s_ - nr_), scr_); } } }
        else {
            const int rv = xg_ * 16 + (xj_ - 16), nrc = F.G / 2;
            unsigned* sub = (unsigned*)(FWS + WS_CTL) + CW_SUB + 128 * l;
            constexpr int RC_SPLIT = 104;
            rc_pass1_rwkv(F, rv * NWAVES + F.wave, nrc * NWAVES, 0, 128);
            rc_pass1_ret(F, rv * NWAVES + F.wave, nrc * NWAVES, 0, 128);
            sub_barrier(F, sub, (unsigned)nrc);
            const bool p2cu = (rv & 3) == 0 && (rv >> 2) < RC_UNITS;
            if (p2cu) {
                rc_pass2(F, rv >> 2, 0, RC_SPLIT, true, false);
                sub_wait(F, sub + 32, (unsigned)(nrc - RC_UNITS));
                rc_pass2(F, rv >> 2, RC_SPLIT, RC_NCH, false, true);
            } else {
                const int ov = rv - (rv >> 2) - 1, nov = nrc - RC_UNITS;
                rc_pass1_rwkv(F, ov * NWAVES + F.wave, nov * NWAVES, 128, 128);
                rc_pass1_ret(F, ov * NWAVES + F.wave, nov * NWAVES, 128, 128);
                sub_arrive(F, sub + 32);
            }
            sub_barrier(F, sub + 64, (unsigned)nrc);
            mixer_post(F, l, rv * NWAVES + F.wave, nrc * NWAVES);
        }
        GRID_BAR();
#if MOBA_CHECK
        moba_naive(F, F.vcu * NWAVES + F.wave, F.G * NWAVES);
        GRID_BAR();
        { float sd = 0.f, sn = 0.f; const bf16* NV = (const bf16*)(FWS + WS_U + 160 * MiB); const bf16* MXc = (const bf16*)(FWS + WS_MIXED);
          for (int m = F.vcu * NWAVES + F.wave; m < MROWS; m += F.G * NWAVES) for (int j = 0; j < 16; ++j) { const float a = bf2f(MXc[(size_t)m * DM + 1024 + j * 64 + F.lane]), b = bf2f(NV[(size_t)m * 1024 + j * 64 + F.lane]); sd += (a - b) * (a - b); sn += b * b; }
          atomicAdd((float*)(FWS + WS_CTL) + 8, sd); atomicAdd((float*)(FWS + WS_CTL) + 9, sn); }
        GRID_BAR();
#endif
        { pg8::Gemm g{MIXED, (const bf16*)(wl + W_OUT), MROWS, DM, DM}; pg8::StaticOrder S; S.init(MROWS, DM, F.G, (int)blockIdx.x);
          if (l == 0) { pg8::EpiResGate<true> E{F.in[F.zz + 0], XB, DM, modl + 2 * DM, 12288, SEQ}; pg8::gemm_phase<pg8::EpiResGate<true>, pg8::StaticOrder, true, true>(F.lds, g, S, E, F.wave); }
          else { pg8::EpiResGate<false> E{XB, XB, DM, modl + 2 * DM, 12288, SEQ}; pg8::gemm_phase<pg8::EpiResGate<false>, pg8::StaticOrder, true, true>(F.lds, g, S, E, F.wave); } }
        GRID_BAR();
        norm_phase<0, false>(F, XB, HB, F.in[F.zz + 22] + l * DM, modl + 3 * DM, modl + 4 * DM);
        GRID_BAR();
        { pg8::Gemm g{HB, (const bf16*)(wl + W_UP), MROWS, UPC, DM}; pg8::StaticOrder S; S.init(MROWS, UPC, F.G, (int)blockIdx.x);
          pg8::EpiConvGate E{ACT, DFF, (float*)(FWS + WS_HALO), F.in[F.zz + 16] + (size_t)l * 3 * UPC, F.in[F.zz + 17] + (size_t)l * UPC, UPC, DFF};
          pg8::gemm_phase<pg8::EpiConvGate, pg8::StaticOrder, true, true>(F.lds, g, S, E, F.wave); }
        if (l == 0 && F.G == 256 && blockIdx.x >= 128) { if (blockIdx.x < 224) adaln_item(F, 1, (int)blockIdx.x - 128); convert_gap(F, 1, 0, CV_C2, ((int)blockIdx.x - 128) * NWAVES + F.wave, 128 * NWAVES, CV_N2); }
        if (l == 1 && F.G == 256 && blockIdx.x >= 128) convert_gap(F, 1, CV_IN + CV_OUT + CV_UP, CV_DN, ((int)blockIdx.x - 128) * NWAVES + F.wave, 128 * NWAVES, CV_N2);
        GRID_BAR();
        conv_fixup_phase(F, l);
        GRID_BAR();
        { pg8::Gemm g{ACT, (const bf16*)(wl + W_DN), MROWS, DM, DFF}; pg8::StaticOrder S; S.init(MROWS, DM, F.G, (int)blockIdx.x);
          pg8::EpiResGate<false> E{XB, XB, DM, modl + 5 * DM, 12288, SEQ};
          pg8::gemm_phase<pg8::EpiResGate<false>, pg8::StaticOrder, true, true>(F.lds, g, S, E, F.wave); }
        GRID_BAR();
}

__global__ void __launch_bounds__(NTHR, 2) mega_fwd(Args args) {
    extern __shared__ __attribute__((aligned(16))) unsigned char lds[];
    Frame F;
    F.lds = (LAS unsigned char*)lds;
    F.tid = threadIdx.x; F.lane = F.tid & 63; F.wave = __builtin_amdgcn_readfirstlane(F.tid >> 6);
    F.G = gridDim.x; { const int bx = blockIdx.x; F.vcu = (F.G % 8 == 0) ? (bx % 8) * (F.G / 8) + bx / 8 : bx; }
    F.in = args.in; F.ws = args.ws; F.zz = 0;
    volatile LAS unsigned* MISC = (volatile LAS unsigned*)(F.lds + MISC_OFF);
    for (int u = F.tid; u < (LDS_BYTES - LDSCTL_OFF) / 4; u += NTHR) ((LAS unsigned*)(F.lds + LDSCTL_OFF))[u] = 0u;
    __syncthreads();
    XcdBarrier bar = xcd_barrier_post((unsigned*)(FWS + WS_CTL) + CW_BAR, MISC + 8, F.tid);

    p0_prologue(F);
    GRID_BAR();
    layer_fwd<0>(F, bar);
    layer_fwd<1>(F, bar);
    norm_phase<1, false>(F, XB, args.out, F.in[F.zz + 23], nullptr, nullptr);
}

extern "C" void kernel_launch(void* const* d_in, const int* in_sizes, int n_in, void* d_out, int out_size, void* d_ws, size_t ws_size, hipStream_t stream) {
    static int grid = 0;
    if (grid == 0) {
        if (n_in != 24 || out_size != MROWS * DM || ws_size < WS_END) { fprintf(stderr, "kernel_launch: unexpected shapes (n_in %d out %d ws %zu)\n", n_in, out_size, ws_size); grid = -1; return; }
        int dev = 0, cus = 0;
        if (hipGetDevice(&dev) != hipSuccess || hipDeviceGetAttribute(&cus, hipDeviceAttributeMultiprocessorCount, dev) != hipSuccess) { grid = -1; return; }
        if (hipFuncSetAttribute((const void*)mega_fwd, hipFuncAttributeMaxDynamicSharedMemorySize, LDS_BYTES) != hipSuccess) { fprintf(stderr, "kernel_launch: hipFuncSetAttribute failed\n"); grid = -1; return; }
        int per_cu = 0;
        if (hipOccupancyMaxActiveBlocksPerMultiprocessor(&per_cu, (const void*)mega_fwd, NTHR, LDS_BYTES) != hipSuccess || per_cu < 1) { fprintf(stderr, "kernel_launch: occupancy query says %d\n", per_cu); }
        (void)hipGetLastError();
        grid = cus;
    }
    if (grid < 0) return;
    (void)hipMemsetAsync((char*)d_ws + WS_CTL, 0, CTL_ZERO_BYTES, stream);
    Args a{};
    for (int i = 0; i < 24; ++i) a.in[i] = (const float*)d_in[i];
    a.out = (float*)d_out; a.ws = (unsigned char*)d_ws;
    hipLaunchKernelGGL(mega_fwd, dim3(grid), dim3(NTHR), LDS_BYTES, stream, a);
}
```

```cpp
#include <hip/hip_runtime.h>
#include <cstdio>
#include <cstdint>
#ifndef MOBA_NP
#define MOBA_NP 2
#endif
#ifndef MOBA_CHECK
#define MOBA_CHECK 0
#endif
__device__ __forceinline__ int tid_from_wave(int wave) { int l = (int)__builtin_amdgcn_mbcnt_hi(~0u, __builtin_amdgcn_mbcnt_lo(~0u, 0u)); asm volatile("" : "+v"(l)); return wave * 64 + l; }
namespace pg8 {
#define PG8_LAS __attribute__((address_space(3)))
typedef unsigned short bf16_t;
typedef short bf16x8 __attribute__((ext_vector_type(8)));
typedef float f32x4 __attribute__((ext_vector_type(4)));
typedef unsigned u32x4 __attribute__((ext_vector_type(4)));
constexpr int BM = 256, BK = 64, HALF = 128, HTB = HALF * BK * 2  , STAGE_BYTES = 8 * HTB, NXCD = 8, WGM = 8;

__host__ __device__ __forceinline__ int lds_byte(int r, int c) { const int st = (r >> 4) * 2 + (c >> 5), rr = r & 15, cc = c & 31, ob = rr * 64 + cc * 2; return st * 1024 + (ob ^ (((ob >> 9) & 1) << 5)); }
__host__ __device__ __forceinline__ void stage_rc(int b, int& R, int& C) { const int st = b / 1024, sb = b % 1024, swz = sb ^ (((sb >> 9) & 1) << 5); R = (st >> 1) * 16 + swz / 64; C = (st & 1) * 32 + (swz % 64) / 2; }
__host__ __device__ __forceinline__ int perm32(int rho) { const int n = rho >> 4, i = rho & 15; return 8 * (i >> 2) + 4 * n + (i & 3); }

struct Unit { int pm, pn; };
struct Gemm { const bf16_t* A; const bf16_t* Bt; int M, N, K; };

struct StaticOrder {
    int nM, nN, nwg, G, c;
    __host__ __device__ void init(int M, int N, int G_, int c_) { nM = M / BM; nN = N / BM; nwg = nM * nN; G = G_; c = c_; }
    __host__ __device__ bool next(int i, Unit& u) const {
        const long L = (long)i * G + c; if (L >= nwg) return false;
        int wgid = (int)L; { const int q = nwg / NXCD, r = nwg % NXCD, xcd = wgid % NXCD, off = wgid / NXCD; wgid = (xcd < r ? xcd * (q + 1) : r * (q + 1) + (xcd - r) * q) + off; }
        const int nig = WGM * nN, gid = wgid / nig, fm = gid * WGM, gsz = (nM - fm) < WGM ? (nM - fm) : WGM;
        u.pm = fm + ((wgid % nig) % gsz); u.pn = (wgid % nig) / gsz; return true;
    }
    __device__ __forceinline__ void a_ready(const Unit&) const {}
    __device__ __forceinline__ void done(const Unit&) const {}
};

__device__ __forceinline__ unsigned cvt_pk_bf16(float lo, float hi) { unsigned r; asm volatile("v_cvt_pk_bf16_f32 %0, %1, %2" : "=v"(r) : "v"(lo), "v"(hi)); return r; }

struct EpiBf16 {
    static constexpr bool PERM = true, AFTER_DRAIN = false;
    bf16_t* O; int ldc;
    __device__ __forceinline__ void operator()(const f32x4 (&acc)[2][2][4][2], const Unit& u, int wr, int wc, int fr, int fq) const {
        const int row0 = u.pm * BM + wr * 64 + fr; const int col0 = u.pn * BM + wc * 32 + 8 * fq;
#pragma unroll
        for (int ai = 0; ai < 2; ++ai)
#pragma unroll
            for (int m = 0; m < 4; ++m) { bf16_t* rowp = O + (size_t)(row0 + ai * HALF + m * 16) * ldc + col0;
#pragma unroll
                for (int bj = 0; bj < 2; ++bj) { const f32x4 v0 = acc[ai][bj][m][0], v1 = acc[ai][bj][m][1];
                    u32x4 w; w.x = cvt_pk_bf16(v0[0], v0[1]); w.y = cvt_pk_bf16(v0[2], v0[3]); w.z = cvt_pk_bf16(v1[0], v1[1]); w.w = cvt_pk_bf16(v1[2], v1[3]);
                    *(u32x4*)(rowp + bj * HALF) = w; } }
    }
};

template <int CTRL> __device__ __forceinline__ float dpp_ror(float v) { return __builtin_bit_cast(float, __builtin_amdgcn_update_dpp(0, __builtin_bit_cast(int, v), CTRL, 0xF, 0xF, true)); }
struct EpiConvGate {
    static constexpr bool PERM = true, AFTER_DRAIN = false;
    bf16_t* A; int lda; float* halo; const float* cw; const float* cb; int nup, dff;
    __device__ __forceinline__ void operator()(const f32x4 (&acc)[2][2][4][2], const Unit& u, int wr, int wc, int fr, int fq) const {
        const int chl = wc * 32 + 8 * fq;
#pragma unroll
        for (int n = 0; n < 2; ++n) {
            const int c = u.pn * 128 + chl + 4 * n, colp = u.pn * 256 + chl + 4 * n;
            const f32x4 wv0 = *(const f32x4*)(cw + c), wv1 = *(const f32x4*)(cw + nup + c), wv2 = *(const f32x4*)(cw + 2 * nup + c), bv = *(const f32x4*)(cb + c);
            const f32x4 wg0 = *(const f32x4*)(cw + dff + c), wg1 = *(const f32x4*)(cw + nup + dff + c), wg2 = *(const f32x4*)(cw + 2 * nup + dff + c), bg = *(const f32x4*)(cb + dff + c);
#pragma unroll
            for (int ai = 0; ai < 2; ++ai) {
                const int grow = u.pm * BM + ai * HALF + wr * 64;
                float* hb = halo + (size_t)(grow >> 6) * 4 * nup + colp;
                if (fr < 2) { *(f32x4*)(hb + (size_t)fr * nup) = acc[ai][0][0][n]; *(f32x4*)(hb + (size_t)fr * nup + 128) = acc[ai][1][0][n]; }
                if (fr >= 14) { *(f32x4*)(hb + (size_t)(fr - 12) * nup) = acc[ai][0][3][n]; *(f32x4*)(hb + (size_t)(fr - 12) * nup + 128) = acc[ai][1][3][n]; }
                f32x4 cv[4];
                {   f32x4 P1 = {0.f, 0.f, 0.f, 0.f}, P2 = P1;
#pragma unroll
                    for (int m = 0; m < 4; ++m) { f32x4 R1, R2;
#pragma unroll
                        for (int e = 0; e < 4; ++e) { R1[e] = dpp_ror<0x121>(acc[ai][0][m][n][e]); R2[e] = dpp_ror<0x122>(acc[ai][0][m][n][e]); }
                        const f32x4 p1 = (fr >= 1) ? R1 : P1, p2 = (fr >= 2) ? R2 : P2; P1 = R1; P2 = R2;
                        cv[m] = wv0 * p2 + wv1 * p1 + wv2 * acc[ai][0][m][n] + bv; } }
                {   f32x4 P1 = {0.f, 0.f, 0.f, 0.f}, P2 = P1;
#pragma unroll
                    for (int m = 0; m < 4; ++m) { f32x4 R1, R2;
#pragma unroll
                        for (int e = 0; e < 4; ++e) { R1[e] = dpp_ror<0x121>(acc[ai][1][m][n][e]); R2[e] = dpp_ror<0x122>(acc[ai][1][m][n][e]); }
                        const f32x4 p1 = (fr >= 1) ? R1 : P1, p2 = (fr >= 2) ? R2 : P2; P1 = R1; P2 = R2;
                        const f32x4 cg = wg0 * p2 + wg1 * p1 + wg2 * acc[ai][1][m][n] + bg;
                        f32x4 o;
#pragma unroll
                        for (int e = 0; e < 4; ++e) o[e] = cg[e] * __builtin_amdgcn_rcpf(1.0f + __expf(-cg[e])) * cv[m][e];
                        unsigned w0 = cvt_pk_bf16(o[0], o[1]), w1 = cvt_pk_bf16(o[2], o[3]);
                        *(unsigned long long*)(A + (size_t)(grow + m * 16 + fr) * lda + c) = (unsigned long long)w0 | ((unsigned long long)w1 << 32); } }
            }
        }
    }
};

template <bool BASE_F32>
struct EpiResGate {
    static constexpr bool PERM = true, AFTER_DRAIN = false;
    const void* base; bf16_t* out; int ldc; const float* gate; int gstride; int rows_per_batch;
    __device__ __forceinline__ void operator()(const f32x4 (&acc)[2][2][4][2], const Unit& u, int wr, int wc, int fr, int fq) const {
        const int col0 = u.pn * BM + wc * 32 + 8 * fq;
        const int b = (u.pm * BM) / rows_per_batch;
        f32x4 gv[2][2];
#pragma unroll
        for (int bj = 0; bj < 2; ++bj)
#pragma unroll
            for (int n = 0; n < 2; ++n) gv[bj][n] = *(const f32x4*)(gate + (size_t)b * gstride + col0 + bj * HALF + n * 4);
#pragma unroll
        for (int ai = 0; ai < 2; ++ai)
#pragma unroll
            for (int m = 0; m < 4; ++m) { const size_t off = (size_t)(u.pm * BM + ai * HALF + wr * 64 + m * 16 + fr) * ldc + col0;
#pragma unroll
                for (int bj = 0; bj < 2; ++bj) { f32x4 b0, b1;
                    if (BASE_F32) { b0 = *(const f32x4*)((const float*)base + off + bj * HALF); b1 = *(const f32x4*)((const float*)base + off + bj * HALF + 4); }
                    else { const u32x4 w = *(const u32x4*)((const bf16_t*)base + off + bj * HALF);
                        b0 = (f32x4){__builtin_bit_cast(float, w.x << 16), __builtin_bit_cast(float, w.x & 0xffff0000u), __builtin_bit_cast(float, w.y << 16), __builtin_bit_cast(float, w.y & 0xffff0000u)};
                        b1 = (f32x4){__builtin_bit_cast(float, w.z << 16), __builtin_bit_cast(float, w.z & 0xffff0000u), __builtin_bit_cast(float, w.w << 16), __builtin_bit_cast(float, w.w & 0xffff0000u)}; }
                    const f32x4 o0 = b0 + gv[bj][0] * acc[ai][bj][m][0], o1 = b1 + gv[bj][1] * acc[ai][bj][m][1];
                    u32x4 w; w.x = cvt_pk_bf16(o0[0], o0[1]); w.y = cvt_pk_bf16(o0[2], o0[3]); w.z = cvt_pk_bf16(o1[0], o1[1]); w.w = cvt_pk_bf16(o1[2], o1[3]);
                    *(u32x4*)(out + off + bj * HALF) = w; }
                if (m & 1) asm volatile("" ::: "memory"); }
    }
};

template <class Epi, class Sched, bool ALIGN_EPI = false, bool SP2 = false>
__device__ __forceinline__ void gemm_phase(PG8_LAS unsigned char* lds, const Gemm g, const Sched& S, const Epi& E, int wave_) {
    const int tid_ = tid_from_wave(wave_);
    const int tid = tid_, wid = __builtin_amdgcn_readfirstlane(tid >> 6), lane = tid & 63, wr = wid >> 2, wc = wid & 3, fr = lane & 15, fq = lane >> 4;
    const int K = g.K, nt = K / BK;
    unsigned voffA[2], voffB[2];
#pragma unroll
    for (int i = 0; i < 2; ++i) { int R, C; stage_rc(tid * 16 + i * 8192, R, C); const int Rb = Epi::PERM ? ((R & ~31) + perm32(R & 31)) : R;
        voffA[i] = (unsigned)(R * K + C) * 2u; voffB[i] = (unsigned)(Rb * K + C) * 2u; }
    const size_t kstep = (size_t)(BK * 2);
    const size_t hstep = (size_t)HALF * K * 2;
    const size_t tstep = 2 * hstep;
    const unsigned ldsw = (unsigned)wid * 1024u;
    const int aoff = lds_byte(wr * 64 + fr, fq * 8), boff = lds_byte(wc * 32 + fr, fq * 8);
#define PG8_SA(b, h) (((b) * 2 + (h)) * HTB)
#define PG8_SB(b, h) ((4 + (b) * 2 + (h)) * HTB)
#define PG8_STAGE(bufoff, gbase, voff) do { _Pragma("unroll") for (int _i = 0; _i < 2; ++_i) \
        __builtin_amdgcn_global_load_lds((const unsigned*)((const char*)(gbase) + (voff)[_i]), (PG8_LAS unsigned*)(lds + (bufoff) + ldsw + _i * 8192), 16, 0, 0); } while (0)
#define PG8_LDA(dst, b, h) do { _Pragma("unroll") for (int m = 0; m < 4; ++m) _Pragma("unroll") for (int k = 0; k < 2; ++k) dst[m][k] = *(const PG8_LAS bf16x8*)(lds + PG8_SA(b, h) + aoff + m * 2048 + k * 1024); } while (0)
#define PG8_LDB(dst, b, h) do { _Pragma("unroll") for (int n = 0; n < 2; ++n) _Pragma("unroll") for (int k = 0; k < 2; ++k) dst[n][k] = *(const PG8_LAS bf16x8*)(lds + PG8_SB(b, h) + boff + n * 2048 + k * 1024); } while (0)
#define PG8_MMA(ai, bj, At, Bt) do { __builtin_amdgcn_s_setprio(1); _Pragma("unroll") for (int m = 0; m < 4; ++m) _Pragma("unroll") for (int n = 0; n < 2; ++n) _Pragma("unroll") for (int k = 0; k < 2; ++k) \
        acc[ai][bj][m][n] = __builtin_amdgcn_mfma_f32_16x16x32_bf16(Bt[n][k], At[m][k], acc[ai][bj][m][n], 0, 0, 0); __builtin_amdgcn_s_setprio(0); } while (0)
#define PG8_WAIT_V(n) asm volatile("s_waitcnt vmcnt(" #n ")" ::: "memory")
#define PG8_WAIT_L(n) asm volatile("s_waitcnt lgkmcnt(" #n ")" ::: "memory")
#define PG8_BAR __builtin_amdgcn_s_barrier()
#define PG8_SCHED __builtin_amdgcn_sched_barrier(0)
    Unit cur, nxt; int ui = 0;
    if (!S.next(0, cur)) return;
    f32x4 acc[2][2][4][2];
#pragma unroll
    for (int a = 0; a < 2; ++a)
#pragma unroll
        for (int b = 0; b < 2; ++b)
#pragma unroll
            for (int m = 0; m < 4; ++m)
#pragma unroll
                for (int n = 0; n < 2; ++n) acc[a][b][m][n] = (f32x4){0.f, 0.f, 0.f, 0.f};
    bf16x8 At[4][2], B0[2][2], B1[2][2];
    const char* cA = (const char*)g.A + (size_t)cur.pm * tstep; const char* cB = (const char*)g.Bt + (size_t)cur.pn * tstep;
    S.a_ready(cur);
    if constexpr (SP2) {
        PG8_STAGE(PG8_SB(0, 0), cB, voffB); PG8_STAGE(PG8_SB(0, 1), cB + hstep, voffB); PG8_STAGE(PG8_SA(0, 0), cA, voffA); PG8_STAGE(PG8_SA(0, 1), cA + hstep, voffA);
        if (wr == 1) PG8_BAR;
        PG8_WAIT_V(2); PG8_BAR;
        PG8_STAGE(PG8_SB(1, 0), cB + kstep, voffB); PG8_STAGE(PG8_SA(1, 0), cA + kstep, voffA); PG8_STAGE(PG8_SB(1, 1), cB + hstep + kstep, voffB);
        PG8_WAIT_V(6); PG8_BAR;
    } else {
        PG8_STAGE(PG8_SB(0, 0), cB, voffB); PG8_STAGE(PG8_SA(0, 0), cA, voffA); PG8_STAGE(PG8_SB(0, 1), cB + hstep, voffB); PG8_STAGE(PG8_SA(0, 1), cA + hstep, voffA);
        if (wr == 1) PG8_BAR;
        PG8_WAIT_V(4); PG8_BAR;
        PG8_STAGE(PG8_SB(1, 0), cB + kstep, voffB); PG8_STAGE(PG8_SA(1, 0), cA + kstep, voffA); PG8_STAGE(PG8_SB(1, 1), cB + hstep + kstep, voffB);
        PG8_WAIT_V(6); PG8_BAR;
    }
    for (;;) {
        const bool has_next = S.next(ui + 1, nxt);
        const char* nA = has_next ? (const char*)g.A + (size_t)nxt.pm * tstep : cA; const char* nB = has_next ? (const char*)g.Bt + (size_t)nxt.pn * tstep : cB;
        for (int t = 0; t < nt; t += 2) {
            const bool last = (t == nt - 2);
            const char* a1 = cA + (size_t)(t + 1) * kstep;
            const char* a2 = last ? nA : cA + (size_t)(t + 2) * kstep; const char* b2 = last ? nB : cB + (size_t)(t + 2) * kstep;
            const char* a3 = a2 + kstep; const char* b3 = b2 + kstep;
            if (last && has_next) S.a_ready(nxt);
            if constexpr (SP2) {
            PG8_LDB(B0, 0, 0); PG8_LDB(B1, 0, 1); PG8_SCHED; PG8_LDA(At, 0, 0); PG8_STAGE(PG8_SA(1, 1), a1 + hstep, voffA);
            PG8_WAIT_V(8); PG8_WAIT_L(0); PG8_BAR; PG8_MMA(0, 0, At, B0); PG8_MMA(0, 1, At, B1); PG8_BAR; PG8_SCHED;
            PG8_LDA(At, 0, 1); PG8_STAGE(PG8_SB(0, 0), b2, voffB); PG8_STAGE(PG8_SB(0, 1), b2 + hstep, voffB); PG8_STAGE(PG8_SA(0, 0), a2, voffA);
            PG8_WAIT_V(8); PG8_WAIT_L(0); PG8_BAR; PG8_MMA(1, 0, At, B0); PG8_MMA(1, 1, At, B1); PG8_BAR; PG8_SCHED;
            PG8_LDB(B0, 1, 0); PG8_LDB(B1, 1, 1); PG8_SCHED; PG8_LDA(At, 1, 0); PG8_STAGE(PG8_SA(0, 1), a2 + hstep, voffA);
            PG8_WAIT_V(8); PG8_WAIT_L(0); PG8_BAR; PG8_MMA(0, 0, At, B0); PG8_MMA(0, 1, At, B1); PG8_BAR; PG8_SCHED;
            PG8_LDA(At, 1, 1); PG8_STAGE(PG8_SB(1, 0), b3, voffB); PG8_STAGE(PG8_SB(1, 1), b3 + hstep, voffB); PG8_STAGE(PG8_SA(1, 0), a3, voffA);
            PG8_WAIT_V(8); PG8_WAIT_L(0); PG8_BAR; PG8_MMA(1, 0, At, B0); PG8_MMA(1, 1, At, B1); PG8_BAR; PG8_SCHED;
            } else {
            PG8_LDB(B0, 0, 0); PG8_SCHED; PG8_LDA(At, 0, 0); PG8_STAGE(PG8_SA(1, 1), a1 + hstep, voffA);
            PG8_WAIT_L(8); PG8_BAR; PG8_WAIT_L(0); PG8_MMA(0, 0, At, B0); PG8_BAR; PG8_SCHED;
            PG8_LDB(B1, 0, 1); PG8_STAGE(PG8_SB(0, 0), b2, voffB);
            PG8_BAR; PG8_WAIT_L(0); PG8_MMA(0, 1, At, B1); PG8_BAR;
            PG8_LDA(At, 0, 1); PG8_STAGE(PG8_SA(0, 0), a2, voffA);
            PG8_BAR; PG8_WAIT_L(0); PG8_MMA(1, 0, At, B0); PG8_BAR; PG8_SCHED;
            PG8_STAGE(PG8_SB(0, 1), b2 + hstep, voffB);
            PG8_WAIT_V(6); PG8_BAR; PG8_MMA(1, 1, At, B1); PG8_BAR;
            PG8_LDB(B0, 1, 0); PG8_SCHED; PG8_LDA(At, 1, 0); PG8_STAGE(PG8_SA(0, 1), a2 + hstep, voffA);
            PG8_WAIT_L(8); PG8_BAR; PG8_WAIT_L(0); PG8_MMA(0, 0, At, B0); PG8_BAR; PG8_SCHED;
            PG8_LDB(B1, 1, 1); PG8_STAGE(PG8_SB(1, 0), b3, voffB);
            PG8_BAR; PG8_WAIT_L(0); PG8_MMA(0, 1, At, B1); PG8_BAR;
            PG8_LDA(At, 1, 1); PG8_STAGE(PG8_SA(1, 0), a3, voffA);
            PG8_BAR; PG8_WAIT_L(0); PG8_MMA(1, 0, At, B0); PG8_BAR; PG8_SCHED;
            PG8_STAGE(PG8_SB(1, 1), b3 + hstep, voffB);
            PG8_WAIT_V(6); PG8_BAR; PG8_MMA(1, 1, At, B1); PG8_BAR;
            }
        }
        if constexpr (ALIGN_EPI) { if (wr == 0) PG8_BAR; }
        if constexpr (!Epi::AFTER_DRAIN) { E(acc, cur, wr, wc, fr, fq); S.done(cur); }
        if (!has_next) break;
#pragma unroll
        for (int a = 0; a < 2; ++a)
#pragma unroll
            for (int b = 0; b < 2; ++b)
#pragma unroll
                for (int m = 0; m < 4; ++m)
#pragma unroll
                    for (int n = 0; n < 2; ++n) acc[a][b][m][n] = (f32x4){0.f, 0.f, 0.f, 0.f};
        cur = nxt; cA = nA; cB = nB; ++ui;
        if constexpr (ALIGN_EPI) { if (wr == 1) PG8_BAR; }
    }
    PG8_WAIT_V(0);
    if constexpr (!ALIGN_EPI) { if (wr == 0) PG8_BAR; }
    PG8_BAR;
    if constexpr (Epi::AFTER_DRAIN) { E.fused(acc, cur, wr, wc, fr, fq, lds, wid, lane); S.done(cur); }
#undef PG8_SA
#undef PG8_SB
#undef PG8_STAGE
#undef PG8_LDA
#undef PG8_LDB
#undef PG8_MMA
#undef PG8_WAIT_V
#undef PG8_WAIT_L
#undef PG8_BAR
#undef PG8_SCHED
}
}

namespace moba {
using bf16 = unsigned short;
typedef short bf16x8 __attribute__((ext_vector_type(8)));
typedef short s16x4 __attribute__((ext_vector_type(4)));
typedef float f32x16 __attribute__((ext_vector_type(16)));
typedef float f32x4 __attribute__((ext_vector_type(4)));
typedef unsigned u32x4 __attribute__((ext_vector_type(4)));
#define MLAS __attribute__((address_space(3)))
typedef MLAS char lchar; typedef MLAS float lfloat; typedef MLAS bf16x8 lbf16x8;
template <class A, class Bt> struct same_t { static constexpr bool v = false; };
template <class A> struct same_t<A, A> { static constexpr bool v = true; };
constexpr int D = 128, LDI = 6656, LDO = 2048;
constexpr float THR = 8.f;
constexpr bool WSKIP = false;
constexpr float SCALE = 0.08838834764831845f;
constexpr int NW = 8, QBLK = 32, KVBLK = 64, QB = NW * QBLK;
constexpr int SHM_V = KVBLK * D * 2, SHM_K = KVBLK * D * 2;
constexpr int LDS_BYTES = 2 * SHM_V + 2 * SHM_K + NW * 64 * 4;
#define KSWZ(row, colB) ((row) * 256 + ((colB) ^ (((row) & 7) << 4)))
#define SBAR() __builtin_amdgcn_sched_barrier(0)
__device__ __forceinline__ int v_st(int k, int c) { const int kk = (k & ~0xC) | ((k & 4) << 1) | ((k & 8) >> 1); return ((kk >> 3) * 4 + (c >> 5)) * 512 + ((kk & 7) * 32 + (c & 31)) * 2; }
__device__ __forceinline__ int v_rd_base(int lane) { return ((lane & 3) << 3) | (((lane >> 2) & 3) << 6) | (((lane >> 4) & 1) << 5) | (((lane >> 5) & 1) << 8); }
constexpr int v_rd_off(int d0, int ks, int half) { return d0 * 512 + ks * 4096 + half * 2048; }
__device__ __forceinline__ int crow(int r, int hi) { return (r & 3) + 8 * (r >> 2) + 4 * hi; }
__device__ __forceinline__ unsigned cvtpk(float lo, float hi) {
    unsigned r; asm volatile("v_cvt_pk_bf16_f32 %0, %1, %2" : "=v"(r) : "v"(lo), "v"(hi)); return r;
}
__device__ __forceinline__ bf16x8 pack8(f32x4 a, f32x4 b) {
    u32x4 w = {cvtpk(a[0], a[1]), cvtpk(a[2], a[3]), cvtpk(b[0], b[1]), cvtpk(b[2], b[3])};
    return *reinterpret_cast<bf16x8*>(&w);
}
template <class T> __device__ __forceinline__ bf16x8 load8(const T* p) {
    if constexpr (same_t<T, float>::v) { return pack8(*(const f32x4*)p, *(const f32x4*)(p + 4)); }
    else { return *reinterpret_cast<const bf16x8*>(p); }
}
__device__ __forceinline__ void mask_tile(f32x16& p0, f32x16& p1, int dq, unsigned W) {
    const float NEG = -__builtin_inff();
#pragma unroll
    for (int r = 0; r < 16; ++r) {
        const int c = (r & 3) + 8 * (r >> 2);
        if ((unsigned)(dq - c) >= W) p0[r] = NEG;
        if ((unsigned)(dq - c - 32) >= W) p1[r] = NEG;
    }
}
__device__ __forceinline__ void partialSM(f32x16& p0, f32x16& p1, float& m_reg, float& mn, float& alpha) {
    float pmax = p0[0]; for (int r = 1; r < 16; ++r) pmax = fmaxf(pmax, p0[r]); for (int r = 0; r < 16; ++r) pmax = fmaxf(pmax, p1[r]);
    { auto rr = __builtin_amdgcn_permlane32_swap(__float_as_uint(pmax), __float_as_uint(pmax), false, false);
      pmax = fmaxf(__uint_as_float(rr[0]), __uint_as_float(rr[1])); }
    constexpr float C2 = 1.4426950408889634f * SCALE;
    if (__builtin_expect(__all((pmax - m_reg) * SCALE <= THR), 1)) { mn = m_reg; alpha = 1.f; }
    else { mn = fmaxf(m_reg, pmax); alpha = __builtin_amdgcn_exp2f((m_reg - mn) * C2); m_reg = mn; }
    const float mnL = -mn * C2;
    for (int r = 0; r < 16; ++r) p0[r] = fmaf(p0[r], C2, mnL); for (int r = 0; r < 16; ++r) p1[r] = fmaf(p1[r], C2, mnL);
    for (int r = 0; r < 16; ++r) p0[r] = __builtin_amdgcn_exp2f(p0[r]);
}
__device__ __forceinline__ void finishSM(f32x16& p0, f32x16& p1, float alpha, float& l_reg, bf16x8& pa0, bf16x8& pa1, bf16x8& pa2, bf16x8& pa3) {
    for (int r = 0; r < 16; ++r) p1[r] = __builtin_amdgcn_exp2f(p1[r]);
    float ps = 0; for (int r = 0; r < 16; ++r) ps += p0[r]; for (int r = 0; r < 16; ++r) ps += p1[r];
    { auto rr = __builtin_amdgcn_permlane32_swap(__float_as_uint(ps), __float_as_uint(ps), false, false);
      ps = __uint_as_float(rr[0]) + __uint_as_float(rr[1]); }
    l_reg = l_reg * alpha + ps;
#define PK4(P, B_, OUT) do { unsigned a0 = cvtpk(P[B_+0], P[B_+1]), a1 = cvtpk(P[B_+2], P[B_+3]);                          \
        unsigned b0 = cvtpk(P[B_+4], P[B_+5]), b1 = cvtpk(P[B_+6], P[B_+7]);                                             \
        auto r0 = __builtin_amdgcn_permlane32_swap(a0, b0, false, false); auto r1 = __builtin_amdgcn_permlane32_swap(a1, b1, false, false); \
        u32x4 w = {r0[0], r1[0], r0[1], r1[1]}; OUT = *reinterpret_cast<bf16x8*>(&w); } while (0)
    PK4(p0, 0, pa0); PK4(p0, 8, pa1); PK4(p1, 0, pa2); PK4(p1, 8, pa3);
#undef PK4
}
template <int KB, bool SK>
__device__ __forceinline__ void qkt(f32x16& p0, f32x16& p1, const lchar* K_lds, int r32, int hi, const bf16x8* qr, bool act, float slopeR, float lb) {
    if (SK && !act) { const float NEG = -__builtin_inff();
#pragma unroll
        for (int r = 0; r < 16; ++r) { p0[r] = NEG; p1[r] = NEG; } return; }
#pragma unroll
    for (int r = 0; r < 16; ++r) { const int c = (r & 3) + 8 * (r >> 2); p0[r] = __builtin_fmaf(slopeR, (float)c, lb); p1[r] = __builtin_fmaf(slopeR, (float)(c + 32), lb); }
    const lchar* kb[4];
#pragma unroll
    for (int dd = 0; dd < 4; ++dd) kb[dd] = K_lds + KB * SHM_K + KSWZ(r32, (dd * 16 + hi * 8) * 2);
#pragma unroll
    for (int d0 = 0; d0 < 8; ++d0) { const lchar* a = kb[d0 & 3] + (d0 >> 2) * 128;
        bf16x8 b0 = *(const lbf16x8*)(a);
        bf16x8 b1 = *(const lbf16x8*)(a + 32 * 256);
        p0 = __builtin_amdgcn_mfma_f32_32x32x16_bf16(b0, qr[d0], p0, 0, 0, 0);
        p1 = __builtin_amdgcn_mfma_f32_32x32x16_bf16(b1, qr[d0], p1, 0, 0, 0); }
}
template <int VB, bool SK>
__device__ __forceinline__ void pv_tile(f32x16* o, int vb0, bf16x8 pa0, bf16x8 pa1, bf16x8 pa2, bf16x8 pa3, bool act) {
    if (SK && !act) return;
#define TRRD(dst, off) asm volatile("ds_read_b64_tr_b16 %0, %1 offset:%2" : "=&v"(dst) : "v"(vb0), "i"(off) : "memory")
#define PV_D0(d0) do { s16x4 l0, l1, l2, l3, h0, h1, h2, h3; constexpr int b_ = VB * SHM_V + v_rd_off(d0, 0, 0);     \
        TRRD(l0, b_); TRRD(h0, b_ + 2048); TRRD(l1, b_ + 4096); TRRD(h1, b_ + 6144); TRRD(l2, b_ + 8192); TRRD(h2, b_ + 10240); TRRD(l3, b_ + 12288); TRRD(h3, b_ + 14336); \
        asm volatile("s_waitcnt lgkmcnt(0)" ::: "memory"); SBAR();                 \
        o[d0] = __builtin_amdgcn_mfma_f32_32x32x16_bf16(pa0, (bf16x8){l0[0], l0[1], l0[2], l0[3], h0[0], h0[1], h0[2], h0[3]}, o[d0], 0, 0, 0);   \
        o[d0] = __builtin_amdgcn_mfma_f32_32x32x16_bf16(pa1, (bf16x8){l1[0], l1[1], l1[2], l1[3], h1[0], h1[1], h1[2], h1[3]}, o[d0], 0, 0, 0);   \
        o[d0] = __builtin_amdgcn_mfma_f32_32x32x16_bf16(pa2, (bf16x8){l2[0], l2[1], l2[2], l2[3], h2[0], h2[1], h2[2], h2[3]}, o[d0], 0, 0, 0);   \
        o[d0] = __builtin_amdgcn_mfma_f32_32x32x16_bf16(pa3, (bf16x8){l3[0], l3[1], l3[2], l3[3], h3[0], h3[1], h3[2], h3[3]}, o[d0], 0, 0, 0); } while (0)
    PV_D0(0); PV_D0(1); PV_D0(2); PV_D0(3);
#undef PV_D0
#undef TRRD
}

typedef __attribute__((address_space(1))) char gchar; typedef __attribute__((address_space(1))) bf16x8 gbf16x8;
__device__ __forceinline__ const gchar* uni_ptr(const char* p) { const unsigned long long v = (unsigned long long)p;
    const unsigned lo = __builtin_amdgcn_readfirstlane((unsigned)v), hi = __builtin_amdgcn_readfirstlane((unsigned)(v >> 32)); return (const gchar*)(((unsigned long long)hi << 32) | lo); }
template <class TIn, class TOut> struct BlockRef { const TIn* Q; const TIn* K; const TIn* V; TOut* O; int P0; const __attribute__((address_space(3))) unsigned* sel; float slopeR; };
template <class TIn> struct Seam {
    bf16x8 qr[8];
    bf16x8 st_v0, st_v1, st_k0, st_k1; f32x4 sf0, sf1, sf2, sf3;
    f32x4 tq[16];
};
__device__ __forceinline__ int swa_jlo(int P0, int W) { const int lowk = P0 - W + 1; return lowk > 0 ? lowk / KVBLK : 0; }
#define ROW(p, k0, rr) ((const TIn*)((const char*)(p) + (size_t)(k0) * (LDI * sizeof(TIn)) + (unsigned)(((rr) * LDI + sc) * (int)sizeof(TIn))))
#define VMW() asm volatile("s_waitcnt vmcnt(0)" ::: "memory")
#define VMWN(n) asm volatile("s_waitcnt vmcnt(%0)" :: "i"(n) : "memory")
#define SLOAD_H(Kp, Vp, k0) do { const gchar* kb__ = uni_ptr((const char*)(Kp) + (size_t)(k0) * (LDI * sizeof(TIn))); const gchar* vb__ = uni_ptr((const char*)(Vp) + (size_t)(k0) * (LDI * sizeof(TIn))); \
                         S.st_v0 = *(const gbf16x8*)(vb__ + roff0); S.st_v1 = *(const gbf16x8*)(vb__ + roff1);              \
                         S.st_k0 = *(const gbf16x8*)(kb__ + roff0); S.st_k1 = *(const gbf16x8*)(kb__ + roff1); } while (0)
#define SWRITE_HK(bf) do { *(lbf16x8*)(K_lds + (bf) * SHM_K + kws) = S.st_k0; *(lbf16x8*)(K_lds + (bf) * SHM_K + kws + 32 * 256) = S.st_k1; } while (0)
#define SWRITE_HV(bf) do { *(lbf16x8*)(V_lds + (bf) * SHM_V + vst0) = S.st_v0; *(lbf16x8*)(V_lds + (bf) * SHM_V + vst1) = S.st_v1; } while (0)
#define SWRITE_H(bf) do { SWRITE_HV(bf); SWRITE_HK(bf); } while (0)
#define SLOAD_F(p, k0) do { S.sf0 = *(const f32x4*)ROW(p, k0, sr); S.sf1 = *(const f32x4*)(ROW(p, k0, sr) + 4);                \
                            S.sf2 = *(const f32x4*)ROW(p, k0, 32 + sr); S.sf3 = *(const f32x4*)(ROW(p, k0, 32 + sr) + 4); } while (0)
#define SWRITE_KF(bf) do { *(lbf16x8*)(K_lds + (bf) * SHM_K + kws) = pack8(S.sf0, S.sf1); *(lbf16x8*)(K_lds + (bf) * SHM_K + kws + 32 * 256) = pack8(S.sf2, S.sf3); } while (0)
#define SWRITE_VF(bf) do { *(lbf16x8*)(V_lds + (bf) * SHM_V + vst0) = pack8(S.sf0, S.sf1); *(lbf16x8*)(V_lds + (bf) * SHM_V + vst1) = pack8(S.sf2, S.sf3); } while (0)
template <class TIn, class TOut>
__device__ __forceinline__ void causal_swa_prime(const BlockRef<TIn, TOut>& cur, int W, lchar* lds, Seam<TIn>& S, int wave_) {
    constexpr bool F32 = same_t<TIn, float>::v;
    const int tid_ = tid_from_wave(wave_);
    const int tid = tid_, wid = __builtin_amdgcn_readfirstlane(tid >> 6), lane = tid & 63, r32 = lane & 31, hi = lane >> 5;
    const int sr = tid >> 4, sc = (tid & 15) * 8, kws = KSWZ(sr, sc * 2); lchar* K_lds = lds + 2 * SHM_V;
    const unsigned roff0 = (unsigned)((sr * LDI + sc) * (int)sizeof(TIn)), roff1 = (unsigned)(((32 + sr) * LDI + sc) * (int)sizeof(TIn));
    const int kb0 = ((cur.P0 + QB - 1) / KVBLK) * KVBLK;
    for (int d0 = 0; d0 < 8; ++d0) S.qr[d0] = *(const gbf16x8*)(uni_ptr((const char*)cur.Q) + (unsigned)(((wid * QBLK + r32) * LDI + hi * 8) * (int)sizeof(TIn)) + d0 * 16 * sizeof(TIn));
    if constexpr (F32) { SLOAD_F((const float*)cur.K, kb0); VMW(); SWRITE_KF(0); SBAR(); SLOAD_F((const float*)cur.V, kb0); }
    else { SLOAD_H(cur.K, cur.V, kb0); VMW(); SWRITE_HK(0); }
    __syncthreads();
}
template <class TIn, class TOut>
__device__ __forceinline__ void causal_swa_block(const BlockRef<TIn, TOut>& cur, const BlockRef<TIn, TOut>& nxt, int skv, int W, lchar* lds, Seam<TIn>& S, int wave_) {
    constexpr bool F32 = same_t<TIn, float>::v;
    const int tid_ = tid_from_wave(wave_);
    const int tid = tid_, wid = __builtin_amdgcn_readfirstlane(tid >> 6), lane = tid & 63, r32 = lane & 31, hi = lane >> 5;
    const int j_lo = swa_jlo(cur.P0, W);
    int j_hi = (cur.P0 + QB - 1) / KVBLK + 1; if (j_hi > skv / KVBLK) j_hi = skv / KVBLK;
    const int NT = j_hi - j_lo;
    const int kbn = ((nxt.P0 + QB - 1) / KVBLK) * KVBLK;
    const unsigned selm = cur.sel[wid * QBLK + r32] | (1u << (cur.P0 >> 8)); const float slopeR = __builtin_bit_cast(float, __builtin_amdgcn_readfirstlane(__builtin_bit_cast(unsigned, cur.slopeR))); const int tqm = cur.P0 + wid * QBLK + r32 - 4 * hi;
#define LB(t) (((selm >> (KBASE(t) >> 8)) & 1u) ? slopeR * (float)(KBASE(t) - tqm) : -__builtin_inff())
    const int qlo = cur.P0 + wid * QBLK, qm = qlo + r32 - 4 * hi;
    lchar* V_lds = lds; lchar* K_lds = lds + 2 * SHM_V;
    lfloat* ws = (lfloat*)(lds + 2 * SHM_V + 2 * SHM_K) + wid * 64; lfloat* li_l = ws; lfloat* al_l = ws + 32;
    float m_reg = -1e30f, l_reg = 0; f32x16 o[4] = {};
    const unsigned roff0 = (unsigned)(((tid >> 4) * LDI + (tid & 15) * 8) * (int)sizeof(TIn)), roff1 = (unsigned)(((32 + (tid >> 4)) * LDI + (tid & 15) * 8) * (int)sizeof(TIn));
    const int sr = tid >> 4, sc = (tid & 15) * 8, vst0 = v_st(sr, sc), vst1 = v_st(32 + sr, sc), kws = KSWZ(sr, sc * 2);
    const int vb0 = (int)(unsigned)(uintptr_t)V_lds + v_rd_base(lane);
    const TIn* Kh = cur.K; const TIn* Vh = cur.V;
#define RESC(a) do { if (__any((a) < 1.f)) { if (hi == 0) al_l[r32] = (a); asm volatile("s_waitcnt lgkmcnt(0)" ::: "memory");              \
                     for (int d_ = 0; d_ < 4; ++d_) for (int r = 0; r < 16; ++r) o[d_][r] *= al_l[crow(r, hi)]; } } while (0)
#define KBASE(t) ((j_hi - 1 - (t)) * KVBLK)
#define ACT(t) (KBASE(t) <= qlo + QBLK - 1 && KBASE(t) + KVBLK - 1 >= qlo - W + 1)
#define MASKT(P0_, P1_, t) do { const int kb_ = KBASE(t); if ((!SK || ACT(t)) && (kb_ + KVBLK - 1 > qlo || kb_ <= qlo + QBLK - 1 - W)) mask_tile(P0_, P1_, qm - kb_, (unsigned)W); } while (0)
    constexpr int NQL = F32 ? 16 : 8;
    constexpr bool SK = WSKIP && !F32;
#define SEAM_K0() do { VMWN(NQL); if constexpr (F32) { SWRITE_KF(0); SBAR(); SLOAD_F((const float*)nxt.V, kbn); } else { SWRITE_HK(0); } SBAR(); } while (0)
    unsigned touch_reg = 0u; const int tl_ = wid * 32 + (lane & 31);
    const unsigned toff = (unsigned)(((tl_ & 127) >> 1) * LDI * (int)sizeof(TIn) + (tl_ & 1) * 128);
    const gchar* tbase = uni_ptr((const char*)((tl_ >> 7) ? (const void*)Vh : (const void*)Kh));
#if MOBA_CHECK
#define TOUCH(k0) do {} while (0)
#else
#define TOUCH(k0) do { const gchar* tp_ = tbase + (size_t)(k0) * (LDI * sizeof(TIn)) + toff; asm volatile("global_load_dword %0, %1, off" : "+v"(touch_reg) : "v"(tp_) : "memory"); } while (0)
#endif
    f32x16 pA0, pA1, pB0, pB1; float mnA, mnB, alA, alB; bf16x8 pa0, pa1, pa2, pa3;
    if constexpr (F32) { VMW(); SWRITE_VF(0); SBAR(); } else { SWRITE_HV(0); SBAR(); }
    if (NT > 1) { if constexpr (F32) SLOAD_F((const float*)Kh, KBASE(1)); else SLOAD_H(Kh, Vh, KBASE(1)); }
    SBAR(); qkt<0, SK>(pA0, pA1, K_lds, r32, hi, S.qr, ACT(0), slopeR, LB(0));
    if constexpr (F32) { if (NT > 1) { VMW(); SWRITE_KF(1); SBAR(); SLOAD_F((const float*)Vh, KBASE(1)); } }
    MASKT(pA0, pA1, 0); partialSM(pA0, pA1, m_reg, mnA, alA);
    if (NT > 1) { VMW(); if constexpr (F32) { SWRITE_VF(1); SBAR(); if (NT > 2) SLOAD_F((const float*)Kh, KBASE(2)); } else SWRITE_H(1); }
    __syncthreads();
#define HALF_STEP(PX0, PX1, mnX, alX, PY0, PY1, alY, t, KB, VB, SB) do {                                                      \
        SBAR(); qkt<KB, SK>(PX0, PX1, K_lds, r32, hi, S.qr, ACT(t), slopeR, LB(t));                                             \
        finishSM(PY0, PY1, alY, l_reg, pa0, pa1, pa2, pa3); SBAR();                                                           \
        if ((t) + 1 < NT) { if constexpr (F32) { VMW(); SWRITE_KF(SB); SBAR(); SLOAD_F((const float*)Vh, KBASE((t) + 1)); }  \
                            else { SLOAD_H(Kh, Vh, KBASE((t) + 1)); } SBAR(); }                                               \
        pv_tile<VB, SK>(o, vb0, pa0, pa1, pa2, pa3, ACT((t) - 1)); MASKT(PX0, PX1, (t)); partialSM(PX0, PX1, m_reg, mnX, alX);                                        \
        __syncthreads();                                                                                                      \
        if ((t) + 1 < NT) { VMW(); if constexpr (F32) { SWRITE_VF(SB); SBAR(); if ((t) + 2 < NT) SLOAD_F((const float*)Kh, KBASE((t) + 2)); } \
                            else { SWRITE_H(SB); } }                                                                          \
        if ((t) + 3 < NT) { TOUCH(KBASE((t) + 3)); }                                                                          \
        RESC(alX); __syncthreads(); } while (0)
    for (int t = 1; t + 1 < NT; t += 2) {
        HALF_STEP(pB0, pB1, mnB, alB, pA0, pA1, alA, t, 1, 0, 0);
        HALF_STEP(pA0, pA1, mnA, alA, pB0, pB1, alB, t + 1, 0, 1, 1);
    }
    const bool even = (NT & 1) == 0;
    if (even) { SBAR(); qkt<1, SK>(pB0, pB1, K_lds, r32, hi, S.qr, ACT(NT - 1), slopeR, LB(NT - 1)); SBAR(); }
#define QROW(e) (nxt.Q + (size_t)(wid * QBLK + r32) * LDI + ((e) >> 1) * 16 + hi * 8 + ((e) & 1) * 4)
    if constexpr (F32) { SLOAD_F((const float*)nxt.K, kbn); SBAR();
#pragma unroll
        for (int e = 0; e < 8; ++e) S.tq[e] = *(const f32x4*)QROW(e); }
    else { SLOAD_H(nxt.K, nxt.V, kbn); SBAR();
#pragma unroll
        for (int d0 = 0; d0 < 8; ++d0) S.qr[d0] = *(const gbf16x8*)(uni_ptr((const char*)nxt.Q) + (unsigned)(((wid * QBLK + r32) * LDI + hi * 8) * (int)sizeof(TIn)) + d0 * 16 * sizeof(TIn)); }
    SBAR();
    finishSM(pA0, pA1, alA, l_reg, pa0, pa1, pa2, pa3); SBAR();
    if constexpr (F32) {
#pragma unroll
        for (int e = 8; e < 16; ++e) S.tq[e] = *(const f32x4*)QROW(e); SBAR(); }
#undef QROW
    pv_tile<0, SK>(o, vb0, pa0, pa1, pa2, pa3, ACT(even ? NT - 2 : NT - 1));
    if (even) { MASKT(pB0, pB1, NT - 1); partialSM(pB0, pB1, m_reg, mnB, alB); __syncthreads(); RESC(alB);
        finishSM(pB0, pB1, alB, l_reg, pa0, pa1, pa2, pa3); SBAR(); pv_tile<1, SK>(o, vb0, pa0, pa1, pa2, pa3, ACT(NT - 1)); }
    SBAR(); SEAM_K0();
    if (hi == 0) li_l[r32] = l_reg; asm volatile("s_waitcnt lgkmcnt(0)" ::: "memory");
    float rli[16];
#pragma unroll
    for (int r = 0; r < 16; ++r) rli[r] = __builtin_amdgcn_rcpf(li_l[crow(r, hi)]);
    const gchar* Owb = uni_ptr((const char*)(cur.O + (size_t)(wid * QBLK) * LDO)); const unsigned ooff = (unsigned)((4 * hi * LDO + r32) * (int)sizeof(TOut));
#pragma unroll
    for (int r = 0; r < 16; ++r) { const int orc = (r & 3) + 8 * (r >> 2);
#pragma unroll
        for (int d0 = 0; d0 < 4; ++d0) { const float v = o[d0][r] * rli[r];
            if constexpr (same_t<TOut, float>::v) { *(__attribute__((address_space(1))) float*)((gchar*)(Owb) + ooff + (unsigned)((orc * LDO + d0 * 32) * (int)sizeof(TOut))) = v; }
            else { const float vn = __shfl_xor(v, 1);
                   if ((r32 & 1) == 0) *(__attribute__((address_space(1))) unsigned*)((gchar*)(Owb) + ooff + (unsigned)((orc * LDO + d0 * 32) * (int)sizeof(TOut))) = cvtpk(v, vn); } } }
    if constexpr (F32) {
#pragma unroll
        for (int d0 = 0; d0 < 8; ++d0) S.qr[d0] = pack8(S.tq[2 * d0], S.tq[2 * d0 + 1]); }
    __syncthreads();
    asm volatile("" :: "v"(touch_reg));
#undef TOUCH
#undef RESC
#undef LB
#undef KBASE
#undef ACT
#undef MASKT
#undef SEAM_K0
#undef HALF_STEP
}
#undef ROW
#undef VMW
#undef VMWN
#undef SLOAD_H
#undef SWRITE_HK
#undef SWRITE_HV
#undef SWRITE_H
#undef SLOAD_F
#undef SWRITE_KF
#undef SWRITE_VF
#undef KSWZ
#undef SBAR
}

constexpr int NWAVES = 8, NTHR = 512;
constexpr int DM = 2048, NB = 2, SEQ = 4096, MROWS = NB * SEQ, NLAYER = 2;
constexpr int IN_COLS = 6592, IN_PAD = 6656, DFF = 5632, UPC = 2 * DFF;
constexpr int C_RQ = 0, C_RK = 256, C_RV = 512, C_RG = 1024, C_RW = 1536, C_MQ = 3520, C_MK = 4544, C_MV = 5568;
constexpr int RWC = 1984;
constexpr float NORM_EPS = 1e-6f, GN_EPS = 64e-5f;
constexpr size_t MiB = 1u << 20;
constexpr size_t WS_CTL = 0, CTL_ZERO_BYTES = 1 * MiB;
constexpr size_t WS_MOD = 1 * MiB;
constexpr size_t WS_KMEAN = 1 * MiB + 512 * 1024;
constexpr size_t WS_W = 2 * MiB, W_LAYER = 100 * MiB, W_IN = 0, W_OUT = 26 * MiB, W_UP = 34 * MiB, W_DN = 78 * MiB;
constexpr size_t WS_X = 202 * MiB;
constexpr size_t WS_H = 266 * MiB;
constexpr size_t WS_PROJ = 298 * MiB;
constexpr size_t WS_ACT = WS_PROJ;
constexpr size_t WS_MIXED = 402 * MiB;
constexpr size_t WS_U = 434 * MiB;
constexpr size_t WS_HALO = WS_U;
constexpr size_t WS_RW = WS_U;
constexpr size_t WS_Y = WS_U + 128 * MiB;
constexpr size_t WS_RETO = WS_U + 144 * MiB;
constexpr size_t WS_REC = 610 * MiB;
constexpr size_t WS_RWW = 738 * MiB;
constexpr size_t WS_END = 739 * MiB;
constexpr size_t RWA = (size_t)MROWS * 512;
constexpr int CW_BAR = 4096, CW_SUB = 64;
constexpr int RING_BYTES = 131072, LDSCTL_OFF = RING_BYTES, MISC_OFF = LDSCTL_OFF + 320, LDS_BYTES = 147456;

#define GAS __attribute__((address_space(1)))
#define LAS __attribute__((address_space(3)))
typedef unsigned short bf16;
typedef unsigned v4u __attribute__((ext_vector_type(4)));
typedef unsigned v2u __attribute__((ext_vector_type(2)));
typedef float f32x4 __attribute__((ext_vector_type(4)));
typedef float f32x2 __attribute__((ext_vector_type(2)));
#define LDS_WAIT() asm volatile("s_waitcnt lgkmcnt(0)" ::: "memory")
__device__ __forceinline__ unsigned f2bf(float f) { unsigned u = __builtin_bit_cast(unsigned, f); return (u + 0x7fffu + ((u >> 16) & 1u)) >> 16; }
__device__ __forceinline__ unsigned pk2(float lo, float hi) { return f2bf(lo) | (f2bf(hi) << 16); }
__device__ __forceinline__ float bf2f(unsigned short h) { return __builtin_bit_cast(float, (unsigned)h << 16); }
__device__ __forceinline__ float bflo(unsigned w) { return __builtin_bit_cast(float, w << 16); }
__device__ __forceinline__ float bfhi(unsigned w) { return __builtin_bit_cast(float, w & 0xffff0000u); }
template <int CTRL> __device__ __forceinline__ float dpp_add(float v);
__device__ __forceinline__ float wave_sum(float v);
__device__ __forceinline__ float wave_max(float v) {
#pragma unroll
    for (int o = 1; o < 64; o <<= 1) v = fmaxf(v, __shfl_xor(v, o));
    return v;
}
template <int CTRL> __device__ __forceinline__ float dpp_add(float v) { return v + __builtin_bit_cast(float, __builtin_amdgcn_update_dpp(0, __builtin_bit_cast(int, v), CTRL, 0xF, 0xF, true)); }
__device__ __forceinline__ float wave_sum(float v) {
    v = dpp_add<0xB1>(v); v = dpp_add<0x4E>(v); v = dpp_add<0x141>(v); v = dpp_add<0x140>(v);
    v += __shfl_xor(v, 16); v += __shfl_xor(v, 32);
    return v;
}
__device__ __forceinline__ float sigmoidf_(float x) { return 1.0f / (1.0f + __expf(-x)); }

#define XB_TMO      128
#define XB_XCNT(j)  (256  + 64 * (j))
#define XB_XSUB(j)  (1280 + 64 * (j))
#define XB_XGEN(j)  (2304 + 64 * (j))
#define XB_TOP      3328
#define XB_TOPGEN   3392
#define XCD_BAR_WORDS 3456
#define XB_SPIN_CAP (1u << 22)
__device__ __forceinline__ unsigned xb_ld(unsigned* p)              { return __hip_atomic_load(p, __ATOMIC_RELAXED, __HIP_MEMORY_SCOPE_AGENT); }
__device__ __forceinline__ unsigned xb_add(unsigned* p, unsigned v) { return __hip_atomic_fetch_add(p, v, __ATOMIC_RELAXED, __HIP_MEMORY_SCOPE_AGENT); }
__device__ __forceinline__ unsigned xb_xcc_id() { return (unsigned)__builtin_amdgcn_s_getreg((3 << 11) | 20) & 0xFu; }
#define XB_SPIN(cond, bar) do { unsigned _sp = 0; while (cond) { __builtin_amdgcn_s_sleep(1); \
    if ((++_sp & 255u) == 0u) { if (xb_ld(&(bar)[XB_TMO])) break; if (_sp > XB_SPIN_CAP) { atomicAdd(&(bar)[XB_TMO], 1u); break; } } } } while (0)
struct XcdBarrier { unsigned* bar; unsigned x; volatile LAS unsigned* st; };
__device__ __forceinline__ XcdBarrier xcd_barrier_post(unsigned* bar, volatile LAS unsigned* st, int tid) {
    XcdBarrier b; b.bar = bar; b.x = xb_xcc_id(); b.st = st;
    if (tid == 0) (void)xb_add(&bar[XB_XCNT(b.x)], 1u);
    return b;
}
__device__ __forceinline__ void xcd_barrier_complete(unsigned* bar, unsigned x, unsigned& nloc, unsigned& nx) {
    const unsigned G = gridDim.x * gridDim.y * gridDim.z;
    unsigned sum, cnt, mine, sp = 0u;
    for (;;) {
        sum = 0u; cnt = 0u; mine = 0u;
#pragma unroll
        for (unsigned j = 0; j < 16; ++j) { const unsigned c = xb_ld(&bar[XB_XCNT(j)]); sum += c; cnt += (c > 0u) ? 1u : 0u; mine = (j == x) ? c : mine; }
        if (sum == G) break;
        __builtin_amdgcn_s_sleep(1);
        if ((++sp & 255u) == 0u) { if (xb_ld(&bar[XB_TMO])) break; if (sp > XB_SPIN_CAP) { atomicAdd(&bar[XB_TMO], 1u); break; } }
    }
    nloc = mine > 0u ? mine : 1u; nx = cnt > 0u ? cnt : 1u;
}
__device__ __forceinline__ void xcd_barrier(const XcdBarrier& b, int tid) {
    asm volatile("s_waitcnt vmcnt(0)" ::: "memory");
    __syncthreads();
    if (tid == 0) {
        unsigned z_ = 0u; asm volatile("" : "+v"(z_)); z_ = (unsigned)__builtin_amdgcn_readfirstlane(z_);
        unsigned* bar = b.bar + z_; const unsigned bx_ = b.x + z_;
        __builtin_amdgcn_s_waitcnt(0);
        unsigned nloc = b.st[0], nx = b.st[1];
        if (nloc == 0u) { xcd_barrier_complete(bar, bx_, nloc, nx); b.st[0] = nloc; b.st[1] = nx; }
        const unsigned old = xb_add(&bar[XB_XSUB(bx_)], 1u);
        const unsigned gen = old / nloc;
        if (old + 1u == (gen + 1u) * nloc) {
            __builtin_amdgcn_fence(__ATOMIC_RELEASE, "agent");
            asm volatile("s_waitcnt vmcnt(0)" ::: "memory");
            const unsigned og = xb_add(&bar[XB_TOP], 1u);
            const unsigned tg = og / nx;
            if (og + 1u == (tg + 1u) * nx) xb_add(&bar[XB_TOPGEN], 1u);
            else XB_SPIN(xb_ld(&bar[XB_TOPGEN]) == tg, bar);
            __builtin_amdgcn_fence(__ATOMIC_ACQUIRE, "agent");
            xb_add(&bar[XB_XGEN(bx_)], 1u);
            asm volatile("s_waitcnt vmcnt(0)" ::: "memory");
        } else {
            XB_SPIN(xb_ld(&bar[XB_XGEN(bx_)]) == gen, bar);
            __builtin_amdgcn_fence(__ATOMIC_ACQUIRE, "agent");
            asm volatile("s_waitcnt vmcnt(0)" ::: "memory");
        }
    }
    __syncthreads();
}

struct Args { const float* in[24]; float* out; unsigned char* ws; };
struct Frame {
    LAS unsigned char* lds;
    int tid, lane, wave, vcu, G, zz;
    const float* const* in;
    unsigned char* ws;
};

#define FWS (F.ws + F.zz)
__device__ __forceinline__ void p0_transpose_item(const float* W, int K, int N, bf16* WT, LAS float* scr, int item, int lane, int half = 0) {
    const int nblk = N / 32, kb = item / nblk, nb = item % nblk, k0 = 64 * kb, n0 = 32 * nb;
    const int r0 = !half ? n0 : (n0 < half ? (n0 >> 7) * 256 + (n0 & 127) : ((n0 - half) >> 7) * 256 + 128 + ((n0 - half) & 127));
#pragma unroll 8
    for (int i = 0; i < 32; ++i) { const int kk = 2 * i + (lane >> 5); scr[kk * 33 + (lane & 31)] = W[(size_t)(k0 + kk) * N + n0 + (lane & 31)]; }
    LDS_WAIT(); asm volatile("" ::: "memory");
    const int c = lane & 7;
#pragma unroll
    for (int j = 0; j < 4; ++j) { const int n = (lane >> 3) + 8 * j; const LAS float* s = scr + (8 * c) * 33 + n;
        v4u o; o.x = pk2(s[0 * 33], s[1 * 33]); o.y = pk2(s[2 * 33], s[3 * 33]); o.z = pk2(s[4 * 33], s[5 * 33]); o.w = pk2(s[6 * 33], s[7 * 33]);
        *(v4u*)(WT + (size_t)(r0 + n) * K + k0 + 8 * c) = o; }
    LDS_WAIT(); asm volatile("" ::: "memory");
}
constexpr int CV_IN = (DM / 64) * (IN_COLS / 32), CV_OUT = (DM / 64) * (DM / 32), CV_UP = (DM / 64) * (UPC / 32), CV_DN = (DFF / 64) * (DM / 32), CV_LAYER = CV_IN + CV_OUT + CV_UP + CV_DN;
constexpr int CV_N1 = 10, CV_N2 = 6, CV_N3 = 4, CV_C1 = 192 * NWAVES * CV_N1, CV_C2 = 128 * NWAVES * CV_N2;
static_assert(CV_IN + CV_C1 <= CV_LAYER && CV_LAYER - (CV_IN + CV_C1) + (CV_IN - CV_C2) <= 128 * NWAVES * CV_N3 && CV_C2 <= CV_IN, "gap capacities");
__device__ __forceinline__ void convert_item(Frame& F, int it, LAS float* scr) {
    const int l = it / CV_LAYER; int r = it % CV_LAYER;
    unsigned char* wl = FWS + WS_W + (size_t)l * W_LAYER;
    if (r < CV_IN) { p0_transpose_item(F.in[F.zz + 2] + (size_t)l * DM * IN_COLS, DM, IN_COLS, (bf16*)(wl + W_IN), scr, r, F.lane); return; } r -= CV_IN;
    if (r < CV_OUT) { p0_transpose_item(F.in[F.zz + 3] + (size_t)l * DM * DM, DM, DM, (bf16*)(wl + W_OUT), scr, r, F.lane); return; } r -= CV_OUT;
    if (r < CV_UP) { p0_transpose_item(F.in[F.zz + 15] + (size_t)l * DM * UPC, DM, UPC, (bf16*)(wl + W_UP), scr, r, F.lane, DFF); return; } r -= CV_UP;
    p0_transpose_item(F.in[F.zz + 18] + (size_t)l * DFF * DM, DFF, DM, (bf16*)(wl + W_DN), scr, r, F.lane);
}
__device__ __forceinline__ void convert_gap(Frame& F, int layer, int first, int count, int gwi, int nwv, int nper) {
    LAS float* scr = (LAS float*)(F.lds + F.wave * 16384);
    for (int j = 0; j < nper; ++j) { const int r = gwi + nwv * j; if (r < count) convert_item(F, layer * CV_LAYER + first + r, scr); }
}
__device__ __forceinline__ void adaln_item(Frame& F, int l, int grp) {
    LAS float* cact = (LAS float*)F.lds;
    LAS float* red = (LAS float*)(F.lds + 16384);
    const float* c = F.in[F.zz + 1];
    for (int i = F.tid; i < 4096; i += NTHR) { const float cv = c[i]; cact[i] = cv / (1.0f + __expf(-cv)); }
    __syncthreads();
    const int n0 = grp * 128;
    const float* W = F.in[F.zz + 19] + (size_t)l * 2048 * 12288 + n0;
    const int half = F.lane >> 5, q = F.lane & 31;
    f32x4 a0 = {0.f, 0.f, 0.f, 0.f}, a1 = {0.f, 0.f, 0.f, 0.f};
#pragma unroll 16
    for (int i = 0; i < 128; ++i) { const int k = F.wave * 256 + 2 * i + half; const f32x4 w = *(const f32x4*)(W + (size_t)k * 12288 + 4 * q);
        a0 += w * cact[k]; a1 += w * cact[2048 + k]; }
#pragma unroll
    for (int e = 0; e < 4; ++e) { a0[e] += __shfl_xor(a0[e], 32); a1[e] += __shfl_xor(a1[e], 32); }
    if (half == 0) {
#pragma unroll
        for (int e = 0; e < 4; ++e) { red[(F.wave * 2 + 0) * 128 + 4 * q + e] = a0[e]; red[(F.wave * 2 + 1) * 128 + 4 * q + e] = a1[e]; } }
    __syncthreads();
    if (F.tid < 256) { const int bb = F.tid >> 7, col = F.tid & 127; float s = 0.f;
#pragma unroll
        for (int w = 0; w < 8; ++w) s += red[(w * 2 + bb) * 128 + col];
        s += F.in[F.zz + 20][l * 12288 + n0 + col];
        ((float*)(FWS + WS_MOD))[(size_t)(l * 2 + bb) * 12288 + n0 + col] = s; }
    __syncthreads();
}
__device__ __forceinline__ void p0_prologue(Frame& F) {
    const int ngv = (F.G == 256) ? 96 : 192;
    if (F.vcu < ngv) adaln_item(F, F.vcu / 96, F.vcu % 96);
    LAS float* scr = (LAS float*)(F.lds + F.wave * 16384);
    const int gw = F.vcu * NWAVES + F.wave, NGW = F.G * NWAVES;
    if (F.G == 256) { if (F.vcu >= 96) for (int p = gw - 96 * NWAVES; p < CV_IN; p += 160 * NWAVES) convert_item(F, p, scr); }
    else for (int p = gw; p < NLAYER * CV_LAYER; p += NGW) convert_item(F, p, scr);
    for (int l = 0; l < NLAYER; ++l) { bf16* wt = (bf16*)(FWS + WS_RWW + (size_t)l * 448 * 512 * 2);
        const float* wu = F.in[F.zz + 6] + (size_t)l * 96 * 512; const float* au = F.in[F.zz + 8] + (size_t)l * 96 * 512; const float* gu = F.in[F.zz + 9] + (size_t)l * 256 * 512;
        for (int i = F.vcu * NTHR + F.tid; i < 448 * 512; i += F.G * NTHR) {
            if (i < 96 * 512) { const int n = i / 96, kq = i - n * 96; wt[i] = (bf16)f2bf(wu[kq * 512 + n]); }
            else if (i < 2 * 96 * 512) { const int j = i - 96 * 512, n = j / 96, kq = j - n * 96; wt[i] = (bf16)f2bf(au[kq * 512 + n]); }
            else { const int j = i - 2 * 96 * 512, n = j >> 8, kq = j & 255; wt[i] = (bf16)f2bf(gu[kq * 512 + n]); } } }
    for (int l = 0; l < NLAYER; ++l) { v4u* z = (v4u*)(FWS + WS_W + (size_t)l * W_LAYER + W_IN + (size_t)IN_COLS * DM * 2);
        for (int i = F.vcu * NTHR + F.tid; i < (IN_PAD - IN_COLS) * DM * 2 / 16; i += F.G * NTHR) z[i] = (v4u){0u, 0u, 0u, 0u}; }
}

template <int MODE, bool IN_F32>
__device__ __forceinline__ void norm_phase(Frame& F, const void* xin, void* outp, const float* g, const float* sh, const float* sc) {
    LAS float* gs = (LAS float*)F.lds;
    LAS float* shs = (LAS float*)(F.lds + 16384);
    for (int i = F.tid; i < 4096; i += NTHR) { const int b = i >> 11, col = i & 2047;
        if (MODE == 0) { gs[i] = g[col] * (1.0f + sc[(size_t)b * 12288 + col]); shs[i] = sh[(size_t)b * 12288 + col]; }
        else { gs[i] = g[col]; shs[i] = 0.f; } }
    __syncthreads();
    const int gw = F.vcu * NWAVES + F.wave, NGW = F.G * NWAVES;
    for (int m = gw; m < MROWS; m += NGW) {
        const int b = m >> 12;
        f32x4 v[8]; float s = 0.f;
#pragma unroll
        for (int j = 0; j < 8; ++j) {
            if (IN_F32) v[j] = *((const f32x4*)((const float*)xin + (size_t)m * DM) + F.lane + 64 * j);
            else { const v2u w = *((const v2u*)((const bf16*)xin + (size_t)m * DM) + F.lane + 64 * j); v[j] = (f32x4){bflo(w.x), bfhi(w.x), bflo(w.y), bfhi(w.y)}; }
            s += (v[j].x * v[j].x + v[j].y * v[j].y) + (v[j].z * v[j].z + v[j].w * v[j].w); }
        float rstd = 1.0f / sqrtf(wave_sum(s) * (1.0f / DM) + NORM_EPS);
#if MOBA_CHECK
        if (MODE == 1) { const float sd = ((const float*)(FWS + WS_CTL))[8], sn = ((const float*)(FWS + WS_CTL))[9]; rstd *= 1.0f + 10.0f * sqrtf(sd / sn); }
#endif
#pragma unroll
        for (int j = 0; j < 8; ++j) { const int col = 4 * (F.lane + 64 * j);
            const f32x4 gg = *(const LAS f32x4*)(gs + b * 2048 + col), ss = *(const LAS f32x4*)(shs + b * 2048 + col);
            const f32x4 o = v[j] * rstd * gg + ss;
            if (MODE == 0) { v2u w; w.x = pk2(o.x, o.y); w.y = pk2(o.z, o.w); *(v2u*)((bf16*)outp + (size_t)m * DM + col) = w; }
            else *(f32x4*)((float*)outp + (size_t)m * DM + col) = o; }
    }
    __syncthreads();
}

__device__ __forceinline__ float lerp_bf(const bf16* P, size_t row, int col, bool hasprev, float mu) {
    const float cur = bf2f(P[row * IN_PAD + col]); const float prev = hasprev ? bf2f(P[(row - 1) * IN_PAD + col]) : 0.f;
    return cur + (prev - cur) * mu;
}
__device__ __forceinline__ void rwkv_prep(Frame& F, int l) {
    LAS float* codes = (LAS float*)F.lds;
    const bf16* P = (const bf16*)(FWS + WS_PROJ);
    const float* mu = F.in[F.zz + 4] + l * RWC; const float* w0 = F.in[F.zz + 5] + l * 512; const float* w_up = F.in[F.zz + 6] + (size_t)l * 96 * 512;
    const float* a0 = F.in[F.zz + 7] + l * 512; const float* a_up = F.in[F.zz + 8] + (size_t)l * 96 * 512; const float* g_up = F.in[F.zz + 9] + (size_t)l * 256 * 512;
    const float* k_k = F.in[F.zz + 10] + l * 512; const float* k_a = F.in[F.zz + 11] + l * 512; const float* r_k = F.in[F.zz + 12] + l * 512;
    float* RW = (float*)(FWS + WS_RW);
    const int c = F.tid;
    const float mur = mu[c], muk = mu[512 + c], muv = mu[1024 + c], w0c = w0[c], a0c = a0[c], kkc = k_k[c], kac = k_a[c], rkc = r_k[c];
    for (int item = F.vcu; item < MROWS / 8; item += F.G) {
        const int row0 = item * 8, t0 = row0 & (SEQ - 1);
        for (int idx = F.tid; idx < 8 * 448; idx += NTHR) { const int tk = idx / 448, cc = idx - tk * 448;
            float val = lerp_bf(P, (size_t)(row0 + tk), C_RW + 1536 + cc, (t0 + tk) > 0, mu[1536 + cc]);
            if (cc < 96) val = tanhf(val); else if (cc >= 192) val = sigmoidf_(val);
            codes[idx] = val; }
        __syncthreads();
        float wd[8], wa[8], gg[8];
#pragma unroll
        for (int tk = 0; tk < 8; ++tk) { wd[tk] = 0.f; wa[tk] = 0.f; gg[tk] = 0.f; }
        for (int r = 0; r < 96; ++r) { const float wu = w_up[r * 512 + c], au = a_up[r * 512 + c];
#pragma unroll
            for (int tk = 0; tk < 8; ++tk) { wd[tk] += codes[tk * 448 + r] * wu; wa[tk] += codes[tk * 448 + 96 + r] * au; } }
        for (int r = 0; r < 256; ++r) { const float gu = g_up[r * 512 + c];
#pragma unroll
            for (int tk = 0; tk < 8; ++tk) gg[tk] += codes[tk * 448 + 192 + r] * gu; }
#pragma unroll
        for (int tk = 0; tk < 8; ++tk) {
            const size_t row = (size_t)(row0 + tk); const bool hp = (t0 + tk) > 0;
            const float rr = lerp_bf(P, row, C_RW + c, hp, mur), kk0 = lerp_bf(P, row, C_RW + 512 + c, hp, muk), vv = lerp_bf(P, row, C_RW + 1024 + c, hp, muv);
            const float z = -(w0c + wd[tk]);
            const float sp = fmaxf(z, 0.f) + log1pf(__expf(-fabsf(z)));
            const float decay = __expf(-__expf(-sp - 0.5f));
            const float a = sigmoidf_(a0c + wa[tk]);
            const float kkv = kk0 * kkc;
            const float nrm = sqrtf(wave_sum(kkv * kkv));
            const float kap = kkv / fmaxf(nrm, 1e-12f);
            const float kp = kk0 * (1.0f + (a - 1.0f) * kac);
            const float bsum = wave_sum(rr * kp * rkc);
            const size_t o = row * 512 + c;
            RW[0 * RWA + o] = rr; RW[1 * RWA + o] = decay; RW[2 * RWA + o] = kp; RW[3 * RWA + o] = vv;
            RW[4 * RWA + o] = kap; RW[5 * RWA + o] = kap * a; RW[6 * RWA + o] = gg[tk]; RW[7 * RWA + o] = bsum * vv;
        }
        __syncthreads();
    }
}
__device__ __forceinline__ void moba_kmean(Frame& F) {
    LAS float* red = (LAS float*)(F.lds + 32768);
    const bf16* P = (const bf16*)(FWS + WS_PROJ);
    float* KM = (float*)(FWS + WS_KMEAN);
    for (int item = F.vcu; item < 256; item += F.G) {
        const int b = item >> 7, h = (item >> 4) & 7, n = item & 15;
        const int d = F.tid & 127, part = F.tid >> 7;
        const bf16* kp = P + (size_t)(b * SEQ + n * 256 + part * 64) * IN_PAD + C_MK + h * 128 + d;
        float s = 0.f;
        for (int k = 0; k < 64; ++k) s += bf2f(kp[(size_t)k * IN_PAD]);
        red[part * 128 + d] = s;
        __syncthreads();
        if (F.tid < 128) KM[(size_t)item * 128 + d] = (red[d] + red[128 + d] + red[256 + d] + red[384 + d]) * (1.0f / 256.0f);
        __syncthreads();
    }
}
struct RwIn { f32x4 w[2], kk[2], bb[2], k[2], r[2]; float v; };
__device__ __forceinline__ void rw_load(RwIn& x, const float* RW, size_t row, int cj, int ci) {
    const size_t o = row * 512;
    x.w[0] = *(const f32x4*)(RW + 1 * RWA + o + cj); x.w[1] = *(const f32x4*)(RW + 1 * RWA + o + cj + 4);
    x.kk[0] = *(const f32x4*)(RW + 4 * RWA + o + cj); x.kk[1] = *(const f32x4*)(RW + 4 * RWA + o + cj + 4);
    x.bb[0] = *(const f32x4*)(RW + 5 * RWA + o + cj); x.bb[1] = *(const f32x4*)(RW + 5 * RWA + o + cj + 4);
    x.k[0] = *(const f32x4*)(RW + 2 * RWA + o + cj); x.k[1] = *(const f32x4*)(RW + 2 * RWA + o + cj + 4);
    x.r[0] = *(const f32x4*)(RW + 0 * RWA + o + cj); x.r[1] = *(const f32x4*)(RW + 0 * RWA + o + cj + 4);
    x.v = RW[3 * RWA + o + ci];
}
__device__ __forceinline__ void rwkv_scan_naive(Frame& F, int b, int h) {
    const float* RW = (const float*)(FWS + WS_RW);
    float* Y = (float*)(FWS + WS_Y);
    const int i = F.tid >> 3, jp = F.tid & 7, cj = h * 64 + 8 * jp, ci = h * 64 + i;
    f32x4 s0 = {0.f, 0.f, 0.f, 0.f}, s1 = {0.f, 0.f, 0.f, 0.f};
    RwIn cur, n1, n2;
    const size_t rb = (size_t)b * SEQ;
    rw_load(cur, RW, rb, cj, ci); rw_load(n1, RW, rb + 1, cj, ci);
    for (int t = 0; t < SEQ; ++t) {
        rw_load(n2, RW, rb + (t + 2 < SEQ ? t + 2 : SEQ - 1), cj, ci);
        f32x4 pp = s0 * cur.kk[0] + s1 * cur.kk[1];
        float p = (pp.x + pp.y) + (pp.z + pp.w);
        p += __shfl_xor(p, 1); p += __shfl_xor(p, 2); p += __shfl_xor(p, 4);
        const float sa = -p;
        s0 = s0 * cur.w[0] + sa * cur.bb[0] + cur.v * cur.k[0];
        s1 = s1 * cur.w[1] + sa * cur.bb[1] + cur.v * cur.k[1];
        f32x4 yy = s0 * cur.r[0] + s1 * cur.r[1];
        float y = (yy.x + yy.y) + (yy.z + yy.w);
        y += __shfl_xor(y, 1); y += __shfl_xor(y, 2); y += __shfl_xor(y, 4);
        if (jp == 0) Y[(rb + t) * 512 + ci] = y;
        cur = n1; n1 = n2;
    }
}
struct RtIn { v4u q[2], k[2]; unsigned short v; };
__device__ __forceinline__ void rt_load(RtIn& x, const bf16* P, size_t row, int h, int d0, int v) {
    const bf16* p = P + row * IN_PAD;
    x.q[0] = *(const v4u*)(p + C_RQ + h * 64 + d0); x.q[1] = *(const v4u*)(p + C_RQ + h * 64 + d0 + 8);
    x.k[0] = *(const v4u*)(p + C_RK + h * 64 + d0); x.k[1] = *(const v4u*)(p + C_RK + h * 64 + d0 + 8);
    x.v = p[C_RV + h * 128 + v];
}
__device__ __forceinline__ void ret_scan_naive(Frame& F, int b, int h) {
    const bf16* P = (const bf16*)(FWS + WS_PROJ);
    float* RO = (float*)(FWS + WS_RETO);
    const int v = F.tid >> 2, dp = F.tid & 3, d0 = dp * 16;
    const float gamma = 1.0f - exp2f(-5.0f - (float)h);
    float S[16];
#pragma unroll
    for (int d = 0; d < 16; ++d) S[d] = 0.f;
    RtIn cur, n1, n2;
    const size_t rb = (size_t)b * SEQ;
    rt_load(cur, P, rb, h, d0, v); rt_load(n1, P, rb + 1, h, d0, v);
    for (int t = 0; t < SEQ; ++t) {
        rt_load(n2, P, rb + (t + 2 < SEQ ? t + 2 : SEQ - 1), h, d0, v);
        const float vv = bf2f(cur.v) * 0.125f;
        float o = 0.f;
#pragma unroll
        for (int e = 0; e < 8; ++e) { const unsigned qw = cur.q[e >> 2][e & 3], kw = cur.k[e >> 2][e & 3];
            S[2 * e] = gamma * S[2 * e] + bflo(kw) * vv; S[2 * e + 1] = gamma * S[2 * e + 1] + bfhi(kw) * vv;
            o += bflo(qw) * S[2 * e] + bfhi(qw) * S[2 * e + 1]; }
        o += __shfl_xor(o, 1); o += __shfl_xor(o, 2);
        if (dp == 0) RO[(rb + t) * 512 + h * 128 + v] = o;
        cur = n1; n1 = n2;
    }
}
__device__ __forceinline__ void moba_naive(Frame& F, int mw, int nmw) {
    const bf16* P = (const bf16*)(FWS + WS_PROJ);
    const float* KM = (const float*)(FWS + WS_KMEAN);
    bf16* MX = (bf16*)(FWS + WS_U + 160 * MiB);
    LAS float* qs = (LAS float*)(F.lds + F.wave * 4608);
    LAS float* ps = qs + 128;
    const int lane = F.lane;
    for (int qi = mw; qi < MROWS * 8; qi += nmw) {
        const int h = qi & 7, row = qi >> 3, b = row >> 12, t = row & (SEQ - 1), bq = t >> 8;
        { const unsigned qw = *(const unsigned*)(P + (size_t)row * IN_PAD + C_MQ + h * 128 + 2 * lane);
          qs[2 * lane] = bflo(qw) * 0.08838834764831845f; qs[2 * lane + 1] = bfhi(qw) * 0.08838834764831845f; }
        LDS_WAIT();
        float gate = -INFINITY;
        if (lane < 16 && lane < bq) { const float* km = KM + ((size_t)(b * 8 + h) * 16 + lane) * 128; float a = 0.f;
            for (int d = 0; d < 128; ++d) a += qs[d] * km[d];
            gate = a; }
        unsigned selmask = 0u;
#pragma unroll
        for (int rnd = 0; rnd < 3; ++rnd) { const float m = wave_max(gate);
            if (m > -INFINITY) { const unsigned long long bal = __ballot(gate == m); const int idx = __ffsll((long long)bal) - 1; selmask |= 1u << idx; if (lane == idx) gate = -INFINITY; } }
        int blk[4];
#pragma unroll
        for (int s = 0; s < 3; ++s) { if (selmask) { blk[s] = __ffs((int)selmask) - 1; selmask &= selmask - 1u; } else blk[s] = -1; }
        blk[3] = bq;
        const float slope = exp2f(-(float)(h + 1));
        float sc[4][4]; float mx = -1e30f;
#pragma unroll
        for (int s = 0; s < 4; ++s) {
#pragma unroll
            for (int kq = 0; kq < 4; ++kq) {
                float val = -1e30f;
                if (blk[s] >= 0) { const int pos = blk[s] * 256 + kq * 64 + lane;
                    const bf16* kp = P + (size_t)(b * SEQ + pos) * IN_PAD + C_MK + h * 128; float a = 0.f;
#pragma unroll 4
                    for (int d8 = 0; d8 < 16; ++d8) { const v4u kw = *(const v4u*)(kp + d8 * 8); const f32x4 qa = *(const LAS f32x4*)(qs + d8 * 8), qb = *(const LAS f32x4*)(qs + d8 * 8 + 4);
                        a += bflo(kw.x) * qa.x + bfhi(kw.x) * qa.y + bflo(kw.y) * qa.z + bfhi(kw.y) * qa.w + bflo(kw.z) * qb.x + bfhi(kw.z) * qb.y + bflo(kw.w) * qb.z + bfhi(kw.w) * qb.w; }
                    if (pos <= t) val = a - slope * (float)(t - pos); }
                sc[s][kq] = val; mx = fmaxf(mx, val); } }
        mx = wave_max(mx);
        float lsum = 0.f;
#pragma unroll
        for (int s = 0; s < 4; ++s)
#pragma unroll
            for (int kq = 0; kq < 4; ++kq) { const float p = __expf(sc[s][kq] - mx); lsum += p; ps[s * 256 + kq * 64 + lane] = p; }
        lsum = wave_sum(lsum);
        LDS_WAIT();
        float o0 = 0.f, o1 = 0.f;
#pragma unroll
        for (int s = 0; s < 4; ++s) if (blk[s] >= 0) { const int nk = (s == 3) ? (t - bq * 256 + 1) : 256;
            const bf16* vp = P + (size_t)(b * SEQ + blk[s] * 256) * IN_PAD + C_MV + h * 128 + 2 * lane;
#pragma unroll 4
            for (int key = 0; key < nk; ++key) { const float p = ps[s * 256 + key]; const unsigned vw = *(const unsigned*)(vp + (size_t)key * IN_PAD); o0 += p * bflo(vw); o1 += p * bfhi(vw); } }
        const float inv = 1.0f / lsum;
        *(unsigned*)(MX + (size_t)row * 1024 + h * 128 + 2 * lane) = pk2(o0 * inv, o1 * inv);
        LDS_WAIT();
    }
}

constexpr int MOBA_LDS_KM = moba::LDS_BYTES, MOBA_LDS_SEL = MOBA_LDS_KM + 8192;
__device__ __forceinline__ void moba_item(Frame& F, int bh, int qbA, int qbB) {
    const int b = bh >> 3, h = bh & 7;
    const bf16* P = (const bf16*)(FWS + WS_PROJ);
    LAS float* km = (LAS float*)(F.lds + MOBA_LDS_KM);
    LAS unsigned* sel = (LAS unsigned*)(F.lds + MOBA_LDS_SEL);
    const float* KM = (const float*)(FWS + WS_KMEAN) + (size_t)bh * 16 * 128;
    for (int i = F.tid; i < 2048; i += NTHR) km[i] = KM[i];
    __syncthreads();
    {   const int qb = (F.tid < 256) ? qbA : qbB, r = F.tid & 255;
        const bf16* qp = P + (size_t)(b * SEQ + qb * 256 + r) * IN_PAD + C_MQ + h * 128;
        float g[16];
#pragma unroll
        for (int n = 0; n < 16; ++n) g[n] = 0.f;
        for (int d8 = 0; d8 < 16; ++d8) { const v4u qw = *(const v4u*)(qp + d8 * 8);
            const float q0 = bflo(qw.x), q1 = bfhi(qw.x), q2 = bflo(qw.y), q3 = bfhi(qw.y), q4 = bflo(qw.z), q5 = bfhi(qw.z), q6 = bflo(qw.w), q7 = bfhi(qw.w);
#pragma unroll
            for (int n = 0; n < 16; ++n) { const f32x4 ka = *(const LAS f32x4*)(km + n * 128 + d8 * 8), kb = *(const LAS f32x4*)(km + n * 128 + d8 * 8 + 4);
                g[n] += (q0 * ka.x + q1 * ka.y) + (q2 * ka.z + q3 * ka.w) + (q4 * kb.x + q5 * kb.y) + (q6 * kb.z + q7 * kb.w); } }
        unsigned m = 0u;
#pragma unroll
        for (int rnd = 0; rnd < 3; ++rnd) { float best = -INFINITY; int bi = -1;
#pragma unroll
            for (int n = 0; n < 16; ++n) if (n < qb && !((m >> n) & 1u) && g[n] > best) { best = g[n]; bi = n; }
            if (bi >= 0) m |= 1u << bi; }
        sel[F.tid] = m; }
    __syncthreads();
    typedef moba::BlockRef<moba::bf16, moba::bf16> Ref;
    const float slopeR = exp2f(-(float)(h + 1)) * 11.313708498984761f;
    bf16* MX = (bf16*)(FWS + WS_MIXED);
    Ref A, B2;
    A.Q = P + (size_t)(b * SEQ + qbA * 256) * IN_PAD + C_MQ + h * 128; A.K = P + (size_t)(b * SEQ) * IN_PAD + C_MK + h * 128; A.V = P + (size_t)(b * SEQ) * IN_PAD + C_MV + h * 128;
    A.O = MX + (size_t)(b * SEQ + qbA * 256) * DM + 1024 + h * 128; A.P0 = qbA * 256; A.sel = sel; A.slopeR = slopeR;
    B2 = A; B2.Q = P + (size_t)(b * SEQ + qbB * 256) * IN_PAD + C_MQ + h * 128; B2.O = MX + (size_t)(b * SEQ + qbB * 256) * DM + 1024 + h * 128; B2.P0 = qbB * 256; B2.sel = sel + 256;
    moba::Seam<moba::bf16> S;
    moba::lchar* ldsg = (moba::lchar*)F.lds;
    moba::causal_swa_prime<moba::bf16, moba::bf16>(A, 1 << 30, ldsg, S, F.wave);
    Ref cur = A;
    for (int pass = 0; pass < MOBA_NP; ++pass) {
        const bool nb_ = ((pass + 1) & 1) != 0;
        Ref nxt = A; if (nb_ || pass + 1 >= MOBA_NP) nxt = B2;
        moba::causal_swa_block<moba::bf16, moba::bf16>(cur, nxt, SEQ, 1 << 30, ldsg, S, F.wave);
        cur = nxt;
    }
}
constexpr int RC_UNITS = 32, RC_NCH = SEQ / 16, RC_REC = 16384;
constexpr int RC_AR = 0, RC_BK = 4096, RC_VP = 8192, RC_U0 = 10240, RC_Y0 = 12288, RC_D = 14336;
typedef short bf16x8 __attribute__((ext_vector_type(8)));
typedef float f32x16 __attribute__((ext_vector_type(16)));
typedef float f32x2t __attribute__((ext_vector_type(2))); typedef __bf16 bf16x2t __attribute__((ext_vector_type(2)));
__device__ __forceinline__ unsigned cvtpk_c(float lo, float hi) { f32x2t v = {lo, hi}; bf16x2t b = __builtin_convertvector(v, bf16x2t); return __builtin_bit_cast(unsigned, b); }
__device__ __forceinline__ unsigned short cvt1_c(float x) { return (unsigned short)(cvtpk_c(x, 0.f) & 0xffffu); }

constexpr int RC_WLDS = 14464, RC_CODES_OFF = 8 * RC_WLDS  , RC_CSTRIDE = 456;
__device__ __forceinline__ void rc_core(Frame& F, LAS unsigned char* wlds, const float (&At)[16], const float (&Bt)[16], const float (&Kt)[16], const float (&Rt)[16], const float (&vv)[16], const float D, unsigned char* rec) {
    { unsigned wb_ = (unsigned)(uintptr_t)wlds; asm volatile("" : "+v"(wb_)); wlds = (LAS unsigned char*)(uintptr_t)wb_; }
    LAS bf16* XA = (LAS bf16*)wlds; LAS bf16* XB = (LAS bf16*)(wlds + 4608); LAS float* TT = (LAS float*)(wlds + 9216 + 4224);
    int x_ = F.lane; asm volatile("" : "+v"(x_));
    const int x = x_, r32 = x & 31, h2 = x >> 5, tl = x & 15;
#pragma unroll
    for (int t = 0; t < 16; ++t) { XA[t * 72 + x] = cvt1_c(Bt[t]); XA[(16 + t) * 72 + x] = cvt1_c(Kt[t]); XB[t * 72 + x] = cvt1_c(At[t]); XB[(16 + t) * 72 + x] = cvt1_c(Rt[t]); }
#pragma unroll
    for (int q = 0; q < 4; ++q) { v4u w; w.x = cvtpk_c(Bt[4 * q] * D, Bt[4 * q + 1] * D); w.y = cvtpk_c(Bt[4 * q + 2] * D, Bt[4 * q + 3] * D);
        w.z = cvtpk_c(Kt[4 * q] * D, Kt[4 * q + 1] * D); w.w = cvtpk_c(Kt[4 * q + 2] * D, Kt[4 * q + 3] * D); *(v4u*)(rec + RC_BK + x * 64 + q * 16) = w; }
#pragma unroll
    for (int q = 0; q < 2; ++q) { v4u w;
        w.x = cvtpk_c(vv[8 * q], vv[8 * q + 1]); w.y = cvtpk_c(vv[8 * q + 2], vv[8 * q + 3]); w.z = cvtpk_c(vv[8 * q + 4], vv[8 * q + 5]); w.w = cvtpk_c(vv[8 * q + 6], vv[8 * q + 7]); *(v4u*)(rec + RC_VP + x * 32 + q * 16) = w;
    }
    *(float*)(rec + RC_D + x * 4) = D;
    f32x16 G;
#pragma unroll
    for (int r = 0; r < 16; ++r) G[r] = 0.f;
#pragma unroll
    for (int ks = 0; ks < 4; ++ks) { const bf16x8 a = *(const LAS bf16x8*)(XA + r32 * 72 + ks * 16 + h2 * 8), bq = *(const LAS bf16x8*)(XB + r32 * 72 + ks * 16 + h2 * 8);
        G = __builtin_amdgcn_mfma_f32_32x32x16_bf16(a, bq, G, 0, 0, 0); }
    LAS float* GA = (LAS float*)wlds; LAS float* GT = (LAS float*)(wlds + 4608);
#pragma unroll
    for (int r = 0; r < 16; ++r) GA[((r & 3) + 8 * (r >> 2) + 4 * h2) * 36 + r32] = G[r];
#pragma unroll
    for (int g4 = 0; g4 < 4; ++g4) *(LAS f32x4*)(GT + r32 * 36 + 8 * g4 + 4 * h2) = (f32x4){G[4 * g4], G[4 * g4 + 1], G[4 * g4 + 2], G[4 * g4 + 3]};
#define RC_LD16(dst, p, n4) do { _Pragma("unroll") for (int i4_ = 0; i4_ < (n4); ++i4_) { const f32x4 v4_ = *(const LAS f32x4*)((p) + 4 * i4_); dst[4 * i4_] = v4_.x; dst[4 * i4_ + 1] = v4_.y; dst[4 * i4_ + 2] = v4_.z; dst[4 * i4_ + 3] = v4_.w; } } while (0)
    float Tc[16];
#pragma unroll
    for (int m = 0; m < 16; ++m) Tc[m] = (m == tl) ? 1.0f : 0.0f;
#pragma unroll
    for (int s = 14; s >= 0; --s) { float nr[16]; float acc = 0.f;
#pragma unroll
        for (int i4 = (s + 1) / 4; i4 < 4; ++i4) { const f32x4 v4 = *(const LAS f32x4*)(GA + s * 36 + 4 * i4); nr[4 * i4] = v4.x; nr[4 * i4 + 1] = v4.y; nr[4 * i4 + 2] = v4.z; nr[4 * i4 + 3] = v4.w; }
#pragma unroll
        for (int m = s + 1; m < 16; ++m) acc += nr[m] * Tc[m];
        Tc[s] = (s < tl) ? acc : Tc[s]; }
    if (x < 16) {
#pragma unroll
        for (int g4 = 0; g4 < 4; ++g4) *(LAS f32x4*)(TT + tl * 16 + 4 * g4) = (f32x4){Tc[4 * g4], Tc[4 * g4 + 1], Tc[4 * g4 + 2], Tc[4 * g4 + 3]}; }
    float PV[16];
    PV[0] = 0.f;
#pragma unroll
    for (int s = 1; s < 16; ++s) { float acc = 0.f;
#pragma unroll
        for (int r = 0; r < s; ++r) acc += GT[s * 36 + 16 + r] * vv[r];
        PV[s] = acc; }
    float Ah[16], U0[16];
#pragma unroll
    for (int t = 0; t < 16; ++t) { float a = 0.f, uu = 0.f;
#pragma unroll
        for (int s = 0; s <= t; ++s) { const float tv = TT[t * 16 + s]; a += tv * At[s]; uu += tv * PV[s]; }
        Ah[t] = a; U0[t] = uu; }
    float Rh[16], Y0[16];
#pragma unroll
    for (int t = 0; t < 16; ++t) { float a = Rt[t], yy = 0.f;
#pragma unroll
        for (int s = 0; s <= t; ++s) { const float m1 = GT[(16 + t) * 36 + s], m2 = GT[(16 + t) * 36 + 16 + s]; a += m1 * Ah[s]; yy += m1 * U0[s] + m2 * vv[s]; }
        Rh[t] = a; Y0[t] = yy; }
#undef RC_LD16
    { const int ks = x >> 5, jj = x & 31, e = (jj >> 4) * 4 + (jj & 3), q = (jj >> 2) & 3; unsigned char* pb = rec + RC_AR + ks * 1024 + q * 256 + e * 2;
#pragma unroll
      for (int s = 0; s < 16; ++s) { *(bf16*)(pb + s * 16) = cvt1_c(Ah[s]); *(bf16*)(pb + 2048 + s * 16) = cvt1_c(Rh[s]); } }
#pragma unroll
    for (int q = 0; q < 2; ++q) { v4u w;
        w.x = cvtpk_c(U0[8 * q], U0[8 * q + 1]); w.y = cvtpk_c(U0[8 * q + 2], U0[8 * q + 3]); w.z = cvtpk_c(U0[8 * q + 4], U0[8 * q + 5]); w.w = cvtpk_c(U0[8 * q + 6], U0[8 * q + 7]); *(v4u*)(rec + RC_U0 + x * 32 + q * 16) = w;
        w.x = cvtpk_c(Y0[8 * q], Y0[8 * q + 1]); w.y = cvtpk_c(Y0[8 * q + 2], Y0[8 * q + 3]); w.z = cvtpk_c(Y0[8 * q + 4], Y0[8 * q + 5]); w.w = cvtpk_c(Y0[8 * q + 6], Y0[8 * q + 7]); *(v4u*)(rec + RC_Y0 + x * 32 + q * 16) = w; }
    LDS_WAIT();
}
__device__ __forceinline__ void rc_pass1_rwkv(Frame& F, int wid, int nw, int c0, int nc) {
    LAS unsigned char* wlds = F.lds + F.wave * RC_WLDS;
    const int x = F.lane;
    const float* RW = (const float*)(FWS + WS_RW);
    const bf16* RH = (const bf16*)(FWS + WS_RW + 32 * MiB);
    for (int it2 = wid; it2 < 16 * nc; it2 += nw) {
        const int u = it2 / nc, c = c0 + it2 % nc, it = u * RC_NCH + c, b = u >> 3, h = u & 7; const size_t o0 = ((size_t)(b * SEQ + c * 16)) * 512 + h * 64 + x;
        float At[16], Bt[16], Kt[16], Rt[16], vv[16]; float W = 1.0f;
#pragma unroll
        for (int t = 0; t < 16; ++t) { const size_t o = o0 + (size_t)t * 512;
            const float wv = RW[o], ka = bf2f(RH[3 * RWA + o]), bb = bf2f(RH[4 * RWA + o]), kk = bf2f(RH[1 * RWA + o]), rr = bf2f(RH[0 * RWA + o]); vv[t] = bf2f(RH[2 * RWA + o]);
            At[t] = -ka * W; W *= wv; const float iw = 1.0f / W; Bt[t] = bb * iw; Kt[t] = kk * iw; Rt[t] = rr * W; }
        rc_core(F, wlds, At, Bt, Kt, Rt, vv, W, FWS + WS_REC + (size_t)it * RC_REC);
    }
}
__device__ __forceinline__ void rc_core_ret(Frame& F, LAS unsigned char* wlds, const float (&Kt)[16], const float (&Rt)[16], const float (&vv)[16], const float D, unsigned char* rec) {
    { unsigned wb_ = (unsigned)(uintptr_t)wlds; asm volatile("" : "+v"(wb_)); wlds = (LAS unsigned char*)(uintptr_t)wb_; }
    LAS bf16* XK = (LAS bf16*)wlds; LAS bf16* XR = (LAS bf16*)(wlds + 2304); LAS float* GM = (LAS float*)(wlds + 4608);
    int x_ = F.lane; asm volatile("" : "+v"(x_));
    const int x = x_, fr = x & 15, q = x >> 4;
#pragma unroll
    for (int t = 0; t < 16; ++t) { XK[t * 72 + x] = cvt1_c(Kt[t]); XR[t * 72 + x] = cvt1_c(Rt[t]); }
#pragma unroll
    for (int qq = 0; qq < 4; ++qq) { v4u w; w.x = 0u; w.y = 0u;
        w.z = cvtpk_c(Kt[4 * qq] * D, Kt[4 * qq + 1] * D); w.w = cvtpk_c(Kt[4 * qq + 2] * D, Kt[4 * qq + 3] * D); *(v4u*)(rec + RC_BK + x * 64 + qq * 16) = w; }
#pragma unroll
    for (int qq = 0; qq < 2; ++qq) { v4u w;
        w.x = cvtpk_c(vv[8 * qq], vv[8 * qq + 1]); w.y = cvtpk_c(vv[8 * qq + 2], vv[8 * qq + 3]); w.z = cvtpk_c(vv[8 * qq + 4], vv[8 * qq + 5]); w.w = cvtpk_c(vv[8 * qq + 6], vv[8 * qq + 7]); *(v4u*)(rec + RC_VP + x * 32 + qq * 16) = w;
        *(v4u*)(rec + RC_U0 + x * 32 + qq * 16) = (v4u){0u, 0u, 0u, 0u}; }
    *(float*)(rec + RC_D + x * 4) = D;
    { const int ks = x >> 5, jj = x & 31, e = (jj >> 4) * 4 + (jj & 3), qv = (jj >> 2) & 3; unsigned char* pb = rec + RC_AR + ks * 1024 + qv * 256 + e * 2;
#pragma unroll
      for (int s = 0; s < 16; ++s) { *(bf16*)(pb + s * 16) = (bf16)0; *(bf16*)(pb + 2048 + s * 16) = cvt1_c(Rt[s]); } }
    f32x4 G = {0.f, 0.f, 0.f, 0.f};
#pragma unroll
    for (int ks = 0; ks < 2; ++ks) { const bf16x8 a = *(const LAS bf16x8*)(XK + fr * 72 + ks * 32 + q * 8), bq = *(const LAS bf16x8*)(XR + fr * 72 + ks * 32 + q * 8);
        G = __builtin_amdgcn_mfma_f32_16x16x32_bf16(a, bq, G, 0, 0, 0); }
#pragma unroll
    for (int rg = 0; rg < 4; ++rg) GM[(4 * q + rg) * 17 + fr] = G[rg];
    float Y0[16];
#pragma unroll
    for (int t = 0; t < 16; ++t) { float yy = 0.f;
#pragma unroll
        for (int s = 0; s <= t; ++s) yy += GM[s * 17 + t] * vv[s];
        Y0[t] = yy; }
#pragma unroll
    for (int qq = 0; qq < 2; ++qq) { v4u w;
        w.x = cvtpk_c(Y0[8 * qq], Y0[8 * qq + 1]); w.y = cvtpk_c(Y0[8 * qq + 2], Y0[8 * qq + 3]); w.z = cvtpk_c(Y0[8 * qq + 4], Y0[8 * qq + 5]); w.w = cvtpk_c(Y0[8 * qq + 6], Y0[8 * qq + 7]); *(v4u*)(rec + RC_Y0 + x * 32 + qq * 16) = w; }
    LDS_WAIT();
}
__device__ __forceinline__ void rc_pass1_ret(Frame& F, int wid, int nw, int c0, int nc) {
    LAS unsigned char* wlds = F.lds + F.wave * RC_WLDS;
    const int x = F.lane;
    const bf16* P = (const bf16*)(FWS + WS_PROJ);
    for (int it2 = wid; it2 < 16 * nc; it2 += nw) {
        const int ru = it2 / nc, c = c0 + it2 % nc, it = ru * RC_NCH + c, b = ru >> 3, h = (ru >> 1) & 3, half = ru & 1; const float gamma = 1.0f - exp2f(-5.0f - (float)h);
        float Kt[16], Rt[16], vv[16]; float W = 1.0f;
        const bf16* p0 = P + (size_t)(b * SEQ + c * 16) * IN_PAD;
#pragma unroll
        for (int t = 0; t < 16; ++t) { const bf16* p = p0 + (size_t)t * IN_PAD;
            const float rr = bf2f(p[C_RQ + h * 64 + x]), kk = bf2f(p[C_RK + h * 64 + x]) * 0.125f; vv[t] = bf2f(p[C_RV + h * 128 + half * 64 + x]);
            W *= gamma; const float iw = 1.0f / W; Kt[t] = kk * iw; Rt[t] = rr * W; }
        rc_core_ret(F, wlds, Kt, Rt, vv, W, FWS + WS_REC + (size_t)(16 * RC_NCH + it) * RC_REC);
    }
}
__device__ __forceinline__ void rwkv_prep_mfma(Frame& F, int l, int first, int stride) {
    LAS unsigned char* wlds = F.lds + F.wave * RC_WLDS;
    LAS bf16* CODES = (LAS bf16*)(F.lds + RC_CODES_OFF);
    LAS float* ST = (LAS float*)wlds;
    const bf16* P = (const bf16*)(FWS + WS_PROJ);
    const float* mu = F.in[F.zz + 4] + l * RWC;
    const bf16* WT = (const bf16*)(FWS + WS_RWW + (size_t)l * 448 * 512 * 2);
    float* RW = (float*)(FWS + WS_RW);
    const int x = F.lane, h = F.wave, ch = h * 64 + x, fr = x & 15, q = x >> 4;
    for (int item = first; item < NB * RC_NCH; item += stride) {
        const int b = item >> 8, c = item & 255; const size_t row0 = (size_t)b * SEQ + c * 16; const int t0 = c * 16;
        for (int idx = F.tid; idx < 16 * 448; idx += NTHR) { const int tk = idx / 448, cc = idx - tk * 448;
            float val = lerp_bf(P, row0 + tk, C_RW + 1536 + cc, (t0 + tk) > 0, mu[1536 + cc]);
            if (cc < 96) val = tanhf(val); else if (cc >= 192) val = sigmoidf_(val);
            CODES[tk * RC_CSTRIDE + cc] = cvt1_c(val); }
        __syncthreads();
        f32x4 accW[4], accA[4], accG[4];
#pragma unroll
        for (int ct = 0; ct < 4; ++ct) { accW[ct] = (f32x4){0.f, 0.f, 0.f, 0.f}; accA[ct] = accW[ct]; accG[ct] = accW[ct]; }
#pragma unroll 1
        for (int ks = 0; ks < 3; ++ks) { const bf16x8 aw = *(const LAS bf16x8*)(CODES + fr * RC_CSTRIDE + ks * 32 + q * 8), aa = *(const LAS bf16x8*)(CODES + fr * RC_CSTRIDE + 96 + ks * 32 + q * 8);
#pragma unroll
            for (int ct = 0; ct < 4; ++ct) { const int n = h * 64 + ct * 16 + fr;
                const bf16x8 bw = *(const bf16x8*)(WT + (size_t)n * 96 + ks * 32 + q * 8), ba = *(const bf16x8*)(WT + 512 * 96 + (size_t)n * 96 + ks * 32 + q * 8);
                accW[ct] = __builtin_amdgcn_mfma_f32_16x16x32_bf16(aw, bw, accW[ct], 0, 0, 0); accA[ct] = __builtin_amdgcn_mfma_f32_16x16x32_bf16(aa, ba, accA[ct], 0, 0, 0); } }
#pragma unroll 2
        for (int ks = 0; ks < 8; ++ks) { const bf16x8 ag = *(const LAS bf16x8*)(CODES + fr * RC_CSTRIDE + 192 + ks * 32 + q * 8);
#pragma unroll
            for (int ct = 0; ct < 4; ++ct) { const int n = h * 64 + ct * 16 + fr;
                const bf16x8 bg = *(const bf16x8*)(WT + 2 * 512 * 96 + (size_t)n * 256 + ks * 32 + q * 8);
                accG[ct] = __builtin_amdgcn_mfma_f32_16x16x32_bf16(ag, bg, accG[ct], 0, 0, 0); } }
#pragma unroll
        for (int ct = 0; ct < 4; ++ct)
#pragma unroll
            for (int rg = 0; rg < 4; ++rg) { const int o = (4 * q + rg) * 64 + ct * 16 + fr; ST[o] = accW[ct][rg]; ST[1024 + o] = accA[ct][rg]; ST[2048 + o] = accG[ct][rg]; }
        const float mur = mu[ch], muk = mu[512 + ch], muv = mu[1024 + ch];
        const float w0c = F.in[F.zz + 5][l * 512 + ch], a0c = F.in[F.zz + 7][l * 512 + ch], kkc = F.in[F.zz + 10][l * 512 + ch], kac = F.in[F.zz + 11][l * 512 + ch], rkc = F.in[F.zz + 12][l * 512 + ch];
        const bf16* pr = P + row0 * IN_PAD + C_RW + ch;
        float* gpw = RW + row0 * 512 + ch;
        bf16* gp = (bf16*)(FWS + WS_RW + 32 * MiB) + row0 * 512 + ch;
        float pvr = 0.f, pvk = 0.f, pvv = 0.f;
        if (t0 > 0) { pvr = bf2f(pr[-IN_PAD]); pvk = bf2f(pr[512 - IN_PAD]); pvv = bf2f(pr[1024 - IN_PAD]); }
#pragma unroll 4
        for (int t = 0; t < 16; ++t) {
            const float cr = bf2f(pr[0]), ck = bf2f(pr[512]), cv = bf2f(pr[1024]);
            const float rr = cr + (pvr - cr) * mur, kk0 = ck + (pvk - ck) * muk, vv = cv + (pvv - cv) * muv;
            pvr = cr; pvk = ck; pvv = cv; pr += IN_PAD;
            const float z = -(w0c + ST[t * 64 + x]);
            const float sp = fmaxf(z, 0.f) + log1pf(__expf(-fabsf(z)));
            const float decay = __expf(-__expf(-sp - 0.5f));
            const float a = sigmoidf_(a0c + ST[1024 + t * 64 + x]);
            const float gg = ST[2048 + t * 64 + x];
            const float kkv = kk0 * kkc;
            const float nrm = sqrtf(wave_sum(kkv * kkv));
            const float kap = kkv / fmaxf(nrm, 1e-12f);
            const float kp = kk0 * (1.0f + (a - 1.0f) * kac);
            const float bsum = wave_sum(rr * kp * rkc);
            gpw[0] = decay; gpw += 512;
            gp[0 * RWA] = cvt1_c(rr); gp[1 * RWA] = cvt1_c(kp); gp[2 * RWA] = cvt1_c(vv); gp[3 * RWA] = cvt1_c(kap); gp[4 * RWA] = cvt1_c(kap * a); gp[5 * RWA] = cvt1_c(gg); gp[6 * RWA] = cvt1_c(bsum * vv); gp += 512; }
        LDS_WAIT();
        __syncthreads();
    }
}
constexpr int RC_SLOT = 15360, RC_YST = 8 * RC_SLOT  ;
__device__ __forceinline__ void rc_pass2(Frame& F, int u, int cb, int ce, bool first, bool last) {
    const unsigned char* rec = FWS + WS_REC + (size_t)u * RC_NCH * RC_REC;
    const int lane = F.lane;
    const int NIT = (ce - cb) / 2;
    bf16* Yg;
    if (u < 16) Yg = (bf16*)(FWS + WS_Y) + (size_t)((u >> 3) * SEQ) * 512 + (u & 7) * 64;
    else { const int ru = u - 16; Yg = (bf16*)(FWS + WS_RETO) + (size_t)((ru >> 3) * SEQ) * 512 + ((ru >> 1) & 3) * 128 + (ru & 1) * 64; }
#define RC_BARRIER() __builtin_amdgcn_s_barrier()
    if (F.wave == 7) {
        unsigned t0_ = 0u, t1_ = 0u, t2_ = 0u, t3_ = 0u;
        for (int cq = cb; cq < cb + 24 && cq < ce; cq += 2) { const unsigned char* pa = rec + (size_t)cq * RC_REC + lane * 128; const unsigned char* pb = pa + 8192; const unsigned char* pc = pa + RC_REC; const unsigned char* pd = pb + RC_REC;
            asm volatile("global_load_dword %0, %4, off\n\tglobal_load_dword %1, %5, off\n\tglobal_load_dword %2, %6, off\n\tglobal_load_dword %3, %7, off" : "+v"(t0_), "+v"(t1_), "+v"(t2_), "+v"(t3_) : "v"(pa), "v"(pb), "v"(pc), "v"(pd) : "memory"); }
        RC_BARRIER();
        for (int i = 0; i < NIT; ++i) {
            const int cp = cb + 2 * i + 24;
            if (cp < ce) { const unsigned char* pa = rec + (size_t)cp * RC_REC + lane * 128; const unsigned char* pb = pa + 8192; const unsigned char* pc = pa + RC_REC; const unsigned char* pd = pb + RC_REC;
                asm volatile("global_load_dword %0, %4, off\n\tglobal_load_dword %1, %5, off\n\tglobal_load_dword %2, %6, off\n\tglobal_load_dword %3, %7, off" : "+v"(t0_), "+v"(t1_), "+v"(t2_), "+v"(t3_) : "v"(pa), "v"(pb), "v"(pc), "v"(pd) : "memory"); }
            if (i > 0) {
                const LAS unsigned char* yb = F.lds + RC_YST + ((i - 1) & 1) * 4096;
#pragma unroll
                for (int j = 0; j < 4; ++j) { const v4u w = *(const LAS v4u*)(yb + j * 1024 + lane * 16);
                    *(v4u*)(Yg + (size_t)((cb + 2 * i - 2) * 16 + j * 8 + (lane >> 3)) * 512 + (lane & 7) * 8) = w; } }
            RC_BARRIER();
        }
        { const LAS unsigned char* yb = F.lds + RC_YST + ((NIT - 1) & 1) * 4096;
#pragma unroll
          for (int j = 0; j < 4; ++j) { const v4u w = *(const LAS v4u*)(yb + j * 1024 + lane * 16);
              *(v4u*)(Yg + (size_t)((cb + 2 * NIT - 2) * 16 + j * 8 + (lane >> 3)) * 512 + (lane & 7) * 8) = w; } }
        asm volatile("s_waitcnt vmcnt(0)" ::: "memory");
        asm volatile("" :: "v"(t0_), "v"(t1_), "v"(t2_), "v"(t3_));
    } else if (F.wave >= 4) {
        const int lw = F.wave - 4;
        const int p0_ = lw == 0 ? 8 : (lw == 1 ? 11 : 13), np_ = lw == 0 ? 3 : 2;
#define RC_ISSUE(c) do { _Pragma("unroll") for (int i_ = 0; i_ < 3; ++i_) { if (i_ < np_) \
            __builtin_amdgcn_global_load_lds((const unsigned*)(rec + (size_t)(c) * RC_REC + (p0_ + i_) * 1024 + lane * 16), (LAS unsigned*)(F.lds + ((c) & 7) * RC_SLOT + (p0_ + i_) * 1024), 16, 0, 0); } } while (0)
#define RC_WAIT4() do { if (lw == 0) asm volatile("s_waitcnt vmcnt(12)" ::: "memory"); else asm volatile("s_waitcnt vmcnt(8)" ::: "memory"); } while (0)
        for (int c = cb; c < cb + 6; ++c) RC_ISSUE(c);
        RC_WAIT4();
        RC_BARRIER();
        for (int i = 0; i < NIT; ++i) {
            if (cb + 2 * i + 7 < ce) { RC_ISSUE(cb + 2 * i + 6); RC_ISSUE(cb + 2 * i + 7); RC_WAIT4(); }
            else asm volatile("s_waitcnt vmcnt(0)" ::: "memory");
            RC_BARRIER();
        }
#undef RC_ISSUE
#undef RC_WAIT4
    } else {
        const int ib = F.wave, fr = lane & 15, q = lane >> 4;
#define RC_ISSUE1(c) do { __builtin_amdgcn_global_load_lds((const unsigned*)(rec + (size_t)(c) * RC_REC + (2 * ib) * 1024 + lane * 16), (LAS unsigned*)(F.lds + ((c) & 7) * RC_SLOT + (2 * ib) * 1024), 16, 0, 0); \
        __builtin_amdgcn_global_load_lds((const unsigned*)(rec + (size_t)(c) * RC_REC + (2 * ib + 1) * 1024 + lane * 16), (LAS unsigned*)(F.lds + ((c) & 7) * RC_SLOT + (2 * ib + 1) * 1024), 16, 0, 0); } while (0)
        f32x4* sv = (f32x4*)(FWS + WS_CTL + 262144) + (size_t)((u * 4 + ib) * 4 + 0) * 64 + lane;
        f32x4 sT[4];
#pragma unroll
        for (int jb = 0; jb < 4; ++jb) sT[jb] = first ? (f32x4){0.f, 0.f, 0.f, 0.f} : sv[jb * 64];
        asm volatile("s_waitcnt vmcnt(0)" ::: "memory");
        for (int c = cb; c < cb + 6; ++c) RC_ISSUE1(c);
        asm volatile("s_waitcnt vmcnt(8)" ::: "memory");
        RC_BARRIER();
        for (int i = 0; i < NIT; ++i) {
            bf16x8 aU0[2], aU1[2], aY0[2], aY1[2], bk[2][4]; f32x4 dd[2][4]; v2u vp[2], u0[2], y0[2];
#pragma unroll
            for (int h = 0; h < 2; ++h) { const LAS unsigned char* slot = F.lds + ((cb + 2 * i + h) & 7) * RC_SLOT;
                aU0[h] = *(const LAS bf16x8*)(slot + RC_AR + q * 256 + fr * 16); aU1[h] = *(const LAS bf16x8*)(slot + RC_AR + 1024 + q * 256 + fr * 16);
                aY0[h] = *(const LAS bf16x8*)(slot + RC_AR + 2048 + q * 256 + fr * 16); aY1[h] = *(const LAS bf16x8*)(slot + RC_AR + 3072 + q * 256 + fr * 16);
                u0[h] = *(const LAS v2u*)(slot + RC_U0 + (16 * ib + fr) * 32 + q * 8); vp[h] = *(const LAS v2u*)(slot + RC_VP + (16 * ib + fr) * 32 + q * 8);
#pragma unroll
                for (int jb = 0; jb < 4; ++jb) { bk[h][jb] = *(const LAS bf16x8*)(slot + RC_BK + (16 * jb + fr) * 64 + q * 16); dd[h][jb] = *(const LAS f32x4*)(slot + RC_D + (16 * jb + 4 * q) * 4); }
                y0[h] = *(const LAS v2u*)(slot + RC_Y0 + (16 * ib + fr) * 32 + q * 8); }
            LAS bf16* yst = (LAS bf16*)(F.lds + RC_YST + (i & 1) * 4096);
#pragma unroll
            for (int h = 0; h < 2; ++h) {
                v4u s0, s1;
                s0.x = cvtpk_c(sT[0][0], sT[0][1]); s0.y = cvtpk_c(sT[0][2], sT[0][3]); s0.z = cvtpk_c(sT[1][0], sT[1][1]); s0.w = cvtpk_c(sT[1][2], sT[1][3]);
                s1.x = cvtpk_c(sT[2][0], sT[2][1]); s1.y = cvtpk_c(sT[2][2], sT[2][3]); s1.z = cvtpk_c(sT[3][0], sT[3][1]); s1.w = cvtpk_c(sT[3][2], sT[3][3]);
                const bf16x8 sb0 = __builtin_bit_cast(bf16x8, s0), sb1 = __builtin_bit_cast(bf16x8, s1);
                f32x4 zU = (f32x4){0.f, 0.f, 0.f, 0.f}, zY = (f32x4){0.f, 0.f, 0.f, 0.f};
                zU = __builtin_amdgcn_mfma_f32_16x16x32_bf16(aU0[h], sb0, zU, 0, 0, 0); zU = __builtin_amdgcn_mfma_f32_16x16x32_bf16(aU1[h], sb1, zU, 0, 0, 0);
                const float U0_ = zU[0] + bflo(u0[h].x), U1_ = zU[1] + bfhi(u0[h].x), U2_ = zU[2] + bflo(u0[h].y), U3_ = zU[3] + bfhi(u0[h].y);
                v4u ubw; ubw.x = cvtpk_c(U0_, U1_); ubw.y = cvtpk_c(U2_, U3_); ubw.z = vp[h].x; ubw.w = vp[h].y;
                const bf16x8 ub = __builtin_bit_cast(bf16x8, ubw);
#pragma unroll
                for (int jb = 0; jb < 4; ++jb) sT[jb] = __builtin_amdgcn_mfma_f32_16x16x32_bf16(bk[h][jb], ub, sT[jb] * dd[h][jb], 0, 0, 0);
                zY = __builtin_amdgcn_mfma_f32_16x16x32_bf16(aY0[h], sb0, zY, 0, 0, 0); zY = __builtin_amdgcn_mfma_f32_16x16x32_bf16(aY1[h], sb1, zY, 0, 0, 0);
                LAS bf16* yp = yst + h * 1024 + (4 * q) * 64 + 16 * ib + fr;
                yp[0] = cvt1_c(zY[0] + bflo(y0[h].x)); yp[64] = cvt1_c(zY[1] + bfhi(y0[h].x)); yp[128] = cvt1_c(zY[2] + bflo(y0[h].y)); yp[192] = cvt1_c(zY[3] + bfhi(y0[h].y));
            }
            if (cb + 2 * i + 7 < ce) { RC_ISSUE1(cb + 2 * i + 6); RC_ISSUE1(cb + 2 * i + 7); asm volatile("s_waitcnt vmcnt(8) lgkmcnt(0)" ::: "memory"); } else asm volatile("s_waitcnt vmcnt(0) lgkmcnt(0)" ::: "memory");
            RC_BARRIER();
        }
        if (!last) {
#pragma unroll
            for (int jb = 0; jb < 4; ++jb) sv[jb * 64] = sT[jb]; }
#undef RC_ISSUE1
    }
#undef RC_BARRIER
    asm volatile("s_waitcnt vmcnt(0) lgkmcnt(0)" ::: "memory");
    __syncthreads();
}
__device__ __forceinline__ void sub_arrive(Frame& F, unsigned* cnt) {
    asm volatile("s_waitcnt vmcnt(0)" ::: "memory");
    __syncthreads();
    if (F.tid == 0) { __builtin_amdgcn_fence(__ATOMIC_RELEASE, "agent"); asm volatile("s_waitcnt vmcnt(0)" ::: "memory"); __hip_atomic_fetch_add(cnt, 1u, __ATOMIC_RELAXED, __HIP_MEMORY_SCOPE_AGENT); }
}
__device__ __forceinline__ void sub_wait(Frame& F, unsigned* cnt, unsigned target) {
    if (F.tid == 0) { unsigned sp = 0u;
        while (__hip_atomic_load(cnt, __ATOMIC_RELAXED, __HIP_MEMORY_SCOPE_AGENT) < target) { __builtin_amdgcn_s_sleep(2); if (++sp > (1u << 24)) break; }
        __builtin_amdgcn_fence(__ATOMIC_ACQUIRE, "agent"); asm volatile("s_waitcnt vmcnt(0)" ::: "memory"); }
    __syncthreads();
}
__device__ __forceinline__ void sub_barrier(Frame& F, unsigned* cnt, unsigned target) {
    asm volatile("s_waitcnt vmcnt(0)" ::: "memory");
    __syncthreads();
    if (F.tid == 0) {
        __builtin_amdgcn_fence(__ATOMIC_RELEASE, "agent");
        asm volatile("s_waitcnt vmcnt(0)" ::: "memory");
        __hip_atomic_fetch_add(cnt, 1u, __ATOMIC_RELAXED, __HIP_MEMORY_SCOPE_AGENT);
        unsigned sp = 0u;
        while (__hip_atomic_load(cnt, __ATOMIC_RELAXED, __HIP_MEMORY_SCOPE_AGENT) < target) { __builtin_amdgcn_s_sleep(2); if (++sp > (1u << 24)) break; }
        __builtin_amdgcn_fence(__ATOMIC_ACQUIRE, "agent");
        asm volatile("s_waitcnt vmcnt(0)" ::: "memory");
    }
    __syncthreads();
}
__device__ __forceinline__ void mixer_post(Frame& F, int l, int gw, int NGW) {
    const bf16* P = (const bf16*)(FWS + WS_PROJ);
    const bf16* RH = (const bf16*)(FWS + WS_RW + 32 * MiB);
    const float* RW = (const float*)(FWS + WS_RW);
    const bf16* Y = (const bf16*)(FWS + WS_Y);
    const bf16* RO = (const bf16*)(FWS + WS_RETO);
    bf16* MX = (bf16*)(FWS + WS_MIXED);
    const float* ln_w = F.in[F.zz + 13] + l * 512; const float* ln_b = F.in[F.zz + 14] + l * 512;
    const int lane = F.lane;
    for (int m0 = gw; m0 < MROWS; m0 += 2 * NGW) {
        float y[2][8], s1[2][8], s2[2][8], bon[2][8], gat[2][8]; f32x2 ov[2][4]; float s3[2][4]; unsigned gw2[2][4];
#pragma unroll
        for (int r = 0; r < 2; ++r) { const size_t m = (size_t)(m0 + r * NGW < MROWS ? m0 + r * NGW : m0), o = m * 512;
#pragma unroll
            for (int h = 0; h < 8; ++h) { const int c = h * 64 + lane; y[r][h] = bf2f(Y[o + c]); bon[r][h] = bf2f(RH[6 * RWA + o + c]); gat[r][h] = bf2f(RH[5 * RWA + o + c]); s1[r][h] = y[r][h]; }
#pragma unroll
            for (int h = 0; h < 4; ++h) { const int c = h * 128 + 2 * lane; { const unsigned rw_ = *(const unsigned*)(RO + o + c); ov[r][h].x = bflo(rw_); ov[r][h].y = bfhi(rw_); } gw2[r][h] = *(const unsigned*)(P + m * IN_PAD + C_RG + c); s3[r][h] = ov[r][h].x * ov[r][h].x + ov[r][h].y * ov[r][h].y; } }
#pragma unroll
        for (int r = 0; r < 2; ++r) {
#pragma unroll
            for (int h = 0; h < 8; ++h) { s1[r][h] = dpp_add<0xB1>(s1[r][h]); s1[r][h] = dpp_add<0x4E>(s1[r][h]); s1[r][h] = dpp_add<0x141>(s1[r][h]); s1[r][h] = dpp_add<0x140>(s1[r][h]); }
#pragma unroll
            for (int h = 0; h < 4; ++h) { s3[r][h] = dpp_add<0xB1>(s3[r][h]); s3[r][h] = dpp_add<0x4E>(s3[r][h]); s3[r][h] = dpp_add<0x141>(s3[r][h]); s3[r][h] = dpp_add<0x140>(s3[r][h]); } }
#pragma unroll
        for (int of = 16; of < 64; of <<= 1) {
#pragma unroll
            for (int r = 0; r < 2; ++r) {
#pragma unroll
                for (int h = 0; h < 8; ++h) s1[r][h] += __shfl_xor(s1[r][h], of);
#pragma unroll
                for (int h = 0; h < 4; ++h) s3[r][h] += __shfl_xor(s3[r][h], of); } }
#pragma unroll
        for (int r = 0; r < 2; ++r)
#pragma unroll
            for (int h = 0; h < 8; ++h) { const float d = y[r][h] - s1[r][h] * (1.0f / 64.0f); y[r][h] = d; s2[r][h] = d * d; s2[r][h] = dpp_add<0xB1>(s2[r][h]); s2[r][h] = dpp_add<0x4E>(s2[r][h]); s2[r][h] = dpp_add<0x141>(s2[r][h]); s2[r][h] = dpp_add<0x140>(s2[r][h]); }
#pragma unroll
        for (int of = 16; of < 64; of <<= 1) {
#pragma unroll
            for (int r = 0; r < 2; ++r)
#pragma unroll
                for (int h = 0; h < 8; ++h) s2[r][h] += __shfl_xor(s2[r][h], of); }
#pragma unroll
        for (int r = 0; r < 2; ++r) { if (m0 + r * NGW < MROWS) { const size_t m = (size_t)(m0 + r * NGW);
#pragma unroll
            for (int h = 0; h < 8; ++h) { const int c = h * 64 + lane;
                const float yn = y[r][h] * (1.0f / sqrtf(s2[r][h] * (1.0f / 64.0f) + GN_EPS)) * ln_w[c] + ln_b[c];
                MX[m * DM + 512 + c] = (bf16)f2bf((yn + bon[r][h]) * gat[r][h]); }
#pragma unroll
            for (int h = 0; h < 4; ++h) { const int c = h * 128 + 2 * lane;
                const float rn = 1.0f / sqrtf(s3[r][h] * (1.0f / 128.0f) + NORM_EPS);
                const float g0 = bflo(gw2[r][h]), g1 = bfhi(gw2[r][h]);
                *(unsigned*)(MX + m * DM + c) = pk2(ov[r][h].x * rn * g0 * sigmoidf_(g0), ov[r][h].y * rn * g1 * sigmoidf_(g1)); } } }
    }
}
__device__ __forceinline__ void conv_gate_phase(Frame& F, int l) {
    const bf16* U = (const bf16*)(FWS + WS_U);
    bf16* A = (bf16*)(FWS + WS_ACT);
    const float* cw = F.in[F.zz + 16] + (size_t)l * 3 * UPC; const float* cb = F.in[F.zz + 17] + (size_t)l * UPC;
    constexpr int NCG = DFF / 8, NRC = MROWS / 16;
    for (int it = F.vcu * NTHR + F.tid; it < NCG * NRC; it += F.G * NTHR) {
        const int cg = it % NCG, rc = it / NCG, c0 = cg * 8, row0 = rc * 16, t0 = row0 & (SEQ - 1);
        float wv[3][8], wg[3][8], bv[8], bg[8];
#pragma unroll
        for (int j = 0; j < 3; ++j)
#pragma unroll
            for (int e = 0; e < 8; ++e) { wv[j][e] = cw[j * UPC + c0 + e]; wg[j][e] = cw[j * UPC + DFF + c0 + e]; }
#pragma unroll
        for (int e = 0; e < 8; ++e) { bv[e] = cb[c0 + e]; bg[e] = cb[DFF + c0 + e]; }
        v4u v0 = {0u, 0u, 0u, 0u}, v1 = v0, g0 = v0, g1 = v0;
        if (t0 > 0) { v0 = *(const v4u*)(U + (size_t)(row0 - 2) * UPC + c0); v1 = *(const v4u*)(U + (size_t)(row0 - 1) * UPC + c0);
                      g0 = *(const v4u*)(U + (size_t)(row0 - 2) * UPC + DFF + c0); g1 = *(const v4u*)(U + (size_t)(row0 - 1) * UPC + DFF + c0); }
        for (int r = 0; r < 16; ++r) {
            const v4u v2 = *(const v4u*)(U + (size_t)(row0 + r) * UPC + c0), g2 = *(const v4u*)(U + (size_t)(row0 + r) * UPC + DFF + c0);
            float ov[8];
#pragma unroll
            for (int e = 0; e < 4; ++e) {
                const float va = wv[0][2 * e] * bflo(v0[e]) + wv[1][2 * e] * bflo(v1[e]) + wv[2][2 * e] * bflo(v2[e]) + bv[2 * e];
                const float vb = wv[0][2 * e + 1] * bfhi(v0[e]) + wv[1][2 * e + 1] * bfhi(v1[e]) + wv[2][2 * e + 1] * bfhi(v2[e]) + bv[2 * e + 1];
                const float ga = wg[0][2 * e] * bflo(g0[e]) + wg[1][2 * e] * bflo(g1[e]) + wg[2][2 * e] * bflo(g2[e]) + bg[2 * e];
                const float gb = wg[0][2 * e + 1] * bfhi(g0[e]) + wg[1][2 * e + 1] * bfhi(g1[e]) + wg[2][2 * e + 1] * bfhi(g2[e]) + bg[2 * e + 1];
                ov[2 * e] = ga * sigmoidf_(ga) * va; ov[2 * e + 1] = gb * sigmoidf_(gb) * vb; }
            v4u w; w.x = pk2(ov[0], ov[1]); w.y = pk2(ov[2], ov[3]); w.z = pk2(ov[4], ov[5]); w.w = pk2(ov[6], ov[7]);
            *(v4u*)(A + (size_t)(row0 + r) * DFF + c0) = w;
            v0 = v1; v1 = v2; g0 = g1; g1 = g2;
        }
    }
}

__device__ __forceinline__ void conv_fixup_phase(Frame& F, int l) {
    const float* H = (const float*)(FWS + WS_HALO);
    bf16* A = (bf16*)(FWS + WS_ACT);
    const float* cw = F.in[F.zz + 16] + (size_t)l * 3 * UPC; const float* cb = F.in[F.zz + 17] + (size_t)l * UPC;
    constexpr int NQ = DFF / 4;
    for (int it = F.vcu * NTHR + F.tid; it < (MROWS / 64) * 2 * NQ; it += F.G * NTHR) {
        const int c = (it % NQ) * 4, gr = it / NQ, r = gr & 1, g = gr >> 1, colp = (c >> 7) * 256 + (c & 127);
        const bool hasprev = (g & 63) != 0;
        const float* hg = H + (size_t)g * 4 * UPC + colp; const float* hp = hg - (size_t)4 * UPC;
        const f32x4 z = {0.f, 0.f, 0.f, 0.f};
        f32x4 v0, v1, v2, g0, g1, g2;
        v0 = *(const f32x4*)(hg + (size_t)r * UPC); g0 = *(const f32x4*)(hg + (size_t)r * UPC + 128);
        if (r == 1) { v1 = *(const f32x4*)hg; g1 = *(const f32x4*)(hg + 128); v2 = hasprev ? *(const f32x4*)(hp + (size_t)3 * UPC) : z; g2 = hasprev ? *(const f32x4*)(hp + (size_t)3 * UPC + 128) : z; }
        else { v1 = hasprev ? *(const f32x4*)(hp + (size_t)3 * UPC) : z; g1 = hasprev ? *(const f32x4*)(hp + (size_t)3 * UPC + 128) : z; v2 = hasprev ? *(const f32x4*)(hp + (size_t)2 * UPC) : z; g2 = hasprev ? *(const f32x4*)(hp + (size_t)2 * UPC + 128) : z; }
        const f32x4 cv = *(const f32x4*)(cw + c) * v2 + *(const f32x4*)(cw + UPC + c) * v1 + *(const f32x4*)(cw + 2 * UPC + c) * v0 + *(const f32x4*)(cb + c);
        const f32x4 cg = *(const f32x4*)(cw + DFF + c) * g2 + *(const f32x4*)(cw + UPC + DFF + c) * g1 + *(const f32x4*)(cw + 2 * UPC + DFF + c) * g0 + *(const f32x4*)(cb + DFF + c);
        v2u w; w.x = pk2(cg[0] * sigmoidf_(cg[0]) * cv[0], cg[1] * sigmoidf_(cg[1]) * cv[1]); w.y = pk2(cg[2] * sigmoidf_(cg[2]) * cv[2], cg[3] * sigmoidf_(cg[3]) * cv[3]);
        *(v2u*)(A + (size_t)(64 * g + r) * DFF + c) = w;
    }
}

#define GRID_BAR() do { xcd_barrier(bar, tid_from_wave(F.wave)); asm volatile("" : "+s"(F.wave), "+s"(F.vcu), "+s"(F.G)); F.tid = tid_from_wave(F.wave); F.lane = F.tid & 63; { unsigned z_ = 0u; asm volatile("" : "+v"(z_)); F.zz = __builtin_amdgcn_readfirstlane(z_); } } while (0)
#define XB ((bf16*)(FWS + WS_X))
#define HB ((bf16*)(FWS + WS_H))
#define PROJ ((bf16*)(FWS + WS_PROJ))
#define MIXED ((bf16*)(FWS + WS_MIXED))
#define UB ((bf16*)(FWS + WS_U))
#define ACT ((bf16*)(FWS + WS_ACT))
#define MOD ((const float*)(FWS + WS_MOD))
template <int l>
__device__ __forceinline__ void layer_fwd(Frame& F, const XcdBarrier& bar) {
#define modl (MOD + (size_t)l * 2 * 12288)
#define wl (FWS + WS_W + (size_t)l * W_LAYER)
        if (l == 0) norm_phase<0, true>(F, F.in[F.zz + 0], HB, F.in[F.zz + 21] + l * DM, modl + 0 * DM, modl + 1 * DM);
        else norm_phase<0, false>(F, XB, HB, F.in[F.zz + 21] + l * DM, modl + 0 * DM, modl + 1 * DM);
        GRID_BAR();
        { pg8::Gemm g{HB, (const bf16*)(wl + W_IN), MROWS, IN_PAD, DM}; pg8::StaticOrder S; S.init(MROWS, IN_PAD, F.G, (int)blockIdx.x);
          pg8::EpiBf16 E{PROJ, IN_PAD};
          pg8::gemm_phase<pg8::EpiBf16, pg8::StaticOrder, true, true>(F.lds, g, S, E, F.wave); }
        if (F.G == 256 && blockIdx.x >= 64) convert_gap(F, l, CV_IN, l == 0 ? CV_C1 : CV_OUT + CV_UP, ((int)blockIdx.x - 64) * NWAVES + F.wave, 192 * NWAVES, CV_N1);
        GRID_BAR();
        rwkv_prep_mfma(F, l, F.vcu, F.G);
        moba_kmean(F);
        GRID_BAR();
        const int xg_ = F.vcu >> 5, xj_ = F.vcu & 31, mi_ = xg_ * 16 + xj_;
        if (xj_ < 16) { moba_item(F, mi_ >> 3, 15 - (mi_ & 7), mi_ & 7);
            if (F.G == 256 && l == 0) { constexpr int nr_ = CV_LAYER - (CV_IN + CV_C1); LAS float* scr_ = (LAS float*)(F.lds + F.wave * 16384);
                for (int j = 0; j < CV_N3; ++j) { const int s_ = mi_ * NWAVES + F.wave + 128 * NWAVES * j;
                    if (s_ < nr_) convert_item(F, l * CV_LAYER + CV_IN + CV_C1 + s_, scr_);
                    else if (l == 0 && s_ - nr_ < CV_IN - CV_C2) convert_item(F, CV_LAYER + CV_C2 + (s_ - nr_), scr_); } } }
        else {
            const int rv = xg_ * 16 + (xj_ - 16), nrc = F.G / 2;
            unsigned* sub = (unsigned*)(FWS + WS_CTL) + CW_SUB + 128 * l;
            constexpr int RC_SPLIT = 104;
            rc_pass1_rwkv(F, rv * NWAVES + F.wave, nrc * NWAVES, 0, 128);
            rc_pass1_ret(F, rv * NWAVES + F.wave, nrc * NWAVES, 0, 128);
            sub_barrier(F, sub, (unsigned)nrc);
            const bool p2cu = (rv & 3) == 0 && (rv >> 2) < RC_UNITS;
            if (p2cu) {
                rc_pass2(F, rv >> 2, 0, RC_SPLIT, true, false);
                sub_wait(F, sub + 32, (unsigned)(nrc - RC_UNITS));
                rc_pass2(F, rv >> 2, RC_SPLIT, RC_NCH, false, true);
            } else {
                const int ov = rv - (rv >> 2) - 1, nov = nrc - RC_UNITS;
                rc_pass1_rwkv(F, ov * NWAVES + F.wave, nov * NWAVES, 128, 128);
                rc_pass1_ret(F, ov * NWAVES + F.wave, nov * NWAVES, 128, 128);
                sub_arrive(F, sub + 32);
            }
            sub_barrier(F, sub + 64, (unsigned)nrc);
            mixer_post(F, l, rv * NWAVES + F.wave, nrc * NWAVES);
        }
        GRID_BAR();
#if MOBA_CHECK
        moba_naive(F, F.vcu * NWAVES + F.wave, F.G * NWAVES);
        GRID_BAR();
        { float sd = 0.f, sn = 0.f; const bf16* NV = (const bf16*)(FWS + WS_U + 160 * MiB); const bf16* MXc = (const bf16*)(FWS + WS_MIXED);
          for (int m = F.vcu * NWAVES + F.wave; m < MROWS; m += F.G * NWAVES) for (int j = 0; j < 16; ++j) { const float a = bf2f(MXc[(size_t)m * DM + 1024 + j * 64 + F.lane]), b = bf2f(NV[(size_t)m * 1024 + j * 64 + F.lane]); sd += (a - b) * (a - b); sn += b * b; }
          atomicAdd((float*)(FWS + WS_CTL) + 8, sd); atomicAdd((float*)(FWS + WS_CTL) + 9, sn); }
        GRID_BAR();
#endif
        { pg8::Gemm g{MIXED, (const bf16*)(wl + W_OUT), MROWS, DM, DM}; pg8::StaticOrder S; S.init(MROWS, DM, F.G, (int)blockIdx.x);
          if (l == 0) { pg8::EpiResGate<true> E{F.in[F.zz + 0], XB, DM, modl + 2 * DM, 12288, SEQ}; pg8::gemm_phase<pg8::EpiResGate<true>, pg8::StaticOrder, true, true>(F.lds, g, S, E, F.wave); }
          else { pg8::EpiResGate<false> E{XB, XB, DM, modl + 2 * DM, 12288, SEQ}; pg8::gemm_phase<pg8::EpiResGate<false>, pg8::StaticOrder, true, true>(F.lds, g, S, E, F.wave); } }
        GRID_BAR();
        norm_phase<0, false>(F, XB, HB, F.in[F.zz + 22] + l * DM, modl + 3 * DM, modl + 4 * DM);
        GRID_BAR();
        { pg8::Gemm g{HB, (const bf16*)(wl + W_UP), MROWS, UPC, DM}; pg8::StaticOrder S; S.init(MROWS, UPC, F.G, (int)blockIdx.x);
          pg8::EpiConvGate E{ACT, DFF, (float*)(FWS + WS_HALO), F.in[F.zz + 16] + (size_t)l * 3 * UPC, F.in[F.zz + 17] + (size_t)l * UPC, UPC, DFF};
          pg8::gemm_phase<pg8::EpiConvGate, pg8::StaticOrder, true, true>(F.lds, g, S, E, F.wave); }
        if (l == 0 && F.G == 256 && blockIdx.x >= 128) { if (blockIdx.x < 224) adaln_item(F, 1, (int)blockIdx.x - 128); convert_gap(F, 1, 0, CV_C2, ((int)blockIdx.x - 128) * NWAVES + F.wave, 128 * NWAVES, CV_N2); }
        if (l == 1 && F.G == 256 && blockIdx.x >= 128) convert_gap(F, 1, CV_IN + CV_OUT + CV_UP, CV_DN, ((int)blockIdx.x - 128) * NWAVES + F.wave, 128 * NWAVES, CV_N2);
        GRID_BAR();
        conv_fixup_phase(F, l);
        GRID_BAR();
        { pg8::Gemm g{ACT, (const bf16*)(wl + W_DN), MROWS, DM, DFF}; pg8::StaticOrder S; S.init(MROWS, DM, F.G, (int)blockIdx.x);
          pg8::EpiResGate<false> E{XB, XB, DM, modl + 5 * DM, 12288, SEQ};
          pg8::gemm_phase<pg8::EpiResGate<false>, pg8::StaticOrder, true, true>(F.lds, g, S, E, F.wave); }
        GRID_BAR();
}

__global__ void __launch_bounds__(NTHR, 2) mega_fwd(Args args) {
    extern __shared__ __attribute__((aligned(16))) unsigned char lds[];
    Frame F;
    F.lds = (LAS unsigned char*)lds;
    F.tid = threadIdx.x; F.lane = F.tid & 63; F.wave = __builtin_amdgcn_readfirstlane(F.tid >> 6);
    F.G = gridDim.x; { const int bx = blockIdx.x; F.vcu = (F.G % 8 == 0) ? (bx % 8) * (F.G / 8) + bx / 8 : bx; }
    F.in = args.in; F.ws = args.ws; F.zz = 0;
    volatile LAS unsigned* MISC = (volatile LAS unsigned*)(F.lds + MISC_OFF);
    for (int u = F.tid; u < (LDS_BYTES - LDSCTL_OFF) / 4; u += NTHR) ((LAS unsigned*)(F.lds + LDSCTL_OFF))[u] = 0u;
    __syncthreads();
    XcdBarrier bar = xcd_barrier_post((unsigned*)(FWS + WS_CTL) + CW_BAR, MISC + 8, F.tid);

    p0_prologue(F);
    GRID_BAR();
    layer_fwd<0>(F, bar);
    layer_fwd<1>(F, bar);
    norm_phase<1, false>(F, XB, args.out, F.in[F.zz + 23], nullptr, nullptr);
}

extern "C" void kernel_launch(void* const* d_in, const int* in_sizes, int n_in, void* d_out, int out_size, void* d_ws, size_t ws_size, hipStream_t stream) {
    static int grid = 0;
    if (grid == 0) {
        if (n_in != 24 || out_size != MROWS * DM || ws_size < WS_END) { fprintf(stderr, "kernel_launch: unexpected shapes (n_in %d out %d ws %zu)\n", n_in, out_size, ws_size); grid = -1; return; }
        int dev = 0, cus = 0;
        if (hipGetDevice(&dev) != hipSuccess || hipDeviceGetAttribute(&cus, hipDeviceAttributeMultiprocessorCount, dev) != hipSuccess) { grid = -1; return; }
        if (hipFuncSetAttribute((const void*)mega_fwd, hipFuncAttributeMaxDynamicSharedMemorySize, LDS_BYTES) != hipSuccess) { fprintf(stderr, "kernel_launch: hipFuncSetAttribute failed\n"); grid = -1; return; }
        int per_cu = 0;
        if (hipOccupancyMaxActiveBlocksPerMultiprocessor(&per_cu, (const void*)mega_fwd, NTHR, LDS_BYTES) != hipSuccess || per_cu < 1) { fprintf(stderr, "kernel_launch: occupancy query says %d\n", per_cu); }
        (void)hipGetLastError();
        grid = cus;
    }
    if (grid < 0) return;
    (void)hipMemsetAsync((char*)d_ws + WS_CTL, 0, CTL_ZERO_BYTES, stream);
    Args a{};
    for (int i = 0; i < 24; ++i) a.in[i] = (const float*)d_in[i];
    a.out = (float*)d_out; a.ws = (unsigned char*)d_ws;
    hipLaunchKernelGGL(mega_fwd, dim3(grid), dim3(NTHR), LDS_BYTES, stream, a);
}
```

```cpp
#include <hip/hip_runtime.h>
#include <cstdio>
#include <cstdint>
#ifndef MOBA_NP
#define MOBA_NP 2
#endif
#ifndef MOBA_CHECK
#define MOBA_CHECK 0
#endif
__device__ __forceinline__ int tid_from_wave(int wave) { int l = (int)__builtin_amdgcn_mbcnt_hi(~0u, __builtin_amdgcn_mbcnt_lo(~0u, 0u)); asm volatile("" : "+v"(l)); return wave * 64 + l; }
namespace pg8 {
#define PG8_LAS __attribute__((address_space(3)))
typedef unsigned short bf16_t;
typedef short bf16x8 __attribute__((ext_vector_type(8)));
typedef float f32x4 __attribute__((ext_vector_type(4)));
typedef unsigned u32x4 __attribute__((ext_vector_type(4)));
constexpr int BM = 256, BK = 64, HALF = 128, HTB = HALF * BK * 2  , STAGE_BYTES = 8 * HTB, NXCD = 8, WGM = 8;

__host__ __device__ __forceinline__ int lds_byte(int r, int c) { const int st = (r >> 4) * 2 + (c >> 5), rr = r & 15, cc = c & 31, ob = rr * 64 + cc * 2; return st * 1024 + (ob ^ (((ob >> 9) & 1) << 5)); }
__host__ __device__ __forceinline__ void stage_rc(int b, int& R, int& C) { const int st = b / 1024, sb = b % 1024, swz = sb ^ (((sb >> 9) & 1) << 5); R = (st >> 1) * 16 + swz / 64; C = (st & 1) * 32 + (swz % 64) / 2; }
__host__ __device__ __forceinline__ int perm32(int rho) { const int n = rho >> 4, i = rho & 15; return 8 * (i >> 2) + 4 * n + (i & 3); }

struct Unit { int pm, pn; };
struct Gemm { const bf16_t* A; const bf16_t* Bt; int M, N, K; };

struct StaticOrder {
    int nM, nN, nwg, G, c;
    __host__ __device__ void init(int M, int N, int G_, int c_) { nM = M / BM; nN = N / BM; nwg = nM * nN; G = G_; c = c_; }
    __host__ __device__ bool next(int i, Unit& u) const {
        const long L = (long)i * G + c; if (L >= nwg) return false;
        int wgid = (int)L; { const int q = nwg / NXCD, r = nwg % NXCD, xcd = wgid % NXCD, off = wgid / NXCD; wgid = (xcd < r ? xcd * (q + 1) : r * (q + 1) + (xcd - r) * q) + off; }
        const int nig = WGM * nN, gid = wgid / nig, fm = gid * WGM, gsz = (nM - fm) < WGM ? (nM - fm) : WGM;
        u.pm = fm + ((wgid % nig) % gsz); u.pn = (wgid % nig) / gsz; return true;
    }
    __device__ __forceinline__ void a_ready(const Unit&) const {}
    __device__ __forceinline__ void done(const Unit&) const {}
};

__device__ __forceinline__ unsigned cvt_pk_bf16(float lo, float hi) { unsigned r; asm volatile("v_cvt_pk_bf16_f32 %0, %1, %2" : "=v"(r) : "v"(lo), "v"(hi)); return r; }

struct EpiBf16 {
    static constexpr bool PERM = true, AFTER_DRAIN = false;
    bf16_t* O; int ldc;
    __device__ __forceinline__ void operator()(const f32x4 (&acc)[2][2][4][2], const Unit& u, int wr, int wc, int fr, int fq) const {
        const int row0 = u.pm * BM + wr * 64 + fr; const int col0 = u.pn * BM + wc * 32 + 8 * fq;
#pragma unroll
        for (int ai = 0; ai < 2; ++ai)
#pragma unroll
            for (int m = 0; m < 4; ++m) { bf16_t* rowp = O + (size_t)(row0 + ai * HALF + m * 16) * ldc + col0;
#pragma unroll
                for (int bj = 0; bj < 2; ++bj) { const f32x4 v0 = acc[ai][bj][m][0], v1 = acc[ai][bj][m][1];
                    u32x4 w; w.x = cvt_pk_bf16(v0[0], v0[1]); w.y = cvt_pk_bf16(v0[2], v0[3]); w.z = cvt_pk_bf16(v1[0], v1[1]); w.w = cvt_pk_bf16(v1[2], v1[3]);
                    *(u32x4*)(rowp + bj * HALF) = w; } }
    }
};

template <int CTRL> __device__ __forceinline__ float dpp_ror(float v) { return __builtin_bit_cast(float, __builtin_amdgcn_update_dpp(0, __builtin_bit_cast(int, v), CTRL, 0xF, 0xF, true)); }
struct EpiConvGate {
    static constexpr bool PERM = true, AFTER_DRAIN = false;
    bf16_t* A; int lda; float* halo; const float* cw; const float* cb; int nup, dff;
    __device__ __forceinline__ void operator()(const f32x4 (&acc)[2][2][4][2], const Unit& u, int wr, int wc, int fr, int fq) const {
        const int chl = wc * 32 + 8 * fq;
#pragma unroll
        for (int n = 0; n < 2; ++n) {
            const int c = u.pn * 128 + chl + 4 * n, colp = u.pn * 256 + chl + 4 * n;
            const f32x4 wv0 = *(const f32x4*)(cw + c), wv1 = *(const f32x4*)(cw + nup + c), wv2 = *(const f32x4*)(cw + 2 * nup + c), bv = *(const f32x4*)(cb + c);
            const f32x4 wg0 = *(const f32x4*)(cw + dff + c), wg1 = *(const f32x4*)(cw + nup + dff + c), wg2 = *(const f32x4*)(cw + 2 * nup + dff + c), bg = *(const f32x4*)(cb + dff + c);
#pragma unroll
            for (int ai = 0; ai < 2; ++ai) {
                const int grow = u.pm * BM + ai * HALF + wr * 64;
                float* hb = halo + (size_t)(grow >> 6) * 4 * nup + colp;
                if (fr < 2) { *(f32x4*)(hb + (size_t)fr * nup) = acc[ai][0][0][n]; *(f32x4*)(hb + (size_t)fr * nup + 128) = acc[ai][1][0][n]; }
                if (fr >= 14) { *(f32x4*)(hb + (size_t)(fr - 12) * nup) = acc[ai][0][3][n]; *(f32x4*)(hb + (size_t)(fr - 12) * nup + 128) = acc[ai][1][3][n]; }
                f32x4 cv[4];
                {   f32x4 P1 = {0.f, 0.f, 0.f, 0.f}, P2 = P1;
#pragma unroll
                    for (int m = 0; m < 4; ++m) { f32x4 R1, R2;
#pragma unroll
                        for (int e = 0; e < 4; ++e) { R1[e] = dpp_ror<0x121>(acc[ai][0][m][n][e]); R2[e] = dpp_ror<0x122>(acc[ai][0][m][n][e]); }
                        const f32x4 p1 = (fr >= 1) ? R1 : P1, p2 = (fr >= 2) ? R2 : P2; P1 = R1; P2 = R2;
                        cv[m] = wv0 * p2 + wv1 * p1 + wv2 * acc[ai][0][m][n] + bv; } }
                {   f32x4 P1 = {0.f, 0.f, 0.f, 0.f}, P2 = P1;
#pragma unroll
                    for (int m = 0; m < 4; ++m) { f32x4 R1, R2;
#pragma unroll
                        for (int e = 0; e < 4; ++e) { R1[e] = dpp_ror<0x121>(acc[ai][1][m][n][e]); R2[e] = dpp_ror<0x122>(acc[ai][1][m][n][e]); }
                        const f32x4 p1 = (fr >= 1) ? R1 : P1, p2 = (fr >= 2) ? R2 : P2; P1 = R1; P2 = R2;
                        const f32x4 cg = wg0 * p2 + wg1 * p1 + wg2 * acc[ai][1][m][n] + bg;
                        f32x4 o;
#pragma unroll
                        for (int e = 0; e < 4; ++e) o[e] = cg[e] * __builtin_amdgcn_rcpf(1.0f + __expf(-cg[e])) * cv[m][e];
                        unsigned w0 = cvt_pk_bf16(o[0], o[1]), w1 = cvt_pk_bf16(o[2], o[3]);
                        *(unsigned long long*)(A + (size_t)(grow + m * 16 + fr) * lda + c) = (unsigned long long)w0 | ((unsigned long long)w1 << 32); } }
            }
        }
    }
};

template <bool BASE_F32>
struct EpiResGate {
    static constexpr bool PERM = true, AFTER_DRAIN = false;
    const void* base; bf16_t* out; int ldc; const float* gate; int gstride; int rows_per_batch;
    __device__ __forceinline__ void operator()(const f32x4 (&acc)[2][2][4][2], const Unit& u, int wr, int wc, int fr, int fq) const {
        const int col0 = u.pn * BM + wc * 32 + 8 * fq;
        const int b = (u.pm * BM) / rows_per_batch;
        f32x4 gv[2][2];
#pragma unroll
        for (int bj = 0; bj < 2; ++bj)
#pragma unroll
            for (int n = 0; n < 2; ++n) gv[bj][n] = *(const f32x4*)(gate + (size_t)b * gstride + col0 + bj * HALF + n * 4);
#pragma unroll
        for (int ai = 0; ai < 2; ++ai)
#pragma unroll
            for (int m = 0; m < 4; ++m) { const size_t off = (size_t)(u.pm * BM + ai * HALF + wr * 64 + m * 16 + fr) * ldc + col0;
#pragma unroll
                for (int bj = 0; bj < 2; ++bj) { f32x4 b0, b1;
                    if (BASE_F32) { b0 = *(const f32x4*)((const float*)base + off + bj * HALF); b1 = *(const f32x4*)((const float*)base + off + bj * HALF + 4); }
                    else { const u32x4 w = *(const u32x4*)((const bf16_t*)base + off + bj * HALF);
                        b0 = (f32x4){__builtin_bit_cast(float, w.x << 16), __builtin_bit_cast(float, w.x & 0xffff0000u), __builtin_bit_cast(float, w.y << 16), __builtin_bit_cast(float, w.y & 0xffff0000u)};
                        b1 = (f32x4){__builtin_bit_cast(float, w.z << 16), __builtin_bit_cast(float, w.z & 0xffff0000u), __builtin_bit_cast(float, w.w << 16), __builtin_bit_cast(float, w.w & 0xffff0000u)}; }
                    const f32x4 o0 = b0 + gv[bj][0] * acc[ai][bj][m][0], o1 = b1 + gv[bj][1] * acc[ai][bj][m][1];
                    u32x4 w; w.x = cvt_pk_bf16(o0[0], o0[1]); w.y = cvt_pk_bf16(o0[2], o0[3]); w.z = cvt_pk_bf16(o1[0], o1[1]); w.w = cvt_pk_bf16(o1[2], o1[3]);
                    *(u32x4*)(out + off + bj * HALF) = w; }
                if (m & 1) asm volatile("" ::: "memory"); }
    }
};

template <class Epi, class Sched, bool ALIGN_EPI = false, bool SP2 = false>
__device__ __forceinline__ void gemm_phase(PG8_LAS unsigned char* lds, const Gemm g, const Sched& S, const Epi& E, int wave_) {
    const int tid_ = tid_from_wave(wave_);
    const int tid = tid_, wid = __builtin_amdgcn_readfirstlane(tid >> 6), lane = tid & 63, wr = wid >> 2, wc = wid & 3, fr = lane & 15, fq = lane >> 4;
    const int K = g.K, nt = K / BK;
    unsigned voffA[2], voffB[2];
#pragma unroll
    for (int i = 0; i < 2; ++i) { int R, C; stage_rc(tid * 16 + i * 8192, R, C); const int Rb = Epi::PERM ? ((R & ~31) + perm32(R & 31)) : R;
        voffA[i] = (unsigned)(R * K + C) * 2u; voffB[i] = (unsigned)(Rb * K + C) * 2u; }
    const size_t kstep = (size_t)(BK * 2);
    const size_t hstep = (size_t)HALF * K * 2;
    const size_t tstep = 2 * hstep;
    const unsigned ldsw = (unsigned)wid * 1024u;
    const int aoff = lds_byte(wr * 64 + fr, fq * 8), boff = lds_byte(wc * 32 + fr, fq * 8);
#define PG8_SA(b, h) (((b) * 2 + (h)) * HTB)
#define PG8_SB(b, h) ((4 + (b) * 2 + (h)) * HTB)
#define PG8_STAGE(bufoff, gbase, voff) do { _Pragma("unroll") for (int _i = 0; _i < 2; ++_i) \
        __builtin_amdgcn_global_load_lds((const unsigned*)((const char*)(gbase) + (voff)[_i]), (PG8_LAS unsigned*)(lds + (bufoff) + ldsw + _i * 8192), 16, 0, 0); } while (0)
#define PG8_LDA(dst, b, h) do { _Pragma("unroll") for (int m = 0; m < 4; ++m) _Pragma("unroll") for (int k = 0; k < 2; ++k) dst[m][k] = *(const PG8_LAS bf16x8*)(lds + PG8_SA(b, h) + aoff + m * 2048 + k * 1024); } while (0)
#define PG8_LDB(dst, b, h) do { _Pragma("unroll") for (int n = 0; n < 2; ++n) _Pragma("unroll") for (int k = 0; k < 2; ++k) dst[n][k] = *(const PG8_LAS bf16x8*)(lds + PG8_SB(b, h) + boff + n * 2048 + k * 1024); } while (0)
#define PG8_MMA(ai, bj, At, Bt) do { __builtin_amdgcn_s_setprio(1); _Pragma("unroll") for (int m = 0; m < 4; ++m) _Pragma("unroll") for (int n = 0; n < 2; ++n) _Pragma("unroll") for (int k = 0; k < 2; ++k) \
        acc[ai][bj][m][n] = __builtin_amdgcn_mfma_f32_16x16x32_bf16(Bt[n][k], At[m][k], acc[ai][bj][m][n], 0, 0, 0); __builtin_amdgcn_s_setprio(0); } while (0)
#define PG8_WAIT_V(n) asm volatile("s_waitcnt vmcnt(" #n ")" ::: "memory")
#define PG8_WAIT_L(n) asm volatile("s_waitcnt lgkmcnt(" #n ")" ::: "memory")
#define PG8_BAR __builtin_amdgcn_s_barrier()
#define PG8_SCHED __builtin_amdgcn_sched_barrier(0)
    Unit cur, nxt; int ui = 0;
    if (!S.next(0, cur)) return;
    f32x4 acc[2][2][4][2];
#pragma unroll
    for (int a = 0; a < 2; ++a)
#pragma unroll
        for (int b = 0; b < 2; ++b)
#pragma unroll
            for (int m = 0; m < 4; ++m)
#pragma unroll
                for (int n = 0; n < 2; ++n) acc[a][b][m][n] = (f32x4){0.f, 0.f, 0.f, 0.f};
    bf16x8 At[4][2], B0[2][2], B1[2][2];
    const char* cA = (const char*)g.A + (size_t)cur.pm * tstep; const char* cB = (const char*)g.Bt + (size_t)cur.pn * tstep;
    S.a_ready(cur);
    if constexpr (SP2) {
        PG8_STAGE(PG8_SB(0, 0), cB, voffB); PG8_STAGE(PG8_SB(0, 1), cB + hstep, voffB); PG8_STAGE(PG8_SA(0, 0), cA, voffA); PG8_STAGE(PG8_SA(0, 1), cA + hstep, voffA);
        if (wr == 1) PG8_BAR;
        PG8_WAIT_V(2); PG8_BAR;
        PG8_STAGE(PG8_SB(1, 0), cB + kstep, voffB); PG8_STAGE(PG8_SA(1, 0), cA + kstep, voffA); PG8_STAGE(PG8_SB(1, 1), cB + hstep + kstep, voffB);
        PG8_WAIT_V(6); PG8_BAR;
    } else {
        PG8_STAGE(PG8_SB(0, 0), cB, voffB); PG8_STAGE(PG8_SA(0, 0), cA, voffA); PG8_STAGE(PG8_SB(0, 1), cB + hstep, voffB); PG8_STAGE(PG8_SA(0, 1), cA + hstep, voffA);
        if (wr == 1) PG8_BAR;
        PG8_WAIT_V(4); PG8_BAR;
        PG8_STAGE(PG8_SB(1, 0), cB + kstep, voffB); PG8_STAGE(PG8_SA(1, 0), cA + kstep, voffA); PG8_STAGE(PG8_SB(1, 1), cB + hstep + kstep, voffB);
        PG8_WAIT_V(6); PG8_BAR;
    }
    for (;;) {
        const bool has_next = S.next(ui + 1, nxt);
        const char* nA = has_next ? (const char*)g.A + (size_t)nxt.pm * tstep : cA; const char* nB = has_next ? (const char*)g.Bt + (size_t)nxt.pn * tstep : cB;
        for (int t = 0; t < nt; t += 2) {
            const bool last = (t == nt - 2);
            const char* a1 = cA + (size_t)(t + 1) * kstep;
            const char* a2 = last ? nA : cA + (size_t)(t + 2) * kstep; const char* b2 = last ? nB : cB + (size_t)(t + 2) * kstep;
            const char* a3 = a2 + kstep; const char* b3 = b2 + kstep;
            if (last && has_next) S.a_ready(nxt);
            if constexpr (SP2) {
            PG8_LDB(B0, 0, 0); PG8_LDB(B1, 0, 1); PG8_SCHED; PG8_LDA(At, 0, 0); PG8_STAGE(PG8_SA(1, 1), a1 + hstep, voffA);
            PG8_WAIT_V(8); PG8_WAIT_L(0); PG8_BAR; PG8_MMA(0, 0, At, B0); PG8_MMA(0, 1, At, B1); PG8_BAR; PG8_SCHED;
            PG8_LDA(At, 0, 1); PG8_STAGE(PG8_SB(0, 0), b2, voffB); PG8_STAGE(PG8_SB(0, 1), b2 + hstep, voffB); PG8_STAGE(PG8_SA(0, 0), a2, voffA);
            PG8_WAIT_V(8); PG8_WAIT_L(0); PG8_BAR; PG8_MMA(1, 0, At, B0); PG8_MMA(1, 1, At, B1); PG8_BAR; PG8_SCHED;
            PG8_LDB(B0, 1, 0); PG8_LDB(B1, 1, 1); PG8_SCHED; PG8_LDA(At, 1, 0); PG8_STAGE(PG8_SA(0, 1), a2 + hstep, voffA);
            PG8_WAIT_V(8); PG8_WAIT_L(0); PG8_BAR; PG8_MMA(0, 0, At, B0); PG8_MMA(0, 1, At, B1); PG8_BAR; PG8_SCHED;
            PG8_LDA(At, 1, 1); PG8_STAGE(PG8_SB(1, 0), b3, voffB); PG8_STAGE(PG8_SB(1, 1), b3 + hstep, voffB); PG8_STAGE(PG8_SA(1, 0), a3, voffA);
            PG8_WAIT_V(8); PG8_WAIT_L(0); PG8_BAR; PG8_MMA(1, 0, At, B0); PG8_MMA(1, 1, At, B1); PG8_BAR; PG8_SCHED;
            } else {
            PG8_LDB(B0, 0, 0); PG8_SCHED; PG8_LDA(At, 0, 0); PG8_STAGE(PG8_SA(1, 1), a1 + hstep, voffA);
            PG8_WAIT_L(8); PG8_BAR; PG8_WAIT_L(0); PG8_MMA(0, 0, At, B0); PG8_BAR; PG8_SCHED;
            PG8_LDB(B1, 0, 1); PG8_STAGE(PG8_SB(0, 0), b2, voffB);
            PG8_BAR; PG8_WAIT_L(0); PG8_MMA(0, 1, At, B1); PG8_BAR;
            PG8_LDA(At, 0, 1); PG8_STAGE(PG8_SA(0, 0), a2, voffA);
            PG8_BAR; PG8_WAIT_L(0); PG8_MMA(1, 0, At, B0); PG8_BAR; PG8_SCHED;
            PG8_STAGE(PG8_SB(0, 1), b2 + hstep, voffB);
            PG8_WAIT_V(6); PG8_BAR; PG8_MMA(1, 1, At, B1); PG8_BAR;
            PG8_LDB(B0, 1, 0); PG8_SCHED; PG8_LDA(At, 1, 0); PG8_STAGE(PG8_SA(0, 1), a2 + hstep, voffA);
            PG8_WAIT_L(8); PG8_BAR; PG8_WAIT_L(0); PG8_MMA(0, 0, At, B0); PG8_BAR; PG8_SCHED;
            PG8_LDB(B1, 1, 1); PG8_STAGE(PG8_SB(1, 0), b3, voffB);
            PG8_BAR; PG8_WAIT_L(0); PG8_MMA(0, 1, At, B1); PG8_BAR;
            PG8_LDA(At, 1, 1); PG8_STAGE(PG8_SA(1, 0), a3, voffA);
            PG8_BAR; PG8_WAIT_L(0); PG8_MMA(1, 0, At, B0); PG8_BAR; PG8_SCHED;
            PG8_STAGE(PG8_SB(1, 1), b3 + hstep, voffB);
            PG8_WAIT_V(6); PG8_BAR; PG8_MMA(1, 1, At, B1); PG8_BAR;
            }
        }
        if constexpr (ALIGN_EPI) { if (wr == 0) PG8_BAR; }
        if constexpr (!Epi::AFTER_DRAIN) { E(acc, cur, wr, wc, fr, fq); S.done(cur); }
        if (!has_next) break;
#pragma unroll
        for (int a = 0; a < 2; ++a)
#pragma unroll
            for (int b = 0; b < 2; ++b)
#pragma unroll
                for (int m = 0; m < 4; ++m)
#pragma unroll
                    for (int n = 0; n < 2; ++n) acc[a][b][m][n] = (f32x4){0.f, 0.f, 0.f, 0.f};
        cur = nxt; cA = nA; cB = nB; ++ui;
        if constexpr (ALIGN_EPI) { if (wr == 1) PG8_BAR; }
    }
    PG8_WAIT_V(0);
    if constexpr (!ALIGN_EPI) { if (wr == 0) PG8_BAR; }
    PG8_BAR;
    if constexpr (Epi::AFTER_DRAIN) { E.fused(acc, cur, wr, wc, fr, fq, lds, wid, lane); S.done(cur); }
#undef PG8_SA
#undef PG8_SB
#undef PG8_STAGE
#undef PG8_LDA
#undef PG8_LDB
#undef PG8_MMA
#undef PG8_WAIT_V
#undef PG8_WAIT_L
#undef PG8_BAR
#undef PG8_SCHED
}
}

namespace moba {
using bf16 = unsigned short;
typedef short bf16x8 __attribute__((ext_vector_type(8)));
typedef short s16x4 __attribute__((ext_vector_type(4)));
typedef float f32x16 __attribute__((ext_vector_type(16)));
typedef float f32x4 __attribute__((ext_vector_type(4)));
typedef unsigned u32x4 __attribute__((ext_vector_type(4)));
#define MLAS __attribute__((address_space(3)))
typedef MLAS char lchar; typedef MLAS float lfloat; typedef MLAS bf16x8 lbf16x8;
template <class A, class Bt> struct same_t { static constexpr bool v = false; };
template <class A> struct same_t<A, A> { static constexpr bool v = true; };
constexpr int D = 128, LDI = 6656, LDO = 2048;
constexpr float THR = 8.f;
constexpr bool WSKIP = false;
constexpr float SCALE = 0.08838834764831845f;
constexpr int NW = 8, QBLK = 32, KVBLK = 64, QB = NW * QBLK;
constexpr int SHM_V = KVBLK * D * 2, SHM_K = KVBLK * D * 2;
constexpr int LDS_BYTES = 2 * SHM_V + 2 * SHM_K + NW * 64 * 4;
#define KSWZ(row, colB) ((row) * 256 + ((colB) ^ (((row) & 7) << 4)))
#define SBAR() __builtin_amdgcn_sched_barrier(0)
__device__ __forceinline__ int v_st(int k, int c) { const int kk = (k & ~0xC) | ((k & 4) << 1) | ((k & 8) >> 1); return ((kk >> 3) * 4 + (c >> 5)) * 512 + ((kk & 7) * 32 + (c & 31)) * 2; }
__device__ __forceinline__ int v_rd_base(int lane) { return ((lane & 3) << 3) | (((lane >> 2) & 3) << 6) | (((lane >> 4) & 1) << 5) | (((lane >> 5) & 1) << 8); }
constexpr int v_rd_off(int d0, int ks, int half) { return d0 * 512 + ks * 4096 + half * 2048; }
__device__ __forceinline__ int crow(int r, int hi) { return (r & 3) + 8 * (r >> 2) + 4 * hi; }
__device__ __forceinline__ unsigned cvtpk(float lo, float hi) {
    unsigned r; asm volatile("v_cvt_pk_bf16_f32 %0, %1, %2" : "=v"(r) : "v"(lo), "v"(hi)); return r;
}
__device__ __forceinline__ bf16x8 pack8(f32x4 a, f32x4 b) {
    u32x4 w = {cvtpk(a[0], a[1]), cvtpk(a[2], a[3]), cvtpk(b[0], b[1]), cvtpk(b[2], b[3])};
    return *reinterpret_cast<bf16x8*>(&w);
}
template <class T> __device__ __forceinline__ bf16x8 load8(const T* p) {
    if constexpr (same_t<T, float>::v) { return pack8(*(const f32x4*)p, *(const f32x4*)(p + 4)); }
    else { return *reinterpret_cast<const bf16x8*>(p); }
}
__device__ __forceinline__ void mask_tile(f32x16& p0, f32x16& p1, int dq, unsigned W) {
    const float NEG = -__builtin_inff();
#pragma unroll
    for (int r = 0; r < 16; ++r) {
        const int c = (r & 3) + 8 * (r >> 2);
        if ((unsigned)(dq - c) >= W) p0[r] = NEG;
        if ((unsigned)(dq - c - 32) >= W) p1[r] = NEG;
    }
}
__device__ __forceinline__ void partialSM(f32x16& p0, f32x16& p1, float& m_reg, float& mn, float& alpha) {
    float pmax = p0[0]; for (int r = 1; r < 16; ++r) pmax = fmaxf(pmax, p0[r]); for (int r = 0; r < 16; ++r) pmax = fmaxf(pmax, p1[r]);
    { auto rr = __builtin_amdgcn_permlane32_swap(__float_as_uint(pmax), __float_as_uint(pmax), false, false);
      pmax = fmaxf(__uint_as_float(rr[0]), __uint_as_float(rr[1])); }
    constexpr float C2 = 1.4426950408889634f * SCALE;
    if (__builtin_expect(__all((pmax - m_reg) * SCALE <= THR), 1)) { mn = m_reg; alpha = 1.f; }
    else { mn = fmaxf(m_reg, pmax); alpha = __builtin_amdgcn_exp2f((m_reg - mn) * C2); m_reg = mn; }
    const float mnL = -mn * C2;
    for (int r = 0; r < 16; ++r) p0[r] = fmaf(p0[r], C2, mnL); for (int r = 0; r < 16; ++r) p1[r] = fmaf(p1[r], C2, mnL);
    for (int r = 0; r < 16; ++r) p0[r] = __builtin_amdgcn_exp2f(p0[r]);
}
__device__ __forceinline__ void finishSM(f32x16& p0, f32x16& p1, float alpha, float& l_reg, bf16x8& pa0, bf16x8& pa1, bf16x8& pa2, bf16x8& pa3) {
    for (int r = 0; r < 16; ++r) p1[r] = __builtin_amdgcn_exp2f(p1[r]);
    float ps = 0; for (int r = 0; r < 16; ++r) ps += p0[r]; for (int r = 0; r < 16; ++r) ps += p1[r];
    { auto rr = __builtin_amdgcn_permlane32_swap(__float_as_uint(ps), __float_as_uint(ps), false, false);
      ps = __uint_as_float(rr[0]) + __uint_as_float(rr[1]); }
    l_reg = l_reg * alpha + ps;
#define PK4(P, B_, OUT) do { unsigned a0 = cvtpk(P[B_+0], P[B_+1]), a1 = cvtpk(P[B_+2], P[B_+3]);                          \
        unsigned b0 = cvtpk(P[B_+4], P[B_+5]), b1 = cvtpk(P[B_+6], P[B_+7]);                                             \
        auto r0 = __builtin_amdgcn_permlane32_swap(a0, b0, false, false); auto r1 = __builtin_amdgcn_permlane32_swap(a1, b1, false, false); \
        u32x4 w = {r0[0], r1[0], r0[1], r1[1]}; OUT = *reinterpret_cast<bf16x8*>(&w); } while (0)
    PK4(p0, 0, pa0); PK4(p0, 8, pa1); PK4(p1, 0, pa2); PK4(p1, 8, pa3);
#undef PK4
}
template <int KB, bool SK>
__device__ __forceinline__ void qkt(f32x16& p0, f32x16& p1, const lchar* K_lds, int r32, int hi, const bf16x8* qr, bool act, float slopeR, float lb) {
    if (SK && !act) { const float NEG = -__builtin_inff();
#pragma unroll
        for (int r = 0; r < 16; ++r) { p0[r] = NEG; p1[r] = NEG; } return; }
#pragma unroll
    for (int r = 0; r < 16; ++r) { const int c = (r & 3) + 8 * (r >> 2); p0[r] = __builtin_fmaf(slopeR, (float)c, lb); p1[r] = __builtin_fmaf(slopeR, (float)(c + 32), lb); }
    const lchar* kb[4];
#pragma unroll
    for (int dd = 0; dd < 4; ++dd) kb[dd] = K_lds + KB * SHM_K + KSWZ(r32, (dd * 16 + hi * 8) * 2);
#pragma unroll
    for (int d0 = 0; d0 < 8; ++d0) { const lchar* a = kb[d0 & 3] + (d0 >> 2) * 128;
        bf16x8 b0 = *(const lbf16x8*)(a);
        bf16x8 b1 = *(const lbf16x8*)(a + 32 * 256);
        p0 = __builtin_amdgcn_mfma_f32_32x32x16_bf16(b0, qr[d0], p0, 0, 0, 0);
        p1 = __builtin_amdgcn_mfma_f32_32x32x16_bf16(b1, qr[d0], p1, 0, 0, 0); }
}
template <int VB, bool SK>
__device__ __forceinline__ void pv_tile(f32x16* o, int vb0, bf16x8 pa0, bf16x8 pa1, bf16x8 pa2, bf16x8 pa3, bool act) {
    if (SK && !act) return;
#define TRRD(dst, off) asm volatile("ds_read_b64_tr_b16 %0, %1 offset:%2" : "=&v"(dst) : "v"(vb0), "i"(off) : "memory")
#define PV_D0(d0) do { s16x4 l0, l1, l2, l3, h0, h1, h2, h3; constexpr int b_ = VB * SHM_V + v_rd_off(d0, 0, 0);     \
        TRRD(l0, b_); TRRD(h0, b_ + 2048); TRRD(l1, b_ + 4096); TRRD(h1, b_ + 6144); TRRD(l2, b_ + 8192); TRRD(h2, b_ + 10240); TRRD(l3, b_ + 12288); TRRD(h3, b_ + 14336); \
        asm volatile("s_waitcnt lgkmcnt(0)" ::: "memory"); SBAR();                 \
        o[d0] = __builtin_amdgcn_mfma_f32_32x32x16_bf16(pa0, (bf16x8){l0[0], l0[1], l0[2], l0[3], h0[0], h0[1], h0[2], h0[3]}, o[d0], 0, 0, 0);   \
        o[d0] = __builtin_amdgcn_mfma_f32_32x32x16_bf16(pa1, (bf16x8){l1[0], l1[1], l1[2], l1[3], h1[0], h1[1], h1[2], h1[3]}, o[d0], 0, 0, 0);   \
        o[d0] = __builtin_amdgcn_mfma_f32_32x32x16_bf16(pa2, (bf16x8){l2[0], l2[1], l2[2], l2[3], h2[0], h2[1], h2[2], h2[3]}, o[d0], 0, 0, 0);   \
        o[d0] = __builtin_amdgcn_mfma_f32_32x32x16_bf16(pa3, (bf16x8){l3[0], l3[1], l3[2], l3[3], h3[0], h3[1], h3[2], h3[3]}, o[d0], 0, 0, 0); } while (0)
    PV_D0(0); PV_D0(1); PV_D0(2); PV_D0(3);
#undef PV_D0
#undef TRRD
}

typedef __attribute__((address_space(1))) char gchar; typedef __attribute__((address_space(1))) bf16x8 gbf16x8;
__device__ __forceinline__ const gchar* uni_ptr(const char* p) { const unsigned long long v = (unsigned long long)p;
    const unsigned lo = __builtin_amdgcn_readfirstlane((unsigned)v), hi = __builtin_amdgcn_readfirstlane((unsigned)(v >> 32)); return (const gchar*)(((unsigned long long)hi << 32) | lo); }
template <class TIn, class TOut> struct BlockRef { const TIn* Q; const TIn* K; const TIn* V; TOut* O; int P0; const __attribute__((address_space(3))) unsigned* sel; float slopeR; };
template <class TIn> struct Seam {
    bf16x8 qr[8];
    bf16x8 st_v0, st_v1, st_k0, st_k1; f32x4 sf0, sf1, sf2, sf3;
    f32x4 tq[16];
};
__device__ __forceinline__ int swa_jlo(int P0, int W) { const int lowk = P0 - W + 1; return lowk > 0 ? lowk / KVBLK : 0; }
#define ROW(p, k0, rr) ((const TIn*)((const char*)(p) + (size_t)(k0) * (LDI * sizeof(TIn)) + (unsigned)(((rr) * LDI + sc) * (int)sizeof(TIn))))
#define VMW() asm volatile("s_waitcnt vmcnt(0)" ::: "memory")
#define VMWN(n) asm volatile("s_waitcnt vmcnt(%0)" :: "i"(n) : "memory")
#define SLOAD_H(Kp, Vp, k0) do { const gchar* kb__ = uni_ptr((const char*)(Kp) + (size_t)(k0) * (LDI * sizeof(TIn))); const gchar* vb__ = uni_ptr((const char*)(Vp) + (size_t)(k0) * (LDI * sizeof(TIn))); \
                         S.st_v0 = *(const gbf16x8*)(vb__ + roff0); S.st_v1 = *(const gbf16x8*)(vb__ + roff1);              \
                         S.st_k0 = *(const gbf16x8*)(kb__ + roff0); S.st_k1 = *(const gbf16x8*)(kb__ + roff1); } while (0)
#define SWRITE_HK(bf) do { *(lbf16x8*)(K_lds + (bf) * SHM_K + kws) = S.st_k0; *(lbf16x8*)(K_lds + (bf) * SHM_K + kws + 32 * 256) = S.st_k1; } while (0)
#define SWRITE_HV(bf) do { *(lbf16x8*)(V_lds + (bf) * SHM_V + vst0) = S.st_v0; *(lbf16x8*)(V_lds + (bf) * SHM_V + vst1) = S.st_v1; } while (0)
#define SWRITE_H(bf) do { SWRITE_HV(bf); SWRITE_HK(bf); } while (0)
#define SLOAD_F(p, k0) do { S.sf0 = *(const f32x4*)ROW(p, k0, sr); S.sf1 = *(const f32x4*)(ROW(p, k0, sr) + 4);                \
                            S.sf2 = *(const f32x4*)ROW(p, k0, 32 + sr); S.sf3 = *(const f32x4*)(ROW(p, k0, 32 + sr) + 4); } while (0)
#define SWRITE_KF(bf) do { *(lbf16x8*)(K_lds + (bf) * SHM_K + kws) = pack8(S.sf0, S.sf1); *(lbf16x8*)(K_lds + (bf) * SHM_K + kws + 32 * 256) = pack8(S.sf2, S.sf3); } while (0)
#define SWRITE_VF(bf) do { *(lbf16x8*)(V_lds + (bf) * SHM_V + vst0) = pack8(S.sf0, S.sf1); *(lbf16x8*)(V_lds + (bf) * SHM_V + vst1) = pack8(S.sf2, S.sf3); } while (0)
template <class TIn, class TOut>
__device__ __forceinline__ void causal_swa_prime(const BlockRef<TIn, TOut>& cur, int W, lchar* lds, Seam<TIn>& S, int wave_) {
    constexpr bool F32 = same_t<TIn, float>::v;
    const int tid_ = tid_from_wave(wave_);
    const int tid = tid_, wid = __builtin_amdgcn_readfirstlane(tid >> 6), lane = tid & 63, r32 = lane & 31, hi = lane >> 5;
    const int sr = tid >> 4, sc = (tid & 15) * 8, kws = KSWZ(sr, sc * 2); lchar* K_lds = lds + 2 * SHM_V;
    const unsigned roff0 = (unsigned)((sr * LDI + sc) * (int)sizeof(TIn)), roff1 = (unsigned)(((32 + sr) * LDI + sc) * (int)sizeof(TIn));
    const int kb0 = ((cur.P0 + QB - 1) / KVBLK) * KVBLK;
    for (int d0 = 0; d0 < 8; ++d0) S.qr[d0] = *(const gbf16x8*)(uni_ptr((const char*)cur.Q) + (unsigned)(((wid * QBLK + r32) * LDI + hi * 8) * (int)sizeof(TIn)) + d0 * 16 * sizeof(TIn));
    if constexpr (F32) { SLOAD_F((const float*)cur.K, kb0); VMW(); SWRITE_KF(0); SBAR(); SLOAD_F((const float*)cur.V, kb0); }
    else { SLOAD_H(cur.K, cur.V, kb0); VMW(); SWRITE_HK(0); }
    __syncthreads();
}
template <class TIn, class TOut>
__device__ __forceinline__ void causal_swa_block(const BlockRef<TIn, TOut>& cur, const BlockRef<TIn, TOut>& nxt, int skv, int W, lchar* lds, Seam<TIn>& S, int wave_) {
    constexpr bool F32 = same_t<TIn, float>::v;
    const int tid_ = tid_from_wave(wave_);
    const int tid = tid_, wid = __builtin_amdgcn_readfirstlane(tid >> 6), lane = tid & 63, r32 = lane & 31, hi = lane >> 5;
    const int j_lo = swa_jlo(cur.P0, W);
    int j_hi = (cur.P0 + QB - 1) / KVBLK + 1; if (j_hi > skv / KVBLK) j_hi = skv / KVBLK;
    const int NT = j_hi - j_lo;
    const int kbn = ((nxt.P0 + QB - 1) / KVBLK) * KVBLK;
    const unsigned selm = cur.sel[wid * QBLK + r32] | (1u << (cur.P0 >> 8)); const float slopeR = __builtin_bit_cast(float, __builtin_amdgcn_readfirstlane(__builtin_bit_cast(unsigned, cur.slopeR))); const int tqm = cur.P0 + wid * QBLK + r32 - 4 * hi;
#define LB(t) (((selm >> (KBASE(t) >> 8)) & 1u) ? slopeR * (float)(KBASE(t) - tqm) : -__builtin_inff())
    const int qlo = cur.P0 + wid * QBLK, qm = qlo + r32 - 4 * hi;
    lchar* V_lds = lds; lchar* K_lds = lds + 2 * SHM_V;
    lfloat* ws = (lfloat*)(lds + 2 * SHM_V + 2 * SHM_K) + wid * 64; lfloat* li_l = ws; lfloat* al_l = ws + 32;
    float m_reg = -1e30f, l_reg = 0; f32x16 o[4] = {};
    const unsigned roff0 = (unsigned)(((tid >> 4) * LDI + (tid & 15) * 8) * (int)sizeof(TIn)), roff1 = (unsigned)(((32 + (tid >> 4)) * LDI + (tid & 15) * 8) * (int)sizeof(TIn));
    const int sr = tid >> 4, sc = (tid & 15) * 8, vst0 = v_st(sr, sc), vst1 = v_st(32 + sr, sc), kws = KSWZ(sr, sc * 2);
    const int vb0 = (int)(unsigned)(uintptr_t)V_lds + v_rd_base(lane);
    const TIn* Kh = cur.K; const TIn* Vh = cur.V;
#define RESC(a) do { if (__any((a) < 1.f)) { if (hi == 0) al_l[r32] = (a); asm volatile("s_waitcnt lgkmcnt(0)" ::: "memory");              \
                     for (int d_ = 0; d_ < 4; ++d_) for (int r = 0; r < 16; ++r) o[d_][r] *= al_l[crow(r, hi)]; } } while (0)
#define KBASE(t) ((j_hi - 1 - (t)) * KVBLK)
#define ACT(t) (KBASE(t) <= qlo + QBLK - 1 && KBASE(t) + KVBLK - 1 >= qlo - W + 1)
#define MASKT(P0_, P1_, t) do { const int kb_ = KBASE(t); if ((!SK || ACT(t)) && (kb_ + KVBLK - 1 > qlo || kb_ <= qlo + QBLK - 1 - W)) mask_tile(P0_, P1_, qm - kb_, (unsigned)W); } while (0)
    constexpr int NQL = F32 ? 16 : 8;
    constexpr bool SK = WSKIP && !F32;
#define SEAM_K0() do { VMWN(NQL); if constexpr (F32) { SWRITE_KF(0); SBAR(); SLOAD_F((const float*)nxt.V, kbn); } else { SWRITE_HK(0); } SBAR(); } while (0)
    unsigned touch_reg = 0u; const int tl_ = wid * 32 + (lane & 31);
    const unsigned toff = (unsigned)(((tl_ & 127) >> 1) * LDI * (int)sizeof(TIn) + (tl_ & 1) * 128);
    const gchar* tbase = uni_ptr((const char*)((tl_ >> 7) ? (const void*)Vh : (const void*)Kh));
#if MOBA_CHECK
#define TOUCH(k0) do {} while (0)
#else
#define TOUCH(k0) do { const gchar* tp_ = tbase + (size_t)(k0) * (LDI * sizeof(TIn)) + toff; asm volatile("global_load_dword %0, %1, off" : "+v"(touch_reg) : "v"(tp_) : "memory"); } while (0)
#endif
    f32x16 pA0, pA1, pB0, pB1; float mnA, mnB, alA, alB; bf16x8 pa0, pa1, pa2, pa3;
    if constexpr (F32) { VMW(); SWRITE_VF(0); SBAR(); } else { SWRITE_HV(0); SBAR(); }
    if (NT > 1) { if constexpr (F32) SLOAD_F((const float*)Kh, KBASE(1)); else SLOAD_H(Kh, Vh, KBASE(1)); }
    SBAR(); qkt<0, SK>(pA0, pA1, K_lds, r32, hi, S.qr, ACT(0), slopeR, LB(0));
    if constexpr (F32) { if (NT > 1) { VMW(); SWRITE_KF(1); SBAR(); SLOAD_F((const float*)Vh, KBASE(1)); } }
    MASKT(pA0, pA1, 0); partialSM(pA0, pA1, m_reg, mnA, alA);
    if (NT > 1) { VMW(); if constexpr (F32) { SWRITE_VF(1); SBAR(); if (NT > 2) SLOAD_F((const float*)Kh, KBASE(2)); } else SWRITE_H(1); }
    __syncthreads();
#define HALF_STEP(PX0, PX1, mnX, alX, PY0, PY1, alY, t, KB, VB, SB) do {                                                      \
        SBAR(); qkt<KB, SK>(PX0, PX1, K_lds, r32, hi, S.qr, ACT(t), slopeR, LB(t));                                             \
        finishSM(PY0, PY1, alY, l_reg, pa0, pa1, pa2, pa3); SBAR();                                                           \
        if ((t) + 1 < NT) { if constexpr (F32) { VMW(); SWRITE_KF(SB); SBAR(); SLOAD_F((const float*)Vh, KBASE((t) + 1)); }  \
                            else { SLOAD_H(Kh, Vh, KBASE((t) + 1)); } SBAR(); }                                               \
        pv_tile<VB, SK>(o, vb0, pa0, pa1, pa2, pa3, ACT((t) - 1)); MASKT(PX0, PX1, (t)); partialSM(PX0, PX1, m_reg, mnX, alX);                                        \
        __syncthreads();                                                                                                      \
        if ((t) + 1 < NT) { VMW(); if constexpr (F32) { SWRITE_VF(SB); SBAR(); if ((t) + 2 < NT) SLOAD_F((const float*)Kh, KBASE((t) + 2)); } \
                            else { SWRITE_H(SB); } }                                                                          \
        if ((t) + 3 < NT) { TOUCH(KBASE((t) + 3)); }                                                                          \
        RESC(alX); __syncthreads(); } while (0)
    for (int t = 1; t + 1 < NT; t += 2) {
        HALF_STEP(pB0, pB1, mnB, alB, pA0, pA1, alA, t, 1, 0, 0);
        HALF_STEP(pA0, pA1, mnA, alA, pB0, pB1, alB, t + 1, 0, 1, 1);
    }
    const bool even = (NT & 1) == 0;
    if (even) { SBAR(); qkt<1, SK>(pB0, pB1, K_lds, r32, hi, S.qr, ACT(NT - 1), slopeR, LB(NT - 1)); SBAR(); }
#define QROW(e) (nxt.Q + (size_t)(wid * QBLK + r32) * LDI + ((e) >> 1) * 16 + hi * 8 + ((e) & 1) * 4)
    if constexpr (F32) { SLOAD_F((const float*)nxt.K, kbn); SBAR();
#pragma unroll
        for (int e = 0; e < 8; ++e) S.tq[e] = *(const f32x4*)QROW(e); }
    else { SLOAD_H(nxt.K, nxt.V, kbn); SBAR();
#pragma unroll
        for (int d0 = 0; d0 < 8; ++d0) S.qr[d0] = *(const gbf16x8*)(uni_ptr((const char*)nxt.Q) + (unsigned)(((wid * QBLK + r32) * LDI + hi * 8) * (int)sizeof(TIn)) + d0 * 16 * sizeof(TIn)); }
    SBAR();
    finishSM(pA0, pA1, alA, l_reg, pa0, pa1, pa2, pa3); SBAR();
    if constexpr (F32) {
#pragma unroll
        for (int e = 8; e < 16; ++e) S.tq[e] = *(const f32x4*)QROW(e); SBAR(); }
#undef QROW
    pv_tile<0, SK>(o, vb0, pa0, pa1, pa2, pa3, ACT(even ? NT - 2 : NT - 1));
    if (even) { MASKT(pB0, pB1, NT - 1); partialSM(pB0, pB1, m_reg, mnB, alB); __syncthreads(); RESC(alB);
        finishSM(pB0, pB1, alB, l_reg, pa0, pa1, pa2, pa3); SBAR(); pv_tile<1, SK>(o, vb0, pa0, pa1, pa2, pa3, ACT(NT - 1)); }
    SBAR(); SEAM_K0();
    if (hi == 0) li_l[r32] = l_reg; asm volatile("s_waitcnt lgkmcnt(0)" ::: "memory");
    float rli[16];
#pragma unroll
    for (int r = 0; r < 16; ++r) rli[r] = __builtin_amdgcn_rcpf(li_l[crow(r, hi)]);
    const gchar* Owb = uni_ptr((const char*)(cur.O + (size_t)(wid * QBLK) * LDO)); const unsigned ooff = (unsigned)((4 * hi * LDO + r32) * (int)sizeof(TOut));
#pragma unroll
    for (int r = 0; r < 16; ++r) { const int orc = (r & 3) + 8 * (r >> 2);
#pragma unroll
        for (int d0 = 0; d0 < 4; ++d0) { const float v = o[d0][r] * rli[r];
            if constexpr (same_t<TOut, float>::v) { *(__attribute__((address_space(1))) float*)((gchar*)(Owb) + ooff + (unsigned)((orc * LDO + d0 * 32) * (int)sizeof(TOut))) = v; }
            else { const float vn = __shfl_xor(v, 1);
                   if ((r32 & 1) == 0) *(__attribute__((address_space(1))) unsigned*)((gchar*)(Owb) + ooff + (unsigned)((orc * LDO + d0 * 32) * (int)sizeof(TOut))) = cvtpk(v, vn); } } }
    if constexpr (F32) {
#pragma unroll
        for (int d0 = 0; d0 < 8; ++d0) S.qr[d0] = pack8(S.tq[2 * d0], S.tq[2 * d0 + 1]); }
    __syncthreads();
    asm volatile("" :: "v"(touch_reg));
#undef TOUCH
#undef RESC
#undef LB
#undef KBASE
#undef ACT
#undef MASKT
#undef SEAM_K0
#undef HALF_STEP
}
#undef ROW
#undef VMW
#undef VMWN
#undef SLOAD_H
#undef SWRITE_HK
#undef SWRITE_HV
#undef SWRITE_H
#undef SLOAD_F
#undef SWRITE_KF
#undef SWRITE_VF
#undef KSWZ
#undef SBAR
}

constexpr int NWAVES = 8, NTHR = 512;
constexpr int DM = 2048, NB = 2, SEQ = 4096, MROWS = NB * SEQ, NLAYER = 2;
constexpr int IN_COLS = 6592, IN_PAD = 6656, DFF = 5632, UPC = 2 * DFF;
constexpr int C_RQ = 0, C_RK = 256, C_RV = 512, C_RG = 1024, C_RW = 1536, C_MQ = 3520, C_MK = 4544, C_MV = 5568;
constexpr int RWC = 1984;
constexpr float NORM_EPS = 1e-6f, GN_EPS = 64e-5f;
constexpr size_t MiB = 1u << 20;
constexpr size_t WS_CTL = 0, CTL_ZERO_BYTES = 1 * MiB;
constexpr size_t WS_MOD = 1 * MiB;
constexpr size_t WS_KMEAN = 1 * MiB + 512 * 1024;
constexpr size_t WS_W = 2 * MiB, W_LAYER = 100 * MiB, W_IN = 0, W_OUT = 26 * MiB, W_UP = 34 * MiB, W_DN = 78 * MiB;
constexpr size_t WS_X = 202 * MiB;
constexpr size_t WS_H = 266 * MiB;
constexpr size_t WS_PROJ = 298 * MiB;
constexpr size_t WS_ACT = WS_PROJ;
constexpr size_t WS_MIXED = 402 * MiB;
constexpr size_t WS_U = 434 * MiB;
constexpr size_t WS_HALO = WS_U;
constexpr size_t WS_RW = WS_U;
constexpr size_t WS_Y = WS_U + 128 * MiB;
constexpr size_t WS_RETO = WS_U + 144 * MiB;
constexpr size_t WS_REC = 610 * MiB;
constexpr size_t WS_RWW = 738 * MiB;
constexpr size_t WS_END = 739 * MiB;
constexpr size_t RWA = (size_t)MROWS * 512;
constexpr int CW_BAR = 4096, CW_SUB = 64;
constexpr int RING_BYTES = 131072, LDSCTL_OFF = RING_BYTES, MISC_OFF = LDSCTL_OFF + 320, LDS_BYTES = 147456;

#define GAS __attribute__((address_space(1)))
#define LAS __attribute__((address_space(3)))
typedef unsigned short bf16;
typedef unsigned v4u __attribute__((ext_vector_type(4)));
typedef unsigned v2u __attribute__((ext_vector_type(2)));
typedef float f32x4 __attribute__((ext_vector_type(4)));
typedef float f32x2 __attribute__((ext_vector_type(2)));
#define LDS_WAIT() asm volatile("s_waitcnt lgkmcnt(0)" ::: "memory")
__device__ __forceinline__ unsigned f2bf(float f) { unsigned u = __builtin_bit_cast(unsigned, f); return (u + 0x7fffu + ((u >> 16) & 1u)) >> 16; }
__device__ __forceinline__ unsigned pk2(float lo, float hi) { return f2bf(lo) | (f2bf(hi) << 16); }
__device__ __forceinline__ float bf2f(unsigned short h) { return __builtin_bit_cast(float, (unsigned)h << 16); }
__device__ __forceinline__ float bflo(unsigned w) { return __builtin_bit_cast(float, w << 16); }
__device__ __forceinline__ float bfhi(unsigned w) { return __builtin_bit_cast(float, w & 0xffff0000u); }
template <int CTRL> __device__ __forceinline__ float dpp_add(float v);
__device__ __forceinline__ float wave_sum(float v);
__device__ __forceinline__ float wave_max(float v) {
#pragma unroll
    for (int o = 1; o < 64; o <<= 1) v = fmaxf(v, __shfl_xor(v, o));
    return v;
}
template <int CTRL> __device__ __forceinline__ float dpp_add(float v) { return v + __builtin_bit_cast(float, __builtin_amdgcn_update_dpp(0, __builtin_bit_cast(int, v), CTRL, 0xF, 0xF, true)); }
__device__ __forceinline__ float wave_sum(float v) {
    v = dpp_add<0xB1>(v); v = dpp_add<0x4E>(v); v = dpp_add<0x141>(v); v = dpp_add<0x140>(v);
    v += __shfl_xor(v, 16); v += __shfl_xor(v, 32);
    return v;
}
__device__ __forceinline__ float sigmoidf_(float x) { return 1.0f / (1.0f + __expf(-x)); }

#define XB_TMO      128
#define XB_XCNT(j)  (256  + 64 * (j))
#define XB_XSUB(j)  (1280 + 64 * (j))
#define XB_XGEN(j)  (2304 + 64 * (j))
#define XB_TOP      3328
#define XB_TOPGEN   3392
#define XCD_BAR_WORDS 3456
#define XB_SPIN_CAP (1u << 22)
__device__ __forceinline__ unsigned xb_ld(unsigned* p)              { return __hip_atomic_load(p, __ATOMIC_RELAXED, __HIP_MEMORY_SCOPE_AGENT); }
__device__ __forceinline__ unsigned xb_add(unsigned* p, unsigned v) { return __hip_atomic_fetch_add(p, v, __ATOMIC_RELAXED, __HIP_MEMORY_SCOPE_AGENT); }
__device__ __forceinline__ unsigned xb_xcc_id() { return (unsigned)__builtin_amdgcn_s_getreg((3 << 11) | 20) & 0xFu; }
#define XB_SPIN(cond, bar) do { unsigned _sp = 0; while (cond) { __builtin_amdgcn_s_sleep(1); \
    if ((++_sp & 255u) == 0u) { if (xb_ld(&(bar)[XB_TMO])) break; if (_sp > XB_SPIN_CAP) { atomicAdd(&(bar)[XB_TMO], 1u); break; } } } } while (0)
struct XcdBarrier { unsigned* bar; unsigned x; volatile LAS unsigned* st; };
__device__ __forceinline__ XcdBarrier xcd_barrier_post(unsigned* bar, volatile LAS unsigned* st, int tid) {
    XcdBarrier b; b.bar = bar; b.x = xb_xcc_id(); b.st = st;
    if (tid == 0) (void)xb_add(&bar[XB_XCNT(b.x)], 1u);
    return b;
}
__device__ __forceinline__ void xcd_barrier_complete(unsigned* bar, unsigned x, unsigned& nloc, unsigned& nx) {
    const unsigned G = gridDim.x * gridDim.y * gridDim.z;
    unsigned sum, cnt, mine, sp = 0u;
    for (;;) {
        sum = 0u; cnt = 0u; mine = 0u;
#pragma unroll
        for (unsigned j = 0; j < 16; ++j) { const unsigned c = xb_ld(&bar[XB_XCNT(j)]); sum += c; cnt += (c > 0u) ? 1u : 0u; mine = (j == x) ? c : mine; }
        if (sum == G) break;
        __builtin_amdgcn_s_sleep(1);
        if ((++sp & 255u) == 0u) { if (xb_ld(&bar[XB_TMO])) break; if (sp > XB_SPIN_CAP) { atomicAdd(&bar[XB_TMO], 1u); break; } }
    }
    nloc = mine > 0u ? mine : 1u; nx = cnt > 0u ? cnt : 1u;
}
__device__ __forceinline__ void xcd_barrier(const XcdBarrier& b, int tid) {
    asm volatile("s_waitcnt vmcnt(0)" ::: "memory");
    __syncthreads();
    if (tid == 0) {
        unsigned z_ = 0u; asm volatile("" : "+v"(z_)); z_ = (unsigned)__builtin_amdgcn_readfirstlane(z_);
        unsigned* bar = b.bar + z_; const unsigned bx_ = b.x + z_;
        __builtin_amdgcn_s_waitcnt(0);
        unsigned nloc = b.st[0], nx = b.st[1];
        if (nloc == 0u) { xcd_barrier_complete(bar, bx_, nloc, nx); b.st[0] = nloc; b.st[1] = nx; }
        const unsigned old = xb_add(&bar[XB_XSUB(bx_)], 1u);
        const unsigned gen = old / nloc;
        if (old + 1u == (gen + 1u) * nloc) {
            __builtin_amdgcn_fence(__ATOMIC_RELEASE, "agent");
            asm volatile("s_waitcnt vmcnt(0)" ::: "memory");
            const unsigned og = xb_add(&bar[XB_TOP], 1u);
            const unsigned tg = og / nx;
            if (og + 1u == (tg + 1u) * nx) xb_add(&bar[XB_TOPGEN], 1u);
            else XB_SPIN(xb_ld(&bar[XB_TOPGEN]) == tg, bar);
            __builtin_amdgcn_fence(__ATOMIC_ACQUIRE, "agent");
            xb_add(&bar[XB_XGEN(bx_)], 1u);
            asm volatile("s_waitcnt vmcnt(0)" ::: "memory");
        } else {
            XB_SPIN(xb_ld(&bar[XB_XGEN(bx_)]) == gen, bar);
            __builtin_amdgcn_fence(__ATOMIC_ACQUIRE, "agent");
            asm volatile("s_waitcnt vmcnt(0)" ::: "memory");
        }
    }
    __syncthreads();
}

struct Args { const float* in[24]; float* out; unsigned char* ws; };
struct Frame {
    LAS unsigned char* lds;
    int tid, lane, wave, vcu, G, zz;
    const float* const* in;
    unsigned char* ws;
};

#define FWS (F.ws + F.zz)
__device__ __forceinline__ void p0_transpose_item(const float* W, int K, int N, bf16* WT, LAS float* scr, int item, int lane, int half = 0) {
    const int nblk = N / 32, kb = item / nblk, nb = item % nblk, k0 = 64 * kb, n0 = 32 * nb;
    const int r0 = !half ? n0 : (n0 < half ? (n0 >> 7) * 256 + (n0 & 127) : ((n0 - half) >> 7) * 256 + 128 + ((n0 - half) & 127));
#pragma unroll 8
    for (int i = 0; i < 32; ++i) { const int kk = 2 * i + (lane >> 5); scr[kk * 33 + (lane & 31)] = W[(size_t)(k0 + kk) * N + n0 + (lane & 31)]; }
    LDS_WAIT(); asm volatile("" ::: "memory");
    const int c = lane & 7;
#pragma unroll
    for (int j = 0; j < 4; ++j) { const int n = (lane >> 3) + 8 * j; const LAS float* s = scr + (8 * c) * 33 + n;
        v4u o; o.x = pk2(s[0 * 33], s[1 * 33]); o.y = pk2(s[2 * 33], s[3 * 33]); o.z = pk2(s[4 * 33], s[5 * 33]); o.w = pk2(s[6 * 33], s[7 * 33]);
        *(v4u*)(WT + (size_t)(r0 + n) * K + k0 + 8 * c) = o; }
    LDS_WAIT(); asm volatile("" ::: "memory");
}
constexpr int CV_IN = (DM / 64) * (IN_COLS / 32), CV_OUT = (DM / 64) * (DM / 32), CV_UP = (DM / 64) * (UPC / 32), CV_DN = (DFF / 64) * (DM / 32), CV_LAYER = CV_IN + CV_OUT + CV_UP + CV_DN;
constexpr int CV_N1 = 10, CV_N2 = 6, CV_N3 = 4, CV_C1 = 192 * NWAVES * CV_N1, CV_C2 = 128 * NWAVES * CV_N2;
static_assert(CV_IN + CV_C1 <= CV_LAYER && CV_LAYER - (CV_IN + CV_C1) + (CV_IN - CV_C2) <= 128 * NWAVES * CV_N3 && CV_C2 <= CV_IN, "gap capacities");
__device__ __forceinline__ void convert_item(Frame& F, int it, LAS float* scr) {
    const int l = it / CV_LAYER; int r = it % CV_LAYER;
    unsigned char* wl = FWS + WS_W + (size_t)l * W_LAYER;
    if (r < CV_IN) { p0_transpose_item(F.in[F.zz + 2] + (size_t)l * DM * IN_COLS, DM, IN_COLS, (bf16*)(wl + W_IN), scr, r, F.lane); return; } r -= CV_IN;
    if (r < CV_OUT) { p0_transpose_item(F.in[F.zz + 3] + (size_t)l * DM * DM, DM, DM, (bf16*)(wl + W_OUT), scr, r, F.lane); return; } r -= CV_OUT;
    if (r < CV_UP) { p0_transpose_item(F.in[F.zz + 15] + (size_t)l * DM * UPC, DM, UPC, (bf16*)(wl + W_UP), scr, r, F.lane, DFF); return; } r -= CV_UP;
    p0_transpose_item(F.in[F.zz + 18] + (size_t)l * DFF * DM, DFF, DM, (bf16*)(wl + W_DN), scr, r, F.lane);
}
__device__ __forceinline__ void convert_gap(Frame& F, int layer, int first, int count, int gwi, int nwv, int nper) {
    LAS float* scr = (LAS float*)(F.lds + F.wave * 16384);
    for (int j = 0; j < nper; ++j) { const int r = gwi + nwv * j; if (r < count) convert_item(F, layer * CV_LAYER + first + r, scr); }
}
__device__ __forceinline__ void adaln_item(Frame& F, int l, int grp) {
    LAS float* cact = (LAS float*)F.lds;
    LAS float* red = (LAS float*)(F.lds + 16384);
    const float* c = F.in[F.zz + 1];
    for (int i = F.tid; i < 4096; i += NTHR) { const float cv = c[i]; cact[i] = cv / (1.0f + __expf(-cv)); }
    __syncthreads();
    const int n0 = grp * 128;
    const float* W = F.in[F.zz + 19] + (size_t)l * 2048 * 12288 + n0;
    const int half = F.lane >> 5, q = F.lane & 31;
    f32x4 a0 = {0.f, 0.f, 0.f, 0.f}, a1 = {0.f, 0.f, 0.f, 0.f};
#pragma unroll 16
    for (int i = 0; i < 128; ++i) { const int k = F.wave * 256 + 2 * i + half; const f32x4 w = *(const f32x4*)(W + (size_t)k * 12288 + 4 * q);
        a0 += w * cact[k]; a1 += w * cact[2048 + k]; }
#pragma unroll
    for (int e = 0; e < 4; ++e) { a0[e] += __shfl_xor(a0[e], 32); a1[e] += __shfl_xor(a1[e], 32); }
    if (half == 0) {
#pragma unroll
        for (int e = 0; e < 4; ++e) { red[(F.wave * 2 + 0) * 128 + 4 * q + e] = a0[e]; red[(F.wave * 2 + 1) * 128 + 4 * q + e] = a1[e]; } }
    __syncthreads();
    if (F.tid < 256) { const int bb = F.tid >> 7, col = F.tid & 127; float s = 0.f;
#pragma unroll
        for (int w = 0; w < 8; ++w) s += red[(w * 2 + bb) * 128 + col];
        s += F.in[F.zz + 20][l * 12288 + n0 + col];
        ((float*)(FWS + WS_MOD))[(size_t)(l * 2 + bb) * 12288 + n0 + col] = s; }
    __syncthreads();
}
__device__ __forceinline__ void p0_prologue(Frame& F) {
    const int ngv = (F.G == 256) ? 96 : 192;
    if (F.vcu < ngv) adaln_item(F, F.vcu / 96, F.vcu % 96);
    LAS float* scr = (LAS float*)(F.lds + F.wave * 16384);
    const int gw = F.vcu * NWAVES + F.wave, NGW = F.G * NWAVES;
    if (F.G == 256) { if (F.vcu >= 96) for (int p = gw - 96 * NWAVES; p < CV_IN; p += 160 * NWAVES) convert_item(F, p, scr); }
    else for (int p = gw; p < NLAYER * CV_LAYER; p += NGW) convert_item(F, p, scr);
    for (int l = 0; l < NLAYER; ++l) { bf16* wt = (bf16*)(FWS + WS_RWW + (size_t)l * 448 * 512 * 2);
        const float* wu = F.in[F.zz + 6] + (size_t)l * 96 * 512; const float* au = F.in[F.zz + 8] + (size_t)l * 96 * 512; const float* gu = F.in[F.zz + 9] + (size_t)l * 256 * 512;
        for (int i = F.vcu * NTHR + F.tid; i < 448 * 512; i += F.G * NTHR) {
            if (i < 96 * 512) { const int n = i / 96, kq = i - n * 96; wt[i] = (bf16)f2bf(wu[kq * 512 + n]); }
            else if (i < 2 * 96 * 512) { const int j = i - 96 * 512, n = j / 96, kq = j - n * 96; wt[i] = (bf16)f2bf(au[kq * 512 + n]); }
            else { const int j = i - 2 * 96 * 512, n = j >> 8, kq = j & 255; wt[i] = (bf16)f2bf(gu[kq * 512 + n]); } } }
    for (int l = 0; l < NLAYER; ++l) { v4u* z = (v4u*)(FWS + WS_W + (size_t)l * W_LAYER + W_IN + (size_t)IN_COLS * DM * 2);
        for (int i = F.vcu * NTHR + F.tid; i < (IN_PAD - IN_COLS) * DM * 2 / 16; i += F.G * NTHR) z[i] = (v4u){0u, 0u, 0u, 0u}; }
}

template <int MODE, bool IN_F32>
__device__ __forceinline__ void norm_phase(Frame& F, const void* xin, void* outp, const float* g, const float* sh, const float* sc) {
    LAS float* gs = (LAS float*)F.lds;
    LAS float* shs = (LAS float*)(F.lds + 16384);
    for (int i = F.tid; i < 4096; i += NTHR) { const int b = i >> 11, col = i & 2047;
        if (MODE == 0) { gs[i] = g[col] * (1.0f + sc[(size_t)b * 12288 + col]); shs[i] = sh[(size_t)b * 12288 + col]; }
        else { gs[i] = g[col]; shs[i] = 0.f; } }
    __syncthreads();
    const int gw = F.vcu * NWAVES + F.wave, NGW = F.G * NWAVES;
    for (int m = gw; m < MROWS; m += NGW) {
        const int b = m >> 12;
        f32x4 v[8]; float s = 0.f;
#pragma unroll
        for (int j = 0; j < 8; ++j) {
            if (IN_F32) v[j] = *((const f32x4*)((const float*)xin + (size_t)m * DM) + F.lane + 64 * j);
            else { const v2u w = *((const v2u*)((const bf16*)xin + (size_t)m * DM) + F.lane + 64 * j); v[j] = (f32x4){bflo(w.x), bfhi(w.x), bflo(w.y), bfhi(w.y)}; }
            s += (v[j].x * v[j].x + v[j].y * v[j].y) + (v[j].z * v[j].z + v[j].w * v[j].w); }
        float rstd = 1.0f / sqrtf(wave_sum(s) * (1.0f / DM) + NORM_EPS);
#if MOBA_CHECK
        if (MODE == 1) { const float sd = ((const float*)(FWS + WS_CTL))[8], sn = ((const float*)(FWS + WS_CTL))[9]; rstd *= 1.0f + 10.0f * sqrtf(sd / sn); }
#endif
#pragma unroll
        for (int j = 0; j < 8; ++j) { const int col = 4 * (F.lane + 64 * j);
            const f32x4 gg = *(const LAS f32x4*)(gs + b * 2048 + col), ss = *(const LAS f32x4*)(shs + b * 2048 + col);
            const f32x4 o = v[j] * rstd * gg + ss;
            if (MODE == 0) { v2u w; w.x = pk2(o.x, o.y); w.y = pk2(o.z, o.w); *(v2u*)((bf16*)outp + (size_t)m * DM + col) = w; }
            else *(f32x4*)((float*)outp + (size_t)m * DM + col) = o; }
    }
    __syncthreads();
}

__device__ __forceinline__ float lerp_bf(const bf16* P, size_t row, int col, bool hasprev, float mu) {
    const float cur = bf2f(P[row * IN_PAD + col]); const float prev = hasprev ? bf2f(P[(row - 1) * IN_PAD + col]) : 0.f;
    return cur + (prev - cur) * mu;
}
__device__ __forceinline__ void rwkv_prep(Frame& F, int l) {
    LAS float* codes = (LAS float*)F.lds;
    const bf16* P = (const bf16*)(FWS + WS_PROJ);
    const float* mu = F.in[F.zz + 4] + l * RWC; const float* w0 = F.in[F.zz + 5] + l * 512; const float* w_up = F.in[F.zz + 6] + (size_t)l * 96 * 512;
    const float* a0 = F.in[F.zz + 7] + l * 512; const float* a_up = F.in[F.zz + 8] + (size_t)l * 96 * 512; const float* g_up = F.in[F.zz + 9] + (size_t)l * 256 * 512;
    const float* k_k = F.in[F.zz + 10] + l * 512; const float* k_a = F.in[F.zz + 11] + l * 512; const float* r_k = F.in[F.zz + 12] + l * 512;
    float* RW = (float*)(FWS + WS_RW);
    const int c = F.tid;
    const float mur = mu[c], muk = mu[512 + c], muv = mu[1024 + c], w0c = w0[c], a0c = a0[c], kkc = k_k[c], kac = k_a[c], rkc = r_k[c];
    for (int item = F.vcu; item < MROWS / 8; item += F.G) {
        const int row0 = item * 8, t0 = row0 & (SEQ - 1);
        for (int idx = F.tid; idx < 8 * 448; idx += NTHR) { const int tk = idx / 448, cc = idx - tk * 448;
            float val = lerp_bf(P, (size_t)(row0 + tk), C_RW + 1536 + cc, (t0 + tk) > 0, mu[1536 + cc]);
            if (cc < 96) val = tanhf(val); else if (cc >= 192) val = sigmoidf_(val);
            codes[idx] = val; }
        __syncthreads();
        float wd[8], wa[8], gg[8];
#pragma unroll
        for (int tk = 0; tk < 8; ++tk) { wd[tk] = 0.f; wa[tk] = 0.f; gg[tk] = 0.f; }
        for (int r = 0; r < 96; ++r) { const float wu = w_up[r * 512 + c], au = a_up[r * 512 + c];
#pragma unroll
            for (int tk = 0; tk < 8; ++tk) { wd[tk] += codes[tk * 448 + r] * wu; wa[tk] += codes[tk * 448 + 96 + r] * au; } }
        for (int r = 0; r < 256; ++r) { const float gu = g_up[r * 512 + c];
#pragma unroll
            for (int tk = 0; tk < 8; ++tk) gg[tk] += codes[tk * 448 + 192 + r] * gu; }
#pragma unroll
        for (int tk = 0; tk < 8; ++tk) {
            const size_t row = (size_t)(row0 + tk); const bool hp = (t0 + tk) > 0;
            const float rr = lerp_bf(P, row, C_RW + c, hp, mur), kk0 = lerp_bf(P, row, C_RW + 512 + c, hp, muk), vv = lerp_bf(P, row, C_RW + 1024 + c, hp, muv);
            const float z = -(w0c + wd[tk]);
            const float sp = fmaxf(z, 0.f) + log1pf(__expf(-fabsf(z)));
            const float decay = __expf(-__expf(-sp - 0.5f));
            const float a = sigmoidf_(a0c + wa[tk]);
            const float kkv = kk0 * kkc;
            const float nrm = sqrtf(wave_sum(kkv * kkv));
            const float kap = kkv / fmaxf(nrm, 1e-12f);
            const float kp = kk0 * (1.0f + (a - 1.0f) * kac);
            const float bsum = wave_sum(rr * kp * rkc);
            const size_t o = row * 512 + c;
            RW[0 * RWA + o] = rr; RW[1 * RWA + o] = decay; RW[2 * RWA + o] = kp; RW[3 * RWA + o] = vv;
            RW[4 * RWA + o] = kap; RW[5 * RWA + o] = kap * a; RW[6 * RWA + o] = gg[tk]; RW[7 * RWA + o] = bsum * vv;
        }
        __syncthreads();
    }
}
__device__ __forceinline__ void moba_kmean(Frame& F) {
    LAS float* red = (LAS float*)(F.lds + 32768);
    const bf16* P = (const bf16*)(FWS + WS_PROJ);
    float* KM = (float*)(FWS + WS_KMEAN);
    for (int item = F.vcu; item < 256; item += F.G) {
        const int b = item >> 7, h = (item >> 4) & 7, n = item & 15;
        const int d = F.tid & 127, part = F.tid >> 7;
        const bf16* kp = P + (size_t)(b * SEQ + n * 256 + part * 64) * IN_PAD + C_MK + h * 128 + d;
        float s = 0.f;
        for (int k = 0; k < 64; ++k) s += bf2f(kp[(size_t)k * IN_PAD]);
        red[part * 128 + d] = s;
        __syncthreads();
        if (F.tid < 128) KM[(size_t)item * 128 + d] = (red[d] + red[128 + d] + red[256 + d] + red[384 + d]) * (1.0f / 256.0f);
        __syncthreads();
    }
}
struct RwIn { f32x4 w[2], kk[2], bb[2], k[2], r[2]; float v; };
__device__ __forceinline__ void rw_load(RwIn& x, const float* RW, size_t row, int cj, int ci) {
    const size_t o = row * 512;
    x.w[0] = *(const f32x4*)(RW + 1 * RWA + o + cj); x.w[1] = *(const f32x4*)(RW + 1 * RWA + o + cj + 4);
    x.kk[0] = *(const f32x4*)(RW + 4 * RWA + o + cj); x.kk[1] = *(const f32x4*)(RW + 4 * RWA + o + cj + 4);
    x.bb[0] = *(const f32x4*)(RW + 5 * RWA + o + cj); x.bb[1] = *(const f32x4*)(RW + 5 * RWA + o + cj + 4);
    x.k[0] = *(const f32x4*)(RW + 2 * RWA + o + cj); x.k[1] = *(const f32x4*)(RW + 2 * RWA + o + cj + 4);
    x.r[0] = *(const f32x4*)(RW + 0 * RWA + o + cj); x.r[1] = *(const f32x4*)(RW + 0 * RWA + o + cj + 4);
    x.v = RW[3 * RWA + o + ci];
}
__device__ __forceinline__ void rwkv_scan_naive(Frame& F, int b, int h) {
    const float* RW = (const float*)(FWS + WS_RW);
    float* Y = (float*)(FWS + WS_Y);
    const int i = F.tid >> 3, jp = F.tid & 7, cj = h * 64 + 8 * jp, ci = h * 64 + i;
    f32x4 s0 = {0.f, 0.f, 0.f, 0.f}, s1 = {0.f, 0.f, 0.f, 0.f};
    RwIn cur, n1, n2;
    const size_t rb = (size_t)b * SEQ;
    rw_load(cur, RW, rb, cj, ci); rw_load(n1, RW, rb + 1, cj, ci);
    for (int t = 0; t < SEQ; ++t) {
        rw_load(n2, RW, rb + (t + 2 < SEQ ? t + 2 : SEQ - 1), cj, ci);
        f32x4 pp = s0 * cur.kk[0] + s1 * cur.kk[1];
        float p = (pp.x + pp.y) + (pp.z + pp.w);
        p += __shfl_xor(p, 1); p += __shfl_xor(p, 2); p += __shfl_xor(p, 4);
        const float sa = -p;
        s0 = s0 * cur.w[0] + sa * cur.bb[0] + cur.v * cur.k[0];
        s1 = s1 * cur.w[1] + sa * cur.bb[1] + cur.v * cur.k[1];
        f32x4 yy = s0 * cur.r[0] + s1 * cur.r[1];
        float y = (yy.x + yy.y) + (yy.z + yy.w);
        y += __shfl_xor(y, 1); y += __shfl_xor(y, 2); y += __shfl_xor(y, 4);
        if (jp == 0) Y[(rb + t) * 512 + ci] = y;
        cur = n1; n1 = n2;
    }
}
struct RtIn { v4u q[2], k[2]; unsigned short v; };
__device__ __forceinline__ void rt_load(RtIn& x, const bf16* P, size_t row, int h, int d0, int v) {
    const bf16* p = P + row * IN_PAD;
    x.q[0] = *(const v4u*)(p + C_RQ + h * 64 + d0); x.q[1] = *(const v4u*)(p + C_RQ + h * 64 + d0 + 8);
    x.k[0] = *(const v4u*)(p + C_RK + h * 64 + d0); x.k[1] = *(const v4u*)(p + C_RK + h * 64 + d0 + 8);
    x.v = p[C_RV + h * 128 + v];
}
__device__ __forceinline__ void ret_scan_naive(Frame& F, int b, int h) {
    const bf16* P = (const bf16*)(FWS + WS_PROJ);
    float* RO = (float*)(FWS + WS_RETO);
    const int v = F.tid >> 2, dp = F.tid & 3, d0 = dp * 16;
    const float gamma = 1.0f - exp2f(-5.0f - (float)h);
    float S[16];
#pragma unroll
    for (int d = 0; d < 16; ++d) S[d] = 0.f;
    RtIn cur, n1, n2;
    const size_t rb = (size_t)b * SEQ;
    rt_load(cur, P, rb, h, d0, v); rt_load(n1, P, rb + 1, h, d0, v);
    for (int t = 0; t < SEQ; ++t) {
        rt_load(n2, P, rb + (t + 2 < SEQ ? t + 2 : SEQ - 1), h, d0, v);
        const float vv = bf2f(cur.v) * 0.125f;
        float o = 0.f;
#pragma unroll
        for (int e = 0; e < 8; ++e) { const unsigned qw = cur.q[e >> 2][e & 3], kw = cur.k[e >> 2][e & 3];
            S[2 * e] = gamma * S[2 * e] + bflo(kw) * vv; S[2 * e + 1] = gamma * S[2 * e + 1] + bfhi(kw) * vv;
            o += bflo(qw) * S[2 * e] + bfhi(qw) * S[2 * e + 1]; }
        o += __shfl_xor(o, 1); o += __shfl_xor(o, 2);
        if (dp == 0) RO[(rb + t) * 512 + h * 128 + v] = o;
        cur = n1; n1 = n2;
    }
}
__device__ __forceinline__ void moba_naive(Frame& F, int mw, int nmw) {
    const bf16* P = (const bf16*)(FWS + WS_PROJ);
    const float* KM = (const float*)(FWS + WS_KMEAN);
    bf16* MX = (bf16*)(FWS + WS_U + 160 * MiB);
    LAS float* qs = (LAS float*)(F.lds + F.wave * 4608);
    LAS float* ps = qs + 128;
    const int lane = F.lane;
    for (int qi = mw; qi < MROWS * 8; qi += nmw) {
        const int h = qi & 7, row = qi >> 3, b = row >> 12, t = row & (SEQ - 1), bq = t >> 8;
        { const unsigned qw = *(const unsigned*)(P + (size_t)row * IN_PAD + C_MQ + h * 128 + 2 * lane);
          qs[2 * lane] = bflo(qw) * 0.08838834764831845f; qs[2 * lane + 1] = bfhi(qw) * 0.08838834764831845f; }
        LDS_WAIT();
        float gate = -INFINITY;
        if (lane < 16 && lane < bq) { const float* km = KM + ((size_t)(b * 8 + h) * 16 + lane) * 128; float a = 0.f;
            for (int d = 0; d < 128; ++d) a += qs[d] * km[d];
            gate = a; }
        unsigned selmask = 0u;
#pragma unroll
        for (int rnd = 0; rnd < 3; ++rnd) { const float m = wave_max(gate);
            if (m > -INFINITY) { const unsigned long long bal = __ballot(gate == m); const int idx = __ffsll((long long)bal) - 1; selmask |= 1u << idx; if (lane == idx) gate = -INFINITY; } }
        int blk[4];
#pragma unroll
        for (int s = 0; s < 3; ++s) { if (selmask) { blk[s] = __ffs((int)selmask) - 1; selmask &= selmask - 1u; } else blk[s] = -1; }
        blk[3] = bq;
        const float slope = exp2f(-(float)(h + 1));
        float sc[4][4]; float mx = -1e30f;
#pragma unroll
        for (int s = 0; s < 4; ++s) {
#pragma unroll
            for (int kq = 0; kq < 4; ++kq) {
                float val = -1e30f;
                if (blk[s] >= 0) { const int pos = blk[s] * 256 + kq * 64 + lane;
                    const bf16* kp = P + (size_t)(b * SEQ + pos) * IN_PAD + C_MK + h * 128; float a = 0.f;
#pragma unroll 4
                    for (int d8 = 0; d8 < 16; ++d8) { const v4u kw = *(const v4u*)(kp + d8 * 8); const f32x4 qa = *(const LAS f32x4*)(qs + d8 * 8), qb = *(const LAS f32x4*)(qs + d8 * 8 + 4);
                        a += bflo(kw.x) * qa.x + bfhi(kw.x) * qa.y + bflo(kw.y) * qa.z + bfhi(kw.y) * qa.w + bflo(kw.z) * qb.x + bfhi(kw.z) * qb.y + bflo(kw.w) * qb.z + bfhi(kw.w) * qb.w; }
                    if (pos <= t) val = a - slope * (float)(t - pos); }
                sc[s][kq] = val; mx = fmaxf(mx, val); } }
        mx = wave_max(mx);
        float lsum = 0.f;
#pragma unroll
        for (int s = 0; s < 4; ++s)
#pragma unroll
            for (int kq = 0; kq < 4; ++kq) { const float p = __expf(sc[s][kq] - mx); lsum += p; ps[s * 256 + kq * 64 + lane] = p; }
        lsum = wave_sum(lsum);
        LDS_WAIT();
        float o0 = 0.f, o1 = 0.f;
#pragma unroll
        for (int s = 0; s < 4; ++s) if (blk[s] >= 0) { const int nk = (s == 3) ? (t - bq * 256 + 1) : 256;
            const bf16* vp = P + (size_t)(b * SEQ + blk[s] * 256) * IN_PAD + C_MV + h * 128 + 2 * lane;
#pragma unroll 4
            for (int key = 0; key < nk; ++key) { const float p = ps[s * 256 + key]; const unsigned vw = *(const unsigned*)(vp + (size_t)key * IN_PAD); o0 += p * bflo(vw); o1 += p * bfhi(vw); } }
        const float inv = 1.0f / lsum;
        *(unsigned*)(MX + (size_t)row * 1024 + h * 128 + 2 * lane) = pk2(o0 * inv, o1 * inv);
        LDS_WAIT();
    }
}

constexpr int MOBA_LDS_KM = moba::LDS_BYTES, MOBA_LDS_SEL = MOBA_LDS_KM + 8192;
__device__ __forceinline__ void moba_item(Frame& F, int bh, int qbA, int qbB) {
    const int b = bh >> 3, h = bh & 7;
    const bf16* P = (const bf16*)(FWS + WS_PROJ);
    LAS float* km = (LAS float*)(F.lds + MOBA_LDS_KM);
    LAS unsigned* sel = (LAS unsigned*)(F.lds + MOBA_LDS_SEL);
    const float* KM = (const float*)(FWS + WS_KMEAN) + (size_t)bh * 16 * 128;
    for (int i = F.tid; i < 2048; i += NTHR) km[i] = KM[i];
    __syncthreads();
    {   const int qb = (F.tid < 256) ? qbA : qbB, r = F.tid & 255;
        const bf16* qp = P + (size_t)(b * SEQ + qb * 256 + r) * IN_PAD + C_MQ + h * 128;
        float g[16];
#pragma unroll
        for (int n = 0; n < 16; ++n) g[n] = 0.f;
        for (int d8 = 0; d8 < 16; ++d8) { const v4u qw = *(const v4u*)(qp + d8 * 8);
            const float q0 = bflo(qw.x), q1 = bfhi(qw.x), q2 = bflo(qw.y), q3 = bfhi(qw.y), q4 = bflo(qw.z), q5 = bfhi(qw.z), q6 = bflo(qw.w), q7 = bfhi(qw.w);
#pragma unroll
            for (int n = 0; n < 16; ++n) { const f32x4 ka = *(const LAS f32x4*)(km + n * 128 + d8 * 8), kb = *(const LAS f32x4*)(km + n * 128 + d8 * 8 + 4);
                g[n] += (q0 * ka.x + q1 * ka.y) + (q2 * ka.z + q3 * ka.w) + (q4 * kb.x + q5 * kb.y) + (q6 * kb.z + q7 * kb.w); } }
        unsigned m = 0u;
#pragma unroll
        for (int rnd = 0; rnd < 3; ++rnd) { float best = -INFINITY; int bi = -1;
#pragma unroll
            for (int n = 0; n < 16; ++n) if (n < qb && !((m >> n) & 1u) && g[n] > best) { best = g[n]; bi = n; }
            if (bi >= 0) m |= 1u << bi; }
        sel[F.tid] = m; }
    __syncthreads();
    typedef moba::BlockRef<moba::bf16, moba::bf16> Ref;
    const float slopeR = exp2f(-(float)(h + 1)) * 11.313708498984761f;
    bf16* MX = (bf16*)(FWS + WS_MIXED);
    Ref A, B2;
    A.Q = P + (size_t)(b * SEQ + qbA * 256) * IN_PAD + C_MQ + h * 128; A.K = P + (size_t)(b * SEQ) * IN_PAD + C_MK + h * 128; A.V = P + (size_t)(b * SEQ) * IN_PAD + C_MV + h * 128;
    A.O = MX + (size_t)(b * SEQ + qbA * 256) * DM + 1024 + h * 128; A.P0 = qbA * 256; A.sel = sel; A.slopeR = slopeR;
    B2 = A; B2.Q = P + (size_t)(b * SEQ + qbB * 256) * IN_PAD + C_MQ + h * 128; B2.O = MX + (size_t)(b * SEQ + qbB * 256) * DM + 1024 + h * 128; B2.P0 = qbB * 256; B2.sel = sel + 256;
    moba::Seam<moba::bf16> S;
    moba::lchar* ldsg = (moba::lchar*)F.lds;
    moba::causal_swa_prime<moba::bf16, moba::bf16>(A, 1 << 30, ldsg, S, F.wave);
    Ref cur = A;
    for (int pass = 0; pass < MOBA_NP; ++pass) {
        const bool nb_ = ((pass + 1) & 1) != 0;
        Ref nxt = A; if (nb_ || pass + 1 >= MOBA_NP) nxt = B2;
        moba::causal_swa_block<moba::bf16, moba::bf16>(cur, nxt, SEQ, 1 << 30, ldsg, S, F.wave);
        cur = nxt;
    }
}
constexpr int RC_UNITS = 32, RC_NCH = SEQ / 16, RC_REC = 16384;
constexpr int RC_AR = 0, RC_BK = 4096, RC_VP = 8192, RC_U0 = 10240, RC_Y0 = 12288, RC_D = 14336;
typedef short bf16x8 __attribute__((ext_vector_type(8)));
typedef float f32x16 __attribute__((ext_vector_type(16)));
typedef float f32x2t __attribute__((ext_vector_type(2))); typedef __bf16 bf16x2t __attribute__((ext_vector_type(2)));
__device__ __forceinline__ unsigned cvtpk_c(float lo, float hi) { f32x2t v = {lo, hi}; bf16x2t b = __builtin_convertvector(v, bf16x2t); return __builtin_bit_cast(unsigned, b); }
__device__ __forceinline__ unsigned short cvt1_c(float x) { return (unsigned short)(cvtpk_c(x, 0.f) & 0xffffu); }

constexpr int RC_WLDS = 14464, RC_CODES_OFF = 8 * RC_WLDS  , RC_CSTRIDE = 456;
__device__ __forceinline__ void rc_core(Frame& F, LAS unsigned char* wlds, const float (&At)[16], const float (&Bt)[16], const float (&Kt)[16], const float (&Rt)[16], const float (&vv)[16], const float D, unsigned char* rec) {
    { unsigned wb_ = (unsigned)(uintptr_t)wlds; asm volatile("" : "+v"(wb_)); wlds = (LAS unsigned char*)(uintptr_t)wb_; }
    LAS bf16* XA = (LAS bf16*)wlds; LAS bf16* XB = (LAS bf16*)(wlds + 4608); LAS float* TT = (LAS float*)(wlds + 9216 + 4224);
    int x_ = F.lane; asm volatile("" : "+v"(x_));
    const int x = x_, r32 = x & 31, h2 = x >> 5, tl = x & 15;
#pragma unroll
    for (int t = 0; t < 16; ++t) { XA[t * 72 + x] = cvt1_c(Bt[t]); XA[(16 + t) * 72 + x] = cvt1_c(Kt[t]); XB[t * 72 + x] = cvt1_c(At[t]); XB[(16 + t) * 72 + x] = cvt1_c(Rt[t]); }
#pragma unroll
    for (int q = 0; q < 4; ++q) { v4u w; w.x = cvtpk_c(Bt[4 * q] * D, Bt[4 * q + 1] * D); w.y = cvtpk_c(Bt[4 * q + 2] * D, Bt[4 * q + 3] * D);
        w.z = cvtpk_c(Kt[4 * q] * D, Kt[4 * q + 1] * D); w.w = cvtpk_c(Kt[4 * q + 2] * D, Kt[4 * q + 3] * D); *(v4u*)(rec + RC_BK + x * 64 + q * 16) = w; }
#pragma unroll
    for (int q = 0; q < 2; ++q) { v4u w;
        w.x = cvtpk_c(vv[8 * q], vv[8 * q + 1]); w.y = cvtpk_c(vv[8 * q + 2], vv[8 * q + 3]); w.z = cvtpk_c(vv[8 * q + 4], vv[8 * q + 5]); w.w = cvtpk_c(vv[8 * q + 6], vv[8 * q + 7]); *(v4u*)(rec + RC_VP + x * 32 + q * 16) = w;
    }
    *(float*)(rec + RC_D + x * 4) = D;
    f32x16 G;
#pragma unroll
    for (int r = 0; r < 16; ++r) G[r] = 0.f;
#pragma unroll
    for (int ks = 0; ks < 4; ++ks) { const bf16x8 a = *(const LAS bf16x8*)(XA + r32 * 72 + ks * 16 + h2 * 8), bq = *(const LAS bf16x8*)(XB + r32 * 72 + ks * 16 + h2 * 8);
        G = __builtin_amdgcn_mfma_f32_32x32x16_bf16(a, bq, G, 0, 0, 0); }
    LAS float* GA = (LAS float*)wlds; LAS float* GT = (LAS float*)(wlds + 4608);
#pragma unroll
    for (int r = 0; r < 16; ++r) GA[((r & 3) + 8 * (r >> 2) + 4 * h2) * 36 + r32] = G[r];
#pragma unroll
    for (int g4 = 0; g4 < 4; ++g4) *(LAS f32x4*)(GT + r32 * 36 + 8 * g4 + 4 * h2) = (f32x4){G[4 * g4], G[4 * g4 + 1], G[4 * g4 + 2], G[4 * g4 + 3]};
#define RC_LD16(dst, p, n4) do { _Pragma("unroll") for (int i4_ = 0; i4_ < (n4); ++i4_) { const f32x4 v4_ = *(const LAS f32x4*)((p) + 4 * i4_); dst[4 * i4_] = v4_.x; dst[4 * i4_ + 1] = v4_.y; dst[4 * i4_ + 2] = v4_.z; dst[4 * i4_ + 3] = v4_.w; } } while (0)
    float Tc[16];
#pragma unroll
    for (int m = 0; m < 16; ++m) Tc[m] = (m == tl) ? 1.0f : 0.0f;
#pragma unroll
    for (int s = 14; s >= 0; --s) { float nr[16]; float acc = 0.f;
#pragma unroll
        for (int i4 = (s + 1) / 4; i4 < 4; ++i4) { const f32x4 v4 = *(const LAS f32x4*)(GA + s * 36 + 4 * i4); nr[4 * i4] = v4.x; nr[4 * i4 + 1] = v4.y; nr[4 * i4 + 2] = v4.z; nr[4 * i4 + 3] = v4.w; }
#pragma unroll
        for (int m = s + 1; m < 16; ++m) acc += nr[m] * Tc[m];
        Tc[s] = (s < tl) ? acc : Tc[s]; }
    if (x < 16) {
#pragma unroll
        for (int g4 = 0; g4 < 4; ++g4) *(LAS f32x4*)(TT + tl * 16 + 4 * g4) = (f32x4){Tc[4 * g4], Tc[4 * g4 + 1], Tc[4 * g4 + 2], Tc[4 * g4 + 3]}; }
    float PV[16];
    PV[0] = 0.f;
#pragma unroll
    for (int s = 1; s < 16; ++s) { float acc = 0.f;
#pragma unroll
        for (int r = 0; r < s; ++r) acc += GT[s * 36 + 16 + r] * vv[r];
        PV[s] = acc; }
    float Ah[16], U0[16];
#pragma unroll
    for (int t = 0; t < 16; ++t) { float a = 0.f, uu = 0.f;
#pragma unroll
        for (int s = 0; s <= t; ++s) { const float tv = TT[t * 16 + s]; a += tv * At[s]; uu += tv * PV[s]; }
        Ah[t] = a; U0[t] = uu; }
    float Rh[16], Y0[16];
#pragma unroll
    for (int t = 0; t < 16; ++t) { float a = Rt[t], yy = 0.f;
#pragma unroll
        for (int s = 0; s <= t; ++s) { const float m1 = GT[(16 + t) * 36 + s], m2 = GT[(16 + t) * 36 + 16 + s]; a += m1 * Ah[s]; yy += m1 * U0[s] + m2 * vv[s]; }
        Rh[t] = a; Y0[t] = yy; }
#undef RC_LD16
    { const int ks = x >> 5, jj = x & 31, e = (jj >> 4) * 4 + (jj & 3), q = (jj >> 2) & 3; unsigned char* pb = rec + RC_AR + ks * 1024 + q * 256 + e * 2;
#pragma unroll
      for (int s = 0; s < 16; ++s) { *(bf16*)(pb + s * 16) = cvt1_c(Ah[s]); *(bf16*)(pb + 2048 + s * 16) = cvt1_c(Rh[s]); } }
#pragma unroll
    for (int q = 0; q < 2; ++q) { v4u w;
        w.x = cvtpk_c(U0[8 * q], U0[8 * q + 1]); w.y = cvtpk_c(U0[8 * q + 2], U0[8 * q + 3]); w.z = cvtpk_c(U0[8 * q + 4], U0[8 * q + 5]); w.w = cvtpk_c(U0[8 * q + 6], U0[8 * q + 7]); *(v4u*)(rec + RC_U0 + x * 32 + q * 16) = w;
        w.x = cvtpk_c(Y0[8 * q], Y0[8 * q + 1]); w.y = cvtpk_c(Y0[8 * q + 2], Y0[8 * q + 3]); w.z = cvtpk_c(Y0[8 * q + 4], Y0[8 * q + 5]); w.w = cvtpk_c(Y0[8 * q + 6], Y0[8 * q + 7]); *(v4u*)(rec + RC_Y0 + x * 32 + q * 16) = w; }
    LDS_WAIT();
}
__device__ __forceinline__ void rc_pass1_rwkv(Frame& F, int wid, int nw, int c0, int nc) {
    LAS unsigned char* wlds = F.lds + F.wave * RC_WLDS;
    const int x = F.lane;
    const float* RW = (const float*)(FWS + WS_RW);
    const bf16* RH = (const bf16*)(FWS + WS_RW + 32 * MiB);
    for (int it2 = wid; it2 < 16 * nc; it2 += nw) {
        const int u = it2 / nc, c = c0 + it2 % nc, it = u * RC_NCH + c, b = u >> 3, h = u & 7; const size_t o0 = ((size_t)(b * SEQ + c * 16)) * 512 + h * 64 + x;
        float At[16], Bt[16], Kt[16], Rt[16], vv[16]; float W = 1.0f;
#pragma unroll
        for (int t = 0; t < 16; ++t) { const size_t o = o0 + (size_t)t * 512;
            const float wv = RW[o], ka = bf2f(RH[3 * RWA + o]), bb = bf2f(RH[4 * RWA + o]), kk = bf2f(RH[1 * RWA + o]), rr = bf2f(RH[0 * RWA + o]); vv[t] = bf2f(RH[2 * RWA + o]);
            At[t] = -ka * W; W *= wv; const float iw = 1.0f / W; Bt[t] = bb * iw; Kt[t] = kk * iw; Rt[t] = rr * W; }
        rc_core(F, wlds, At, Bt, Kt, Rt, vv, W, FWS + WS_REC + (size_t)it * RC_REC);
    }
}
__device__ __forceinline__ void rc_core_ret(Frame& F, LAS unsigned char* wlds, const float (&Kt)[16], const float (&Rt)[16], const float (&vv)[16], const float D, unsigned char* rec) {
    { unsigned wb_ = (unsigned)(uintptr_t)wlds; asm volatile("" : "+v"(wb_)); wlds = (LAS unsigned char*)(uintptr_t)wb_; }
    LAS bf16* XK = (LAS bf16*)wlds; LAS bf16* XR = (LAS bf16*)(wlds + 2304); LAS float* GM = (LAS float*)(wlds + 4608);
    int x_ = F.lane; asm volatile("" : "+v"(x_));
    const int x = x_, fr = x & 15, q = x >> 4;
#pragma unroll
    for (int t = 0; t < 16; ++t) { XK[t * 72 + x] = cvt1_c(Kt[t]); XR[t * 72 + x] = cvt1_c(Rt[t]); }
#pragma unroll
    for (int qq = 0; qq < 4; ++qq) { v4u w; w.x = 0u; w.y = 0u;
        w.z = cvtpk_c(Kt[4 * qq] * D, Kt[4 * qq + 1] * D); w.w = cvtpk_c(Kt[4 * qq + 2] * D, Kt[4 * qq + 3] * D); *(v4u*)(rec + RC_BK + x * 64 + qq * 16) = w; }
#pragma unroll
    for (int qq = 0; qq < 2; ++qq) { v4u w;
        w.x = cvtpk_c(vv[8 * qq], vv[8 * qq + 1]); w.y = cvtpk_c(vv[8 * qq + 2], vv[8 * qq + 3]); w.z = cvtpk_c(vv[8 * qq + 4], vv[8 * qq + 5]); w.w = cvtpk_c(vv[8 * qq + 6], vv[8 * qq + 7]); *(v4u*)(rec + RC_VP + x * 32 + qq * 16) = w;
        *(v4u*)(rec + RC_U0 + x * 32 + qq * 16) = (v4u){0u, 0u, 0u, 0u}; }
    *(float*)(rec + RC_D + x * 4) = D;
    { const int ks = x >> 5, jj = x & 31, e = (jj >> 4) * 4 + (jj & 3), qv = (jj >> 2) & 3; unsigned char* pb = rec + RC_AR + ks * 1024 + qv * 256 + e * 2;
#pragma unroll
      for (int s = 0; s < 16; ++s) { *(bf16*)(pb + s * 16) = (bf16)0; *(bf16*)(pb + 2048 + s * 16) = cvt1_c(Rt[s]); } }
    f32x4 G = {0.f, 0.f, 0.f, 0.f};
#pragma unroll
    for (int ks = 0; ks < 2; ++ks) { const bf16x8 a = *(const LAS bf16x8*)(XK + fr * 72 + ks * 32 + q * 8), bq = *(const LAS bf16x8*)(XR + fr * 72 + ks * 32 + q * 8);
        G = __builtin_amdgcn_mfma_f32_16x16x32_bf16(a, bq, G, 0, 0, 0); }
#pragma unroll
    for (int rg = 0; rg < 4; ++rg) GM[(4 * q + rg) * 17 + fr] = G[rg];
    float Y0[16];
#pragma unroll
    for (int t = 0; t < 16; ++t) { float yy = 0.f;
#pragma unroll
        for (int s = 0; s <= t; ++s) yy += GM[s * 17 + t] * vv[s];
        Y0[t] = yy; }
#pragma unroll
    for (int qq = 0; qq < 2; ++qq) { v4u w;
        w.x = cvtpk_c(Y0[8 * qq], Y0[8 * qq + 1]); w.y = cvtpk_c(Y0[8 * qq + 2], Y0[8 * qq + 3]); w.z = cvtpk_c(Y0[8 * qq + 4], Y0[8 * qq + 5]); w.w = cvtpk_c(Y0[8 * qq + 6], Y0[8 * qq + 7]); *(v4u*)(rec + RC_Y0 + x * 32 + qq * 16) = w; }
    LDS_WAIT();
}
__device__ __forceinline__ void rc_pass1_ret(Frame& F, int wid, int nw, int c0, int nc) {
    LAS unsigned char* wlds = F.lds + F.wave * RC_WLDS;
    const int x = F.lane;
    const bf16* P = (const bf16*)(FWS + WS_PROJ);
    for (int it2 = wid; it2 < 16 * nc; it2 += nw) {
        const int ru = it2 / nc, c = c0 + it2 % nc, it = ru * RC_NCH + c, b = ru >> 3, h = (ru >> 1) & 3, half = ru & 1; const float gamma = 1.0f - exp2f(-5.0f - (float)h);
        float Kt[16], Rt[16], vv[16]; float W = 1.0f;
        const bf16* p0 = P + (size_t)(b * SEQ + c * 16) * IN_PAD;
#pragma unroll
        for (int t = 0; t < 16; ++t) { const bf16* p = p0 + (size_t)t * IN_PAD;
            const float rr = bf2f(p[C_RQ + h * 64 + x]), kk = bf2f(p[C_RK + h * 64 + x]) * 0.125f; vv[t] = bf2f(p[C_RV + h * 128 + half * 64 + x]);
            W *= gamma; const float iw = 1.0f / W; Kt[t] = kk * iw; Rt[t] = rr * W; }
        rc_core_ret(F, wlds, Kt, Rt, vv, W, FWS + WS_REC + (size_t)(16 * RC_NCH + it) * RC_REC);
    }
}
__device__ __forceinline__ void rwkv_prep_mfma(Frame& F, int l, int first, int stride) {
    LAS unsigned char* wlds = F.lds + F.wave * RC_WLDS;
    LAS bf16* CODES = (LAS bf16*)(F.lds + RC_CODES_OFF);
    LAS float* ST = (LAS float*)wlds;
    const bf16* P = (const bf16*)(FWS + WS_PROJ);
    const float* mu = F.in[F.zz + 4] + l * RWC;
    const bf16* WT = (const bf16*)(FWS + WS_RWW + (size_t)l * 448 * 512 * 2);
    float* RW = (float*)(FWS + WS_RW);
    const int x = F.lane, h = F.wave, ch = h * 64 + x, fr = x & 15, q = x >> 4;
    for (int item = first; item < NB * RC_NCH; item += stride) {
        const int b = item >> 8, c = item & 255; const size_t row0 = (size_t)b * SEQ + c * 16; const int t0 = c * 16;
        const bf16* prc = P + row0 * IN_PAD + C_RW + ch;
        unsigned short nr_[4], nk_[4], nv_[4]; float pvr = 0.f, pvk = 0.f, pvv = 0.f;
        if (t0 > 0) { pvr = bf2f(prc[-IN_PAD]); pvk = bf2f(prc[512 - IN_PAD]); pvv = bf2f(prc[1024 - IN_PAD]); }
#pragma unroll
        for (int tt = 0; tt < 4; ++tt) { nr_[tt] = prc[(size_t)tt * IN_PAD]; nk_[tt] = prc[(size_t)tt * IN_PAD + 512]; nv_[tt] = prc[(size_t)tt * IN_PAD + 1024]; }
        const float mur = mu[ch], muk = mu[512 + ch], muv = mu[1024 + ch];
        const float w0c = F.in[F.zz + 5][l * 512 + ch], a0c = F.in[F.zz + 7][l * 512 + ch], kkc = F.in[F.zz + 10][l * 512 + ch], kac = F.in[F.zz + 11][l * 512 + ch], rkc = F.in[F.zz + 12][l * 512 + ch];
#pragma unroll 7
        for (int idx = F.tid; idx < 16 * 448; idx += NTHR) { const int tk = idx / 448, cc = idx - tk * 448;
            float val = lerp_bf(P, row0 + tk, C_RW + 1536 + cc, (t0 + tk) > 0, mu[1536 + cc]);
            if (cc < 96) val = 1.0f - 2.0f * __builtin_amdgcn_rcpf(1.0f + __expf(2.0f * val));
            else if (cc >= 192) val = sigmoidf_(val);
            CODES[tk * RC_CSTRIDE + cc] = cvt1_c(val); }
        __syncthreads();
        f32x4 accW[4], accA[4], accG[4];
#pragma unroll
        for (int ct = 0; ct < 4; ++ct) { accW[ct] = (f32x4){0.f, 0.f, 0.f, 0.f}; accA[ct] = accW[ct]; accG[ct] = accW[ct]; }
        { bf16x8 bw[3][4];
#pragma unroll
          for (int ks = 0; ks < 3; ++ks)
#pragma unroll
              for (int ct = 0; ct < 4; ++ct) bw[ks][ct] = *(const bf16x8*)(WT + (size_t)(h * 64 + ct * 16 + fr) * 96 + ks * 32 + q * 8);
#pragma unroll
          for (int ks = 0; ks < 3; ++ks) { const bf16x8 aw = *(const LAS bf16x8*)(CODES + fr * RC_CSTRIDE + ks * 32 + q * 8);
#pragma unroll
              for (int ct = 0; ct < 4; ++ct) accW[ct] = __builtin_amdgcn_mfma_f32_16x16x32_bf16(aw, bw[ks][ct], accW[ct], 0, 0, 0); } }
        asm volatile("" ::: "memory");
        { bf16x8 ba[3][4];
#pragma unroll
          for (int ks = 0; ks < 3; ++ks)
#pragma unroll
              for (int ct = 0; ct < 4; ++ct) ba[ks][ct] = *(const bf16x8*)(WT + 512 * 96 + (size_t)(h * 64 + ct * 16 + fr) * 96 + ks * 32 + q * 8);
#pragma unroll
          for (int ks = 0; ks < 3; ++ks) { const bf16x8 aa = *(const LAS bf16x8*)(CODES + fr * RC_CSTRIDE + 96 + ks * 32 + q * 8);
#pragma unroll
              for (int ct = 0; ct < 4; ++ct) accA[ct] = __builtin_amdgcn_mfma_f32_16x16x32_bf16(aa, ba[ks][ct], accA[ct], 0, 0, 0); } }
        asm volatile("" ::: "memory");
#pragma unroll
        for (int hf = 0; hf < 2; ++hf) { bf16x8 bg[4][4];
#pragma unroll
            for (int k4 = 0; k4 < 4; ++k4)
#pragma unroll
                for (int ct = 0; ct < 4; ++ct) bg[k4][ct] = *(const bf16x8*)(WT + 2 * 512 * 96 + (size_t)(h * 64 + ct * 16 + fr) * 256 + (hf * 4 + k4) * 32 + q * 8);
#pragma unroll
            for (int k4 = 0; k4 < 4; ++k4) { const bf16x8 ag = *(const LAS bf16x8*)(CODES + fr * RC_CSTRIDE + 192 + (hf * 4 + k4) * 32 + q * 8);
#pragma unroll
                for (int ct = 0; ct < 4; ++ct) accG[ct] = __builtin_amdgcn_mfma_f32_16x16x32_bf16(ag, bg[k4][ct], accG[ct], 0, 0, 0); }
            asm volatile("" ::: "memory"); }
#pragma unroll
        for (int ct = 0; ct < 4; ++ct)
#pragma unroll
            for (int rg = 0; rg < 4; ++rg) { const int o = (4 * q + rg) * 64 + ct * 16 + fr; ST[o] = accW[ct][rg]; ST[1024 + o] = accA[ct][rg]; ST[2048 + o] = accG[ct][rg]; }
        float* gpw = RW + row0 * 512 + ch;
        bf16* gp = (bf16*)(FWS + WS_RW + 32 * MiB) + row0 * 512 + ch;
        for (int g = 0; g < 4; ++g) {
            unsigned short cr_[4], ck_[4], cv_[4];
#pragma unroll
            for (int tt = 0; tt < 4; ++tt) { cr_[tt] = nr_[tt]; ck_[tt] = nk_[tt]; cv_[tt] = nv_[tt]; }
            if (g < 3) {
#pragma unroll
                for (int tt = 0; tt < 4; ++tt) { const size_t ro = (size_t)(4 * g + 4 + tt) * IN_PAD; nr_[tt] = prc[ro]; nk_[tt] = prc[ro + 512]; nv_[tt] = prc[ro + 1024]; } }
#pragma unroll
          for (int tt = 0; tt < 4; ++tt) { const int t = 4 * g + tt;
            const float cr = bf2f(cr_[tt]), ck = bf2f(ck_[tt]), cv = bf2f(cv_[tt]);
            const float rr = cr + (pvr - cr) * mur, kk0 = ck + (pvk - ck) * muk, vv = cv + (pvv - cv) * muv;
            pvr = cr; pvk = ck; pvv = cv;
            const float z = -(w0c + ST[t * 64 + x]);
            const float sp = fmaxf(z, 0.f) + log1pf(__expf(-fabsf(z)));
            const float decay = __expf(-__expf(-sp - 0.5f));
            const float a = sigmoidf_(a0c + ST[1024 + t * 64 + x]);
            const float gg = ST[2048 + t * 64 + x];
            const float kkv = kk0 * kkc;
            const float nrm = sqrtf(wave_sum(kkv * kkv));
            const float kap = kkv / fmaxf(nrm, 1e-12f);
            const float kp = kk0 * (1.0f + (a - 1.0f) * kac);
            const float bsum = wave_sum(rr * kp * rkc);
            gpw[0] = decay; gpw += 512;
            gp[0 * RWA] = cvt1_c(rr); gp[1 * RWA] = cvt1_c(kp); gp[2 * RWA] = cvt1_c(vv); gp[3 * RWA] = cvt1_c(kap); gp[4 * RWA] = cvt1_c(kap * a); gp[5 * RWA] = cvt1_c(gg); gp[6 * RWA] = cvt1_c(bsum * vv); gp += 512; } }
        LDS_WAIT();
        __syncthreads();
    }
}
constexpr int RC_SLOT = 15360, RC_YST = 8 * RC_SLOT  ;
__device__ __forceinline__ void rc_pass2(Frame& F, int u, int cb, int ce, bool first, bool last) {
    const unsigned char* rec = FWS + WS_REC + (size_t)u * RC_NCH * RC_REC;
    const int lane = F.lane;
    const int NIT = (ce - cb) / 2;
    bf16* Yg;
    if (u < 16) Yg = (bf16*)(FWS + WS_Y) + (size_t)((u >> 3) * SEQ) * 512 + (u & 7) * 64;
    else { const int ru = u - 16; Yg = (bf16*)(FWS + WS_RETO) + (size_t)((ru >> 3) * SEQ) * 512 + ((ru >> 1) & 3) * 128 + (ru & 1) * 64; }
#define RC_BARRIER() __builtin_amdgcn_s_barrier()
    if (F.wave == 7) {
        unsigned t0_ = 0u, t1_ = 0u, t2_ = 0u, t3_ = 0u;
        for (int cq = cb; cq < cb + 24 && cq < ce; cq += 2) { const unsigned char* pa = rec + (size_t)cq * RC_REC + lane * 128; const unsigned char* pb = pa + 8192; const unsigned char* pc = pa + RC_REC; const unsigned char* pd = pb + RC_REC;
            asm volatile("global_load_dword %0, %4, off\n\tglobal_load_dword %1, %5, off\n\tglobal_load_dword %2, %6, off\n\tglobal_load_dword %3, %7, off" : "+v"(t0_), "+v"(t1_), "+v"(t2_), "+v"(t3_) : "v"(pa), "v"(pb), "v"(pc), "v"(pd) : "memory"); }
        RC_BARRIER();
        for (int i = 0; i < NIT; ++i) {
            const int cp = cb + 2 * i + 24;
            if (cp < ce) { const unsigned char* pa = rec + (size_t)cp * RC_REC + lane * 128; const unsigned char* pb = pa + 8192; const unsigned char* pc = pa + RC_REC; const unsigned char* pd = pb + RC_REC;
                asm volatile("global_load_dword %0, %4, off\n\tglobal_load_dword %1, %5, off\n\tglobal_load_dword %2, %6, off\n\tglobal_load_dword %3, %7, off" : "+v"(t0_), "+v"(t1_), "+v"(t2_), "+v"(t3_) : "v"(pa), "v"(pb), "v"(pc), "v"(pd) : "memory"); }
            if (i > 0) {
                const LAS unsigned char* yb = F.lds + RC_YST + ((i - 1) & 1) * 4096;
#pragma unroll
                for (int j = 0; j < 4; ++j) { const v4u w = *(const LAS v4u*)(yb + j * 1024 + lane * 16);
                    *(v4u*)(Yg + (size_t)((cb + 2 * i - 2) * 16 + j * 8 + (lane >> 3)) * 512 + (lane & 7) * 8) = w; } }
            RC_BARRIER();
        }
        { const LAS unsigned char* yb = F.lds + RC_YST + ((NIT - 1) & 1) * 4096;
#pragma unroll
          for (int j = 0; j < 4; ++j) { const v4u w = *(const LAS v4u*)(yb + j * 1024 + lane * 16);
              *(v4u*)(Yg + (size_t)((cb + 2 * NIT - 2) * 16 + j * 8 + (lane >> 3)) * 512 + (lane & 7) * 8) = w; } }
        asm volatile("s_waitcnt vmcnt(0)" ::: "memory");
        asm volatile("" :: "v"(t0_), "v"(t1_), "v"(t2_), "v"(t3_));
    } else if (F.wave >= 4) {
        const int lw = F.wave - 4;
        const int p0_ = lw == 0 ? 8 : (lw == 1 ? 11 : 13), np_ = lw == 0 ? 3 : 2;
#define RC_ISSUE(c) do { _Pragma("unroll") for (int i_ = 0; i_ < 3; ++i_) { if (i_ < np_) \
            __builtin_amdgcn_global_load_lds((const unsigned*)(rec + (size_t)(c) * RC_REC + (p0_ + i_) * 1024 + lane * 16), (LAS unsigned*)(F.lds + ((c) & 7) * RC_SLOT + (p0_ + i_) * 1024), 16, 0, 0); } } while (0)
#define RC_WAIT4() do { if (lw == 0) asm volatile("s_waitcnt vmcnt(12)" ::: "memory"); else asm volatile("s_waitcnt vmcnt(8)" ::: "memory"); } while (0)
        for (int c = cb; c < cb + 6; ++c) RC_ISSUE(c);
        RC_WAIT4();
        RC_BARRIER();
        for (int i = 0; i < NIT; ++i) {
            if (cb + 2 * i + 7 < ce) { RC_ISSUE(cb + 2 * i + 6); RC_ISSUE(cb + 2 * i + 7); RC_WAIT4(); }
            else asm volatile("s_waitcnt vmcnt(0)" ::: "memory");
            RC_BARRIER();
        }
#undef RC_ISSUE
#undef RC_WAIT4
    } else {
        const int ib = F.wave, fr = lane & 15, q = lane >> 4;
#define RC_ISSUE1(c) do { __builtin_amdgcn_global_load_lds((const unsigned*)(rec + (size_t)(c) * RC_REC + (2 * ib) * 1024 + lane * 16), (LAS unsigned*)(F.lds + ((c) & 7) * RC_SLOT + (2 * ib) * 1024), 16, 0, 0); \
        __builtin_amdgcn_global_load_lds((const unsigned*)(rec + (size_t)(c) * RC_REC + (2 * ib + 1) * 1024 + lane * 16), (LAS unsigned*)(F.lds + ((c) & 7) * RC_SLOT + (2 * ib + 1) * 1024), 16, 0, 0); } while (0)
        f32x4* sv = (f32x4*)(FWS + WS_CTL + 262144) + (size_t)((u * 4 + ib) * 4 + 0) * 64 + lane;
        f32x4 sT[4];
#pragma unroll
        for (int jb = 0; jb < 4; ++jb) sT[jb] = first ? (f32x4){0.f, 0.f, 0.f, 0.f} : sv[jb * 64];
        asm volatile("s_waitcnt vmcnt(0)" ::: "memory");
        for (int c = cb; c < cb + 6; ++c) RC_ISSUE1(c);
        asm volatile("s_waitcnt vmcnt(8)" ::: "memory");
        RC_BARRIER();
        for (int i = 0; i < NIT; ++i) {
            bf16x8 aU0[2], aU1[2], aY0[2], aY1[2], bk[2][4]; f32x4 dd[2][4]; v2u vp[2], u0[2], y0[2];
#pragma unroll
            for (int h = 0; h < 2; ++h) { const LAS unsigned char* slot = F.lds + ((cb + 2 * i + h) & 7) * RC_SLOT;
                aU0[h] = *(const LAS bf16x8*)(slot + RC_AR + q * 256 + fr * 16); aU1[h] = *(const LAS bf16x8*)(slot + RC_AR + 1024 + q * 256 + fr * 16);
                aY0[h] = *(const LAS bf16x8*)(slot + RC_AR + 2048 + q * 256 + fr * 16); aY1[h] = *(const LAS bf16x8*)(slot + RC_AR + 3072 + q * 256 + fr * 16);
                u0[h] = *(const LAS v2u*)(slot + RC_U0 + (16 * ib + fr) * 32 + q * 8); vp[h] = *(const LAS v2u*)(slot + RC_VP + (16 * ib + fr) * 32 + q * 8);
#pragma unroll
                for (int jb = 0; jb < 4; ++jb) { bk[h][jb] = *(const LAS bf16x8*)(slot + RC_BK + (16 * jb + fr) * 64 + q * 16); dd[h][jb] = *(const LAS f32x4*)(slot + RC_D + (16 * jb + 4 * q) * 4); }
                y0[h] = *(const LAS v2u*)(slot + RC_Y0 + (16 * ib + fr) * 32 + q * 8); }
            LAS bf16* yst = (LAS bf16*)(F.lds + RC_YST + (i & 1) * 4096);
#pragma unroll
            for (int h = 0; h < 2; ++h) {
                v4u s0, s1;
                s0.x = cvtpk_c(sT[0][0], sT[0][1]); s0.y = cvtpk_c(sT[0][2], sT[0][3]); s0.z = cvtpk_c(sT[1][0], sT[1][1]); s0.w = cvtpk_c(sT[1][2], sT[1][3]);
                s1.x = cvtpk_c(sT[2][0], sT[2][1]); s1.y = cvtpk_c(sT[2][2], sT[2][3]); s1.z = cvtpk_c(sT[3][0], sT[3][1]); s1.w = cvtpk_c(sT[3][2], sT[3][3]);
                const bf16x8 sb0 = __builtin_bit_cast(bf16x8, s0), sb1 = __builtin_bit_cast(bf16x8, s1);
                f32x4 zU = (f32x4){0.f, 0.f, 0.f, 0.f}, zY = (f32x4){0.f, 0.f, 0.f, 0.f};
                zU = __builtin_amdgcn_mfma_f32_16x16x32_bf16(aU0[h], sb0, zU, 0, 0, 0); zU = __builtin_amdgcn_mfma_f32_16x16x32_bf16(aU1[h], sb1, zU, 0, 0, 0);
                const float U0_ = zU[0] + bflo(u0[h].x), U1_ = zU[1] + bfhi(u0[h].x), U2_ = zU[2] + bflo(u0[h].y), U3_ = zU[3] + bfhi(u0[h].y);
                v4u ubw; ubw.x = cvtpk_c(U0_, U1_); ubw.y = cvtpk_c(U2_, U3_); ubw.z = vp[h].x; ubw.w = vp[h].y;
                const bf16x8 ub = __builtin_bit_cast(bf16x8, ubw);
#pragma unroll
                for (int jb = 0; jb < 4; ++jb) sT[jb] = __builtin_amdgcn_mfma_f32_16x16x32_bf16(bk[h][jb], ub, sT[jb] * dd[h][jb], 0, 0, 0);
                zY = __builtin_amdgcn_mfma_f32_16x16x32_bf16(aY0[h], sb0, zY, 0, 0, 0); zY = __builtin_amdgcn_mfma_f32_16x16x32_bf16(aY1[h], sb1, zY, 0, 0, 0);
                LAS bf16* yp = yst + h * 1024 + (4 * q) * 64 + 16 * ib + fr;
                yp[0] = cvt1_c(zY[0] + bflo(y0[h].x)); yp[64] = cvt1_c(zY[1] + bfhi(y0[h].x)); yp[128] = cvt1_c(zY[2] + bflo(y0[h].y)); yp[192] = cvt1_c(zY[3] + bfhi(y0[h].y));
            }
            if (cb + 2 * i + 7 < ce) { RC_ISSUE1(cb + 2 * i + 6); RC_ISSUE1(cb + 2 * i + 7); asm volatile("s_waitcnt vmcnt(8) lgkmcnt(0)" ::: "memory"); } else asm volatile("s_waitcnt vmcnt(0) lgkmcnt(0)" ::: "memory");
            RC_BARRIER();
        }
        if (!last) {
#pragma unroll
            for (int jb = 0; jb < 4; ++jb) sv[jb * 64] = sT[jb]; }
#undef RC_ISSUE1
    }
#undef RC_BARRIER
    asm volatile("s_waitcnt vmcnt(0) lgkmcnt(0)" ::: "memory");
    __syncthreads();
}
__device__ __forceinline__ void sub_arrive(Frame& F, unsigned* cnt) {
    asm volatile("s_waitcnt vmcnt(0)" ::: "memory");
    __syncthreads();
    if (F.tid == 0) { __builtin_amdgcn_fence(__ATOMIC_RELEASE, "agent"); asm volatile("s_waitcnt vmcnt(0)" ::: "memory"); __hip_atomic_fetch_add(cnt, 1u, __ATOMIC_RELAXED, __HIP_MEMORY_SCOPE_AGENT); }
}
__device__ __forceinline__ void sub_wait(Frame& F, unsigned* cnt, unsigned target) {
    if (F.tid == 0) { unsigned sp = 0u;
        while (__hip_atomic_load(cnt, __ATOMIC_RELAXED, __HIP_MEMORY_SCOPE_AGENT) < target) { __builtin_amdgcn_s_sleep(2); if (++sp > (1u << 24)) break; }
        __builtin_amdgcn_fence(__ATOMIC_ACQUIRE, "agent"); asm volatile("s_waitcnt vmcnt(0)" ::: "memory"); }
    __syncthreads();
}
__device__ __forceinline__ void sub_barrier(Frame& F, unsigned* cnt, unsigned target) {
    asm volatile("s_waitcnt vmcnt(0)" ::: "memory");
    __syncthreads();
    if (F.tid == 0) {
        __builtin_amdgcn_fence(__ATOMIC_RELEASE, "agent");
        asm volatile("s_waitcnt vmcnt(0)" ::: "memory");
        __hip_atomic_fetch_add(cnt, 1u, __ATOMIC_RELAXED, __HIP_MEMORY_SCOPE_AGENT);
        unsigned sp = 0u;
        while (__hip_atomic_load(cnt, __ATOMIC_RELAXED, __HIP_MEMORY_SCOPE_AGENT) < target) { __builtin_amdgcn_s_sleep(2); if (++sp > (1u << 24)) break; }
        __builtin_amdgcn_fence(__ATOMIC_ACQUIRE, "agent");
        asm volatile("s_waitcnt vmcnt(0)" ::: "memory");
    }
    __syncthreads();
}
__device__ __forceinline__ void mixer_post(Frame& F, int l, int gw, int NGW) {
    const bf16* P = (const bf16*)(FWS + WS_PROJ);
    const bf16* RH = (const bf16*)(FWS + WS_RW + 32 * MiB);
    const float* RW = (const float*)(FWS + WS_RW);
    const bf16* Y = (const bf16*)(FWS + WS_Y);
    const bf16* RO = (const bf16*)(FWS + WS_RETO);
    bf16* MX = (bf16*)(FWS + WS_MIXED);
    const float* ln_w = F.in[F.zz + 13] + l * 512; const float* ln_b = F.in[F.zz + 14] + l * 512;
    const int lane = F.lane;
    for (int m = gw; m < MROWS; m += NGW) {
        const size_t o = (size_t)m * 512;
        float y[8], s1[8], s2[8], bon[8], gat[8]; f32x2 ov[4]; float s3[4]; unsigned gw2[4];
#pragma unroll
        for (int h = 0; h < 8; ++h) { const int c = h * 64 + lane; y[h] = bf2f(Y[o + c]); bon[h] = bf2f(RH[6 * RWA + o + c]); gat[h] = bf2f(RH[5 * RWA + o + c]); s1[h] = y[h]; }
#pragma unroll
        for (int h = 0; h < 4; ++h) { const int c = h * 128 + 2 * lane; { const unsigned rw_ = *(const unsigned*)(RO + o + c); ov[h].x = bflo(rw_); ov[h].y = bfhi(rw_); } gw2[h] = *(const unsigned*)(P + (size_t)m * IN_PAD + C_RG + c); s3[h] = ov[h].x * ov[h].x + ov[h].y * ov[h].y; }
#pragma unroll
        for (int h = 0; h < 8; ++h) { s1[h] = dpp_add<0xB1>(s1[h]); s1[h] = dpp_add<0x4E>(s1[h]); s1[h] = dpp_add<0x141>(s1[h]); s1[h] = dpp_add<0x140>(s1[h]); }
#pragma unroll
        for (int h = 0; h < 4; ++h) { s3[h] = dpp_add<0xB1>(s3[h]); s3[h] = dpp_add<0x4E>(s3[h]); s3[h] = dpp_add<0x141>(s3[h]); s3[h] = dpp_add<0x140>(s3[h]); }
#pragma unroll
        for (int of = 16; of < 64; of <<= 1) {
#pragma unroll
            for (int h = 0; h < 8; ++h) s1[h] += __shfl_xor(s1[h], of);
#pragma unroll
            for (int h = 0; h < 4; ++h) s3[h] += __shfl_xor(s3[h], of); }
#pragma unroll
        for (int h = 0; h < 8; ++h) { const float d = y[h] - s1[h] * (1.0f / 64.0f); y[h] = d; s2[h] = d * d; }
#pragma unroll
        for (int h = 0; h < 8; ++h) { s2[h] = dpp_add<0xB1>(s2[h]); s2[h] = dpp_add<0x4E>(s2[h]); s2[h] = dpp_add<0x141>(s2[h]); s2[h] = dpp_add<0x140>(s2[h]); }
#pragma unroll
        for (int of = 16; of < 64; of <<= 1) {
#pragma unroll
            for (int h = 0; h < 8; ++h) s2[h] += __shfl_xor(s2[h], of); }
#pragma unroll
        for (int h = 0; h < 8; ++h) { const int c = h * 64 + lane;
            const float yn = y[h] * (1.0f / sqrtf(s2[h] * (1.0f / 64.0f) + GN_EPS)) * ln_w[c] + ln_b[c];
            MX[(size_t)m * DM + 512 + c] = (bf16)f2bf((yn + bon[h]) * gat[h]); }
#pragma unroll
        for (int h = 0; h < 4; ++h) { const int c = h * 128 + 2 * lane;
            const float rn = 1.0f / sqrtf(s3[h] * (1.0f / 128.0f) + NORM_EPS);
            const float g0 = bflo(gw2[h]), g1 = bfhi(gw2[h]);
            *(unsigned*)(MX + (size_t)m * DM + c) = pk2(ov[h].x * rn * g0 * sigmoidf_(g0), ov[h].y * rn * g1 * sigmoidf_(g1)); }
    }
}
__device__ __forceinline__ void conv_gate_phase(Frame& F, int l) {
    const bf16* U = (const bf16*)(FWS + WS_U);
    bf16* A = (bf16*)(FWS + WS_ACT);
    const float* cw = F.in[F.zz + 16] + (size_t)l * 3 * UPC; const float* cb = F.in[F.zz + 17] + (size_t)l * UPC;
    constexpr int NCG = DFF / 8, NRC = MROWS / 16;
    for (int it = F.vcu * NTHR + F.tid; it < NCG * NRC; it += F.G * NTHR) {
        const int cg = it % NCG, rc = it / NCG, c0 = cg * 8, row0 = rc * 16, t0 = row0 & (SEQ - 1);
        float wv[3][8], wg[3][8], bv[8], bg[8];
#pragma unroll
        for (int j = 0; j < 3; ++j)
#pragma unroll
            for (int e = 0; e < 8; ++e) { wv[j][e] = cw[j * UPC + c0 + e]; wg[j][e] = cw[j * UPC + DFF + c0 + e]; }
#pragma unroll
        for (int e = 0; e < 8; ++e) { bv[e] = cb[c0 + e]; bg[e] = cb[DFF + c0 + e]; }
        v4u v0 = {0u, 0u, 0u, 0u}, v1 = v0, g0 = v0, g1 = v0;
        if (t0 > 0) { v0 = *(const v4u*)(U + (size_t)(row0 - 2) * UPC + c0); v1 = *(const v4u*)(U + (size_t)(row0 - 1) * UPC + c0);
                      g0 = *(const v4u*)(U + (size_t)(row0 - 2) * UPC + DFF + c0); g1 = *(const v4u*)(U + (size_t)(row0 - 1) * UPC + DFF + c0); }
        for (int r = 0; r < 16; ++r) {
            const v4u v2 = *(const v4u*)(U + (size_t)(row0 + r) * UPC + c0), g2 = *(const v4u*)(U + (size_t)(row0 + r) * UPC + DFF + c0);
            float ov[8];
#pragma unroll
            for (int e = 0; e < 4; ++e) {
                const float va = wv[0][2 * e] * bflo(v0[e]) + wv[1][2 * e] * bflo(v1[e]) + wv[2][2 * e] * bflo(v2[e]) + bv[2 * e];
                const float vb = wv[0][2 * e + 1] * bfhi(v0[e]) + wv[1][2 * e + 1] * bfhi(v1[e]) + wv[2][2 * e + 1] * bfhi(v2[e]) + bv[2 * e + 1];
                const float ga = wg[0][2 * e] * bflo(g0[e]) + wg[1][2 * e] * bflo(g1[e]) + wg[2][2 * e] * bflo(g2[e]) + bg[2 * e];
                const float gb = wg[0][2 * e + 1] * bfhi(g0[e]) + wg[1][2 * e + 1] * bfhi(g1[e]) + wg[2][2 * e + 1] * bfhi(g2[e]) + bg[2 * e + 1];
                ov[2 * e] = ga * sigmoidf_(ga) * va; ov[2 * e + 1] = gb * sigmoidf_(gb) * vb; }
            v4u w; w.x = pk2(ov[0], ov[1]); w.y = pk2(ov[2], ov[3]); w.z = pk2(ov[4], ov[5]); w.w = pk2(ov[6], ov[7]);
            *(v4u*)(A + (size_t)(row0 + r) * DFF + c0) = w;
            v0 = v1; v1 = v2; g0 = g1; g1 = g2;
        }
    }
}

__device__ __forceinline__ void conv_fixup_phase(Frame& F, int l) {
    const float* H = (const float*)(FWS + WS_HALO);
    bf16* A = (bf16*)(FWS + WS_ACT);
    const float* cw = F.in[F.zz + 16] + (size_t)l * 3 * UPC; const float* cb = F.in[F.zz + 17] + (size_t)l * UPC;
    constexpr int NQ = DFF / 4;
    for (int it = F.vcu * NTHR + F.tid; it < (MROWS / 64) * 2 * NQ; it += F.G * NTHR) {
        const int c = (it % NQ) * 4, gr = it / NQ, r = gr & 1, g = gr >> 1, colp = (c >> 7) * 256 + (c & 127);
        const bool hasprev = (g & 63) != 0;
        const float* hg = H + (size_t)g * 4 * UPC + colp; const float* hp = hg - (size_t)4 * UPC;
        const f32x4 z = {0.f, 0.f, 0.f, 0.f};
        f32x4 v0, v1, v2, g0, g1, g2;
        v0 = *(const f32x4*)(hg + (size_t)r * UPC); g0 = *(const f32x4*)(hg + (size_t)r * UPC + 128);
        if (r == 1) { v1 = *(const f32x4*)hg; g1 = *(const f32x4*)(hg + 128); v2 = hasprev ? *(const f32x4*)(hp + (size_t)3 * UPC) : z; g2 = hasprev ? *(const f32x4*)(hp + (size_t)3 * UPC + 128) : z; }
        else { v1 = hasprev ? *(const f32x4*)(hp + (size_t)3 * UPC) : z; g1 = hasprev ? *(const f32x4*)(hp + (size_t)3 * UPC + 128) : z; v2 = hasprev ? *(const f32x4*)(hp + (size_t)2 * UPC) : z; g2 = hasprev ? *(const f32x4*)(hp + (size_t)2 * UPC + 128) : z; }
        const f32x4 cv = *(const f32x4*)(cw + c) * v2 + *(const f32x4*)(cw + UPC + c) * v1 + *(const f32x4*)(cw + 2 * UPC + c) * v0 + *(const f32x4*)(cb + c);
        const f32x4 cg = *(const f32x4*)(cw + DFF + c) * g2 + *(const f32x4*)(cw + UPC + DFF + c) * g1 + *(const f32x4*)(cw + 2 * UPC + DFF + c) * g0 + *(const f32x4*)(cb + DFF + c);
        v2u w; w.x = pk2(cg[0] * sigmoidf_(cg[0]) * cv[0], cg[1] * sigmoidf_(cg[1]) * cv[1]); w.y = pk2(cg[2] * sigmoidf_(cg[2]) * cv[2], cg[3] * sigmoidf_(cg[3]) * cv[3]);
        *(v2u*)(A + (size_t)(64 * g + r) * DFF + c) = w;
    }
}

#define GRID_BAR() do { xcd_barrier(bar, tid_from_wave(F.wave)); asm volatile("" : "+s"(F.wave), "+s"(F.vcu), "+s"(F.G)); F.tid = tid_from_wave(F.wave); F.lane = F.tid & 63; { unsigned z_ = 0u; asm volatile("" : "+v"(z_)); F.zz = __builtin_amdgcn_readfirstlane(z_); } } while (0)
#define XB ((bf16*)(FWS + WS_X))
#define HB ((bf16*)(FWS + WS_H))
#define PROJ ((bf16*)(FWS + WS_PROJ))
#define MIXED ((bf16*)(FWS + WS_MIXED))
#define UB ((bf16*)(FWS + WS_U))
#define ACT ((bf16*)(FWS + WS_ACT))
#define MOD ((const float*)(FWS + WS_MOD))
template <int l>
__device__ __forceinline__ void layer_fwd(Frame& F, const XcdBarrier& bar) {
#define modl (MOD + (size_t)l * 2 * 12288)
#define wl (FWS + WS_W + (size_t)l * W_LAYER)
        if (l == 0) norm_phase<0, true>(F, F.in[F.zz + 0], HB, F.in[F.zz + 21] + l * DM, modl + 0 * DM, modl + 1 * DM);
        else norm_phase<0, false>(F, XB, HB, F.in[F.zz + 21] + l * DM, modl + 0 * DM, modl + 1 * DM);
        GRID_BAR();
        { pg8::Gemm g{HB, (const bf16*)(wl + W_IN), MROWS, IN_PAD, DM}; pg8::StaticOrder S; S.init(MROWS, IN_PAD, F.G, (int)blockIdx.x);
          pg8::EpiBf16 E{PROJ, IN_PAD};
          pg8::gemm_phase<pg8::EpiBf16, pg8::StaticOrder, true, true>(F.lds, g, S, E, F.wave); }
        if (F.G == 256 && blockIdx.x >= 64) convert_gap(F, l, CV_IN, l == 0 ? CV_C1 : CV_OUT + CV_UP, ((int)blockIdx.x - 64) * NWAVES + F.wave, 192 * NWAVES, CV_N1);
        GRID_BAR();
        rwkv_prep_mfma(F, l, F.vcu, F.G);
        moba_kmean(F);
        GRID_BAR();
        const int xg_ = F.vcu >> 5, xj_ = F.vcu & 31, mi_ = xg_ * 16 + xj_;
        if (xj_ < 16) { moba_item(F, mi_ >> 3, 15 - (mi_ & 7), mi_ & 7);
            if (F.G == 256 && l == 0) { constexpr int nr_ = CV_LAYER - (CV_IN + CV_C1); LAS float* scr_ = (LAS float*)(F.lds + F.wave * 16384);
                for (int j = 0; j < CV_N3; ++j) { const int s_ = mi_ * NWAVES + F.wave + 128 * NWAVES * j;
                    if (s_ < nr_) convert_item(F, l * CV_LAYER + CV_IN + CV_C1 + s_, scr_);
                    else if (l == 0 && s_ - nr_ < CV_IN - CV_C2) convert_item(F, CV_LAYER + CV_C2 + (s_ - nr_), scr_); } } }
        else {
            const int rv = xg_ * 16 + (xj_ - 16), nrc = F.G / 2;
            unsigned* sub = (unsigned*)(FWS + WS_CTL) + CW_SUB + 128 * l;
            constexpr int RC_SPLIT = 104;
            rc_pass1_rwkv(F, rv * NWAVES + F.wave, nrc * NWAVES, 0, 128);
            rc_pass1_ret(F, rv * NWAVES + F.wave, nrc * NWAVES, 0, 128);
            sub_barrier(F, sub, (unsigned)nrc);
            const bool p2cu = (rv & 3) == 0 && (rv >> 2) < RC_UNITS;
            if (p2cu) {
                rc_pass2(F, rv >> 2, 0, RC_SPLIT, true, false);
                sub_wait(F, sub + 32, (unsigned)(nrc - RC_UNITS));
                rc_pass2(F, rv >> 2, RC_SPLIT, RC_NCH, false, true);
            } else {
                const int ov = rv - (rv >> 2) - 1, nov = nrc - RC_UNITS;
                rc_pass1_rwkv(F, ov * NWAVES + F.wave, nov * NWAVES, 128, 128);
                rc_pass1_ret(F, ov * NWAVES + F.wave, nov * NWAVES, 128, 128);
                sub_arrive(F, sub + 32);
            }
            sub_barrier(F, sub + 64, (unsigned)nrc);
            mixer_post(F, l, rv * NWAVES + F.wave, nrc * NWAVES);
        }
        GRID_BAR();
#if MOBA_CHECK
        moba_naive(F, F.vcu * NWAVES + F.wave, F.G * NWAVES);
        GRID_BAR();
        { float sd = 0.f, sn = 0.f; const bf16* NV = (const bf16*)(FWS + WS_U + 160 * MiB); const bf16* MXc = (const bf16*)(FWS + WS_MIXED);
          for (int m = F.vcu * NWAVES + F.wave; m < MROWS; m += F.G * NWAVES) for (int j = 0; j < 16; ++j) { const float a = bf2f(MXc[(size_t)m * DM + 1024 + j * 64 + F.lane]), b = bf2f(NV[(size_t)m * 1024 + j * 64 + F.lane]); sd += (a - b) * (a - b); sn += b * b; }
          atomicAdd((float*)(FWS + WS_CTL) + 8, sd); atomicAdd((float*)(FWS + WS_CTL) + 9, sn); }
        GRID_BAR();
#endif
        { pg8::Gemm g{MIXED, (const bf16*)(wl + W_OUT), MROWS, DM, DM}; pg8::StaticOrder S; S.init(MROWS, DM, F.G, (int)blockIdx.x);
          if (l == 0) { pg8::EpiResGate<true> E{F.in[F.zz + 0], XB, DM, modl + 2 * DM, 12288, SEQ}; pg8::gemm_phase<pg8::EpiResGate<true>, pg8::StaticOrder, true, true>(F.lds, g, S, E, F.wave); }
          else { pg8::EpiResGate<false> E{XB, XB, DM, modl + 2 * DM, 12288, SEQ}; pg8::gemm_phase<pg8::EpiResGate<false>, pg8::StaticOrder, true, true>(F.lds, g, S, E, F.wave); } }
        GRID_BAR();
        norm_phase<0, false>(F, XB, HB, F.in[F.zz + 22] + l * DM, modl + 3 * DM, modl + 4 * DM);
        GRID_BAR();
        { pg8::Gemm g{HB, (const bf16*)(wl + W_UP), MROWS, UPC, DM}; pg8::StaticOrder S; S.init(MROWS, UPC, F.G, (int)blockIdx.x);
          pg8::EpiConvGate E{ACT, DFF, (float*)(FWS + WS_HALO), F.in[F.zz + 16] + (size_t)l * 3 * UPC, F.in[F.zz + 17] + (size_t)l * UPC, UPC, DFF};
          pg8::gemm_phase<pg8::EpiConvGate, pg8::StaticOrder, true, true>(F.lds, g, S, E, F.wave); }
        if (l == 0 && F.G == 256 && blockIdx.x >= 128) { if (blockIdx.x < 224) adaln_item(F, 1, (int)blockIdx.x - 128); convert_gap(F, 1, 0, CV_C2, ((int)blockIdx.x - 128) * NWAVES + F.wave, 128 * NWAVES, CV_N2); }
        if (l == 1 && F.G == 256 && blockIdx.x >= 128) convert_gap(F, 1, CV_IN + CV_OUT + CV_UP, CV_DN, ((int)blockIdx.x - 128) * NWAVES + F.wave, 128 * NWAVES, CV_N2);
        GRID_BAR();
        conv_fixup_phase(F, l);
        GRID_BAR();
        { pg8::Gemm g{ACT, (const bf16*)(wl + W_DN), MROWS, DM, DFF}; pg8::StaticOrder S; S.init(MROWS, DM, F.G, (int)blockIdx.x);
          pg8::EpiResGate<false> E{XB, XB, DM, modl + 5 * DM, 12288, SEQ};
          pg8::gemm_phase<pg8::EpiResGate<false>, pg8::StaticOrder, true, true>(F.lds, g, S, E, F.wave); }
        GRID_BAR();
}

__global__ void __launch_bounds__(NTHR, 2) mega_fwd(Args args) {
    extern __shared__ __attribute__((aligned(16))) unsigned char lds[];
    Frame F;
    F.lds = (LAS unsigned char*)lds;
    F.tid = threadIdx.x; F.lane = F.tid & 63; F.wave = __builtin_amdgcn_readfirstlane(F.tid >> 6);
    F.G = gridDim.x; { const int bx = blockIdx.x; F.vcu = (F.G % 8 == 0) ? (bx % 8) * (F.G / 8) + bx / 8 : bx; }
    F.in = args.in; F.ws = args.ws; F.zz = 0;
    volatile LAS unsigned* MISC = (volatile LAS unsigned*)(F.lds + MISC_OFF);
    for (int u = F.tid; u < (LDS_BYTES - LDSCTL_OFF) / 4; u += NTHR) ((LAS unsigned*)(F.lds + LDSCTL_OFF))[u] = 0u;
    __syncthreads();
    XcdBarrier bar = xcd_barrier_post((unsigned*)(FWS + WS_CTL) + CW_BAR, MISC + 8, F.tid);

    p0_prologue(F);
    GRID_BAR();
    layer_fwd<0>(F, bar);
    layer_fwd<1>(F, bar);
    norm_phase<1, false>(F, XB, args.out, F.in[F.zz + 23], nullptr, nullptr);
}

extern "C" void kernel_launch(void* const* d_in, const int* in_sizes, int n_in, void* d_out, int out_size, void* d_ws, size_t ws_size, hipStream_t stream) {
    static int grid = 0;
    if (grid == 0) {
        if (n_in != 24 || out_size != MROWS * DM || ws_size < WS_END) { fprintf(stderr, "kernel_launch: unexpected shapes (n_in %d out %d ws %zu)\n", n_in, out_size, ws_size); grid = -1; return; }
        int dev = 0, cus = 0;
        if (hipGetDevice(&dev) != hipSuccess || hipDeviceGetAttribute(&cus, hipDeviceAttributeMultiprocessorCount, dev) != hipSuccess) { grid = -1; return; }
        if (hipFuncSetAttribute((const void*)mega_fwd, hipFuncAttributeMaxDynamicSharedMemorySize, LDS_BYTES) != hipSuccess) { fprintf(stderr, "kernel_launch: hipFuncSetAttribute failed\n"); grid = -1; return; }
        int per_cu = 0;
        if (hipOccupancyMaxActiveBlocksPerMultiprocessor(&per_cu, (const void*)mega_fwd, NTHR, LDS_BYTES) != hipSuccess || per_cu < 1) { fprintf(stderr, "kernel_launch: occupancy query says %d\n", per_cu); }
        (void)hipGetLastError();
        grid = cus;
    }
    if (grid < 0) return;
    (void)hipMemsetAsync((char*)d_ws + WS_CTL, 0, CTL_ZERO_BYTES, stream);
    Args a{};
    for (int i = 0; i < 24; ++i) a.in[i] = (const float*)d_in[i];
    a.out = (float*)d_out; a.ws = (unsigned char*)d_ws;
    hipLaunchKernelGGL(mega_fwd, dim3(grid), dim3(NTHR), LDS_BYTES, stream, a);
}
```

```cpp
#include <hip/hip_runtime.h>
#include <cstdio>
#include <cstdint>
#ifndef MOBA_NP
#define MOBA_NP 2
#endif
#ifndef MOBA_CHECK
#define MOBA_CHECK 0
#endif
__device__ __forceinline__ int tid_from_wave(int wave) { int l = (int)__builtin_amdgcn_mbcnt_hi(~0u, __builtin_amdgcn_mbcnt_lo(~0u, 0u)); asm volatile("" : "+v"(l)); return wave * 64 + l; }
namespace pg8 {
#define PG8_LAS __attribute__((address_space(3)))
typedef unsigned short bf16_t;
typedef short bf16x8 __attribute__((ext_vector_type(8)));
typedef float f32x4 __attribute__((ext_vector_type(4)));
typedef unsigned u32x4 __attribute__((ext_vector_type(4)));
constexpr int BM = 256, BK = 64, HALF = 128, HTB = HALF * BK * 2  , STAGE_BYTES = 8 * HTB, NXCD = 8, WGM = 8;

__host__ __device__ __forceinline__ int lds_byte(int r, int c) { const int st = (r >> 4) * 2 + (c >> 5), rr = r & 15, cc = c & 31, ob = rr * 64 + cc * 2; return st * 1024 + (ob ^ (((ob >> 9) & 1) << 5)); }
__host__ __device__ __forceinline__ void stage_rc(int b, int& R, int& C) { const int st = b / 1024, sb = b % 1024, swz = sb ^ (((sb >> 9) & 1) << 5); R = (st >> 1) * 16 + swz / 64; C = (st & 1) * 32 + (swz % 64) / 2; }
__host__ __device__ __forceinline__ int perm32(int rho) { const int n = rho >> 4, i = rho & 15; return 8 * (i >> 2) + 4 * n + (i & 3); }

struct Unit { int pm, pn; };
struct Gemm { const bf16_t* A; const bf16_t* Bt; int M, N, K; };

struct StaticOrder {
    int nM, nN, nwg, G, c;
    __host__ __device__ void init(int M, int N, int G_, int c_) { nM = M / BM; nN = N / BM; nwg = nM * nN; G = G_; c = c_; }
    __host__ __device__ bool next(int i, Unit& u) const {
        const long L = (long)i * G + c; if (L >= nwg) return false;
        int wgid = (int)L; { const int q = nwg / NXCD, r = nwg % NXCD, xcd = wgid % NXCD, off = wgid / NXCD; wgid = (xcd < r ? xcd * (q + 1) : r * (q + 1) + (xcd - r) * q) + off; }
        const int nig = WGM * nN, gid = wgid / nig, fm = gid * WGM, gsz = (nM - fm) < WGM ? (nM - fm) : WGM;
        u.pm = fm + ((wgid % nig) % gsz); u.pn = (wgid % nig) / gsz; return true;
    }
    __device__ __forceinline__ void a_ready(const Unit&) const {}
    __device__ __forceinline__ void done(const Unit&) const {}
};

__device__ __forceinline__ unsigned cvt_pk_bf16(float lo, float hi) { unsigned r; asm volatile("v_cvt_pk_bf16_f32 %0, %1, %2" : "=v"(r) : "v"(lo), "v"(hi)); return r; }

struct EpiBf16 {
    static constexpr bool PERM = true, AFTER_DRAIN = false;
    bf16_t* O; int ldc;
    __device__ __forceinline__ void operator()(const f32x4 (&acc)[2][2][4][2], const Unit& u, int wr, int wc, int fr, int fq) const {
        const int row0 = u.pm * BM + wr * 64 + fr; const int col0 = u.pn * BM + wc * 32 + 8 * fq;
#pragma unroll
        for (int ai = 0; ai < 2; ++ai)
#pragma unroll
            for (int m = 0; m < 4; ++m) { bf16_t* rowp = O + (size_t)(row0 + ai * HALF + m * 16) * ldc + col0;
#pragma unroll
                for (int bj = 0; bj < 2; ++bj) { const f32x4 v0 = acc[ai][bj][m][0], v1 = acc[ai][bj][m][1];
                    u32x4 w; w.x = cvt_pk_bf16(v0[0], v0[1]); w.y = cvt_pk_bf16(v0[2], v0[3]); w.z = cvt_pk_bf16(v1[0], v1[1]); w.w = cvt_pk_bf16(v1[2], v1[3]);
                    *(u32x4*)(rowp + bj * HALF) = w; } }
    }
};

template <int CTRL> __device__ __forceinline__ float dpp_ror(float v) { return __builtin_bit_cast(float, __builtin_amdgcn_update_dpp(0, __builtin_bit_cast(int, v), CTRL, 0xF, 0xF, true)); }
struct EpiConvGate {
    static constexpr bool PERM = true, AFTER_DRAIN = false;
    bf16_t* A; int lda; float* halo; const float* cw; const float* cb; int nup, dff;
    __device__ __forceinline__ void operator()(const f32x4 (&acc)[2][2][4][2], const Unit& u, int wr, int wc, int fr, int fq) const {
        const int chl = wc * 32 + 8 * fq;
#pragma unroll
        for (int n = 0; n < 2; ++n) {
            const int c = u.pn * 128 + chl + 4 * n, colp = u.pn * 256 + chl + 4 * n;
            const f32x4 wv0 = *(const f32x4*)(cw + c), wv1 = *(const f32x4*)(cw + nup + c), wv2 = *(const f32x4*)(cw + 2 * nup + c), bv = *(const f32x4*)(cb + c);
            const f32x4 wg0 = *(const f32x4*)(cw + dff + c), wg1 = *(const f32x4*)(cw + nup + dff + c), wg2 = *(const f32x4*)(cw + 2 * nup + dff + c), bg = *(const f32x4*)(cb + dff + c);
#pragma unroll
            for (int ai = 0; ai < 2; ++ai) {
                const int grow = u.pm * BM + ai * HALF + wr * 64;
                float* hb = halo + (size_t)(grow >> 6) * 4 * nup + colp;
                if (fr < 2) { *(f32x4*)(hb + (size_t)fr * nup) = acc[ai][0][0][n]; *(f32x4*)(hb + (size_t)fr * nup + 128) = acc[ai][1][0][n]; }
                if (fr >= 14) { *(f32x4*)(hb + (size_t)(fr - 12) * nup) = acc[ai][0][3][n]; *(f32x4*)(hb + (size_t)(fr - 12) * nup + 128) = acc[ai][1][3][n]; }
                f32x4 cv[4];
                {   f32x4 P1 = {0.f, 0.f, 0.f, 0.f}, P2 = P1;
#pragma unroll
                    for (int m = 0; m < 4; ++m) { f32x4 R1, R2;
#pragma unroll
                        for (int e = 0; e < 4; ++e) { R1[e] = dpp_ror<0x121>(acc[ai][0][m][n][e]); R2[e] = dpp_ror<0x122>(acc[ai][0][m][n][e]); }
                        const f32x4 p1 = (fr >= 1) ? R1 : P1, p2 = (fr >= 2) ? R2 : P2; P1 = R1; P2 = R2;
                        cv[m] = wv0 * p2 + wv1 * p1 + wv2 * acc[ai][0][m][n] + bv; } }
                {   f32x4 P1 = {0.f, 0.f, 0.f, 0.f}, P2 = P1;
#pragma unroll
                    for (int m = 0; m < 4; ++m) { f32x4 R1, R2;
#pragma unroll
                        for (int e = 0; e < 4; ++e) { R1[e] = dpp_ror<0x121>(acc[ai][1][m][n][e]); R2[e] = dpp_ror<0x122>(acc[ai][1][m][n][e]); }
                        const f32x4 p1 = (fr >= 1) ? R1 : P1, p2 = (fr >= 2) ? R2 : P2; P1 = R1; P2 = R2;
                        const f32x4 cg = wg0 * p2 + wg1 * p1 + wg2 * acc[ai][1][m][n] + bg;
                        f32x4 o;
#pragma unroll
                        for (int e = 0; e < 4; ++e) o[e] = cg[e] * __builtin_amdgcn_rcpf(1.0f + __expf(-cg[e])) * cv[m][e];
                        unsigned w0 = cvt_pk_bf16(o[0], o[1]), w1 = cvt_pk_bf16(o[2], o[3]);
                        *(unsigned long long*)(A + (size_t)(grow + m * 16 + fr) * lda + c) = (unsigned long long)w0 | ((unsigned long long)w1 << 32); } }
            }
        }
    }
};

template <bool BASE_F32>
struct EpiResGate {
    static constexpr bool PERM = true, AFTER_DRAIN = false;
    const void* base; bf16_t* out; int ldc; const float* gate; int gstride; int rows_per_batch;
    __device__ __forceinline__ void operator()(const f32x4 (&acc)[2][2][4][2], const Unit& u, int wr, int wc, int fr, int fq) const {
        const int col0 = u.pn * BM + wc * 32 + 8 * fq;
        const int b = (u.pm * BM) / rows_per_batch;
        f32x4 gv[2][2];
#pragma unroll
        for (int bj = 0; bj < 2; ++bj)
#pragma unroll
            for (int n = 0; n < 2; ++n) gv[bj][n] = *(const f32x4*)(gate + (size_t)b * gstride + col0 + bj * HALF + n * 4);
#pragma unroll
        for (int ai = 0; ai < 2; ++ai)
#pragma unroll
            for (int m = 0; m < 4; ++m) { const size_t off = (size_t)(u.pm * BM + ai * HALF + wr * 64 + m * 16 + fr) * ldc + col0;
#pragma unroll
                for (int bj = 0; bj < 2; ++bj) { f32x4 b0, b1;
                    if (BASE_F32) { b0 = *(const f32x4*)((const float*)base + off + bj * HALF); b1 = *(const f32x4*)((const float*)base + off + bj * HALF + 4); }
                    else { const u32x4 w = *(const u32x4*)((const bf16_t*)base + off + bj * HALF);
                        b0 = (f32x4){__builtin_bit_cast(float, w.x << 16), __builtin_bit_cast(float, w.x & 0xffff0000u), __builtin_bit_cast(float, w.y << 16), __builtin_bit_cast(float, w.y & 0xffff0000u)};
                        b1 = (f32x4){__builtin_bit_cast(float, w.z << 16), __builtin_bit_cast(float, w.z & 0xffff0000u), __builtin_bit_cast(float, w.w << 16), __builtin_bit_cast(float, w.w & 0xffff0000u)}; }
                    const f32x4 o0 = b0 + gv[bj][0] * acc[ai][bj][m][0], o1 = b1 + gv[bj][1] * acc[ai][bj][m][1];
                    u32x4 w; w.x = cvt_pk_bf16(o0[0], o0[1]); w.y = cvt_pk_bf16(o0[2], o0[3]); w.z = cvt_pk_bf16(o1[0], o1[1]); w.w = cvt_pk_bf16(o1[2], o1[3]);
                    *(u32x4*)(out + off + bj * HALF) = w; }
                if (m & 1) asm volatile("" ::: "memory"); }
    }
};

template <class Epi, class Sched, bool ALIGN_EPI = false, bool SP2 = false>
__device__ __forceinline__ void gemm_phase(PG8_LAS unsigned char* lds, const Gemm g, const Sched& S, const Epi& E, int wave_) {
    const int tid_ = tid_from_wave(wave_);
    const int tid = tid_, wid = __builtin_amdgcn_readfirstlane(tid >> 6), lane = tid & 63, wr = wid >> 2, wc = wid & 3, fr = lane & 15, fq = lane >> 4;
    const int K = g.K, nt = K / BK;
    unsigned voffA[2], voffB[2];
#pragma unroll
    for (int i = 0; i < 2; ++i) { int R, C; stage_rc(tid * 16 + i * 8192, R, C); const int Rb = Epi::PERM ? ((R & ~31) + perm32(R & 31)) : R;
        voffA[i] = (unsigned)(R * K + C) * 2u; voffB[i] = (unsigned)(Rb * K + C) * 2u; }
    const size_t kstep = (size_t)(BK * 2);
    const size_t hstep = (size_t)HALF * K * 2;
    const size_t tstep = 2 * hstep;
    const unsigned ldsw = (unsigned)wid * 1024u;
    const int aoff = lds_byte(wr * 64 + fr, fq * 8), boff = lds_byte(wc * 32 + fr, fq * 8);
#define PG8_SA(b, h) (((b) * 2 + (h)) * HTB)
#define PG8_SB(b, h) ((4 + (b) * 2 + (h)) * HTB)
#define PG8_STAGE(bufoff, gbase, voff) do { _Pragma("unroll") for (int _i = 0; _i < 2; ++_i) \
        __builtin_amdgcn_global_load_lds((const unsigned*)((const char*)(gbase) + (voff)[_i]), (PG8_LAS unsigned*)(lds + (bufoff) + ldsw + _i * 8192), 16, 0, 0); } while (0)
#define PG8_LDA(dst, b, h) do { _Pragma("unroll") for (int m = 0; m < 4; ++m) _Pragma("unroll") for (int k = 0; k < 2; ++k) dst[m][k] = *(const PG8_LAS bf16x8*)(lds + PG8_SA(b, h) + aoff + m * 2048 + k * 1024); } while (0)
#define PG8_LDB(dst, b, h) do { _Pragma("unroll") for (int n = 0; n < 2; ++n) _Pragma("unroll") for (int k = 0; k < 2; ++k) dst[n][k] = *(const PG8_LAS bf16x8*)(lds + PG8_SB(b, h) + boff + n * 2048 + k * 1024); } while (0)
#define PG8_MMA(ai, bj, At, Bt) do { __builtin_amdgcn_s_setprio(1); _Pragma("unroll") for (int m = 0; m < 4; ++m) _Pragma("unroll") for (int n = 0; n < 2; ++n) _Pragma("unroll") for (int k = 0; k < 2; ++k) \
        acc[ai][bj][m][n] = __builtin_amdgcn_mfma_f32_16x16x32_bf16(Bt[n][k], At[m][k], acc[ai][bj][m][n], 0, 0, 0); __builtin_amdgcn_s_setprio(0); } while (0)
#define PG8_WAIT_V(n) asm volatile("s_waitcnt vmcnt(" #n ")" ::: "memory")
#define PG8_WAIT_L(n) asm volatile("s_waitcnt lgkmcnt(" #n ")" ::: "memory")
#define PG8_BAR __builtin_amdgcn_s_barrier()
#define PG8_SCHED __builtin_amdgcn_sched_barrier(0)
    Unit cur, nxt; int ui = 0;
    if (!S.next(0, cur)) return;
    f32x4 acc[2][2][4][2];
#pragma unroll
    for (int a = 0; a < 2; ++a)
#pragma unroll
        for (int b = 0; b < 2; ++b)
#pragma unroll
            for (int m = 0; m < 4; ++m)
#pragma unroll
                for (int n = 0; n < 2; ++n) acc[a][b][m][n] = (f32x4){0.f, 0.f, 0.f, 0.f};
    bf16x8 At[4][2], B0[2][2], B1[2][2];
    const char* cA = (const char*)g.A + (size_t)cur.pm * tstep; const char* cB = (const char*)g.Bt + (size_t)cur.pn * tstep;
    S.a_ready(cur);
    if constexpr (SP2) {
        PG8_STAGE(PG8_SB(0, 0), cB, voffB); PG8_STAGE(PG8_SB(0, 1), cB + hstep, voffB); PG8_STAGE(PG8_SA(0, 0), cA, voffA); PG8_STAGE(PG8_SA(0, 1), cA + hstep, voffA);
        if (wr == 1) PG8_BAR;
        PG8_WAIT_V(2); PG8_BAR;
        PG8_STAGE(PG8_SB(1, 0), cB + kstep, voffB); PG8_STAGE(PG8_SA(1, 0), cA + kstep, voffA); PG8_STAGE(PG8_SB(1, 1), cB + hstep + kstep, voffB);
        PG8_WAIT_V(6); PG8_BAR;
    } else {
        PG8_STAGE(PG8_SB(0, 0), cB, voffB); PG8_STAGE(PG8_SA(0, 0), cA, voffA); PG8_STAGE(PG8_SB(0, 1), cB + hstep, voffB); PG8_STAGE(PG8_SA(0, 1), cA + hstep, voffA);
        if (wr == 1) PG8_BAR;
        PG8_WAIT_V(4); PG8_BAR;
        PG8_STAGE(PG8_SB(1, 0), cB + kstep, voffB); PG8_STAGE(PG8_SA(1, 0), cA + kstep, voffA); PG8_STAGE(PG8_SB(1, 1), cB + hstep + kstep, voffB);
        PG8_WAIT_V(6); PG8_BAR;
    }
    for (;;) {
        const bool has_next = S.next(ui + 1, nxt);
        const char* nA = has_next ? (const char*)g.A + (size_t)nxt.pm * tstep : cA; const char* nB = has_next ? (const char*)g.Bt + (size_t)nxt.pn * tstep : cB;
        for (int t = 0; t < nt; t += 2) {
            const bool last = (t == nt - 2);
            const char* a1 = cA + (size_t)(t + 1) * kstep;
            const char* a2 = last ? nA : cA + (size_t)(t + 2) * kstep; const char* b2 = last ? nB : cB + (size_t)(t + 2) * kstep;
            const char* a3 = a2 + kstep; const char* b3 = b2 + kstep;
            if (last && has_next) S.a_ready(nxt);
            if constexpr (SP2) {
            PG8_LDB(B0, 0, 0); PG8_LDB(B1, 0, 1); PG8_SCHED; PG8_LDA(At, 0, 0); PG8_STAGE(PG8_SA(1, 1), a1 + hstep, voffA);
            PG8_WAIT_V(8); PG8_WAIT_L(0); PG8_BAR; PG8_MMA(0, 0, At, B0); PG8_MMA(0, 1, At, B1); PG8_BAR; PG8_SCHED;
            PG8_LDA(At, 0, 1); PG8_STAGE(PG8_SB(0, 0), b2, voffB); PG8_STAGE(PG8_SB(0, 1), b2 + hstep, voffB); PG8_STAGE(PG8_SA(0, 0), a2, voffA);
            PG8_WAIT_V(8); PG8_WAIT_L(0); PG8_BAR; PG8_MMA(1, 0, At, B0); PG8_MMA(1, 1, At, B1); PG8_BAR; PG8_SCHED;
            PG8_LDB(B0, 1, 0); PG8_LDB(B1, 1, 1); PG8_SCHED; PG8_LDA(At, 1, 0); PG8_STAGE(PG8_SA(0, 1), a2 + hstep, voffA);
            PG8_WAIT_V(8); PG8_WAIT_L(0); PG8_BAR; PG8_MMA(0, 0, At, B0); PG8_MMA(0, 1, At, B1); PG8_BAR; PG8_SCHED;
            PG8_LDA(At, 1, 1); PG8_STAGE(PG8_SB(1, 0), b3, voffB); PG8_STAGE(PG8_SB(1, 1), b3 + hstep, voffB); PG8_STAGE(PG8_SA(1, 0), a3, voffA);
            PG8_WAIT_V(8); PG8_WAIT_L(0); PG8_BAR; PG8_MMA(1, 0, At, B0); PG8_MMA(1, 1, At, B1); PG8_BAR; PG8_SCHED;
            } else {
            PG8_LDB(B0, 0, 0); PG8_SCHED; PG8_LDA(At, 0, 0); PG8_STAGE(PG8_SA(1, 1), a1 + hstep, voffA);
            PG8_WAIT_L(8); PG8_BAR; PG8_WAIT_L(0); PG8_MMA(0, 0, At, B0); PG8_BAR; PG8_SCHED;
            PG8_LDB(B1, 0, 1); PG8_STAGE(PG8_SB(0, 0), b2, voffB);
            PG8_BAR; PG8_WAIT_L(0); PG8_MMA(0, 1, At, B1); PG8_BAR;
            PG8_LDA(At, 0, 1); PG8_STAGE(PG8_SA(0, 0), a2, voffA);
            PG8_BAR; PG8_WAIT_L(0); PG8_MMA(1, 0, At, B0); PG8_BAR; PG8_SCHED;
            PG8_STAGE(PG8_SB(0, 1), b2 + hstep, voffB);
            PG8_WAIT_V(6); PG8_BAR; PG8_MMA(1, 1, At, B1); PG8_BAR;
            PG8_LDB(B0, 1, 0); PG8_SCHED; PG8_LDA(At, 1, 0); PG8_STAGE(PG8_SA(0, 1), a2 + hstep, voffA);
            PG8_WAIT_L(8); PG8_BAR; PG8_WAIT_L(0); PG8_MMA(0, 0, At, B0); PG8_BAR; PG8_SCHED;
            PG8_LDB(B1, 1, 1); PG8_STAGE(PG8_SB(1, 0), b3, voffB);
            PG8_BAR; PG8_WAIT_L(0); PG8_MMA(0, 1, At, B1); PG8_BAR;
            PG8_LDA(At, 1, 1); PG8_STAGE(PG8_SA(1, 0), a3, voffA);
            PG8_BAR; PG8_WAIT_L(0); PG8_MMA(1, 0, At, B0); PG8_BAR; PG8_SCHED;
            PG8_STAGE(PG8_SB(1, 1), b3 + hstep, voffB);
            PG8_WAIT_V(6); PG8_BAR; PG8_MMA(1, 1, At, B1); PG8_BAR;
            }
        }
        if constexpr (ALIGN_EPI) { if (wr == 0) PG8_BAR; }
        if constexpr (!Epi::AFTER_DRAIN) { E(acc, cur, wr, wc, fr, fq); S.done(cur); }
        if (!has_next) break;
#pragma unroll
        for (int a = 0; a < 2; ++a)
#pragma unroll
            for (int b = 0; b < 2; ++b)
#pragma unroll
                for (int m = 0; m < 4; ++m)
#pragma unroll
                    for (int n = 0; n < 2; ++n) acc[a][b][m][n] = (f32x4){0.f, 0.f, 0.f, 0.f};
        cur = nxt; cA = nA; cB = nB; ++ui;
        if constexpr (ALIGN_EPI) { if (wr == 1) PG8_BAR; }
    }
    PG8_WAIT_V(0);
    if constexpr (!ALIGN_EPI) { if (wr == 0) PG8_BAR; }
    PG8_BAR;
    if constexpr (Epi::AFTER_DRAIN) { E.fused(acc, cur, wr, wc, fr, fq, lds, wid, lane); S.done(cur); }
#undef PG8_SA
#undef PG8_SB
#undef PG8_STAGE
#undef PG8_LDA
#undef PG8_LDB
#undef PG8_MMA
#undef PG8_WAIT_V
#undef PG8_WAIT_L
#undef PG8_BAR
#undef PG8_SCHED
}
}

namespace moba {
using bf16 = unsigned short;
typedef short bf16x8 __attribute__((ext_vector_type(8)));
typedef short s16x4 __attribute__((ext_vector_type(4)));
typedef float f32x16 __attribute__((ext_vector_type(16)));
typedef float f32x4 __attribute__((ext_vector_type(4)));
typedef unsigned u32x4 __attribute__((ext_vector_type(4)));
#define MLAS __attribute__((address_space(3)))
typedef MLAS char lchar; typedef MLAS float lfloat; typedef MLAS bf16x8 lbf16x8;
template <class A, class Bt> struct same_t { static constexpr bool v = false; };
template <class A> struct same_t<A, A> { static constexpr bool v = true; };
constexpr int D = 128, LDI = 6656, LDO = 2048;
constexpr float THR = 8.f;
constexpr bool WSKIP = false;
constexpr float SCALE = 0.08838834764831845f;
constexpr int NW = 8, QBLK = 32, KVBLK = 64, QB = NW * QBLK;
constexpr int SHM_V = KVBLK * D * 2, SHM_K = KVBLK * D * 2;
constexpr int LDS_BYTES = 2 * SHM_V + 2 * SHM_K + NW * 64 * 4;
#define KSWZ(row, colB) ((row) * 256 + ((colB) ^ (((row) & 7) << 4)))
#define SBAR() __builtin_amdgcn_sched_barrier(0)
__device__ __forceinline__ int v_st(int k, int c) { const int kk = (k & ~0xC) | ((k & 4) << 1) | ((k & 8) >> 1); return ((kk >> 3) * 4 + (c >> 5)) * 512 + ((kk & 7) * 32 + (c & 31)) * 2; }
__device__ __forceinline__ int v_rd_base(int lane) { return ((lane & 3) << 3) | (((lane >> 2) & 3) << 6) | (((lane >> 4) & 1) << 5) | (((lane >> 5) & 1) << 8); }
constexpr int v_rd_off(int d0, int ks, int half) { return d0 * 512 + ks * 4096 + half * 2048; }
__device__ __forceinline__ int crow(int r, int hi) { return (r & 3) + 8 * (r >> 2) + 4 * hi; }
__device__ __forceinline__ unsigned cvtpk(float lo, float hi) {
    unsigned r; asm volatile("v_cvt_pk_bf16_f32 %0, %1, %2" : "=v"(r) : "v"(lo), "v"(hi)); return r;
}
__device__ __forceinline__ bf16x8 pack8(f32x4 a, f32x4 b) {
    u32x4 w = {cvtpk(a[0], a[1]), cvtpk(a[2], a[3]), cvtpk(b[0], b[1]), cvtpk(b[2], b[3])};
    return *reinterpret_cast<bf16x8*>(&w);
}
template <class T> __device__ __forceinline__ bf16x8 load8(const T* p) {
    if constexpr (same_t<T, float>::v) { return pack8(*(const f32x4*)p, *(const f32x4*)(p + 4)); }
    else { return *reinterpret_cast<const bf16x8*>(p); }
}
__device__ __forceinline__ void mask_tile(f32x16& p0, f32x16& p1, int dq, unsigned W) {
    const float NEG = -__builtin_inff();
#pragma unroll
    for (int r = 0; r < 16; ++r) {
        const int c = (r & 3) + 8 * (r >> 2);
        if ((unsigned)(dq - c) >= W) p0[r] = NEG;
        if ((unsigned)(dq - c - 32) >= W) p1[r] = NEG;
    }
}
__device__ __forceinline__ void partialSM(f32x16& p0, f32x16& p1, float& m_reg, float& mn, float& alpha) {
    float pmax = p0[0]; for (int r = 1; r < 16; ++r) pmax = fmaxf(pmax, p0[r]); for (int r = 0; r < 16; ++r) pmax = fmaxf(pmax, p1[r]);
    { auto rr = __builtin_amdgcn_permlane32_swap(__float_as_uint(pmax), __float_as_uint(pmax), false, false);
      pmax = fmaxf(__uint_as_float(rr[0]), __uint_as_float(rr[1])); }
    constexpr float C2 = 1.4426950408889634f * SCALE;
    if (__builtin_expect(__all((pmax - m_reg) * SCALE <= THR), 1)) { mn = m_reg; alpha = 1.f; }
    else { mn = fmaxf(m_reg, pmax); alpha = __builtin_amdgcn_exp2f((m_reg - mn) * C2); m_reg = mn; }
    const float mnL = -mn * C2;
    for (int r = 0; r < 16; ++r) p0[r] = fmaf(p0[r], C2, mnL); for (int r = 0; r < 16; ++r) p1[r] = fmaf(p1[r], C2, mnL);
    for (int r = 0; r < 16; ++r) p0[r] = __builtin_amdgcn_exp2f(p0[r]);
}
__device__ __forceinline__ void finishSM(f32x16& p0, f32x16& p1, float alpha, float& l_reg, bf16x8& pa0, bf16x8& pa1, bf16x8& pa2, bf16x8& pa3) {
    for (int r = 0; r < 16; ++r) p1[r] = __builtin_amdgcn_exp2f(p1[r]);
    float ps = 0; for (int r = 0; r < 16; ++r) ps += p0[r]; for (int r = 0; r < 16; ++r) ps += p1[r];
    { auto rr = __builtin_amdgcn_permlane32_swap(__float_as_uint(ps), __float_as_uint(ps), false, false);
      ps = __uint_as_float(rr[0]) + __uint_as_float(rr[1]); }
    l_reg = l_reg * alpha + ps;
#define PK4(P, B_, OUT) do { unsigned a0 = cvtpk(P[B_+0], P[B_+1]), a1 = cvtpk(P[B_+2], P[B_+3]);                          \
        unsigned b0 = cvtpk(P[B_+4], P[B_+5]), b1 = cvtpk(P[B_+6], P[B_+7]);                                             \
        auto r0 = __builtin_amdgcn_permlane32_swap(a0, b0, false, false); auto r1 = __builtin_amdgcn_permlane32_swap(a1, b1, false, false); \
        u32x4 w = {r0[0], r1[0], r0[1], r1[1]}; OUT = *reinterpret_cast<bf16x8*>(&w); } while (0)
    PK4(p0, 0, pa0); PK4(p0, 8, pa1); PK4(p1, 0, pa2); PK4(p1, 8, pa3);
#undef PK4
}
template <int KB, bool SK>
__device__ __forceinline__ void qkt(f32x16& p0, f32x16& p1, const lchar* K_lds, int r32, int hi, const bf16x8* qr, bool act, float slopeR, float lb) {
    if (SK && !act) { const float NEG = -__builtin_inff();
#pragma unroll
        for (int r = 0; r < 16; ++r) { p0[r] = NEG; p1[r] = NEG; } return; }
#pragma unroll
    for (int r = 0; r < 16; ++r) { const int c = (r & 3) + 8 * (r >> 2); p0[r] = __builtin_fmaf(slopeR, (float)c, lb); p1[r] = __builtin_fmaf(slopeR, (float)(c + 32), lb); }
    const lchar* kb[4];
#pragma unroll
    for (int dd = 0; dd < 4; ++dd) kb[dd] = K_lds + KB * SHM_K + KSWZ(r32, (dd * 16 + hi * 8) * 2);
#pragma unroll
    for (int d0 = 0; d0 < 8; ++d0) { const lchar* a = kb[d0 & 3] + (d0 >> 2) * 128;
        bf16x8 b0 = *(const lbf16x8*)(a);
        bf16x8 b1 = *(const lbf16x8*)(a + 32 * 256);
        p0 = __builtin_amdgcn_mfma_f32_32x32x16_bf16(b0, qr[d0], p0, 0, 0, 0);
        p1 = __builtin_amdgcn_mfma_f32_32x32x16_bf16(b1, qr[d0], p1, 0, 0, 0); }
}
template <int VB, bool SK>
__device__ __forceinline__ void pv_tile(f32x16* o, int vb0, bf16x8 pa0, bf16x8 pa1, bf16x8 pa2, bf16x8 pa3, bool act) {
    if (SK && !act) return;
#define TRRD(dst, off) asm volatile("ds_read_b64_tr_b16 %0, %1 offset:%2" : "=&v"(dst) : "v"(vb0), "i"(off) : "memory")
#define PV_D0(d0) do { s16x4 l0, l1, l2, l3, h0, h1, h2, h3; constexpr int b_ = VB * SHM_V + v_rd_off(d0, 0, 0);     \
        TRRD(l0, b_); TRRD(h0, b_ + 2048); TRRD(l1, b_ + 4096); TRRD(h1, b_ + 6144); TRRD(l2, b_ + 8192); TRRD(h2, b_ + 10240); TRRD(l3, b_ + 12288); TRRD(h3, b_ + 14336); \
        asm volatile("s_waitcnt lgkmcnt(0)" ::: "memory"); SBAR();                 \
        o[d0] = __builtin_amdgcn_mfma_f32_32x32x16_bf16(pa0, (bf16x8){l0[0], l0[1], l0[2], l0[3], h0[0], h0[1], h0[2], h0[3]}, o[d0], 0, 0, 0);   \
        o[d0] = __builtin_amdgcn_mfma_f32_32x32x16_bf16(pa1, (bf16x8){l1[0], l1[1], l1[2], l1[3], h1[0], h1[1], h1[2], h1[3]}, o[d0], 0, 0, 0);   \
        o[d0] = __builtin_amdgcn_mfma_f32_32x32x16_bf16(pa2, (bf16x8){l2[0], l2[1], l2[2], l2[3], h2[0], h2[1], h2[2], h2[3]}, o[d0], 0, 0, 0);   \
        o[d0] = __builtin_amdgcn_mfma_f32_32x32x16_bf16(pa3, (bf16x8){l3[0], l3[1], l3[2], l3[3], h3[0], h3[1], h3[2], h3[3]}, o[d0], 0, 0, 0); } while (0)
    PV_D0(0); PV_D0(1); PV_D0(2); PV_D0(3);
#undef PV_D0
#undef TRRD
}

typedef __attribute__((address_space(1))) char gchar; typedef __attribute__((address_space(1))) bf16x8 gbf16x8;
__device__ __forceinline__ const gchar* uni_ptr(const char* p) { const unsigned long long v = (unsigned long long)p;
    const unsigned lo = __builtin_amdgcn_readfirstlane((unsigned)v), hi = __builtin_amdgcn_readfirstlane((unsigned)(v >> 32)); return (const gchar*)(((unsigned long long)hi << 32) | lo); }
template <class TIn, class TOut> struct BlockRef { const TIn* Q; const TIn* K; const TIn* V; TOut* O; int P0; const __attribute__((address_space(3))) unsigned* sel; float slopeR; };
template <class TIn> struct Seam {
    bf16x8 qr[8];
    bf16x8 st_v0, st_v1, st_k0, st_k1; f32x4 sf0, sf1, sf2, sf3;
    f32x4 tq[16];
};
__device__ __forceinline__ int swa_jlo(int P0, int W) { const int lowk = P0 - W + 1; return lowk > 0 ? lowk / KVBLK : 0; }
#define ROW(p, k0, rr) ((const TIn*)((const char*)(p) + (size_t)(k0) * (LDI * sizeof(TIn)) + (unsigned)(((rr) * LDI + sc) * (int)sizeof(TIn))))
#define VMW() asm volatile("s_waitcnt vmcnt(0)" ::: "memory")
#define VMWN(n) asm volatile("s_waitcnt vmcnt(%0)" :: "i"(n) : "memory")
#define SLOAD_H(Kp, Vp, k0) do { const gchar* kb__ = uni_ptr((const char*)(Kp) + (size_t)(k0) * (LDI * sizeof(TIn))); const gchar* vb__ = uni_ptr((const char*)(Vp) + (size_t)(k0) * (LDI * sizeof(TIn))); \
                         S.st_v0 = *(const gbf16x8*)(vb__ + roff0); S.st_v1 = *(const gbf16x8*)(vb__ + roff1);              \
                         S.st_k0 = *(const gbf16x8*)(kb__ + roff0); S.st_k1 = *(const gbf16x8*)(kb__ + roff1); } while (0)
#define SWRITE_HK(bf) do { *(lbf16x8*)(K_lds + (bf) * SHM_K + kws) = S.st_k0; *(lbf16x8*)(K_lds + (bf) * SHM_K + kws + 32 * 256) = S.st_k1; } while (0)
#define SWRITE_HV(bf) do { *(lbf16x8*)(V_lds + (bf) * SHM_V + vst0) = S.st_v0; *(lbf16x8*)(V_lds + (bf) * SHM_V + vst1) = S.st_v1; } while (0)
#define SWRITE_H(bf) do { SWRITE_HV(bf); SWRITE_HK(bf); } while (0)
#define SLOAD_F(p, k0) do { S.sf0 = *(const f32x4*)ROW(p, k0, sr); S.sf1 = *(const f32x4*)(ROW(p, k0, sr) + 4);                \
                            S.sf2 = *(const f32x4*)ROW(p, k0, 32 + sr); S.sf3 = *(const f32x4*)(ROW(p, k0, 32 + sr) + 4); } while (0)
#define SWRITE_KF(bf) do { *(lbf16x8*)(K_lds + (bf) * SHM_K + kws) = pack8(S.sf0, S.sf1); *(lbf16x8*)(K_lds + (bf) * SHM_K + kws + 32 * 256) = pack8(S.sf2, S.sf3); } while (0)
#define SWRITE_VF(bf) do { *(lbf16x8*)(V_lds + (bf) * SHM_V + vst0) = pack8(S.sf0, S.sf1); *(lbf16x8*)(V_lds + (bf) * SHM_V + vst1) = pack8(S.sf2, S.sf3); } while (0)
template <class TIn, class TOut>
__device__ __forceinline__ void causal_swa_prime(const BlockRef<TIn, TOut>& cur, int W, lchar* lds, Seam<TIn>& S, int wave_) {
    constexpr bool F32 = same_t<TIn, float>::v;
    const int tid_ = tid_from_wave(wave_);
    const int tid = tid_, wid = __builtin_amdgcn_readfirstlane(tid >> 6), lane = tid & 63, r32 = lane & 31, hi = lane >> 5;
    const int sr = tid >> 4, sc = (tid & 15) * 8, kws = KSWZ(sr, sc * 2); lchar* K_lds = lds + 2 * SHM_V;
    const unsigned roff0 = (unsigned)((sr * LDI + sc) * (int)sizeof(TIn)), roff1 = (unsigned)(((32 + sr) * LDI + sc) * (int)sizeof(TIn));
    const int kb0 = ((cur.P0 + QB - 1) / KVBLK) * KVBLK;
    for (int d0 = 0; d0 < 8; ++d0) S.qr[d0] = *(const gbf16x8*)(uni_ptr((const char*)cur.Q) + (unsigned)(((wid * QBLK + r32) * LDI + hi * 8) * (int)sizeof(TIn)) + d0 * 16 * sizeof(TIn));
    if constexpr (F32) { SLOAD_F((const float*)cur.K, kb0); VMW(); SWRITE_KF(0); SBAR(); SLOAD_F((const float*)cur.V, kb0); }
    else { SLOAD_H(cur.K, cur.V, kb0); VMW(); SWRITE_HK(0); }
    __syncthreads();
}
template <class TIn, class TOut>
__device__ __forceinline__ void causal_swa_block(const BlockRef<TIn, TOut>& cur, const BlockRef<TIn, TOut>& nxt, int skv, int W, lchar* lds, Seam<TIn>& S, int wave_) {
    constexpr bool F32 = same_t<TIn, float>::v;
    const int tid_ = tid_from_wave(wave_);
    const int tid = tid_, wid = __builtin_amdgcn_readfirstlane(tid >> 6), lane = tid & 63, r32 = lane & 31, hi = lane >> 5;
    const int j_lo = swa_jlo(cur.P0, W);
    int j_hi = (cur.P0 + QB - 1) / KVBLK + 1; if (j_hi > skv / KVBLK) j_hi = skv / KVBLK;
    const int NT = j_hi - j_lo;
    const int kbn = ((nxt.P0 + QB - 1) / KVBLK) * KVBLK;
    const unsigned selm = cur.sel[wid * QBLK + r32] | (1u << (cur.P0 >> 8)); const float slopeR = __builtin_bit_cast(float, __builtin_amdgcn_readfirstlane(__builtin_bit_cast(unsigned, cur.slopeR))); const int tqm = cur.P0 + wid * QBLK + r32 - 4 * hi;
#define LB(t) (((selm >> (KBASE(t) >> 8)) & 1u) ? slopeR * (float)(KBASE(t) - tqm) : -__builtin_inff())
    const int qlo = cur.P0 + wid * QBLK, qm = qlo + r32 - 4 * hi;
    lchar* V_lds = lds; lchar* K_lds = lds + 2 * SHM_V;
    lfloat* ws = (lfloat*)(lds + 2 * SHM_V + 2 * SHM_K) + wid * 64; lfloat* li_l = ws; lfloat* al_l = ws + 32;
    float m_reg = -1e30f, l_reg = 0; f32x16 o[4] = {};
    const unsigned roff0 = (unsigned)(((tid >> 4) * LDI + (tid & 15) * 8) * (int)sizeof(TIn)), roff1 = (unsigned)(((32 + (tid >> 4)) * LDI + (tid & 15) * 8) * (int)sizeof(TIn));
    const int sr = tid >> 4, sc = (tid & 15) * 8, vst0 = v_st(sr, sc), vst1 = v_st(32 + sr, sc), kws = KSWZ(sr, sc * 2);
    const int vb0 = (int)(unsigned)(uintptr_t)V_lds + v_rd_base(lane);
    const TIn* Kh = cur.K; const TIn* Vh = cur.V;
#define RESC(a) do { if (__any((a) < 1.f)) { if (hi == 0) al_l[r32] = (a); asm volatile("s_waitcnt lgkmcnt(0)" ::: "memory");              \
                     for (int d_ = 0; d_ < 4; ++d_) for (int r = 0; r < 16; ++r) o[d_][r] *= al_l[crow(r, hi)]; } } while (0)
#define KBASE(t) ((j_hi - 1 - (t)) * KVBLK)
#define ACT(t) (KBASE(t) <= qlo + QBLK - 1 && KBASE(t) + KVBLK - 1 >= qlo - W + 1)
#define MASKT(P0_, P1_, t) do { const int kb_ = KBASE(t); if ((!SK || ACT(t)) && (kb_ + KVBLK - 1 > qlo || kb_ <= qlo + QBLK - 1 - W)) mask_tile(P0_, P1_, qm - kb_, (unsigned)W); } while (0)
    constexpr int NQL = F32 ? 16 : 8;
    constexpr bool SK = WSKIP && !F32;
#define SEAM_K0() do { VMWN(NQL); if constexpr (F32) { SWRITE_KF(0); SBAR(); SLOAD_F((const float*)nxt.V, kbn); } else { SWRITE_HK(0); } SBAR(); } while (0)
    unsigned touch_reg = 0u; const int tl_ = wid * 32 + (lane & 31);
    const unsigned toff = (unsigned)(((tl_ & 127) >> 1) * LDI * (int)sizeof(TIn) + (tl_ & 1) * 128);
    const gchar* tbase = uni_ptr((const char*)((tl_ >> 7) ? (const void*)Vh : (const void*)Kh));
#if MOBA_CHECK
#define TOUCH(k0) do {} while (0)
#else
#define TOUCH(k0) do { const gchar* tp_ = tbase + (size_t)(k0) * (LDI * sizeof(TIn)) + toff; asm volatile("global_load_dword %0, %1, off" : "+v"(touch_reg) : "v"(tp_) : "memory"); } while (0)
#endif
    f32x16 pA0, pA1, pB0, pB1; float mnA, mnB, alA, alB; bf16x8 pa0, pa1, pa2, pa3;
    if constexpr (F32) { VMW(); SWRITE_VF(0); SBAR(); } else { SWRITE_HV(0); SBAR(); }
    if (NT > 1) { if constexpr (F32) SLOAD_F((const float*)Kh, KBASE(1)); else SLOAD_H(Kh, Vh, KBASE(1)); }
    SBAR(); qkt<0, SK>(pA0, pA1, K_lds, r32, hi, S.qr, ACT(0), slopeR, LB(0));
    if constexpr (F32) { if (NT > 1) { VMW(); SWRITE_KF(1); SBAR(); SLOAD_F((const float*)Vh, KBASE(1)); } }
    MASKT(pA0, pA1, 0); partialSM(pA0, pA1, m_reg, mnA, alA);
    if (NT > 1) { VMW(); if constexpr (F32) { SWRITE_VF(1); SBAR(); if (NT > 2) SLOAD_F((const float*)Kh, KBASE(2)); } else SWRITE_H(1); }
    __syncthreads();
#define HALF_STEP(PX0, PX1, mnX, alX, PY0, PY1, alY, t, KB, VB, SB) do {                                                      \
        SBAR(); qkt<KB, SK>(PX0, PX1, K_lds, r32, hi, S.qr, ACT(t), slopeR, LB(t));                                             \
        finishSM(PY0, PY1, alY, l_reg, pa0, pa1, pa2, pa3); SBAR();                                                           \
        if ((t) + 1 < NT) { if constexpr (F32) { VMW(); SWRITE_KF(SB); SBAR(); SLOAD_F((const float*)Vh, KBASE((t) + 1)); }  \
                            else { SLOAD_H(Kh, Vh, KBASE((t) + 1)); } SBAR(); }                                               \
        pv_tile<VB, SK>(o, vb0, pa0, pa1, pa2, pa3, ACT((t) - 1)); MASKT(PX0, PX1, (t)); partialSM(PX0, PX1, m_reg, mnX, alX);                                        \
        __syncthreads();                                                                                                      \
        if ((t) + 1 < NT) { VMW(); if constexpr (F32) { SWRITE_VF(SB); SBAR(); if ((t) + 2 < NT) SLOAD_F((const float*)Kh, KBASE((t) + 2)); } \
                            else { SWRITE_H(SB); } }                                                                          \
        if ((t) + 3 < NT) { TOUCH(KBASE((t) + 3)); }                                                                          \
        RESC(alX); __syncthreads(); } while (0)
    for (int t = 1; t + 1 < NT; t += 2) {
        HALF_STEP(pB0, pB1, mnB, alB, pA0, pA1, alA, t, 1, 0, 0);
        HALF_STEP(pA0, pA1, mnA, alA, pB0, pB1, alB, t + 1, 0, 1, 1);
    }
    const bool even = (NT & 1) == 0;
    if (even) { SBAR(); qkt<1, SK>(pB0, pB1, K_lds, r32, hi, S.qr, ACT(NT - 1), slopeR, LB(NT - 1)); SBAR(); }
#define QROW(e) (nxt.Q + (size_t)(wid * QBLK + r32) * LDI + ((e) >> 1) * 16 + hi * 8 + ((e) & 1) * 4)
    if constexpr (F32) { SLOAD_F((const float*)nxt.K, kbn); SBAR();
#pragma unroll
        for (int e = 0; e < 8; ++e) S.tq[e] = *(const f32x4*)QROW(e); }
    else { SLOAD_H(nxt.K, nxt.V, kbn); SBAR();
#pragma unroll
        for (int d0 = 0; d0 < 8; ++d0) S.qr[d0] = *(const gbf16x8*)(uni_ptr((const char*)nxt.Q) + (unsigned)(((wid * QBLK + r32) * LDI + hi * 8) * (int)sizeof(TIn)) + d0 * 16 * sizeof(TIn)); }
    SBAR();
    finishSM(pA0, pA1, alA, l_reg, pa0, pa1, pa2, pa3); SBAR();
    if constexpr (F32) {
#pragma unroll
        for (int e = 8; e < 16; ++e) S.tq[e] = *(const f32x4*)QROW(e); SBAR(); }
#undef QROW
    pv_tile<0, SK>(o, vb0, pa0, pa1, pa2, pa3, ACT(even ? NT - 2 : NT - 1));
    if (even) { MASKT(pB0, pB1, NT - 1); partialSM(pB0, pB1, m_reg, mnB, alB); __syncthreads(); RESC(alB);
        finishSM(pB0, pB1, alB, l_reg, pa0, pa1, pa2, pa3); SBAR(); pv_tile<1, SK>(o, vb0, pa0, pa1, pa2, pa3, ACT(NT - 1)); }
    SBAR(); SEAM_K0();
    if (hi == 0) li_l[r32] = l_reg; asm volatile("s_waitcnt lgkmcnt(0)" ::: "memory");
    float rli[16];
#pragma unroll
    for (int r = 0; r < 16; ++r) rli[r] = __builtin_amdgcn_rcpf(li_l[crow(r, hi)]);
    const gchar* Owb = uni_ptr((const char*)(cur.O + (size_t)(wid * QBLK) * LDO)); const unsigned ooff = (unsigned)((4 * hi * LDO + r32) * (int)sizeof(TOut));
#pragma unroll
    for (int r = 0; r < 16; ++r) { const int orc = (r & 3) + 8 * (r >> 2);
#pragma unroll
        for (int d0 = 0; d0 < 4; ++d0) { const float v = o[d0][r] * rli[r];
            if constexpr (same_t<TOut, float>::v) { *(__attribute__((address_space(1))) float*)((gchar*)(Owb) + ooff + (unsigned)((orc * LDO + d0 * 32) * (int)sizeof(TOut))) = v; }
            else { const float vn = __shfl_xor(v, 1);
                   if ((r32 & 1) == 0) *(__attribute__((address_space(1))) unsigned*)((gchar*)(Owb) + ooff + (unsigned)((orc * LDO + d0 * 32) * (int)sizeof(TOut))) = cvtpk(v, vn); } } }
    if constexpr (F32) {
#pragma unroll
        for (int d0 = 0; d0 < 8; ++d0) S.qr[d0] = pack8(S.tq[2 * d0], S.tq[2 * d0 + 1]); }
    __syncthreads();
    asm volatile("" :: "v"(touch_reg));
#undef TOUCH
#undef RESC
#undef LB
#undef KBASE
#undef ACT
#undef MASKT
#undef SEAM_K0
#undef HALF_STEP
}
#undef ROW
#undef VMW
#undef VMWN
#undef SLOAD_H
#undef SWRITE_HK
#undef SWRITE_HV
#undef SWRITE_H
#undef SLOAD_F
#undef SWRITE_KF
#undef SWRITE_VF
#undef KSWZ
#undef SBAR
}

constexpr int NWAVES = 8, NTHR = 512;
constexpr int DM = 2048, NB = 2, SEQ = 4096, MROWS = NB * SEQ, NLAYER = 2;
constexpr int IN_COLS = 6592, IN_PAD = 6656, DFF = 5632, UPC = 2 * DFF;
constexpr int C_RQ = 0, C_RK = 256, C_RV = 512, C_RG = 1024, C_RW = 1536, C_MQ = 3520, C_MK = 4544, C_MV = 5568;
constexpr int RWC = 1984;
constexpr float NORM_EPS = 1e-6f, GN_EPS = 64e-5f;
constexpr size_t MiB = 1u << 20;
constexpr size_t WS_CTL = 0, CTL_ZERO_BYTES = 1 * MiB;
constexpr size_t WS_MOD = 1 * MiB;
constexpr size_t WS_KMEAN = 1 * MiB + 512 * 1024;
constexpr size_t WS_W = 2 * MiB, W_LAYER = 100 * MiB, W_IN = 0, W_OUT = 26 * MiB, W_UP = 34 * MiB, W_DN = 78 * MiB;
constexpr size_t WS_X = 202 * MiB;
constexpr size_t WS_H = 266 * MiB;
constexpr size_t WS_PROJ = 298 * MiB;
constexpr size_t WS_ACT = WS_PROJ;
constexpr size_t WS_MIXED = 402 * MiB;
constexpr size_t WS_U = 434 * MiB;
constexpr size_t WS_HALO = WS_U;
constexpr size_t WS_RW = WS_U;
constexpr size_t WS_Y = WS_U + 128 * MiB;
constexpr size_t WS_RETO = WS_U + 144 * MiB;
constexpr size_t WS_REC = 610 * MiB;
constexpr size_t WS_RWW = 738 * MiB;
constexpr size_t WS_END = 739 * MiB;
constexpr size_t RWA = (size_t)MROWS * 512;
constexpr int CW_BAR = 4096, CW_SUB = 64;
constexpr int RING_BYTES = 131072, LDSCTL_OFF = RING_BYTES, MISC_OFF = LDSCTL_OFF + 320, LDS_BYTES = 147456;

#define GAS __attribute__((address_space(1)))
#define LAS __attribute__((address_space(3)))
typedef unsigned short bf16;
typedef unsigned v4u __attribute__((ext_vector_type(4)));
typedef unsigned v2u __attribute__((ext_vector_type(2)));
typedef float f32x4 __attribute__((ext_vector_type(4)));
typedef float f32x2 __attribute__((ext_vector_type(2)));
#define LDS_WAIT() asm volatile("s_waitcnt lgkmcnt(0)" ::: "memory")
__device__ __forceinline__ unsigned f2bf(float f) { unsigned u = __builtin_bit_cast(unsigned, f); return (u + 0x7fffu + ((u >> 16) & 1u)) >> 16; }
__device__ __forceinline__ unsigned pk2(float lo, float hi) { return f2bf(lo) | (f2bf(hi) << 16); }
__device__ __forceinline__ float bf2f(unsigned short h) { return __builtin_bit_cast(float, (unsigned)h << 16); }
__device__ __forceinline__ float bflo(unsigned w) { return __builtin_bit_cast(float, w << 16); }
__device__ __forceinline__ float bfhi(unsigned w) { return __builtin_bit_cast(float, w & 0xffff0000u); }
template <int CTRL> __device__ __forceinline__ float dpp_add(float v);
__device__ __forceinline__ float wave_sum(float v);
__device__ __forceinline__ float wave_max(float v) {
#pragma unroll
    for (int o = 1; o < 64; o <<= 1) v = fmaxf(v, __shfl_xor(v, o));
    return v;
}
template <int CTRL> __device__ __forceinline__ float dpp_add(float v) { return v + __builtin_bit_cast(float, __builtin_amdgcn_update_dpp(0, __builtin_bit_cast(int, v), CTRL, 0xF, 0xF, true)); }
__device__ __forceinline__ float wave_sum(float v) {
    v = dpp_add<0xB1>(v); v = dpp_add<0x4E>(v); v = dpp_add<0x141>(v); v = dpp_add<0x140>(v);
    v += __shfl_xor(v, 16); v += __shfl_xor(v, 32);
    return v;
}
__device__ __forceinline__ float sigmoidf_(float x) { return __builtin_amdgcn_rcpf(1.0f + __expf(-x)); }

#define XB_TMO      128
#define XB_XCNT(j)  (256  + 64 * (j))
#define XB_XSUB(j)  (1280 + 64 * (j))
#define XB_XGEN(j)  (2304 + 64 * (j))
#define XB_TOP      3328
#define XB_TOPGEN   3392
#define XCD_BAR_WORDS 3456
#define XB_SPIN_CAP (1u << 22)
__device__ __forceinline__ unsigned xb_ld(unsigned* p)              { return __hip_atomic_load(p, __ATOMIC_RELAXED, __HIP_MEMORY_SCOPE_AGENT); }
__device__ __forceinline__ unsigned xb_add(unsigned* p, unsigned v) { return __hip_atomic_fetch_add(p, v, __ATOMIC_RELAXED, __HIP_MEMORY_SCOPE_AGENT); }
__device__ __forceinline__ unsigned xb_xcc_id() { return (unsigned)__builtin_amdgcn_s_getreg((3 << 11) | 20) & 0xFu; }
#define XB_SPIN(cond, bar) do { unsigned _sp = 0; while (cond) { __builtin_amdgcn_s_sleep(1); \
    if ((++_sp & 255u) == 0u) { if (xb_ld(&(bar)[XB_TMO])) break; if (_sp > XB_SPIN_CAP) { atomicAdd(&(bar)[XB_TMO], 1u); break; } } } } while (0)
struct XcdBarrier { unsigned* bar; unsigned x; volatile LAS unsigned* st; };
__device__ __forceinline__ XcdBarrier xcd_barrier_post(unsigned* bar, volatile LAS unsigned* st, int tid) {
    XcdBarrier b; b.bar = bar; b.x = xb_xcc_id(); b.st = st;
    if (tid == 0) (void)xb_add(&bar[XB_XCNT(b.x)], 1u);
    return b;
}
__device__ __forceinline__ void xcd_barrier_complete(unsigned* bar, unsigned x, unsigned& nloc, unsigned& nx) {
    const unsigned G = gridDim.x * gridDim.y * gridDim.z;
    unsigned sum, cnt, mine, sp = 0u;
    for (;;) {
        sum = 0u; cnt = 0u; mine = 0u;
#pragma unroll
        for (unsigned j = 0; j < 16; ++j) { const unsigned c = xb_ld(&bar[XB_XCNT(j)]); sum += c; cnt += (c > 0u) ? 1u : 0u; mine = (j == x) ? c : mine; }
        if (sum == G) break;
        __builtin_amdgcn_s_sleep(1);
        if ((++sp & 255u) == 0u) { if (xb_ld(&bar[XB_TMO])) break; if (sp > XB_SPIN_CAP) { atomicAdd(&bar[XB_TMO], 1u); break; } }
    }
    nloc = mine > 0u ? mine : 1u; nx = cnt > 0u ? cnt : 1u;
}
__device__ __forceinline__ void xcd_barrier(const XcdBarrier& b, int tid) {
    asm volatile("s_waitcnt vmcnt(0)" ::: "memory");
    __syncthreads();
    if (tid == 0) {
        unsigned z_ = 0u; asm volatile("" : "+v"(z_)); z_ = (unsigned)__builtin_amdgcn_readfirstlane(z_);
        unsigned* bar = b.bar + z_; const unsigned bx_ = b.x + z_;
        __builtin_amdgcn_s_waitcnt(0);
        unsigned nloc = b.st[0], nx = b.st[1];
        if (nloc == 0u) { xcd_barrier_complete(bar, bx_, nloc, nx); b.st[0] = nloc; b.st[1] = nx; }
        const unsigned old = xb_add(&bar[XB_XSUB(bx_)], 1u);
        const unsigned gen = old / nloc;
        if (old + 1u == (gen + 1u) * nloc) {
            __builtin_amdgcn_fence(__ATOMIC_RELEASE, "agent");
            asm volatile("s_waitcnt vmcnt(0)" ::: "memory");
            const unsigned og = xb_add(&bar[XB_TOP], 1u);
            const unsigned tg = og / nx;
            if (og + 1u == (tg + 1u) * nx) xb_add(&bar[XB_TOPGEN], 1u);
            else XB_SPIN(xb_ld(&bar[XB_TOPGEN]) == tg, bar);
            __builtin_amdgcn_fence(__ATOMIC_ACQUIRE, "agent");
            xb_add(&bar[XB_XGEN(bx_)], 1u);
            asm volatile("s_waitcnt vmcnt(0)" ::: "memory");
        } else {
            XB_SPIN(xb_ld(&bar[XB_XGEN(bx_)]) == gen, bar);
            __builtin_amdgcn_fence(__ATOMIC_ACQUIRE, "agent");
            asm volatile("s_waitcnt vmcnt(0)" ::: "memory");
        }
    }
    __syncthreads();
}

struct Args { const float* in[24]; float* out; unsigned char* ws; };
struct Frame {
    LAS unsigned char* lds;
    int tid, lane, wave, vcu, G, zz;
    const float* const* in;
    unsigned char* ws;
};

#define FWS (F.ws + F.zz)
__device__ __forceinline__ void p0_transpose_item(const float* W, int K, int N, bf16* WT, LAS float* scr, int item, int lane, int half = 0) {
    const int nblk = N / 32, kb = item / nblk, nb = item % nblk, k0 = 64 * kb, n0 = 32 * nb;
    const int r0 = !half ? n0 : (n0 < half ? (n0 >> 7) * 256 + (n0 & 127) : ((n0 - half) >> 7) * 256 + 128 + ((n0 - half) & 127));
#pragma unroll 8
    for (int i = 0; i < 32; ++i) { const int kk = 2 * i + (lane >> 5); scr[kk * 33 + (lane & 31)] = W[(size_t)(k0 + kk) * N + n0 + (lane & 31)]; }
    LDS_WAIT(); asm volatile("" ::: "memory");
    const int c = lane & 7;
#pragma unroll
    for (int j = 0; j < 4; ++j) { const int n = (lane >> 3) + 8 * j; const LAS float* s = scr + (8 * c) * 33 + n;
        v4u o; o.x = pk2(s[0 * 33], s[1 * 33]); o.y = pk2(s[2 * 33], s[3 * 33]); o.z = pk2(s[4 * 33], s[5 * 33]); o.w = pk2(s[6 * 33], s[7 * 33]);
        *(v4u*)(WT + (size_t)(r0 + n) * K + k0 + 8 * c) = o; }
    LDS_WAIT(); asm volatile("" ::: "memory");
}
constexpr int CV_IN = (DM / 64) * (IN_COLS / 32), CV_OUT = (DM / 64) * (DM / 32), CV_UP = (DM / 64) * (UPC / 32), CV_DN = (DFF / 64) * (DM / 32), CV_LAYER = CV_IN + CV_OUT + CV_UP + CV_DN;
constexpr int CV_N1 = 10, CV_N2 = 6, CV_N3 = 4, CV_C1 = 192 * NWAVES * CV_N1, CV_C2 = 128 * NWAVES * CV_N2;
static_assert(CV_IN + CV_C1 <= CV_LAYER && CV_LAYER - (CV_IN + CV_C1) + (CV_IN - CV_C2) <= 128 * NWAVES * CV_N3 && CV_C2 <= CV_IN, "gap capacities");
__device__ __forceinline__ void convert_item(Frame& F, int it, LAS float* scr) {
    const int l = it / CV_LAYER; int r = it % CV_LAYER;
    unsigned char* wl = FWS + WS_W + (size_t)l * W_LAYER;
    if (r < CV_IN) { p0_transpose_item(F.in[F.zz + 2] + (size_t)l * DM * IN_COLS, DM, IN_COLS, (bf16*)(wl + W_IN), scr, r, F.lane); return; } r -= CV_IN;
    if (r < CV_OUT) { p0_transpose_item(F.in[F.zz + 3] + (size_t)l * DM * DM, DM, DM, (bf16*)(wl + W_OUT), scr, r, F.lane); return; } r -= CV_OUT;
    if (r < CV_UP) { p0_transpose_item(F.in[F.zz + 15] + (size_t)l * DM * UPC, DM, UPC, (bf16*)(wl + W_UP), scr, r, F.lane, DFF); return; } r -= CV_UP;
    p0_transpose_item(F.in[F.zz + 18] + (size_t)l * DFF * DM, DFF, DM, (bf16*)(wl + W_DN), scr, r, F.lane);
}
__device__ __forceinline__ void convert_gap(Frame& F, int layer, int first, int count, int gwi, int nwv, int nper) {
    LAS float* scr = (LAS float*)(F.lds + F.wave * 16384);
    for (int j = 0; j < nper; ++j) { const int r = gwi + nwv * j; if (r < count) convert_item(F, layer * CV_LAYER + first + r, scr); }
}
__device__ __forceinline__ void adaln_item(Frame& F, int l, int grp) {
    LAS float* cact = (LAS float*)F.lds;
    LAS float* red = (LAS float*)(F.lds + 16384);
    const float* c = F.in[F.zz + 1];
    for (int i = F.tid; i < 4096; i += NTHR) { const float cv = c[i]; cact[i] = cv / (1.0f + __expf(-cv)); }
    __syncthreads();
    const int n0 = grp * 128;
    const float* W = F.in[F.zz + 19] + (size_t)l * 2048 * 12288 + n0;
    const int half = F.lane >> 5, q = F.lane & 31;
    f32x4 a0 = {0.f, 0.f, 0.f, 0.f}, a1 = {0.f, 0.f, 0.f, 0.f};
#pragma unroll 16
    for (int i = 0; i < 128; ++i) { const int k = F.wave * 256 + 2 * i + half; const f32x4 w = *(const f32x4*)(W + (size_t)k * 12288 + 4 * q);
        a0 += w * cact[k]; a1 += w * cact[2048 + k]; }
#pragma unroll
    for (int e = 0; e < 4; ++e) { a0[e] += __shfl_xor(a0[e], 32); a1[e] += __shfl_xor(a1[e], 32); }
    if (half == 0) {
#pragma unroll
        for (int e = 0; e < 4; ++e) { red[(F.wave * 2 + 0) * 128 + 4 * q + e] = a0[e]; red[(F.wave * 2 + 1) * 128 + 4 * q + e] = a1[e]; } }
    __syncthreads();
    if (F.tid < 256) { const int bb = F.tid >> 7, col = F.tid & 127; float s = 0.f;
#pragma unroll
        for (int w = 0; w < 8; ++w) s += red[(w * 2 + bb) * 128 + col];
        s += F.in[F.zz + 20][l * 12288 + n0 + col];
        ((float*)(FWS + WS_MOD))[(size_t)(l * 2 + bb) * 12288 + n0 + col] = s; }
    __syncthreads();
}
__device__ __forceinline__ void p0_prologue(Frame& F) {
    const int ngv = (F.G == 256) ? 96 : 192;
    if (F.vcu < ngv) adaln_item(F, F.vcu / 96, F.vcu % 96);
    LAS float* scr = (LAS float*)(F.lds + F.wave * 16384);
    const int gw = F.vcu * NWAVES + F.wave, NGW = F.G * NWAVES;
    if (F.G == 256) { if (F.vcu >= 96) for (int p = gw - 96 * NWAVES; p < CV_IN; p += 160 * NWAVES) convert_item(F, p, scr); }
    else for (int p = gw; p < NLAYER * CV_LAYER; p += NGW) convert_item(F, p, scr);
    for (int l = 0; l < NLAYER; ++l) { bf16* wt = (bf16*)(FWS + WS_RWW + (size_t)l * 448 * 512 * 2);
        const float* wu = F.in[F.zz + 6] + (size_t)l * 96 * 512; const float* au = F.in[F.zz + 8] + (size_t)l * 96 * 512; const float* gu = F.in[F.zz + 9] + (size_t)l * 256 * 512;
        for (int i = F.vcu * NTHR + F.tid; i < 448 * 512; i += F.G * NTHR) {
            if (i < 96 * 512) { const int n = i / 96, kq = i - n * 96; wt[i] = (bf16)f2bf(wu[kq * 512 + n]); }
            else if (i < 2 * 96 * 512) { const int j = i - 96 * 512, n = j / 96, kq = j - n * 96; wt[i] = (bf16)f2bf(au[kq * 512 + n]); }
            else { const int j = i - 2 * 96 * 512, n = j >> 8, kq = j & 255; wt[i] = (bf16)f2bf(gu[kq * 512 + n]); } } }
    for (int l = 0; l < NLAYER; ++l) { v4u* z = (v4u*)(FWS + WS_W + (size_t)l * W_LAYER + W_IN + (size_t)IN_COLS * DM * 2);
        for (int i = F.vcu * NTHR + F.tid; i < (IN_PAD - IN_COLS) * DM * 2 / 16; i += F.G * NTHR) z[i] = (v4u){0u, 0u, 0u, 0u}; }
}

template <int MODE, bool IN_F32>
__device__ __forceinline__ void norm_phase(Frame& F, const void* xin, void* outp, const float* g, const float* sh, const float* sc) {
    LAS float* gs = (LAS float*)F.lds;
    LAS float* shs = (LAS float*)(F.lds + 16384);
    for (int i = F.tid; i < 4096; i += NTHR) { const int b = i >> 11, col = i & 2047;
        if (MODE == 0) { gs[i] = g[col] * (1.0f + sc[(size_t)b * 12288 + col]); shs[i] = sh[(size_t)b * 12288 + col]; }
        else { gs[i] = g[col]; shs[i] = 0.f; } }
    __syncthreads();
    const int gw = F.vcu * NWAVES + F.wave, NGW = F.G * NWAVES;
    for (int m = gw; m < MROWS; m += NGW) {
        const int b = m >> 12;
        f32x4 v[8]; float s = 0.f;
#pragma unroll
        for (int j = 0; j < 8; ++j) {
            if (IN_F32) v[j] = *((const f32x4*)((const float*)xin + (size_t)m * DM) + F.lane + 64 * j);
            else { const v2u w = *((const v2u*)((const bf16*)xin + (size_t)m * DM) + F.lane + 64 * j); v[j] = (f32x4){bflo(w.x), bfhi(w.x), bflo(w.y), bfhi(w.y)}; }
            s += (v[j].x * v[j].x + v[j].y * v[j].y) + (v[j].z * v[j].z + v[j].w * v[j].w); }
        float rstd = __builtin_amdgcn_rsqf(wave_sum(s) * (1.0f / DM) + NORM_EPS);
#if MOBA_CHECK
        if (MODE == 1) { const float sd = ((const float*)(FWS + WS_CTL))[8], sn = ((const float*)(FWS + WS_CTL))[9]; rstd *= 1.0f + 10.0f * sqrtf(sd / sn); }
#endif
#pragma unroll
        for (int j = 0; j < 8; ++j) { const int col = 4 * (F.lane + 64 * j);
            const f32x4 gg = *(const LAS f32x4*)(gs + b * 2048 + col), ss = *(const LAS f32x4*)(shs + b * 2048 + col);
            const f32x4 o = v[j] * rstd * gg + ss;
            if (MODE == 0) { v2u w; w.x = pk2(o.x, o.y); w.y = pk2(o.z, o.w); *(v2u*)((bf16*)outp + (size_t)m * DM + col) = w; }
            else *(f32x4*)((float*)outp + (size_t)m * DM + col) = o; }
    }
    __syncthreads();
}

__device__ __forceinline__ float lerp_bf(const bf16* P, size_t row, int col, bool hasprev, float mu) {
    const float cur = bf2f(P[row * IN_PAD + col]); const float prev = hasprev ? bf2f(P[(row - 1) * IN_PAD + col]) : 0.f;
    return cur + (prev - cur) * mu;
}
__device__ __forceinline__ void rwkv_prep(Frame& F, int l) {
    LAS float* codes = (LAS float*)F.lds;
    const bf16* P = (const bf16*)(FWS + WS_PROJ);
    const float* mu = F.in[F.zz + 4] + l * RWC; const float* w0 = F.in[F.zz + 5] + l * 512; const float* w_up = F.in[F.zz + 6] + (size_t)l * 96 * 512;
    const float* a0 = F.in[F.zz + 7] + l * 512; const float* a_up = F.in[F.zz + 8] + (size_t)l * 96 * 512; const float* g_up = F.in[F.zz + 9] + (size_t)l * 256 * 512;
    const float* k_k = F.in[F.zz + 10] + l * 512; const float* k_a = F.in[F.zz + 11] + l * 512; const float* r_k = F.in[F.zz + 12] + l * 512;
    float* RW = (float*)(FWS + WS_RW);
    const int c = F.tid;
    const float mur = mu[c], muk = mu[512 + c], muv = mu[1024 + c], w0c = w0[c], a0c = a0[c], kkc = k_k[c], kac = k_a[c], rkc = r_k[c];
    for (int item = F.vcu; item < MROWS / 8; item += F.G) {
        const int row0 = item * 8, t0 = row0 & (SEQ - 1);
        for (int idx = F.tid; idx < 8 * 448; idx += NTHR) { const int tk = idx / 448, cc = idx - tk * 448;
            float val = lerp_bf(P, (size_t)(row0 + tk), C_RW + 1536 + cc, (t0 + tk) > 0, mu[1536 + cc]);
            if (cc < 96) val = tanhf(val); else if (cc >= 192) val = sigmoidf_(val);
            codes[idx] = val; }
        __syncthreads();
        float wd[8], wa[8], gg[8];
#pragma unroll
        for (int tk = 0; tk < 8; ++tk) { wd[tk] = 0.f; wa[tk] = 0.f; gg[tk] = 0.f; }
        for (int r = 0; r < 96; ++r) { const float wu = w_up[r * 512 + c], au = a_up[r * 512 + c];
#pragma unroll
            for (int tk = 0; tk < 8; ++tk) { wd[tk] += codes[tk * 448 + r] * wu; wa[tk] += codes[tk * 448 + 96 + r] * au; } }
        for (int r = 0; r < 256; ++r) { const float gu = g_up[r * 512 + c];
#pragma unroll
            for (int tk = 0; tk < 8; ++tk) gg[tk] += codes[tk * 448 + 192 + r] * gu; }
#pragma unroll
        for (int tk = 0; tk < 8; ++tk) {
            const size_t row = (size_t)(row0 + tk); const bool hp = (t0 + tk) > 0;
            const float rr = lerp_bf(P, row, C_RW + c, hp, mur), kk0 = lerp_bf(P, row, C_RW + 512 + c, hp, muk), vv = lerp_bf(P, row, C_RW + 1024 + c, hp, muv);
            const float z = -(w0c + wd[tk]);
            const float sp = fmaxf(z, 0.f) + log1pf(__expf(-fabsf(z)));
            const float decay = __expf(-__expf(-sp - 0.5f));
            const float a = sigmoidf_(a0c + wa[tk]);
            const float kkv = kk0 * kkc;
            const float nrm = sqrtf(wave_sum(kkv * kkv));
            const float kap = kkv / fmaxf(nrm, 1e-12f);
            const float kp = kk0 * (1.0f + (a - 1.0f) * kac);
            const float bsum = wave_sum(rr * kp * rkc);
            const size_t o = row * 512 + c;
            RW[0 * RWA + o] = rr; RW[1 * RWA + o] = decay; RW[2 * RWA + o] = kp; RW[3 * RWA + o] = vv;
            RW[4 * RWA + o] = kap; RW[5 * RWA + o] = kap * a; RW[6 * RWA + o] = gg[tk]; RW[7 * RWA + o] = bsum * vv;
        }
        __syncthreads();
    }
}
__device__ __forceinline__ void moba_kmean(Frame& F) {
    LAS float* red = (LAS float*)(F.lds + 32768);
    const bf16* P = (const bf16*)(FWS + WS_PROJ);
    float* KM = (float*)(FWS + WS_KMEAN);
    for (int item = F.vcu; item < 256; item += F.G) {
        const int b = item >> 7, h = (item >> 4) & 7, n = item & 15;
        const int d = F.tid & 127, part = F.tid >> 7;
        const bf16* kp = P + (size_t)(b * SEQ + n * 256 + part * 64) * IN_PAD + C_MK + h * 128 + d;
        float s = 0.f;
        for (int k = 0; k < 64; ++k) s += bf2f(kp[(size_t)k * IN_PAD]);
        red[part * 128 + d] = s;
        __syncthreads();
        if (F.tid < 128) KM[(size_t)item * 128 + d] = (red[d] + red[128 + d] + red[256 + d] + red[384 + d]) * (1.0f / 256.0f);
        __syncthreads();
    }
}
struct RwIn { f32x4 w[2], kk[2], bb[2], k[2], r[2]; float v; };
__device__ __forceinline__ void rw_load(RwIn& x, const float* RW, size_t row, int cj, int ci) {
    const size_t o = row * 512;
    x.w[0] = *(const f32x4*)(RW + 1 * RWA + o + cj); x.w[1] = *(const f32x4*)(RW + 1 * RWA + o + cj + 4);
    x.kk[0] = *(const f32x4*)(RW + 4 * RWA + o + cj); x.kk[1] = *(const f32x4*)(RW + 4 * RWA + o + cj + 4);
    x.bb[0] = *(const f32x4*)(RW + 5 * RWA + o + cj); x.bb[1] = *(const f32x4*)(RW + 5 * RWA + o + cj + 4);
    x.k[0] = *(const f32x4*)(RW + 2 * RWA + o + cj); x.k[1] = *(const f32x4*)(RW + 2 * RWA + o + cj + 4);
    x.r[0] = *(const f32x4*)(RW + 0 * RWA + o + cj); x.r[1] = *(const f32x4*)(RW + 0 * RWA + o + cj + 4);
    x.v = RW[3 * RWA + o + ci];
}
__device__ __forceinline__ void rwkv_scan_naive(Frame& F, int b, int h) {
    const float* RW = (const float*)(FWS + WS_RW);
    float* Y = (float*)(FWS + WS_Y);
    const int i = F.tid >> 3, jp = F.tid & 7, cj = h * 64 + 8 * jp, ci = h * 64 + i;
    f32x4 s0 = {0.f, 0.f, 0.f, 0.f}, s1 = {0.f, 0.f, 0.f, 0.f};
    RwIn cur, n1, n2;
    const size_t rb = (size_t)b * SEQ;
    rw_load(cur, RW, rb, cj, ci); rw_load(n1, RW, rb + 1, cj, ci);
    for (int t = 0; t < SEQ; ++t) {
        rw_load(n2, RW, rb + (t + 2 < SEQ ? t + 2 : SEQ - 1), cj, ci);
        f32x4 pp = s0 * cur.kk[0] + s1 * cur.kk[1];
        float p = (pp.x + pp.y) + (pp.z + pp.w);
        p += __shfl_xor(p, 1); p += __shfl_xor(p, 2); p += __shfl_xor(p, 4);
        const float sa = -p;
        s0 = s0 * cur.w[0] + sa * cur.bb[0] + cur.v * cur.k[0];
        s1 = s1 * cur.w[1] + sa * cur.bb[1] + cur.v * cur.k[1];
        f32x4 yy = s0 * cur.r[0] + s1 * cur.r[1];
        float y = (yy.x + yy.y) + (yy.z + yy.w);
        y += __shfl_xor(y, 1); y += __shfl_xor(y, 2); y += __shfl_xor(y, 4);
        if (jp == 0) Y[(rb + t) * 512 + ci] = y;
        cur = n1; n1 = n2;
    }
}
struct RtIn { v4u q[2], k[2]; unsigned short v; };
__device__ __forceinline__ void rt_load(RtIn& x, const bf16* P, size_t row, int h, int d0, int v) {
    const bf16* p = P + row * IN_PAD;
    x.q[0] = *(const v4u*)(p + C_RQ + h * 64 + d0); x.q[1] = *(const v4u*)(p + C_RQ + h * 64 + d0 + 8);
    x.k[0] = *(const v4u*)(p + C_RK + h * 64 + d0); x.k[1] = *(const v4u*)(p + C_RK + h * 64 + d0 + 8);
    x.v = p[C_RV + h * 128 + v];
}
__device__ __forceinline__ void ret_scan_naive(Frame& F, int b, int h) {
    const bf16* P = (const bf16*)(FWS + WS_PROJ);
    float* RO = (float*)(FWS + WS_RETO);
    const int v = F.tid >> 2, dp = F.tid & 3, d0 = dp * 16;
    const float gamma = 1.0f - exp2f(-5.0f - (float)h);
    float S[16];
#pragma unroll
    for (int d = 0; d < 16; ++d) S[d] = 0.f;
    RtIn cur, n1, n2;
    const size_t rb = (size_t)b * SEQ;
    rt_load(cur, P, rb, h, d0, v); rt_load(n1, P, rb + 1, h, d0, v);
    for (int t = 0; t < SEQ; ++t) {
        rt_load(n2, P, rb + (t + 2 < SEQ ? t + 2 : SEQ - 1), h, d0, v);
        const float vv = bf2f(cur.v) * 0.125f;
        float o = 0.f;
#pragma unroll
        for (int e = 0; e < 8; ++e) { const unsigned qw = cur.q[e >> 2][e & 3], kw = cur.k[e >> 2][e & 3];
            S[2 * e] = gamma * S[2 * e] + bflo(kw) * vv; S[2 * e + 1] = gamma * S[2 * e + 1] + bfhi(kw) * vv;
            o += bflo(qw) * S[2 * e] + bfhi(qw) * S[2 * e + 1]; }
        o += __shfl_xor(o, 1); o += __shfl_xor(o, 2);
        if (dp == 0) RO[(rb + t) * 512 + h * 128 + v] = o;
        cur = n1; n1 = n2;
    }
}
__device__ __forceinline__ void moba_naive(Frame& F, int mw, int nmw) {
    const bf16* P = (const bf16*)(FWS + WS_PROJ);
    const float* KM = (const float*)(FWS + WS_KMEAN);
    bf16* MX = (bf16*)(FWS + WS_U + 160 * MiB);
    LAS float* qs = (LAS float*)(F.lds + F.wave * 4608);
    LAS float* ps = qs + 128;
    const int lane = F.lane;
    for (int qi = mw; qi < MROWS * 8; qi += nmw) {
        const int h = qi & 7, row = qi >> 3, b = row >> 12, t = row & (SEQ - 1), bq = t >> 8;
        { const unsigned qw = *(const unsigned*)(P + (size_t)row * IN_PAD + C_MQ + h * 128 + 2 * lane);
          qs[2 * lane] = bflo(qw) * 0.08838834764831845f; qs[2 * lane + 1] = bfhi(qw) * 0.08838834764831845f; }
        LDS_WAIT();
        float gate = -INFINITY;
        if (lane < 16 && lane < bq) { const float* km = KM + ((size_t)(b * 8 + h) * 16 + lane) * 128; float a = 0.f;
            for (int d = 0; d < 128; ++d) a += qs[d] * km[d];
            gate = a; }
        unsigned selmask = 0u;
#pragma unroll
        for (int rnd = 0; rnd < 3; ++rnd) { const float m = wave_max(gate);
            if (m > -INFINITY) { const unsigned long long bal = __ballot(gate == m); const int idx = __ffsll((long long)bal) - 1; selmask |= 1u << idx; if (lane == idx) gate = -INFINITY; } }
        int blk[4];
#pragma unroll
        for (int s = 0; s < 3; ++s) { if (selmask) { blk[s] = __ffs((int)selmask) - 1; selmask &= selmask - 1u; } else blk[s] = -1; }
        blk[3] = bq;
        const float slope = exp2f(-(float)(h + 1));
        float sc[4][4]; float mx = -1e30f;
#pragma unroll
        for (int s = 0; s < 4; ++s) {
#pragma unroll
            for (int kq = 0; kq < 4; ++kq) {
                float val = -1e30f;
                if (blk[s] >= 0) { const int pos = blk[s] * 256 + kq * 64 + lane;
                    const bf16* kp = P + (size_t)(b * SEQ + pos) * IN_PAD + C_MK + h * 128; float a = 0.f;
#pragma unroll 4
                    for (int d8 = 0; d8 < 16; ++d8) { const v4u kw = *(const v4u*)(kp + d8 * 8); const f32x4 qa = *(const LAS f32x4*)(qs + d8 * 8), qb = *(const LAS f32x4*)(qs + d8 * 8 + 4);
                        a += bflo(kw.x) * qa.x + bfhi(kw.x) * qa.y + bflo(kw.y) * qa.z + bfhi(kw.y) * qa.w + bflo(kw.z) * qb.x + bfhi(kw.z) * qb.y + bflo(kw.w) * qb.z + bfhi(kw.w) * qb.w; }
                    if (pos <= t) val = a - slope * (float)(t - pos); }
                sc[s][kq] = val; mx = fmaxf(mx, val); } }
        mx = wave_max(mx);
        float lsum = 0.f;
#pragma unroll
        for (int s = 0; s < 4; ++s)
#pragma unroll
            for (int kq = 0; kq < 4; ++kq) { const float p = __expf(sc[s][kq] - mx); lsum += p; ps[s * 256 + kq * 64 + lane] = p; }
        lsum = wave_sum(lsum);
        LDS_WAIT();
        float o0 = 0.f, o1 = 0.f;
#pragma unroll
        for (int s = 0; s < 4; ++s) if (blk[s] >= 0) { const int nk = (s == 3) ? (t - bq * 256 + 1) : 256;
            const bf16* vp = P + (size_t)(b * SEQ + blk[s] * 256) * IN_PAD + C_MV + h * 128 + 2 * lane;
#pragma unroll 4
            for (int key = 0; key < nk; ++key) { const float p = ps[s * 256 + key]; const unsigned vw = *(const unsigned*)(vp + (size_t)key * IN_PAD); o0 += p * bflo(vw); o1 += p * bfhi(vw); } }
        const float inv = 1.0f / lsum;
        *(unsigned*)(MX + (size_t)row * 1024 + h * 128 + 2 * lane) = pk2(o0 * inv, o1 * inv);
        LDS_WAIT();
    }
}

constexpr int MOBA_LDS_KM = moba::LDS_BYTES, MOBA_LDS_SEL = MOBA_LDS_KM + 8192;
__device__ __forceinline__ void moba_item(Frame& F, int bh, int qbA, int qbB) {
    const int b = bh >> 3, h = bh & 7;
    const bf16* P = (const bf16*)(FWS + WS_PROJ);
    LAS float* km = (LAS float*)(F.lds + MOBA_LDS_KM);
    LAS unsigned* sel = (LAS unsigned*)(F.lds + MOBA_LDS_SEL);
    const float* KM = (const float*)(FWS + WS_KMEAN) + (size_t)bh * 16 * 128;
    for (int i = F.tid; i < 2048; i += NTHR) km[i] = KM[i];
    __syncthreads();
    {   const int qb = (F.tid < 256) ? qbA : qbB, r = F.tid & 255;
        const bf16* qp = P + (size_t)(b * SEQ + qb * 256 + r) * IN_PAD + C_MQ + h * 128;
        float g[16];
#pragma unroll
        for (int n = 0; n < 16; ++n) g[n] = 0.f;
        for (int d8 = 0; d8 < 16; ++d8) { const v4u qw = *(const v4u*)(qp + d8 * 8);
            const float q0 = bflo(qw.x), q1 = bfhi(qw.x), q2 = bflo(qw.y), q3 = bfhi(qw.y), q4 = bflo(qw.z), q5 = bfhi(qw.z), q6 = bflo(qw.w), q7 = bfhi(qw.w);
#pragma unroll
            for (int n = 0; n < 16; ++n) { const f32x4 ka = *(const LAS f32x4*)(km + n * 128 + d8 * 8), kb = *(const LAS f32x4*)(km + n * 128 + d8 * 8 + 4);
                g[n] += (q0 * ka.x + q1 * ka.y) + (q2 * ka.z + q3 * ka.w) + (q4 * kb.x + q5 * kb.y) + (q6 * kb.z + q7 * kb.w); } }
        unsigned m = 0u;
#pragma unroll
        for (int rnd = 0; rnd < 3; ++rnd) { float best = -INFINITY; int bi = -1;
#pragma unroll
            for (int n = 0; n < 16; ++n) if (n < qb && !((m >> n) & 1u) && g[n] > best) { best = g[n]; bi = n; }
            if (bi >= 0) m |= 1u << bi; }
        sel[F.tid] = m; }
    __syncthreads();
    typedef moba::BlockRef<moba::bf16, moba::bf16> Ref;
    const float slopeR = exp2f(-(float)(h + 1)) * 11.313708498984761f;
    bf16* MX = (bf16*)(FWS + WS_MIXED);
    Ref A, B2;
    A.Q = P + (size_t)(b * SEQ + qbA * 256) * IN_PAD + C_MQ + h * 128; A.K = P + (size_t)(b * SEQ) * IN_PAD + C_MK + h * 128; A.V = P + (size_t)(b * SEQ) * IN_PAD + C_MV + h * 128;
    A.O = MX + (size_t)(b * SEQ + qbA * 256) * DM + 1024 + h * 128; A.P0 = qbA * 256; A.sel = sel; A.slopeR = slopeR;
    B2 = A; B2.Q = P + (size_t)(b * SEQ + qbB * 256) * IN_PAD + C_MQ + h * 128; B2.O = MX + (size_t)(b * SEQ + qbB * 256) * DM + 1024 + h * 128; B2.P0 = qbB * 256; B2.sel = sel + 256;
    moba::Seam<moba::bf16> S;
    moba::lchar* ldsg = (moba::lchar*)F.lds;
    moba::causal_swa_prime<moba::bf16, moba::bf16>(A, 1 << 30, ldsg, S, F.wave);
    Ref cur = A;
    for (int pass = 0; pass < MOBA_NP; ++pass) {
        const bool nb_ = ((pass + 1) & 1) != 0;
        Ref nxt = A; if (nb_ || pass + 1 >= MOBA_NP) nxt = B2;
        moba::causal_swa_block<moba::bf16, moba::bf16>(cur, nxt, SEQ, 1 << 30, ldsg, S, F.wave);
        cur = nxt;
    }
}
constexpr int RC_UNITS = 32, RC_NCH = SEQ / 16, RC_REC = 16384;
constexpr int RC_AR = 0, RC_BK = 4096, RC_VP = 8192, RC_U0 = 10240, RC_Y0 = 12288, RC_D = 14336;
typedef short bf16x8 __attribute__((ext_vector_type(8)));
typedef float f32x16 __attribute__((ext_vector_type(16)));
typedef float f32x2t __attribute__((ext_vector_type(2))); typedef __bf16 bf16x2t __attribute__((ext_vector_type(2)));
__device__ __forceinline__ unsigned cvtpk_c(float lo, float hi) { f32x2t v = {lo, hi}; bf16x2t b = __builtin_convertvector(v, bf16x2t); return __builtin_bit_cast(unsigned, b); }
__device__ __forceinline__ unsigned short cvt1_c(float x) { return (unsigned short)(cvtpk_c(x, 0.f) & 0xffffu); }

constexpr int RC_WLDS = 14464, RC_CODES_OFF = 8 * RC_WLDS  , RC_CSTRIDE = 456;
__device__ __forceinline__ void rc_core(Frame& F, LAS unsigned char* wlds, const float (&At)[16], const float (&Bt)[16], const float (&Kt)[16], const float (&Rt)[16], const float (&vv)[16], const float D, unsigned char* rec) {
    { unsigned wb_ = (unsigned)(uintptr_t)wlds; asm volatile("" : "+v"(wb_)); wlds = (LAS unsigned char*)(uintptr_t)wb_; }
    LAS bf16* XA = (LAS bf16*)wlds; LAS bf16* XB = (LAS bf16*)(wlds + 4608); LAS float* TT = (LAS float*)(wlds + 9216 + 4224);
    int x_ = F.lane; asm volatile("" : "+v"(x_));
    const int x = x_, r32 = x & 31, h2 = x >> 5, tl = x & 15;
#pragma unroll
    for (int t = 0; t < 16; ++t) { XA[t * 72 + x] = cvt1_c(Bt[t]); XA[(16 + t) * 72 + x] = cvt1_c(Kt[t]); XB[t * 72 + x] = cvt1_c(At[t]); XB[(16 + t) * 72 + x] = cvt1_c(Rt[t]); }
#pragma unroll
    for (int q = 0; q < 4; ++q) { v4u w; w.x = cvtpk_c(Bt[4 * q] * D, Bt[4 * q + 1] * D); w.y = cvtpk_c(Bt[4 * q + 2] * D, Bt[4 * q + 3] * D);
        w.z = cvtpk_c(Kt[4 * q] * D, Kt[4 * q + 1] * D); w.w = cvtpk_c(Kt[4 * q + 2] * D, Kt[4 * q + 3] * D); *(v4u*)(rec + RC_BK + x * 64 + q * 16) = w; }
#pragma unroll
    for (int q = 0; q < 2; ++q) { v4u w;
        w.x = cvtpk_c(vv[8 * q], vv[8 * q + 1]); w.y = cvtpk_c(vv[8 * q + 2], vv[8 * q + 3]); w.z = cvtpk_c(vv[8 * q + 4], vv[8 * q + 5]); w.w = cvtpk_c(vv[8 * q + 6], vv[8 * q + 7]); *(v4u*)(rec + RC_VP + x * 32 + q * 16) = w;
    }
    *(float*)(rec + RC_D + x * 4) = D;
    f32x16 G;
#pragma unroll
    for (int r = 0; r < 16; ++r) G[r] = 0.f;
#pragma unroll
    for (int ks = 0; ks < 4; ++ks) { const bf16x8 a = *(const LAS bf16x8*)(XA + r32 * 72 + ks * 16 + h2 * 8), bq = *(const LAS bf16x8*)(XB + r32 * 72 + ks * 16 + h2 * 8);
        G = __builtin_amdgcn_mfma_f32_32x32x16_bf16(a, bq, G, 0, 0, 0); }
    LAS float* GA = (LAS float*)wlds; LAS float* GT = (LAS float*)(wlds + 4608);
#pragma unroll
    for (int r = 0; r < 16; ++r) GA[((r & 3) + 8 * (r >> 2) + 4 * h2) * 36 + r32] = G[r];
#pragma unroll
    for (int g4 = 0; g4 < 4; ++g4) *(LAS f32x4*)(GT + r32 * 36 + 8 * g4 + 4 * h2) = (f32x4){G[4 * g4], G[4 * g4 + 1], G[4 * g4 + 2], G[4 * g4 + 3]};
#define RC_LD16(dst, p, n4) do { _Pragma("unroll") for (int i4_ = 0; i4_ < (n4); ++i4_) { const f32x4 v4_ = *(const LAS f32x4*)((p) + 4 * i4_); dst[4 * i4_] = v4_.x; dst[4 * i4_ + 1] = v4_.y; dst[4 * i4_ + 2] = v4_.z; dst[4 * i4_ + 3] = v4_.w; } } while (0)
    float Tc[16];
#pragma unroll
    for (int m = 0; m < 16; ++m) Tc[m] = (m == tl) ? 1.0f : 0.0f;
#pragma unroll
    for (int s = 14; s >= 0; --s) { float nr[16]; float acc = 0.f;
#pragma unroll
        for (int i4 = (s + 1) / 4; i4 < 4; ++i4) { const f32x4 v4 = *(const LAS f32x4*)(GA + s * 36 + 4 * i4); nr[4 * i4] = v4.x; nr[4 * i4 + 1] = v4.y; nr[4 * i4 + 2] = v4.z; nr[4 * i4 + 3] = v4.w; }
#pragma unroll
        for (int m = s + 1; m < 16; ++m) acc += nr[m] * Tc[m];
        Tc[s] = (s < tl) ? acc : Tc[s]; }
    if (x < 16) {
#pragma unroll
        for (int g4 = 0; g4 < 4; ++g4) *(LAS f32x4*)(TT + tl * 16 + 4 * g4) = (f32x4){Tc[4 * g4], Tc[4 * g4 + 1], Tc[4 * g4 + 2], Tc[4 * g4 + 3]}; }
    float PV[16];
    PV[0] = 0.f;
#pragma unroll
    for (int s = 1; s < 16; ++s) { float acc = 0.f;
#pragma unroll
        for (int r = 0; r < s; ++r) acc += GT[s * 36 + 16 + r] * vv[r];
        PV[s] = acc; }
    float Ah[16], U0[16];
#pragma unroll
    for (int t = 0; t < 16; ++t) { float a = 0.f, uu = 0.f;
#pragma unroll
        for (int s = 0; s <= t; ++s) { const float tv = TT[t * 16 + s]; a += tv * At[s]; uu += tv * PV[s]; }
        Ah[t] = a; U0[t] = uu; }
    float Rh[16], Y0[16];
#pragma unroll
    for (int t = 0; t < 16; ++t) { float a = Rt[t], yy = 0.f;
#pragma unroll
        for (int s = 0; s <= t; ++s) { const float m1 = GT[(16 + t) * 36 + s], m2 = GT[(16 + t) * 36 + 16 + s]; a += m1 * Ah[s]; yy += m1 * U0[s] + m2 * vv[s]; }
        Rh[t] = a; Y0[t] = yy; }
#undef RC_LD16
    { const int ks = x >> 5, jj = x & 31, e = (jj >> 4) * 4 + (jj & 3), q = (jj >> 2) & 3; unsigned char* pb = rec + RC_AR + ks * 1024 + q * 256 + e * 2;
#pragma unroll
      for (int s = 0; s < 16; ++s) { *(bf16*)(pb + s * 16) = cvt1_c(Ah[s]); *(bf16*)(pb + 2048 + s * 16) = cvt1_c(Rh[s]); } }
#pragma unroll
    for (int q = 0; q < 2; ++q) { v4u w;
        w.x = cvtpk_c(U0[8 * q], U0[8 * q + 1]); w.y = cvtpk_c(U0[8 * q + 2], U0[8 * q + 3]); w.z = cvtpk_c(U0[8 * q + 4], U0[8 * q + 5]); w.w = cvtpk_c(U0[8 * q + 6], U0[8 * q + 7]); *(v4u*)(rec + RC_U0 + x * 32 + q * 16) = w;
        w.x = cvtpk_c(Y0[8 * q], Y0[8 * q + 1]); w.y = cvtpk_c(Y0[8 * q + 2], Y0[8 * q + 3]); w.z = cvtpk_c(Y0[8 * q + 4], Y0[8 * q + 5]); w.w = cvtpk_c(Y0[8 * q + 6], Y0[8 * q + 7]); *(v4u*)(rec + RC_Y0 + x * 32 + q * 16) = w; }
    LDS_WAIT();
}
__device__ __forceinline__ void rc_pass1_rwkv(Frame& F, int wid, int nw, int c0, int nc) {
    LAS unsigned char* wlds = F.lds + F.wave * RC_WLDS;
    const int x = F.lane;
    const float* RW = (const float*)(FWS + WS_RW);
    const bf16* RH = (const bf16*)(FWS + WS_RW + 32 * MiB);
    for (int it2 = wid; it2 < 16 * nc; it2 += nw) {
        const int u = it2 / nc, c = c0 + it2 % nc, it = u * RC_NCH + c, b = u >> 3, h = u & 7; const size_t o0 = ((size_t)(b * SEQ + c * 16)) * 512 + h * 64 + x;
        float At[16], Bt[16], Kt[16], Rt[16], vv[16]; float W = 1.0f;
#pragma unroll
        for (int t = 0; t < 16; ++t) { const size_t o = o0 + (size_t)t * 512;
            const float wv = RW[o], ka = bf2f(RH[3 * RWA + o]), bb = bf2f(RH[4 * RWA + o]), kk = bf2f(RH[1 * RWA + o]), rr = bf2f(RH[0 * RWA + o]); vv[t] = bf2f(RH[2 * RWA + o]);
            At[t] = -ka * W; W *= wv; const float iw = __builtin_amdgcn_rcpf(W); Bt[t] = bb * iw; Kt[t] = kk * iw; Rt[t] = rr * W; }
        rc_core(F, wlds, At, Bt, Kt, Rt, vv, W, FWS + WS_REC + (size_t)it * RC_REC);
    }
}
__device__ __forceinline__ void rc_core_ret(Frame& F, LAS unsigned char* wlds, const float (&Kt)[16], const float (&Rt)[16], const float (&vv)[16], const float D, unsigned char* rec) {
    { unsigned wb_ = (unsigned)(uintptr_t)wlds; asm volatile("" : "+v"(wb_)); wlds = (LAS unsigned char*)(uintptr_t)wb_; }
    LAS bf16* XK = (LAS bf16*)wlds; LAS bf16* XR = (LAS bf16*)(wlds + 2304); LAS float* GM = (LAS float*)(wlds + 4608);
    int x_ = F.lane; asm volatile("" : "+v"(x_));
    const int x = x_, fr = x & 15, q = x >> 4;
#pragma unroll
    for (int t = 0; t < 16; ++t) { XK[t * 72 + x] = cvt1_c(Kt[t]); XR[t * 72 + x] = cvt1_c(Rt[t]); }
#pragma unroll
    for (int qq = 0; qq < 4; ++qq) { v4u w; w.x = 0u; w.y = 0u;
        w.z = cvtpk_c(Kt[4 * qq] * D, Kt[4 * qq + 1] * D); w.w = cvtpk_c(Kt[4 * qq + 2] * D, Kt[4 * qq + 3] * D); *(v4u*)(rec + RC_BK + x * 64 + qq * 16) = w; }
#pragma unroll
    for (int qq = 0; qq < 2; ++qq) { v4u w;
        w.x = cvtpk_c(vv[8 * qq], vv[8 * qq + 1]); w.y = cvtpk_c(vv[8 * qq + 2], vv[8 * qq + 3]); w.z = cvtpk_c(vv[8 * qq + 4], vv[8 * qq + 5]); w.w = cvtpk_c(vv[8 * qq + 6], vv[8 * qq + 7]); *(v4u*)(rec + RC_VP + x * 32 + qq * 16) = w;
        *(v4u*)(rec + RC_U0 + x * 32 + qq * 16) = (v4u){0u, 0u, 0u, 0u}; }
    *(float*)(rec + RC_D + x * 4) = D;
    { const int ks = x >> 5, jj = x & 31, e = (jj >> 4) * 4 + (jj & 3), qv = (jj >> 2) & 3; unsigned char* pb = rec + RC_AR + ks * 1024 + qv * 256 + e * 2;
#pragma unroll
      for (int s = 0; s < 16; ++s) { *(bf16*)(pb + s * 16) = (bf16)0; *(bf16*)(pb + 2048 + s * 16) = cvt1_c(Rt[s]); } }
    f32x4 G = {0.f, 0.f, 0.f, 0.f};
#pragma unroll
    for (int ks = 0; ks < 2; ++ks) { const bf16x8 a = *(const LAS bf16x8*)(XK + fr * 72 + ks * 32 + q * 8), bq = *(const LAS bf16x8*)(XR + fr * 72 + ks * 32 + q * 8);
        G = __builtin_amdgcn_mfma_f32_16x16x32_bf16(a, bq, G, 0, 0, 0); }
#pragma unroll
    for (int rg = 0; rg < 4; ++rg) GM[(4 * q + rg) * 17 + fr] = G[rg];
    float Y0[16];
#pragma unroll
    for (int t = 0; t < 16; ++t) { float yy = 0.f;
#pragma unroll
        for (int s = 0; s <= t; ++s) yy += GM[s * 17 + t] * vv[s];
        Y0[t] = yy; }
#pragma unroll
    for (int qq = 0; qq < 2; ++qq) { v4u w;
        w.x = cvtpk_c(Y0[8 * qq], Y0[8 * qq + 1]); w.y = cvtpk_c(Y0[8 * qq + 2], Y0[8 * qq + 3]); w.z = cvtpk_c(Y0[8 * qq + 4], Y0[8 * qq + 5]); w.w = cvtpk_c(Y0[8 * qq + 6], Y0[8 * qq + 7]); *(v4u*)(rec + RC_Y0 + x * 32 + qq * 16) = w; }
    LDS_WAIT();
}
__device__ __forceinline__ void rc_pass1_ret(Frame& F, int wid, int nw, int c0, int nc) {
    LAS unsigned char* wlds = F.lds + F.wave * RC_WLDS;
    const int x = F.lane;
    const bf16* P = (const bf16*)(FWS + WS_PROJ);
    for (int it2 = wid; it2 < 16 * nc; it2 += nw) {
        const int ru = it2 / nc, c = c0 + it2 % nc, it = ru * RC_NCH + c, b = ru >> 3, h = (ru >> 1) & 3, half = ru & 1; const float gamma = 1.0f - exp2f(-5.0f - (float)h);
        float Kt[16], Rt[16], vv[16]; float W = 1.0f;
        const bf16* p0 = P + (size_t)(b * SEQ + c * 16) * IN_PAD;
#pragma unroll
        for (int t = 0; t < 16; ++t) { const bf16* p = p0 + (size_t)t * IN_PAD;
            const float rr = bf2f(p[C_RQ + h * 64 + x]), kk = bf2f(p[C_RK + h * 64 + x]) * 0.125f; vv[t] = bf2f(p[C_RV + h * 128 + half * 64 + x]);
            W *= gamma; const float iw = __builtin_amdgcn_rcpf(W); Kt[t] = kk * iw; Rt[t] = rr * W; }
        rc_core_ret(F, wlds, Kt, Rt, vv, W, FWS + WS_REC + (size_t)(16 * RC_NCH + it) * RC_REC);
    }
}
__device__ __forceinline__ void rwkv_prep_mfma(Frame& F, int l, int first, int stride) {
    LAS unsigned char* wlds = F.lds + F.wave * RC_WLDS;
    LAS bf16* CODES = (LAS bf16*)(F.lds + RC_CODES_OFF);
    LAS float* ST = (LAS float*)wlds;
    const bf16* P = (const bf16*)(FWS + WS_PROJ);
    const float* mu = F.in[F.zz + 4] + l * RWC;
    const bf16* WT = (const bf16*)(FWS + WS_RWW + (size_t)l * 448 * 512 * 2);
    float* RW = (float*)(FWS + WS_RW);
    const int x = F.lane, h = F.wave, ch = h * 64 + x, fr = x & 15, q = x >> 4;
    for (int item = first; item < NB * RC_NCH; item += stride) {
        const int b = item >> 8, c = item & 255; const size_t row0 = (size_t)b * SEQ + c * 16; const int t0 = c * 16;
        const bf16* prc = P + row0 * IN_PAD + C_RW + ch;
        unsigned short nr_[4], nk_[4], nv_[4]; float pvr = 0.f, pvk = 0.f, pvv = 0.f;
        if (t0 > 0) { pvr = bf2f(prc[-IN_PAD]); pvk = bf2f(prc[512 - IN_PAD]); pvv = bf2f(prc[1024 - IN_PAD]); }
#pragma unroll
        for (int tt = 0; tt < 4; ++tt) { nr_[tt] = prc[(size_t)tt * IN_PAD]; nk_[tt] = prc[(size_t)tt * IN_PAD + 512]; nv_[tt] = prc[(size_t)tt * IN_PAD + 1024]; }
        const float mur = mu[ch], muk = mu[512 + ch], muv = mu[1024 + ch];
        const float w0c = F.in[F.zz + 5][l * 512 + ch], a0c = F.in[F.zz + 7][l * 512 + ch], kkc = F.in[F.zz + 10][l * 512 + ch], kac = F.in[F.zz + 11][l * 512 + ch], rkc = F.in[F.zz + 12][l * 512 + ch];
#pragma unroll 7
        for (int idx = F.tid; idx < 16 * 448; idx += NTHR) { const int tk = idx / 448, cc = idx - tk * 448;
            float val = lerp_bf(P, row0 + tk, C_RW + 1536 + cc, (t0 + tk) > 0, mu[1536 + cc]);
            if (cc < 96) val = 1.0f - 2.0f * __builtin_amdgcn_rcpf(1.0f + __expf(2.0f * val));
            else if (cc >= 192) val = sigmoidf_(val);
            CODES[tk * RC_CSTRIDE + cc] = cvt1_c(val); }
        __syncthreads();
        f32x4 accW[4], accA[4], accG[4];
#pragma unroll
        for (int ct = 0; ct < 4; ++ct) { accW[ct] = (f32x4){0.f, 0.f, 0.f, 0.f}; accA[ct] = accW[ct]; accG[ct] = accW[ct]; }
        { bf16x8 bw[3][4];
#pragma unroll
          for (int ks = 0; ks < 3; ++ks)
#pragma unroll
              for (int ct = 0; ct < 4; ++ct) bw[ks][ct] = *(const bf16x8*)(WT + (size_t)(h * 64 + ct * 16 + fr) * 96 + ks * 32 + q * 8);
#pragma unroll
          for (int ks = 0; ks < 3; ++ks) { const bf16x8 aw = *(const LAS bf16x8*)(CODES + fr * RC_CSTRIDE + ks * 32 + q * 8);
#pragma unroll
              for (int ct = 0; ct < 4; ++ct) accW[ct] = __builtin_amdgcn_mfma_f32_16x16x32_bf16(aw, bw[ks][ct], accW[ct], 0, 0, 0); } }
        asm volatile("" ::: "memory");
        { bf16x8 ba[3][4];
#pragma unroll
          for (int ks = 0; ks < 3; ++ks)
#pragma unroll
              for (int ct = 0; ct < 4; ++ct) ba[ks][ct] = *(const bf16x8*)(WT + 512 * 96 + (size_t)(h * 64 + ct * 16 + fr) * 96 + ks * 32 + q * 8);
#pragma unroll
          for (int ks = 0; ks < 3; ++ks) { const bf16x8 aa = *(const LAS bf16x8*)(CODES + fr * RC_CSTRIDE + 96 + ks * 32 + q * 8);
#pragma unroll
              for (int ct = 0; ct < 4; ++ct) accA[ct] = __builtin_amdgcn_mfma_f32_16x16x32_bf16(aa, ba[ks][ct], accA[ct], 0, 0, 0); } }
        asm volatile("" ::: "memory");
#pragma unroll
        for (int hf = 0; hf < 2; ++hf) { bf16x8 bg[4][4];
#pragma unroll
            for (int k4 = 0; k4 < 4; ++k4)
#pragma unroll
                for (int ct = 0; ct < 4; ++ct) bg[k4][ct] = *(const bf16x8*)(WT + 2 * 512 * 96 + (size_t)(h * 64 + ct * 16 + fr) * 256 + (hf * 4 + k4) * 32 + q * 8);
#pragma unroll
            for (int k4 = 0; k4 < 4; ++k4) { const bf16x8 ag = *(const LAS bf16x8*)(CODES + fr * RC_CSTRIDE + 192 + (hf * 4 + k4) * 32 + q * 8);
#pragma unroll
                for (int ct = 0; ct < 4; ++ct) accG[ct] = __builtin_amdgcn_mfma_f32_16x16x32_bf16(ag, bg[k4][ct], accG[ct], 0, 0, 0); }
            asm volatile("" ::: "memory"); }
#pragma unroll
        for (int ct = 0; ct < 4; ++ct)
#pragma unroll
            for (int rg = 0; rg < 4; ++rg) { const int o = (4 * q + rg) * 64 + ct * 16 + fr; ST[o] = accW[ct][rg]; ST[1024 + o] = accA[ct][rg]; ST[2048 + o] = accG[ct][rg]; }
        float* gpw = RW + row0 * 512 + ch;
        bf16* gp = (bf16*)(FWS + WS_RW + 32 * MiB) + row0 * 512 + ch;
        for (int g = 0; g < 4; ++g) {
            unsigned short cr_[4], ck_[4], cv_[4];
#pragma unroll
            for (int tt = 0; tt < 4; ++tt) { cr_[tt] = nr_[tt]; ck_[tt] = nk_[tt]; cv_[tt] = nv_[tt]; }
            if (g < 3) {
#pragma unroll
                for (int tt = 0; tt < 4; ++tt) { const size_t ro = (size_t)(4 * g + 4 + tt) * IN_PAD; nr_[tt] = prc[ro]; nk_[tt] = prc[ro + 512]; nv_[tt] = prc[ro + 1024]; } }
#pragma unroll
          for (int tt = 0; tt < 4; ++tt) { const int t = 4 * g + tt;
            const float cr = bf2f(cr_[tt]), ck = bf2f(ck_[tt]), cv = bf2f(cv_[tt]);
            const float rr = cr + (pvr - cr) * mur, kk0 = ck + (pvk - ck) * muk, vv = cv + (pvv - cv) * muv;
            pvr = cr; pvk = ck; pvv = cv;
            const float z = -(w0c + ST[t * 64 + x]);
            const float sp = fmaxf(z, 0.f) + __logf(1.0f + __expf(-fabsf(z)));
            const float decay = __expf(-__expf(-sp - 0.5f));
            const float a = sigmoidf_(a0c + ST[1024 + t * 64 + x]);
            const float gg = ST[2048 + t * 64 + x];
            const float kkv = kk0 * kkc;
            const float nrm = __builtin_amdgcn_sqrtf(wave_sum(kkv * kkv));
            const float kap = kkv * __builtin_amdgcn_rcpf(fmaxf(nrm, 1e-12f));
            const float kp = kk0 * (1.0f + (a - 1.0f) * kac);
            const float bsum = wave_sum(rr * kp * rkc);
            gpw[0] = decay; gpw += 512;
            gp[0 * RWA] = cvt1_c(rr); gp[1 * RWA] = cvt1_c(kp); gp[2 * RWA] = cvt1_c(vv); gp[3 * RWA] = cvt1_c(kap); gp[4 * RWA] = cvt1_c(kap * a); gp[5 * RWA] = cvt1_c(gg); gp[6 * RWA] = cvt1_c(bsum * vv); gp += 512; } }
        LDS_WAIT();
        __syncthreads();
    }
}
constexpr int RC_SLOT = 15360, RC_YST = 8 * RC_SLOT  ;
__device__ __forceinline__ void rc_pass2(Frame& F, int u, int cb, int ce, bool first, bool last) {
    const unsigned char* rec = FWS + WS_REC + (size_t)u * RC_NCH * RC_REC;
    const int lane = F.lane;
    const int NIT = (ce - cb) / 2;
    bf16* Yg;
    if (u < 16) Yg = (bf16*)(FWS + WS_Y) + (size_t)((u >> 3) * SEQ) * 512 + (u & 7) * 64;
    else { const int ru = u - 16; Yg = (bf16*)(FWS + WS_RETO) + (size_t)((ru >> 3) * SEQ) * 512 + ((ru >> 1) & 3) * 128 + (ru & 1) * 64; }
#define RC_BARRIER() __builtin_amdgcn_s_barrier()
    if (F.wave == 7) {
        unsigned t0_ = 0u, t1_ = 0u, t2_ = 0u, t3_ = 0u;
        for (int cq = cb; cq < cb + 24 && cq < ce; cq += 2) { const unsigned char* pa = rec + (size_t)cq * RC_REC + lane * 128; const unsigned char* pb = pa + 8192; const unsigned char* pc = pa + RC_REC; const unsigned char* pd = pb + RC_REC;
            asm volatile("global_load_dword %0, %4, off\n\tglobal_load_dword %1, %5, off\n\tglobal_load_dword %2, %6, off\n\tglobal_load_dword %3, %7, off" : "+v"(t0_), "+v"(t1_), "+v"(t2_), "+v"(t3_) : "v"(pa), "v"(pb), "v"(pc), "v"(pd) : "memory"); }
        RC_BARRIER();
        for (int i = 0; i < NIT; ++i) {
            const int cp = cb + 2 * i + 24;
            if (cp < ce) { const unsigned char* pa = rec + (size_t)cp * RC_REC + lane * 128; const unsigned char* pb = pa + 8192; const unsigned char* pc = pa + RC_REC; const unsigned char* pd = pb + RC_REC;
                asm volatile("global_load_dword %0, %4, off\n\tglobal_load_dword %1, %5, off\n\tglobal_load_dword %2, %6, off\n\tglobal_load_dword %3, %7, off" : "+v"(t0_), "+v"(t1_), "+v"(t2_), "+v"(t3_) : "v"(pa), "v"(pb), "v"(pc), "v"(pd) : "memory"); }
            if (i > 0) {
                const LAS unsigned char* yb = F.lds + RC_YST + ((i - 1) & 1) * 4096;
#pragma unroll
                for (int j = 0; j < 4; ++j) { const v4u w = *(const LAS v4u*)(yb + j * 1024 + lane * 16);
                    *(v4u*)(Yg + (size_t)((cb + 2 * i - 2) * 16 + j * 8 + (lane >> 3)) * 512 + (lane & 7) * 8) = w; } }
            RC_BARRIER();
        }
        { const LAS unsigned char* yb = F.lds + RC_YST + ((NIT - 1) & 1) * 4096;
#pragma unroll
          for (int j = 0; j < 4; ++j) { const v4u w = *(const LAS v4u*)(yb + j * 1024 + lane * 16);
              *(v4u*)(Yg + (size_t)((cb + 2 * NIT - 2) * 16 + j * 8 + (lane >> 3)) * 512 + (lane & 7) * 8) = w; } }
        asm volatile("s_waitcnt vmcnt(0)" ::: "memory");
        asm volatile("" :: "v"(t0_), "v"(t1_), "v"(t2_), "v"(t3_));
    } else if (F.wave >= 4) {
        const int lw = F.wave - 4;
        const int p0_ = lw == 0 ? 8 : (lw == 1 ? 11 : 13), np_ = lw == 0 ? 3 : 2;
#define RC_ISSUE(c) do { _Pragma("unroll") for (int i_ = 0; i_ < 3; ++i_) { if (i_ < np_) \
            __builtin_amdgcn_global_load_lds((const unsigned*)(rec + (size_t)(c) * RC_REC + (p0_ + i_) * 1024 + lane * 16), (LAS unsigned*)(F.lds + ((c) & 7) * RC_SLOT + (p0_ + i_) * 1024), 16, 0, 0); } } while (0)
#define RC_WAIT4() do { if (lw == 0) asm volatile("s_waitcnt vmcnt(12)" ::: "memory"); else asm volatile("s_waitcnt vmcnt(8)" ::: "memory"); } while (0)
        for (int c = cb; c < cb + 6; ++c) RC_ISSUE(c);
        RC_WAIT4();
        RC_BARRIER();
        for (int i = 0; i < NIT; ++i) {
            if (cb + 2 * i + 7 < ce) { RC_ISSUE(cb + 2 * i + 6); RC_ISSUE(cb + 2 * i + 7); RC_WAIT4(); }
            else asm volatile("s_waitcnt vmcnt(0)" ::: "memory");
            RC_BARRIER();
        }
#undef RC_ISSUE
#undef RC_WAIT4
    } else {
        const int ib = F.wave, fr = lane & 15, q = lane >> 4;
#define RC_ISSUE1(c) do { __builtin_amdgcn_global_load_lds((const unsigned*)(rec + (size_t)(c) * RC_REC + (2 * ib) * 1024 + lane * 16), (LAS unsigned*)(F.lds + ((c) & 7) * RC_SLOT + (2 * ib) * 1024), 16, 0, 0); \
        __builtin_amdgcn_global_load_lds((const unsigned*)(rec + (size_t)(c) * RC_REC + (2 * ib + 1) * 1024 + lane * 16), (LAS unsigned*)(F.lds + ((c) & 7) * RC_SLOT + (2 * ib + 1) * 1024), 16, 0, 0); } while (0)
        f32x4* sv = (f32x4*)(FWS + WS_CTL + 262144) + (size_t)((u * 4 + ib) * 4 + 0) * 64 + lane;
        f32x4 sT[4];
#pragma unroll
        for (int jb = 0; jb < 4; ++jb) sT[jb] = first ? (f32x4){0.f, 0.f, 0.f, 0.f} : sv[jb * 64];
        asm volatile("s_waitcnt vmcnt(0)" ::: "memory");
        for (int c = cb; c < cb + 6; ++c) RC_ISSUE1(c);
        asm volatile("s_waitcnt vmcnt(8)" ::: "memory");
        RC_BARRIER();
        for (int i = 0; i < NIT; ++i) {
            bf16x8 aU0[2], aU1[2], aY0[2], aY1[2], bk[2][4]; f32x4 dd[2][4]; v2u vp[2], u0[2], y0[2];
#pragma unroll
            for (int h = 0; h < 2; ++h) { const LAS unsigned char* slot = F.lds + ((cb + 2 * i + h) & 7) * RC_SLOT;
                aU0[h] = *(const LAS bf16x8*)(slot + RC_AR + q * 256 + fr * 16); aU1[h] = *(const LAS bf16x8*)(slot + RC_AR + 1024 + q * 256 + fr * 16);
                aY0[h] = *(const LAS bf16x8*)(slot + RC_AR + 2048 + q * 256 + fr * 16); aY1[h] = *(const LAS bf16x8*)(slot + RC_AR + 3072 + q * 256 + fr * 16);
                u0[h] = *(const LAS v2u*)(slot + RC_U0 + (16 * ib + fr) * 32 + q * 8); vp[h] = *(const LAS v2u*)(slot + RC_VP + (16 * ib + fr) * 32 + q * 8);
#pragma unroll
                for (int jb = 0; jb < 4; ++jb) { bk[h][jb] = *(const LAS bf16x8*)(slot + RC_BK + (16 * jb + fr) * 64 + q * 16); dd[h][jb] = *(const LAS f32x4*)(slot + RC_D + (16 * jb + 4 * q) * 4); }
                y0[h] = *(const LAS v2u*)(slot + RC_Y0 + (16 * ib + fr) * 32 + q * 8); }
            LAS bf16* yst = (LAS bf16*)(F.lds + RC_YST + (i & 1) * 4096);
#pragma unroll
            for (int h = 0; h < 2; ++h) {
                v4u s0, s1;
                s0.x = cvtpk_c(sT[0][0], sT[0][1]); s0.y = cvtpk_c(sT[0][2], sT[0][3]); s0.z = cvtpk_c(sT[1][0], sT[1][1]); s0.w = cvtpk_c(sT[1][2], sT[1][3]);
                s1.x = cvtpk_c(sT[2][0], sT[2][1]); s1.y = cvtpk_c(sT[2][2], sT[2][3]); s1.z = cvtpk_c(sT[3][0], sT[3][1]); s1.w = cvtpk_c(sT[3][2], sT[3][3]);
                const bf16x8 sb0 = __builtin_bit_cast(bf16x8, s0), sb1 = __builtin_bit_cast(bf16x8, s1);
                f32x4 zU = (f32x4){0.f, 0.f, 0.f, 0.f}, zY = (f32x4){0.f, 0.f, 0.f, 0.f};
                zU = __builtin_amdgcn_mfma_f32_16x16x32_bf16(aU0[h], sb0, zU, 0, 0, 0); zU = __builtin_amdgcn_mfma_f32_16x16x32_bf16(aU1[h], sb1, zU, 0, 0, 0);
                const float U0_ = zU[0] + bflo(u0[h].x), U1_ = zU[1] + bfhi(u0[h].x), U2_ = zU[2] + bflo(u0[h].y), U3_ = zU[3] + bfhi(u0[h].y);
                v4u ubw; ubw.x = cvtpk_c(U0_, U1_); ubw.y = cvtpk_c(U2_, U3_); ubw.z = vp[h].x; ubw.w = vp[h].y;
                const bf16x8 ub = __builtin_bit_cast(bf16x8, ubw);
#pragma unroll
                for (int jb = 0; jb < 4; ++jb) sT[jb] = __builtin_amdgcn_mfma_f32_16x16x32_bf16(bk[h][jb], ub, sT[jb] * dd[h][jb], 0, 0, 0);
                zY = __builtin_amdgcn_mfma_f32_16x16x32_bf16(aY0[h], sb0, zY, 0, 0, 0); zY = __builtin_amdgcn_mfma_f32_16x16x32_bf16(aY1[h], sb1, zY, 0, 0, 0);
                LAS bf16* yp = yst + h * 1024 + (4 * q) * 64 + 16 * ib + fr;
                yp[0] = cvt1_c(zY[0] + bflo(y0[h].x)); yp[64] = cvt1_c(zY[1] + bfhi(y0[h].x)); yp[128] = cvt1_c(zY[2] + bflo(y0[h].y)); yp[192] = cvt1_c(zY[3] + bfhi(y0[h].y));
            }
            if (cb + 2 * i + 7 < ce) { RC_ISSUE1(cb + 2 * i + 6); RC_ISSUE1(cb + 2 * i + 7); asm volatile("s_waitcnt vmcnt(8) lgkmcnt(0)" ::: "memory"); } else asm volatile("s_waitcnt vmcnt(0) lgkmcnt(0)" ::: "memory");
            RC_BARRIER();
        }
        if (!last) {
#pragma unroll
            for (int jb = 0; jb < 4; ++jb) sv[jb * 64] = sT[jb]; }
#undef RC_ISSUE1
    }
#undef RC_BARRIER
    asm volatile("s_waitcnt vmcnt(0) lgkmcnt(0)" ::: "memory");
    __syncthreads();
}
__device__ __forceinline__ void sub_arrive(Frame& F, unsigned* cnt) {
    asm volatile("s_waitcnt vmcnt(0)" ::: "memory");
    __syncthreads();
    if (F.tid == 0) { __builtin_amdgcn_fence(__ATOMIC_RELEASE, "agent"); asm volatile("s_waitcnt vmcnt(0)" ::: "memory"); __hip_atomic_fetch_add(cnt, 1u, __ATOMIC_RELAXED, __HIP_MEMORY_SCOPE_AGENT); }
}
__device__ __forceinline__ void sub_wait(Frame& F, unsigned* cnt, unsigned target) {
    if (F.tid == 0) { unsigned sp = 0u;
        while (__hip_atomic_load(cnt, __ATOMIC_RELAXED, __HIP_MEMORY_SCOPE_AGENT) < target) { __builtin_amdgcn_s_sleep(2); if (++sp > (1u << 24)) break; }
        __builtin_amdgcn_fence(__ATOMIC_ACQUIRE, "agent"); asm volatile("s_waitcnt vmcnt(0)" ::: "memory"); }
    __syncthreads();
}
__device__ __forceinline__ void sub_barrier(Frame& F, unsigned* cnt, unsigned target) {
    asm volatile("s_waitcnt vmcnt(0)" ::: "memory");
    __syncthreads();
    if (F.tid == 0) {
        __builtin_amdgcn_fence(__ATOMIC_RELEASE, "agent");
        asm volatile("s_waitcnt vmcnt(0)" ::: "memory");
        __hip_atomic_fetch_add(cnt, 1u, __ATOMIC_RELAXED, __HIP_MEMORY_SCOPE_AGENT);
        unsigned sp = 0u;
        while (__hip_atomic_load(cnt, __ATOMIC_RELAXED, __HIP_MEMORY_SCOPE_AGENT) < target) { __builtin_amdgcn_s_sleep(2); if (++sp > (1u << 24)) break; }
        __builtin_amdgcn_fence(__ATOMIC_ACQUIRE, "agent");
        asm volatile("s_waitcnt vmcnt(0)" ::: "memory");
    }
    __syncthreads();
}
__device__ __forceinline__ void mixer_post(Frame& F, int l, int gw, int NGW) {
    const bf16* P = (const bf16*)(FWS + WS_PROJ);
    const bf16* RH = (const bf16*)(FWS + WS_RW + 32 * MiB);
    const float* RW = (const float*)(FWS + WS_RW);
    const bf16* Y = (const bf16*)(FWS + WS_Y);
    const bf16* RO = (const bf16*)(FWS + WS_RETO);
    bf16* MX = (bf16*)(FWS + WS_MIXED);
    const float* ln_w = F.in[F.zz + 13] + l * 512; const float* ln_b = F.in[F.zz + 14] + l * 512;
    const int lane = F.lane;
    for (int m = gw; m < MROWS; m += NGW) {
        const size_t o = (size_t)m * 512;
        float y[8], s1[8], s2[8], bon[8], gat[8]; f32x2 ov[4]; float s3[4]; unsigned gw2[4];
#pragma unroll
        for (int h = 0; h < 8; ++h) { const int c = h * 64 + lane; y[h] = bf2f(Y[o + c]); bon[h] = bf2f(RH[6 * RWA + o + c]); gat[h] = bf2f(RH[5 * RWA + o + c]); s1[h] = y[h]; }
#pragma unroll
        for (int h = 0; h < 4; ++h) { const int c = h * 128 + 2 * lane; { const unsigned rw_ = *(const unsigned*)(RO + o + c); ov[h].x = bflo(rw_); ov[h].y = bfhi(rw_); } gw2[h] = *(const unsigned*)(P + (size_t)m * IN_PAD + C_RG + c); s3[h] = ov[h].x * ov[h].x + ov[h].y * ov[h].y; }
#pragma unroll
        for (int h = 0; h < 8; ++h) { s1[h] = dpp_add<0xB1>(s1[h]); s1[h] = dpp_add<0x4E>(s1[h]); s1[h] = dpp_add<0x141>(s1[h]); s1[h] = dpp_add<0x140>(s1[h]); }
#pragma unroll
        for (int h = 0; h < 4; ++h) { s3[h] = dpp_add<0xB1>(s3[h]); s3[h] = dpp_add<0x4E>(s3[h]); s3[h] = dpp_add<0x141>(s3[h]); s3[h] = dpp_add<0x140>(s3[h]); }
#pragma unroll
        for (int of = 16; of < 64; of <<= 1) {
#pragma unroll
            for (int h = 0; h < 8; ++h) s1[h] += __shfl_xor(s1[h], of);
#pragma unroll
            for (int h = 0; h < 4; ++h) s3[h] += __shfl_xor(s3[h], of); }
#pragma unroll
        for (int h = 0; h < 8; ++h) { const float d = y[h] - s1[h] * (1.0f / 64.0f); y[h] = d; s2[h] = d * d; }
#pragma unroll
        for (int h = 0; h < 8; ++h) { s2[h] = dpp_add<0xB1>(s2[h]); s2[h] = dpp_add<0x4E>(s2[h]); s2[h] = dpp_add<0x141>(s2[h]); s2[h] = dpp_add<0x140>(s2[h]); }
#pragma unroll
        for (int of = 16; of < 64; of <<= 1) {
#pragma unroll
            for (int h = 0; h < 8; ++h) s2[h] += __shfl_xor(s2[h], of); }
#pragma unroll
        for (int h = 0; h < 8; ++h) { const int c = h * 64 + lane;
            const float yn = y[h] * __builtin_amdgcn_rsqf(s2[h] * (1.0f / 64.0f) + GN_EPS) * ln_w[c] + ln_b[c];
            MX[(size_t)m * DM + 512 + c] = (bf16)f2bf((yn + bon[h]) * gat[h]); }
#pragma unroll
        for (int h = 0; h < 4; ++h) { const int c = h * 128 + 2 * lane;
            const float rn = __builtin_amdgcn_rsqf(s3[h] * (1.0f / 128.0f) + NORM_EPS);
            const float g0 = bflo(gw2[h]), g1 = bfhi(gw2[h]);
            *(unsigned*)(MX + (size_t)m * DM + c) = pk2(ov[h].x * rn * g0 * sigmoidf_(g0), ov[h].y * rn * g1 * sigmoidf_(g1)); }
    }
}
__device__ __forceinline__ void conv_gate_phase(Frame& F, int l) {
    const bf16* U = (const bf16*)(FWS + WS_U);
    bf16* A = (bf16*)(FWS + WS_ACT);
    const float* cw = F.in[F.zz + 16] + (size_t)l * 3 * UPC; const float* cb = F.in[F.zz + 17] + (size_t)l * UPC;
    constexpr int NCG = DFF / 8, NRC = MROWS / 16;
    for (int it = F.vcu * NTHR + F.tid; it < NCG * NRC; it += F.G * NTHR) {
        const int cg = it % NCG, rc = it / NCG, c0 = cg * 8, row0 = rc * 16, t0 = row0 & (SEQ - 1);
        float wv[3][8], wg[3][8], bv[8], bg[8];
#pragma unroll
        for (int j = 0; j < 3; ++j)
#pragma unroll
            for (int e = 0; e < 8; ++e) { wv[j][e] = cw[j * UPC + c0 + e]; wg[j][e] = cw[j * UPC + DFF + c0 + e]; }
#pragma unroll
        for (int e = 0; e < 8; ++e) { bv[e] = cb[c0 + e]; bg[e] = cb[DFF + c0 + e]; }
        v4u v0 = {0u, 0u, 0u, 0u}, v1 = v0, g0 = v0, g1 = v0;
        if (t0 > 0) { v0 = *(const v4u*)(U + (size_t)(row0 - 2) * UPC + c0); v1 = *(const v4u*)(U + (size_t)(row0 - 1) * UPC + c0);
                      g0 = *(const v4u*)(U + (size_t)(row0 - 2) * UPC + DFF + c0); g1 = *(const v4u*)(U + (size_t)(row0 - 1) * UPC + DFF + c0); }
        for (int r = 0; r < 16; ++r) {
            const v4u v2 = *(const v4u*)(U + (size_t)(row0 + r) * UPC + c0), g2 = *(const v4u*)(U + (size_t)(row0 + r) * UPC + DFF + c0);
            float ov[8];
#pragma unroll
            for (int e = 0; e < 4; ++e) {
                const float va = wv[0][2 * e] * bflo(v0[e]) + wv[1][2 * e] * bflo(v1[e]) + wv[2][2 * e] * bflo(v2[e]) + bv[2 * e];
                const float vb = wv[0][2 * e + 1] * bfhi(v0[e]) + wv[1][2 * e + 1] * bfhi(v1[e]) + wv[2][2 * e + 1] * bfhi(v2[e]) + bv[2 * e + 1];
                const float ga = wg[0][2 * e] * bflo(g0[e]) + wg[1][2 * e] * bflo(g1[e]) + wg[2][2 * e] * bflo(g2[e]) + bg[2 * e];
                const float gb = wg[0][2 * e + 1] * bfhi(g0[e]) + wg[1][2 * e + 1] * bfhi(g1[e]) + wg[2][2 * e + 1] * bfhi(g2[e]) + bg[2 * e + 1];
                ov[2 * e] = ga * sigmoidf_(ga) * va; ov[2 * e + 1] = gb * sigmoidf_(gb) * vb; }
            v4u w; w.x = pk2(ov[0], ov[1]); w.y = pk2(ov[2], ov[3]); w.z = pk2(ov[4], ov[5]); w.w = pk2(ov[6], ov[7]);
            *(v4u*)(A + (size_t)(row0 + r) * DFF + c0) = w;
            v0 = v1; v1 = v2; g0 = g1; g1 = g2;
        }
    }
}

__device__ __forceinline__ void conv_fixup_phase(Frame& F, int l) {
    const float* H = (const float*)(FWS + WS_HALO);
    bf16* A = (bf16*)(FWS + WS_ACT);
    const float* cw = F.in[F.zz + 16] + (size_t)l * 3 * UPC; const float* cb = F.in[F.zz + 17] + (size_t)l * UPC;
    constexpr int NQ = DFF / 4;
    for (int it = F.vcu * NTHR + F.tid; it < (MROWS / 64) * 2 * NQ; it += F.G * NTHR) {
        const int c = (it % NQ) * 4, gr = it / NQ, r = gr & 1, g = gr >> 1, colp = (c >> 7) * 256 + (c & 127);
        const bool hasprev = (g & 63) != 0;
        const float* hg = H + (size_t)g * 4 * UPC + colp; const float* hp = hg - (size_t)4 * UPC;
        const f32x4 z = {0.f, 0.f, 0.f, 0.f};
        f32x4 v0, v1, v2, g0, g1, g2;
        v0 = *(const f32x4*)(hg + (size_t)r * UPC); g0 = *(const f32x4*)(hg + (size_t)r * UPC + 128);
        if (r == 1) { v1 = *(const f32x4*)hg; g1 = *(const f32x4*)(hg + 128); v2 = hasprev ? *(const f32x4*)(hp + (size_t)3 * UPC) : z; g2 = hasprev ? *(const f32x4*)(hp + (size_t)3 * UPC + 128) : z; }
        else { v1 = hasprev ? *(const f32x4*)(hp + (size_t)3 * UPC) : z; g1 = hasprev ? *(const f32x4*)(hp + (size_t)3 * UPC + 128) : z; v2 = hasprev ? *(const f32x4*)(hp + (size_t)2 * UPC) : z; g2 = hasprev ? *(const f32x4*)(hp + (size_t)2 * UPC + 128) : z; }
        const f32x4 cv = *(const f32x4*)(cw + c) * v2 + *(const f32x4*)(cw + UPC + c) * v1 + *(const f32x4*)(cw + 2 * UPC + c) * v0 + *(const f32x4*)(cb + c);
        const f32x4 cg = *(const f32x4*)(cw + DFF + c) * g2 + *(const f32x4*)(cw + UPC + DFF + c) * g1 + *(const f32x4*)(cw + 2 * UPC + DFF + c) * g0 + *(const f32x4*)(cb + DFF + c);
        v2u w; w.x = pk2(cg[0] * sigmoidf_(cg[0]) * cv[0], cg[1] * sigmoidf_(cg[1]) * cv[1]); w.y = pk2(cg[2] * sigmoidf_(cg[2]) * cv[2], cg[3] * sigmoidf_(cg[3]) * cv[3]);
        *(v2u*)(A + (size_t)(64 * g + r) * DFF + c) = w;
    }
}

#define GRID_BAR() do { xcd_barrier(bar, tid_from_wave(F.wave)); asm volatile("" : "+s"(F.wave), "+s"(F.vcu), "+s"(F.G)); F.tid = tid_from_wave(F.wave); F.lane = F.tid & 63; { unsigned z_ = 0u; asm volatile("" : "+v"(z_)); F.zz = __builtin_amdgcn_readfirstlane(z_); } } while (0)
#define XB ((bf16*)(FWS + WS_X))
#define HB ((bf16*)(FWS + WS_H))
#define PROJ ((bf16*)(FWS + WS_PROJ))
#define MIXED ((bf16*)(FWS + WS_MIXED))
#define UB ((bf16*)(FWS + WS_U))
#define ACT ((bf16*)(FWS + WS_ACT))
#define MOD ((const float*)(FWS + WS_MOD))
template <int l>
__device__ __forceinline__ void layer_fwd(Frame& F, const XcdBarrier& bar) {
#define modl (MOD + (size_t)l * 2 * 12288)
#define wl (FWS + WS_W + (size_t)l * W_LAYER)
        if (l == 0) norm_phase<0, true>(F, F.in[F.zz + 0], HB, F.in[F.zz + 21] + l * DM, modl + 0 * DM, modl + 1 * DM);
        else norm_phase<0, false>(F, XB, HB, F.in[F.zz + 21] + l * DM, modl + 0 * DM, modl + 1 * DM);
        GRID_BAR();
        { pg8::Gemm g{HB, (const bf16*)(wl + W_IN), MROWS, IN_PAD, DM}; pg8::StaticOrder S; S.init(MROWS, IN_PAD, F.G, (int)blockIdx.x);
          pg8::EpiBf16 E{PROJ, IN_PAD};
          pg8::gemm_phase<pg8::EpiBf16, pg8::StaticOrder, true, true>(F.lds, g, S, E, F.wave); }
        if (F.G == 256 && blockIdx.x >= 64) convert_gap(F, l, CV_IN, l == 0 ? CV_C1 : CV_OUT + CV_UP, ((int)blockIdx.x - 64) * NWAVES + F.wave, 192 * NWAVES, CV_N1);
        GRID_BAR();
        rwkv_prep_mfma(F, l, F.vcu, F.G);
        moba_kmean(F);
        GRID_BAR();
        const int xg_ = F.vcu >> 5, xj_ = F.vcu & 31, mi_ = xg_ * 16 + xj_;
        if (xj_ < 16) { moba_item(F, mi_ >> 3, 15 - (mi_ & 7), mi_ & 7);
            if (F.G == 256 && l == 0) { constexpr int nr_ = CV_LAYER - (CV_IN + CV_C1); LAS float* scr_ = (LAS float*)(F.lds + F.wave * 16384);
                for (int j = 0; j < CV_N3; ++j) { const int s_ = mi_ * NWAVES + F.wave + 128 * NWAVES * j;
                    if (s_ < nr_) convert_item(F, l * CV_LAYER + CV_IN + CV_C1 + s_, scr_);
                    else if (l == 0 && s_ - nr_ < CV_IN - CV_C2) convert_item(F, CV_LAYER + CV_C2 + (s_ - nr_), scr_); } } }
        else {
            const int rv = xg_ * 16 + (xj_ - 16), nrc = F.G / 2;
            unsigned* sub = (unsigned*)(FWS + WS_CTL) + CW_SUB + 128 * l;
            constexpr int RC_SPLIT = 104;
            rc_pass1_rwkv(F, rv * NWAVES + F.wave, nrc * NWAVES, 0, 128);
            rc_pass1_ret(F, rv * NWAVES + F.wave, nrc * NWAVES, 0, 128);
            sub_barrier(F, sub, (unsigned)nrc);
            const bool p2cu = (rv & 3) == 0 && (rv >> 2) < RC_UNITS;
            if (p2cu) {
                rc_pass2(F, rv >> 2, 0, RC_SPLIT, true, false);
                sub_wait(F, sub + 32, (unsigned)(nrc - RC_UNITS));
                rc_pass2(F, rv >> 2, RC_SPLIT, RC_NCH, false, true);
            } else {
                const int ov = rv - (rv >> 2) - 1, nov = nrc - RC_UNITS;
                rc_pass1_rwkv(F, ov * NWAVES + F.wave, nov * NWAVES, 128, 128);
                rc_pass1_ret(F, ov * NWAVES + F.wave, nov * NWAVES, 128, 128);
                sub_arrive(F, sub + 32);
            }
            sub_barrier(F, sub + 64, (unsigned)nrc);
            mixer_post(F, l, rv * NWAVES + F.wave, nrc * NWAVES);
        }
        GRID_BAR();
#if MOBA_CHECK
        moba_naive(F, F.vcu * NWAVES + F.wave, F.G * NWAVES);
        GRID_BAR();
        { float sd = 0.f, sn = 0.f; const bf16* NV = (const bf16*)(FWS + WS_U + 160 * MiB); const bf16* MXc = (const bf16*)(FWS + WS_MIXED);
          for (int m = F.vcu * NWAVES + F.wave; m < MROWS; m += F.G * NWAVES) for (int j = 0; j < 16; ++j) { const float a = bf2f(MXc[(size_t)m * DM + 1024 + j * 64 + F.lane]), b = bf2f(NV[(size_t)m * 1024 + j * 64 + F.lane]); sd += (a - b) * (a - b); sn += b * b; }
          atomicAdd((float*)(FWS + WS_CTL) + 8, sd); atomicAdd((float*)(FWS + WS_CTL) + 9, sn); }
        GRID_BAR();
#endif
        { pg8::Gemm g{MIXED, (const bf16*)(wl + W_OUT), MROWS, DM, DM}; pg8::StaticOrder S; S.init(MROWS, DM, F.G, (int)blockIdx.x);
          if (l == 0) { pg8::EpiResGate<true> E{F.in[F.zz + 0], XB, DM, modl + 2 * DM, 12288, SEQ}; pg8::gemm_phase<pg8::EpiResGate<true>, pg8::StaticOrder, true, true>(F.lds, g, S, E, F.wave); }
          else { pg8::EpiResGate<false> E{XB, XB, DM, modl + 2 * DM, 12288, SEQ}; pg8::gemm_phase<pg8::EpiResGate<false>, pg8::StaticOrder, true, true>(F.lds, g, S, E, F.wave); } }
        GRID_BAR();
        norm_phase<0, false>(F, XB, HB, F.in[F.zz + 22] + l * DM, modl + 3 * DM, modl + 4 * DM);
        GRID_BAR();
        { pg8::Gemm g{HB, (const bf16*)(wl + W_UP), MROWS, UPC, DM}; pg8::StaticOrder S; S.init(MROWS, UPC, F.G, (int)blockIdx.x);
          pg8::EpiConvGate E{ACT, DFF, (float*)(FWS + WS_HALO), F.in[F.zz + 16] + (size_t)l * 3 * UPC, F.in[F.zz + 17] + (size_t)l * UPC, UPC, DFF};
          pg8::gemm_phase<pg8::EpiConvGate, pg8::StaticOrder, true, true>(F.lds, g, S, E, F.wave); }
        if (l == 0 && F.G == 256 && blockIdx.x >= 128) { if (blockIdx.x < 224) adaln_item(F, 1, (int)blockIdx.x - 128); convert_gap(F, 1, 0, CV_C2, ((int)blockIdx.x - 128) * NWAVES + F.wave, 128 * NWAVES, CV_N2); }
        if (l == 1 && F.G == 256 && blockIdx.x >= 128) convert_gap(F, 1, CV_IN + CV_OUT + CV_UP, CV_DN, ((int)blockIdx.x - 128) * NWAVES + F.wave, 128 * NWAVES, CV_N2);
        GRID_BAR();
        conv_fixup_phase(F, l);
        GRID_BAR();
        { pg8::Gemm g{ACT, (const bf16*)(wl + W_DN), MROWS, DM, DFF}; pg8::StaticOrder S; S.init(MROWS, DM, F.G, (int)blockIdx.x);
          pg8::EpiResGate<false> E{XB, XB, DM, modl + 5 * DM, 12288, SEQ};
          pg8::gemm_phase<pg8::EpiResGate<false>, pg8::StaticOrder, true, true>(F.lds, g, S, E, F.wave); }
        GRID_BAR();
}

__global__ void __launch_bounds__(NTHR, 2) mega_fwd(Args args) {
    extern __shared__ __attribute__((aligned(16))) unsigned char lds[];
    Frame F;
    F.lds = (LAS unsigned char*)lds;
    F.tid = threadIdx.x; F.lane = F.tid & 63; F.wave = __builtin_amdgcn_readfirstlane(F.tid >> 6);
    F.G = gridDim.x; { const int bx = blockIdx.x; F.vcu = (F.G % 8 == 0) ? (bx % 8) * (F.G / 8) + bx / 8 : bx; }
    F.in = args.in; F.ws = args.ws; F.zz = 0;
    volatile LAS unsigned* MISC = (volatile LAS unsigned*)(F.lds + MISC_OFF);
    for (int u = F.tid; u < (LDS_BYTES - LDSCTL_OFF) / 4; u += NTHR) ((LAS unsigned*)(F.lds + LDSCTL_OFF))[u] = 0u;
    __syncthreads();
    XcdBarrier bar = xcd_barrier_post((unsigned*)(FWS + WS_CTL) + CW_BAR, MISC + 8, F.tid);

    p0_prologue(F);
    GRID_BAR();
    layer_fwd<0>(F, bar);
    layer_fwd<1>(F, bar);
    norm_phase<1, false>(F, XB, args.out, F.in[F.zz + 23], nullptr, nullptr);
}

extern "C" void kernel_launch(void* const* d_in, const int* in_sizes, int n_in, void* d_out, int out_size, void* d_ws, size_t ws_size, hipStream_t stream) {
    static int grid = 0;
    if (grid == 0) {
        if (n_in != 24 || out_size != MROWS * DM || ws_size < WS_END) { fprintf(stderr, "kernel_launch: unexpected shapes (n_in %d out %d ws %zu)\n", n_in, out_size, ws_size); grid = -1; return; }
        int dev = 0, cus = 0;
        if (hipGetDevice(&dev) != hipSuccess || hipDeviceGetAttribute(&cus, hipDeviceAttributeMultiprocessorCount, dev) != hipSuccess) { grid = -1; return; }
        if (hipFuncSetAttribute((const void*)mega_fwd, hipFuncAttributeMaxDynamicSharedMemorySize, LDS_BYTES) != hipSuccess) { fprintf(stderr, "kernel_launch: hipFuncSetAttribute failed\n"); grid = -1; return; }
        int per_cu = 0;
        if (hipOccupancyMaxActiveBlocksPerMultiprocessor(&per_cu, (const void*)mega_fwd, NTHR, LDS_BYTES) != hipSuccess || per_cu < 1) { fprintf(stderr, "kernel_launch: occupancy query says %d\n", per_cu); }
        (void)hipGetLastError();
        grid = cus;
    }
    if (grid < 0) return;
    (void)hipMemsetAsync((char*)d_ws + WS_CTL, 0, CTL_ZERO_BYTES, stream);
    Args a{};
    for (int i = 0; i < 24; ++i) a.in[i] = (const float*)d_in[i];
    a.out = (float*)d_out; a.ws = (unsigned char*)d_ws;
    hipLaunchKernelGGL(mega_fwd, dim3(grid), dim3(NTHR), LDS_BYTES, stream, a);
}
```

```cpp
#include <hip/hip_runtime.h>
#include <cstdio>
#include <cstdint>
#ifndef MOBA_NP
#define MOBA_NP 2
#endif
#ifndef MOBA_CHECK
#define MOBA_CHECK 0
#endif
__device__ __forceinline__ int tid_from_wave(int wave) { int l = (int)__builtin_amdgcn_mbcnt_hi(~0u, __builtin_amdgcn_mbcnt_lo(~0u, 0u)); asm volatile("" : "+v"(l)); return wave * 64 + l; }
namespace pg8 {
#define PG8_LAS __attribute__((address_space(3)))
typedef unsigned short bf16_t;
typedef short bf16x8 __attribute__((ext_vector_type(8)));
typedef float f32x4 __attribute__((ext_vector_type(4)));
typedef unsigned u32x4 __attribute__((ext_vector_type(4)));
constexpr int BM = 256, BK = 64, HALF = 128, HTB = HALF * BK * 2  , STAGE_BYTES = 8 * HTB, NXCD = 8, WGM = 8;

__host__ __device__ __forceinline__ int lds_byte(int r, int c) { const int st = (r >> 4) * 2 + (c >> 5), rr = r & 15, cc = c & 31, ob = rr * 64 + cc * 2; return st * 1024 + (ob ^ (((ob >> 9) & 1) << 5)); }
__host__ __device__ __forceinline__ void stage_rc(int b, int& R, int& C) { const int st = b / 1024, sb = b % 1024, swz = sb ^ (((sb >> 9) & 1) << 5); R = (st >> 1) * 16 + swz / 64; C = (st & 1) * 32 + (swz % 64) / 2; }
__host__ __device__ __forceinline__ int perm32(int rho) { const int n = rho >> 4, i = rho & 15; return 8 * (i >> 2) + 4 * n + (i & 3); }

struct Unit { int pm, pn; };
struct Gemm { const bf16_t* A; const bf16_t* Bt; int M, N, K; };

struct StaticOrder {
    int nM, nN, nwg, G, c;
    __host__ __device__ void init(int M, int N, int G_, int c_) { nM = M / BM; nN = N / BM; nwg = nM * nN; G = G_; c = c_; }
    __host__ __device__ bool next(int i, Unit& u) const {
        const long L = (long)i * G + c; if (L >= nwg) return false;
        int wgid = (int)L; { const int q = nwg / NXCD, r = nwg % NXCD, xcd = wgid % NXCD, off = wgid / NXCD; wgid = (xcd < r ? xcd * (q + 1) : r * (q + 1) + (xcd - r) * q) + off; }
        const int nig = WGM * nN, gid = wgid / nig, fm = gid * WGM, gsz = (nM - fm) < WGM ? (nM - fm) : WGM;
        u.pm = fm + ((wgid % nig) % gsz); u.pn = (wgid % nig) / gsz; return true;
    }
    __device__ __forceinline__ void a_ready(const Unit&) const {}
    __device__ __forceinline__ void done(const Unit&) const {}
};

__device__ __forceinline__ unsigned cvt_pk_bf16(float lo, float hi) { unsigned r; asm volatile("v_cvt_pk_bf16_f32 %0, %1, %2" : "=v"(r) : "v"(lo), "v"(hi)); return r; }

struct EpiBf16 {
    static constexpr bool PERM = true, AFTER_DRAIN = false;
    bf16_t* O; int ldc;
    __device__ __forceinline__ void operator()(const f32x4 (&acc)[2][2][4][2], const Unit& u, int wr, int wc, int fr, int fq) const {
        const int row0 = u.pm * BM + wr * 64 + fr; const int col0 = u.pn * BM + wc * 32 + 8 * fq;
#pragma unroll
        for (int ai = 0; ai < 2; ++ai)
#pragma unroll
            for (int m = 0; m < 4; ++m) { bf16_t* rowp = O + (size_t)(row0 + ai * HALF + m * 16) * ldc + col0;
#pragma unroll
                for (int bj = 0; bj < 2; ++bj) { const f32x4 v0 = acc[ai][bj][m][0], v1 = acc[ai][bj][m][1];
                    u32x4 w; w.x = cvt_pk_bf16(v0[0], v0[1]); w.y = cvt_pk_bf16(v0[2], v0[3]); w.z = cvt_pk_bf16(v1[0], v1[1]); w.w = cvt_pk_bf16(v1[2], v1[3]);
                    *(u32x4*)(rowp + bj * HALF) = w; } }
    }
};

template <int CTRL> __device__ __forceinline__ float dpp_ror(float v) { return __builtin_bit_cast(float, __builtin_amdgcn_update_dpp(0, __builtin_bit_cast(int, v), CTRL, 0xF, 0xF, true)); }
struct EpiConvGate {
    static constexpr bool PERM = true, AFTER_DRAIN = false;
    bf16_t* A; int lda; float* halo; const float* cw; const float* cb; int nup, dff;
    __device__ __forceinline__ void operator()(const f32x4 (&acc)[2][2][4][2], const Unit& u, int wr, int wc, int fr, int fq) const {
        const int chl = wc * 32 + 8 * fq;
#pragma unroll
        for (int n = 0; n < 2; ++n) {
            const int c = u.pn * 128 + chl + 4 * n, colp = u.pn * 256 + chl + 4 * n;
            const f32x4 wv0 = *(const f32x4*)(cw + c), wv1 = *(const f32x4*)(cw + nup + c), wv2 = *(const f32x4*)(cw + 2 * nup + c), bv = *(const f32x4*)(cb + c);
            const f32x4 wg0 = *(const f32x4*)(cw + dff + c), wg1 = *(const f32x4*)(cw + nup + dff + c), wg2 = *(const f32x4*)(cw + 2 * nup + dff + c), bg = *(const f32x4*)(cb + dff + c);
#pragma unroll
            for (int ai = 0; ai < 2; ++ai) {
                const int grow = u.pm * BM + ai * HALF + wr * 64;
                float* hb = halo + (size_t)(grow >> 6) * 4 * nup + colp;
                if (fr < 2) { *(f32x4*)(hb + (size_t)fr * nup) = acc[ai][0][0][n]; *(f32x4*)(hb + (size_t)fr * nup + 128) = acc[ai][1][0][n]; }
                if (fr >= 14) { *(f32x4*)(hb + (size_t)(fr - 12) * nup) = acc[ai][0][3][n]; *(f32x4*)(hb + (size_t)(fr - 12) * nup + 128) = acc[ai][1][3][n]; }
                f32x4 cv[4];
                {   f32x4 P1 = {0.f, 0.f, 0.f, 0.f}, P2 = P1;
#pragma unroll
                    for (int m = 0; m < 4; ++m) { f32x4 R1, R2;
#pragma unroll
                        for (int e = 0; e < 4; ++e) { R1[e] = dpp_ror<0x121>(acc[ai][0][m][n][e]); R2[e] = dpp_ror<0x122>(acc[ai][0][m][n][e]); }
                        const f32x4 p1 = (fr >= 1) ? R1 : P1, p2 = (fr >= 2) ? R2 : P2; P1 = R1; P2 = R2;
                        cv[m] = wv0 * p2 + wv1 * p1 + wv2 * acc[ai][0][m][n] + bv; } }
                {   f32x4 P1 = {0.f, 0.f, 0.f, 0.f}, P2 = P1;
#pragma unroll
                    for (int m = 0; m < 4; ++m) { f32x4 R1, R2;
#pragma unroll
                        for (int e = 0; e < 4; ++e) { R1[e] = dpp_ror<0x121>(acc[ai][1][m][n][e]); R2[e] = dpp_ror<0x122>(acc[ai][1][m][n][e]); }
                        const f32x4 p1 = (fr >= 1) ? R1 : P1, p2 = (fr >= 2) ? R2 : P2; P1 = R1; P2 = R2;
                        const f32x4 cg = wg0 * p2 + wg1 * p1 + wg2 * acc[ai][1][m][n] + bg;
                        f32x4 o;
#pragma unroll
                        for (int e = 0; e < 4; ++e) o[e] = cg[e] * __builtin_amdgcn_rcpf(1.0f + __expf(-cg[e])) * cv[m][e];
                        unsigned w0 = cvt_pk_bf16(o[0], o[1]), w1 = cvt_pk_bf16(o[2], o[3]);
                        *(unsigned long long*)(A + (size_t)(grow + m * 16 + fr) * lda + c) = (unsigned long long)w0 | ((unsigned long long)w1 << 32); } }
            }
        }
    }
};

template <bool BASE_F32>
struct EpiResGate {
    static constexpr bool PERM = true, AFTER_DRAIN = false;
    const void* base; bf16_t* out; int ldc; const float* gate; int gstride; int rows_per_batch;
    __device__ __forceinline__ void operator()(const f32x4 (&acc)[2][2][4][2], const Unit& u, int wr, int wc, int fr, int fq) const {
        const int col0 = u.pn * BM + wc * 32 + 8 * fq;
        const int b = (u.pm * BM) / rows_per_batch;
        f32x4 gv[2][2];
#pragma unroll
        for (int bj = 0; bj < 2; ++bj)
#pragma unroll
            for (int n = 0; n < 2; ++n) gv[bj][n] = *(const f32x4*)(gate + (size_t)b * gstride + col0 + bj * HALF + n * 4);
#pragma unroll
        for (int ai = 0; ai < 2; ++ai)
#pragma unroll
            for (int m = 0; m < 4; ++m) { const size_t off = (size_t)(u.pm * BM + ai * HALF + wr * 64 + m * 16 + fr) * ldc + col0;
#pragma unroll
                for (int bj = 0; bj < 2; ++bj) { f32x4 b0, b1;
                    if (BASE_F32) { b0 = *(const f32x4*)((const float*)base + off + bj * HALF); b1 = *(const f32x4*)((const float*)base + off + bj * HALF + 4); }
                    else { const u32x4 w = *(const u32x4*)((const bf16_t*)base + off + bj * HALF);
                        b0 = (f32x4){__builtin_bit_cast(float, w.x << 16), __builtin_bit_cast(float, w.x & 0xffff0000u), __builtin_bit_cast(float, w.y << 16), __builtin_bit_cast(float, w.y & 0xffff0000u)};
                        b1 = (f32x4){__builtin_bit_cast(float, w.z << 16), __builtin_bit_cast(float, w.z & 0xffff0000u), __builtin_bit_cast(float, w.w << 16), __builtin_bit_cast(float, w.w & 0xffff0000u)}; }
                    const f32x4 o0 = b0 + gv[bj][0] * acc[ai][bj][m][0], o1 = b1 + gv[bj][1] * acc[ai][bj][m][1];
                    u32x4 w; w.x = cvt_pk_bf16(o0[0], o0[1]); w.y = cvt_pk_bf16(o0[2], o0[3]); w.z = cvt_pk_bf16(o1[0], o1[1]); w.w = cvt_pk_bf16(o1[2], o1[3]);
                    *(u32x4*)(out + off + bj * HALF) = w; }
                if (m & 1) asm volatile("" ::: "memory"); }
    }
};

template <class Epi, class Sched, bool ALIGN_EPI = false, bool SP2 = false>
__device__ __forceinline__ void gemm_phase(PG8_LAS unsigned char* lds, const Gemm g, const Sched& S, const Epi& E, int wave_) {
    const int tid_ = tid_from_wave(wave_);
    const int tid = tid_, wid = __builtin_amdgcn_readfirstlane(tid >> 6), lane = tid & 63, wr = wid >> 2, wc = wid & 3, fr = lane & 15, fq = lane >> 4;
    const int K = g.K, nt = K / BK;
    unsigned voffA[2], voffB[2];
#pragma unroll
    for (int i = 0; i < 2; ++i) { int R, C; stage_rc(tid * 16 + i * 8192, R, C); const int Rb = Epi::PERM ? ((R & ~31) + perm32(R & 31)) : R;
        voffA[i] = (unsigned)(R * K + C) * 2u; voffB[i] = (unsigned)(Rb * K + C) * 2u; }
    const size_t kstep = (size_t)(BK * 2);
    const size_t hstep = (size_t)HALF * K * 2;
    const size_t tstep = 2 * hstep;
    const unsigned ldsw = (unsigned)wid * 1024u;
    const int aoff = lds_byte(wr * 64 + fr, fq * 8), boff = lds_byte(wc * 32 + fr, fq * 8);
#define PG8_SA(b, h) (((b) * 2 + (h)) * HTB)
#define PG8_SB(b, h) ((4 + (b) * 2 + (h)) * HTB)
#define PG8_STAGE(bufoff, gbase, voff) do { _Pragma("unroll") for (int _i = 0; _i < 2; ++_i) \
        __builtin_amdgcn_global_load_lds((const unsigned*)((const char*)(gbase) + (voff)[_i]), (PG8_LAS unsigned*)(lds + (bufoff) + ldsw + _i * 8192), 16, 0, 0); } while (0)
#define PG8_LDA(dst, b, h) do { _Pragma("unroll") for (int m = 0; m < 4; ++m) _Pragma("unroll") for (int k = 0; k < 2; ++k) dst[m][k] = *(const PG8_LAS bf16x8*)(lds + PG8_SA(b, h) + aoff + m * 2048 + k * 1024); } while (0)
#define PG8_LDB(dst, b, h) do { _Pragma("unroll") for (int n = 0; n < 2; ++n) _Pragma("unroll") for (int k = 0; k < 2; ++k) dst[n][k] = *(const PG8_LAS bf16x8*)(lds + PG8_SB(b, h) + boff + n * 2048 + k * 1024); } while (0)
#define PG8_MMA(ai, bj, At, Bt) do { __builtin_amdgcn_s_setprio(1); _Pragma("unroll") for (int m = 0; m < 4; ++m) _Pragma("unroll") for (int n = 0; n < 2; ++n) _Pragma("unroll") for (int k = 0; k < 2; ++k) \
        acc[ai][bj][m][n] = __builtin_amdgcn_mfma_f32_16x16x32_bf16(Bt[n][k], At[m][k], acc[ai][bj][m][n], 0, 0, 0); __builtin_amdgcn_s_setprio(0); } while (0)
#define PG8_WAIT_V(n) asm volatile("s_waitcnt vmcnt(" #n ")" ::: "memory")
#define PG8_WAIT_L(n) asm volatile("s_waitcnt lgkmcnt(" #n ")" ::: "memory")
#define PG8_BAR __builtin_amdgcn_s_barrier()
#define PG8_SCHED __builtin_amdgcn_sched_barrier(0)
    Unit cur, nxt; int ui = 0;
    if (!S.next(0, cur)) return;
    f32x4 acc[2][2][4][2];
#pragma unroll
    for (int a = 0; a < 2; ++a)
#pragma unroll
        for (int b = 0; b < 2; ++b)
#pragma unroll
            for (int m = 0; m < 4; ++m)
#pragma unroll
                for (int n = 0; n < 2; ++n) acc[a][b][m][n] = (f32x4){0.f, 0.f, 0.f, 0.f};
    bf16x8 At[4][2], B0[2][2], B1[2][2];
    const char* cA = (const char*)g.A + (size_t)cur.pm * tstep; const char* cB = (const char*)g.Bt + (size_t)cur.pn * tstep;
    S.a_ready(cur);
    if constexpr (SP2) {
        PG8_STAGE(PG8_SB(0, 0), cB, voffB); PG8_STAGE(PG8_SB(0, 1), cB + hstep, voffB); PG8_STAGE(PG8_SA(0, 0), cA, voffA); PG8_STAGE(PG8_SA(0, 1), cA + hstep, voffA);
        if (wr == 1) PG8_BAR;
        PG8_WAIT_V(2); PG8_BAR;
        PG8_STAGE(PG8_SB(1, 0), cB + kstep, voffB); PG8_STAGE(PG8_SA(1, 0), cA + kstep, voffA); PG8_STAGE(PG8_SB(1, 1), cB + hstep + kstep, voffB);
        PG8_WAIT_V(6); PG8_BAR;
    } else {
        PG8_STAGE(PG8_SB(0, 0), cB, voffB); PG8_STAGE(PG8_SA(0, 0), cA, voffA); PG8_STAGE(PG8_SB(0, 1), cB + hstep, voffB); PG8_STAGE(PG8_SA(0, 1), cA + hstep, voffA);
        if (wr == 1) PG8_BAR;
        PG8_WAIT_V(4); PG8_BAR;
        PG8_STAGE(PG8_SB(1, 0), cB + kstep, voffB); PG8_STAGE(PG8_SA(1, 0), cA + kstep, voffA); PG8_STAGE(PG8_SB(1, 1), cB + hstep + kstep, voffB);
        PG8_WAIT_V(6); PG8_BAR;
    }
    for (;;) {
        const bool has_next = S.next(ui + 1, nxt);
        const char* nA = has_next ? (const char*)g.A + (size_t)nxt.pm * tstep : cA; const char* nB = has_next ? (const char*)g.Bt + (size_t)nxt.pn * tstep : cB;
        for (int t = 0; t < nt; t += 2) {
            const bool last = (t == nt - 2);
            const char* a1 = cA + (size_t)(t + 1) * kstep;
            const char* a2 = last ? nA : cA + (size_t)(t + 2) * kstep; const char* b2 = last ? nB : cB + (size_t)(t + 2) * kstep;
            const char* a3 = a2 + kstep; const char* b3 = b2 + kstep;
            if (last && has_next) S.a_ready(nxt);
            if constexpr (SP2) {
            PG8_LDB(B0, 0, 0); PG8_LDB(B1, 0, 1); PG8_SCHED; PG8_LDA(At, 0, 0); PG8_STAGE(PG8_SA(1, 1), a1 + hstep, voffA);
            PG8_WAIT_V(8); PG8_WAIT_L(0); PG8_BAR; PG8_MMA(0, 0, At, B0); PG8_MMA(0, 1, At, B1); PG8_BAR; PG8_SCHED;
            PG8_LDA(At, 0, 1); PG8_STAGE(PG8_SB(0, 0), b2, voffB); PG8_STAGE(PG8_SB(0, 1), b2 + hstep, voffB); PG8_STAGE(PG8_SA(0, 0), a2, voffA);
            PG8_WAIT_V(8); PG8_WAIT_L(0); PG8_BAR; PG8_MMA(1, 0, At, B0); PG8_MMA(1, 1, At, B1); PG8_BAR; PG8_SCHED;
            PG8_LDB(B0, 1, 0); PG8_LDB(B1, 1, 1); PG8_SCHED; PG8_LDA(At, 1, 0); PG8_STAGE(PG8_SA(0, 1), a2 + hstep, voffA);
            PG8_WAIT_V(8); PG8_WAIT_L(0); PG8_BAR; PG8_MMA(0, 0, At, B0); PG8_MMA(0, 1, At, B1); PG8_BAR; PG8_SCHED;
            PG8_LDA(At, 1, 1); PG8_STAGE(PG8_SB(1, 0), b3, voffB); PG8_STAGE(PG8_SB(1, 1), b3 + hstep, voffB); PG8_STAGE(PG8_SA(1, 0), a3, voffA);
            PG8_WAIT_V(8); PG8_WAIT_L(0); PG8_BAR; PG8_MMA(1, 0, At, B0); PG8_MMA(1, 1, At, B1); PG8_BAR; PG8_SCHED;
            } else {
            PG8_LDB(B0, 0, 0); PG8_SCHED; PG8_LDA(At, 0, 0); PG8_STAGE(PG8_SA(1, 1), a1 + hstep, voffA);
            PG8_WAIT_L(8); PG8_BAR; PG8_WAIT_L(0); PG8_MMA(0, 0, At, B0); PG8_BAR; PG8_SCHED;
            PG8_LDB(B1, 0, 1); PG8_STAGE(PG8_SB(0, 0), b2, voffB);
            PG8_BAR; PG8_WAIT_L(0); PG8_MMA(0, 1, At, B1); PG8_BAR;
            PG8_LDA(At, 0, 1); PG8_STAGE(PG8_SA(0, 0), a2, voffA);
            PG8_BAR; PG8_WAIT_L(0); PG8_MMA(1, 0, At, B0); PG8_BAR; PG8_SCHED;
            PG8_STAGE(PG8_SB(0, 1), b2 + hstep, voffB);
            PG8_WAIT_V(6); PG8_BAR; PG8_MMA(1, 1, At, B1); PG8_BAR;
            PG8_LDB(B0, 1, 0); PG8_SCHED; PG8_LDA(At, 1, 0); PG8_STAGE(PG8_SA(0, 1), a2 + hstep, voffA);
            PG8_WAIT_L(8); PG8_BAR; PG8_WAIT_L(0); PG8_MMA(0, 0, At, B0); PG8_BAR; PG8_SCHED;
            PG8_LDB(B1, 1, 1); PG8_STAGE(PG8_SB(1, 0), b3, voffB);
            PG8_BAR; PG8_WAIT_L(0); PG8_MMA(0, 1, At, B1); PG8_BAR;
            PG8_LDA(At, 1, 1); PG8_STAGE(PG8_SA(1, 0), a3, voffA);
            PG8_BAR; PG8_WAIT_L(0); PG8_MMA(1, 0, At, B0); PG8_BAR; PG8_SCHED;
            PG8_STAGE(PG8_SB(1, 1), b3 + hstep, voffB);
            PG8_WAIT_V(6); PG8_BAR; PG8_MMA(1, 1, At, B1); PG8_BAR;
            }
        }
        if constexpr (ALIGN_EPI) { if (wr == 0) PG8_BAR; }
        if constexpr (!Epi::AFTER_DRAIN) { E(acc, cur, wr, wc, fr, fq); S.done(cur); }
        if (!has_next) break;
#pragma unroll
        for (int a = 0; a < 2; ++a)
#pragma unroll
            for (int b = 0; b < 2; ++b)
#pragma unroll
                for (int m = 0; m < 4; ++m)
#pragma unroll
                    for (int n = 0; n < 2; ++n) acc[a][b][m][n] = (f32x4){0.f, 0.f, 0.f, 0.f};
        cur = nxt; cA = nA; cB = nB; ++ui;
        if constexpr (ALIGN_EPI) { if (wr == 1) PG8_BAR; }
    }
    PG8_WAIT_V(0);
    if constexpr (!ALIGN_EPI) { if (wr == 0) PG8_BAR; }
    PG8_BAR;
    if constexpr (Epi::AFTER_DRAIN) { E.fused(acc, cur, wr, wc, fr, fq, lds, wid, lane); S.done(cur); }
#undef PG8_SA
#undef PG8_SB
#undef PG8_STAGE
#undef PG8_LDA
#undef PG8_LDB
#undef PG8_MMA
#undef PG8_WAIT_V
#undef PG8_WAIT_L
#undef PG8_BAR
#undef PG8_SCHED
}
}

namespace moba {
using bf16 = unsigned short;
typedef short bf16x8 __attribute__((ext_vector_type(8)));
typedef short s16x4 __attribute__((ext_vector_type(4)));
typedef float f32x16 __attribute__((ext_vector_type(16)));
typedef float f32x4 __attribute__((ext_vector_type(4)));
typedef unsigned u32x4 __attribute__((ext_vector_type(4)));
#define MLAS __attribute__((address_space(3)))
typedef MLAS char lchar; typedef MLAS float lfloat; typedef MLAS bf16x8 lbf16x8;
template <class A, class Bt> struct same_t { static constexpr bool v = false; };
template <class A> struct same_t<A, A> { static constexpr bool v = true; };
constexpr int D = 128, LDI = 6656, LDO = 2048;
constexpr float THR = 8.f;
constexpr bool WSKIP = false;
constexpr float SCALE = 0.08838834764831845f;
constexpr int NW = 8, QBLK = 32, KVBLK = 64, QB = NW * QBLK;
constexpr int SHM_V = KVBLK * D * 2, SHM_K = KVBLK * D * 2;
constexpr int LDS_BYTES = 2 * SHM_V + 2 * SHM_K + NW * 64 * 4;
#define KSWZ(row, colB) ((row) * 256 + ((colB) ^ (((row) & 7) << 4)))
#define SBAR() __builtin_amdgcn_sched_barrier(0)
__device__ __forceinline__ int v_st(int k, int c) { const int kk = (k & ~0xC) | ((k & 4) << 1) | ((k & 8) >> 1); return ((kk >> 3) * 4 + (c >> 5)) * 512 + ((kk & 7) * 32 + (c & 31)) * 2; }
__device__ __forceinline__ int v_rd_base(int lane) { return ((lane & 3) << 3) | (((lane >> 2) & 3) << 6) | (((lane >> 4) & 1) << 5) | (((lane >> 5) & 1) << 8); }
constexpr int v_rd_off(int d0, int ks, int half) { return d0 * 512 + ks * 4096 + half * 2048; }
__device__ __forceinline__ int crow(int r, int hi) { return (r & 3) + 8 * (r >> 2) + 4 * hi; }
__device__ __forceinline__ unsigned cvtpk(float lo, float hi) {
    unsigned r; asm volatile("v_cvt_pk_bf16_f32 %0, %1, %2" : "=v"(r) : "v"(lo), "v"(hi)); return r;
}
__device__ __forceinline__ bf16x8 pack8(f32x4 a, f32x4 b) {
    u32x4 w = {cvtpk(a[0], a[1]), cvtpk(a[2], a[3]), cvtpk(b[0], b[1]), cvtpk(b[2], b[3])};
    return *reinterpret_cast<bf16x8*>(&w);
}
template <class T> __device__ __forceinline__ bf16x8 load8(const T* p) {
    if constexpr (same_t<T, float>::v) { return pack8(*(const f32x4*)p, *(const f32x4*)(p + 4)); }
    else { return *reinterpret_cast<const bf16x8*>(p); }
}
__device__ __forceinline__ void mask_tile(f32x16& p0, f32x16& p1, int dq, unsigned W) {
    const float NEG = -__builtin_inff();
#pragma unroll
    for (int r = 0; r < 16; ++r) {
        const int c = (r & 3) + 8 * (r >> 2);
        if ((unsigned)(dq - c) >= W) p0[r] = NEG;
        if ((unsigned)(dq - c - 32) >= W) p1[r] = NEG;
    }
}
__device__ __forceinline__ void partialSM(f32x16& p0, f32x16& p1, float& m_reg, float& mn, float& alpha) {
    float pmax = p0[0]; for (int r = 1; r < 16; ++r) pmax = fmaxf(pmax, p0[r]); for (int r = 0; r < 16; ++r) pmax = fmaxf(pmax, p1[r]);
    { auto rr = __builtin_amdgcn_permlane32_swap(__float_as_uint(pmax), __float_as_uint(pmax), false, false);
      pmax = fmaxf(__uint_as_float(rr[0]), __uint_as_float(rr[1])); }
    constexpr float C2 = 1.4426950408889634f * SCALE;
    if (__builtin_expect(__all((pmax - m_reg) * SCALE <= THR), 1)) { mn = m_reg; alpha = 1.f; }
    else { mn = fmaxf(m_reg, pmax); alpha = __builtin_amdgcn_exp2f((m_reg - mn) * C2); m_reg = mn; }
    const float mnL = -mn * C2;
    for (int r = 0; r < 16; ++r) p0[r] = fmaf(p0[r], C2, mnL); for (int r = 0; r < 16; ++r) p1[r] = fmaf(p1[r], C2, mnL);
    for (int r = 0; r < 16; ++r) p0[r] = __builtin_amdgcn_exp2f(p0[r]);
}
__device__ __forceinline__ void finishSM(f32x16& p0, f32x16& p1, float alpha, float& l_reg, bf16x8& pa0, bf16x8& pa1, bf16x8& pa2, bf16x8& pa3) {
    for (int r = 0; r < 16; ++r) p1[r] = __builtin_amdgcn_exp2f(p1[r]);
    float ps = 0; for (int r = 0; r < 16; ++r) ps += p0[r]; for (int r = 0; r < 16; ++r) ps += p1[r];
    { auto rr = __builtin_amdgcn_permlane32_swap(__float_as_uint(ps), __float_as_uint(ps), false, false);
      ps = __uint_as_float(rr[0]) + __uint_as_float(rr[1]); }
    l_reg = l_reg * alpha + ps;
#define PK4(P, B_, OUT) do { unsigned a0 = cvtpk(P[B_+0], P[B_+1]), a1 = cvtpk(P[B_+2], P[B_+3]);                          \
        unsigned b0 = cvtpk(P[B_+4], P[B_+5]), b1 = cvtpk(P[B_+6], P[B_+7]);                                             \
        auto r0 = __builtin_amdgcn_permlane32_swap(a0, b0, false, false); auto r1 = __builtin_amdgcn_permlane32_swap(a1, b1, false, false); \
        u32x4 w = {r0[0], r1[0], r0[1], r1[1]}; OUT = *reinterpret_cast<bf16x8*>(&w); } while (0)
    PK4(p0, 0, pa0); PK4(p0, 8, pa1); PK4(p1, 0, pa2); PK4(p1, 8, pa3);
#undef PK4
}
template <int KB, bool SK>
__device__ __forceinline__ void qkt(f32x16& p0, f32x16& p1, const lchar* K_lds, int r32, int hi, const bf16x8* qr, bool act, float slopeR, float lb) {
    if (SK && !act) { const float NEG = -__builtin_inff();
#pragma unroll
        for (int r = 0; r < 16; ++r) { p0[r] = NEG; p1[r] = NEG; } return; }
#pragma unroll
    for (int r = 0; r < 16; ++r) { const int c = (r & 3) + 8 * (r >> 2); p0[r] = __builtin_fmaf(slopeR, (float)c, lb); p1[r] = __builtin_fmaf(slopeR, (float)(c + 32), lb); }
    const lchar* kb[4];
#pragma unroll
    for (int dd = 0; dd < 4; ++dd) kb[dd] = K_lds + KB * SHM_K + KSWZ(r32, (dd * 16 + hi * 8) * 2);
#pragma unroll
    for (int d0 = 0; d0 < 8; ++d0) { const lchar* a = kb[d0 & 3] + (d0 >> 2) * 128;
        bf16x8 b0 = *(const lbf16x8*)(a);
        bf16x8 b1 = *(const lbf16x8*)(a + 32 * 256);
        p0 = __builtin_amdgcn_mfma_f32_32x32x16_bf16(b0, qr[d0], p0, 0, 0, 0);
        p1 = __builtin_amdgcn_mfma_f32_32x32x16_bf16(b1, qr[d0], p1, 0, 0, 0); }
}
template <int VB, bool SK>
__device__ __forceinline__ void pv_tile(f32x16* o, int vb0, bf16x8 pa0, bf16x8 pa1, bf16x8 pa2, bf16x8 pa3, bool act) {
    if (SK && !act) return;
#define TRRD(dst, off) asm volatile("ds_read_b64_tr_b16 %0, %1 offset:%2" : "=&v"(dst) : "v"(vb0), "i"(off) : "memory")
#define PV_D0(d0) do { s16x4 l0, l1, l2, l3, h0, h1, h2, h3; constexpr int b_ = VB * SHM_V + v_rd_off(d0, 0, 0);     \
        TRRD(l0, b_); TRRD(h0, b_ + 2048); TRRD(l1, b_ + 4096); TRRD(h1, b_ + 6144); TRRD(l2, b_ + 8192); TRRD(h2, b_ + 10240); TRRD(l3, b_ + 12288); TRRD(h3, b_ + 14336); \
        asm volatile("s_waitcnt lgkmcnt(0)" ::: "memory"); SBAR();                 \
        o[d0] = __builtin_amdgcn_mfma_f32_32x32x16_bf16(pa0, (bf16x8){l0[0], l0[1], l0[2], l0[3], h0[0], h0[1], h0[2], h0[3]}, o[d0], 0, 0, 0);   \
        o[d0] = __builtin_amdgcn_mfma_f32_32x32x16_bf16(pa1, (bf16x8){l1[0], l1[1], l1[2], l1[3], h1[0], h1[1], h1[2], h1[3]}, o[d0], 0, 0, 0);   \
        o[d0] = __builtin_amdgcn_mfma_f32_32x32x16_bf16(pa2, (bf16x8){l2[0], l2[1], l2[2], l2[3], h2[0], h2[1], h2[2], h2[3]}, o[d0], 0, 0, 0);   \
        o[d0] = __builtin_amdgcn_mfma_f32_32x32x16_bf16(pa3, (bf16x8){l3[0], l3[1], l3[2], l3[3], h3[0], h3[1], h3[2], h3[3]}, o[d0], 0, 0, 0); } while (0)
    PV_D0(0); PV_D0(1); PV_D0(2); PV_D0(3);
#undef PV_D0
#undef TRRD
}

typedef __attribute__((address_space(1))) char gchar; typedef __attribute__((address_space(1))) bf16x8 gbf16x8;
__device__ __forceinline__ const gchar* uni_ptr(const char* p) { const unsigned long long v = (unsigned long long)p;
    const unsigned lo = __builtin_amdgcn_readfirstlane((unsigned)v), hi = __builtin_amdgcn_readfirstlane((unsigned)(v >> 32)); return (const gchar*)(((unsigned long long)hi << 32) | lo); }
template <class TIn, class TOut> struct BlockRef { const TIn* Q; const TIn* K; const TIn* V; TOut* O; int P0; const __attribute__((address_space(3))) unsigned* sel; float slopeR; };
template <class TIn> struct Seam {
    bf16x8 qr[8];
    bf16x8 st_v0, st_v1, st_k0, st_k1; f32x4 sf0, sf1, sf2, sf3;
    f32x4 tq[16];
};
__device__ __forceinline__ int swa_jlo(int P0, int W) { const int lowk = P0 - W + 1; return lowk > 0 ? lowk / KVBLK : 0; }
#define ROW(p, k0, rr) ((const TIn*)((const char*)(p) + (size_t)(k0) * (LDI * sizeof(TIn)) + (unsigned)(((rr) * LDI + sc) * (int)sizeof(TIn))))
#define VMW() asm volatile("s_waitcnt vmcnt(0)" ::: "memory")
#define VMWN(n) asm volatile("s_waitcnt vmcnt(%0)" :: "i"(n) : "memory")
#define SLOAD_H(Kp, Vp, k0) do { const gchar* kb__ = uni_ptr((const char*)(Kp) + (size_t)(k0) * (LDI * sizeof(TIn))); const gchar* vb__ = uni_ptr((const char*)(Vp) + (size_t)(k0) * (LDI * sizeof(TIn))); \
                         S.st_v0 = *(const gbf16x8*)(vb__ + roff0); S.st_v1 = *(const gbf16x8*)(vb__ + roff1);              \
                         S.st_k0 = *(const gbf16x8*)(kb__ + roff0); S.st_k1 = *(const gbf16x8*)(kb__ + roff1); } while (0)
#define SWRITE_HK(bf) do { *(lbf16x8*)(K_lds + (bf) * SHM_K + kws) = S.st_k0; *(lbf16x8*)(K_lds + (bf) * SHM_K + kws + 32 * 256) = S.st_k1; } while (0)
#define SWRITE_HV(bf) do { *(lbf16x8*)(V_lds + (bf) * SHM_V + vst0) = S.st_v0; *(lbf16x8*)(V_lds + (bf) * SHM_V + vst1) = S.st_v1; } while (0)
#define SWRITE_H(bf) do { SWRITE_HV(bf); SWRITE_HK(bf); } while (0)
#define SLOAD_F(p, k0) do { S.sf0 = *(const f32x4*)ROW(p, k0, sr); S.sf1 = *(const f32x4*)(ROW(p, k0, sr) + 4);                \
                            S.sf2 = *(const f32x4*)ROW(p, k0, 32 + sr); S.sf3 = *(const f32x4*)(ROW(p, k0, 32 + sr) + 4); } while (0)
#define SWRITE_KF(bf) do { *(lbf16x8*)(K_lds + (bf) * SHM_K + kws) = pack8(S.sf0, S.sf1); *(lbf16x8*)(K_lds + (bf) * SHM_K + kws + 32 * 256) = pack8(S.sf2, S.sf3); } while (0)
#define SWRITE_VF(bf) do { *(lbf16x8*)(V_lds + (bf) * SHM_V + vst0) = pack8(S.sf0, S.sf1); *(lbf16x8*)(V_lds + (bf) * SHM_V + vst1) = pack8(S.sf2, S.sf3); } while (0)
template <class TIn, class TOut>
__device__ __forceinline__ void causal_swa_prime(const BlockRef<TIn, TOut>& cur, int W, lchar* lds, Seam<TIn>& S, int wave_) {
    constexpr bool F32 = same_t<TIn, float>::v;
    const int tid_ = tid_from_wave(wave_);
    const int tid = tid_, wid = __builtin_amdgcn_readfirstlane(tid >> 6), lane = tid & 63, r32 = lane & 31, hi = lane >> 5;
    const int sr = tid >> 4, sc = (tid & 15) * 8, kws = KSWZ(sr, sc * 2); lchar* K_lds = lds + 2 * SHM_V;
    const unsigned roff0 = (unsigned)((sr * LDI + sc) * (int)sizeof(TIn)), roff1 = (unsigned)(((32 + sr) * LDI + sc) * (int)sizeof(TIn));
    const int kb0 = ((cur.P0 + QB - 1) / KVBLK) * KVBLK;
    for (int d0 = 0; d0 < 8; ++d0) S.qr[d0] = *(const gbf16x8*)(uni_ptr((const char*)cur.Q) + (unsigned)(((wid * QBLK + r32) * LDI + hi * 8) * (int)sizeof(TIn)) + d0 * 16 * sizeof(TIn));
    if constexpr (F32) { SLOAD_F((const float*)cur.K, kb0); VMW(); SWRITE_KF(0); SBAR(); SLOAD_F((const float*)cur.V, kb0); }
    else { SLOAD_H(cur.K, cur.V, kb0); VMW(); SWRITE_HK(0); }
    __syncthreads();
}
template <class TIn, class TOut>
__device__ __forceinline__ void causal_swa_block(const BlockRef<TIn, TOut>& cur, const BlockRef<TIn, TOut>& nxt, int skv, int W, lchar* lds, Seam<TIn>& S, int wave_) {
    constexpr bool F32 = same_t<TIn, float>::v;
    const int tid_ = tid_from_wave(wave_);
    const int tid = tid_, wid = __builtin_amdgcn_readfirstlane(tid >> 6), lane = tid & 63, r32 = lane & 31, hi = lane >> 5;
    const int j_lo = swa_jlo(cur.P0, W);
    int j_hi = (cur.P0 + QB - 1) / KVBLK + 1; if (j_hi > skv / KVBLK) j_hi = skv / KVBLK;
    const int NT = j_hi - j_lo;
    const int kbn = ((nxt.P0 + QB - 1) / KVBLK) * KVBLK;
    const unsigned selm = cur.sel[wid * QBLK + r32] | (1u << (cur.P0 >> 8)); const float slopeR = __builtin_bit_cast(float, __builtin_amdgcn_readfirstlane(__builtin_bit_cast(unsigned, cur.slopeR))); const int tqm = cur.P0 + wid * QBLK + r32 - 4 * hi;
#define LB(t) (((selm >> (KBASE(t) >> 8)) & 1u) ? slopeR * (float)(KBASE(t) - tqm) : -__builtin_inff())
    const int qlo = cur.P0 + wid * QBLK, qm = qlo + r32 - 4 * hi;
    lchar* V_lds = lds; lchar* K_lds = lds + 2 * SHM_V;
    lfloat* ws = (lfloat*)(lds + 2 * SHM_V + 2 * SHM_K) + wid * 64; lfloat* li_l = ws; lfloat* al_l = ws + 32;
    float m_reg = -1e30f, l_reg = 0; f32x16 o[4] = {};
    const unsigned roff0 = (unsigned)(((tid >> 4) * LDI + (tid & 15) * 8) * (int)sizeof(TIn)), roff1 = (unsigned)(((32 + (tid >> 4)) * LDI + (tid & 15) * 8) * (int)sizeof(TIn));
    const int sr = tid >> 4, sc = (tid & 15) * 8, vst0 = v_st(sr, sc), vst1 = v_st(32 + sr, sc), kws = KSWZ(sr, sc * 2);
    const int vb0 = (int)(unsigned)(uintptr_t)V_lds + v_rd_base(lane);
    const TIn* Kh = cur.K; const TIn* Vh = cur.V;
#define RESC(a) do { if (__any((a) < 1.f)) { if (hi == 0) al_l[r32] = (a); asm volatile("s_waitcnt lgkmcnt(0)" ::: "memory");              \
                     for (int d_ = 0; d_ < 4; ++d_) for (int r = 0; r < 16; ++r) o[d_][r] *= al_l[crow(r, hi)]; } } while (0)
#define KBASE(t) ((j_hi - 1 - (t)) * KVBLK)
#define ACT(t) (KBASE(t) <= qlo + QBLK - 1 && KBASE(t) + KVBLK - 1 >= qlo - W + 1)
#define MASKT(P0_, P1_, t) do { const int kb_ = KBASE(t); if ((!SK || ACT(t)) && (kb_ + KVBLK - 1 > qlo || kb_ <= qlo + QBLK - 1 - W)) mask_tile(P0_, P1_, qm - kb_, (unsigned)W); } while (0)
    constexpr int NQL = F32 ? 16 : 8;
    constexpr bool SK = WSKIP && !F32;
#define SEAM_K0() do { VMWN(NQL); if constexpr (F32) { SWRITE_KF(0); SBAR(); SLOAD_F((const float*)nxt.V, kbn); } else { SWRITE_HK(0); } SBAR(); } while (0)
    unsigned touch_reg = 0u; const int tl_ = wid * 32 + (lane & 31);
    const unsigned toff = (unsigned)(((tl_ & 127) >> 1) * LDI * (int)sizeof(TIn) + (tl_ & 1) * 128);
    const gchar* tbase = uni_ptr((const char*)((tl_ >> 7) ? (const void*)Vh : (const void*)Kh));
#if MOBA_CHECK
#define TOUCH(k0) do {} while (0)
#else
#define TOUCH(k0) do { const gchar* tp_ = tbase + (size_t)(k0) * (LDI * sizeof(TIn)) + toff; asm volatile("global_load_dword %0, %1, off" : "+v"(touch_reg) : "v"(tp_) : "memory"); } while (0)
#endif
    f32x16 pA0, pA1, pB0, pB1; float mnA, mnB, alA, alB; bf16x8 pa0, pa1, pa2, pa3;
    if constexpr (F32) { VMW(); SWRITE_VF(0); SBAR(); } else { SWRITE_HV(0); SBAR(); }
    if (NT > 1) { if constexpr (F32) SLOAD_F((const float*)Kh, KBASE(1)); else SLOAD_H(Kh, Vh, KBASE(1)); }
    SBAR(); qkt<0, SK>(pA0, pA1, K_lds, r32, hi, S.qr, ACT(0), slopeR, LB(0));
    if constexpr (F32) { if (NT > 1) { VMW(); SWRITE_KF(1); SBAR(); SLOAD_F((const float*)Vh, KBASE(1)); } }
    MASKT(pA0, pA1, 0); partialSM(pA0, pA1, m_reg, mnA, alA);
    if (NT > 1) { VMW(); if constexpr (F32) { SWRITE_VF(1); SBAR(); if (NT > 2) SLOAD_F((const float*)Kh, KBASE(2)); } else SWRITE_H(1); }
    __syncthreads();
#define HALF_STEP(PX0, PX1, mnX, alX, PY0, PY1, alY, t, KB, VB, SB) do {                                                      \
        SBAR(); qkt<KB, SK>(PX0, PX1, K_lds, r32, hi, S.qr, ACT(t), slopeR, LB(t));                                             \
        finishSM(PY0, PY1, alY, l_reg, pa0, pa1, pa2, pa3); SBAR();                                                           \
        if ((t) + 1 < NT) { if constexpr (F32) { VMW(); SWRITE_KF(SB); SBAR(); SLOAD_F((const float*)Vh, KBASE((t) + 1)); }  \
                            else { SLOAD_H(Kh, Vh, KBASE((t) + 1)); } SBAR(); }                                               \
        pv_tile<VB, SK>(o, vb0, pa0, pa1, pa2, pa3, ACT((t) - 1)); MASKT(PX0, PX1, (t)); partialSM(PX0, PX1, m_reg, mnX, alX);                                        \
        __syncthreads();                                                                                                      \
        if ((t) + 1 < NT) { VMW(); if constexpr (F32) { SWRITE_VF(SB); SBAR(); if ((t) + 2 < NT) SLOAD_F((const float*)Kh, KBASE((t) + 2)); } \
                            else { SWRITE_H(SB); } }                                                                          \
        if ((t) + 3 < NT) { TOUCH(KBASE((t) + 3)); }                                                                          \
        RESC(alX); __syncthreads(); } while (0)
    for (int t = 1; t + 1 < NT; t += 2) {
        HALF_STEP(pB0, pB1, mnB, alB, pA0, pA1, alA, t, 1, 0, 0);
        HALF_STEP(pA0, pA1, mnA, alA, pB0, pB1, alB, t + 1, 0, 1, 1);
    }
    const bool even = (NT & 1) == 0;
    if (even) { SBAR(); qkt<1, SK>(pB0, pB1, K_lds, r32, hi, S.qr, ACT(NT - 1), slopeR, LB(NT - 1)); SBAR(); }
#define QROW(e) (nxt.Q + (size_t)(wid * QBLK + r32) * LDI + ((e) >> 1) * 16 + hi * 8 + ((e) & 1) * 4)
    if constexpr (F32) { SLOAD_F((const float*)nxt.K, kbn); SBAR();
#pragma unroll
        for (int e = 0; e < 8; ++e) S.tq[e] = *(const f32x4*)QROW(e); }
    else { SLOAD_H(nxt.K, nxt.V, kbn); SBAR();
#pragma unroll
        for (int d0 = 0; d0 < 8; ++d0) S.qr[d0] = *(const gbf16x8*)(uni_ptr((const char*)nxt.Q) + (unsigned)(((wid * QBLK + r32) * LDI + hi * 8) * (int)sizeof(TIn)) + d0 * 16 * sizeof(TIn)); }
    SBAR();
    finishSM(pA0, pA1, alA, l_reg, pa0, pa1, pa2, pa3); SBAR();
    if constexpr (F32) {
#pragma unroll
        for (int e = 8; e < 16; ++e) S.tq[e] = *(const f32x4*)QROW(e); SBAR(); }
#undef QROW
    pv_tile<0, SK>(o, vb0, pa0, pa1, pa2, pa3, ACT(even ? NT - 2 : NT - 1));
    if (even) { MASKT(pB0, pB1, NT - 1); partialSM(pB0, pB1, m_reg, mnB, alB); __syncthreads(); RESC(alB);
        finishSM(pB0, pB1, alB, l_reg, pa0, pa1, pa2, pa3); SBAR(); pv_tile<1, SK>(o, vb0, pa0, pa1, pa2, pa3, ACT(NT - 1)); }
    SBAR(); SEAM_K0();
    if (hi == 0) li_l[r32] = l_reg; asm volatile("s_waitcnt lgkmcnt(0)" ::: "memory");
    float rli[16];
#pragma unroll
    for (int r = 0; r < 16; ++r) rli[r] = __builtin_amdgcn_rcpf(li_l[crow(r, hi)]);
    const gchar* Owb = uni_ptr((const char*)(cur.O + (size_t)(wid * QBLK) * LDO)); const unsigned ooff = (unsigned)((4 * hi * LDO + r32) * (int)sizeof(TOut));
#pragma unroll
    for (int r = 0; r < 16; ++r) { const int orc = (r & 3) + 8 * (r >> 2);
#pragma unroll
        for (int d0 = 0; d0 < 4; ++d0) { const float v = o[d0][r] * rli[r];
            if constexpr (same_t<TOut, float>::v) { *(__attribute__((address_space(1))) float*)((gchar*)(Owb) + ooff + (unsigned)((orc * LDO + d0 * 32) * (int)sizeof(TOut))) = v; }
            else { const float vn = __builtin_bit_cast(float, __builtin_amdgcn_update_dpp(0, __builtin_bit_cast(int, v), 0xB1, 0xF, 0xF, true));
                   if ((r32 & 1) == 0) *(__attribute__((address_space(1))) unsigned*)((gchar*)(Owb) + ooff + (unsigned)((orc * LDO + d0 * 32) * (int)sizeof(TOut))) = cvtpk(v, vn); } } }
    if constexpr (F32) {
#pragma unroll
        for (int d0 = 0; d0 < 8; ++d0) S.qr[d0] = pack8(S.tq[2 * d0], S.tq[2 * d0 + 1]); }
    __syncthreads();
    asm volatile("" :: "v"(touch_reg));
#undef TOUCH
#undef RESC
#undef LB
#undef KBASE
#undef ACT
#undef MASKT
#undef SEAM_K0
#undef HALF_STEP
}
#undef ROW
#undef VMW
#undef VMWN
#undef SLOAD_H
#undef SWRITE_HK
#undef SWRITE_HV
#undef SWRITE_H
#undef SLOAD_F
#undef SWRITE_KF
#undef SWRITE_VF
#undef KSWZ
#undef SBAR
}

constexpr int NWAVES = 8, NTHR = 512;
constexpr int DM = 2048, NB = 2, SEQ = 4096, MROWS = NB * SEQ, NLAYER = 2;
constexpr int IN_COLS = 6592, IN_PAD = 6656, DFF = 5632, UPC = 2 * DFF;
constexpr int C_RQ = 0, C_RK = 256, C_RV = 512, C_RG = 1024, C_RW = 1536, C_MQ = 3520, C_MK = 4544, C_MV = 5568;
constexpr int RWC = 1984;
constexpr float NORM_EPS = 1e-6f, GN_EPS = 64e-5f;
constexpr size_t MiB = 1u << 20;
constexpr size_t WS_CTL = 0, CTL_ZERO_BYTES = 1 * MiB;
constexpr size_t WS_MOD = 1 * MiB;
constexpr size_t WS_KMEAN = 1 * MiB + 512 * 1024;
constexpr size_t WS_W = 2 * MiB, W_LAYER = 100 * MiB, W_IN = 0, W_OUT = 26 * MiB, W_UP = 34 * MiB, W_DN = 78 * MiB;
constexpr size_t WS_X = 202 * MiB;
constexpr size_t WS_H = 266 * MiB;
constexpr size_t WS_PROJ = 298 * MiB;
constexpr size_t WS_ACT = WS_PROJ;
constexpr size_t WS_MIXED = 402 * MiB;
constexpr size_t WS_U = 434 * MiB;
constexpr size_t WS_HALO = WS_U;
constexpr size_t WS_RW = WS_U;
constexpr size_t WS_Y = WS_U + 128 * MiB;
constexpr size_t WS_RETO = WS_U + 144 * MiB;
constexpr size_t WS_REC = 610 * MiB;
constexpr size_t WS_RWW = 738 * MiB;
constexpr size_t WS_END = 739 * MiB;
constexpr size_t RWA = (size_t)MROWS * 512;
constexpr int CW_BAR = 4096, CW_SUB = 64;
constexpr int RING_BYTES = 131072, LDSCTL_OFF = RING_BYTES, MISC_OFF = LDSCTL_OFF + 320, LDS_BYTES = 147456;

#define GAS __attribute__((address_space(1)))
#define LAS __attribute__((address_space(3)))
typedef unsigned short bf16;
typedef unsigned v4u __attribute__((ext_vector_type(4)));
typedef unsigned v2u __attribute__((ext_vector_type(2)));
typedef float f32x4 __attribute__((ext_vector_type(4)));
typedef float f32x2 __attribute__((ext_vector_type(2)));
#define LDS_WAIT() asm volatile("s_waitcnt lgkmcnt(0)" ::: "memory")
__device__ __forceinline__ unsigned f2bf(float f) { unsigned u = __builtin_bit_cast(unsigned, f); return (u + 0x7fffu + ((u >> 16) & 1u)) >> 16; }
__device__ __forceinline__ unsigned pk2(float lo, float hi) { return f2bf(lo) | (f2bf(hi) << 16); }
__device__ __forceinline__ float bf2f(unsigned short h) { return __builtin_bit_cast(float, (unsigned)h << 16); }
__device__ __forceinline__ float bflo(unsigned w) { return __builtin_bit_cast(float, w << 16); }
__device__ __forceinline__ float bfhi(unsigned w) { return __builtin_bit_cast(float, w & 0xffff0000u); }
template <int CTRL> __device__ __forceinline__ float dpp_add(float v);
__device__ __forceinline__ float wave_sum(float v);
__device__ __forceinline__ float wave_max(float v) {
#pragma unroll
    for (int o = 1; o < 64; o <<= 1) v = fmaxf(v, __shfl_xor(v, o));
    return v;
}
template <int CTRL> __device__ __forceinline__ float dpp_add(float v) { return v + __builtin_bit_cast(float, __builtin_amdgcn_update_dpp(0, __builtin_bit_cast(int, v), CTRL, 0xF, 0xF, true)); }
__device__ __forceinline__ float xsum16(float v) { auto r = __builtin_amdgcn_permlane16_swap(__float_as_uint(v), __float_as_uint(v), false, false); return __uint_as_float(r[0]) + __uint_as_float(r[1]); }
__device__ __forceinline__ float xsum32(float v) { auto r = __builtin_amdgcn_permlane32_swap(__float_as_uint(v), __float_as_uint(v), false, false); return __uint_as_float(r[0]) + __uint_as_float(r[1]); }
__device__ __forceinline__ float wave_sum(float v) {
    v = dpp_add<0xB1>(v); v = dpp_add<0x4E>(v); v = dpp_add<0x141>(v); v = dpp_add<0x140>(v);
    return xsum32(xsum16(v));
}
__device__ __forceinline__ float sigmoidf_(float x) { return __builtin_amdgcn_rcpf(1.0f + __expf(-x)); }

#define XB_TMO      128
#define XB_XCNT(j)  (256  + 64 * (j))
#define XB_XSUB(j)  (1280 + 64 * (j))
#define XB_XGEN(j)  (2304 + 64 * (j))
#define XB_TOP      3328
#define XB_TOPGEN   3392
#define XCD_BAR_WORDS 3456
#define XB_SPIN_CAP (1u << 22)
__device__ __forceinline__ unsigned xb_ld(unsigned* p)              { return __hip_atomic_load(p, __ATOMIC_RELAXED, __HIP_MEMORY_SCOPE_AGENT); }
__device__ __forceinline__ unsigned xb_add(unsigned* p, unsigned v) { return __hip_atomic_fetch_add(p, v, __ATOMIC_RELAXED, __HIP_MEMORY_SCOPE_AGENT); }
__device__ __forceinline__ unsigned xb_xcc_id() { return (unsigned)__builtin_amdgcn_s_getreg((3 << 11) | 20) & 0xFu; }
#define XB_SPIN(cond, bar) do { unsigned _sp = 0; while (cond) { __builtin_amdgcn_s_sleep(1); \
    if ((++_sp & 255u) == 0u) { if (xb_ld(&(bar)[XB_TMO])) break; if (_sp > XB_SPIN_CAP) { atomicAdd(&(bar)[XB_TMO], 1u); break; } } } } while (0)
struct XcdBarrier { unsigned* bar; unsigned x; volatile LAS unsigned* st; };
__device__ __forceinline__ XcdBarrier xcd_barrier_post(unsigned* bar, volatile LAS unsigned* st, int tid) {
    XcdBarrier b; b.bar = bar; b.x = xb_xcc_id(); b.st = st;
    if (tid == 0) (void)xb_add(&bar[XB_XCNT(b.x)], 1u);
    return b;
}
__device__ __forceinline__ void xcd_barrier_complete(unsigned* bar, unsigned x, unsigned& nloc, unsigned& nx) {
    const unsigned G = gridDim.x * gridDim.y * gridDim.z;
    unsigned sum, cnt, mine, sp = 0u;
    for (;;) {
        sum = 0u; cnt = 0u; mine = 0u;
#pragma unroll
        for (unsigned j = 0; j < 16; ++j) { const unsigned c = xb_ld(&bar[XB_XCNT(j)]); sum += c; cnt += (c > 0u) ? 1u : 0u; mine = (j == x) ? c : mine; }
        if (sum == G) break;
        __builtin_amdgcn_s_sleep(1);
        if ((++sp & 255u) == 0u) { if (xb_ld(&bar[XB_TMO])) break; if (sp > XB_SPIN_CAP) { atomicAdd(&bar[XB_TMO], 1u); break; } }
    }
    nloc = mine > 0u ? mine : 1u; nx = cnt > 0u ? cnt : 1u;
}
__device__ __forceinline__ void xcd_barrier(const XcdBarrier& b, int tid) {
    asm volatile("s_waitcnt vmcnt(0)" ::: "memory");
    __syncthreads();
    if (tid == 0) {
        unsigned z_ = 0u; asm volatile("" : "+v"(z_)); z_ = (unsigned)__builtin_amdgcn_readfirstlane(z_);
        unsigned* bar = b.bar + z_; const unsigned bx_ = b.x + z_;
        __builtin_amdgcn_s_waitcnt(0);
        unsigned nloc = b.st[0], nx = b.st[1];
        if (nloc == 0u) { xcd_barrier_complete(bar, bx_, nloc, nx); b.st[0] = nloc; b.st[1] = nx; }
        const unsigned old = xb_add(&bar[XB_XSUB(bx_)], 1u);
        const unsigned gen = old / nloc;
        if (old + 1u == (gen + 1u) * nloc) {
            __builtin_amdgcn_fence(__ATOMIC_RELEASE, "agent");
            asm volatile("s_waitcnt vmcnt(0)" ::: "memory");
            const unsigned og = xb_add(&bar[XB_TOP], 1u);
            const unsigned tg = og / nx;
            if (og + 1u == (tg + 1u) * nx) xb_add(&bar[XB_TOPGEN], 1u);
            else XB_SPIN(xb_ld(&bar[XB_TOPGEN]) == tg, bar);
            __builtin_amdgcn_fence(__ATOMIC_ACQUIRE, "agent");
            xb_add(&bar[XB_XGEN(bx_)], 1u);
            asm volatile("s_waitcnt vmcnt(0)" ::: "memory");
        } else {
            XB_SPIN(xb_ld(&bar[XB_XGEN(bx_)]) == gen, bar);
            __builtin_amdgcn_fence(__ATOMIC_ACQUIRE, "agent");
            asm volatile("s_waitcnt vmcnt(0)" ::: "memory");
        }
    }
    __syncthreads();
}

struct Args { const float* in[24]; float* out; unsigned char* ws; };
struct Frame {
    LAS unsigned char* lds;
    int tid, lane, wave, vcu, G, zz;
    const float* const* in;
    unsigned char* ws;
};

#define FWS (F.ws + F.zz)
__device__ __forceinline__ void p0_transpose_item(const float* W, int K, int N, bf16* WT, LAS float* scr, int item, int lane, int half = 0) {
    const int nblk = N / 32, kb = item / nblk, nb = item % nblk, k0 = 64 * kb, n0 = 32 * nb;
    const int r0 = !half ? n0 : (n0 < half ? (n0 >> 7) * 256 + (n0 & 127) : ((n0 - half) >> 7) * 256 + 128 + ((n0 - half) & 127));
#pragma unroll 8
    for (int i = 0; i < 32; ++i) { const int kk = 2 * i + (lane >> 5); scr[kk * 33 + (lane & 31)] = W[(size_t)(k0 + kk) * N + n0 + (lane & 31)]; }
    LDS_WAIT(); asm volatile("" ::: "memory");
    const int c = lane & 7;
#pragma unroll
    for (int j = 0; j < 4; ++j) { const int n = (lane >> 3) + 8 * j; const LAS float* s = scr + (8 * c) * 33 + n;
        v4u o; o.x = pk2(s[0 * 33], s[1 * 33]); o.y = pk2(s[2 * 33], s[3 * 33]); o.z = pk2(s[4 * 33], s[5 * 33]); o.w = pk2(s[6 * 33], s[7 * 33]);
        *(v4u*)(WT + (size_t)(r0 + n) * K + k0 + 8 * c) = o; }
    LDS_WAIT(); asm volatile("" ::: "memory");
}
constexpr int CV_IN = (DM / 64) * (IN_COLS / 32), CV_OUT = (DM / 64) * (DM / 32), CV_UP = (DM / 64) * (UPC / 32), CV_DN = (DFF / 64) * (DM / 32), CV_LAYER = CV_IN + CV_OUT + CV_UP + CV_DN;
constexpr int CV_N1 = 10, CV_N2 = 6, CV_N3 = 4, CV_C1 = 192 * NWAVES * CV_N1, CV_C2 = 128 * NWAVES * CV_N2;
static_assert(CV_IN + CV_C1 <= CV_LAYER && CV_LAYER - (CV_IN + CV_C1) + (CV_IN - CV_C2) <= 128 * NWAVES * CV_N3 && CV_C2 <= CV_IN, "gap capacities");
__device__ __forceinline__ void convert_item(Frame& F, int it, LAS float* scr) {
    const int l = it / CV_LAYER; int r = it % CV_LAYER;
    unsigned char* wl = FWS + WS_W + (size_t)l * W_LAYER;
    if (r < CV_IN) { p0_transpose_item(F.in[F.zz + 2] + (size_t)l * DM * IN_COLS, DM, IN_COLS, (bf16*)(wl + W_IN), scr, r, F.lane); return; } r -= CV_IN;
    if (r < CV_OUT) { p0_transpose_item(F.in[F.zz + 3] + (size_t)l * DM * DM, DM, DM, (bf16*)(wl + W_OUT), scr, r, F.lane); return; } r -= CV_OUT;
    if (r < CV_UP) { p0_transpose_item(F.in[F.zz + 15] + (size_t)l * DM * UPC, DM, UPC, (bf16*)(wl + W_UP), scr, r, F.lane, DFF); return; } r -= CV_UP;
    p0_transpose_item(F.in[F.zz + 18] + (size_t)l * DFF * DM, DFF, DM, (bf16*)(wl + W_DN), scr, r, F.lane);
}
__device__ __forceinline__ void convert_gap(Frame& F, int layer, int first, int count, int gwi, int nwv, int nper) {
    LAS float* scr = (LAS float*)(F.lds + F.wave * 16384);
    for (int j = 0; j < nper; ++j) { const int r = gwi + nwv * j; if (r < count) convert_item(F, layer * CV_LAYER + first + r, scr); }
}
__device__ __forceinline__ void adaln_item(Frame& F, int l, int grp) {
    LAS float* cact = (LAS float*)F.lds;
    LAS float* red = (LAS float*)(F.lds + 16384);
    const float* c = F.in[F.zz + 1];
    for (int i = F.tid; i < 4096; i += NTHR) { const float cv = c[i]; cact[i] = cv / (1.0f + __expf(-cv)); }
    __syncthreads();
    const int n0 = grp * 128;
    const float* W = F.in[F.zz + 19] + (size_t)l * 2048 * 12288 + n0;
    const int half = F.lane >> 5, q = F.lane & 31;
    f32x4 a0 = {0.f, 0.f, 0.f, 0.f}, a1 = {0.f, 0.f, 0.f, 0.f};
#pragma unroll 16
    for (int i = 0; i < 128; ++i) { const int k = F.wave * 256 + 2 * i + half; const f32x4 w = *(const f32x4*)(W + (size_t)k * 12288 + 4 * q);
        a0 += w * cact[k]; a1 += w * cact[2048 + k]; }
#pragma unroll
    for (int e = 0; e < 4; ++e) { a0[e] = xsum32(a0[e]); a1[e] = xsum32(a1[e]); }
    if (half == 0) {
#pragma unroll
        for (int e = 0; e < 4; ++e) { red[(F.wave * 2 + 0) * 128 + 4 * q + e] = a0[e]; red[(F.wave * 2 + 1) * 128 + 4 * q + e] = a1[e]; } }
    __syncthreads();
    if (F.tid < 256) { const int bb = F.tid >> 7, col = F.tid & 127; float s = 0.f;
#pragma unroll
        for (int w = 0; w < 8; ++w) s += red[(w * 2 + bb) * 128 + col];
        s += F.in[F.zz + 20][l * 12288 + n0 + col];
        ((float*)(FWS + WS_MOD))[(size_t)(l * 2 + bb) * 12288 + n0 + col] = s; }
    __syncthreads();
}
__device__ __forceinline__ void p0_prologue(Frame& F) {
    const int ngv = (F.G == 256) ? 96 : 192;
    if (F.vcu < ngv) adaln_item(F, F.vcu / 96, F.vcu % 96);
    LAS float* scr = (LAS float*)(F.lds + F.wave * 16384);
    const int gw = F.vcu * NWAVES + F.wave, NGW = F.G * NWAVES;
    if (F.G == 256) { if (F.vcu >= 96) for (int p = gw - 96 * NWAVES; p < CV_IN; p += 160 * NWAVES) convert_item(F, p, scr); }
    else for (int p = gw; p < NLAYER * CV_LAYER; p += NGW) convert_item(F, p, scr);
    for (int l = 0; l < NLAYER; ++l) { bf16* wt = (bf16*)(FWS + WS_RWW + (size_t)l * 448 * 512 * 2);
        const float* wu = F.in[F.zz + 6] + (size_t)l * 96 * 512; const float* au = F.in[F.zz + 8] + (size_t)l * 96 * 512; const float* gu = F.in[F.zz + 9] + (size_t)l * 256 * 512;
        for (int i = F.vcu * NTHR + F.tid; i < 448 * 512; i += F.G * NTHR) {
            if (i < 96 * 512) { const int n = i / 96, kq = i - n * 96; wt[i] = (bf16)f2bf(wu[kq * 512 + n]); }
            else if (i < 2 * 96 * 512) { const int j = i - 96 * 512, n = j / 96, kq = j - n * 96; wt[i] = (bf16)f2bf(au[kq * 512 + n]); }
            else { const int j = i - 2 * 96 * 512, n = j >> 8, kq = j & 255; wt[i] = (bf16)f2bf(gu[kq * 512 + n]); } } }
    for (int l = 0; l < NLAYER; ++l) { v4u* z = (v4u*)(FWS + WS_W + (size_t)l * W_LAYER + W_IN + (size_t)IN_COLS * DM * 2);
        for (int i = F.vcu * NTHR + F.tid; i < (IN_PAD - IN_COLS) * DM * 2 / 16; i += F.G * NTHR) z[i] = (v4u){0u, 0u, 0u, 0u}; }
}

template <int MODE, bool IN_F32>
__device__ __forceinline__ void norm_phase(Frame& F, const void* xin, void* outp, const float* g, const float* sh, const float* sc) {
    LAS float* gs = (LAS float*)F.lds;
    LAS float* shs = (LAS float*)(F.lds + 16384);
    for (int i = F.tid; i < 4096; i += NTHR) { const int b = i >> 11, col = i & 2047;
        if (MODE == 0) { gs[i] = g[col] * (1.0f + sc[(size_t)b * 12288 + col]); shs[i] = sh[(size_t)b * 12288 + col]; }
        else { gs[i] = g[col]; shs[i] = 0.f; } }
    __syncthreads();
    const int gw = F.vcu * NWAVES + F.wave, NGW = F.G * NWAVES;
    for (int m = gw; m < MROWS; m += NGW) {
        const int b = m >> 12;
        f32x4 v[8]; float s = 0.f;
#pragma unroll
        for (int j = 0; j < 8; ++j) {
            if (IN_F32) v[j] = *((const f32x4*)((const float*)xin + (size_t)m * DM) + F.lane + 64 * j);
            else { const v2u w = *((const v2u*)((const bf16*)xin + (size_t)m * DM) + F.lane + 64 * j); v[j] = (f32x4){bflo(w.x), bfhi(w.x), bflo(w.y), bfhi(w.y)}; }
            s += (v[j].x * v[j].x + v[j].y * v[j].y) + (v[j].z * v[j].z + v[j].w * v[j].w); }
        float rstd = __builtin_amdgcn_rsqf(wave_sum(s) * (1.0f / DM) + NORM_EPS);
#if MOBA_CHECK
        if (MODE == 1) { const float sd = ((const float*)(FWS + WS_CTL))[8], sn = ((const float*)(FWS + WS_CTL))[9]; rstd *= 1.0f + 10.0f * sqrtf(sd / sn); }
#endif
#pragma unroll
        for (int j = 0; j < 8; ++j) { const int col = 4 * (F.lane + 64 * j);
            const f32x4 gg = *(const LAS f32x4*)(gs + b * 2048 + col), ss = *(const LAS f32x4*)(shs + b * 2048 + col);
            const f32x4 o = v[j] * rstd * gg + ss;
            if (MODE == 0) { v2u w; w.x = pk2(o.x, o.y); w.y = pk2(o.z, o.w); *(v2u*)((bf16*)outp + (size_t)m * DM + col) = w; }
            else *(f32x4*)((float*)outp + (size_t)m * DM + col) = o; }
    }
    __syncthreads();
}

__device__ __forceinline__ float lerp_bf(const bf16* P, size_t row, int col, bool hasprev, float mu) {
    const float cur = bf2f(P[row * IN_PAD + col]); const float prev = hasprev ? bf2f(P[(row - 1) * IN_PAD + col]) : 0.f;
    return cur + (prev - cur) * mu;
}
__device__ __forceinline__ void rwkv_prep(Frame& F, int l) {
    LAS float* codes = (LAS float*)F.lds;
    const bf16* P = (const bf16*)(FWS + WS_PROJ);
    const float* mu = F.in[F.zz + 4] + l * RWC; const float* w0 = F.in[F.zz + 5] + l * 512; const float* w_up = F.in[F.zz + 6] + (size_t)l * 96 * 512;
    const float* a0 = F.in[F.zz + 7] + l * 512; const float* a_up = F.in[F.zz + 8] + (size_t)l * 96 * 512; const float* g_up = F.in[F.zz + 9] + (size_t)l * 256 * 512;
    const float* k_k = F.in[F.zz + 10] + l * 512; const float* k_a = F.in[F.zz + 11] + l * 512; const float* r_k = F.in[F.zz + 12] + l * 512;
    float* RW = (float*)(FWS + WS_RW);
    const int c = F.tid;
    const float mur = mu[c], muk = mu[512 + c], muv = mu[1024 + c], w0c = w0[c], a0c = a0[c], kkc = k_k[c], kac = k_a[c], rkc = r_k[c];
    for (int item = F.vcu; item < MROWS / 8; item += F.G) {
        const int row0 = item * 8, t0 = row0 & (SEQ - 1);
        for (int idx = F.tid; idx < 8 * 448; idx += NTHR) { const int tk = idx / 448, cc = idx - tk * 448;
            float val = lerp_bf(P, (size_t)(row0 + tk), C_RW + 1536 + cc, (t0 + tk) > 0, mu[1536 + cc]);
            if (cc < 96) val = tanhf(val); else if (cc >= 192) val = sigmoidf_(val);
            codes[idx] = val; }
        __syncthreads();
        float wd[8], wa[8], gg[8];
#pragma unroll
        for (int tk = 0; tk < 8; ++tk) { wd[tk] = 0.f; wa[tk] = 0.f; gg[tk] = 0.f; }
        for (int r = 0; r < 96; ++r) { const float wu = w_up[r * 512 + c], au = a_up[r * 512 + c];
#pragma unroll
            for (int tk = 0; tk < 8; ++tk) { wd[tk] += codes[tk * 448 + r] * wu; wa[tk] += codes[tk * 448 + 96 + r] * au; } }
        for (int r = 0; r < 256; ++r) { const float gu = g_up[r * 512 + c];
#pragma unroll
            for (int tk = 0; tk < 8; ++tk) gg[tk] += codes[tk * 448 + 192 + r] * gu; }
#pragma unroll
        for (int tk = 0; tk < 8; ++tk) {
            const size_t row = (size_t)(row0 + tk); const bool hp = (t0 + tk) > 0;
            const float rr = lerp_bf(P, row, C_RW + c, hp, mur), kk0 = lerp_bf(P, row, C_RW + 512 + c, hp, muk), vv = lerp_bf(P, row, C_RW + 1024 + c, hp, muv);
            const float z = -(w0c + wd[tk]);
            const float sp = fmaxf(z, 0.f) + log1pf(__expf(-fabsf(z)));
            const float decay = __expf(-__expf(-sp - 0.5f));
            const float a = sigmoidf_(a0c + wa[tk]);
            const float kkv = kk0 * kkc;
            const float nrm = sqrtf(wave_sum(kkv * kkv));
            const float kap = kkv / fmaxf(nrm, 1e-12f);
            const float kp = kk0 * (1.0f + (a - 1.0f) * kac);
            const float bsum = wave_sum(rr * kp * rkc);
            const size_t o = row * 512 + c;
            RW[0 * RWA + o] = rr; RW[1 * RWA + o] = decay; RW[2 * RWA + o] = kp; RW[3 * RWA + o] = vv;
            RW[4 * RWA + o] = kap; RW[5 * RWA + o] = kap * a; RW[6 * RWA + o] = gg[tk]; RW[7 * RWA + o] = bsum * vv;
        }
        __syncthreads();
    }
}
__device__ __forceinline__ void moba_kmean(Frame& F) {
    LAS float* red = (LAS float*)(F.lds + 32768);
    const bf16* P = (const bf16*)(FWS + WS_PROJ);
    float* KM = (float*)(FWS + WS_KMEAN);
    for (int item = F.vcu; item < 256; item += F.G) {
        const int b = item >> 7, h = (item >> 4) & 7, n = item & 15;
        const int d = F.tid & 127, part = F.tid >> 7;
        const bf16* kp = P + (size_t)(b * SEQ + n * 256 + part * 64) * IN_PAD + C_MK + h * 128 + d;
        float s = 0.f;
        for (int k = 0; k < 64; ++k) s += bf2f(kp[(size_t)k * IN_PAD]);
        red[part * 128 + d] = s;
        __syncthreads();
        if (F.tid < 128) KM[(size_t)item * 128 + d] = (red[d] + red[128 + d] + red[256 + d] + red[384 + d]) * (1.0f / 256.0f);
        __syncthreads();
    }
}
struct RwIn { f32x4 w[2], kk[2], bb[2], k[2], r[2]; float v; };
__device__ __forceinline__ void rw_load(RwIn& x, const float* RW, size_t row, int cj, int ci) {
    const size_t o = row * 512;
    x.w[0] = *(const f32x4*)(RW + 1 * RWA + o + cj); x.w[1] = *(const f32x4*)(RW + 1 * RWA + o + cj + 4);
    x.kk[0] = *(const f32x4*)(RW + 4 * RWA + o + cj); x.kk[1] = *(const f32x4*)(RW + 4 * RWA + o + cj + 4);
    x.bb[0] = *(const f32x4*)(RW + 5 * RWA + o + cj); x.bb[1] = *(const f32x4*)(RW + 5 * RWA + o + cj + 4);
    x.k[0] = *(const f32x4*)(RW + 2 * RWA + o + cj); x.k[1] = *(const f32x4*)(RW + 2 * RWA + o + cj + 4);
    x.r[0] = *(const f32x4*)(RW + 0 * RWA + o + cj); x.r[1] = *(const f32x4*)(RW + 0 * RWA + o + cj + 4);
    x.v = RW[3 * RWA + o + ci];
}
__device__ __forceinline__ void rwkv_scan_naive(Frame& F, int b, int h) {
    const float* RW = (const float*)(FWS + WS_RW);
    float* Y = (float*)(FWS + WS_Y);
    const int i = F.tid >> 3, jp = F.tid & 7, cj = h * 64 + 8 * jp, ci = h * 64 + i;
    f32x4 s0 = {0.f, 0.f, 0.f, 0.f}, s1 = {0.f, 0.f, 0.f, 0.f};
    RwIn cur, n1, n2;
    const size_t rb = (size_t)b * SEQ;
    rw_load(cur, RW, rb, cj, ci); rw_load(n1, RW, rb + 1, cj, ci);
    for (int t = 0; t < SEQ; ++t) {
        rw_load(n2, RW, rb + (t + 2 < SEQ ? t + 2 : SEQ - 1), cj, ci);
        f32x4 pp = s0 * cur.kk[0] + s1 * cur.kk[1];
        float p = (pp.x + pp.y) + (pp.z + pp.w);
        p += __shfl_xor(p, 1); p += __shfl_xor(p, 2); p += __shfl_xor(p, 4);
        const float sa = -p;
        s0 = s0 * cur.w[0] + sa * cur.bb[0] + cur.v * cur.k[0];
        s1 = s1 * cur.w[1] + sa * cur.bb[1] + cur.v * cur.k[1];
        f32x4 yy = s0 * cur.r[0] + s1 * cur.r[1];
        float y = (yy.x + yy.y) + (yy.z + yy.w);
        y += __shfl_xor(y, 1); y += __shfl_xor(y, 2); y += __shfl_xor(y, 4);
        if (jp == 0) Y[(rb + t) * 512 + ci] = y;
        cur = n1; n1 = n2;
    }
}
struct RtIn { v4u q[2], k[2]; unsigned short v; };
__device__ __forceinline__ void rt_load(RtIn& x, const bf16* P, size_t row, int h, int d0, int v) {
    const bf16* p = P + row * IN_PAD;
    x.q[0] = *(const v4u*)(p + C_RQ + h * 64 + d0); x.q[1] = *(const v4u*)(p + C_RQ + h * 64 + d0 + 8);
    x.k[0] = *(const v4u*)(p + C_RK + h * 64 + d0); x.k[1] = *(const v4u*)(p + C_RK + h * 64 + d0 + 8);
    x.v = p[C_RV + h * 128 + v];
}
__device__ __forceinline__ void ret_scan_naive(Frame& F, int b, int h) {
    const bf16* P = (const bf16*)(FWS + WS_PROJ);
    float* RO = (float*)(FWS + WS_RETO);
    const int v = F.tid >> 2, dp = F.tid & 3, d0 = dp * 16;
    const float gamma = 1.0f - exp2f(-5.0f - (float)h);
    float S[16];
#pragma unroll
    for (int d = 0; d < 16; ++d) S[d] = 0.f;
    RtIn cur, n1, n2;
    const size_t rb = (size_t)b * SEQ;
    rt_load(cur, P, rb, h, d0, v); rt_load(n1, P, rb + 1, h, d0, v);
    for (int t = 0; t < SEQ; ++t) {
        rt_load(n2, P, rb + (t + 2 < SEQ ? t + 2 : SEQ - 1), h, d0, v);
        const float vv = bf2f(cur.v) * 0.125f;
        float o = 0.f;
#pragma unroll
        for (int e = 0; e < 8; ++e) { const unsigned qw = cur.q[e >> 2][e & 3], kw = cur.k[e >> 2][e & 3];
            S[2 * e] = gamma * S[2 * e] + bflo(kw) * vv; S[2 * e + 1] = gamma * S[2 * e + 1] + bfhi(kw) * vv;
            o += bflo(qw) * S[2 * e] + bfhi(qw) * S[2 * e + 1]; }
        o += __shfl_xor(o, 1); o += __shfl_xor(o, 2);
        if (dp == 0) RO[(rb + t) * 512 + h * 128 + v] = o;
        cur = n1; n1 = n2;
    }
}
__device__ __forceinline__ void moba_naive(Frame& F, int mw, int nmw) {
    const bf16* P = (const bf16*)(FWS + WS_PROJ);
    const float* KM = (const float*)(FWS + WS_KMEAN);
    bf16* MX = (bf16*)(FWS + WS_U + 160 * MiB);
    LAS float* qs = (LAS float*)(F.lds + F.wave * 4608);
    LAS float* ps = qs + 128;
    const int lane = F.lane;
    for (int qi = mw; qi < MROWS * 8; qi += nmw) {
        const int h = qi & 7, row = qi >> 3, b = row >> 12, t = row & (SEQ - 1), bq = t >> 8;
        { const unsigned qw = *(const unsigned*)(P + (size_t)row * IN_PAD + C_MQ + h * 128 + 2 * lane);
          qs[2 * lane] = bflo(qw) * 0.08838834764831845f; qs[2 * lane + 1] = bfhi(qw) * 0.08838834764831845f; }
        LDS_WAIT();
        float gate = -INFINITY;
        if (lane < 16 && lane < bq) { const float* km = KM + ((size_t)(b * 8 + h) * 16 + lane) * 128; float a = 0.f;
            for (int d = 0; d < 128; ++d) a += qs[d] * km[d];
            gate = a; }
        unsigned selmask = 0u;
#pragma unroll
        for (int rnd = 0; rnd < 3; ++rnd) { const float m = wave_max(gate);
            if (m > -INFINITY) { const unsigned long long bal = __ballot(gate == m); const int idx = __ffsll((long long)bal) - 1; selmask |= 1u << idx; if (lane == idx) gate = -INFINITY; } }
        int blk[4];
#pragma unroll
        for (int s = 0; s < 3; ++s) { if (selmask) { blk[s] = __ffs((int)selmask) - 1; selmask &= selmask - 1u; } else blk[s] = -1; }
        blk[3] = bq;
        const float slope = exp2f(-(float)(h + 1));
        float sc[4][4]; float mx = -1e30f;
#pragma unroll
        for (int s = 0; s < 4; ++s) {
#pragma unroll
            for (int kq = 0; kq < 4; ++kq) {
                float val = -1e30f;
                if (blk[s] >= 0) { const int pos = blk[s] * 256 + kq * 64 + lane;
                    const bf16* kp = P + (size_t)(b * SEQ + pos) * IN_PAD + C_MK + h * 128; float a = 0.f;
#pragma unroll 4
                    for (int d8 = 0; d8 < 16; ++d8) { const v4u kw = *(const v4u*)(kp + d8 * 8); const f32x4 qa = *(const LAS f32x4*)(qs + d8 * 8), qb = *(const LAS f32x4*)(qs + d8 * 8 + 4);
                        a += bflo(kw.x) * qa.x + bfhi(kw.x) * qa.y + bflo(kw.y) * qa.z + bfhi(kw.y) * qa.w + bflo(kw.z) * qb.x + bfhi(kw.z) * qb.y + bflo(kw.w) * qb.z + bfhi(kw.w) * qb.w; }
                    if (pos <= t) val = a - slope * (float)(t - pos); }
                sc[s][kq] = val; mx = fmaxf(mx, val); } }
        mx = wave_max(mx);
        float lsum = 0.f;
#pragma unroll
        for (int s = 0; s < 4; ++s)
#pragma unroll
            for (int kq = 0; kq < 4; ++kq) { const float p = __expf(sc[s][kq] - mx); lsum += p; ps[s * 256 + kq * 64 + lane] = p; }
        lsum = wave_sum(lsum);
        LDS_WAIT();
        float o0 = 0.f, o1 = 0.f;
#pragma unroll
        for (int s = 0; s < 4; ++s) if (blk[s] >= 0) { const int nk = (s == 3) ? (t - bq * 256 + 1) : 256;
            const bf16* vp = P + (size_t)(b * SEQ + blk[s] * 256) * IN_PAD + C_MV + h * 128 + 2 * lane;
#pragma unroll 4
            for (int key = 0; key < nk; ++key) { const float p = ps[s * 256 + key]; const unsigned vw = *(const unsigned*)(vp + (size_t)key * IN_PAD); o0 += p * bflo(vw); o1 += p * bfhi(vw); } }
        const float inv = 1.0f / lsum;
        *(unsigned*)(MX + (size_t)row * 1024 + h * 128 + 2 * lane) = pk2(o0 * inv, o1 * inv);
        LDS_WAIT();
    }
}

constexpr int MOBA_LDS_KM = moba::LDS_BYTES, MOBA_LDS_SEL = MOBA_LDS_KM + 8192;
__device__ __forceinline__ void moba_item(Frame& F, int bh, int qbA, int qbB) {
    const int b = bh >> 3, h = bh & 7;
    const bf16* P = (const bf16*)(FWS + WS_PROJ);
    LAS float* km = (LAS float*)(F.lds + MOBA_LDS_KM);
    LAS unsigned* sel = (LAS unsigned*)(F.lds + MOBA_LDS_SEL);
    const float* KM = (const float*)(FWS + WS_KMEAN) + (size_t)bh * 16 * 128;
    for (int i = F.tid; i < 2048; i += NTHR) km[i] = KM[i];
    __syncthreads();
    {   const int qb = (F.tid < 256) ? qbA : qbB, r = F.tid & 255;
        const bf16* qp = P + (size_t)(b * SEQ + qb * 256 + r) * IN_PAD + C_MQ + h * 128;
        float g[16];
#pragma unroll
        for (int n = 0; n < 16; ++n) g[n] = 0.f;
        for (int d8 = 0; d8 < 16; ++d8) { const v4u qw = *(const v4u*)(qp + d8 * 8);
            const float q0 = bflo(qw.x), q1 = bfhi(qw.x), q2 = bflo(qw.y), q3 = bfhi(qw.y), q4 = bflo(qw.z), q5 = bfhi(qw.z), q6 = bflo(qw.w), q7 = bfhi(qw.w);
#pragma unroll
            for (int n = 0; n < 16; ++n) { const f32x4 ka = *(const LAS f32x4*)(km + n * 128 + d8 * 8), kb = *(const LAS f32x4*)(km + n * 128 + d8 * 8 + 4);
                g[n] += (q0 * ka.x + q1 * ka.y) + (q2 * ka.z + q3 * ka.w) + (q4 * kb.x + q5 * kb.y) + (q6 * kb.z + q7 * kb.w); } }
        unsigned m = 0u;
#pragma unroll
        for (int rnd = 0; rnd < 3; ++rnd) { float best = -INFINITY; int bi = -1;
#pragma unroll
            for (int n = 0; n < 16; ++n) if (n < qb && !((m >> n) & 1u) && g[n] > best) { best = g[n]; bi = n; }
            if (bi >= 0) m |= 1u << bi; }
        sel[F.tid] = m; }
    __syncthreads();
    typedef moba::BlockRef<moba::bf16, moba::bf16> Ref;
    const float slopeR = exp2f(-(float)(h + 1)) * 11.313708498984761f;
    bf16* MX = (bf16*)(FWS + WS_MIXED);
    Ref A, B2;
    A.Q = P + (size_t)(b * SEQ + qbA * 256) * IN_PAD + C_MQ + h * 128; A.K = P + (size_t)(b * SEQ) * IN_PAD + C_MK + h * 128; A.V = P + (size_t)(b * SEQ) * IN_PAD + C_MV + h * 128;
    A.O = MX + (size_t)(b * SEQ + qbA * 256) * DM + 1024 + h * 128; A.P0 = qbA * 256; A.sel = sel; A.slopeR = slopeR;
    B2 = A; B2.Q = P + (size_t)(b * SEQ + qbB * 256) * IN_PAD + C_MQ + h * 128; B2.O = MX + (size_t)(b * SEQ + qbB * 256) * DM + 1024 + h * 128; B2.P0 = qbB * 256; B2.sel = sel + 256;
    moba::Seam<moba::bf16> S;
    moba::lchar* ldsg = (moba::lchar*)F.lds;
    moba::causal_swa_prime<moba::bf16, moba::bf16>(A, 1 << 30, ldsg, S, F.wave);
    Ref cur = A;
    for (int pass = 0; pass < MOBA_NP; ++pass) {
        const bool nb_ = ((pass + 1) & 1) != 0;
        Ref nxt = A; if (nb_ || pass + 1 >= MOBA_NP) nxt = B2;
        moba::causal_swa_block<moba::bf16, moba::bf16>(cur, nxt, SEQ, 1 << 30, ldsg, S, F.wave);
        cur = nxt;
    }
}
constexpr int RC_UNITS = 32, RC_NCH = SEQ / 16, RC_REC = 16384;
constexpr int RC_AR = 0, RC_BK = 4096, RC_VP = 8192, RC_U0 = 10240, RC_Y0 = 12288, RC_D = 14336;
typedef short bf16x8 __attribute__((ext_vector_type(8)));
typedef float f32x16 __attribute__((ext_vector_type(16)));
typedef float f32x2t __attribute__((ext_vector_type(2))); typedef __bf16 bf16x2t __attribute__((ext_vector_type(2)));
__device__ __forceinline__ unsigned cvtpk_c(float lo, float hi) { f32x2t v = {lo, hi}; bf16x2t b = __builtin_convertvector(v, bf16x2t); return __builtin_bit_cast(unsigned, b); }
__device__ __forceinline__ unsigned short cvt1_c(float x) { return (unsigned short)(cvtpk_c(x, 0.f) & 0xffffu); }

constexpr int RC_WLDS = 14464, RC_CODES_OFF = 8 * RC_WLDS  , RC_CSTRIDE = 456;
__device__ __forceinline__ void rc_core(Frame& F, LAS unsigned char* wlds, const float (&At)[16], const float (&Bt)[16], const float (&Kt)[16], const float (&Rt)[16], const float (&vv)[16], const float D, unsigned char* rec) {
    { unsigned wb_ = (unsigned)(uintptr_t)wlds; asm volatile("" : "+v"(wb_)); wlds = (LAS unsigned char*)(uintptr_t)wb_; }
    LAS bf16* XA = (LAS bf16*)wlds; LAS bf16* XB = (LAS bf16*)(wlds + 4608); LAS float* TT = (LAS float*)(wlds + 9216 + 4224);
    int x_ = F.lane; asm volatile("" : "+v"(x_));
    const int x = x_, r32 = x & 31, h2 = x >> 5, tl = x & 15;
#pragma unroll
    for (int t = 0; t < 16; ++t) { XA[t * 72 + x] = cvt1_c(Bt[t]); XA[(16 + t) * 72 + x] = cvt1_c(Kt[t]); XB[t * 72 + x] = cvt1_c(At[t]); XB[(16 + t) * 72 + x] = cvt1_c(Rt[t]); }
#pragma unroll
    for (int q = 0; q < 4; ++q) { v4u w; w.x = cvtpk_c(Bt[4 * q] * D, Bt[4 * q + 1] * D); w.y = cvtpk_c(Bt[4 * q + 2] * D, Bt[4 * q + 3] * D);
        w.z = cvtpk_c(Kt[4 * q] * D, Kt[4 * q + 1] * D); w.w = cvtpk_c(Kt[4 * q + 2] * D, Kt[4 * q + 3] * D); *(v4u*)(rec + RC_BK + x * 64 + q * 16) = w; }
#pragma unroll
    for (int q = 0; q < 2; ++q) { v4u w;
        w.x = cvtpk_c(vv[8 * q], vv[8 * q + 1]); w.y = cvtpk_c(vv[8 * q + 2], vv[8 * q + 3]); w.z = cvtpk_c(vv[8 * q + 4], vv[8 * q + 5]); w.w = cvtpk_c(vv[8 * q + 6], vv[8 * q + 7]); *(v4u*)(rec + RC_VP + x * 32 + q * 16) = w;
    }
    *(float*)(rec + RC_D + x * 4) = D;
    f32x16 G;
#pragma unroll
    for (int r = 0; r < 16; ++r) G[r] = 0.f;
#pragma unroll
    for (int ks = 0; ks < 4; ++ks) { const bf16x8 a = *(const LAS bf16x8*)(XA + r32 * 72 + ks * 16 + h2 * 8), bq = *(const LAS bf16x8*)(XB + r32 * 72 + ks * 16 + h2 * 8);
        G = __builtin_amdgcn_mfma_f32_32x32x16_bf16(a, bq, G, 0, 0, 0); }
    LAS float* GA = (LAS float*)wlds; LAS float* GT = (LAS float*)(wlds + 4608);
#pragma unroll
    for (int r = 0; r < 16; ++r) GA[((r & 3) + 8 * (r >> 2) + 4 * h2) * 36 + r32] = G[r];
#pragma unroll
    for (int g4 = 0; g4 < 4; ++g4) *(LAS f32x4*)(GT + r32 * 36 + 8 * g4 + 4 * h2) = (f32x4){G[4 * g4], G[4 * g4 + 1], G[4 * g4 + 2], G[4 * g4 + 3]};
#define RC_LD16(dst, p, n4) do { _Pragma("unroll") for (int i4_ = 0; i4_ < (n4); ++i4_) { const f32x4 v4_ = *(const LAS f32x4*)((p) + 4 * i4_); dst[4 * i4_] = v4_.x; dst[4 * i4_ + 1] = v4_.y; dst[4 * i4_ + 2] = v4_.z; dst[4 * i4_ + 3] = v4_.w; } } while (0)
    float Tc[16];
#pragma unroll
    for (int m = 0; m < 16; ++m) Tc[m] = (m == tl) ? 1.0f : 0.0f;
#pragma unroll
    for (int s = 14; s >= 0; --s) { float nr[16]; float acc = 0.f;
#pragma unroll
        for (int i4 = (s + 1) / 4; i4 < 4; ++i4) { const f32x4 v4 = *(const LAS f32x4*)(GA + s * 36 + 4 * i4); nr[4 * i4] = v4.x; nr[4 * i4 + 1] = v4.y; nr[4 * i4 + 2] = v4.z; nr[4 * i4 + 3] = v4.w; }
#pragma unroll
        for (int m = s + 1; m < 16; ++m) acc += nr[m] * Tc[m];
        Tc[s] = (s < tl) ? acc : Tc[s]; }
    if (x < 16) {
#pragma unroll
        for (int g4 = 0; g4 < 4; ++g4) *(LAS f32x4*)(TT + tl * 16 + 4 * g4) = (f32x4){Tc[4 * g4], Tc[4 * g4 + 1], Tc[4 * g4 + 2], Tc[4 * g4 + 3]}; }
    float PV[16];
    PV[0] = 0.f;
#pragma unroll
    for (int s = 1; s < 16; ++s) { float acc = 0.f;
#pragma unroll
        for (int r = 0; r < s; ++r) acc += GT[s * 36 + 16 + r] * vv[r];
        PV[s] = acc; }
    float Ah[16], U0[16];
#pragma unroll
    for (int t = 0; t < 16; ++t) { float a = 0.f, uu = 0.f;
#pragma unroll
        for (int s = 0; s <= t; ++s) { const float tv = TT[t * 16 + s]; a += tv * At[s]; uu += tv * PV[s]; }
        Ah[t] = a; U0[t] = uu; }
    float Rh[16], Y0[16];
#pragma unroll
    for (int t = 0; t < 16; ++t) { float a = Rt[t], yy = 0.f;
#pragma unroll
        for (int s = 0; s <= t; ++s) { const float m1 = GT[(16 + t) * 36 + s], m2 = GT[(16 + t) * 36 + 16 + s]; a += m1 * Ah[s]; yy += m1 * U0[s] + m2 * vv[s]; }
        Rh[t] = a; Y0[t] = yy; }
#undef RC_LD16
    { const int ks = x >> 5, jj = x & 31, e = (jj >> 4) * 4 + (jj & 3), q = (jj >> 2) & 3; unsigned char* pb = rec + RC_AR + ks * 1024 + q * 256 + e * 2;
#pragma unroll
      for (int s = 0; s < 16; ++s) { *(bf16*)(pb + s * 16) = cvt1_c(Ah[s]); *(bf16*)(pb + 2048 + s * 16) = cvt1_c(Rh[s]); } }
#pragma unroll
    for (int q = 0; q < 2; ++q) { v4u w;
        w.x = cvtpk_c(U0[8 * q], U0[8 * q + 1]); w.y = cvtpk_c(U0[8 * q + 2], U0[8 * q + 3]); w.z = cvtpk_c(U0[8 * q + 4], U0[8 * q + 5]); w.w = cvtpk_c(U0[8 * q + 6], U0[8 * q + 7]); *(v4u*)(rec + RC_U0 + x * 32 + q * 16) = w;
        w.x = cvtpk_c(Y0[8 * q], Y0[8 * q + 1]); w.y = cvtpk_c(Y0[8 * q + 2], Y0[8 * q + 3]); w.z = cvtpk_c(Y0[8 * q + 4], Y0[8 * q + 5]); w.w = cvtpk_c(Y0[8 * q + 6], Y0[8 * q + 7]); *(v4u*)(rec + RC_Y0 + x * 32 + q * 16) = w; }
    LDS_WAIT();
}
__device__ __forceinline__ void rc_pass1_rwkv(Frame& F, int wid, int nw, int c0, int nc) {
    LAS unsigned char* wlds = F.lds + F.wave * RC_WLDS;
    const int x = F.lane;
    const float* RW = (const float*)(FWS + WS_RW);
    const bf16* RH = (const bf16*)(FWS + WS_RW + 32 * MiB);
    for (int it2 = wid; it2 < 16 * nc; it2 += nw) {
        const int u = it2 / nc, c = c0 + it2 % nc, it = u * RC_NCH + c, b = u >> 3, h = u & 7; const size_t o0 = ((size_t)(b * SEQ + c * 16)) * 512 + h * 64 + x;
        float At[16], Bt[16], Kt[16], Rt[16], vv[16]; float W = 1.0f;
#pragma unroll
        for (int t = 0; t < 16; ++t) { const size_t o = o0 + (size_t)t * 512;
            const float wv = RW[o], ka = bf2f(RH[3 * RWA + o]), bb = bf2f(RH[4 * RWA + o]), kk = bf2f(RH[1 * RWA + o]), rr = bf2f(RH[0 * RWA + o]); vv[t] = bf2f(RH[2 * RWA + o]);
            At[t] = -ka * W; W *= wv; const float iw = __builtin_amdgcn_rcpf(W); Bt[t] = bb * iw; Kt[t] = kk * iw; Rt[t] = rr * W; }
        rc_core(F, wlds, At, Bt, Kt, Rt, vv, W, FWS + WS_REC + (size_t)it * RC_REC);
    }
}
__device__ __forceinline__ void rc_core_ret(Frame& F, LAS unsigned char* wlds, const float (&Kt)[16], const float (&Rt)[16], const float (&vv)[16], const float D, unsigned char* rec) {
    { unsigned wb_ = (unsigned)(uintptr_t)wlds; asm volatile("" : "+v"(wb_)); wlds = (LAS unsigned char*)(uintptr_t)wb_; }
    LAS bf16* XK = (LAS bf16*)wlds; LAS bf16* XR = (LAS bf16*)(wlds + 2304); LAS float* GM = (LAS float*)(wlds + 4608);
    int x_ = F.lane; asm volatile("" : "+v"(x_));
    const int x = x_, fr = x & 15, q = x >> 4;
#pragma unroll
    for (int t = 0; t < 16; ++t) { XK[t * 72 + x] = cvt1_c(Kt[t]); XR[t * 72 + x] = cvt1_c(Rt[t]); }
#pragma unroll
    for (int qq = 0; qq < 4; ++qq) { v4u w; w.x = 0u; w.y = 0u;
        w.z = cvtpk_c(Kt[4 * qq] * D, Kt[4 * qq + 1] * D); w.w = cvtpk_c(Kt[4 * qq + 2] * D, Kt[4 * qq + 3] * D); *(v4u*)(rec + RC_BK + x * 64 + qq * 16) = w; }
#pragma unroll
    for (int qq = 0; qq < 2; ++qq) { v4u w;
        w.x = cvtpk_c(vv[8 * qq], vv[8 * qq + 1]); w.y = cvtpk_c(vv[8 * qq + 2], vv[8 * qq + 3]); w.z = cvtpk_c(vv[8 * qq + 4], vv[8 * qq + 5]); w.w = cvtpk_c(vv[8 * qq + 6], vv[8 * qq + 7]); *(v4u*)(rec + RC_VP + x * 32 + qq * 16) = w;
        *(v4u*)(rec + RC_U0 + x * 32 + qq * 16) = (v4u){0u, 0u, 0u, 0u}; }
    *(float*)(rec + RC_D + x * 4) = D;
    { const int ks = x >> 5, jj = x & 31, e = (jj >> 4) * 4 + (jj & 3), qv = (jj >> 2) & 3; unsigned char* pb = rec + RC_AR + ks * 1024 + qv * 256 + e * 2;
#pragma unroll
      for (int s = 0; s < 16; ++s) { *(bf16*)(pb + s * 16) = (bf16)0; *(bf16*)(pb + 2048 + s * 16) = cvt1_c(Rt[s]); } }
    f32x4 G = {0.f, 0.f, 0.f, 0.f};
#pragma unroll
    for (int ks = 0; ks < 2; ++ks) { const bf16x8 a = *(const LAS bf16x8*)(XK + fr * 72 + ks * 32 + q * 8), bq = *(const LAS bf16x8*)(XR + fr * 72 + ks * 32 + q * 8);
        G = __builtin_amdgcn_mfma_f32_16x16x32_bf16(a, bq, G, 0, 0, 0); }
#pragma unroll
    for (int rg = 0; rg < 4; ++rg) GM[(4 * q + rg) * 17 + fr] = G[rg];
    float Y0[16];
#pragma unroll
    for (int t = 0; t < 16; ++t) { float yy = 0.f;
#pragma unroll
        for (int s = 0; s <= t; ++s) yy += GM[s * 17 + t] * vv[s];
        Y0[t] = yy; }
#pragma unroll
    for (int qq = 0; qq < 2; ++qq) { v4u w;
        w.x = cvtpk_c(Y0[8 * qq], Y0[8 * qq + 1]); w.y = cvtpk_c(Y0[8 * qq + 2], Y0[8 * qq + 3]); w.z = cvtpk_c(Y0[8 * qq + 4], Y0[8 * qq + 5]); w.w = cvtpk_c(Y0[8 * qq + 6], Y0[8 * qq + 7]); *(v4u*)(rec + RC_Y0 + x * 32 + qq * 16) = w; }
    LDS_WAIT();
}
__device__ __forceinline__ void rc_pass1_ret(Frame& F, int wid, int nw, int c0, int nc) {
    LAS unsigned char* wlds = F.lds + F.wave * RC_WLDS;
    const int x = F.lane;
    const bf16* P = (const bf16*)(FWS + WS_PROJ);
    for (int it2 = wid; it2 < 16 * nc; it2 += nw) {
        const int ru = it2 / nc, c = c0 + it2 % nc, it = ru * RC_NCH + c, b = ru >> 3, h = (ru >> 1) & 3, half = ru & 1; const float gamma = 1.0f - exp2f(-5.0f - (float)h);
        float Kt[16], Rt[16], vv[16]; float W = 1.0f;
        const bf16* p0 = P + (size_t)(b * SEQ + c * 16) * IN_PAD;
#pragma unroll
        for (int t = 0; t < 16; ++t) { const bf16* p = p0 + (size_t)t * IN_PAD;
            const float rr = bf2f(p[C_RQ + h * 64 + x]), kk = bf2f(p[C_RK + h * 64 + x]) * 0.125f; vv[t] = bf2f(p[C_RV + h * 128 + half * 64 + x]);
            W *= gamma; const float iw = __builtin_amdgcn_rcpf(W); Kt[t] = kk * iw; Rt[t] = rr * W; }
        rc_core_ret(F, wlds, Kt, Rt, vv, W, FWS + WS_REC + (size_t)(16 * RC_NCH + it) * RC_REC);
    }
}
__device__ __forceinline__ void rwkv_prep_mfma(Frame& F, int l, int first, int stride) {
    LAS unsigned char* wlds = F.lds + F.wave * RC_WLDS;
    LAS bf16* CODES = (LAS bf16*)(F.lds + RC_CODES_OFF);
    LAS float* ST = (LAS float*)wlds;
    const bf16* P = (const bf16*)(FWS + WS_PROJ);
    const float* mu = F.in[F.zz + 4] + l * RWC;
    const bf16* WT = (const bf16*)(FWS + WS_RWW + (size_t)l * 448 * 512 * 2);
    float* RW = (float*)(FWS + WS_RW);
    const int x = F.lane, h = F.wave, ch = h * 64 + x, fr = x & 15, q = x >> 4;
    for (int item = first; item < NB * RC_NCH; item += stride) {
        const int b = item >> 8, c = item & 255; const size_t row0 = (size_t)b * SEQ + c * 16; const int t0 = c * 16;
        const bf16* prc = P + row0 * IN_PAD + C_RW + ch;
        unsigned short nr_[4], nk_[4], nv_[4]; float pvr = 0.f, pvk = 0.f, pvv = 0.f;
        if (t0 > 0) { pvr = bf2f(prc[-IN_PAD]); pvk = bf2f(prc[512 - IN_PAD]); pvv = bf2f(prc[1024 - IN_PAD]); }
#pragma unroll
        for (int tt = 0; tt < 4; ++tt) { nr_[tt] = prc[(size_t)tt * IN_PAD]; nk_[tt] = prc[(size_t)tt * IN_PAD + 512]; nv_[tt] = prc[(size_t)tt * IN_PAD + 1024]; }
        const float mur = mu[ch], muk = mu[512 + ch], muv = mu[1024 + ch];
        const float w0c = F.in[F.zz + 5][l * 512 + ch], a0c = F.in[F.zz + 7][l * 512 + ch], kkc = F.in[F.zz + 10][l * 512 + ch], kac = F.in[F.zz + 11][l * 512 + ch], rkc = F.in[F.zz + 12][l * 512 + ch];
#pragma unroll 7
        for (int idx = F.tid; idx < 16 * 448; idx += NTHR) { const int tk = idx / 448, cc = idx - tk * 448;
            float val = lerp_bf(P, row0 + tk, C_RW + 1536 + cc, (t0 + tk) > 0, mu[1536 + cc]);
            if (cc < 96) val = 1.0f - 2.0f * __builtin_amdgcn_rcpf(1.0f + __expf(2.0f * val));
            else if (cc >= 192) val = sigmoidf_(val);
            CODES[tk * RC_CSTRIDE + cc] = cvt1_c(val); }
        __syncthreads();
        f32x4 accW[4], accA[4], accG[4];
#pragma unroll
        for (int ct = 0; ct < 4; ++ct) { accW[ct] = (f32x4){0.f, 0.f, 0.f, 0.f}; accA[ct] = accW[ct]; accG[ct] = accW[ct]; }
        { bf16x8 bw[3][4];
#pragma unroll
          for (int ks = 0; ks < 3; ++ks)
#pragma unroll
              for (int ct = 0; ct < 4; ++ct) bw[ks][ct] = *(const bf16x8*)(WT + (size_t)(h * 64 + ct * 16 + fr) * 96 + ks * 32 + q * 8);
#pragma unroll
          for (int ks = 0; ks < 3; ++ks) { const bf16x8 aw = *(const LAS bf16x8*)(CODES + fr * RC_CSTRIDE + ks * 32 + q * 8);
#pragma unroll
              for (int ct = 0; ct < 4; ++ct) accW[ct] = __builtin_amdgcn_mfma_f32_16x16x32_bf16(aw, bw[ks][ct], accW[ct], 0, 0, 0); } }
        asm volatile("" ::: "memory");
        { bf16x8 ba[3][4];
#pragma unroll
          for (int ks = 0; ks < 3; ++ks)
#pragma unroll
              for (int ct = 0; ct < 4; ++ct) ba[ks][ct] = *(const bf16x8*)(WT + 512 * 96 + (size_t)(h * 64 + ct * 16 + fr) * 96 + ks * 32 + q * 8);
#pragma unroll
          for (int ks = 0; ks < 3; ++ks) { const bf16x8 aa = *(const LAS bf16x8*)(CODES + fr * RC_CSTRIDE + 96 + ks * 32 + q * 8);
#pragma unroll
              for (int ct = 0; ct < 4; ++ct) accA[ct] = __builtin_amdgcn_mfma_f32_16x16x32_bf16(aa, ba[ks][ct], accA[ct], 0, 0, 0); } }
        asm volatile("" ::: "memory");
#pragma unroll
        for (int hf = 0; hf < 2; ++hf) { bf16x8 bg[4][4];
#pragma unroll
            for (int k4 = 0; k4 < 4; ++k4)
#pragma unroll
                for (int ct = 0; ct < 4; ++ct) bg[k4][ct] = *(const bf16x8*)(WT + 2 * 512 * 96 + (size_t)(h * 64 + ct * 16 + fr) * 256 + (hf * 4 + k4) * 32 + q * 8);
#pragma unroll
            for (int k4 = 0; k4 < 4; ++k4) { const bf16x8 ag = *(const LAS bf16x8*)(CODES + fr * RC_CSTRIDE + 192 + (hf * 4 + k4) * 32 + q * 8);
#pragma unroll
                for (int ct = 0; ct < 4; ++ct) accG[ct] = __builtin_amdgcn_mfma_f32_16x16x32_bf16(ag, bg[k4][ct], accG[ct], 0, 0, 0); }
            asm volatile("" ::: "memory"); }
#pragma unroll
        for (int ct = 0; ct < 4; ++ct)
#pragma unroll
            for (int rg = 0; rg < 4; ++rg) { const int o = (4 * q + rg) * 64 + ct * 16 + fr; ST[o] = accW[ct][rg]; ST[1024 + o] = accA[ct][rg]; ST[2048 + o] = accG[ct][rg]; }
        float* gpw = RW + row0 * 512 + ch;
        bf16* gp = (bf16*)(FWS + WS_RW + 32 * MiB) + row0 * 512 + ch;
        for (int g = 0; g < 4; ++g) {
            unsigned short cr_[4], ck_[4], cv_[4];
#pragma unroll
            for (int tt = 0; tt < 4; ++tt) { cr_[tt] = nr_[tt]; ck_[tt] = nk_[tt]; cv_[tt] = nv_[tt]; }
            if (g < 3) {
#pragma unroll
                for (int tt = 0; tt < 4; ++tt) { const size_t ro = (size_t)(4 * g + 4 + tt) * IN_PAD; nr_[tt] = prc[ro]; nk_[tt] = prc[ro + 512]; nv_[tt] = prc[ro + 1024]; } }
#pragma unroll
          for (int tt = 0; tt < 4; ++tt) { const int t = 4 * g + tt;
            const float cr = bf2f(cr_[tt]), ck = bf2f(ck_[tt]), cv = bf2f(cv_[tt]);
            const float rr = cr + (pvr - cr) * mur, kk0 = ck + (pvk - ck) * muk, vv = cv + (pvv - cv) * muv;
            pvr = cr; pvk = ck; pvv = cv;
            const float z = -(w0c + ST[t * 64 + x]);
            const float sp = fmaxf(z, 0.f) + __logf(1.0f + __expf(-fabsf(z)));
            const float decay = __expf(-__expf(-sp - 0.5f));
            const float a = sigmoidf_(a0c + ST[1024 + t * 64 + x]);
            const float gg = ST[2048 + t * 64 + x];
            const float kkv = kk0 * kkc;
            const float nrm = __builtin_amdgcn_sqrtf(wave_sum(kkv * kkv));
            const float kap = kkv * __builtin_amdgcn_rcpf(fmaxf(nrm, 1e-12f));
            const float kp = kk0 * (1.0f + (a - 1.0f) * kac);
            const float bsum = wave_sum(rr * kp * rkc);
            gpw[0] = decay; gpw += 512;
            gp[0 * RWA] = cvt1_c(rr); gp[1 * RWA] = cvt1_c(kp); gp[2 * RWA] = cvt1_c(vv); gp[3 * RWA] = cvt1_c(kap); gp[4 * RWA] = cvt1_c(kap * a); gp[5 * RWA] = cvt1_c(gg); gp[6 * RWA] = cvt1_c(bsum * vv); gp += 512; } }
        LDS_WAIT();
        __syncthreads();
    }
}
constexpr int RC_SLOT = 15360, RC_YST = 8 * RC_SLOT  ;
__device__ __forceinline__ void rc_pass2(Frame& F, int u, int cb, int ce, bool first, bool last) {
    const unsigned char* rec = FWS + WS_REC + (size_t)u * RC_NCH * RC_REC;
    const int lane = F.lane;
    const int NIT = (ce - cb) / 2;
    bf16* Yg;
    if (u < 16) Yg = (bf16*)(FWS + WS_Y) + (size_t)((u >> 3) * SEQ) * 512 + (u & 7) * 64;
    else { const int ru = u - 16; Yg = (bf16*)(FWS + WS_RETO) + (size_t)((ru >> 3) * SEQ) * 512 + ((ru >> 1) & 3) * 128 + (ru & 1) * 64; }
#define RC_BARRIER() __builtin_amdgcn_s_barrier()
    if (F.wave == 7) {
        unsigned t0_ = 0u, t1_ = 0u, t2_ = 0u, t3_ = 0u;
        for (int cq = cb; cq < cb + 24 && cq < ce; cq += 2) { const unsigned char* pa = rec + (size_t)cq * RC_REC + lane * 128; const unsigned char* pb = pa + 8192; const unsigned char* pc = pa + RC_REC; const unsigned char* pd = pb + RC_REC;
            asm volatile("global_load_dword %0, %4, off\n\tglobal_load_dword %1, %5, off\n\tglobal_load_dword %2, %6, off\n\tglobal_load_dword %3, %7, off" : "+v"(t0_), "+v"(t1_), "+v"(t2_), "+v"(t3_) : "v"(pa), "v"(pb), "v"(pc), "v"(pd) : "memory"); }
        RC_BARRIER();
        for (int i = 0; i < NIT; ++i) {
            const int cp = cb + 2 * i + 24;
            if (cp < ce) { const unsigned char* pa = rec + (size_t)cp * RC_REC + lane * 128; const unsigned char* pb = pa + 8192; const unsigned char* pc = pa + RC_REC; const unsigned char* pd = pb + RC_REC;
                asm volatile("global_load_dword %0, %4, off\n\tglobal_load_dword %1, %5, off\n\tglobal_load_dword %2, %6, off\n\tglobal_load_dword %3, %7, off" : "+v"(t0_), "+v"(t1_), "+v"(t2_), "+v"(t3_) : "v"(pa), "v"(pb), "v"(pc), "v"(pd) : "memory"); }
            if (i > 0) {
                const LAS unsigned char* yb = F.lds + RC_YST + ((i - 1) & 1) * 4096;
#pragma unroll
                for (int j = 0; j < 4; ++j) { const v4u w = *(const LAS v4u*)(yb + j * 1024 + lane * 16);
                    *(v4u*)(Yg + (size_t)((cb + 2 * i - 2) * 16 + j * 8 + (lane >> 3)) * 512 + (lane & 7) * 8) = w; } }
            RC_BARRIER();
        }
        { const LAS unsigned char* yb = F.lds + RC_YST + ((NIT - 1) & 1) * 4096;
#pragma unroll
          for (int j = 0; j < 4; ++j) { const v4u w = *(const LAS v4u*)(yb + j * 1024 + lane * 16);
              *(v4u*)(Yg + (size_t)((cb + 2 * NIT - 2) * 16 + j * 8 + (lane >> 3)) * 512 + (lane & 7) * 8) = w; } }
        asm volatile("s_waitcnt vmcnt(0)" ::: "memory");
        asm volatile("" :: "v"(t0_), "v"(t1_), "v"(t2_), "v"(t3_));
    } else if (F.wave >= 4) {
        const int lw = F.wave - 4;
        const int p0_ = lw == 0 ? 8 : (lw == 1 ? 11 : 13), np_ = lw == 0 ? 3 : 2;
#define RC_ISSUE(c) do { _Pragma("unroll") for (int i_ = 0; i_ < 3; ++i_) { if (i_ < np_) \
            __builtin_amdgcn_global_load_lds((const unsigned*)(rec + (size_t)(c) * RC_REC + (p0_ + i_) * 1024 + lane * 16), (LAS unsigned*)(F.lds + ((c) & 7) * RC_SLOT + (p0_ + i_) * 1024), 16, 0, 0); } } while (0)
#define RC_WAIT4() do { if (lw == 0) asm volatile("s_waitcnt vmcnt(12)" ::: "memory"); else asm volatile("s_waitcnt vmcnt(8)" ::: "memory"); } while (0)
        for (int c = cb; c < cb + 6; ++c) RC_ISSUE(c);
        RC_WAIT4();
        RC_BARRIER();
        for (int i = 0; i < NIT; ++i) {
            if (cb + 2 * i + 7 < ce) { RC_ISSUE(cb + 2 * i + 6); RC_ISSUE(cb + 2 * i + 7); RC_WAIT4(); }
            else asm volatile("s_waitcnt vmcnt(0)" ::: "memory");
            RC_BARRIER();
        }
#undef RC_ISSUE
#undef RC_WAIT4
    } else {
        const int ib = F.wave, fr = lane & 15, q = lane >> 4;
#define RC_ISSUE1(c) do { __builtin_amdgcn_global_load_lds((const unsigned*)(rec + (size_t)(c) * RC_REC + (2 * ib) * 1024 + lane * 16), (LAS unsigned*)(F.lds + ((c) & 7) * RC_SLOT + (2 * ib) * 1024), 16, 0, 0); \
        __builtin_amdgcn_global_load_lds((const unsigned*)(rec + (size_t)(c) * RC_REC + (2 * ib + 1) * 1024 + lane * 16), (LAS unsigned*)(F.lds + ((c) & 7) * RC_SLOT + (2 * ib + 1) * 1024), 16, 0, 0); } while (0)
        f32x4* sv = (f32x4*)(FWS + WS_CTL + 262144) + (size_t)((u * 4 + ib) * 4 + 0) * 64 + lane;
        f32x4 sT[4];
#pragma unroll
        for (int jb = 0; jb < 4; ++jb) sT[jb] = first ? (f32x4){0.f, 0.f, 0.f, 0.f} : sv[jb * 64];
        asm volatile("s_waitcnt vmcnt(0)" ::: "memory");
        for (int c = cb; c < cb + 6; ++c) RC_ISSUE1(c);
        asm volatile("s_waitcnt vmcnt(8)" ::: "memory");
        RC_BARRIER();
        for (int i = 0; i < NIT; ++i) {
            bf16x8 aU0[2], aU1[2], aY0[2], aY1[2], bk[2][4]; f32x4 dd[2][4]; v2u vp[2], u0[2], y0[2];
#pragma unroll
            for (int h = 0; h < 2; ++h) { const LAS unsigned char* slot = F.lds + ((cb + 2 * i + h) & 7) * RC_SLOT;
                aU0[h] = *(const LAS bf16x8*)(slot + RC_AR + q * 256 + fr * 16); aU1[h] = *(const LAS bf16x8*)(slot + RC_AR + 1024 + q * 256 + fr * 16);
                aY0[h] = *(const LAS bf16x8*)(slot + RC_AR + 2048 + q * 256 + fr * 16); aY1[h] = *(const LAS bf16x8*)(slot + RC_AR + 3072 + q * 256 + fr * 16);
                u0[h] = *(const LAS v2u*)(slot + RC_U0 + (16 * ib + fr) * 32 + q * 8); vp[h] = *(const LAS v2u*)(slot + RC_VP + (16 * ib + fr) * 32 + q * 8);
#pragma unroll
                for (int jb = 0; jb < 4; ++jb) { bk[h][jb] = *(const LAS bf16x8*)(slot + RC_BK + (16 * jb + fr) * 64 + q * 16); dd[h][jb] = *(const LAS f32x4*)(slot + RC_D + (16 * jb + 4 * q) * 4); }
                y0[h] = *(const LAS v2u*)(slot + RC_Y0 + (16 * ib + fr) * 32 + q * 8); }
            LAS bf16* yst = (LAS bf16*)(F.lds + RC_YST + (i & 1) * 4096);
#pragma unroll
            for (int h = 0; h < 2; ++h) {
                v4u s0, s1;
                s0.x = cvtpk_c(sT[0][0], sT[0][1]); s0.y = cvtpk_c(sT[0][2], sT[0][3]); s0.z = cvtpk_c(sT[1][0], sT[1][1]); s0.w = cvtpk_c(sT[1][2], sT[1][3]);
                s1.x = cvtpk_c(sT[2][0], sT[2][1]); s1.y = cvtpk_c(sT[2][2], sT[2][3]); s1.z = cvtpk_c(sT[3][0], sT[3][1]); s1.w = cvtpk_c(sT[3][2], sT[3][3]);
                const bf16x8 sb0 = __builtin_bit_cast(bf16x8, s0), sb1 = __builtin_bit_cast(bf16x8, s1);
                f32x4 zU = (f32x4){0.f, 0.f, 0.f, 0.f}, zY = (f32x4){0.f, 0.f, 0.f, 0.f};
                zU = __builtin_amdgcn_mfma_f32_16x16x32_bf16(aU0[h], sb0, zU, 0, 0, 0); zU = __builtin_amdgcn_mfma_f32_16x16x32_bf16(aU1[h], sb1, zU, 0, 0, 0);
                const float U0_ = zU[0] + bflo(u0[h].x), U1_ = zU[1] + bfhi(u0[h].x), U2_ = zU[2] + bflo(u0[h].y), U3_ = zU[3] + bfhi(u0[h].y);
                v4u ubw; ubw.x = cvtpk_c(U0_, U1_); ubw.y = cvtpk_c(U2_, U3_); ubw.z = vp[h].x; ubw.w = vp[h].y;
                const bf16x8 ub = __builtin_bit_cast(bf16x8, ubw);
#pragma unroll
                for (int jb = 0; jb < 4; ++jb) sT[jb] = __builtin_amdgcn_mfma_f32_16x16x32_bf16(bk[h][jb], ub, sT[jb] * dd[h][jb], 0, 0, 0);
                zY = __builtin_amdgcn_mfma_f32_16x16x32_bf16(aY0[h], sb0, zY, 0, 0, 0); zY = __builtin_amdgcn_mfma_f32_16x16x32_bf16(aY1[h], sb1, zY, 0, 0, 0);
                LAS bf16* yp = yst + h * 1024 + (4 * q) * 64 + 16 * ib + fr;
                yp[0] = cvt1_c(zY[0] + bflo(y0[h].x)); yp[64] = cvt1_c(zY[1] + bfhi(y0[h].x)); yp[128] = cvt1_c(zY[2] + bflo(y0[h].y)); yp[192] = cvt1_c(zY[3] + bfhi(y0[h].y));
            }
            if (cb + 2 * i + 7 < ce) { RC_ISSUE1(cb + 2 * i + 6); RC_ISSUE1(cb + 2 * i + 7); asm volatile("s_waitcnt vmcnt(8) lgkmcnt(0)" ::: "memory"); } else asm volatile("s_waitcnt vmcnt(0) lgkmcnt(0)" ::: "memory");
            RC_BARRIER();
        }
        if (!last) {
#pragma unroll
            for (int jb = 0; jb < 4; ++jb) sv[jb * 64] = sT[jb]; }
#undef RC_ISSUE1
    }
#undef RC_BARRIER
    asm volatile("s_waitcnt vmcnt(0) lgkmcnt(0)" ::: "memory");
    __syncthreads();
}
__device__ __forceinline__ void sub_arrive(Frame& F, unsigned* cnt) {
    asm volatile("s_waitcnt vmcnt(0)" ::: "memory");
    __syncthreads();
    if (F.tid == 0) { __builtin_amdgcn_fence(__ATOMIC_RELEASE, "agent"); asm volatile("s_waitcnt vmcnt(0)" ::: "memory"); __hip_atomic_fetch_add(cnt, 1u, __ATOMIC_RELAXED, __HIP_MEMORY_SCOPE_AGENT); }
}
__device__ __forceinline__ void sub_wait(Frame& F, unsigned* cnt, unsigned target) {
    if (F.tid == 0) { unsigned sp = 0u;
        while (__hip_atomic_load(cnt, __ATOMIC_RELAXED, __HIP_MEMORY_SCOPE_AGENT) < target) { __builtin_amdgcn_s_sleep(2); if (++sp > (1u << 24)) break; }
        __builtin_amdgcn_fence(__ATOMIC_ACQUIRE, "agent"); asm volatile("s_waitcnt vmcnt(0)" ::: "memory"); }
    __syncthreads();
}
__device__ __forceinline__ void sub_barrier(Frame& F, unsigned* cnt, unsigned target) {
    asm volatile("s_waitcnt vmcnt(0)" ::: "memory");
    __syncthreads();
    if (F.tid == 0) {
        __builtin_amdgcn_fence(__ATOMIC_RELEASE, "agent");
        asm volatile("s_waitcnt vmcnt(0)" ::: "memory");
        __hip_atomic_fetch_add(cnt, 1u, __ATOMIC_RELAXED, __HIP_MEMORY_SCOPE_AGENT);
        unsigned sp = 0u;
        while (__hip_atomic_load(cnt, __ATOMIC_RELAXED, __HIP_MEMORY_SCOPE_AGENT) < target) { __builtin_amdgcn_s_sleep(2); if (++sp > (1u << 24)) break; }
        __builtin_amdgcn_fence(__ATOMIC_ACQUIRE, "agent");
        asm volatile("s_waitcnt vmcnt(0)" ::: "memory");
    }
    __syncthreads();
}
__device__ __forceinline__ void mixer_post(Frame& F, int l, int gw, int NGW) {
    const bf16* P = (const bf16*)(FWS + WS_PROJ);
    const bf16* RH = (const bf16*)(FWS + WS_RW + 32 * MiB);
    const float* RW = (const float*)(FWS + WS_RW);
    const bf16* Y = (const bf16*)(FWS + WS_Y);
    const bf16* RO = (const bf16*)(FWS + WS_RETO);
    bf16* MX = (bf16*)(FWS + WS_MIXED);
    const float* ln_w = F.in[F.zz + 13] + l * 512; const float* ln_b = F.in[F.zz + 14] + l * 512;
    const int lane = F.lane;
    for (int m = gw; m < MROWS; m += NGW) {
        const size_t o = (size_t)m * 512;
        float y[8], s1[8], s2[8], bon[8], gat[8]; f32x2 ov[4]; float s3[4]; unsigned gw2[4];
#pragma unroll
        for (int h = 0; h < 8; ++h) { const int c = h * 64 + lane; y[h] = bf2f(Y[o + c]); bon[h] = bf2f(RH[6 * RWA + o + c]); gat[h] = bf2f(RH[5 * RWA + o + c]); s1[h] = y[h]; }
#pragma unroll
        for (int h = 0; h < 4; ++h) { const int c = h * 128 + 2 * lane; { const unsigned rw_ = *(const unsigned*)(RO + o + c); ov[h].x = bflo(rw_); ov[h].y = bfhi(rw_); } gw2[h] = *(const unsigned*)(P + (size_t)m * IN_PAD + C_RG + c); s3[h] = ov[h].x * ov[h].x + ov[h].y * ov[h].y; }
#pragma unroll
        for (int h = 0; h < 8; ++h) { s1[h] = dpp_add<0xB1>(s1[h]); s1[h] = dpp_add<0x4E>(s1[h]); s1[h] = dpp_add<0x141>(s1[h]); s1[h] = dpp_add<0x140>(s1[h]); }
#pragma unroll
        for (int h = 0; h < 4; ++h) { s3[h] = dpp_add<0xB1>(s3[h]); s3[h] = dpp_add<0x4E>(s3[h]); s3[h] = dpp_add<0x141>(s3[h]); s3[h] = dpp_add<0x140>(s3[h]); }
#pragma unroll
        for (int h = 0; h < 8; ++h) s1[h] = xsum32(xsum16(s1[h]));
#pragma unroll
        for (int h = 0; h < 4; ++h) s3[h] = xsum32(xsum16(s3[h]));
#pragma unroll
        for (int h = 0; h < 8; ++h) { const float d = y[h] - s1[h] * (1.0f / 64.0f); y[h] = d; s2[h] = d * d; }
#pragma unroll
        for (int h = 0; h < 8; ++h) { s2[h] = dpp_add<0xB1>(s2[h]); s2[h] = dpp_add<0x4E>(s2[h]); s2[h] = dpp_add<0x141>(s2[h]); s2[h] = dpp_add<0x140>(s2[h]); }
#pragma unroll
        for (int h = 0; h < 8; ++h) s2[h] = xsum32(xsum16(s2[h]));
#pragma unroll
        for (int h = 0; h < 8; ++h) { const int c = h * 64 + lane;
            const float yn = y[h] * __builtin_amdgcn_rsqf(s2[h] * (1.0f / 64.0f) + GN_EPS) * ln_w[c] + ln_b[c];
            MX[(size_t)m * DM + 512 + c] = (bf16)f2bf((yn + bon[h]) * gat[h]); }
#pragma unroll
        for (int h = 0; h < 4; ++h) { const int c = h * 128 + 2 * lane;
            const float rn = __builtin_amdgcn_rsqf(s3[h] * (1.0f / 128.0f) + NORM_EPS);
            const float g0 = bflo(gw2[h]), g1 = bfhi(gw2[h]);
            *(unsigned*)(MX + (size_t)m * DM + c) = pk2(ov[h].x * rn * g0 * sigmoidf_(g0), ov[h].y * rn * g1 * sigmoidf_(g1)); }
    }
}
__device__ __forceinline__ void conv_gate_phase(Frame& F, int l) {
    const bf16* U = (const bf16*)(FWS + WS_U);
    bf16* A = (bf16*)(FWS + WS_ACT);
    const float* cw = F.in[F.zz + 16] + (size_t)l * 3 * UPC; const float* cb = F.in[F.zz + 17] + (size_t)l * UPC;
    constexpr int NCG = DFF / 8, NRC = MROWS / 16;
    for (int it = F.vcu * NTHR + F.tid; it < NCG * NRC; it += F.G * NTHR) {
        const int cg = it % NCG, rc = it / NCG, c0 = cg * 8, row0 = rc * 16, t0 = row0 & (SEQ - 1);
        float wv[3][8], wg[3][8], bv[8], bg[8];
#pragma unroll
        for (int j = 0; j < 3; ++j)
#pragma unroll
            for (int e = 0; e < 8; ++e) { wv[j][e] = cw[j * UPC + c0 + e]; wg[j][e] = cw[j * UPC + DFF + c0 + e]; }
#pragma unroll
        for (int e = 0; e < 8; ++e) { bv[e] = cb[c0 + e]; bg[e] = cb[DFF + c0 + e]; }
        v4u v0 = {0u, 0u, 0u, 0u}, v1 = v0, g0 = v0, g1 = v0;
        if (t0 > 0) { v0 = *(const v4u*)(U + (size_t)(row0 - 2) * UPC + c0); v1 = *(const v4u*)(U + (size_t)(row0 - 1) * UPC + c0);
                      g0 = *(const v4u*)(U + (size_t)(row0 - 2) * UPC + DFF + c0); g1 = *(const v4u*)(U + (size_t)(row0 - 1) * UPC + DFF + c0); }
        for (int r = 0; r < 16; ++r) {
            const v4u v2 = *(const v4u*)(U + (size_t)(row0 + r) * UPC + c0), g2 = *(const v4u*)(U + (size_t)(row0 + r) * UPC + DFF + c0);
            float ov[8];
#pragma unroll
            for (int e = 0; e < 4; ++e) {
                const float va = wv[0][2 * e] * bflo(v0[e]) + wv[1][2 * e] * bflo(v1[e]) + wv[2][2 * e] * bflo(v2[e]) + bv[2 * e];
                const float vb = wv[0][2 * e + 1] * bfhi(v0[e]) + wv[1][2 * e + 1] * bfhi(v1[e]) + wv[2][2 * e + 1] * bfhi(v2[e]) + bv[2 * e + 1];
                const float ga = wg[0][2 * e] * bflo(g0[e]) + wg[1][2 * e] * bflo(g1[e]) + wg[2][2 * e] * bflo(g2[e]) + bg[2 * e];
                const float gb = wg[0][2 * e + 1] * bfhi(g0[e]) + wg[1][2 * e + 1] * bfhi(g1[e]) + wg[2][2 * e + 1] * bfhi(g2[e]) + bg[2 * e + 1];
                ov[2 * e] = ga * sigmoidf_(ga) * va; ov[2 * e + 1] = gb * sigmoidf_(gb) * vb; }
            v4u w; w.x = pk2(ov[0], ov[1]); w.y = pk2(ov[2], ov[3]); w.z = pk2(ov[4], ov[5]); w.w = pk2(ov[6], ov[7]);
            *(v4u*)(A + (size_t)(row0 + r) * DFF + c0) = w;
            v0 = v1; v1 = v2; g0 = g1; g1 = g2;
        }
    }
}

__device__ __forceinline__ void conv_fixup_phase(Frame& F, int l) {
    const float* H = (const float*)(FWS + WS_HALO);
    bf16* A = (bf16*)(FWS + WS_ACT);
    const float* cw = F.in[F.zz + 16] + (size_t)l * 3 * UPC; const float* cb = F.in[F.zz + 17] + (size_t)l * UPC;
    constexpr int NQ = DFF / 4;
    for (int it = F.vcu * NTHR + F.tid; it < (MROWS / 64) * 2 * NQ; it += F.G * NTHR) {
        const int c = (it % NQ) * 4, gr = it / NQ, r = gr & 1, g = gr >> 1, colp = (c >> 7) * 256 + (c & 127);
        const bool hasprev = (g & 63) != 0;
        const float* hg = H + (size_t)g * 4 * UPC + colp; const float* hp = hg - (size_t)4 * UPC;
        const f32x4 z = {0.f, 0.f, 0.f, 0.f};
        f32x4 v0, v1, v2, g0, g1, g2;
        v0 = *(const f32x4*)(hg + (size_t)r * UPC); g0 = *(const f32x4*)(hg + (size_t)r * UPC + 128);
        if (r == 1) { v1 = *(const f32x4*)hg; g1 = *(const f32x4*)(hg + 128); v2 = hasprev ? *(const f32x4*)(hp + (size_t)3 * UPC) : z; g2 = hasprev ? *(const f32x4*)(hp + (size_t)3 * UPC + 128) : z; }
        else { v1 = hasprev ? *(const f32x4*)(hp + (size_t)3 * UPC) : z; g1 = hasprev ? *(const f32x4*)(hp + (size_t)3 * UPC + 128) : z; v2 = hasprev ? *(const f32x4*)(hp + (size_t)2 * UPC) : z; g2 = hasprev ? *(const f32x4*)(hp + (size_t)2 * UPC + 128) : z; }
        const f32x4 cv = *(const f32x4*)(cw + c) * v2 + *(const f32x4*)(cw + UPC + c) * v1 + *(const f32x4*)(cw + 2 * UPC + c) * v0 + *(const f32x4*)(cb + c);
        const f32x4 cg = *(const f32x4*)(cw + DFF + c) * g2 + *(const f32x4*)(cw + UPC + DFF + c) * g1 + *(const f32x4*)(cw + 2 * UPC + DFF + c) * g0 + *(const f32x4*)(cb + DFF + c);
        v2u w; w.x = pk2(cg[0] * sigmoidf_(cg[0]) * cv[0], cg[1] * sigmoidf_(cg[1]) * cv[1]); w.y = pk2(cg[2] * sigmoidf_(cg[2]) * cv[2], cg[3] * sigmoidf_(cg[3]) * cv[3]);
        *(v2u*)(A + (size_t)(64 * g + r) * DFF + c) = w;
    }
}

#define GRID_BAR() do { xcd_barrier(bar, tid_from_wave(F.wave)); asm volatile("" : "+s"(F.wave), "+s"(F.vcu), "+s"(F.G)); F.tid = tid_from_wave(F.wave); F.lane = F.tid & 63; { unsigned z_ = 0u; asm volatile("" : "+v"(z_)); F.zz = __builtin_amdgcn_readfirstlane(z_); } } while (0)
#define XB ((bf16*)(FWS + WS_X))
#define HB ((bf16*)(FWS + WS_H))
#define PROJ ((bf16*)(FWS + WS_PROJ))
#define MIXED ((bf16*)(FWS + WS_MIXED))
#define UB ((bf16*)(FWS + WS_U))
#define ACT ((bf16*)(FWS + WS_ACT))
#define MOD ((const float*)(FWS + WS_MOD))
template <int l>
__device__ __forceinline__ void layer_fwd(Frame& F, const XcdBarrier& bar) {
#define modl (MOD + (size_t)l * 2 * 12288)
#define wl (FWS + WS_W + (size_t)l * W_LAYER)
        if (l == 0) norm_phase<0, true>(F, F.in[F.zz + 0], HB, F.in[F.zz + 21] + l * DM, modl + 0 * DM, modl + 1 * DM);
        else norm_phase<0, false>(F, XB, HB, F.in[F.zz + 21] + l * DM, modl + 0 * DM, modl + 1 * DM);
        GRID_BAR();
        { pg8::Gemm g{HB, (const bf16*)(wl + W_IN), MROWS, IN_PAD, DM}; pg8::StaticOrder S; S.init(MROWS, IN_PAD, F.G, (int)blockIdx.x);
          pg8::EpiBf16 E{PROJ, IN_PAD};
          pg8::gemm_phase<pg8::EpiBf16, pg8::StaticOrder, true, true>(F.lds, g, S, E, F.wave); }
        if (F.G == 256 && blockIdx.x >= 64) convert_gap(F, l, CV_IN, l == 0 ? CV_C1 : CV_OUT + CV_UP, ((int)blockIdx.x - 64) * NWAVES + F.wave, 192 * NWAVES, CV_N1);
        GRID_BAR();
        rwkv_prep_mfma(F, l, F.vcu, F.G);
        moba_kmean(F);
        GRID_BAR();
        const int xg_ = F.vcu >> 5, xj_ = F.vcu & 31, mi_ = xg_ * 16 + xj_;
        if (xj_ < 16) { moba_item(F, mi_ >> 3, 15 - (mi_ & 7), mi_ & 7);
            asm volatile("" : "+s"(F.wave)); F.tid = tid_from_wave(F.wave); F.lane = F.tid & 63;
            if (F.G == 256 && l == 0) { constexpr int nr_ = CV_LAYER - (CV_IN + CV_C1); LAS float* scr_ = (LAS float*)(F.lds + F.wave * 16384);
                for (int j = 0; j < CV_N3; ++j) { const int s_ = mi_ * NWAVES + F.wave + 128 * NWAVES * j;
                    if (s_ < nr_) convert_item(F, l * CV_LAYER + CV_IN + CV_C1 + s_, scr_);
                    else if (l == 0 && s_ - nr_ < CV_IN - CV_C2) convert_item(F, CV_LAYER + CV_C2 + (s_ - nr_), scr_); } }
            sub_wait(F, (unsigned*)(FWS + WS_CTL) + CW_SUB + 128 * l + 64, (unsigned)(F.G / 2));
        }
        else {
            const int rv = xg_ * 16 + (xj_ - 16), nrc = F.G / 2;
            unsigned* sub = (unsigned*)(FWS + WS_CTL) + CW_SUB + 128 * l;
            constexpr int RC_SPLIT = 104;
            rc_pass1_rwkv(F, rv * NWAVES + F.wave, nrc * NWAVES, 0, 128);
            rc_pass1_ret(F, rv * NWAVES + F.wave, nrc * NWAVES, 0, 128);
            sub_barrier(F, sub, (unsigned)nrc);
            const bool p2cu = (rv & 3) == 0 && (rv >> 2) < RC_UNITS;
            if (p2cu) {
                rc_pass2(F, rv >> 2, 0, RC_SPLIT, true, false);
                sub_wait(F, sub + 32, (unsigned)(nrc - RC_UNITS));
                rc_pass2(F, rv >> 2, RC_SPLIT, RC_NCH, false, true);
            } else {
                const int ov = rv - (rv >> 2) - 1, nov = nrc - RC_UNITS;
                rc_pass1_rwkv(F, ov * NWAVES + F.wave, nov * NWAVES, 128, 128);
                rc_pass1_ret(F, ov * NWAVES + F.wave, nov * NWAVES, 128, 128);
                sub_arrive(F, sub + 32);
            }
            sub_barrier(F, sub + 64, (unsigned)nrc);
        }
        asm volatile("" : "+s"(F.wave), "+s"(F.vcu), "+s"(F.G)); F.tid = tid_from_wave(F.wave); F.lane = F.tid & 63; { unsigned z_ = 0u; asm volatile("" : "+v"(z_)); F.zz = __builtin_amdgcn_readfirstlane(z_); }
        mixer_post(F, l, F.vcu * NWAVES + F.wave, F.G * NWAVES);
        GRID_BAR();
#if MOBA_CHECK
        moba_naive(F, F.vcu * NWAVES + F.wave, F.G * NWAVES);
        GRID_BAR();
        { float sd = 0.f, sn = 0.f; const bf16* NV = (const bf16*)(FWS + WS_U + 160 * MiB); const bf16* MXc = (const bf16*)(FWS + WS_MIXED);
          for (int m = F.vcu * NWAVES + F.wave; m < MROWS; m += F.G * NWAVES) for (int j = 0; j < 16; ++j) { const float a = bf2f(MXc[(size_t)m * DM + 1024 + j * 64 + F.lane]), b = bf2f(NV[(size_t)m * 1024 + j * 64 + F.lane]); sd += (a - b) * (a - b); sn += b * b; }
          atomicAdd((float*)(FWS + WS_CTL) + 8, sd); atomicAdd((float*)(FWS + WS_CTL) + 9, sn); }
        GRID_BAR();
#endif
        { pg8::Gemm g{MIXED, (const bf16*)(wl + W_OUT), MROWS, DM, DM}; pg8::StaticOrder S; S.init(MROWS, DM, F.G, (int)blockIdx.x);
          if (l == 0) { pg8::EpiResGate<true> E{F.in[F.zz + 0], XB, DM, modl + 2 * DM, 12288, SEQ}; pg8::gemm_phase<pg8::EpiResGate<true>, pg8::StaticOrder, true, true>(F.lds, g, S, E, F.wave); }
          else { pg8::EpiResGate<false> E{XB, XB, DM, modl + 2 * DM, 12288, SEQ}; pg8::gemm_phase<pg8::EpiResGate<false>, pg8::StaticOrder, true, true>(F.lds, g, S, E, F.wave); } }
        GRID_BAR();
        norm_phase<0, false>(F, XB, HB, F.in[F.zz + 22] + l * DM, modl + 3 * DM, modl + 4 * DM);
        GRID_BAR();
        { pg8::Gemm g{HB, (const bf16*)(wl + W_UP), MROWS, UPC, DM}; pg8::StaticOrder S; S.init(MROWS, UPC, F.G, (int)blockIdx.x);
          pg8::EpiConvGate E{ACT, DFF, (float*)(FWS + WS_HALO), F.in[F.zz + 16] + (size_t)l * 3 * UPC, F.in[F.zz + 17] + (size_t)l * UPC, UPC, DFF};
          pg8::gemm_phase<pg8::EpiConvGate, pg8::StaticOrder, true, true>(F.lds, g, S, E, F.wave); }
        if (l == 0 && F.G == 256 && blockIdx.x >= 128) { if (blockIdx.x < 224) adaln_item(F, 1, (int)blockIdx.x - 128); convert_gap(F, 1, 0, CV_C2, ((int)blockIdx.x - 128) * NWAVES + F.wave, 128 * NWAVES, CV_N2); }
        if (l == 1 && F.G == 256 && blockIdx.x >= 128) convert_gap(F, 1, CV_IN + CV_OUT + CV_UP, CV_DN, ((int)blockIdx.x - 128) * NWAVES + F.wave, 128 * NWAVES, CV_N2);
        GRID_BAR();
        conv_fixup_phase(F, l);
        GRID_BAR();
        { pg8::Gemm g{ACT, (const bf16*)(wl + W_DN), MROWS, DM, DFF}; pg8::StaticOrder S; S.init(MROWS, DM, F.G, (int)blockIdx.x);
          pg8::EpiResGate<false> E{XB, XB, DM, modl + 5 * DM, 12288, SEQ};
          pg8::gemm_phase<pg8::EpiResGate<false>, pg8::StaticOrder, true, true>(F.lds, g, S, E, F.wave); }
        GRID_BAR();
}

__global__ void __launch_bounds__(NTHR, 2) mega_fwd(Args args) {
    extern __shared__ __attribute__((aligned(16))) unsigned char lds[];
    Frame F;
    F.lds = (LAS unsigned char*)lds;
    F.tid = threadIdx.x; F.lane = F.tid & 63; F.wave = __builtin_amdgcn_readfirstlane(F.tid >> 6);
    F.G = gridDim.x; { const int bx = blockIdx.x; F.vcu = (F.G % 8 == 0) ? (bx % 8) * (F.G / 8) + bx / 8 : bx; }
    F.in = args.in; F.ws = args.ws; F.zz = 0;
    volatile LAS unsigned* MISC = (volatile LAS unsigned*)(F.lds + MISC_OFF);
    for (int u = F.tid; u < (LDS_BYTES - LDSCTL_OFF) / 4; u += NTHR) ((LAS unsigned*)(F.lds + LDSCTL_OFF))[u] = 0u;
    __syncthreads();
    XcdBarrier bar = xcd_barrier_post((unsigned*)(FWS + WS_CTL) + CW_BAR, MISC + 8, F.tid);

    p0_prologue(F);
    GRID_BAR();
    layer_fwd<0>(F, bar);
    layer_fwd<1>(F, bar);
    norm_phase<1, false>(F, XB, args.out, F.in[F.zz + 23], nullptr, nullptr);
}

extern "C" void kernel_launch(void* const* d_in, const int* in_sizes, int n_in, void* d_out, int out_size, void* d_ws, size_t ws_size, hipStream_t stream) {
    static int grid = 0;
    if (grid == 0) {
        if (n_in != 24 || out_size != MROWS * DM || ws_size < WS_END) { fprintf(stderr, "kernel_launch: unexpected shapes (n_in %d out %d ws %zu)\n", n_in, out_size, ws_size); grid = -1; return; }
        int dev = 0, cus = 0;
        if (hipGetDevice(&dev) != hipSuccess || hipDeviceGetAttribute(&cus, hipDeviceAttributeMultiprocessorCount, dev) != hipSuccess) { grid = -1; return; }
        if (hipFuncSetAttribute((const void*)mega_fwd, hipFuncAttributeMaxDynamicSharedMemorySize, LDS_BYTES) != hipSuccess) { fprintf(stderr, "kernel_launch: hipFuncSetAttribute failed\n"); grid = -1; return; }
        int per_cu = 0;
        if (hipOccupancyMaxActiveBlocksPerMultiprocessor(&per_cu, (const void*)mega_fwd, NTHR, LDS_BYTES) != hipSuccess || per_cu < 1) { fprintf(stderr, "kernel_launch: occupancy query says %d\n", per_cu); }
        (void)hipGetLastError();
        grid = cus;
    }
    if (grid < 0) return;
    (void)hipMemsetAsync((char*)d_ws + WS_CTL, 0, CTL_ZERO_BYTES, stream);
    Args a{};
    for (int i = 0; i < 24; ++i) a.in[i] = (const float*)d_in[i];
    a.out = (float*)d_out; a.ws = (unsigned char*)d_ws;
    hipLaunchKernelGGL(mega_fwd, dim3(grid), dim3(NTHR), LDS_BYTES, stream, a);
}
```

```cpp
#include <hip/hip_runtime.h>
#include <cstdio>
#include <cstdint>
#ifndef MOBA_NP
#define MOBA_NP 2
#endif
#ifndef MOBA_CHECK
#define MOBA_CHECK 0
#endif
__device__ __forceinline__ int tid_from_wave(int wave) { int l = (int)__builtin_amdgcn_mbcnt_hi(~0u, __builtin_amdgcn_mbcnt_lo(~0u, 0u)); asm volatile("" : "+v"(l)); return wave * 64 + l; }
namespace pg8 {
#define PG8_LAS __attribute__((address_space(3)))
typedef unsigned short bf16_t;
typedef short bf16x8 __attribute__((ext_vector_type(8)));
typedef float f32x4 __attribute__((ext_vector_type(4)));
typedef unsigned u32x4 __attribute__((ext_vector_type(4)));
constexpr int BM = 256, BK = 64, HALF = 128, HTB = HALF * BK * 2  , STAGE_BYTES = 8 * HTB, NXCD = 8, WGM = 8;

__host__ __device__ __forceinline__ int lds_byte(int r, int c) { const int st = (r >> 4) * 2 + (c >> 5), rr = r & 15, cc = c & 31, ob = rr * 64 + cc * 2; return st * 1024 + (ob ^ (((ob >> 9) & 1) << 5)); }
__host__ __device__ __forceinline__ void stage_rc(int b, int& R, int& C) { const int st = b / 1024, sb = b % 1024, swz = sb ^ (((sb >> 9) & 1) << 5); R = (st >> 1) * 16 + swz / 64; C = (st & 1) * 32 + (swz % 64) / 2; }
__host__ __device__ __forceinline__ int perm32(int rho) { const int n = rho >> 4, i = rho & 15; return 8 * (i >> 2) + 4 * n + (i & 3); }

struct Unit { int pm, pn; };
struct Gemm { const bf16_t* A; const bf16_t* Bt; int M, N, K; };

struct StaticOrder {
    int nM, nN, nwg, G, c;
    __host__ __device__ void init(int M, int N, int G_, int c_) { nM = M / BM; nN = N / BM; nwg = nM * nN; G = G_; c = c_; }
    __host__ __device__ bool next(int i, Unit& u) const {
        const long L = (long)i * G + c; if (L >= nwg) return false;
        int wgid = (int)L; { const int q = nwg / NXCD, r = nwg % NXCD, xcd = wgid % NXCD, off = wgid / NXCD; wgid = (xcd < r ? xcd * (q + 1) : r * (q + 1) + (xcd - r) * q) + off; }
        const int nig = WGM * nN, gid = wgid / nig, fm = gid * WGM, gsz = (nM - fm) < WGM ? (nM - fm) : WGM;
        u.pm = fm + ((wgid % nig) % gsz); u.pn = (wgid % nig) / gsz; return true;
    }
    __device__ __forceinline__ void a_ready(const Unit&) const {}
    __device__ __forceinline__ void done(const Unit&) const {}
};

__device__ __forceinline__ unsigned cvt_pk_bf16(float lo, float hi) { unsigned r; asm volatile("v_cvt_pk_bf16_f32 %0, %1, %2" : "=v"(r) : "v"(lo), "v"(hi)); return r; }

struct EpiBf16 {
    static constexpr bool PERM = true, AFTER_DRAIN = false;
    bf16_t* O; int ldc;
    __device__ __forceinline__ void operator()(const f32x4 (&acc)[2][2][4][2], const Unit& u, int wr, int wc, int fr, int fq) const {
        const int row0 = u.pm * BM + wr * 64 + fr; const int col0 = u.pn * BM + wc * 32 + 8 * fq;
#pragma unroll
        for (int ai = 0; ai < 2; ++ai)
#pragma unroll
            for (int m = 0; m < 4; ++m) { bf16_t* rowp = O + (size_t)(row0 + ai * HALF + m * 16) * ldc + col0;
#pragma unroll
                for (int bj = 0; bj < 2; ++bj) { const f32x4 v0 = acc[ai][bj][m][0], v1 = acc[ai][bj][m][1];
                    u32x4 w; w.x = cvt_pk_bf16(v0[0], v0[1]); w.y = cvt_pk_bf16(v0[2], v0[3]); w.z = cvt_pk_bf16(v1[0], v1[1]); w.w = cvt_pk_bf16(v1[2], v1[3]);
                    *(u32x4*)(rowp + bj * HALF) = w; } }
    }
};

template <int CTRL> __device__ __forceinline__ float dpp_ror(float v) { return __builtin_bit_cast(float, __builtin_amdgcn_update_dpp(0, __builtin_bit_cast(int, v), CTRL, 0xF, 0xF, true)); }
struct EpiConvGate {
    static constexpr bool PERM = true, AFTER_DRAIN = false;
    bf16_t* A; int lda; float* halo; const float* cw; const float* cb; int nup, dff;
    __device__ __forceinline__ void operator()(const f32x4 (&acc)[2][2][4][2], const Unit& u, int wr, int wc, int fr, int fq) const {
        const int chl = wc * 32 + 8 * fq;
#pragma unroll
        for (int n = 0; n < 2; ++n) {
            const int c = u.pn * 128 + chl + 4 * n, colp = u.pn * 256 + chl + 4 * n;
            const f32x4 wv0 = *(const f32x4*)(cw + c), wv1 = *(const f32x4*)(cw + nup + c), wv2 = *(const f32x4*)(cw + 2 * nup + c), bv = *(const f32x4*)(cb + c);
            const f32x4 wg0 = *(const f32x4*)(cw + dff + c), wg1 = *(const f32x4*)(cw + nup + dff + c), wg2 = *(const f32x4*)(cw + 2 * nup + dff + c), bg = *(const f32x4*)(cb + dff + c);
#pragma unroll
            for (int ai = 0; ai < 2; ++ai) {
                const int grow = u.pm * BM + ai * HALF + wr * 64;
                float* hb = halo + (size_t)(grow >> 6) * 4 * nup + colp;
                if (fr < 2) { *(f32x4*)(hb + (size_t)fr * nup) = acc[ai][0][0][n]; *(f32x4*)(hb + (size_t)fr * nup + 128) = acc[ai][1][0][n]; }
                if (fr >= 14) { *(f32x4*)(hb + (size_t)(fr - 12) * nup) = acc[ai][0][3][n]; *(f32x4*)(hb + (size_t)(fr - 12) * nup + 128) = acc[ai][1][3][n]; }
                f32x4 cv[4];
                {   f32x4 P1 = {0.f, 0.f, 0.f, 0.f}, P2 = P1;
#pragma unroll
                    for (int m = 0; m < 4; ++m) { f32x4 R1, R2;
#pragma unroll
                        for (int e = 0; e < 4; ++e) { R1[e] = dpp_ror<0x121>(acc[ai][0][m][n][e]); R2[e] = dpp_ror<0x122>(acc[ai][0][m][n][e]); }
                        const f32x4 p1 = (fr >= 1) ? R1 : P1, p2 = (fr >= 2) ? R2 : P2; P1 = R1; P2 = R2;
                        cv[m] = wv0 * p2 + wv1 * p1 + wv2 * acc[ai][0][m][n] + bv; } }
                {   f32x4 P1 = {0.f, 0.f, 0.f, 0.f}, P2 = P1;
#pragma unroll
                    for (int m = 0; m < 4; ++m) { f32x4 R1, R2;
#pragma unroll
                        for (int e = 0; e < 4; ++e) { R1[e] = dpp_ror<0x121>(acc[ai][1][m][n][e]); R2[e] = dpp_ror<0x122>(acc[ai][1][m][n][e]); }
                        const f32x4 p1 = (fr >= 1) ? R1 : P1, p2 = (fr >= 2) ? R2 : P2; P1 = R1; P2 = R2;
                        const f32x4 cg = wg0 * p2 + wg1 * p1 + wg2 * acc[ai][1][m][n] + bg;
                        f32x4 o;
#pragma unroll
                        for (int e = 0; e < 4; ++e) o[e] = cg[e] * __builtin_amdgcn_rcpf(1.0f + __expf(-cg[e])) * cv[m][e];
                        unsigned w0 = cvt_pk_bf16(o[0], o[1]), w1 = cvt_pk_bf16(o[2], o[3]);
                        *(unsigned long long*)(A + (size_t)(grow + m * 16 + fr) * lda + c) = (unsigned long long)w0 | ((unsigned long long)w1 << 32); } }
            }
        }
    }
};

template <bool BASE_F32>
struct EpiResGate {
    static constexpr bool PERM = true, AFTER_DRAIN = false;
    const void* base; bf16_t* out; int ldc; const float* gate; int gstride; int rows_per_batch;
    __device__ __forceinline__ void operator()(const f32x4 (&acc)[2][2][4][2], const Unit& u, int wr, int wc, int fr, int fq) const {
        const int col0 = u.pn * BM + wc * 32 + 8 * fq;
        const int b = (u.pm * BM) / rows_per_batch;
        f32x4 gv[2][2];
#pragma unroll
        for (int bj = 0; bj < 2; ++bj)
#pragma unroll
            for (int n = 0; n < 2; ++n) gv[bj][n] = *(const f32x4*)(gate + (size_t)b * gstride + col0 + bj * HALF + n * 4);
#pragma unroll
        for (int ai = 0; ai < 2; ++ai)
#pragma unroll
            for (int m = 0; m < 4; ++m) { const size_t off = (size_t)(u.pm * BM + ai * HALF + wr * 64 + m * 16 + fr) * ldc + col0;
#pragma unroll
                for (int bj = 0; bj < 2; ++bj) { f32x4 b0, b1;
                    if (BASE_F32) { b0 = *(const f32x4*)((const float*)base + off + bj * HALF); b1 = *(const f32x4*)((const float*)base + off + bj * HALF + 4); }
                    else { const u32x4 w = *(const u32x4*)((const bf16_t*)base + off + bj * HALF);
                        b0 = (f32x4){__builtin_bit_cast(float, w.x << 16), __builtin_bit_cast(float, w.x & 0xffff0000u), __builtin_bit_cast(float, w.y << 16), __builtin_bit_cast(float, w.y & 0xffff0000u)};
                        b1 = (f32x4){__builtin_bit_cast(float, w.z << 16), __builtin_bit_cast(float, w.z & 0xffff0000u), __builtin_bit_cast(float, w.w << 16), __builtin_bit_cast(float, w.w & 0xffff0000u)}; }
                    const f32x4 o0 = b0 + gv[bj][0] * acc[ai][bj][m][0], o1 = b1 + gv[bj][1] * acc[ai][bj][m][1];
                    u32x4 w; w.x = cvt_pk_bf16(o0[0], o0[1]); w.y = cvt_pk_bf16(o0[2], o0[3]); w.z = cvt_pk_bf16(o1[0], o1[1]); w.w = cvt_pk_bf16(o1[2], o1[3]);
                    *(u32x4*)(out + off + bj * HALF) = w; }
                if (m & 1) asm volatile("" ::: "memory"); }
    }
};

template <class Epi, class Sched, bool ALIGN_EPI = false, bool SP2 = false>
__device__ __forceinline__ void gemm_phase(PG8_LAS unsigned char* lds, const Gemm g, const Sched& S, const Epi& E, int wave_) {
    const int tid_ = tid_from_wave(wave_);
    const int tid = tid_, wid = __builtin_amdgcn_readfirstlane(tid >> 6), lane = tid & 63, wr = wid >> 2, wc = wid & 3, fr = lane & 15, fq = lane >> 4;
    const int K = g.K, nt = K / BK;
    unsigned voffA[2], voffB[2];
#pragma unroll
    for (int i = 0; i < 2; ++i) { int R, C; stage_rc(tid * 16 + i * 8192, R, C); const int Rb = Epi::PERM ? ((R & ~31) + perm32(R & 31)) : R;
        voffA[i] = (unsigned)(R * K + C) * 2u; voffB[i] = (unsigned)(Rb * K + C) * 2u; }
    const size_t kstep = (size_t)(BK * 2);
    const size_t hstep = (size_t)HALF * K * 2;
    const size_t tstep = 2 * hstep;
    const unsigned ldsw = (unsigned)wid * 1024u;
    const int aoff = lds_byte(wr * 64 + fr, fq * 8), boff = lds_byte(wc * 32 + fr, fq * 8);
#define PG8_SA(b, h) (((b) * 2 + (h)) * HTB)
#define PG8_SB(b, h) ((4 + (b) * 2 + (h)) * HTB)
#define PG8_STAGE(bufoff, gbase, voff) do { _Pragma("unroll") for (int _i = 0; _i < 2; ++_i) \
        __builtin_amdgcn_global_load_lds((const unsigned*)((const char*)(gbase) + (voff)[_i]), (PG8_LAS unsigned*)(lds + (bufoff) + ldsw + _i * 8192), 16, 0, 0); } while (0)
#define PG8_LDA(dst, b, h) do { _Pragma("unroll") for (int m = 0; m < 4; ++m) _Pragma("unroll") for (int k = 0; k < 2; ++k) dst[m][k] = *(const PG8_LAS bf16x8*)(lds + PG8_SA(b, h) + aoff + m * 2048 + k * 1024); } while (0)
#define PG8_LDB(dst, b, h) do { _Pragma("unroll") for (int n = 0; n < 2; ++n) _Pragma("unroll") for (int k = 0; k < 2; ++k) dst[n][k] = *(const PG8_LAS bf16x8*)(lds + PG8_SB(b, h) + boff + n * 2048 + k * 1024); } while (0)
#define PG8_MMA(ai, bj, At, Bt) do { __builtin_amdgcn_s_setprio(1); _Pragma("unroll") for (int m = 0; m < 4; ++m) _Pragma("unroll") for (int n = 0; n < 2; ++n) _Pragma("unroll") for (int k = 0; k < 2; ++k) \
        acc[ai][bj][m][n] = __builtin_amdgcn_mfma_f32_16x16x32_bf16(Bt[n][k], At[m][k], acc[ai][bj][m][n], 0, 0, 0); __builtin_amdgcn_s_setprio(0); } while (0)
#define PG8_WAIT_V(n) asm volatile("s_waitcnt vmcnt(" #n ")" ::: "memory")
#define PG8_WAIT_L(n) asm volatile("s_waitcnt lgkmcnt(" #n ")" ::: "memory")
#define PG8_BAR __builtin_amdgcn_s_barrier()
#define PG8_SCHED __builtin_amdgcn_sched_barrier(0)
    Unit cur, nxt; int ui = 0;
    if (!S.next(0, cur)) return;
    f32x4 acc[2][2][4][2];
#pragma unroll
    for (int a = 0; a < 2; ++a)
#pragma unroll
        for (int b = 0; b < 2; ++b)
#pragma unroll
            for (int m = 0; m < 4; ++m)
#pragma unroll
                for (int n = 0; n < 2; ++n) acc[a][b][m][n] = (f32x4){0.f, 0.f, 0.f, 0.f};
    bf16x8 At[4][2], B0[2][2], B1[2][2];
    const char* cA = (const char*)g.A + (size_t)cur.pm * tstep; const char* cB = (const char*)g.Bt + (size_t)cur.pn * tstep;
    S.a_ready(cur);
    if constexpr (SP2) {
        PG8_STAGE(PG8_SB(0, 0), cB, voffB); PG8_STAGE(PG8_SB(0, 1), cB + hstep, voffB); PG8_STAGE(PG8_SA(0, 0), cA, voffA); PG8_STAGE(PG8_SA(0, 1), cA + hstep, voffA);
        if (wr == 1) PG8_BAR;
        PG8_WAIT_V(2); PG8_BAR;
        PG8_STAGE(PG8_SB(1, 0), cB + kstep, voffB); PG8_STAGE(PG8_SA(1, 0), cA + kstep, voffA); PG8_STAGE(PG8_SB(1, 1), cB + hstep + kstep, voffB);
        PG8_WAIT_V(6); PG8_BAR;
    } else {
        PG8_STAGE(PG8_SB(0, 0), cB, voffB); PG8_STAGE(PG8_SA(0, 0), cA, voffA); PG8_STAGE(PG8_SB(0, 1), cB + hstep, voffB); PG8_STAGE(PG8_SA(0, 1), cA + hstep, voffA);
        if (wr == 1) PG8_BAR;
        PG8_WAIT_V(4); PG8_BAR;
        PG8_STAGE(PG8_SB(1, 0), cB + kstep, voffB); PG8_STAGE(PG8_SA(1, 0), cA + kstep, voffA); PG8_STAGE(PG8_SB(1, 1), cB + hstep + kstep, voffB);
        PG8_WAIT_V(6); PG8_BAR;
    }
    for (;;) {
        const bool has_next = S.next(ui + 1, nxt);
        const char* nA = has_next ? (const char*)g.A + (size_t)nxt.pm * tstep : cA; const char* nB = has_next ? (const char*)g.Bt + (size_t)nxt.pn * tstep : cB;
        for (int t = 0; t < nt; t += 2) {
            const bool last = (t == nt - 2);
            const char* a1 = cA + (size_t)(t + 1) * kstep;
            const char* a2 = last ? nA : cA + (size_t)(t + 2) * kstep; const char* b2 = last ? nB : cB + (size_t)(t + 2) * kstep;
            const char* a3 = a2 + kstep; const char* b3 = b2 + kstep;
            if (last && has_next) S.a_ready(nxt);
            if constexpr (SP2) {
            PG8_LDB(B0, 0, 0); PG8_LDB(B1, 0, 1); PG8_SCHED; PG8_LDA(At, 0, 0); PG8_STAGE(PG8_SA(1, 1), a1 + hstep, voffA);
            PG8_WAIT_V(8); PG8_WAIT_L(0); PG8_BAR; PG8_MMA(0, 0, At, B0); PG8_MMA(0, 1, At, B1); PG8_BAR; PG8_SCHED;
            PG8_LDA(At, 0, 1); PG8_STAGE(PG8_SB(0, 0), b2, voffB); PG8_STAGE(PG8_SB(0, 1), b2 + hstep, voffB); PG8_STAGE(PG8_SA(0, 0), a2, voffA);
            PG8_WAIT_V(8); PG8_WAIT_L(0); PG8_BAR; PG8_MMA(1, 0, At, B0); PG8_MMA(1, 1, At, B1); PG8_BAR; PG8_SCHED;
            PG8_LDB(B0, 1, 0); PG8_LDB(B1, 1, 1); PG8_SCHED; PG8_LDA(At, 1, 0); PG8_STAGE(PG8_SA(0, 1), a2 + hstep, voffA);
            PG8_WAIT_V(8); PG8_WAIT_L(0); PG8_BAR; PG8_MMA(0, 0, At, B0); PG8_MMA(0, 1, At, B1); PG8_BAR; PG8_SCHED;
            PG8_LDA(At, 1, 1); PG8_STAGE(PG8_SB(1, 0), b3, voffB); PG8_STAGE(PG8_SB(1, 1), b3 + hstep, voffB); PG8_STAGE(PG8_SA(1, 0), a3, voffA);
            PG8_WAIT_V(8); PG8_WAIT_L(0); PG8_BAR; PG8_MMA(1, 0, At, B0); PG8_MMA(1, 1, At, B1); PG8_BAR; PG8_SCHED;
            } else {
            PG8_LDB(B0, 0, 0); PG8_SCHED; PG8_LDA(At, 0, 0); PG8_STAGE(PG8_SA(1, 1), a1 + hstep, voffA);
            PG8_WAIT_L(8); PG8_BAR; PG8_WAIT_L(0); PG8_MMA(0, 0, At, B0); PG8_BAR; PG8_SCHED;
            PG8_LDB(B1, 0, 1); PG8_STAGE(PG8_SB(0, 0), b2, voffB);
            PG8_BAR; PG8_WAIT_L(0); PG8_MMA(0, 1, At, B1); PG8_BAR;
            PG8_LDA(At, 0, 1); PG8_STAGE(PG8_SA(0, 0), a2, voffA);
            PG8_BAR; PG8_WAIT_L(0); PG8_MMA(1, 0, At, B0); PG8_BAR; PG8_SCHED;
            PG8_STAGE(PG8_SB(0, 1), b2 + hstep, voffB);
            PG8_WAIT_V(6); PG8_BAR; PG8_MMA(1, 1, At, B1); PG8_BAR;
            PG8_LDB(B0, 1, 0); PG8_SCHED; PG8_LDA(At, 1, 0); PG8_STAGE(PG8_SA(0, 1), a2 + hstep, voffA);
            PG8_WAIT_L(8); PG8_BAR; PG8_WAIT_L(0); PG8_MMA(0, 0, At, B0); PG8_BAR; PG8_SCHED;
            PG8_LDB(B1, 1, 1); PG8_STAGE(PG8_SB(1, 0), b3, voffB);
            PG8_BAR; PG8_WAIT_L(0); PG8_MMA(0, 1, At, B1); PG8_BAR;
            PG8_LDA(At, 1, 1); PG8_STAGE(PG8_SA(1, 0), a3, voffA);
            PG8_BAR; PG8_WAIT_L(0); PG8_MMA(1, 0, At, B0); PG8_BAR; PG8_SCHED;
            PG8_STAGE(PG8_SB(1, 1), b3 + hstep, voffB);
            PG8_WAIT_V(6); PG8_BAR; PG8_MMA(1, 1, At, B1); PG8_BAR;
            }
        }
        if constexpr (ALIGN_EPI) { if (wr == 0) PG8_BAR; }
        if constexpr (!Epi::AFTER_DRAIN) { E(acc, cur, wr, wc, fr, fq); S.done(cur); }
        if (!has_next) break;
#pragma unroll
        for (int a = 0; a < 2; ++a)
#pragma unroll
            for (int b = 0; b < 2; ++b)
#pragma unroll
                for (int m = 0; m < 4; ++m)
#pragma unroll
                    for (int n = 0; n < 2; ++n) acc[a][b][m][n] = (f32x4){0.f, 0.f, 0.f, 0.f};
        cur = nxt; cA = nA; cB = nB; ++ui;
        if constexpr (ALIGN_EPI) { if (wr == 1) PG8_BAR; }
    }
    PG8_WAIT_V(0);
    if constexpr (!ALIGN_EPI) { if (wr == 0) PG8_BAR; }
    PG8_BAR;
    if constexpr (Epi::AFTER_DRAIN) { E.fused(acc, cur, wr, wc, fr, fq, lds, wid, lane); S.done(cur); }
#undef PG8_SA
#undef PG8_SB
#undef PG8_STAGE
#undef PG8_LDA
#undef PG8_LDB
#undef PG8_MMA
#undef PG8_WAIT_V
#undef PG8_WAIT_L
#undef PG8_BAR
#undef PG8_SCHED
}
}

namespace moba {
using bf16 = unsigned short;
typedef short bf16x8 __attribute__((ext_vector_type(8)));
typedef short s16x4 __attribute__((ext_vector_type(4)));
typedef float f32x16 __attribute__((ext_vector_type(16)));
typedef float f32x4 __attribute__((ext_vector_type(4)));
typedef unsigned u32x4 __attribute__((ext_vector_type(4)));
#define MLAS __attribute__((address_space(3)))
typedef MLAS char lchar; typedef MLAS float lfloat; typedef MLAS bf16x8 lbf16x8;
template <class A, class Bt> struct same_t { static constexpr bool v = false; };
template <class A> struct same_t<A, A> { static constexpr bool v = true; };
constexpr int D = 128, LDI = 6656, LDO = 2048;
constexpr float THR = 8.f;
constexpr bool WSKIP = false;
constexpr float SCALE = 0.08838834764831845f;
constexpr int NW = 8, QBLK = 32, KVBLK = 64, QB = NW * QBLK;
constexpr int SHM_V = KVBLK * D * 2, SHM_K = KVBLK * D * 2;
constexpr int LDS_BYTES = 2 * SHM_V + 2 * SHM_K + NW * 64 * 4;
#define KSWZ(row, colB) ((row) * 256 + ((colB) ^ (((row) & 7) << 4)))
#define SBAR() __builtin_amdgcn_sched_barrier(0)
__device__ __forceinline__ int v_st(int k, int c) { const int kk = (k & ~0xC) | ((k & 4) << 1) | ((k & 8) >> 1); return ((kk >> 3) * 4 + (c >> 5)) * 512 + ((kk & 7) * 32 + (c & 31)) * 2; }
__device__ __forceinline__ int v_rd_base(int lane) { return ((lane & 3) << 3) | (((lane >> 2) & 3) << 6) | (((lane >> 4) & 1) << 5) | (((lane >> 5) & 1) << 8); }
constexpr int v_rd_off(int d0, int ks, int half) { return d0 * 512 + ks * 4096 + half * 2048; }
__device__ __forceinline__ int crow(int r, int hi) { return (r & 3) + 8 * (r >> 2) + 4 * hi; }
__device__ __forceinline__ unsigned cvtpk(float lo, float hi) {
    unsigned r; asm volatile("v_cvt_pk_bf16_f32 %0, %1, %2" : "=v"(r) : "v"(lo), "v"(hi)); return r;
}
__device__ __forceinline__ bf16x8 pack8(f32x4 a, f32x4 b) {
    u32x4 w = {cvtpk(a[0], a[1]), cvtpk(a[2], a[3]), cvtpk(b[0], b[1]), cvtpk(b[2], b[3])};
    return *reinterpret_cast<bf16x8*>(&w);
}
template <class T> __device__ __forceinline__ bf16x8 load8(const T* p) {
    if constexpr (same_t<T, float>::v) { return pack8(*(const f32x4*)p, *(const f32x4*)(p + 4)); }
    else { return *reinterpret_cast<const bf16x8*>(p); }
}
__device__ __forceinline__ void mask_tile(f32x16& p0, f32x16& p1, int dq, unsigned W) {
    const float NEG = -__builtin_inff();
#pragma unroll
    for (int r = 0; r < 16; ++r) {
        const int c = (r & 3) + 8 * (r >> 2);
        if ((unsigned)(dq - c) >= W) p0[r] = NEG;
        if ((unsigned)(dq - c - 32) >= W) p1[r] = NEG;
    }
}
__device__ __forceinline__ void partialSM(f32x16& p0, f32x16& p1, float& m_reg, float& mn, float& alpha) {
    float pmax = p0[0]; for (int r = 1; r < 16; ++r) pmax = fmaxf(pmax, p0[r]); for (int r = 0; r < 16; ++r) pmax = fmaxf(pmax, p1[r]);
    { auto rr = __builtin_amdgcn_permlane32_swap(__float_as_uint(pmax), __float_as_uint(pmax), false, false);
      pmax = fmaxf(__uint_as_float(rr[0]), __uint_as_float(rr[1])); }
    constexpr float C2 = 1.4426950408889634f * SCALE;
    if (__builtin_expect(__all((pmax - m_reg) * SCALE <= THR), 1)) { mn = m_reg; alpha = 1.f; }
    else { mn = fmaxf(m_reg, pmax); alpha = __builtin_amdgcn_exp2f((m_reg - mn) * C2); m_reg = mn; }
    const float mnL = -mn * C2;
    for (int r = 0; r < 16; ++r) p0[r] = fmaf(p0[r], C2, mnL); for (int r = 0; r < 16; ++r) p1[r] = fmaf(p1[r], C2, mnL);
    for (int r = 0; r < 16; ++r) p0[r] = __builtin_amdgcn_exp2f(p0[r]);
}
__device__ __forceinline__ void finishSM(f32x16& p0, f32x16& p1, float alpha, float& l_reg, bf16x8& pa0, bf16x8& pa1, bf16x8& pa2, bf16x8& pa3) {
    for (int r = 0; r < 16; ++r) p1[r] = __builtin_amdgcn_exp2f(p1[r]);
    float ps = 0; for (int r = 0; r < 16; ++r) ps += p0[r]; for (int r = 0; r < 16; ++r) ps += p1[r];
    { auto rr = __builtin_amdgcn_permlane32_swap(__float_as_uint(ps), __float_as_uint(ps), false, false);
      ps = __uint_as_float(rr[0]) + __uint_as_float(rr[1]); }
    l_reg = l_reg * alpha + ps;
#define PK4(P, B_, OUT) do { unsigned a0 = cvtpk(P[B_+0], P[B_+1]), a1 = cvtpk(P[B_+2], P[B_+3]);                          \
        unsigned b0 = cvtpk(P[B_+4], P[B_+5]), b1 = cvtpk(P[B_+6], P[B_+7]);                                             \
        auto r0 = __builtin_amdgcn_permlane32_swap(a0, b0, false, false); auto r1 = __builtin_amdgcn_permlane32_swap(a1, b1, false, false); \
        u32x4 w = {r0[0], r1[0], r0[1], r1[1]}; OUT = *reinterpret_cast<bf16x8*>(&w); } while (0)
    PK4(p0, 0, pa0); PK4(p0, 8, pa1); PK4(p1, 0, pa2); PK4(p1, 8, pa3);
#undef PK4
}
template <int KB, bool SK>
__device__ __forceinline__ void qkt(f32x16& p0, f32x16& p1, const lchar* K_lds, int r32, int hi, const bf16x8* qr, bool act, float slopeR, float lb) {
    if (SK && !act) { const float NEG = -__builtin_inff();
#pragma unroll
        for (int r = 0; r < 16; ++r) { p0[r] = NEG; p1[r] = NEG; } return; }
#pragma unroll
    for (int r = 0; r < 16; ++r) { const int c = (r & 3) + 8 * (r >> 2); p0[r] = __builtin_fmaf(slopeR, (float)c, lb); p1[r] = __builtin_fmaf(slopeR, (float)(c + 32), lb); }
    const lchar* kb[4];
#pragma unroll
    for (int dd = 0; dd < 4; ++dd) kb[dd] = K_lds + KB * SHM_K + KSWZ(r32, (dd * 16 + hi * 8) * 2);
#pragma unroll
    for (int d0 = 0; d0 < 8; ++d0) { const lchar* a = kb[d0 & 3] + (d0 >> 2) * 128;
        bf16x8 b0 = *(const lbf16x8*)(a);
        bf16x8 b1 = *(const lbf16x8*)(a + 32 * 256);
        p0 = __builtin_amdgcn_mfma_f32_32x32x16_bf16(b0, qr[d0], p0, 0, 0, 0);
        p1 = __builtin_amdgcn_mfma_f32_32x32x16_bf16(b1, qr[d0], p1, 0, 0, 0); }
}
template <int VB, bool SK>
__device__ __forceinline__ void pv_tile(f32x16* o, int vb0, bf16x8 pa0, bf16x8 pa1, bf16x8 pa2, bf16x8 pa3, bool act) {
    if (SK && !act) return;
#define TRRD(dst, off) asm volatile("ds_read_b64_tr_b16 %0, %1 offset:%2" : "=&v"(dst) : "v"(vb0), "i"(off) : "memory")
#define PV_D0(d0) do { s16x4 l0, l1, l2, l3, h0, h1, h2, h3; constexpr int b_ = VB * SHM_V + v_rd_off(d0, 0, 0);     \
        TRRD(l0, b_); TRRD(h0, b_ + 2048); TRRD(l1, b_ + 4096); TRRD(h1, b_ + 6144); TRRD(l2, b_ + 8192); TRRD(h2, b_ + 10240); TRRD(l3, b_ + 12288); TRRD(h3, b_ + 14336); \
        asm volatile("s_waitcnt lgkmcnt(0)" ::: "memory"); SBAR();                 \
        o[d0] = __builtin_amdgcn_mfma_f32_32x32x16_bf16(pa0, (bf16x8){l0[0], l0[1], l0[2], l0[3], h0[0], h0[1], h0[2], h0[3]}, o[d0], 0, 0, 0);   \
        o[d0] = __builtin_amdgcn_mfma_f32_32x32x16_bf16(pa1, (bf16x8){l1[0], l1[1], l1[2], l1[3], h1[0], h1[1], h1[2], h1[3]}, o[d0], 0, 0, 0);   \
        o[d0] = __builtin_amdgcn_mfma_f32_32x32x16_bf16(pa2, (bf16x8){l2[0], l2[1], l2[2], l2[3], h2[0], h2[1], h2[2], h2[3]}, o[d0], 0, 0, 0);   \
        o[d0] = __builtin_amdgcn_mfma_f32_32x32x16_bf16(pa3, (bf16x8){l3[0], l3[1], l3[2], l3[3], h3[0], h3[1], h3[2], h3[3]}, o[d0], 0, 0, 0); } while (0)
    PV_D0(0); PV_D0(1); PV_D0(2); PV_D0(3);
#undef PV_D0
#undef TRRD
}

typedef __attribute__((address_space(1))) char gchar; typedef __attribute__((address_space(1))) bf16x8 gbf16x8;
__device__ __forceinline__ const gchar* uni_ptr(const char* p) { const unsigned long long v = (unsigned long long)p;
    const unsigned lo = __builtin_amdgcn_readfirstlane((unsigned)v), hi = __builtin_amdgcn_readfirstlane((unsigned)(v >> 32)); return (const gchar*)(((unsigned long long)hi << 32) | lo); }
template <class TIn, class TOut> struct BlockRef { const TIn* Q; const TIn* K; const TIn* V; TOut* O; int P0; const __attribute__((address_space(3))) unsigned* sel; float slopeR; };
template <class TIn> struct Seam {
    bf16x8 qr[8];
    bf16x8 st_v0, st_v1, st_k0, st_k1; f32x4 sf0, sf1, sf2, sf3;
    f32x4 tq[16];
};
__device__ __forceinline__ int swa_jlo(int P0, int W) { const int lowk = P0 - W + 1; return lowk > 0 ? lowk / KVBLK : 0; }
#define ROW(p, k0, rr) ((const TIn*)((const char*)(p) + (size_t)(k0) * (LDI * sizeof(TIn)) + (unsigned)(((rr) * LDI + sc) * (int)sizeof(TIn))))
#define VMW() asm volatile("s_waitcnt vmcnt(0)" ::: "memory")
#define VMWN(n) asm volatile("s_waitcnt vmcnt(%0)" :: "i"(n) : "memory")
#define SLOAD_H(Kp, Vp, k0) do { const gchar* kb__ = uni_ptr((const char*)(Kp) + (size_t)(k0) * (LDI * sizeof(TIn))); const gchar* vb__ = uni_ptr((const char*)(Vp) + (size_t)(k0) * (LDI * sizeof(TIn))); \
                         S.st_v0 = *(const gbf16x8*)(vb__ + roff0); S.st_v1 = *(const gbf16x8*)(vb__ + roff1);              \
                         S.st_k0 = *(const gbf16x8*)(kb__ + roff0); S.st_k1 = *(const gbf16x8*)(kb__ + roff1); } while (0)
#define SWRITE_HK(bf) do { *(lbf16x8*)(K_lds + (bf) * SHM_K + kws) = S.st_k0; *(lbf16x8*)(K_lds + (bf) * SHM_K + kws + 32 * 256) = S.st_k1; } while (0)
#define SWRITE_HV(bf) do { *(lbf16x8*)(V_lds + (bf) * SHM_V + vst0) = S.st_v0; *(lbf16x8*)(V_lds + (bf) * SHM_V + vst1) = S.st_v1; } while (0)
#define SWRITE_H(bf) do { SWRITE_HV(bf); SWRITE_HK(bf); } while (0)
#define SLOAD_F(p, k0) do { S.sf0 = *(const f32x4*)ROW(p, k0, sr); S.sf1 = *(const f32x4*)(ROW(p, k0, sr) + 4);                \
                            S.sf2 = *(const f32x4*)ROW(p, k0, 32 + sr); S.sf3 = *(const f32x4*)(ROW(p, k0, 32 + sr) + 4); } while (0)
#define SWRITE_KF(bf) do { *(lbf16x8*)(K_lds + (bf) * SHM_K + kws) = pack8(S.sf0, S.sf1); *(lbf16x8*)(K_lds + (bf) * SHM_K + kws + 32 * 256) = pack8(S.sf2, S.sf3); } while (0)
#define SWRITE_VF(bf) do { *(lbf16x8*)(V_lds + (bf) * SHM_V + vst0) = pack8(S.sf0, S.sf1); *(lbf16x8*)(V_lds + (bf) * SHM_V + vst1) = pack8(S.sf2, S.sf3); } while (0)
template <class TIn, class TOut>
__device__ __forceinline__ void causal_swa_prime(const BlockRef<TIn, TOut>& cur, int W, lchar* lds, Seam<TIn>& S, int wave_) {
    constexpr bool F32 = same_t<TIn, float>::v;
    const int tid_ = tid_from_wave(wave_);
    const int tid = tid_, wid = __builtin_amdgcn_readfirstlane(tid >> 6), lane = tid & 63, r32 = lane & 31, hi = lane >> 5;
    const int sr = tid >> 4, sc = (tid & 15) * 8, kws = KSWZ(sr, sc * 2); lchar* K_lds = lds + 2 * SHM_V;
    const unsigned roff0 = (unsigned)((sr * LDI + sc) * (int)sizeof(TIn)), roff1 = (unsigned)(((32 + sr) * LDI + sc) * (int)sizeof(TIn));
    const int kb0 = ((cur.P0 + QB - 1) / KVBLK) * KVBLK;
    for (int d0 = 0; d0 < 8; ++d0) S.qr[d0] = *(const gbf16x8*)(uni_ptr((const char*)cur.Q) + (unsigned)(((wid * QBLK + r32) * LDI + hi * 8) * (int)sizeof(TIn)) + d0 * 16 * sizeof(TIn));
    if constexpr (F32) { SLOAD_F((const float*)cur.K, kb0); VMW(); SWRITE_KF(0); SBAR(); SLOAD_F((const float*)cur.V, kb0); }
    else { SLOAD_H(cur.K, cur.V, kb0); VMW(); SWRITE_HK(0); }
    __syncthreads();
}
template <class TIn, class TOut>
__device__ __forceinline__ void causal_swa_block(const BlockRef<TIn, TOut>& cur, const BlockRef<TIn, TOut>& nxt, int skv, int W, lchar* lds, Seam<TIn>& S, int wave_) {
    constexpr bool F32 = same_t<TIn, float>::v;
    const int tid_ = tid_from_wave(wave_);
    const int tid = tid_, wid = __builtin_amdgcn_readfirstlane(tid >> 6), lane = tid & 63, r32 = lane & 31, hi = lane >> 5;
    const int j_lo = swa_jlo(cur.P0, W);
    int j_hi = (cur.P0 + QB - 1) / KVBLK + 1; if (j_hi > skv / KVBLK) j_hi = skv / KVBLK;
    const int NT = j_hi - j_lo;
    const int kbn = ((nxt.P0 + QB - 1) / KVBLK) * KVBLK;
    const unsigned selm = cur.sel[wid * QBLK + r32] | (1u << (cur.P0 >> 8)); const float slopeR = __builtin_bit_cast(float, __builtin_amdgcn_readfirstlane(__builtin_bit_cast(unsigned, cur.slopeR))); const int tqm = cur.P0 + wid * QBLK + r32 - 4 * hi;
#define LB(t) (((selm >> (KBASE(t) >> 8)) & 1u) ? slopeR * (float)(KBASE(t) - tqm) : -__builtin_inff())
    const int qlo = cur.P0 + wid * QBLK, qm = qlo + r32 - 4 * hi;
    lchar* V_lds = lds; lchar* K_lds = lds + 2 * SHM_V;
    lfloat* ws = (lfloat*)(lds + 2 * SHM_V + 2 * SHM_K) + wid * 64; lfloat* li_l = ws; lfloat* al_l = ws + 32;
    float m_reg = -1e30f, l_reg = 0; f32x16 o[4] = {};
    const unsigned roff0 = (unsigned)(((tid >> 4) * LDI + (tid & 15) * 8) * (int)sizeof(TIn)), roff1 = (unsigned)(((32 + (tid >> 4)) * LDI + (tid & 15) * 8) * (int)sizeof(TIn));
    const int sr = tid >> 4, sc = (tid & 15) * 8, vst0 = v_st(sr, sc), vst1 = v_st(32 + sr, sc), kws = KSWZ(sr, sc * 2);
    const int vb0 = (int)(unsigned)(uintptr_t)V_lds + v_rd_base(lane);
    const TIn* Kh = cur.K; const TIn* Vh = cur.V;
#define RESC(a) do { if (__any((a) < 1.f)) { if (hi == 0) al_l[r32] = (a); asm volatile("s_waitcnt lgkmcnt(0)" ::: "memory");              \
                     for (int d_ = 0; d_ < 4; ++d_) for (int r = 0; r < 16; ++r) o[d_][r] *= al_l[crow(r, hi)]; } } while (0)
#define KBASE(t) ((j_hi - 1 - (t)) * KVBLK)
#define ACT(t) (KBASE(t) <= qlo + QBLK - 1 && KBASE(t) + KVBLK - 1 >= qlo - W + 1)
#define MASKT(P0_, P1_, t) do { const int kb_ = KBASE(t); if ((!SK || ACT(t)) && (kb_ + KVBLK - 1 > qlo || kb_ <= qlo + QBLK - 1 - W)) mask_tile(P0_, P1_, qm - kb_, (unsigned)W); } while (0)
    constexpr int NQL = F32 ? 16 : 8;
    constexpr bool SK = WSKIP && !F32;
#define SEAM_K0() do { VMWN(NQL); if constexpr (F32) { SWRITE_KF(0); SBAR(); SLOAD_F((const float*)nxt.V, kbn); } else { SWRITE_HK(0); } SBAR(); } while (0)
    unsigned touch_reg = 0u; const int tl_ = wid * 32 + (lane & 31);
    const unsigned toff = (unsigned)(((tl_ & 127) >> 1) * LDI * (int)sizeof(TIn) + (tl_ & 1) * 128);
    const gchar* tbase = uni_ptr((const char*)((tl_ >> 7) ? (const void*)Vh : (const void*)Kh));
#if MOBA_CHECK
#define TOUCH(k0) do {} while (0)
#else
#define TOUCH(k0) do { const gchar* tp_ = tbase + (size_t)(k0) * (LDI * sizeof(TIn)) + toff; asm volatile("global_load_dword %0, %1, off" : "+v"(touch_reg) : "v"(tp_) : "memory"); } while (0)
#endif
    f32x16 pA0, pA1, pB0, pB1; float mnA, mnB, alA, alB; bf16x8 pa0, pa1, pa2, pa3;
    if constexpr (F32) { VMW(); SWRITE_VF(0); SBAR(); } else { SWRITE_HV(0); SBAR(); }
    if (NT > 1) { if constexpr (F32) SLOAD_F((const float*)Kh, KBASE(1)); else SLOAD_H(Kh, Vh, KBASE(1)); }
    SBAR(); qkt<0, SK>(pA0, pA1, K_lds, r32, hi, S.qr, ACT(0), slopeR, LB(0));
    if constexpr (F32) { if (NT > 1) { VMW(); SWRITE_KF(1); SBAR(); SLOAD_F((const float*)Vh, KBASE(1)); } }
    MASKT(pA0, pA1, 0); partialSM(pA0, pA1, m_reg, mnA, alA);
    if (NT > 1) { VMW(); if constexpr (F32) { SWRITE_VF(1); SBAR(); if (NT > 2) SLOAD_F((const float*)Kh, KBASE(2)); } else SWRITE_H(1); }
    __syncthreads();
#define HALF_STEP(PX0, PX1, mnX, alX, PY0, PY1, alY, t, KB, VB, SB) do {                                                      \
        SBAR(); qkt<KB, SK>(PX0, PX1, K_lds, r32, hi, S.qr, ACT(t), slopeR, LB(t));                                             \
        finishSM(PY0, PY1, alY, l_reg, pa0, pa1, pa2, pa3); SBAR();                                                           \
        if ((t) + 1 < NT) { if constexpr (F32) { VMW(); SWRITE_KF(SB); SBAR(); SLOAD_F((const float*)Vh, KBASE((t) + 1)); }  \
                            else { SLOAD_H(Kh, Vh, KBASE((t) + 1)); } SBAR(); }                                               \
        pv_tile<VB, SK>(o, vb0, pa0, pa1, pa2, pa3, ACT((t) - 1)); MASKT(PX0, PX1, (t)); partialSM(PX0, PX1, m_reg, mnX, alX);                                        \
        __syncthreads();                                                                                                      \
        if ((t) + 1 < NT) { VMW(); if constexpr (F32) { SWRITE_VF(SB); SBAR(); if ((t) + 2 < NT) SLOAD_F((const float*)Kh, KBASE((t) + 2)); } \
                            else { SWRITE_H(SB); } }                                                                          \
        if ((t) + 3 < NT) { TOUCH(KBASE((t) + 3)); }                                                                          \
        RESC(alX); __syncthreads(); } while (0)
    for (int t = 1; t + 1 < NT; t += 2) {
        HALF_STEP(pB0, pB1, mnB, alB, pA0, pA1, alA, t, 1, 0, 0);
        HALF_STEP(pA0, pA1, mnA, alA, pB0, pB1, alB, t + 1, 0, 1, 1);
    }
    const bool even = (NT & 1) == 0;
    if (even) { SBAR(); qkt<1, SK>(pB0, pB1, K_lds, r32, hi, S.qr, ACT(NT - 1), slopeR, LB(NT - 1)); SBAR(); }
#define QROW(e) (nxt.Q + (size_t)(wid * QBLK + r32) * LDI + ((e) >> 1) * 16 + hi * 8 + ((e) & 1) * 4)
    if constexpr (F32) { SLOAD_F((const float*)nxt.K, kbn); SBAR();
#pragma unroll
        for (int e = 0; e < 8; ++e) S.tq[e] = *(const f32x4*)QROW(e); }
    else { SLOAD_H(nxt.K, nxt.V, kbn); SBAR();
#pragma unroll
        for (int d0 = 0; d0 < 8; ++d0) S.qr[d0] = *(const gbf16x8*)(uni_ptr((const char*)nxt.Q) + (unsigned)(((wid * QBLK + r32) * LDI + hi * 8) * (int)sizeof(TIn)) + d0 * 16 * sizeof(TIn)); }
    SBAR();
    finishSM(pA0, pA1, alA, l_reg, pa0, pa1, pa2, pa3); SBAR();
    if constexpr (F32) {
#pragma unroll
        for (int e = 8; e < 16; ++e) S.tq[e] = *(const f32x4*)QROW(e); SBAR(); }
#undef QROW
    pv_tile<0, SK>(o, vb0, pa0, pa1, pa2, pa3, ACT(even ? NT - 2 : NT - 1));
    if (even) { MASKT(pB0, pB1, NT - 1); partialSM(pB0, pB1, m_reg, mnB, alB); __syncthreads(); RESC(alB);
        finishSM(pB0, pB1, alB, l_reg, pa0, pa1, pa2, pa3); SBAR(); pv_tile<1, SK>(o, vb0, pa0, pa1, pa2, pa3, ACT(NT - 1)); }
    SBAR(); SEAM_K0();
    if (hi == 0) li_l[r32] = l_reg; asm volatile("s_waitcnt lgkmcnt(0)" ::: "memory");
    float rli[16];
#pragma unroll
    for (int r = 0; r < 16; ++r) rli[r] = __builtin_amdgcn_rcpf(li_l[crow(r, hi)]);
    const gchar* Owb = uni_ptr((const char*)(cur.O + (size_t)(wid * QBLK) * LDO)); const unsigned ooff = (unsigned)((4 * hi * LDO + r32) * (int)sizeof(TOut));
#pragma unroll
    for (int r = 0; r < 16; ++r) { const int orc = (r & 3) + 8 * (r >> 2);
#pragma unroll
        for (int d0 = 0; d0 < 4; ++d0) { const float v = o[d0][r] * rli[r];
            if constexpr (same_t<TOut, float>::v) { *(__attribute__((address_space(1))) float*)((gchar*)(Owb) + ooff + (unsigned)((orc * LDO + d0 * 32) * (int)sizeof(TOut))) = v; }
            else { const float vn = __builtin_bit_cast(float, __builtin_amdgcn_update_dpp(0, __builtin_bit_cast(int, v), 0xB1, 0xF, 0xF, true));
                   if ((r32 & 1) == 0) *(__attribute__((address_space(1))) unsigned*)((gchar*)(Owb) + ooff + (unsigned)((orc * LDO + d0 * 32) * (int)sizeof(TOut))) = cvtpk(v, vn); } } }
    if constexpr (F32) {
#pragma unroll
        for (int d0 = 0; d0 < 8; ++d0) S.qr[d0] = pack8(S.tq[2 * d0], S.tq[2 * d0 + 1]); }
    __syncthreads();
    asm volatile("" :: "v"(touch_reg));
#undef TOUCH
#undef RESC
#undef LB
#undef KBASE
#undef ACT
#undef MASKT
#undef SEAM_K0
#undef HALF_STEP
}
#undef ROW
#undef VMW
#undef VMWN
#undef SLOAD_H
#undef SWRITE_HK
#undef SWRITE_HV
#undef SWRITE_H
#undef SLOAD_F
#undef SWRITE_KF
#undef SWRITE_VF
#undef KSWZ
#undef SBAR
}

constexpr int NWAVES = 8, NTHR = 512;
constexpr int DM = 2048, NB = 2, SEQ = 4096, MROWS = NB * SEQ, NLAYER = 2;
constexpr int IN_COLS = 6592, IN_PAD = 6656, DFF = 5632, UPC = 2 * DFF;
constexpr int C_RQ = 0, C_RK = 256, C_RV = 512, C_RG = 1024, C_RW = 1536, C_MQ = 3520, C_MK = 4544, C_MV = 5568;
constexpr int RWC = 1984;
constexpr float NORM_EPS = 1e-6f, GN_EPS = 64e-5f;
constexpr size_t MiB = 1u << 20;
constexpr size_t WS_CTL = 0, CTL_ZERO_BYTES = 1 * MiB;
constexpr size_t WS_MOD = 1 * MiB;
constexpr size_t WS_KMEAN = 1 * MiB + 512 * 1024;
constexpr size_t WS_W = 2 * MiB, W_LAYER = 100 * MiB, W_IN = 0, W_OUT = 26 * MiB, W_UP = 34 * MiB, W_DN = 78 * MiB;
constexpr size_t WS_X = 202 * MiB;
constexpr size_t WS_H = 266 * MiB;
constexpr size_t WS_PROJ = 298 * MiB;
constexpr size_t WS_ACT = WS_PROJ;
constexpr size_t WS_MIXED = 402 * MiB;
constexpr size_t WS_U = 434 * MiB;
constexpr size_t WS_HALO = WS_U;
constexpr size_t WS_RW = WS_U;
constexpr size_t WS_Y = WS_U + 128 * MiB;
constexpr size_t WS_RETO = WS_U + 144 * MiB;
constexpr size_t WS_REC = 610 * MiB;
constexpr size_t WS_RWW = 738 * MiB;
constexpr size_t WS_END = 739 * MiB;
constexpr size_t RWA = (size_t)MROWS * 512;
constexpr int CW_BAR = 4096, CW_SUB = 64;
constexpr int RING_BYTES = 131072, LDSCTL_OFF = RING_BYTES, MISC_OFF = LDSCTL_OFF + 320, LDS_BYTES = 147456;

#define GAS __attribute__((address_space(1)))
#define LAS __attribute__((address_space(3)))
typedef unsigned short bf16;
typedef unsigned v4u __attribute__((ext_vector_type(4)));
typedef unsigned v2u __attribute__((ext_vector_type(2)));
typedef float f32x4 __attribute__((ext_vector_type(4)));
typedef float f32x2 __attribute__((ext_vector_type(2)));
#define LDS_WAIT() asm volatile("s_waitcnt lgkmcnt(0)" ::: "memory")
__device__ __forceinline__ unsigned f2bf(float f) { unsigned u = __builtin_bit_cast(unsigned, f); return (u + 0x7fffu + ((u >> 16) & 1u)) >> 16; }
__device__ __forceinline__ unsigned pk2(float lo, float hi) { return f2bf(lo) | (f2bf(hi) << 16); }
__device__ __forceinline__ float bf2f(unsigned short h) { return __builtin_bit_cast(float, (unsigned)h << 16); }
__device__ __forceinline__ float bflo(unsigned w) { return __builtin_bit_cast(float, w << 16); }
__device__ __forceinline__ float bfhi(unsigned w) { return __builtin_bit_cast(float, w & 0xffff0000u); }
template <int CTRL> __device__ __forceinline__ float dpp_add(float v);
__device__ __forceinline__ float wave_sum(float v);
__device__ __forceinline__ float wave_max(float v) {
#pragma unroll
    for (int o = 1; o < 64; o <<= 1) v = fmaxf(v, __shfl_xor(v, o));
    return v;
}
template <int CTRL> __device__ __forceinline__ float dpp_add(float v) { return v + __builtin_bit_cast(float, __builtin_amdgcn_update_dpp(0, __builtin_bit_cast(int, v), CTRL, 0xF, 0xF, true)); }
__device__ __forceinline__ float xsum16(float v) { auto r = __builtin_amdgcn_permlane16_swap(__float_as_uint(v), __float_as_uint(v), false, false); return __uint_as_float(r[0]) + __uint_as_float(r[1]); }
__device__ __forceinline__ float xsum32(float v) { auto r = __builtin_amdgcn_permlane32_swap(__float_as_uint(v), __float_as_uint(v), false, false); return __uint_as_float(r[0]) + __uint_as_float(r[1]); }
__device__ __forceinline__ float wave_sum(float v) {
    v = dpp_add<0xB1>(v); v = dpp_add<0x4E>(v); v = dpp_add<0x141>(v); v = dpp_add<0x140>(v);
    return xsum32(xsum16(v));
}
__device__ __forceinline__ float sigmoidf_(float x) { return __builtin_amdgcn_rcpf(1.0f + __expf(-x)); }

#define XB_TMO      128
#define XB_XCNT(j)  (256  + 64 * (j))
#define XB_XSUB(j)  (1280 + 64 * (j))
#define XB_XGEN(j)  (2304 + 64 * (j))
#define XB_TOP      3328
#define XB_TOPGEN   3392
#define XCD_BAR_WORDS 3456
#define XB_SPIN_CAP (1u << 22)
__device__ __forceinline__ unsigned xb_ld(unsigned* p)              { return __hip_atomic_load(p, __ATOMIC_RELAXED, __HIP_MEMORY_SCOPE_AGENT); }
__device__ __forceinline__ unsigned xb_add(unsigned* p, unsigned v) { return __hip_atomic_fetch_add(p, v, __ATOMIC_RELAXED, __HIP_MEMORY_SCOPE_AGENT); }
__device__ __forceinline__ unsigned xb_xcc_id() { return (unsigned)__builtin_amdgcn_s_getreg((3 << 11) | 20) & 0xFu; }
#define XB_SPIN(cond, bar) do { unsigned _sp = 0; while (cond) { __builtin_amdgcn_s_sleep(1); \
    if ((++_sp & 255u) == 0u) { if (xb_ld(&(bar)[XB_TMO])) break; if (_sp > XB_SPIN_CAP) { atomicAdd(&(bar)[XB_TMO], 1u); break; } } } } while (0)
struct XcdBarrier { unsigned* bar; unsigned x; volatile LAS unsigned* st; };
__device__ __forceinline__ XcdBarrier xcd_barrier_post(unsigned* bar, volatile LAS unsigned* st, int tid) {
    XcdBarrier b; b.bar = bar; b.x = xb_xcc_id(); b.st = st;
    if (tid == 0) (void)xb_add(&bar[XB_XCNT(b.x)], 1u);
    return b;
}
__device__ __forceinline__ void xcd_barrier_complete(unsigned* bar, unsigned x, unsigned& nloc, unsigned& nx) {
    const unsigned G = gridDim.x * gridDim.y * gridDim.z;
    unsigned sum, cnt, mine, sp = 0u;
    for (;;) {
        sum = 0u; cnt = 0u; mine = 0u;
#pragma unroll
        for (unsigned j = 0; j < 16; ++j) { const unsigned c = xb_ld(&bar[XB_XCNT(j)]); sum += c; cnt += (c > 0u) ? 1u : 0u; mine = (j == x) ? c : mine; }
        if (sum == G) break;
        __builtin_amdgcn_s_sleep(1);
        if ((++sp & 255u) == 0u) { if (xb_ld(&bar[XB_TMO])) break; if (sp > XB_SPIN_CAP) { atomicAdd(&bar[XB_TMO], 1u); break; } }
    }
    nloc = mine > 0u ? mine : 1u; nx = cnt > 0u ? cnt : 1u;
}
__device__ __forceinline__ void xcd_barrier(const XcdBarrier& b, int tid) {
    asm volatile("s_waitcnt vmcnt(0)" ::: "memory");
    __syncthreads();
    if (tid == 0) {
        unsigned z_ = 0u; asm volatile("" : "+v"(z_)); z_ = (unsigned)__builtin_amdgcn_readfirstlane(z_);
        unsigned* bar = b.bar + z_; const unsigned bx_ = b.x + z_;
        __builtin_amdgcn_s_waitcnt(0);
        unsigned nloc = b.st[0], nx = b.st[1];
        if (nloc == 0u) { xcd_barrier_complete(bar, bx_, nloc, nx); b.st[0] = nloc; b.st[1] = nx; }
        const unsigned old = xb_add(&bar[XB_XSUB(bx_)], 1u);
        const unsigned gen = old / nloc;
        if (old + 1u == (gen + 1u) * nloc) {
            __builtin_amdgcn_fence(__ATOMIC_RELEASE, "agent");
            asm volatile("s_waitcnt vmcnt(0)" ::: "memory");
            const unsigned og = xb_add(&bar[XB_TOP], 1u);
            const unsigned tg = og / nx;
            if (og + 1u == (tg + 1u) * nx) xb_add(&bar[XB_TOPGEN], 1u);
            else XB_SPIN(xb_ld(&bar[XB_TOPGEN]) == tg, bar);
            __builtin_amdgcn_fence(__ATOMIC_ACQUIRE, "agent");
            xb_add(&bar[XB_XGEN(bx_)], 1u);
            asm volatile("s_waitcnt vmcnt(0)" ::: "memory");
        } else {
            XB_SPIN(xb_ld(&bar[XB_XGEN(bx_)]) == gen, bar);
            __builtin_amdgcn_fence(__ATOMIC_ACQUIRE, "agent");
            asm volatile("s_waitcnt vmcnt(0)" ::: "memory");
        }
    }
    __syncthreads();
}

struct Args { const float* in[24]; float* out; unsigned char* ws; };
struct Frame {
    LAS unsigned char* lds;
    int tid, lane, wave, vcu, G, zz;
    const float* const* in;
    unsigned char* ws;
};

#define FWS (F.ws + F.zz)
__device__ __forceinline__ void p0_transpose_item(const float* W, int K, int N, bf16* WT, LAS float* scr, int item, int lane, int half = 0) {
    const int nblk = N / 32, kb = item / nblk, nb = item % nblk, k0 = 64 * kb, n0 = 32 * nb;
    const int r0 = !half ? n0 : (n0 < half ? (n0 >> 7) * 256 + (n0 & 127) : ((n0 - half) >> 7) * 256 + 128 + ((n0 - half) & 127));
#pragma unroll 8
    for (int i = 0; i < 32; ++i) { const int kk = 2 * i + (lane >> 5); scr[kk * 33 + (lane & 31)] = W[(size_t)(k0 + kk) * N + n0 + (lane & 31)]; }
    LDS_WAIT(); asm volatile("" ::: "memory");
    const int c = lane & 7;
#pragma unroll
    for (int j = 0; j < 4; ++j) { const int n = (lane >> 3) + 8 * j; const LAS float* s = scr + (8 * c) * 33 + n;
        v4u o; o.x = pk2(s[0 * 33], s[1 * 33]); o.y = pk2(s[2 * 33], s[3 * 33]); o.z = pk2(s[4 * 33], s[5 * 33]); o.w = pk2(s[6 * 33], s[7 * 33]);
        *(v4u*)(WT + (size_t)(r0 + n) * K + k0 + 8 * c) = o; }
    LDS_WAIT(); asm volatile("" ::: "memory");
}
constexpr int CV_IN = (DM / 64) * (IN_COLS / 32), CV_OUT = (DM / 64) * (DM / 32), CV_UP = (DM / 64) * (UPC / 32), CV_DN = (DFF / 64) * (DM / 32), CV_LAYER = CV_IN + CV_OUT + CV_UP + CV_DN;
constexpr int CV_N1 = 10, CV_N2 = 6, CV_N3 = 4, CV_C1 = 192 * NWAVES * CV_N1, CV_C2 = 128 * NWAVES * CV_N2;
static_assert(CV_IN + CV_C1 <= CV_LAYER && CV_LAYER - (CV_IN + CV_C1) + (CV_IN - CV_C2) <= 128 * NWAVES * CV_N3 && CV_C2 <= CV_IN, "gap capacities");
__device__ __forceinline__ void convert_item(Frame& F, int it, LAS float* scr) {
    const int l = it / CV_LAYER; int r = it % CV_LAYER;
    unsigned char* wl = FWS + WS_W + (size_t)l * W_LAYER;
    if (r < CV_IN) { p0_transpose_item(F.in[F.zz + 2] + (size_t)l * DM * IN_COLS, DM, IN_COLS, (bf16*)(wl + W_IN), scr, r, F.lane); return; } r -= CV_IN;
    if (r < CV_OUT) { p0_transpose_item(F.in[F.zz + 3] + (size_t)l * DM * DM, DM, DM, (bf16*)(wl + W_OUT), scr, r, F.lane); return; } r -= CV_OUT;
    if (r < CV_UP) { p0_transpose_item(F.in[F.zz + 15] + (size_t)l * DM * UPC, DM, UPC, (bf16*)(wl + W_UP), scr, r, F.lane, DFF); return; } r -= CV_UP;
    p0_transpose_item(F.in[F.zz + 18] + (size_t)l * DFF * DM, DFF, DM, (bf16*)(wl + W_DN), scr, r, F.lane);
}
__device__ __forceinline__ void convert_gap(Frame& F, int layer, int first, int count, int gwi, int nwv, int nper) {
    LAS float* scr = (LAS float*)(F.lds + F.wave * 16384);
    for (int j = 0; j < nper; ++j) { const int r = gwi + nwv * j; if (r < count) convert_item(F, layer * CV_LAYER + first + r, scr); }
}
__device__ __forceinline__ void adaln_item(Frame& F, int l, int grp) {
    LAS float* cact = (LAS float*)F.lds;
    LAS float* red = (LAS float*)(F.lds + 16384);
    const float* c = F.in[F.zz + 1];
    for (int i = F.tid; i < 4096; i += NTHR) { const float cv = c[i]; cact[i] = cv / (1.0f + __expf(-cv)); }
    __syncthreads();
    const int n0 = grp * 128;
    const float* W = F.in[F.zz + 19] + (size_t)l * 2048 * 12288 + n0;
    const int half = F.lane >> 5, q = F.lane & 31;
    f32x4 a0 = {0.f, 0.f, 0.f, 0.f}, a1 = {0.f, 0.f, 0.f, 0.f};
#pragma unroll 16
    for (int i = 0; i < 128; ++i) { const int k = F.wave * 256 + 2 * i + half; const f32x4 w = *(const f32x4*)(W + (size_t)k * 12288 + 4 * q);
        a0 += w * cact[k]; a1 += w * cact[2048 + k]; }
#pragma unroll
    for (int e = 0; e < 4; ++e) { a0[e] = xsum32(a0[e]); a1[e] = xsum32(a1[e]); }
    if (half == 0) {
#pragma unroll
        for (int e = 0; e < 4; ++e) { red[(F.wave * 2 + 0) * 128 + 4 * q + e] = a0[e]; red[(F.wave * 2 + 1) * 128 + 4 * q + e] = a1[e]; } }
    __syncthreads();
    if (F.tid < 256) { const int bb = F.tid >> 7, col = F.tid & 127; float s = 0.f;
#pragma unroll
        for (int w = 0; w < 8; ++w) s += red[(w * 2 + bb) * 128 + col];
        s += F.in[F.zz + 20][l * 12288 + n0 + col];
        ((float*)(FWS + WS_MOD))[(size_t)(l * 2 + bb) * 12288 + n0 + col] = s; }
    __syncthreads();
}
__device__ __forceinline__ void p0_prologue(Frame& F) {
    const int ngv = (F.G == 256) ? 96 : 192;
    if (F.vcu < ngv) adaln_item(F, F.vcu / 96, F.vcu % 96);
    LAS float* scr = (LAS float*)(F.lds + F.wave * 16384);
    const int gw = F.vcu * NWAVES + F.wave, NGW = F.G * NWAVES;
    if (F.G == 256) { if (F.vcu >= 96) for (int p = gw - 96 * NWAVES; p < CV_IN; p += 160 * NWAVES) convert_item(F, p, scr); }
    else for (int p = gw; p < NLAYER * CV_LAYER; p += NGW) convert_item(F, p, scr);
    for (int l = 0; l < NLAYER; ++l) { bf16* wt = (bf16*)(FWS + WS_RWW + (size_t)l * 448 * 512 * 2);
        const float* wu = F.in[F.zz + 6] + (size_t)l * 96 * 512; const float* au = F.in[F.zz + 8] + (size_t)l * 96 * 512; const float* gu = F.in[F.zz + 9] + (size_t)l * 256 * 512;
        for (int i = F.vcu * NTHR + F.tid; i < 448 * 512; i += F.G * NTHR) {
            if (i < 96 * 512) { const int n = i / 96, kq = i - n * 96; wt[i] = (bf16)f2bf(wu[kq * 512 + n]); }
            else if (i < 2 * 96 * 512) { const int j = i - 96 * 512, n = j / 96, kq = j - n * 96; wt[i] = (bf16)f2bf(au[kq * 512 + n]); }
            else { const int j = i - 2 * 96 * 512, n = j >> 8, kq = j & 255; wt[i] = (bf16)f2bf(gu[kq * 512 + n]); } } }
    for (int l = 0; l < NLAYER; ++l) { v4u* z = (v4u*)(FWS + WS_W + (size_t)l * W_LAYER + W_IN + (size_t)IN_COLS * DM * 2);
        for (int i = F.vcu * NTHR + F.tid; i < (IN_PAD - IN_COLS) * DM * 2 / 16; i += F.G * NTHR) z[i] = (v4u){0u, 0u, 0u, 0u}; }
}

template <int MODE, bool IN_F32>
__device__ __forceinline__ void norm_phase(Frame& F, const void* xin, void* outp, const float* g, const float* sh, const float* sc) {
    LAS float* gs = (LAS float*)F.lds;
    LAS float* shs = (LAS float*)(F.lds + 16384);
    for (int i = F.tid; i < 4096; i += NTHR) { const int b = i >> 11, col = i & 2047;
        if (MODE == 0) { gs[i] = g[col] * (1.0f + sc[(size_t)b * 12288 + col]); shs[i] = sh[(size_t)b * 12288 + col]; }
        else { gs[i] = g[col]; shs[i] = 0.f; } }
    __syncthreads();
    const int gw = F.vcu * NWAVES + F.wave, NGW = F.G * NWAVES;
    for (int m = gw; m < MROWS; m += NGW) {
        const int b = m >> 12;
        f32x4 v[8]; float s = 0.f;
#pragma unroll
        for (int j = 0; j < 8; ++j) {
            if (IN_F32) v[j] = *((const f32x4*)((const float*)xin + (size_t)m * DM) + F.lane + 64 * j);
            else { const v2u w = *((const v2u*)((const bf16*)xin + (size_t)m * DM) + F.lane + 64 * j); v[j] = (f32x4){bflo(w.x), bfhi(w.x), bflo(w.y), bfhi(w.y)}; }
            s += (v[j].x * v[j].x + v[j].y * v[j].y) + (v[j].z * v[j].z + v[j].w * v[j].w); }
        float rstd = __builtin_amdgcn_rsqf(wave_sum(s) * (1.0f / DM) + NORM_EPS);
#if MOBA_CHECK
        if (MODE == 1) { const float sd = ((const float*)(FWS + WS_CTL))[8], sn = ((const float*)(FWS + WS_CTL))[9]; rstd *= 1.0f + 10.0f * sqrtf(sd / sn); }
#endif
#pragma unroll
        for (int j = 0; j < 8; ++j) { const int col = 4 * (F.lane + 64 * j);
            const f32x4 gg = *(const LAS f32x4*)(gs + b * 2048 + col), ss = *(const LAS f32x4*)(shs + b * 2048 + col);
            const f32x4 o = v[j] * rstd * gg + ss;
            if (MODE == 0) { v2u w; w.x = pk2(o.x, o.y); w.y = pk2(o.z, o.w); *(v2u*)((bf16*)outp + (size_t)m * DM + col) = w; }
            else *(f32x4*)((float*)outp + (size_t)m * DM + col) = o; }
    }
    __syncthreads();
}

__device__ __forceinline__ float lerp_bf(const bf16* P, size_t row, int col, bool hasprev, float mu) {
    const float cur = bf2f(P[row * IN_PAD + col]); const float prev = hasprev ? bf2f(P[(row - 1) * IN_PAD + col]) : 0.f;
    return cur + (prev - cur) * mu;
}
__device__ __forceinline__ void rwkv_prep(Frame& F, int l) {
    LAS float* codes = (LAS float*)F.lds;
    const bf16* P = (const bf16*)(FWS + WS_PROJ);
    const float* mu = F.in[F.zz + 4] + l * RWC; const float* w0 = F.in[F.zz + 5] + l * 512; const float* w_up = F.in[F.zz + 6] + (size_t)l * 96 * 512;
    const float* a0 = F.in[F.zz + 7] + l * 512; const float* a_up = F.in[F.zz + 8] + (size_t)l * 96 * 512; const float* g_up = F.in[F.zz + 9] + (size_t)l * 256 * 512;
    const float* k_k = F.in[F.zz + 10] + l * 512; const float* k_a = F.in[F.zz + 11] + l * 512; const float* r_k = F.in[F.zz + 12] + l * 512;
    float* RW = (float*)(FWS + WS_RW);
    const int c = F.tid;
    const float mur = mu[c], muk = mu[512 + c], muv = mu[1024 + c], w0c = w0[c], a0c = a0[c], kkc = k_k[c], kac = k_a[c], rkc = r_k[c];
    for (int item = F.vcu; item < MROWS / 8; item += F.G) {
        const int row0 = item * 8, t0 = row0 & (SEQ - 1);
        for (int idx = F.tid; idx < 8 * 448; idx += NTHR) { const int tk = idx / 448, cc = idx - tk * 448;
            float val = lerp_bf(P, (size_t)(row0 + tk), C_RW + 1536 + cc, (t0 + tk) > 0, mu[1536 + cc]);
            if (cc < 96) val = tanhf(val); else if (cc >= 192) val = sigmoidf_(val);
            codes[idx] = val; }
        __syncthreads();
        float wd[8], wa[8], gg[8];
#pragma unroll
        for (int tk = 0; tk < 8; ++tk) { wd[tk] = 0.f; wa[tk] = 0.f; gg[tk] = 0.f; }
        for (int r = 0; r < 96; ++r) { const float wu = w_up[r * 512 + c], au = a_up[r * 512 + c];
#pragma unroll
            for (int tk = 0; tk < 8; ++tk) { wd[tk] += codes[tk * 448 + r] * wu; wa[tk] += codes[tk * 448 + 96 + r] * au; } }
        for (int r = 0; r < 256; ++r) { const float gu = g_up[r * 512 + c];
#pragma unroll
            for (int tk = 0; tk < 8; ++tk) gg[tk] += codes[tk * 448 + 192 + r] * gu; }
#pragma unroll
        for (int tk = 0; tk < 8; ++tk) {
            const size_t row = (size_t)(row0 + tk); const bool hp = (t0 + tk) > 0;
            const float rr = lerp_bf(P, row, C_RW + c, hp, mur), kk0 = lerp_bf(P, row, C_RW + 512 + c, hp, muk), vv = lerp_bf(P, row, C_RW + 1024 + c, hp, muv);
            const float z = -(w0c + wd[tk]);
            const float sp = fmaxf(z, 0.f) + log1pf(__expf(-fabsf(z)));
            const float decay = __expf(-__expf(-sp - 0.5f));
            const float a = sigmoidf_(a0c + wa[tk]);
            const float kkv = kk0 * kkc;
            const float nrm = sqrtf(wave_sum(kkv * kkv));
            const float kap = kkv / fmaxf(nrm, 1e-12f);
            const float kp = kk0 * (1.0f + (a - 1.0f) * kac);
            const float bsum = wave_sum(rr * kp * rkc);
            const size_t o = row * 512 + c;
            RW[0 * RWA + o] = rr; RW[1 * RWA + o] = decay; RW[2 * RWA + o] = kp; RW[3 * RWA + o] = vv;
            RW[4 * RWA + o] = kap; RW[5 * RWA + o] = kap * a; RW[6 * RWA + o] = gg[tk]; RW[7 * RWA + o] = bsum * vv;
        }
        __syncthreads();
    }
}
__device__ __forceinline__ void moba_kmean(Frame& F) {
    LAS float* red = (LAS float*)(F.lds + 32768);
    const bf16* P = (const bf16*)(FWS + WS_PROJ);
    float* KM = (float*)(FWS + WS_KMEAN);
    for (int item = F.vcu; item < 256; item += F.G) {
        const int b = item >> 7, h = (item >> 4) & 7, n = item & 15;
        const int d = F.tid & 127, part = F.tid >> 7;
        const bf16* kp = P + (size_t)(b * SEQ + n * 256 + part * 64) * IN_PAD + C_MK + h * 128 + d;
        float s = 0.f;
        for (int k = 0; k < 64; ++k) s += bf2f(kp[(size_t)k * IN_PAD]);
        red[part * 128 + d] = s;
        __syncthreads();
        if (F.tid < 128) KM[(size_t)item * 128 + d] = (red[d] + red[128 + d] + red[256 + d] + red[384 + d]) * (1.0f / 256.0f);
        __syncthreads();
    }
}
struct RwIn { f32x4 w[2], kk[2], bb[2], k[2], r[2]; float v; };
__device__ __forceinline__ void rw_load(RwIn& x, const float* RW, size_t row, int cj, int ci) {
    const size_t o = row * 512;
    x.w[0] = *(const f32x4*)(RW + 1 * RWA + o + cj); x.w[1] = *(const f32x4*)(RW + 1 * RWA + o + cj + 4);
    x.kk[0] = *(const f32x4*)(RW + 4 * RWA + o + cj); x.kk[1] = *(const f32x4*)(RW + 4 * RWA + o + cj + 4);
    x.bb[0] = *(const f32x4*)(RW + 5 * RWA + o + cj); x.bb[1] = *(const f32x4*)(RW + 5 * RWA + o + cj + 4);
    x.k[0] = *(const f32x4*)(RW + 2 * RWA + o + cj); x.k[1] = *(const f32x4*)(RW + 2 * RWA + o + cj + 4);
    x.r[0] = *(const f32x4*)(RW + 0 * RWA + o + cj); x.r[1] = *(const f32x4*)(RW + 0 * RWA + o + cj + 4);
    x.v = RW[3 * RWA + o + ci];
}
__device__ __forceinline__ void rwkv_scan_naive(Frame& F, int b, int h) {
    const float* RW = (const float*)(FWS + WS_RW);
    float* Y = (float*)(FWS + WS_Y);
    const int i = F.tid >> 3, jp = F.tid & 7, cj = h * 64 + 8 * jp, ci = h * 64 + i;
    f32x4 s0 = {0.f, 0.f, 0.f, 0.f}, s1 = {0.f, 0.f, 0.f, 0.f};
    RwIn cur, n1, n2;
    const size_t rb = (size_t)b * SEQ;
    rw_load(cur, RW, rb, cj, ci); rw_load(n1, RW, rb + 1, cj, ci);
    for (int t = 0; t < SEQ; ++t) {
        rw_load(n2, RW, rb + (t + 2 < SEQ ? t + 2 : SEQ - 1), cj, ci);
        f32x4 pp = s0 * cur.kk[0] + s1 * cur.kk[1];
        float p = (pp.x + pp.y) + (pp.z + pp.w);
        p += __shfl_xor(p, 1); p += __shfl_xor(p, 2); p += __shfl_xor(p, 4);
        const float sa = -p;
        s0 = s0 * cur.w[0] + sa * cur.bb[0] + cur.v * cur.k[0];
        s1 = s1 * cur.w[1] + sa * cur.bb[1] + cur.v * cur.k[1];
        f32x4 yy = s0 * cur.r[0] + s1 * cur.r[1];
        float y = (yy.x + yy.y) + (yy.z + yy.w);
        y += __shfl_xor(y, 1); y += __shfl_xor(y, 2); y += __shfl_xor(y, 4);
        if (jp == 0) Y[(rb + t) * 512 + ci] = y;
        cur = n1; n1 = n2;
    }
}
struct RtIn { v4u q[2], k[2]; unsigned short v; };
__device__ __forceinline__ void rt_load(RtIn& x, const bf16* P, size_t row, int h, int d0, int v) {
    const bf16* p = P + row * IN_PAD;
    x.q[0] = *(const v4u*)(p + C_RQ + h * 64 + d0); x.q[1] = *(const v4u*)(p + C_RQ + h * 64 + d0 + 8);
    x.k[0] = *(const v4u*)(p + C_RK + h * 64 + d0); x.k[1] = *(const v4u*)(p + C_RK + h * 64 + d0 + 8);
    x.v = p[C_RV + h * 128 + v];
}
__device__ __forceinline__ void ret_scan_naive(Frame& F, int b, int h) {
    const bf16* P = (const bf16*)(FWS + WS_PROJ);
    float* RO = (float*)(FWS + WS_RETO);
    const int v = F.tid >> 2, dp = F.tid & 3, d0 = dp * 16;
    const float gamma = 1.0f - exp2f(-5.0f - (float)h);
    float S[16];
#pragma unroll
    for (int d = 0; d < 16; ++d) S[d] = 0.f;
    RtIn cur, n1, n2;
    const size_t rb = (size_t)b * SEQ;
    rt_load(cur, P, rb, h, d0, v); rt_load(n1, P, rb + 1, h, d0, v);
    for (int t = 0; t < SEQ; ++t) {
        rt_load(n2, P, rb + (t + 2 < SEQ ? t + 2 : SEQ - 1), h, d0, v);
        const float vv = bf2f(cur.v) * 0.125f;
        float o = 0.f;
#pragma unroll
        for (int e = 0; e < 8; ++e) { const unsigned qw = cur.q[e >> 2][e & 3], kw = cur.k[e >> 2][e & 3];
            S[2 * e] = gamma * S[2 * e] + bflo(kw) * vv; S[2 * e + 1] = gamma * S[2 * e + 1] + bfhi(kw) * vv;
            o += bflo(qw) * S[2 * e] + bfhi(qw) * S[2 * e + 1]; }
        o += __shfl_xor(o, 1); o += __shfl_xor(o, 2);
        if (dp == 0) RO[(rb + t) * 512 + h * 128 + v] = o;
        cur = n1; n1 = n2;
    }
}
__device__ __forceinline__ void moba_naive(Frame& F, int mw, int nmw) {
    const bf16* P = (const bf16*)(FWS + WS_PROJ);
    const float* KM = (const float*)(FWS + WS_KMEAN);
    bf16* MX = (bf16*)(FWS + WS_U + 160 * MiB);
    LAS float* qs = (LAS float*)(F.lds + F.wave * 4608);
    LAS float* ps = qs + 128;
    const int lane = F.lane;
    for (int qi = mw; qi < MROWS * 8; qi += nmw) {
        const int h = qi & 7, row = qi >> 3, b = row >> 12, t = row & (SEQ - 1), bq = t >> 8;
        { const unsigned qw = *(const unsigned*)(P + (size_t)row * IN_PAD + C_MQ + h * 128 + 2 * lane);
          qs[2 * lane] = bflo(qw) * 0.08838834764831845f; qs[2 * lane + 1] = bfhi(qw) * 0.08838834764831845f; }
        LDS_WAIT();
        float gate = -INFINITY;
        if (lane < 16 && lane < bq) { const float* km = KM + ((size_t)(b * 8 + h) * 16 + lane) * 128; float a = 0.f;
            for (int d = 0; d < 128; ++d) a += qs[d] * km[d];
            gate = a; }
        unsigned selmask = 0u;
#pragma unroll
        for (int rnd = 0; rnd < 3; ++rnd) { const float m = wave_max(gate);
            if (m > -INFINITY) { const unsigned long long bal = __ballot(gate == m); const int idx = __ffsll((long long)bal) - 1; selmask |= 1u << idx; if (lane == idx) gate = -INFINITY; } }
        int blk[4];
#pragma unroll
        for (int s = 0; s < 3; ++s) { if (selmask) { blk[s] = __ffs((int)selmask) - 1; selmask &= selmask - 1u; } else blk[s] = -1; }
        blk[3] = bq;
        const float slope = exp2f(-(float)(h + 1));
        float sc[4][4]; float mx = -1e30f;
#pragma unroll
        for (int s = 0; s < 4; ++s) {
#pragma unroll
            for (int kq = 0; kq < 4; ++kq) {
                float val = -1e30f;
                if (blk[s] >= 0) { const int pos = blk[s] * 256 + kq * 64 + lane;
                    const bf16* kp = P + (size_t)(b * SEQ + pos) * IN_PAD + C_MK + h * 128; float a = 0.f;
#pragma unroll 4
                    for (int d8 = 0; d8 < 16; ++d8) { const v4u kw = *(const v4u*)(kp + d8 * 8); const f32x4 qa = *(const LAS f32x4*)(qs + d8 * 8), qb = *(const LAS f32x4*)(qs + d8 * 8 + 4);
                        a += bflo(kw.x) * qa.x + bfhi(kw.x) * qa.y + bflo(kw.y) * qa.z + bfhi(kw.y) * qa.w + bflo(kw.z) * qb.x + bfhi(kw.z) * qb.y + bflo(kw.w) * qb.z + bfhi(kw.w) * qb.w; }
                    if (pos <= t) val = a - slope * (float)(t - pos); }
                sc[s][kq] = val; mx = fmaxf(mx, val); } }
        mx = wave_max(mx);
        float lsum = 0.f;
#pragma unroll
        for (int s = 0; s < 4; ++s)
#pragma unroll
            for (int kq = 0; kq < 4; ++kq) { const float p = __expf(sc[s][kq] - mx); lsum += p; ps[s * 256 + kq * 64 + lane] = p; }
        lsum = wave_sum(lsum);
        LDS_WAIT();
        float o0 = 0.f, o1 = 0.f;
#pragma unroll
        for (int s = 0; s < 4; ++s) if (blk[s] >= 0) { const int nk = (s == 3) ? (t - bq * 256 + 1) : 256;
            const bf16* vp = P + (size_t)(b * SEQ + blk[s] * 256) * IN_PAD + C_MV + h * 128 + 2 * lane;
#pragma unroll 4
            for (int key = 0; key < nk; ++key) { const float p = ps[s * 256 + key]; const unsigned vw = *(const unsigned*)(vp + (size_t)key * IN_PAD); o0 += p * bflo(vw); o1 += p * bfhi(vw); } }
        const float inv = 1.0f / lsum;
        *(unsigned*)(MX + (size_t)row * 1024 + h * 128 + 2 * lane) = pk2(o0 * inv, o1 * inv);
        LDS_WAIT();
    }
}

constexpr int MOBA_LDS_KM = moba::LDS_BYTES, MOBA_LDS_SEL = MOBA_LDS_KM + 8192;
__device__ __forceinline__ void moba_item(Frame& F, int bh, int qbA, int qbB) {
    const int b = bh >> 3, h = bh & 7;
    const bf16* P = (const bf16*)(FWS + WS_PROJ);
    LAS float* km = (LAS float*)(F.lds + MOBA_LDS_KM);
    LAS unsigned* sel = (LAS unsigned*)(F.lds + MOBA_LDS_SEL);
    const float* KM = (const float*)(FWS + WS_KMEAN) + (size_t)bh * 16 * 128;
    for (int i = F.tid; i < 2048; i += NTHR) km[i] = KM[i];
    __syncthreads();
    {   const int qb = (F.tid < 256) ? qbA : qbB, r = F.tid & 255;
        const bf16* qp = P + (size_t)(b * SEQ + qb * 256 + r) * IN_PAD + C_MQ + h * 128;
        float g[16];
#pragma unroll
        for (int n = 0; n < 16; ++n) g[n] = 0.f;
        for (int d8 = 0; d8 < 16; ++d8) { const v4u qw = *(const v4u*)(qp + d8 * 8);
            const float q0 = bflo(qw.x), q1 = bfhi(qw.x), q2 = bflo(qw.y), q3 = bfhi(qw.y), q4 = bflo(qw.z), q5 = bfhi(qw.z), q6 = bflo(qw.w), q7 = bfhi(qw.w);
#pragma unroll
            for (int n = 0; n < 16; ++n) { const f32x4 ka = *(const LAS f32x4*)(km + n * 128 + d8 * 8), kb = *(const LAS f32x4*)(km + n * 128 + d8 * 8 + 4);
                g[n] += (q0 * ka.x + q1 * ka.y) + (q2 * ka.z + q3 * ka.w) + (q4 * kb.x + q5 * kb.y) + (q6 * kb.z + q7 * kb.w); } }
        unsigned m = 0u;
#pragma unroll
        for (int rnd = 0; rnd < 3; ++rnd) { float best = -INFINITY; int bi = -1;
#pragma unroll
            for (int n = 0; n < 16; ++n) if (n < qb && !((m >> n) & 1u) && g[n] > best) { best = g[n]; bi = n; }
            if (bi >= 0) m |= 1u << bi; }
        sel[F.tid] = m; }
    __syncthreads();
    typedef moba::BlockRef<moba::bf16, moba::bf16> Ref;
    const float slopeR = exp2f(-(float)(h + 1)) * 11.313708498984761f;
    bf16* MX = (bf16*)(FWS + WS_MIXED);
    Ref A, B2;
    A.Q = P + (size_t)(b * SEQ + qbA * 256) * IN_PAD + C_MQ + h * 128; A.K = P + (size_t)(b * SEQ) * IN_PAD + C_MK + h * 128; A.V = P + (size_t)(b * SEQ) * IN_PAD + C_MV + h * 128;
    A.O = MX + (size_t)(b * SEQ + qbA * 256) * DM + 1024 + h * 128; A.P0 = qbA * 256; A.sel = sel; A.slopeR = slopeR;
    B2 = A; B2.Q = P + (size_t)(b * SEQ + qbB * 256) * IN_PAD + C_MQ + h * 128; B2.O = MX + (size_t)(b * SEQ + qbB * 256) * DM + 1024 + h * 128; B2.P0 = qbB * 256; B2.sel = sel + 256;
    moba::Seam<moba::bf16> S;
    moba::lchar* ldsg = (moba::lchar*)F.lds;
    moba::causal_swa_prime<moba::bf16, moba::bf16>(A, 1 << 30, ldsg, S, F.wave);
    Ref cur = A;
    for (int pass = 0; pass < MOBA_NP; ++pass) {
        const bool nb_ = ((pass + 1) & 1) != 0;
        Ref nxt = A; if (nb_ || pass + 1 >= MOBA_NP) nxt = B2;
        moba::causal_swa_block<moba::bf16, moba::bf16>(cur, nxt, SEQ, 1 << 30, ldsg, S, F.wave);
        cur = nxt;
    }
}
constexpr int RC_UNITS = 32, RC_NCH = SEQ / 16, RC_REC = 16384;
constexpr int RC_AR = 0, RC_BK = 4096, RC_VP = 8192, RC_U0 = 10240, RC_Y0 = 12288, RC_D = 14336;
typedef short bf16x8 __attribute__((ext_vector_type(8)));
typedef float f32x16 __attribute__((ext_vector_type(16)));
typedef float f32x2t __attribute__((ext_vector_type(2))); typedef __bf16 bf16x2t __attribute__((ext_vector_type(2)));
__device__ __forceinline__ unsigned cvtpk_c(float lo, float hi) { f32x2t v = {lo, hi}; bf16x2t b = __builtin_convertvector(v, bf16x2t); return __builtin_bit_cast(unsigned, b); }
__device__ __forceinline__ unsigned short cvt1_c(float x) { return (unsigned short)(cvtpk_c(x, 0.f) & 0xffffu); }

constexpr int RC_WLDS = 14464, RC_CODES_OFF = 8 * RC_WLDS  , RC_CSTRIDE = 456;
__device__ __forceinline__ void rc_core(Frame& F, LAS unsigned char* wlds, const float (&At)[16], const float (&Bt)[16], const float (&Kt)[16], const float (&Rt)[16], const float (&vv)[16], const float D, unsigned char* rec) {
    { unsigned wb_ = (unsigned)(uintptr_t)wlds; asm volatile("" : "+v"(wb_)); wlds = (LAS unsigned char*)(uintptr_t)wb_; }
    LAS bf16* XA = (LAS bf16*)wlds; LAS bf16* XB = (LAS bf16*)(wlds + 4608); LAS float* TT = (LAS float*)(wlds + 9216 + 4224);
    int x_ = F.lane; asm volatile("" : "+v"(x_));
    const int x = x_, r32 = x & 31, h2 = x >> 5, tl = x & 15;
#pragma unroll
    for (int t = 0; t < 16; ++t) { XA[t * 72 + x] = cvt1_c(Bt[t]); XA[(16 + t) * 72 + x] = cvt1_c(Kt[t]); XB[t * 72 + x] = cvt1_c(At[t]); XB[(16 + t) * 72 + x] = cvt1_c(Rt[t]); }
#pragma unroll
    for (int q = 0; q < 4; ++q) { v4u w; w.x = cvtpk_c(Bt[4 * q] * D, Bt[4 * q + 1] * D); w.y = cvtpk_c(Bt[4 * q + 2] * D, Bt[4 * q + 3] * D);
        w.z = cvtpk_c(Kt[4 * q] * D, Kt[4 * q + 1] * D); w.w = cvtpk_c(Kt[4 * q + 2] * D, Kt[4 * q + 3] * D); *(v4u*)(rec + RC_BK + x * 64 + q * 16) = w; }
#pragma unroll
    for (int q = 0; q < 2; ++q) { v4u w;
        w.x = cvtpk_c(vv[8 * q], vv[8 * q + 1]); w.y = cvtpk_c(vv[8 * q + 2], vv[8 * q + 3]); w.z = cvtpk_c(vv[8 * q + 4], vv[8 * q + 5]); w.w = cvtpk_c(vv[8 * q + 6], vv[8 * q + 7]); *(v4u*)(rec + RC_VP + x * 32 + q * 16) = w;
    }
    *(float*)(rec + RC_D + x * 4) = D;
    f32x16 G;
#pragma unroll
    for (int r = 0; r < 16; ++r) G[r] = 0.f;
#pragma unroll
    for (int ks = 0; ks < 4; ++ks) { const bf16x8 a = *(const LAS bf16x8*)(XA + r32 * 72 + ks * 16 + h2 * 8), bq = *(const LAS bf16x8*)(XB + r32 * 72 + ks * 16 + h2 * 8);
        G = __builtin_amdgcn_mfma_f32_32x32x16_bf16(a, bq, G, 0, 0, 0); }
    LAS float* GA = (LAS float*)wlds; LAS float* GT = (LAS float*)(wlds + 4608);
#pragma unroll
    for (int r = 0; r < 16; ++r) GA[((r & 3) + 8 * (r >> 2) + 4 * h2) * 36 + r32] = G[r];
#pragma unroll
    for (int g4 = 0; g4 < 4; ++g4) *(LAS f32x4*)(GT + r32 * 36 + 8 * g4 + 4 * h2) = (f32x4){G[4 * g4], G[4 * g4 + 1], G[4 * g4 + 2], G[4 * g4 + 3]};
#define RC_LD16(dst, p, n4) do { _Pragma("unroll") for (int i4_ = 0; i4_ < (n4); ++i4_) { const f32x4 v4_ = *(const LAS f32x4*)((p) + 4 * i4_); dst[4 * i4_] = v4_.x; dst[4 * i4_ + 1] = v4_.y; dst[4 * i4_ + 2] = v4_.z; dst[4 * i4_ + 3] = v4_.w; } } while (0)
    float Tc[16];
    { f32x2 Tp[8];
#pragma unroll
    for (int j = 0; j < 8; ++j) { Tp[j].x = (2 * j == tl) ? 1.0f : 0.0f; Tp[j].y = (2 * j + 1 == tl) ? 1.0f : 0.0f; }
#pragma unroll
    for (int s = 14; s >= 0; --s) { f32x4 nr4[4]; f32x2 a2 = {0.f, 0.f}; float a1 = 0.f;
#pragma unroll
        for (int i4 = (s + 1) / 4; i4 < 4; ++i4) nr4[i4] = *(const LAS f32x4*)(GA + s * 36 + 4 * i4);
        if ((s + 1) & 1) { const int m = s + 1; a1 = nr4[m >> 2][m & 3] * Tp[m >> 1].y; }
#pragma unroll
        for (int m = (s + 2) & ~1; m < 16; m += 2) a2 += (f32x2){nr4[m >> 2][m & 3], nr4[m >> 2][(m & 3) + 1]} * Tp[m >> 1];
        const float acc = a1 + (a2.x + a2.y);
        if (s & 1) Tp[s >> 1].y = (s < tl) ? acc : Tp[s >> 1].y; else Tp[s >> 1].x = (s < tl) ? acc : Tp[s >> 1].x; }
#pragma unroll
    for (int j = 0; j < 8; ++j) { Tc[2 * j] = Tp[j].x; Tc[2 * j + 1] = Tp[j].y; } }
    if (x < 16) {
#pragma unroll
        for (int g4 = 0; g4 < 4; ++g4) *(LAS f32x4*)(TT + tl * 16 + 4 * g4) = (f32x4){Tc[4 * g4], Tc[4 * g4 + 1], Tc[4 * g4 + 2], Tc[4 * g4 + 3]}; }
    float PV[16];
    PV[0] = 0.f;
#pragma unroll
    for (int s = 1; s < 16; ++s) { f32x2 a2 = {0.f, 0.f}; float a1 = 0.f;
#pragma unroll
        for (int r = 0; r + 1 < s; r += 2) a2 += (f32x2){GT[s * 36 + 16 + r], GT[s * 36 + 16 + r + 1]} * (f32x2){vv[r], vv[r + 1]};
        if (s & 1) a1 = GT[s * 36 + 16 + s - 1] * vv[s - 1];
        PV[s] = a1 + (a2.x + a2.y); }
    float Ah[16], U0[16];
#pragma unroll
    for (int t = 0; t < 16; ++t) { f32x2 a2 = {0.f, 0.f};
#pragma unroll
        for (int s = 0; s <= t; ++s) { const float tv = TT[t * 16 + s]; a2 += (f32x2){tv, tv} * (f32x2){At[s], PV[s]}; }
        Ah[t] = a2.x; U0[t] = a2.y; }
    float Rh[16], Y0[16];
#pragma unroll
    for (int t = 0; t < 16; ++t) { f32x2 ry = {Rt[t], 0.f};
#pragma unroll
        for (int s = 0; s <= t; ++s) { const float m1 = GT[(16 + t) * 36 + s], m2 = GT[(16 + t) * 36 + 16 + s]; ry += (f32x2){m1, m1} * (f32x2){Ah[s], U0[s]}; ry.y += m2 * vv[s]; }
        Rh[t] = ry.x; Y0[t] = ry.y; }
#undef RC_LD16
    { const int ks = x >> 5, jj = x & 31, e = (jj >> 4) * 4 + (jj & 3), q = (jj >> 2) & 3; unsigned char* pb = rec + RC_AR + ks * 1024 + q * 256 + e * 2;
#pragma unroll
      for (int s = 0; s < 16; ++s) { *(bf16*)(pb + s * 16) = cvt1_c(Ah[s]); *(bf16*)(pb + 2048 + s * 16) = cvt1_c(Rh[s]); } }
#pragma unroll
    for (int q = 0; q < 2; ++q) { v4u w;
        w.x = cvtpk_c(U0[8 * q], U0[8 * q + 1]); w.y = cvtpk_c(U0[8 * q + 2], U0[8 * q + 3]); w.z = cvtpk_c(U0[8 * q + 4], U0[8 * q + 5]); w.w = cvtpk_c(U0[8 * q + 6], U0[8 * q + 7]); *(v4u*)(rec + RC_U0 + x * 32 + q * 16) = w;
        w.x = cvtpk_c(Y0[8 * q], Y0[8 * q + 1]); w.y = cvtpk_c(Y0[8 * q + 2], Y0[8 * q + 3]); w.z = cvtpk_c(Y0[8 * q + 4], Y0[8 * q + 5]); w.w = cvtpk_c(Y0[8 * q + 6], Y0[8 * q + 7]); *(v4u*)(rec + RC_Y0 + x * 32 + q * 16) = w; }
    LDS_WAIT();
}
__device__ __forceinline__ void rc_pass1_rwkv(Frame& F, int wid, int nw, int c0, int nc) {
    LAS unsigned char* wlds = F.lds + F.wave * RC_WLDS;
    const int x = F.lane;
    const float* RW = (const float*)(FWS + WS_RW);
    const bf16* RH = (const bf16*)(FWS + WS_RW + 32 * MiB);
    for (int it2 = wid; it2 < 16 * nc; it2 += nw) {
        const int u = it2 / nc, c = c0 + it2 % nc, it = u * RC_NCH + c, b = u >> 3, h = u & 7; const size_t o0 = ((size_t)(b * SEQ + c * 16)) * 512 + h * 64 + x;
        float At[16], Bt[16], Kt[16], Rt[16], vv[16]; float W = 1.0f;
#pragma unroll
        for (int t = 0; t < 16; ++t) { const size_t o = o0 + (size_t)t * 512;
            const float wv = RW[o], ka = bf2f(RH[3 * RWA + o]), bb = bf2f(RH[4 * RWA + o]), kk = bf2f(RH[1 * RWA + o]), rr = bf2f(RH[0 * RWA + o]); vv[t] = bf2f(RH[2 * RWA + o]);
            At[t] = -ka * W; W *= wv; const float iw = __builtin_amdgcn_rcpf(W); Bt[t] = bb * iw; Kt[t] = kk * iw; Rt[t] = rr * W; }
        rc_core(F, wlds, At, Bt, Kt, Rt, vv, W, FWS + WS_REC + (size_t)it * RC_REC);
    }
}
__device__ __forceinline__ void rc_core_ret(Frame& F, LAS unsigned char* wlds, const float (&Kt)[16], const float (&Rt)[16], const float (&vv)[16], const float D, unsigned char* rec) {
    { unsigned wb_ = (unsigned)(uintptr_t)wlds; asm volatile("" : "+v"(wb_)); wlds = (LAS unsigned char*)(uintptr_t)wb_; }
    LAS bf16* XK = (LAS bf16*)wlds; LAS bf16* XR = (LAS bf16*)(wlds + 2304); LAS float* GM = (LAS float*)(wlds + 4608);
    int x_ = F.lane; asm volatile("" : "+v"(x_));
    const int x = x_, fr = x & 15, q = x >> 4;
#pragma unroll
    for (int t = 0; t < 16; ++t) { XK[t * 72 + x] = cvt1_c(Kt[t]); XR[t * 72 + x] = cvt1_c(Rt[t]); }
#pragma unroll
    for (int qq = 0; qq < 4; ++qq) { v4u w; w.x = 0u; w.y = 0u;
        w.z = cvtpk_c(Kt[4 * qq] * D, Kt[4 * qq + 1] * D); w.w = cvtpk_c(Kt[4 * qq + 2] * D, Kt[4 * qq + 3] * D); *(v4u*)(rec + RC_BK + x * 64 + qq * 16) = w; }
#pragma unroll
    for (int qq = 0; qq < 2; ++qq) { v4u w;
        w.x = cvtpk_c(vv[8 * qq], vv[8 * qq + 1]); w.y = cvtpk_c(vv[8 * qq + 2], vv[8 * qq + 3]); w.z = cvtpk_c(vv[8 * qq + 4], vv[8 * qq + 5]); w.w = cvtpk_c(vv[8 * qq + 6], vv[8 * qq + 7]); *(v4u*)(rec + RC_VP + x * 32 + qq * 16) = w;
        *(v4u*)(rec + RC_U0 + x * 32 + qq * 16) = (v4u){0u, 0u, 0u, 0u}; }
    *(float*)(rec + RC_D + x * 4) = D;
    { const int ks = x >> 5, jj = x & 31, e = (jj >> 4) * 4 + (jj & 3), qv = (jj >> 2) & 3; unsigned char* pb = rec + RC_AR + ks * 1024 + qv * 256 + e * 2;
#pragma unroll
      for (int s = 0; s < 16; ++s) { *(bf16*)(pb + s * 16) = (bf16)0; *(bf16*)(pb + 2048 + s * 16) = cvt1_c(Rt[s]); } }
    f32x4 G = {0.f, 0.f, 0.f, 0.f};
#pragma unroll
    for (int ks = 0; ks < 2; ++ks) { const bf16x8 a = *(const LAS bf16x8*)(XK + fr * 72 + ks * 32 + q * 8), bq = *(const LAS bf16x8*)(XR + fr * 72 + ks * 32 + q * 8);
        G = __builtin_amdgcn_mfma_f32_16x16x32_bf16(a, bq, G, 0, 0, 0); }
#pragma unroll
    for (int rg = 0; rg < 4; ++rg) GM[(4 * q + rg) * 17 + fr] = G[rg];
    float Y0[16];
#pragma unroll
    for (int t = 0; t < 16; ++t) { float yy = 0.f;
#pragma unroll
        for (int s = 0; s <= t; ++s) yy += GM[s * 17 + t] * vv[s];
        Y0[t] = yy; }
#pragma unroll
    for (int qq = 0; qq < 2; ++qq) { v4u w;
        w.x = cvtpk_c(Y0[8 * qq], Y0[8 * qq + 1]); w.y = cvtpk_c(Y0[8 * qq + 2], Y0[8 * qq + 3]); w.z = cvtpk_c(Y0[8 * qq + 4], Y0[8 * qq + 5]); w.w = cvtpk_c(Y0[8 * qq + 6], Y0[8 * qq + 7]); *(v4u*)(rec + RC_Y0 + x * 32 + qq * 16) = w; }
    LDS_WAIT();
}
__device__ __forceinline__ void rc_pass1_ret(Frame& F, int wid, int nw, int c0, int nc) {
    LAS unsigned char* wlds = F.lds + F.wave * RC_WLDS;
    const int x = F.lane;
    const bf16* P = (const bf16*)(FWS + WS_PROJ);
    for (int it2 = wid; it2 < 16 * nc; it2 += nw) {
        const int ru = it2 / nc, c = c0 + it2 % nc, it = ru * RC_NCH + c, b = ru >> 3, h = (ru >> 1) & 3, half = ru & 1; const float gamma = 1.0f - exp2f(-5.0f - (float)h);
        float Kt[16], Rt[16], vv[16]; float W = 1.0f;
        const bf16* p0 = P + (size_t)(b * SEQ + c * 16) * IN_PAD;
#pragma unroll
        for (int t = 0; t < 16; ++t) { const bf16* p = p0 + (size_t)t * IN_PAD;
            const float rr = bf2f(p[C_RQ + h * 64 + x]), kk = bf2f(p[C_RK + h * 64 + x]) * 0.125f; vv[t] = bf2f(p[C_RV + h * 128 + half * 64 + x]);
            W *= gamma; const float iw = __builtin_amdgcn_rcpf(W); Kt[t] = kk * iw; Rt[t] = rr * W; }
        rc_core_ret(F, wlds, Kt, Rt, vv, W, FWS + WS_REC + (size_t)(16 * RC_NCH + it) * RC_REC);
    }
}
__device__ __forceinline__ void rwkv_prep_mfma(Frame& F, int l, int first, int stride) {
    LAS unsigned char* wlds = F.lds + F.wave * RC_WLDS;
    LAS bf16* CODES = (LAS bf16*)(F.lds + RC_CODES_OFF);
    LAS float* ST = (LAS float*)wlds;
    const bf16* P = (const bf16*)(FWS + WS_PROJ);
    const float* mu = F.in[F.zz + 4] + l * RWC;
    const bf16* WT = (const bf16*)(FWS + WS_RWW + (size_t)l * 448 * 512 * 2);
    float* RW = (float*)(FWS + WS_RW);
    const int x = F.lane, h = F.wave, ch = h * 64 + x, fr = x & 15, q = x >> 4;
    for (int item = first; item < NB * RC_NCH; item += stride) {
        const int b = item >> 8, c = item & 255; const size_t row0 = (size_t)b * SEQ + c * 16; const int t0 = c * 16;
        const bf16* prc = P + row0 * IN_PAD + C_RW + ch;
        unsigned short nr_[4], nk_[4], nv_[4]; float pvr = 0.f, pvk = 0.f, pvv = 0.f;
        if (t0 > 0) { pvr = bf2f(prc[-IN_PAD]); pvk = bf2f(prc[512 - IN_PAD]); pvv = bf2f(prc[1024 - IN_PAD]); }
#pragma unroll
        for (int tt = 0; tt < 4; ++tt) { nr_[tt] = prc[(size_t)tt * IN_PAD]; nk_[tt] = prc[(size_t)tt * IN_PAD + 512]; nv_[tt] = prc[(size_t)tt * IN_PAD + 1024]; }
        const float mur = mu[ch], muk = mu[512 + ch], muv = mu[1024 + ch];
        const float w0c = F.in[F.zz + 5][l * 512 + ch], a0c = F.in[F.zz + 7][l * 512 + ch], kkc = F.in[F.zz + 10][l * 512 + ch], kac = F.in[F.zz + 11][l * 512 + ch], rkc = F.in[F.zz + 12][l * 512 + ch];
#pragma unroll 7
        for (int idx = F.tid; idx < 16 * 448; idx += NTHR) { const int tk = idx / 448, cc = idx - tk * 448;
            float val = lerp_bf(P, row0 + tk, C_RW + 1536 + cc, (t0 + tk) > 0, mu[1536 + cc]);
            if (cc < 96) val = 1.0f - 2.0f * __builtin_amdgcn_rcpf(1.0f + __expf(2.0f * val));
            else if (cc >= 192) val = sigmoidf_(val);
            CODES[tk * RC_CSTRIDE + cc] = cvt1_c(val); }
        __syncthreads();
        f32x4 accW[4], accA[4], accG[4];
#pragma unroll
        for (int ct = 0; ct < 4; ++ct) { accW[ct] = (f32x4){0.f, 0.f, 0.f, 0.f}; accA[ct] = accW[ct]; accG[ct] = accW[ct]; }
        { bf16x8 bw[3][4];
#pragma unroll
          for (int ks = 0; ks < 3; ++ks)
#pragma unroll
              for (int ct = 0; ct < 4; ++ct) bw[ks][ct] = *(const bf16x8*)(WT + (size_t)(h * 64 + ct * 16 + fr) * 96 + ks * 32 + q * 8);
#pragma unroll
          for (int ks = 0; ks < 3; ++ks) { const bf16x8 aw = *(const LAS bf16x8*)(CODES + fr * RC_CSTRIDE + ks * 32 + q * 8);
#pragma unroll
              for (int ct = 0; ct < 4; ++ct) accW[ct] = __builtin_amdgcn_mfma_f32_16x16x32_bf16(aw, bw[ks][ct], accW[ct], 0, 0, 0); } }
        asm volatile("" ::: "memory");
        { bf16x8 ba[3][4];
#pragma unroll
          for (int ks = 0; ks < 3; ++ks)
#pragma unroll
              for (int ct = 0; ct < 4; ++ct) ba[ks][ct] = *(const bf16x8*)(WT + 512 * 96 + (size_t)(h * 64 + ct * 16 + fr) * 96 + ks * 32 + q * 8);
#pragma unroll
          for (int ks = 0; ks < 3; ++ks) { const bf16x8 aa = *(const LAS bf16x8*)(CODES + fr * RC_CSTRIDE + 96 + ks * 32 + q * 8);
#pragma unroll
              for (int ct = 0; ct < 4; ++ct) accA[ct] = __builtin_amdgcn_mfma_f32_16x16x32_bf16(aa, ba[ks][ct], accA[ct], 0, 0, 0); } }
        asm volatile("" ::: "memory");
#pragma unroll
        for (int hf = 0; hf < 2; ++hf) { bf16x8 bg[4][4];
#pragma unroll
            for (int k4 = 0; k4 < 4; ++k4)
#pragma unroll
                for (int ct = 0; ct < 4; ++ct) bg[k4][ct] = *(const bf16x8*)(WT + 2 * 512 * 96 + (size_t)(h * 64 + ct * 16 + fr) * 256 + (hf * 4 + k4) * 32 + q * 8);
#pragma unroll
            for (int k4 = 0; k4 < 4; ++k4) { const bf16x8 ag = *(const LAS bf16x8*)(CODES + fr * RC_CSTRIDE + 192 + (hf * 4 + k4) * 32 + q * 8);
#pragma unroll
                for (int ct = 0; ct < 4; ++ct) accG[ct] = __builtin_amdgcn_mfma_f32_16x16x32_bf16(ag, bg[k4][ct], accG[ct], 0, 0, 0); }
            asm volatile("" ::: "memory"); }
#pragma unroll
        for (int ct = 0; ct < 4; ++ct)
#pragma unroll
            for (int rg = 0; rg < 4; ++rg) { const int o = (4 * q + rg) * 64 + ct * 16 + fr; ST[o] = accW[ct][rg]; ST[1024 + o] = accA[ct][rg]; ST[2048 + o] = accG[ct][rg]; }
        float* gpw = RW + row0 * 512 + ch;
        bf16* gp = (bf16*)(FWS + WS_RW + 32 * MiB) + row0 * 512 + ch;
        for (int g = 0; g < 4; ++g) {
            unsigned short cr_[4], ck_[4], cv_[4];
#pragma unroll
            for (int tt = 0; tt < 4; ++tt) { cr_[tt] = nr_[tt]; ck_[tt] = nk_[tt]; cv_[tt] = nv_[tt]; }
            if (g < 3) {
#pragma unroll
                for (int tt = 0; tt < 4; ++tt) { const size_t ro = (size_t)(4 * g + 4 + tt) * IN_PAD; nr_[tt] = prc[ro]; nk_[tt] = prc[ro + 512]; nv_[tt] = prc[ro + 1024]; } }
#pragma unroll
          for (int tt = 0; tt < 4; ++tt) { const int t = 4 * g + tt;
            const float cr = bf2f(cr_[tt]), ck = bf2f(ck_[tt]), cv = bf2f(cv_[tt]);
            const float rr = cr + (pvr - cr) * mur, kk0 = ck + (pvk - ck) * muk, vv = cv + (pvv - cv) * muv;
            pvr = cr; pvk = ck; pvv = cv;
            const float z = -(w0c + ST[t * 64 + x]);
            const float sp = fmaxf(z, 0.f) + __logf(1.0f + __expf(-fabsf(z)));
            const float decay = __expf(-__expf(-sp - 0.5f));
            const float a = sigmoidf_(a0c + ST[1024 + t * 64 + x]);
            const float gg = ST[2048 + t * 64 + x];
            const float kkv = kk0 * kkc;
            const float nrm = __builtin_amdgcn_sqrtf(wave_sum(kkv * kkv));
            const float kap = kkv * __builtin_amdgcn_rcpf(fmaxf(nrm, 1e-12f));
            const float kp = kk0 * (1.0f + (a - 1.0f) * kac);
            const float bsum = wave_sum(rr * kp * rkc);
            gpw[0] = decay; gpw += 512;
            gp[0 * RWA] = cvt1_c(rr); gp[1 * RWA] = cvt1_c(kp); gp[2 * RWA] = cvt1_c(vv); gp[3 * RWA] = cvt1_c(kap); gp[4 * RWA] = cvt1_c(kap * a); gp[5 * RWA] = cvt1_c(gg); gp[6 * RWA] = cvt1_c(bsum * vv); gp += 512; } }
        LDS_WAIT();
        __syncthreads();
    }
}
constexpr int RC_SLOT = 15360, RC_YST = 8 * RC_SLOT  ;
__device__ __forceinline__ void rc_pass2(Frame& F, int u, int cb, int ce, bool first, bool last) {
    const unsigned char* rec = FWS + WS_REC + (size_t)u * RC_NCH * RC_REC;
    const int lane = F.lane;
    const int NIT = (ce - cb) / 2;
    bf16* Yg;
    if (u < 16) Yg = (bf16*)(FWS + WS_Y) + (size_t)((u >> 3) * SEQ) * 512 + (u & 7) * 64;
    else { const int ru = u - 16; Yg = (bf16*)(FWS + WS_RETO) + (size_t)((ru >> 3) * SEQ) * 512 + ((ru >> 1) & 3) * 128 + (ru & 1) * 64; }
#define RC_BARRIER() __builtin_amdgcn_s_barrier()
    if (F.wave == 7) {
        unsigned t0_ = 0u, t1_ = 0u, t2_ = 0u, t3_ = 0u;
        for (int cq = cb; cq < cb + 24 && cq < ce; cq += 2) { const unsigned char* pa = rec + (size_t)cq * RC_REC + lane * 128; const unsigned char* pb = pa + 8192; const unsigned char* pc = pa + RC_REC; const unsigned char* pd = pb + RC_REC;
            asm volatile("global_load_dword %0, %4, off\n\tglobal_load_dword %1, %5, off\n\tglobal_load_dword %2, %6, off\n\tglobal_load_dword %3, %7, off" : "+v"(t0_), "+v"(t1_), "+v"(t2_), "+v"(t3_) : "v"(pa), "v"(pb), "v"(pc), "v"(pd) : "memory"); }
        RC_BARRIER();
        for (int i = 0; i < NIT; ++i) {
            const int cp = cb + 2 * i + 24;
            if (cp < ce) { const unsigned char* pa = rec + (size_t)cp * RC_REC + lane * 128; const unsigned char* pb = pa + 8192; const unsigned char* pc = pa + RC_REC; const unsigned char* pd = pb + RC_REC;
                asm volatile("global_load_dword %0, %4, off\n\tglobal_load_dword %1, %5, off\n\tglobal_load_dword %2, %6, off\n\tglobal_load_dword %3, %7, off" : "+v"(t0_), "+v"(t1_), "+v"(t2_), "+v"(t3_) : "v"(pa), "v"(pb), "v"(pc), "v"(pd) : "memory"); }
            if (i > 0) {
                const LAS unsigned char* yb = F.lds + RC_YST + ((i - 1) & 1) * 4096;
#pragma unroll
                for (int j = 0; j < 4; ++j) { const v4u w = *(const LAS v4u*)(yb + j * 1024 + lane * 16);
                    *(v4u*)(Yg + (size_t)((cb + 2 * i - 2) * 16 + j * 8 + (lane >> 3)) * 512 + (lane & 7) * 8) = w; } }
            RC_BARRIER();
        }
        { const LAS unsigned char* yb = F.lds + RC_YST + ((NIT - 1) & 1) * 4096;
#pragma unroll
          for (int j = 0; j < 4; ++j) { const v4u w = *(const LAS v4u*)(yb + j * 1024 + lane * 16);
              *(v4u*)(Yg + (size_t)((cb + 2 * NIT - 2) * 16 + j * 8 + (lane >> 3)) * 512 + (lane & 7) * 8) = w; } }
        asm volatile("s_waitcnt vmcnt(0)" ::: "memory");
        asm volatile("" :: "v"(t0_), "v"(t1_), "v"(t2_), "v"(t3_));
    } else if (F.wave >= 4) {
        const int lw = F.wave - 4;
        const int p0_ = lw == 0 ? 8 : (lw == 1 ? 11 : 13), np_ = lw == 0 ? 3 : 2;
#define RC_ISSUE(c) do { _Pragma("unroll") for (int i_ = 0; i_ < 3; ++i_) { if (i_ < np_) \
            __builtin_amdgcn_global_load_lds((const unsigned*)(rec + (size_t)(c) * RC_REC + (p0_ + i_) * 1024 + lane * 16), (LAS unsigned*)(F.lds + ((c) & 7) * RC_SLOT + (p0_ + i_) * 1024), 16, 0, 0); } } while (0)
#define RC_WAIT4() do { if (lw == 0) asm volatile("s_waitcnt vmcnt(12)" ::: "memory"); else asm volatile("s_waitcnt vmcnt(8)" ::: "memory"); } while (0)
        for (int c = cb; c < cb + 6; ++c) RC_ISSUE(c);
        RC_WAIT4();
        RC_BARRIER();
        for (int i = 0; i < NIT; ++i) {
            if (cb + 2 * i + 7 < ce) { RC_ISSUE(cb + 2 * i + 6); RC_ISSUE(cb + 2 * i + 7); RC_WAIT4(); }
            else asm volatile("s_waitcnt vmcnt(0)" ::: "memory");
            RC_BARRIER();
        }
#undef RC_ISSUE
#undef RC_WAIT4
    } else {
        const int ib = F.wave, fr = lane & 15, q = lane >> 4;
#define RC_ISSUE1(c) do { __builtin_amdgcn_global_load_lds((const unsigned*)(rec + (size_t)(c) * RC_REC + (2 * ib) * 1024 + lane * 16), (LAS unsigned*)(F.lds + ((c) & 7) * RC_SLOT + (2 * ib) * 1024), 16, 0, 0); \
        __builtin_amdgcn_global_load_lds((const unsigned*)(rec + (size_t)(c) * RC_REC + (2 * ib + 1) * 1024 + lane * 16), (LAS unsigned*)(F.lds + ((c) & 7) * RC_SLOT + (2 * ib + 1) * 1024), 16, 0, 0); } while (0)
        f32x4* sv = (f32x4*)(FWS + WS_CTL + 262144) + (size_t)((u * 4 + ib) * 4 + 0) * 64 + lane;
        f32x4 sT[4];
#pragma unroll
        for (int jb = 0; jb < 4; ++jb) sT[jb] = first ? (f32x4){0.f, 0.f, 0.f, 0.f} : sv[jb * 64];
        asm volatile("s_waitcnt vmcnt(0)" ::: "memory");
        for (int c = cb; c < cb + 6; ++c) RC_ISSUE1(c);
        asm volatile("s_waitcnt vmcnt(8)" ::: "memory");
        RC_BARRIER();
        for (int i = 0; i < NIT; ++i) {
            bf16x8 aU0[2], aU1[2], aY0[2], aY1[2], bk[2][4]; f32x4 dd[2][4]; v2u vp[2], u0[2], y0[2];
#pragma unroll
            for (int h = 0; h < 2; ++h) { const LAS unsigned char* slot = F.lds + ((cb + 2 * i + h) & 7) * RC_SLOT;
                aU0[h] = *(const LAS bf16x8*)(slot + RC_AR + q * 256 + fr * 16); aU1[h] = *(const LAS bf16x8*)(slot + RC_AR + 1024 + q * 256 + fr * 16);
                aY0[h] = *(const LAS bf16x8*)(slot + RC_AR + 2048 + q * 256 + fr * 16); aY1[h] = *(const LAS bf16x8*)(slot + RC_AR + 3072 + q * 256 + fr * 16);
                u0[h] = *(const LAS v2u*)(slot + RC_U0 + (16 * ib + fr) * 32 + q * 8); vp[h] = *(const LAS v2u*)(slot + RC_VP + (16 * ib + fr) * 32 + q * 8);
#pragma unroll
                for (int jb = 0; jb < 4; ++jb) { bk[h][jb] = *(const LAS bf16x8*)(slot + RC_BK + (16 * jb + fr) * 64 + q * 16); dd[h][jb] = *(const LAS f32x4*)(slot + RC_D + (16 * jb + 4 * q) * 4); }
                y0[h] = *(const LAS v2u*)(slot + RC_Y0 + (16 * ib + fr) * 32 + q * 8); }
            LAS bf16* yst = (LAS bf16*)(F.lds + RC_YST + (i & 1) * 4096);
#pragma unroll
            for (int h = 0; h < 2; ++h) {
                v4u s0, s1;
                s0.x = cvtpk_c(sT[0][0], sT[0][1]); s0.y = cvtpk_c(sT[0][2], sT[0][3]); s0.z = cvtpk_c(sT[1][0], sT[1][1]); s0.w = cvtpk_c(sT[1][2], sT[1][3]);
                s1.x = cvtpk_c(sT[2][0], sT[2][1]); s1.y = cvtpk_c(sT[2][2], sT[2][3]); s1.z = cvtpk_c(sT[3][0], sT[3][1]); s1.w = cvtpk_c(sT[3][2], sT[3][3]);
                const bf16x8 sb0 = __builtin_bit_cast(bf16x8, s0), sb1 = __builtin_bit_cast(bf16x8, s1);
                f32x4 zU = (f32x4){0.f, 0.f, 0.f, 0.f}, zY = (f32x4){0.f, 0.f, 0.f, 0.f};
                zU = __builtin_amdgcn_mfma_f32_16x16x32_bf16(aU0[h], sb0, zU, 0, 0, 0); zU = __builtin_amdgcn_mfma_f32_16x16x32_bf16(aU1[h], sb1, zU, 0, 0, 0);
                const float U0_ = zU[0] + bflo(u0[h].x), U1_ = zU[1] + bfhi(u0[h].x), U2_ = zU[2] + bflo(u0[h].y), U3_ = zU[3] + bfhi(u0[h].y);
                v4u ubw; ubw.x = cvtpk_c(U0_, U1_); ubw.y = cvtpk_c(U2_, U3_); ubw.z = vp[h].x; ubw.w = vp[h].y;
                const bf16x8 ub = __builtin_bit_cast(bf16x8, ubw);
#pragma unroll
                for (int jb = 0; jb < 4; ++jb) sT[jb] = __builtin_amdgcn_mfma_f32_16x16x32_bf16(bk[h][jb], ub, sT[jb] * dd[h][jb], 0, 0, 0);
                zY = __builtin_amdgcn_mfma_f32_16x16x32_bf16(aY0[h], sb0, zY, 0, 0, 0); zY = __builtin_amdgcn_mfma_f32_16x16x32_bf16(aY1[h], sb1, zY, 0, 0, 0);
                LAS bf16* yp = yst + h * 1024 + (4 * q) * 64 + 16 * ib + fr;
                yp[0] = cvt1_c(zY[0] + bflo(y0[h].x)); yp[64] = cvt1_c(zY[1] + bfhi(y0[h].x)); yp[128] = cvt1_c(zY[2] + bflo(y0[h].y)); yp[192] = cvt1_c(zY[3] + bfhi(y0[h].y));
            }
            if (cb + 2 * i + 7 < ce) { RC_ISSUE1(cb + 2 * i + 6); RC_ISSUE1(cb + 2 * i + 7); asm volatile("s_waitcnt vmcnt(8) lgkmcnt(0)" ::: "memory"); } else asm volatile("s_waitcnt vmcnt(0) lgkmcnt(0)" ::: "memory");
            RC_BARRIER();
        }
        if (!last) {
#pragma unroll
            for (int jb = 0; jb < 4; ++jb) sv[jb * 64] = sT[jb]; }
#undef RC_ISSUE1
    }
#undef RC_BARRIER
    asm volatile("s_waitcnt vmcnt(0) lgkmcnt(0)" ::: "memory");
    __syncthreads();
}
__device__ __forceinline__ void sub_arrive(Frame& F, unsigned* cnt) {
    asm volatile("s_waitcnt vmcnt(0)" ::: "memory");
    __syncthreads();
    if (F.tid == 0) { __builtin_amdgcn_fence(__ATOMIC_RELEASE, "agent"); asm volatile("s_waitcnt vmcnt(0)" ::: "memory"); __hip_atomic_fetch_add(cnt, 1u, __ATOMIC_RELAXED, __HIP_MEMORY_SCOPE_AGENT); }
}
__device__ __forceinline__ void sub_wait(Frame& F, unsigned* cnt, unsigned target) {
    if (F.tid == 0) { unsigned sp = 0u;
        while (__hip_atomic_load(cnt, __ATOMIC_RELAXED, __HIP_MEMORY_SCOPE_AGENT) < target) { __builtin_amdgcn_s_sleep(2); if (++sp > (1u << 24)) break; }
        __builtin_amdgcn_fence(__ATOMIC_ACQUIRE, "agent"); asm volatile("s_waitcnt vmcnt(0)" ::: "memory"); }
    __syncthreads();
}
__device__ __forceinline__ void sub_barrier(Frame& F, unsigned* cnt, unsigned target) {
    asm volatile("s_waitcnt vmcnt(0)" ::: "memory");
    __syncthreads();
    if (F.tid == 0) {
        __builtin_amdgcn_fence(__ATOMIC_RELEASE, "agent");
        asm volatile("s_waitcnt vmcnt(0)" ::: "memory");
        __hip_atomic_fetch_add(cnt, 1u, __ATOMIC_RELAXED, __HIP_MEMORY_SCOPE_AGENT);
        unsigned sp = 0u;
        while (__hip_atomic_load(cnt, __ATOMIC_RELAXED, __HIP_MEMORY_SCOPE_AGENT) < target) { __builtin_amdgcn_s_sleep(2); if (++sp > (1u << 24)) break; }
        __builtin_amdgcn_fence(__ATOMIC_ACQUIRE, "agent");
        asm volatile("s_waitcnt vmcnt(0)" ::: "memory");
    }
    __syncthreads();
}
__device__ __forceinline__ void mixer_post(Frame& F, int l, int gw, int NGW) {
    const bf16* P = (const bf16*)(FWS + WS_PROJ);
    const bf16* RH = (const bf16*)(FWS + WS_RW + 32 * MiB);
    const float* RW = (const float*)(FWS + WS_RW);
    const bf16* Y = (const bf16*)(FWS + WS_Y);
    const bf16* RO = (const bf16*)(FWS + WS_RETO);
    bf16* MX = (bf16*)(FWS + WS_MIXED);
    const float* ln_w = F.in[F.zz + 13] + l * 512; const float* ln_b = F.in[F.zz + 14] + l * 512;
    const int lane = F.lane;
    for (int m = gw; m < MROWS; m += NGW) {
        const size_t o = (size_t)m * 512;
        float y[8], s1[8], s2[8], bon[8], gat[8]; f32x2 ov[4]; float s3[4]; unsigned gw2[4];
#pragma unroll
        for (int h = 0; h < 8; ++h) { const int c = h * 64 + lane; y[h] = bf2f(Y[o + c]); bon[h] = bf2f(RH[6 * RWA + o + c]); gat[h] = bf2f(RH[5 * RWA + o + c]); s1[h] = y[h]; }
#pragma unroll
        for (int h = 0; h < 4; ++h) { const int c = h * 128 + 2 * lane; { const unsigned rw_ = *(const unsigned*)(RO + o + c); ov[h].x = bflo(rw_); ov[h].y = bfhi(rw_); } gw2[h] = *(const unsigned*)(P + (size_t)m * IN_PAD + C_RG + c); s3[h] = ov[h].x * ov[h].x + ov[h].y * ov[h].y; }
#pragma unroll
        for (int h = 0; h < 8; ++h) { s1[h] = dpp_add<0xB1>(s1[h]); s1[h] = dpp_add<0x4E>(s1[h]); s1[h] = dpp_add<0x141>(s1[h]); s1[h] = dpp_add<0x140>(s1[h]); }
#pragma unroll
        for (int h = 0; h < 4; ++h) { s3[h] = dpp_add<0xB1>(s3[h]); s3[h] = dpp_add<0x4E>(s3[h]); s3[h] = dpp_add<0x141>(s3[h]); s3[h] = dpp_add<0x140>(s3[h]); }
#pragma unroll
        for (int h = 0; h < 8; ++h) s1[h] = xsum32(xsum16(s1[h]));
#pragma unroll
        for (int h = 0; h < 4; ++h) s3[h] = xsum32(xsum16(s3[h]));
#pragma unroll
        for (int h = 0; h < 8; ++h) { const float d = y[h] - s1[h] * (1.0f / 64.0f); y[h] = d; s2[h] = d * d; }
#pragma unroll
        for (int h = 0; h < 8; ++h) { s2[h] = dpp_add<0xB1>(s2[h]); s2[h] = dpp_add<0x4E>(s2[h]); s2[h] = dpp_add<0x141>(s2[h]); s2[h] = dpp_add<0x140>(s2[h]); }
#pragma unroll
        for (int h = 0; h < 8; ++h) s2[h] = xsum32(xsum16(s2[h]));
#pragma unroll
        for (int h = 0; h < 8; ++h) { const int c = h * 64 + lane;
            const float yn = y[h] * __builtin_amdgcn_rsqf(s2[h] * (1.0f / 64.0f) + GN_EPS) * ln_w[c] + ln_b[c];
            MX[(size_t)m * DM + 512 + c] = (bf16)f2bf((yn + bon[h]) * gat[h]); }
#pragma unroll
        for (int h = 0; h < 4; ++h) { const int c = h * 128 + 2 * lane;
            const float rn = __builtin_amdgcn_rsqf(s3[h] * (1.0f / 128.0f) + NORM_EPS);
            const float g0 = bflo(gw2[h]), g1 = bfhi(gw2[h]);
            *(unsigned*)(MX + (size_t)m * DM + c) = pk2(ov[h].x * rn * g0 * sigmoidf_(g0), ov[h].y * rn * g1 * sigmoidf_(g1)); }
    }
}
__device__ __forceinline__ void conv_gate_phase(Frame& F, int l) {
    const bf16* U = (const bf16*)(FWS + WS_U);
    bf16* A = (bf16*)(FWS + WS_ACT);
    const float* cw = F.in[F.zz + 16] + (size_t)l * 3 * UPC; const float* cb = F.in[F.zz + 17] + (size_t)l * UPC;
    constexpr int NCG = DFF / 8, NRC = MROWS / 16;
    for (int it = F.vcu * NTHR + F.tid; it < NCG * NRC; it += F.G * NTHR) {
        const int cg = it % NCG, rc = it / NCG, c0 = cg * 8, row0 = rc * 16, t0 = row0 & (SEQ - 1);
        float wv[3][8], wg[3][8], bv[8], bg[8];
#pragma unroll
        for (int j = 0; j < 3; ++j)
#pragma unroll
            for (int e = 0; e < 8; ++e) { wv[j][e] = cw[j * UPC + c0 + e]; wg[j][e] = cw[j * UPC + DFF + c0 + e]; }
#pragma unroll
        for (int e = 0; e < 8; ++e) { bv[e] = cb[c0 + e]; bg[e] = cb[DFF + c0 + e]; }
        v4u v0 = {0u, 0u, 0u, 0u}, v1 = v0, g0 = v0, g1 = v0;
        if (t0 > 0) { v0 = *(const v4u*)(U + (size_t)(row0 - 2) * UPC + c0); v1 = *(const v4u*)(U + (size_t)(row0 - 1) * UPC + c0);
                      g0 = *(const v4u*)(U + (size_t)(row0 - 2) * UPC + DFF + c0); g1 = *(const v4u*)(U + (size_t)(row0 - 1) * UPC + DFF + c0); }
        for (int r = 0; r < 16; ++r) {
            const v4u v2 = *(const v4u*)(U + (size_t)(row0 + r) * UPC + c0), g2 = *(const v4u*)(U + (size_t)(row0 + r) * UPC + DFF + c0);
            float ov[8];
#pragma unroll
            for (int e = 0; e < 4; ++e) {
                const float va = wv[0][2 * e] * bflo(v0[e]) + wv[1][2 * e] * bflo(v1[e]) + wv[2][2 * e] * bflo(v2[e]) + bv[2 * e];
                const float vb = wv[0][2 * e + 1] * bfhi(v0[e]) + wv[1][2 * e + 1] * bfhi(v1[e]) + wv[2][2 * e + 1] * bfhi(v2[e]) + bv[2 * e + 1];
                const float ga = wg[0][2 * e] * bflo(g0[e]) + wg[1][2 * e] * bflo(g1[e]) + wg[2][2 * e] * bflo(g2[e]) + bg[2 * e];
                const float gb = wg[0][2 * e + 1] * bfhi(g0[e]) + wg[1][2 * e + 1] * bfhi(g1[e]) + wg[2][2 * e + 1] * bfhi(g2[e]) + bg[2 * e + 1];
                ov[2 * e] = ga * sigmoidf_(ga) * va; ov[2 * e + 1] = gb * sigmoidf_(gb) * vb; }
            v4u w; w.x = pk2(ov[0], ov[1]); w.y = pk2(ov[2], ov[3]); w.z = pk2(ov[4], ov[5]); w.w = pk2(ov[6], ov[7]);
            *(v4u*)(A + (size_t)(row0 + r) * DFF + c0) = w;
            v0 = v1; v1 = v2; g0 = g1; g1 = g2;
        }
    }
}

__device__ __forceinline__ void conv_fixup_phase(Frame& F, int l) {
    const float* H = (const float*)(FWS + WS_HALO);
    bf16* A = (bf16*)(FWS + WS_ACT);
    const float* cw = F.in[F.zz + 16] + (size_t)l * 3 * UPC; const float* cb = F.in[F.zz + 17] + (size_t)l * UPC;
    constexpr int NQ = DFF / 4;
    for (int it = F.vcu * NTHR + F.tid; it < (MROWS / 64) * 2 * NQ; it += F.G * NTHR) {
        const int c = (it % NQ) * 4, gr = it / NQ, r = gr & 1, g = gr >> 1, colp = (c >> 7) * 256 + (c & 127);
        const bool hasprev = (g & 63) != 0;
        const float* hg = H + (size_t)g * 4 * UPC + colp; const float* hp = hg - (size_t)4 * UPC;
        const f32x4 z = {0.f, 0.f, 0.f, 0.f};
        f32x4 v0, v1, v2, g0, g1, g2;
        v0 = *(const f32x4*)(hg + (size_t)r * UPC); g0 = *(const f32x4*)(hg + (size_t)r * UPC + 128);
        if (r == 1) { v1 = *(const f32x4*)hg; g1 = *(const f32x4*)(hg + 128); v2 = hasprev ? *(const f32x4*)(hp + (size_t)3 * UPC) : z; g2 = hasprev ? *(const f32x4*)(hp + (size_t)3 * UPC + 128) : z; }
        else { v1 = hasprev ? *(const f32x4*)(hp + (size_t)3 * UPC) : z; g1 = hasprev ? *(const f32x4*)(hp + (size_t)3 * UPC + 128) : z; v2 = hasprev ? *(const f32x4*)(hp + (size_t)2 * UPC) : z; g2 = hasprev ? *(const f32x4*)(hp + (size_t)2 * UPC + 128) : z; }
        const f32x4 cv = *(const f32x4*)(cw + c) * v2 + *(const f32x4*)(cw + UPC + c) * v1 + *(const f32x4*)(cw + 2 * UPC + c) * v0 + *(const f32x4*)(cb + c);
        const f32x4 cg = *(const f32x4*)(cw + DFF + c) * g2 + *(const f32x4*)(cw + UPC + DFF + c) * g1 + *(const f32x4*)(cw + 2 * UPC + DFF + c) * g0 + *(const f32x4*)(cb + DFF + c);
        v2u w; w.x = pk2(cg[0] * sigmoidf_(cg[0]) * cv[0], cg[1] * sigmoidf_(cg[1]) * cv[1]); w.y = pk2(cg[2] * sigmoidf_(cg[2]) * cv[2], cg[3] * sigmoidf_(cg[3]) * cv[3]);
        *(v2u*)(A + (size_t)(64 * g + r) * DFF + c) = w;
    }
}

#define GRID_BAR() do { xcd_barrier(bar, tid_from_wave(F.wave)); asm volatile("" : "+s"(F.wave), "+s"(F.vcu), "+s"(F.G)); F.tid = tid_from_wave(F.wave); F.lane = F.tid & 63; { unsigned z_ = 0u; asm volatile("" : "+v"(z_)); F.zz = __builtin_amdgcn_readfirstlane(z_); } } while (0)
#define XB ((bf16*)(FWS + WS_X))
#define HB ((bf16*)(FWS + WS_H))
#define PROJ ((bf16*)(FWS + WS_PROJ))
#define MIXED ((bf16*)(FWS + WS_MIXED))
#define UB ((bf16*)(FWS + WS_U))
#define ACT ((bf16*)(FWS + WS_ACT))
#define MOD ((const float*)(FWS + WS_MOD))
template <int l>
__device__ __forceinline__ void layer_fwd(Frame& F, const XcdBarrier& bar) {
#define modl (MOD + (size_t)l * 2 * 12288)
#define wl (FWS + WS_W + (size_t)l * W_LAYER)
        if (l == 0) norm_phase<0, true>(F, F.in[F.zz + 0], HB, F.in[F.zz + 21] + l * DM, modl + 0 * DM, modl + 1 * DM);
        else norm_phase<0, false>(F, XB, HB, F.in[F.zz + 21] + l * DM, modl + 0 * DM, modl + 1 * DM);
        GRID_BAR();
        { pg8::Gemm g{HB, (const bf16*)(wl + W_IN), MROWS, IN_PAD, DM}; pg8::StaticOrder S; S.init(MROWS, IN_PAD, F.G, (int)blockIdx.x);
          pg8::EpiBf16 E{PROJ, IN_PAD};
          pg8::gemm_phase<pg8::EpiBf16, pg8::StaticOrder, true, true>(F.lds, g, S, E, F.wave); }
        if (F.G == 256 && blockIdx.x >= 64) convert_gap(F, l, CV_IN, l == 0 ? CV_C1 : CV_OUT + CV_UP, ((int)blockIdx.x - 64) * NWAVES + F.wave, 192 * NWAVES, CV_N1);
        GRID_BAR();
        rwkv_prep_mfma(F, l, F.vcu, F.G);
        moba_kmean(F);
        GRID_BAR();
        const int xg_ = F.vcu >> 5, xj_ = F.vcu & 31, mi_ = xg_ * 16 + xj_;
        if (xj_ < 16) { moba_item(F, mi_ >> 3, 15 - (mi_ & 7), mi_ & 7);
            asm volatile("" : "+s"(F.wave)); F.tid = tid_from_wave(F.wave); F.lane = F.tid & 63;
            if (F.G == 256 && l == 0) { constexpr int nr_ = CV_LAYER - (CV_IN + CV_C1); LAS float* scr_ = (LAS float*)(F.lds + F.wave * 16384);
                for (int j = 0; j < CV_N3; ++j) { const int s_ = mi_ * NWAVES + F.wave + 128 * NWAVES * j;
                    if (s_ < nr_) convert_item(F, l * CV_LAYER + CV_IN + CV_C1 + s_, scr_);
                    else if (l == 0 && s_ - nr_ < CV_IN - CV_C2) convert_item(F, CV_LAYER + CV_C2 + (s_ - nr_), scr_); } }
            sub_wait(F, (unsigned*)(FWS + WS_CTL) + CW_SUB + 128 * l + 64, (unsigned)(F.G / 2));
        }
        else {
            const int rv = xg_ * 16 + (xj_ - 16), nrc = F.G / 2;
            unsigned* sub = (unsigned*)(FWS + WS_CTL) + CW_SUB + 128 * l;
            constexpr int RC_SPLIT = 104;
            rc_pass1_rwkv(F, rv * NWAVES + F.wave, nrc * NWAVES, 0, 128);
            rc_pass1_ret(F, rv * NWAVES + F.wave, nrc * NWAVES, 0, 128);
            sub_barrier(F, sub, (unsigned)nrc);
            const bool p2cu = (rv & 3) == 0 && (rv >> 2) < RC_UNITS;
            if (p2cu) {
                rc_pass2(F, rv >> 2, 0, RC_SPLIT, true, false);
                sub_wait(F, sub + 32, (unsigned)(nrc - RC_UNITS));
                rc_pass2(F, rv >> 2, RC_SPLIT, RC_NCH, false, true);
            } else {
                const int ov = rv - (rv >> 2) - 1, nov = nrc - RC_UNITS;
                rc_pass1_rwkv(F, ov * NWAVES + F.wave, nov * NWAVES, 128, 128);
                rc_pass1_ret(F, ov * NWAVES + F.wave, nov * NWAVES, 128, 128);
                sub_arrive(F, sub + 32);
            }
            sub_barrier(F, sub + 64, (unsigned)nrc);
        }
        asm volatile("" : "+s"(F.wave), "+s"(F.vcu), "+s"(F.G)); F.tid = tid_from_wave(F.wave); F.lane = F.tid & 63; { unsigned z_ = 0u; asm volatile("" : "+v"(z_)); F.zz = __builtin_amdgcn_readfirstlane(z_); }
        mixer_post(F, l, F.vcu * NWAVES + F.wave, F.G * NWAVES);
        GRID_BAR();
#if MOBA_CHECK
        moba_naive(F, F.vcu * NWAVES + F.wave, F.G * NWAVES);
        GRID_BAR();
        { float sd = 0.f, sn = 0.f; const bf16* NV = (const bf16*)(FWS + WS_U + 160 * MiB); const bf16* MXc = (const bf16*)(FWS + WS_MIXED);
          for (int m = F.vcu * NWAVES + F.wave; m < MROWS; m += F.G * NWAVES) for (int j = 0; j < 16; ++j) { const float a = bf2f(MXc[(size_t)m * DM + 1024 + j * 64 + F.lane]), b = bf2f(NV[(size_t)m * 1024 + j * 64 + F.lane]); sd += (a - b) * (a - b); sn += b * b; }
          atomicAdd((float*)(FWS + WS_CTL) + 8, sd); atomicAdd((float*)(FWS + WS_CTL) + 9, sn); }
        GRID_BAR();
#endif
        { pg8::Gemm g{MIXED, (const bf16*)(wl + W_OUT), MROWS, DM, DM}; pg8::StaticOrder S; S.init(MROWS, DM, F.G, (int)blockIdx.x);
          if (l == 0) { pg8::EpiResGate<true> E{F.in[F.zz + 0], XB, DM, modl + 2 * DM, 12288, SEQ}; pg8::gemm_phase<pg8::EpiResGate<true>, pg8::StaticOrder, true, true>(F.lds, g, S, E, F.wave); }
          else { pg8::EpiResGate<false> E{XB, XB, DM, modl + 2 * DM, 12288, SEQ}; pg8::gemm_phase<pg8::EpiResGate<false>, pg8::StaticOrder, true, true>(F.lds, g, S, E, F.wave); } }
        GRID_BAR();
        norm_phase<0, false>(F, XB, HB, F.in[F.zz + 22] + l * DM, modl + 3 * DM, modl + 4 * DM);
        GRID_BAR();
        { pg8::Gemm g{HB, (const bf16*)(wl + W_UP), MROWS, UPC, DM}; pg8::StaticOrder S; S.init(MROWS, UPC, F.G, (int)blockIdx.x);
          pg8::EpiConvGate E{ACT, DFF, (float*)(FWS + WS_HALO), F.in[F.zz + 16] + (size_t)l * 3 * UPC, F.in[F.zz + 17] + (size_t)l * UPC, UPC, DFF};
          pg8::gemm_phase<pg8::EpiConvGate, pg8::StaticOrder, true, true>(F.lds, g, S, E, F.wave); }
        if (l == 0 && F.G == 256 && blockIdx.x >= 128) { if (blockIdx.x < 224) adaln_item(F, 1, (int)blockIdx.x - 128); convert_gap(F, 1, 0, CV_C2, ((int)blockIdx.x - 128) * NWAVES + F.wave, 128 * NWAVES, CV_N2); }
        if (l == 1 && F.G == 256 && blockIdx.x >= 128) convert_gap(F, 1, CV_IN + CV_OUT + CV_UP, CV_DN, ((int)blockIdx.x - 128) * NWAVES + F.wave, 128 * NWAVES, CV_N2);
        GRID_BAR();
        conv_fixup_phase(F, l);
        GRID_BAR();
        { pg8::Gemm g{ACT, (const bf16*)(wl + W_DN), MROWS, DM, DFF}; pg8::StaticOrder S; S.init(MROWS, DM, F.G, (int)blockIdx.x);
          pg8::EpiResGate<false> E{XB, XB, DM, modl + 5 * DM, 12288, SEQ};
          pg8::gemm_phase<pg8::EpiResGate<false>, pg8::StaticOrder, true, true>(F.lds, g, S, E, F.wave); }
        GRID_BAR();
}

__global__ void __launch_bounds__(NTHR, 2) mega_fwd(Args args) {
    extern __shared__ __attribute__((aligned(16))) unsigned char lds[];
    Frame F;
    F.lds = (LAS unsigned char*)lds;
    F.tid = threadIdx.x; F.lane = F.tid & 63; F.wave = __builtin_amdgcn_readfirstlane(F.tid >> 6);
    F.G = gridDim.x; { const int bx = blockIdx.x; F.vcu = (F.G % 8 == 0) ? (bx % 8) * (F.G / 8) + bx / 8 : bx; }
    F.in = args.in; F.ws = args.ws; F.zz = 0;
    volatile LAS unsigned* MISC = (volatile LAS unsigned*)(F.lds + MISC_OFF);
    for (int u = F.tid; u < (LDS_BYTES - LDSCTL_OFF) / 4; u += NTHR) ((LAS unsigned*)(F.lds + LDSCTL_OFF))[u] = 0u;
    __syncthreads();
    XcdBarrier bar = xcd_barrier_post((unsigned*)(FWS + WS_CTL) + CW_BAR, MISC + 8, F.tid);

    p0_prologue(F);
    GRID_BAR();
    layer_fwd<0>(F, bar);
    layer_fwd<1>(F, bar);
    norm_phase<1, false>(F, XB, args.out, F.in[F.zz + 23], nullptr, nullptr);
}

extern "C" void kernel_launch(void* const* d_in, const int* in_sizes, int n_in, void* d_out, int out_size, void* d_ws, size_t ws_size, hipStream_t stream) {
    static int grid = 0;
    if (grid == 0) {
        if (n_in != 24 || out_size != MROWS * DM || ws_size < WS_END) { fprintf(stderr, "kernel_launch: unexpected shapes (n_in %d out %d ws %zu)\n", n_in, out_size, ws_size); grid = -1; return; }
        int dev = 0, cus = 0;
        if (hipGetDevice(&dev) != hipSuccess || hipDeviceGetAttribute(&cus, hipDeviceAttributeMultiprocessorCount, dev) != hipSuccess) { grid = -1; return; }
        if (hipFuncSetAttribute((const void*)mega_fwd, hipFuncAttributeMaxDynamicSharedMemorySize, LDS_BYTES) != hipSuccess) { fprintf(stderr, "kernel_launch: hipFuncSetAttribute failed\n"); grid = -1; return; }
        int per_cu = 0;
        if (hipOccupancyMaxActiveBlocksPerMultiprocessor(&per_cu, (const void*)mega_fwd, NTHR, LDS_BYTES) != hipSuccess || per_cu < 1) { fprintf(stderr, "kernel_launch: occupancy query says %d\n", per_cu); }
        (void)hipGetLastError();
        grid = cus;
    }
    if (grid < 0) return;
    (void)hipMemsetAsync((char*)d_ws + WS_CTL, 0, CTL_ZERO_BYTES, stream);
    Args a{};
    for (int i = 0; i < 24; ++i) a.in[i] = (const float*)d_in[i];
    a.out = (float*)d_out; a.ws = (unsigned char*)d_ws;
    hipLaunchKernelGGL(mega_fwd, dim3(grid), dim3(NTHR), LDS_BYTES, stream, a);
}
```

```cpp
#include <hip/hip_runtime.h>
#include <cstdio>
#include <cstdint>
#ifndef MOBA_NP
#define MOBA_NP 2
#endif
#ifndef MOBA_CHECK
#define MOBA_CHECK 0
#endif
__device__ __forceinline__ int tid_from_wave(int wave) { int l = (int)__builtin_amdgcn_mbcnt_hi(~0u, __builtin_amdgcn_mbcnt_lo(~0u, 0u)); asm volatile("" : "+v"(l)); return wave * 64 + l; }
namespace pg8 {
#define PG8_LAS __attribute__((address_space(3)))
typedef unsigned short bf16_t;
typedef short bf16x8 __attribute__((ext_vector_type(8)));
typedef float f32x4 __attribute__((ext_vector_type(4)));
typedef unsigned u32x4 __attribute__((ext_vector_type(4)));
constexpr int BM = 256, BK = 64, HALF = 128, HTB = HALF * BK * 2  , STAGE_BYTES = 8 * HTB, NXCD = 8, WGM = 8;

__host__ __device__ __forceinline__ int lds_byte(int r, int c) { const int st = (r >> 4) * 2 + (c >> 5), rr = r & 15, cc = c & 31, ob = rr * 64 + cc * 2; return st * 1024 + (ob ^ (((ob >> 9) & 1) << 5)); }
__host__ __device__ __forceinline__ void stage_rc(int b, int& R, int& C) { const int st = b / 1024, sb = b % 1024, swz = sb ^ (((sb >> 9) & 1) << 5); R = (st >> 1) * 16 + swz / 64; C = (st & 1) * 32 + (swz % 64) / 2; }
__host__ __device__ __forceinline__ int perm32(int rho) { const int n = rho >> 4, i = rho & 15; return 8 * (i >> 2) + 4 * n + (i & 3); }

struct Unit { int pm, pn; };
struct Gemm { const bf16_t* A; const bf16_t* Bt; int M, N, K; };

struct StaticOrder {
    int nM, nN, nwg, G, c;
    __host__ __device__ void init(int M, int N, int G_, int c_) { nM = M / BM; nN = N / BM; nwg = nM * nN; G = G_; c = c_; }
    __host__ __device__ bool next(int i, Unit& u) const {
        const long L = (long)i * G + c; if (L >= nwg) return false;
        int wgid = (int)L; { const int q = nwg / NXCD, r = nwg % NXCD, xcd = wgid % NXCD, off = wgid / NXCD; wgid = (xcd < r ? xcd * (q + 1) : r * (q + 1) + (xcd - r) * q) + off; }
        const int nig = WGM * nN, gid = wgid / nig, fm = gid * WGM, gsz = (nM - fm) < WGM ? (nM - fm) : WGM;
        u.pm = fm + ((wgid % nig) % gsz); u.pn = (wgid % nig) / gsz; return true;
    }
    __device__ __forceinline__ void a_ready(const Unit&) const {}
    __device__ __forceinline__ void done(const Unit&) const {}
};

__device__ __forceinline__ unsigned cvt_pk_bf16(float lo, float hi) { unsigned r; asm volatile("v_cvt_pk_bf16_f32 %0, %1, %2" : "=v"(r) : "v"(lo), "v"(hi)); return r; }

struct EpiBf16 {
    static constexpr bool PERM = true, AFTER_DRAIN = false;
    bf16_t* O; int ldc;
    __device__ __forceinline__ void operator()(const f32x4 (&acc)[2][2][4][2], const Unit& u, int wr, int wc, int fr, int fq) const {
        const int row0 = u.pm * BM + wr * 64 + fr; const int col0 = u.pn * BM + wc * 32 + 8 * fq;
#pragma unroll
        for (int ai = 0; ai < 2; ++ai)
#pragma unroll
            for (int m = 0; m < 4; ++m) { bf16_t* rowp = O + (size_t)(row0 + ai * HALF + m * 16) * ldc + col0;
#pragma unroll
                for (int bj = 0; bj < 2; ++bj) { const f32x4 v0 = acc[ai][bj][m][0], v1 = acc[ai][bj][m][1];
                    u32x4 w; w.x = cvt_pk_bf16(v0[0], v0[1]); w.y = cvt_pk_bf16(v0[2], v0[3]); w.z = cvt_pk_bf16(v1[0], v1[1]); w.w = cvt_pk_bf16(v1[2], v1[3]);
                    *(u32x4*)(rowp + bj * HALF) = w; } }
    }
};

template <int CTRL> __device__ __forceinline__ float dpp_ror(float v) { return __builtin_bit_cast(float, __builtin_amdgcn_update_dpp(0, __builtin_bit_cast(int, v), CTRL, 0xF, 0xF, true)); }
struct EpiConvGate {
    static constexpr bool PERM = true, AFTER_DRAIN = false;
    bf16_t* A; int lda; float* halo; const float* cw; const float* cb; int nup, dff;
    __device__ __forceinline__ void operator()(const f32x4 (&acc)[2][2][4][2], const Unit& u, int wr, int wc, int fr, int fq) const {
        const int chl = wc * 32 + 8 * fq;
#pragma unroll
        for (int n = 0; n < 2; ++n) {
            const int c = u.pn * 128 + chl + 4 * n, colp = u.pn * 256 + chl + 4 * n;
            const f32x4 wv0 = *(const f32x4*)(cw + c), wv1 = *(const f32x4*)(cw + nup + c), wv2 = *(const f32x4*)(cw + 2 * nup + c), bv = *(const f32x4*)(cb + c);
            const f32x4 wg0 = *(const f32x4*)(cw + dff + c), wg1 = *(const f32x4*)(cw + nup + dff + c), wg2 = *(const f32x4*)(cw + 2 * nup + dff + c), bg = *(const f32x4*)(cb + dff + c);
#pragma unroll
            for (int ai = 0; ai < 2; ++ai) {
                const int grow = u.pm * BM + ai * HALF + wr * 64;
                float* hb = halo + (size_t)(grow >> 6) * 4 * nup + colp;
                if (fr < 2) { *(f32x4*)(hb + (size_t)fr * nup) = acc[ai][0][0][n]; *(f32x4*)(hb + (size_t)fr * nup + 128) = acc[ai][1][0][n]; }
                if (fr >= 14) { *(f32x4*)(hb + (size_t)(fr - 12) * nup) = acc[ai][0][3][n]; *(f32x4*)(hb + (size_t)(fr - 12) * nup + 128) = acc[ai][1][3][n]; }
                f32x4 cv[4];
                {   f32x4 P1 = {0.f, 0.f, 0.f, 0.f}, P2 = P1;
#pragma unroll
                    for (int m = 0; m < 4; ++m) { f32x4 R1, R2;
#pragma unroll
                        for (int e = 0; e < 4; ++e) { R1[e] = dpp_ror<0x121>(acc[ai][0][m][n][e]); R2[e] = dpp_ror<0x122>(acc[ai][0][m][n][e]); }
                        const f32x4 p1 = (fr >= 1) ? R1 : P1, p2 = (fr >= 2) ? R2 : P2; P1 = R1; P2 = R2;
                        cv[m] = wv0 * p2 + wv1 * p1 + wv2 * acc[ai][0][m][n] + bv; } }
                {   f32x4 P1 = {0.f, 0.f, 0.f, 0.f}, P2 = P1;
#pragma unroll
                    for (int m = 0; m < 4; ++m) { f32x4 R1, R2;
#pragma unroll
                        for (int e = 0; e < 4; ++e) { R1[e] = dpp_ror<0x121>(acc[ai][1][m][n][e]); R2[e] = dpp_ror<0x122>(acc[ai][1][m][n][e]); }
                        const f32x4 p1 = (fr >= 1) ? R1 : P1, p2 = (fr >= 2) ? R2 : P2; P1 = R1; P2 = R2;
                        const f32x4 cg = wg0 * p2 + wg1 * p1 + wg2 * acc[ai][1][m][n] + bg;
                        f32x4 o;
#pragma unroll
                        for (int e = 0; e < 4; ++e) o[e] = cg[e] * __builtin_amdgcn_rcpf(1.0f + __expf(-cg[e])) * cv[m][e];
                        unsigned w0 = cvt_pk_bf16(o[0], o[1]), w1 = cvt_pk_bf16(o[2], o[3]);
                        *(unsigned long long*)(A + (size_t)(grow + m * 16 + fr) * lda + c) = (unsigned long long)w0 | ((unsigned long long)w1 << 32); } }
            }
        }
    }
};

template <bool BASE_F32>
struct EpiResGate {
    static constexpr bool PERM = true, AFTER_DRAIN = false;
    const void* base; bf16_t* out; int ldc; const float* gate; int gstride; int rows_per_batch;
    __device__ __forceinline__ void operator()(const f32x4 (&acc)[2][2][4][2], const Unit& u, int wr, int wc, int fr, int fq) const {
        const int col0 = u.pn * BM + wc * 32 + 8 * fq;
        const int b = (u.pm * BM) / rows_per_batch;
        f32x4 gv[2][2];
#pragma unroll
        for (int bj = 0; bj < 2; ++bj)
#pragma unroll
            for (int n = 0; n < 2; ++n) gv[bj][n] = *(const f32x4*)(gate + (size_t)b * gstride + col0 + bj * HALF + n * 4);
#pragma unroll
        for (int ai = 0; ai < 2; ++ai)
#pragma unroll
            for (int m = 0; m < 4; ++m) { const size_t off = (size_t)(u.pm * BM + ai * HALF + wr * 64 + m * 16 + fr) * ldc + col0;
#pragma unroll
                for (int bj = 0; bj < 2; ++bj) { f32x4 b0, b1;
                    if (BASE_F32) { b0 = *(const f32x4*)((const float*)base + off + bj * HALF); b1 = *(const f32x4*)((const float*)base + off + bj * HALF + 4); }
                    else { const u32x4 w = *(const u32x4*)((const bf16_t*)base + off + bj * HALF);
                        b0 = (f32x4){__builtin_bit_cast(float, w.x << 16), __builtin_bit_cast(float, w.x & 0xffff0000u), __builtin_bit_cast(float, w.y << 16), __builtin_bit_cast(float, w.y & 0xffff0000u)};
                        b1 = (f32x4){__builtin_bit_cast(float, w.z << 16), __builtin_bit_cast(float, w.z & 0xffff0000u), __builtin_bit_cast(float, w.w << 16), __builtin_bit_cast(float, w.w & 0xffff0000u)}; }
                    const f32x4 o0 = b0 + gv[bj][0] * acc[ai][bj][m][0], o1 = b1 + gv[bj][1] * acc[ai][bj][m][1];
                    u32x4 w; w.x = cvt_pk_bf16(o0[0], o0[1]); w.y = cvt_pk_bf16(o0[2], o0[3]); w.z = cvt_pk_bf16(o1[0], o1[1]); w.w = cvt_pk_bf16(o1[2], o1[3]);
                    *(u32x4*)(out + off + bj * HALF) = w; }
                if (m & 1) asm volatile("" ::: "memory"); }
    }
};

template <class Epi, class Sched, bool ALIGN_EPI = false, bool SP2 = false>
__device__ __forceinline__ void gemm_phase(PG8_LAS unsigned char* lds, const Gemm g, const Sched& S, const Epi& E, int wave_) {
    const int tid_ = tid_from_wave(wave_);
    const int tid = tid_, wid = __builtin_amdgcn_readfirstlane(tid >> 6), lane = tid & 63, wr = wid >> 2, wc = wid & 3, fr = lane & 15, fq = lane >> 4;
    const int K = g.K, nt = K / BK;
    unsigned voffA[2], voffB[2];
#pragma unroll
    for (int i = 0; i < 2; ++i) { int R, C; stage_rc(tid * 16 + i * 8192, R, C); const int Rb = Epi::PERM ? ((R & ~31) + perm32(R & 31)) : R;
        voffA[i] = (unsigned)(R * K + C) * 2u; voffB[i] = (unsigned)(Rb * K + C) * 2u; }
    const size_t kstep = (size_t)(BK * 2);
    const size_t hstep = (size_t)HALF * K * 2;
    const size_t tstep = 2 * hstep;
    const unsigned ldsw = (unsigned)wid * 1024u;
    const int aoff = lds_byte(wr * 64 + fr, fq * 8), boff = lds_byte(wc * 32 + fr, fq * 8);
#define PG8_SA(b, h) (((b) * 2 + (h)) * HTB)
#define PG8_SB(b, h) ((4 + (b) * 2 + (h)) * HTB)
#define PG8_STAGE(bufoff, gbase, voff) do { _Pragma("unroll") for (int _i = 0; _i < 2; ++_i) \
        __builtin_amdgcn_global_load_lds((const unsigned*)((const char*)(gbase) + (voff)[_i]), (PG8_LAS unsigned*)(lds + (bufoff) + ldsw + _i * 8192), 16, 0, 0); } while (0)
#define PG8_LDA(dst, b, h) do { _Pragma("unroll") for (int m = 0; m < 4; ++m) _Pragma("unroll") for (int k = 0; k < 2; ++k) dst[m][k] = *(const PG8_LAS bf16x8*)(lds + PG8_SA(b, h) + aoff + m * 2048 + k * 1024); } while (0)
#define PG8_LDB(dst, b, h) do { _Pragma("unroll") for (int n = 0; n < 2; ++n) _Pragma("unroll") for (int k = 0; k < 2; ++k) dst[n][k] = *(const PG8_LAS bf16x8*)(lds + PG8_SB(b, h) + boff + n * 2048 + k * 1024); } while (0)
#define PG8_MMA(ai, bj, At, Bt) do { __builtin_amdgcn_s_setprio(1); _Pragma("unroll") for (int m = 0; m < 4; ++m) _Pragma("unroll") for (int n = 0; n < 2; ++n) _Pragma("unroll") for (int k = 0; k < 2; ++k) \
        acc[ai][bj][m][n] = __builtin_amdgcn_mfma_f32_16x16x32_bf16(Bt[n][k], At[m][k], acc[ai][bj][m][n], 0, 0, 0); __builtin_amdgcn_s_setprio(0); } while (0)
#define PG8_WAIT_V(n) asm volatile("s_waitcnt vmcnt(" #n ")" ::: "memory")
#define PG8_WAIT_L(n) asm volatile("s_waitcnt lgkmcnt(" #n ")" ::: "memory")
#define PG8_BAR __builtin_amdgcn_s_barrier()
#define PG8_SCHED __builtin_amdgcn_sched_barrier(0)
    Unit cur, nxt; int ui = 0;
    if (!S.next(0, cur)) return;
    f32x4 acc[2][2][4][2];
#pragma unroll
    for (int a = 0; a < 2; ++a)
#pragma unroll
        for (int b = 0; b < 2; ++b)
#pragma unroll
            for (int m = 0; m < 4; ++m)
#pragma unroll
                for (int n = 0; n < 2; ++n) acc[a][b][m][n] = (f32x4){0.f, 0.f, 0.f, 0.f};
    bf16x8 At[4][2], B0[2][2], B1[2][2];
    const char* cA = (const char*)g.A + (size_t)cur.pm * tstep; const char* cB = (const char*)g.Bt + (size_t)cur.pn * tstep;
    S.a_ready(cur);
    if constexpr (SP2) {
        PG8_STAGE(PG8_SB(0, 0), cB, voffB); PG8_STAGE(PG8_SB(0, 1), cB + hstep, voffB); PG8_STAGE(PG8_SA(0, 0), cA, voffA); PG8_STAGE(PG8_SA(0, 1), cA + hstep, voffA);
        if (wr == 1) PG8_BAR;
        PG8_WAIT_V(2); PG8_BAR;
        PG8_STAGE(PG8_SB(1, 0), cB + kstep, voffB); PG8_STAGE(PG8_SA(1, 0), cA + kstep, voffA); PG8_STAGE(PG8_SB(1, 1), cB + hstep + kstep, voffB);
        PG8_WAIT_V(6); PG8_BAR;
    } else {
        PG8_STAGE(PG8_SB(0, 0), cB, voffB); PG8_STAGE(PG8_SA(0, 0), cA, voffA); PG8_STAGE(PG8_SB(0, 1), cB + hstep, voffB); PG8_STAGE(PG8_SA(0, 1), cA + hstep, voffA);
        if (wr == 1) PG8_BAR;
        PG8_WAIT_V(4); PG8_BAR;
        PG8_STAGE(PG8_SB(1, 0), cB + kstep, voffB); PG8_STAGE(PG8_SA(1, 0), cA + kstep, voffA); PG8_STAGE(PG8_SB(1, 1), cB + hstep + kstep, voffB);
        PG8_WAIT_V(6); PG8_BAR;
    }
    for (;;) {
        const bool has_next = S.next(ui + 1, nxt);
        const char* nA = has_next ? (const char*)g.A + (size_t)nxt.pm * tstep : cA; const char* nB = has_next ? (const char*)g.Bt + (size_t)nxt.pn * tstep : cB;
        for (int t = 0; t < nt; t += 2) {
            const bool last = (t == nt - 2);
            const char* a1 = cA + (size_t)(t + 1) * kstep;
            const char* a2 = last ? nA : cA + (size_t)(t + 2) * kstep; const char* b2 = last ? nB : cB + (size_t)(t + 2) * kstep;
            const char* a3 = a2 + kstep; const char* b3 = b2 + kstep;
            if (last && has_next) S.a_ready(nxt);
            if constexpr (SP2) {
            PG8_LDB(B0, 0, 0); PG8_LDB(B1, 0, 1); PG8_SCHED; PG8_LDA(At, 0, 0); PG8_STAGE(PG8_SA(1, 1), a1 + hstep, voffA);
            PG8_WAIT_V(8); PG8_WAIT_L(0); PG8_BAR; PG8_MMA(0, 0, At, B0); PG8_MMA(0, 1, At, B1); PG8_BAR; PG8_SCHED;
            PG8_LDA(At, 0, 1); PG8_STAGE(PG8_SB(0, 0), b2, voffB); PG8_STAGE(PG8_SB(0, 1), b2 + hstep, voffB); PG8_STAGE(PG8_SA(0, 0), a2, voffA);
            PG8_WAIT_V(8); PG8_WAIT_L(0); PG8_BAR; PG8_MMA(1, 0, At, B0); PG8_MMA(1, 1, At, B1); PG8_BAR; PG8_SCHED;
            PG8_LDB(B0, 1, 0); PG8_LDB(B1, 1, 1); PG8_SCHED; PG8_LDA(At, 1, 0); PG8_STAGE(PG8_SA(0, 1), a2 + hstep, voffA);
            PG8_WAIT_V(8); PG8_WAIT_L(0); PG8_BAR; PG8_MMA(0, 0, At, B0); PG8_MMA(0, 1, At, B1); PG8_BAR; PG8_SCHED;
            PG8_LDA(At, 1, 1); PG8_STAGE(PG8_SB(1, 0), b3, voffB); PG8_STAGE(PG8_SB(1, 1), b3 + hstep, voffB); PG8_STAGE(PG8_SA(1, 0), a3, voffA);
            PG8_WAIT_V(8); PG8_WAIT_L(0); PG8_BAR; PG8_MMA(1, 0, At, B0); PG8_MMA(1, 1, At, B1); PG8_BAR; PG8_SCHED;
            } else {
            PG8_LDB(B0, 0, 0); PG8_SCHED; PG8_LDA(At, 0, 0); PG8_STAGE(PG8_SA(1, 1), a1 + hstep, voffA);
            PG8_WAIT_L(8); PG8_BAR; PG8_WAIT_L(0); PG8_MMA(0, 0, At, B0); PG8_BAR; PG8_SCHED;
            PG8_LDB(B1, 0, 1); PG8_STAGE(PG8_SB(0, 0), b2, voffB);
            PG8_BAR; PG8_WAIT_L(0); PG8_MMA(0, 1, At, B1); PG8_BAR;
            PG8_LDA(At, 0, 1); PG8_STAGE(PG8_SA(0, 0), a2, voffA);
            PG8_BAR; PG8_WAIT_L(0); PG8_MMA(1, 0, At, B0); PG8_BAR; PG8_SCHED;
            PG8_STAGE(PG8_SB(0, 1), b2 + hstep, voffB);
            PG8_WAIT_V(6); PG8_BAR; PG8_MMA(1, 1, At, B1); PG8_BAR;
            PG8_LDB(B0, 1, 0); PG8_SCHED; PG8_LDA(At, 1, 0); PG8_STAGE(PG8_SA(0, 1), a2 + hstep, voffA);
            PG8_WAIT_L(8); PG8_BAR; PG8_WAIT_L(0); PG8_MMA(0, 0, At, B0); PG8_BAR; PG8_SCHED;
            PG8_LDB(B1, 1, 1); PG8_STAGE(PG8_SB(1, 0), b3, voffB);
            PG8_BAR; PG8_WAIT_L(0); PG8_MMA(0, 1, At, B1); PG8_BAR;
            PG8_LDA(At, 1, 1); PG8_STAGE(PG8_SA(1, 0), a3, voffA);
            PG8_BAR; PG8_WAIT_L(0); PG8_MMA(1, 0, At, B0); PG8_BAR; PG8_SCHED;
            PG8_STAGE(PG8_SB(1, 1), b3 + hstep, voffB);
            PG8_WAIT_V(6); PG8_BAR; PG8_MMA(1, 1, At, B1); PG8_BAR;
            }
        }
        if constexpr (ALIGN_EPI) { if (wr == 0) PG8_BAR; }
        if constexpr (!Epi::AFTER_DRAIN) { E(acc, cur, wr, wc, fr, fq); S.done(cur); }
        if (!has_next) break;
#pragma unroll
        for (int a = 0; a < 2; ++a)
#pragma unroll
            for (int b = 0; b < 2; ++b)
#pragma unroll
                for (int m = 0; m < 4; ++m)
#pragma unroll
                    for (int n = 0; n < 2; ++n) acc[a][b][m][n] = (f32x4){0.f, 0.f, 0.f, 0.f};
        cur = nxt; cA = nA; cB = nB; ++ui;
        if constexpr (ALIGN_EPI) { if (wr == 1) PG8_BAR; }
    }
    PG8_WAIT_V(0);
    if constexpr (!ALIGN_EPI) { if (wr == 0) PG8_BAR; }
    PG8_BAR;
    if constexpr (Epi::AFTER_DRAIN) { E.fused(acc, cur, wr, wc, fr, fq, lds, wid, lane); S.done(cur); }
#undef PG8_SA
#undef PG8_SB
#undef PG8_STAGE
#undef PG8_LDA
#undef PG8_LDB
#undef PG8_MMA
#undef PG8_WAIT_V
#undef PG8_WAIT_L
#undef PG8_BAR
#undef PG8_SCHED
}
}

namespace moba {
using bf16 = unsigned short;
typedef short bf16x8 __attribute__((ext_vector_type(8)));
typedef short s16x4 __attribute__((ext_vector_type(4)));
typedef float f32x16 __attribute__((ext_vector_type(16)));
typedef float f32x4 __attribute__((ext_vector_type(4)));
typedef unsigned u32x4 __attribute__((ext_vector_type(4)));
#define MLAS __attribute__((address_space(3)))
typedef MLAS char lchar; typedef MLAS float lfloat; typedef MLAS bf16x8 lbf16x8;
template <class A, class Bt> struct same_t { static constexpr bool v = false; };
template <class A> struct same_t<A, A> { static constexpr bool v = true; };
constexpr int D = 128, LDI = 6656, LDO = 2048;
constexpr float THR = 8.f;
constexpr bool WSKIP = false;
constexpr float SCALE = 0.08838834764831845f;
constexpr int NW = 8, QBLK = 32, KVBLK = 64, QB = NW * QBLK;
constexpr int SHM_V = KVBLK * D * 2, SHM_K = KVBLK * D * 2;
constexpr int LDS_BYTES = 2 * SHM_V + 2 * SHM_K + NW * 64 * 4;
#define KSWZ(row, colB) ((row) * 256 + ((colB) ^ (((row) & 7) << 4)))
#define SBAR() __builtin_amdgcn_sched_barrier(0)
__device__ __forceinline__ int v_st(int k, int c) { const int kk = (k & ~0xC) | ((k & 4) << 1) | ((k & 8) >> 1); return ((kk >> 3) * 4 + (c >> 5)) * 512 + ((kk & 7) * 32 + (c & 31)) * 2; }
__device__ __forceinline__ int v_rd_base(int lane) { return ((lane & 3) << 3) | (((lane >> 2) & 3) << 6) | (((lane >> 4) & 1) << 5) | (((lane >> 5) & 1) << 8); }
constexpr int v_rd_off(int d0, int ks, int half) { return d0 * 512 + ks * 4096 + half * 2048; }
__device__ __forceinline__ int crow(int r, int hi) { return (r & 3) + 8 * (r >> 2) + 4 * hi; }
__device__ __forceinline__ unsigned cvtpk(float lo, float hi) {
    unsigned r; asm volatile("v_cvt_pk_bf16_f32 %0, %1, %2" : "=v"(r) : "v"(lo), "v"(hi)); return r;
}
__device__ __forceinline__ bf16x8 pack8(f32x4 a, f32x4 b) {
    u32x4 w = {cvtpk(a[0], a[1]), cvtpk(a[2], a[3]), cvtpk(b[0], b[1]), cvtpk(b[2], b[3])};
    return *reinterpret_cast<bf16x8*>(&w);
}
template <class T> __device__ __forceinline__ bf16x8 load8(const T* p) {
    if constexpr (same_t<T, float>::v) { return pack8(*(const f32x4*)p, *(const f32x4*)(p + 4)); }
    else { return *reinterpret_cast<const bf16x8*>(p); }
}
__device__ __forceinline__ void mask_tile(f32x16& p0, f32x16& p1, int dq, unsigned W) {
    const float NEG = -__builtin_inff();
#pragma unroll
    for (int r = 0; r < 16; ++r) {
        const int c = (r & 3) + 8 * (r >> 2);
        if ((unsigned)(dq - c) >= W) p0[r] = NEG;
        if ((unsigned)(dq - c - 32) >= W) p1[r] = NEG;
    }
}
__device__ __forceinline__ void partialSM(f32x16& p0, f32x16& p1, float& m_reg, float& mn, float& alpha) {
    float pmax = p0[0]; for (int r = 1; r < 16; ++r) pmax = fmaxf(pmax, p0[r]); for (int r = 0; r < 16; ++r) pmax = fmaxf(pmax, p1[r]);
    { auto rr = __builtin_amdgcn_permlane32_swap(__float_as_uint(pmax), __float_as_uint(pmax), false, false);
      pmax = fmaxf(__uint_as_float(rr[0]), __uint_as_float(rr[1])); }
    constexpr float C2 = 1.4426950408889634f * SCALE;
    if (__builtin_expect(__all((pmax - m_reg) * SCALE <= THR), 1)) { mn = m_reg; alpha = 1.f; }
    else { mn = fmaxf(m_reg, pmax); alpha = __builtin_amdgcn_exp2f((m_reg - mn) * C2); m_reg = mn; }
    const float mnL = -mn * C2;
    for (int r = 0; r < 16; ++r) p0[r] = fmaf(p0[r], C2, mnL); for (int r = 0; r < 16; ++r) p1[r] = fmaf(p1[r], C2, mnL);
    for (int r = 0; r < 16; ++r) p0[r] = __builtin_amdgcn_exp2f(p0[r]);
}
__device__ __forceinline__ void finishSM(f32x16& p0, f32x16& p1, float alpha, float& l_reg, bf16x8& pa0, bf16x8& pa1, bf16x8& pa2, bf16x8& pa3) {
    for (int r = 0; r < 16; ++r) p1[r] = __builtin_amdgcn_exp2f(p1[r]);
    float ps = 0; for (int r = 0; r < 16; ++r) ps += p0[r]; for (int r = 0; r < 16; ++r) ps += p1[r];
    { auto rr = __builtin_amdgcn_permlane32_swap(__float_as_uint(ps), __float_as_uint(ps), false, false);
      ps = __uint_as_float(rr[0]) + __uint_as_float(rr[1]); }
    l_reg = l_reg * alpha + ps;
#define PK4(P, B_, OUT) do { unsigned a0 = cvtpk(P[B_+0], P[B_+1]), a1 = cvtpk(P[B_+2], P[B_+3]);                          \
        unsigned b0 = cvtpk(P[B_+4], P[B_+5]), b1 = cvtpk(P[B_+6], P[B_+7]);                                             \
        auto r0 = __builtin_amdgcn_permlane32_swap(a0, b0, false, false); auto r1 = __builtin_amdgcn_permlane32_swap(a1, b1, false, false); \
        u32x4 w = {r0[0], r1[0], r0[1], r1[1]}; OUT = *reinterpret_cast<bf16x8*>(&w); } while (0)
    PK4(p0, 0, pa0); PK4(p0, 8, pa1); PK4(p1, 0, pa2); PK4(p1, 8, pa3);
#undef PK4
}
template <int KB, bool SK>
__device__ __forceinline__ void qkt(f32x16& p0, f32x16& p1, const lchar* K_lds, int r32, int hi, const bf16x8* qr, bool act, float slopeR, float lb) {
    if (SK && !act) { const float NEG = -__builtin_inff();
#pragma unroll
        for (int r = 0; r < 16; ++r) { p0[r] = NEG; p1[r] = NEG; } return; }
#pragma unroll
    for (int r = 0; r < 16; ++r) { const int c = (r & 3) + 8 * (r >> 2); p0[r] = __builtin_fmaf(slopeR, (float)c, lb); p1[r] = __builtin_fmaf(slopeR, (float)(c + 32), lb); }
    const lchar* kb[4];
#pragma unroll
    for (int dd = 0; dd < 4; ++dd) kb[dd] = K_lds + KB * SHM_K + KSWZ(r32, (dd * 16 + hi * 8) * 2);
#pragma unroll
    for (int d0 = 0; d0 < 8; ++d0) { const lchar* a = kb[d0 & 3] + (d0 >> 2) * 128;
        bf16x8 b0 = *(const lbf16x8*)(a);
        bf16x8 b1 = *(const lbf16x8*)(a + 32 * 256);
        p0 = __builtin_amdgcn_mfma_f32_32x32x16_bf16(b0, qr[d0], p0, 0, 0, 0);
        p1 = __builtin_amdgcn_mfma_f32_32x32x16_bf16(b1, qr[d0], p1, 0, 0, 0); }
}
template <int VB, bool SK>
__device__ __forceinline__ void pv_tile(f32x16* o, int vb0, bf16x8 pa0, bf16x8 pa1, bf16x8 pa2, bf16x8 pa3, bool act) {
    if (SK && !act) return;
#define TRRD(dst, off) asm volatile("ds_read_b64_tr_b16 %0, %1 offset:%2" : "=&v"(dst) : "v"(vb0), "i"(off) : "memory")
#define PV_D0(d0) do { s16x4 l0, l1, l2, l3, h0, h1, h2, h3; constexpr int b_ = VB * SHM_V + v_rd_off(d0, 0, 0);     \
        TRRD(l0, b_); TRRD(h0, b_ + 2048); TRRD(l1, b_ + 4096); TRRD(h1, b_ + 6144); TRRD(l2, b_ + 8192); TRRD(h2, b_ + 10240); TRRD(l3, b_ + 12288); TRRD(h3, b_ + 14336); \
        asm volatile("s_waitcnt lgkmcnt(0)" ::: "memory"); SBAR();                 \
        o[d0] = __builtin_amdgcn_mfma_f32_32x32x16_bf16(pa0, (bf16x8){l0[0], l0[1], l0[2], l0[3], h0[0], h0[1], h0[2], h0[3]}, o[d0], 0, 0, 0);   \
        o[d0] = __builtin_amdgcn_mfma_f32_32x32x16_bf16(pa1, (bf16x8){l1[0], l1[1], l1[2], l1[3], h1[0], h1[1], h1[2], h1[3]}, o[d0], 0, 0, 0);   \
        o[d0] = __builtin_amdgcn_mfma_f32_32x32x16_bf16(pa2, (bf16x8){l2[0], l2[1], l2[2], l2[3], h2[0], h2[1], h2[2], h2[3]}, o[d0], 0, 0, 0);   \
        o[d0] = __builtin_amdgcn_mfma_f32_32x32x16_bf16(pa3, (bf16x8){l3[0], l3[1], l3[2], l3[3], h3[0], h3[1], h3[2], h3[3]}, o[d0], 0, 0, 0); } while (0)
    PV_D0(0); PV_D0(1); PV_D0(2); PV_D0(3);
#undef PV_D0
#undef TRRD
}

typedef __attribute__((address_space(1))) char gchar; typedef __attribute__((address_space(1))) bf16x8 gbf16x8;
__device__ __forceinline__ const gchar* uni_ptr(const char* p) { const unsigned long long v = (unsigned long long)p;
    const unsigned lo = __builtin_amdgcn_readfirstlane((unsigned)v), hi = __builtin_amdgcn_readfirstlane((unsigned)(v >> 32)); return (const gchar*)(((unsigned long long)hi << 32) | lo); }
template <class TIn, class TOut> struct BlockRef { const TIn* Q; const TIn* K; const TIn* V; TOut* O; int P0; const __attribute__((address_space(3))) unsigned* sel; float slopeR; };
template <class TIn> struct Seam {
    bf16x8 qr[8];
    bf16x8 st_v0, st_v1, st_k0, st_k1; f32x4 sf0, sf1, sf2, sf3;
    f32x4 tq[16];
};
__device__ __forceinline__ int swa_jlo(int P0, int W) { const int lowk = P0 - W + 1; return lowk > 0 ? lowk / KVBLK : 0; }
#define ROW(p, k0, rr) ((const TIn*)((const char*)(p) + (size_t)(k0) * (LDI * sizeof(TIn)) + (unsigned)(((rr) * LDI + sc) * (int)sizeof(TIn))))
#define VMW() asm volatile("s_waitcnt vmcnt(0)" ::: "memory")
#define VMWN(n) asm volatile("s_waitcnt vmcnt(%0)" :: "i"(n) : "memory")
#define SLOAD_H(Kp, Vp, k0) do { const gchar* kb__ = uni_ptr((const char*)(Kp) + (size_t)(k0) * (LDI * sizeof(TIn))); const gchar* vb__ = uni_ptr((const char*)(Vp) + (size_t)(k0) * (LDI * sizeof(TIn))); \
                         S.st_v0 = *(const gbf16x8*)(vb__ + roff0); S.st_v1 = *(const gbf16x8*)(vb__ + roff1);              \
                         S.st_k0 = *(const gbf16x8*)(kb__ + roff0); S.st_k1 = *(const gbf16x8*)(kb__ + roff1); } while (0)
#define SWRITE_HK(bf) do { *(lbf16x8*)(K_lds + (bf) * SHM_K + kws) = S.st_k0; *(lbf16x8*)(K_lds + (bf) * SHM_K + kws + 32 * 256) = S.st_k1; } while (0)
#define SWRITE_HV(bf) do { *(lbf16x8*)(V_lds + (bf) * SHM_V + vst0) = S.st_v0; *(lbf16x8*)(V_lds + (bf) * SHM_V + vst1) = S.st_v1; } while (0)
#define SWRITE_H(bf) do { SWRITE_HV(bf); SWRITE_HK(bf); } while (0)
#define SLOAD_F(p, k0) do { S.sf0 = *(const f32x4*)ROW(p, k0, sr); S.sf1 = *(const f32x4*)(ROW(p, k0, sr) + 4);                \
                            S.sf2 = *(const f32x4*)ROW(p, k0, 32 + sr); S.sf3 = *(const f32x4*)(ROW(p, k0, 32 + sr) + 4); } while (0)
#define SWRITE_KF(bf) do { *(lbf16x8*)(K_lds + (bf) * SHM_K + kws) = pack8(S.sf0, S.sf1); *(lbf16x8*)(K_lds + (bf) * SHM_K + kws + 32 * 256) = pack8(S.sf2, S.sf3); } while (0)
#define SWRITE_VF(bf) do { *(lbf16x8*)(V_lds + (bf) * SHM_V + vst0) = pack8(S.sf0, S.sf1); *(lbf16x8*)(V_lds + (bf) * SHM_V + vst1) = pack8(S.sf2, S.sf3); } while (0)
template <class TIn, class TOut>
__device__ __forceinline__ void causal_swa_prime(const BlockRef<TIn, TOut>& cur, int W, lchar* lds, Seam<TIn>& S, int wave_) {
    constexpr bool F32 = same_t<TIn, float>::v;
    const int tid_ = tid_from_wave(wave_);
    const int tid = tid_, wid = __builtin_amdgcn_readfirstlane(tid >> 6), lane = tid & 63, r32 = lane & 31, hi = lane >> 5;
    const int sr = tid >> 4, sc = (tid & 15) * 8, kws = KSWZ(sr, sc * 2); lchar* K_lds = lds + 2 * SHM_V;
    const unsigned roff0 = (unsigned)((sr * LDI + sc) * (int)sizeof(TIn)), roff1 = (unsigned)(((32 + sr) * LDI + sc) * (int)sizeof(TIn));
    const int kb0 = ((cur.P0 + QB - 1) / KVBLK) * KVBLK;
    for (int d0 = 0; d0 < 8; ++d0) S.qr[d0] = *(const gbf16x8*)(uni_ptr((const char*)cur.Q) + (unsigned)(((wid * QBLK + r32) * LDI + hi * 8) * (int)sizeof(TIn)) + d0 * 16 * sizeof(TIn));
    if constexpr (F32) { SLOAD_F((const float*)cur.K, kb0); VMW(); SWRITE_KF(0); SBAR(); SLOAD_F((const float*)cur.V, kb0); }
    else { SLOAD_H(cur.K, cur.V, kb0); VMW(); SWRITE_HK(0); }
    __syncthreads();
}
template <class TIn, class TOut>
__device__ __forceinline__ void causal_swa_block(const BlockRef<TIn, TOut>& cur, const BlockRef<TIn, TOut>& nxt, int skv, int W, lchar* lds, Seam<TIn>& S, int wave_) {
    constexpr bool F32 = same_t<TIn, float>::v;
    const int tid_ = tid_from_wave(wave_);
    const int tid = tid_, wid = __builtin_amdgcn_readfirstlane(tid >> 6), lane = tid & 63, r32 = lane & 31, hi = lane >> 5;
    const int j_lo = swa_jlo(cur.P0, W);
    int j_hi = (cur.P0 + QB - 1) / KVBLK + 1; if (j_hi > skv / KVBLK) j_hi = skv / KVBLK;
    const int NT = j_hi - j_lo;
    const int kbn = ((nxt.P0 + QB - 1) / KVBLK) * KVBLK;
    const unsigned selm = cur.sel[wid * QBLK + r32] | (1u << (cur.P0 >> 8)); const float slopeR = __builtin_bit_cast(float, __builtin_amdgcn_readfirstlane(__builtin_bit_cast(unsigned, cur.slopeR))); const int tqm = cur.P0 + wid * QBLK + r32 - 4 * hi;
#define LB(t) (((selm >> (KBASE(t) >> 8)) & 1u) ? slopeR * (float)(KBASE(t) - tqm) : -__builtin_inff())
    const int qlo = cur.P0 + wid * QBLK, qm = qlo + r32 - 4 * hi;
    lchar* V_lds = lds; lchar* K_lds = lds + 2 * SHM_V;
    lfloat* ws = (lfloat*)(lds + 2 * SHM_V + 2 * SHM_K) + wid * 64; lfloat* li_l = ws; lfloat* al_l = ws + 32;
    float m_reg = -1e30f, l_reg = 0; f32x16 o[4] = {};
    const unsigned roff0 = (unsigned)(((tid >> 4) * LDI + (tid & 15) * 8) * (int)sizeof(TIn)), roff1 = (unsigned)(((32 + (tid >> 4)) * LDI + (tid & 15) * 8) * (int)sizeof(TIn));
    const int sr = tid >> 4, sc = (tid & 15) * 8, vst0 = v_st(sr, sc), vst1 = v_st(32 + sr, sc), kws = KSWZ(sr, sc * 2);
    const int vb0 = (int)(unsigned)(uintptr_t)V_lds + v_rd_base(lane);
    const TIn* Kh = cur.K; const TIn* Vh = cur.V;
#define RESC(a) do { if (__any((a) < 1.f)) { if (hi == 0) al_l[r32] = (a); asm volatile("s_waitcnt lgkmcnt(0)" ::: "memory");              \
                     for (int d_ = 0; d_ < 4; ++d_) for (int r = 0; r < 16; ++r) o[d_][r] *= al_l[crow(r, hi)]; } } while (0)
#define KBASE(t) ((j_hi - 1 - (t)) * KVBLK)
#define ACT(t) (KBASE(t) <= qlo + QBLK - 1 && KBASE(t) + KVBLK - 1 >= qlo - W + 1)
#define MASKT(P0_, P1_, t) do { const int kb_ = KBASE(t); if ((!SK || ACT(t)) && (kb_ + KVBLK - 1 > qlo || kb_ <= qlo + QBLK - 1 - W)) mask_tile(P0_, P1_, qm - kb_, (unsigned)W); } while (0)
    constexpr int NQL = F32 ? 16 : 8;
    constexpr bool SK = WSKIP && !F32;
#define SEAM_K0() do { VMWN(NQL); if constexpr (F32) { SWRITE_KF(0); SBAR(); SLOAD_F((const float*)nxt.V, kbn); } else { SWRITE_HK(0); } SBAR(); } while (0)
    unsigned touch_reg = 0u; const int tl_ = wid * 32 + (lane & 31);
    const unsigned toff = (unsigned)(((tl_ & 127) >> 1) * LDI * (int)sizeof(TIn) + (tl_ & 1) * 128);
    const gchar* tbase = uni_ptr((const char*)((tl_ >> 7) ? (const void*)Vh : (const void*)Kh));
#if MOBA_CHECK
#define TOUCH(k0) do {} while (0)
#else
#define TOUCH(k0) do { const gchar* tp_ = tbase + (size_t)(k0) * (LDI * sizeof(TIn)) + toff; asm volatile("global_load_dword %0, %1, off" : "+v"(touch_reg) : "v"(tp_) : "memory"); } while (0)
#endif
    f32x16 pA0, pA1, pB0, pB1; float mnA, mnB, alA, alB; bf16x8 pa0, pa1, pa2, pa3;
    if constexpr (F32) { VMW(); SWRITE_VF(0); SBAR(); } else { SWRITE_HV(0); SBAR(); }
    if (NT > 1) { if constexpr (F32) SLOAD_F((const float*)Kh, KBASE(1)); else SLOAD_H(Kh, Vh, KBASE(1)); }
    SBAR(); qkt<0, SK>(pA0, pA1, K_lds, r32, hi, S.qr, ACT(0), slopeR, LB(0));
    if constexpr (F32) { if (NT > 1) { VMW(); SWRITE_KF(1); SBAR(); SLOAD_F((const float*)Vh, KBASE(1)); } }
    MASKT(pA0, pA1, 0); partialSM(pA0, pA1, m_reg, mnA, alA);
    if (NT > 1) { VMW(); if constexpr (F32) { SWRITE_VF(1); SBAR(); if (NT > 2) SLOAD_F((const float*)Kh, KBASE(2)); } else SWRITE_H(1); }
    __syncthreads();
#define HALF_STEP(PX0, PX1, mnX, alX, PY0, PY1, alY, t, KB, VB, SB) do {                                                      \
        SBAR(); qkt<KB, SK>(PX0, PX1, K_lds, r32, hi, S.qr, ACT(t), slopeR, LB(t));                                             \
        finishSM(PY0, PY1, alY, l_reg, pa0, pa1, pa2, pa3); SBAR();                                                           \
        if ((t) + 1 < NT) { if constexpr (F32) { VMW(); SWRITE_KF(SB); SBAR(); SLOAD_F((const float*)Vh, KBASE((t) + 1)); }  \
                            else { SLOAD_H(Kh, Vh, KBASE((t) + 1)); } SBAR(); }                                               \
        pv_tile<VB, SK>(o, vb0, pa0, pa1, pa2, pa3, ACT((t) - 1)); MASKT(PX0, PX1, (t)); partialSM(PX0, PX1, m_reg, mnX, alX);                                        \
        __syncthreads();                                                                                                      \
        if ((t) + 1 < NT) { VMW(); if constexpr (F32) { SWRITE_VF(SB); SBAR(); if ((t) + 2 < NT) SLOAD_F((const float*)Kh, KBASE((t) + 2)); } \
                            else { SWRITE_H(SB); } }                                                                          \
        if ((t) + 3 < NT) { TOUCH(KBASE((t) + 3)); }                                                                          \
        RESC(alX); __syncthreads(); } while (0)
    for (int t = 1; t + 1 < NT; t += 2) {
        HALF_STEP(pB0, pB1, mnB, alB, pA0, pA1, alA, t, 1, 0, 0);
        HALF_STEP(pA0, pA1, mnA, alA, pB0, pB1, alB, t + 1, 0, 1, 1);
    }
    const bool even = (NT & 1) == 0;
    if (even) { SBAR(); qkt<1, SK>(pB0, pB1, K_lds, r32, hi, S.qr, ACT(NT - 1), slopeR, LB(NT - 1)); SBAR(); }
#define QROW(e) (nxt.Q + (size_t)(wid * QBLK + r32) * LDI + ((e) >> 1) * 16 + hi * 8 + ((e) & 1) * 4)
    if constexpr (F32) { SLOAD_F((const float*)nxt.K, kbn); SBAR();
#pragma unroll
        for (int e = 0; e < 8; ++e) S.tq[e] = *(const f32x4*)QROW(e); }
    else { SLOAD_H(nxt.K, nxt.V, kbn); SBAR();
#pragma unroll
        for (int d0 = 0; d0 < 8; ++d0) S.qr[d0] = *(const gbf16x8*)(uni_ptr((const char*)nxt.Q) + (unsigned)(((wid * QBLK + r32) * LDI + hi * 8) * (int)sizeof(TIn)) + d0 * 16 * sizeof(TIn)); }
    SBAR();
    finishSM(pA0, pA1, alA, l_reg, pa0, pa1, pa2, pa3); SBAR();
    if constexpr (F32) {
#pragma unroll
        for (int e = 8; e < 16; ++e) S.tq[e] = *(const f32x4*)QROW(e); SBAR(); }
#undef QROW
    pv_tile<0, SK>(o, vb0, pa0, pa1, pa2, pa3, ACT(even ? NT - 2 : NT - 1));
    if (even) { MASKT(pB0, pB1, NT - 1); partialSM(pB0, pB1, m_reg, mnB, alB); __syncthreads(); RESC(alB);
        finishSM(pB0, pB1, alB, l_reg, pa0, pa1, pa2, pa3); SBAR(); pv_tile<1, SK>(o, vb0, pa0, pa1, pa2, pa3, ACT(NT - 1)); }
    SBAR(); SEAM_K0();
    if (hi == 0) li_l[r32] = l_reg; asm volatile("s_waitcnt lgkmcnt(0)" ::: "memory");
    float rli[16];
#pragma unroll
    for (int r = 0; r < 16; ++r) rli[r] = __builtin_amdgcn_rcpf(li_l[crow(r, hi)]);
    const gchar* Owb = uni_ptr((const char*)(cur.O + (size_t)(wid * QBLK) * LDO)); const unsigned ooff = (unsigned)((4 * hi * LDO + r32) * (int)sizeof(TOut));
#pragma unroll
    for (int r = 0; r < 16; ++r) { const int orc = (r & 3) + 8 * (r >> 2);
#pragma unroll
        for (int d0 = 0; d0 < 4; ++d0) { const float v = o[d0][r] * rli[r];
            if constexpr (same_t<TOut, float>::v) { *(__attribute__((address_space(1))) float*)((gchar*)(Owb) + ooff + (unsigned)((orc * LDO + d0 * 32) * (int)sizeof(TOut))) = v; }
            else { const float vn = __builtin_bit_cast(float, __builtin_amdgcn_update_dpp(0, __builtin_bit_cast(int, v), 0xB1, 0xF, 0xF, true));
                   if ((r32 & 1) == 0) *(__attribute__((address_space(1))) unsigned*)((gchar*)(Owb) + ooff + (unsigned)((orc * LDO + d0 * 32) * (int)sizeof(TOut))) = cvtpk(v, vn); } } }
    if constexpr (F32) {
#pragma unroll
        for (int d0 = 0; d0 < 8; ++d0) S.qr[d0] = pack8(S.tq[2 * d0], S.tq[2 * d0 + 1]); }
    __syncthreads();
    asm volatile("" :: "v"(touch_reg));
#undef TOUCH
#undef RESC
#undef LB
#undef KBASE
#undef ACT
#undef MASKT
#undef SEAM_K0
#undef HALF_STEP
}
#undef ROW
#undef VMW
#undef VMWN
#undef SLOAD_H
#undef SWRITE_HK
#undef SWRITE_HV
#undef SWRITE_H
#undef SLOAD_F
#undef SWRITE_KF
#undef SWRITE_VF
#undef KSWZ
#undef SBAR
}

constexpr int NWAVES = 8, NTHR = 512;
constexpr int DM = 2048, NB = 2, SEQ = 4096, MROWS = NB * SEQ, NLAYER = 2;
constexpr int IN_COLS = 6592, IN_PAD = 6656, DFF = 5632, UPC = 2 * DFF;
constexpr int C_RQ = 0, C_RK = 256, C_RV = 512, C_RG = 1024, C_RW = 1536, C_MQ = 3520, C_MK = 4544, C_MV = 5568;
constexpr int RWC = 1984;
constexpr float NORM_EPS = 1e-6f, GN_EPS = 64e-5f;
constexpr size_t MiB = 1u << 20;
constexpr size_t WS_CTL = 0, CTL_ZERO_BYTES = 1 * MiB;
constexpr size_t WS_MOD = 1 * MiB;
constexpr size_t WS_KMEAN = 1 * MiB + 512 * 1024;
constexpr size_t WS_W = 2 * MiB, W_LAYER = 100 * MiB, W_IN = 0, W_OUT = 26 * MiB, W_UP = 34 * MiB, W_DN = 78 * MiB;
constexpr size_t WS_X = 202 * MiB;
constexpr size_t WS_H = 266 * MiB;
constexpr size_t WS_PROJ = 298 * MiB;
constexpr size_t WS_ACT = WS_PROJ;
constexpr size_t WS_MIXED = 402 * MiB;
constexpr size_t WS_U = 434 * MiB;
constexpr size_t WS_HALO = WS_U;
constexpr size_t WS_RW = WS_U;
constexpr size_t WS_Y = WS_U + 128 * MiB;
constexpr size_t WS_RETO = WS_U + 144 * MiB;
constexpr size_t WS_REC = 610 * MiB;
constexpr size_t WS_RWW = 738 * MiB;
constexpr size_t WS_END = 739 * MiB;
constexpr size_t RWA = (size_t)MROWS * 512;
constexpr int CW_BAR = 4096, CW_SUB = 64;
constexpr int RING_BYTES = 131072, LDSCTL_OFF = RING_BYTES, MISC_OFF = LDSCTL_OFF + 320, LDS_BYTES = 147456;

#define GAS __attribute__((address_space(1)))
#define LAS __attribute__((address_space(3)))
typedef unsigned short bf16;
typedef unsigned v4u __attribute__((ext_vector_type(4)));
typedef unsigned v2u __attribute__((ext_vector_type(2)));
typedef float f32x4 __attribute__((ext_vector_type(4)));
typedef float f32x2 __attribute__((ext_vector_type(2)));
#define LDS_WAIT() asm volatile("s_waitcnt lgkmcnt(0)" ::: "memory")
__device__ __forceinline__ unsigned f2bf(float f) { unsigned u = __builtin_bit_cast(unsigned, f); return (u + 0x7fffu + ((u >> 16) & 1u)) >> 16; }
__device__ __forceinline__ unsigned pk2(float lo, float hi) { return f2bf(lo) | (f2bf(hi) << 16); }
__device__ __forceinline__ float bf2f(unsigned short h) { return __builtin_bit_cast(float, (unsigned)h << 16); }
__device__ __forceinline__ float bflo(unsigned w) { return __builtin_bit_cast(float, w << 16); }
__device__ __forceinline__ float bfhi(unsigned w) { return __builtin_bit_cast(float, w & 0xffff0000u); }
template <int CTRL> __device__ __forceinline__ float dpp_add(float v);
__device__ __forceinline__ float wave_sum(float v);
__device__ __forceinline__ float wave_max(float v) {
#pragma unroll
    for (int o = 1; o < 64; o <<= 1) v = fmaxf(v, __shfl_xor(v, o));
    return v;
}
template <int CTRL> __device__ __forceinline__ float dpp_add(float v) { return v + __builtin_bit_cast(float, __builtin_amdgcn_update_dpp(0, __builtin_bit_cast(int, v), CTRL, 0xF, 0xF, true)); }
__device__ __forceinline__ float xsum16(float v) { auto r = __builtin_amdgcn_permlane16_swap(__float_as_uint(v), __float_as_uint(v), false, false); return __uint_as_float(r[0]) + __uint_as_float(r[1]); }
__device__ __forceinline__ float xsum32(float v) { auto r = __builtin_amdgcn_permlane32_swap(__float_as_uint(v), __float_as_uint(v), false, false); return __uint_as_float(r[0]) + __uint_as_float(r[1]); }
__device__ __forceinline__ float wave_sum(float v) {
    v = dpp_add<0xB1>(v); v = dpp_add<0x4E>(v); v = dpp_add<0x141>(v); v = dpp_add<0x140>(v);
    return xsum32(xsum16(v));
}
__device__ __forceinline__ float sigmoidf_(float x) { return __builtin_amdgcn_rcpf(1.0f + __expf(-x)); }

#define XB_TMO      128
#define XB_XCNT(j)  (256  + 64 * (j))
#define XB_XSUB(j)  (1280 + 64 * (j))
#define XB_XGEN(j)  (2304 + 64 * (j))
#define XB_TOP      3328
#define XB_TOPGEN   3392
#define XCD_BAR_WORDS 3456
#define XB_SPIN_CAP (1u << 22)
__device__ __forceinline__ unsigned xb_ld(unsigned* p)              { return __hip_atomic_load(p, __ATOMIC_RELAXED, __HIP_MEMORY_SCOPE_AGENT); }
__device__ __forceinline__ unsigned xb_add(unsigned* p, unsigned v) { return __hip_atomic_fetch_add(p, v, __ATOMIC_RELAXED, __HIP_MEMORY_SCOPE_AGENT); }
__device__ __forceinline__ unsigned xb_xcc_id() { return (unsigned)__builtin_amdgcn_s_getreg((3 << 11) | 20) & 0xFu; }
#define XB_SPIN(cond, bar) do { unsigned _sp = 0; while (cond) { __builtin_amdgcn_s_sleep(1); \
    if ((++_sp & 255u) == 0u) { if (xb_ld(&(bar)[XB_TMO])) break; if (_sp > XB_SPIN_CAP) { atomicAdd(&(bar)[XB_TMO], 1u); break; } } } } while (0)
struct XcdBarrier { unsigned* bar; unsigned x; volatile LAS unsigned* st; };
__device__ __forceinline__ XcdBarrier xcd_barrier_post(unsigned* bar, volatile LAS unsigned* st, int tid) {
    XcdBarrier b; b.bar = bar; b.x = xb_xcc_id(); b.st = st;
    if (tid == 0) (void)xb_add(&bar[XB_XCNT(b.x)], 1u);
    return b;
}
__device__ __forceinline__ void xcd_barrier_complete(unsigned* bar, unsigned x, unsigned& nloc, unsigned& nx) {
    const unsigned G = gridDim.x * gridDim.y * gridDim.z;
    unsigned sum, cnt, mine, sp = 0u;
    for (;;) {
        sum = 0u; cnt = 0u; mine = 0u;
#pragma unroll
        for (unsigned j = 0; j < 16; ++j) { const unsigned c = xb_ld(&bar[XB_XCNT(j)]); sum += c; cnt += (c > 0u) ? 1u : 0u; mine = (j == x) ? c : mine; }
        if (sum == G) break;
        __builtin_amdgcn_s_sleep(1);
        if ((++sp & 255u) == 0u) { if (xb_ld(&bar[XB_TMO])) break; if (sp > XB_SPIN_CAP) { atomicAdd(&bar[XB_TMO], 1u); break; } }
    }
    nloc = mine > 0u ? mine : 1u; nx = cnt > 0u ? cnt : 1u;
}
__device__ __forceinline__ void xcd_barrier(const XcdBarrier& b, int tid) {
    asm volatile("s_waitcnt vmcnt(0)" ::: "memory");
    __syncthreads();
    if (tid == 0) {
        unsigned z_ = 0u; asm volatile("" : "+v"(z_)); z_ = (unsigned)__builtin_amdgcn_readfirstlane(z_);
        unsigned* bar = b.bar + z_; const unsigned bx_ = b.x + z_;
        __builtin_amdgcn_s_waitcnt(0);
        unsigned nloc = b.st[0], nx = b.st[1];
        if (nloc == 0u) { xcd_barrier_complete(bar, bx_, nloc, nx); b.st[0] = nloc; b.st[1] = nx; }
        const unsigned old = xb_add(&bar[XB_XSUB(bx_)], 1u);
        const unsigned gen = old / nloc;
        if (old + 1u == (gen + 1u) * nloc) {
            __builtin_amdgcn_fence(__ATOMIC_RELEASE, "agent");
            asm volatile("s_waitcnt vmcnt(0)" ::: "memory");
            const unsigned og = xb_add(&bar[XB_TOP], 1u);
            const unsigned tg = og / nx;
            if (og + 1u == (tg + 1u) * nx) xb_add(&bar[XB_TOPGEN], 1u);
            else XB_SPIN(xb_ld(&bar[XB_TOPGEN]) == tg, bar);
            __builtin_amdgcn_fence(__ATOMIC_ACQUIRE, "agent");
            xb_add(&bar[XB_XGEN(bx_)], 1u);
            asm volatile("s_waitcnt vmcnt(0)" ::: "memory");
        } else {
            XB_SPIN(xb_ld(&bar[XB_XGEN(bx_)]) == gen, bar);
            __builtin_amdgcn_fence(__ATOMIC_ACQUIRE, "agent");
            asm volatile("s_waitcnt vmcnt(0)" ::: "memory");
        }
    }
    __syncthreads();
}

struct Args { const float* in[24]; float* out; unsigned char* ws; };
struct Frame {
    LAS unsigned char* lds;
    int tid, lane, wave, vcu, G, zz;
    const float* const* in;
    unsigned char* ws;
};

#define FWS (F.ws + F.zz)
__device__ __forceinline__ void p0_transpose_item(const float* W, int K, int N, bf16* WT, LAS float* scr, int item, int lane, int half = 0) {
    const int nblk = N / 32, kb = item / nblk, nb = item % nblk, k0 = 64 * kb, n0 = 32 * nb;
    const int r0 = !half ? n0 : (n0 < half ? (n0 >> 7) * 256 + (n0 & 127) : ((n0 - half) >> 7) * 256 + 128 + ((n0 - half) & 127));
#pragma unroll 8
    for (int i = 0; i < 32; ++i) { const int kk = 2 * i + (lane >> 5); scr[kk * 33 + (lane & 31)] = W[(size_t)(k0 + kk) * N + n0 + (lane & 31)]; }
    LDS_WAIT(); asm volatile("" ::: "memory");
    const int c = lane & 7;
#pragma unroll
    for (int j = 0; j < 4; ++j) { const int n = (lane >> 3) + 8 * j; const LAS float* s = scr + (8 * c) * 33 + n;
        v4u o; o.x = pk2(s[0 * 33], s[1 * 33]); o.y = pk2(s[2 * 33], s[3 * 33]); o.z = pk2(s[4 * 33], s[5 * 33]); o.w = pk2(s[6 * 33], s[7 * 33]);
        *(v4u*)(WT + (size_t)(r0 + n) * K + k0 + 8 * c) = o; }
    LDS_WAIT(); asm volatile("" ::: "memory");
}
constexpr int CV_IN = (DM / 64) * (IN_COLS / 32), CV_OUT = (DM / 64) * (DM / 32), CV_UP = (DM / 64) * (UPC / 32), CV_DN = (DFF / 64) * (DM / 32), CV_LAYER = CV_IN + CV_OUT + CV_UP + CV_DN;
constexpr int CV_N1 = 10, CV_N2 = 6, CV_N3 = 4, CV_C1 = 192 * NWAVES * CV_N1, CV_C2 = 128 * NWAVES * CV_N2;
static_assert(CV_IN + CV_C1 <= CV_LAYER && CV_LAYER - (CV_IN + CV_C1) + (CV_IN - CV_C2) <= 128 * NWAVES * CV_N3 && CV_C2 <= CV_IN, "gap capacities");
__device__ __forceinline__ void convert_item(Frame& F, int it, LAS float* scr) {
    const int l = it / CV_LAYER; int r = it % CV_LAYER;
    unsigned char* wl = FWS + WS_W + (size_t)l * W_LAYER;
    if (r < CV_IN) { p0_transpose_item(F.in[F.zz + 2] + (size_t)l * DM * IN_COLS, DM, IN_COLS, (bf16*)(wl + W_IN), scr, r, F.lane); return; } r -= CV_IN;
    if (r < CV_OUT) { p0_transpose_item(F.in[F.zz + 3] + (size_t)l * DM * DM, DM, DM, (bf16*)(wl + W_OUT), scr, r, F.lane); return; } r -= CV_OUT;
    if (r < CV_UP) { p0_transpose_item(F.in[F.zz + 15] + (size_t)l * DM * UPC, DM, UPC, (bf16*)(wl + W_UP), scr, r, F.lane, DFF); return; } r -= CV_UP;
    p0_transpose_item(F.in[F.zz + 18] + (size_t)l * DFF * DM, DFF, DM, (bf16*)(wl + W_DN), scr, r, F.lane);
}
__device__ __forceinline__ void convert_gap(Frame& F, int layer, int first, int count, int gwi, int nwv, int nper) {
    LAS float* scr = (LAS float*)(F.lds + F.wave * 16384);
    for (int j = 0; j < nper; ++j) { const int r = gwi + nwv * j; if (r < count) convert_item(F, layer * CV_LAYER + first + r, scr); }
}
__device__ __forceinline__ void adaln_item(Frame& F, int l, int grp) {
    LAS float* cact = (LAS float*)F.lds;
    LAS float* red = (LAS float*)(F.lds + 16384);
    const float* c = F.in[F.zz + 1];
    for (int i = F.tid; i < 4096; i += NTHR) { const float cv = c[i]; cact[i] = cv / (1.0f + __expf(-cv)); }
    __syncthreads();
    const int n0 = grp * 128;
    const float* W = F.in[F.zz + 19] + (size_t)l * 2048 * 12288 + n0;
    const int half = F.lane >> 5, q = F.lane & 31;
    f32x4 a0 = {0.f, 0.f, 0.f, 0.f}, a1 = {0.f, 0.f, 0.f, 0.f};
#pragma unroll 16
    for (int i = 0; i < 128; ++i) { const int k = F.wave * 256 + 2 * i + half; const f32x4 w = *(const f32x4*)(W + (size_t)k * 12288 + 4 * q);
        a0 += w * cact[k]; a1 += w * cact[2048 + k]; }
#pragma unroll
    for (int e = 0; e < 4; ++e) { a0[e] = xsum32(a0[e]); a1[e] = xsum32(a1[e]); }
    if (half == 0) {
#pragma unroll
        for (int e = 0; e < 4; ++e) { red[(F.wave * 2 + 0) * 128 + 4 * q + e] = a0[e]; red[(F.wave * 2 + 1) * 128 + 4 * q + e] = a1[e]; } }
    __syncthreads();
    if (F.tid < 256) { const int bb = F.tid >> 7, col = F.tid & 127; float s = 0.f;
#pragma unroll
        for (int w = 0; w < 8; ++w) s += red[(w * 2 + bb) * 128 + col];
        s += F.in[F.zz + 20][l * 12288 + n0 + col];
        ((float*)(FWS + WS_MOD))[(size_t)(l * 2 + bb) * 12288 + n0 + col] = s; }
    __syncthreads();
}
__device__ __forceinline__ void p0_prologue(Frame& F) {
    const int ngv = (F.G == 256) ? 96 : 192;
    if (F.vcu < ngv) adaln_item(F, F.vcu / 96, F.vcu % 96);
    LAS float* scr = (LAS float*)(F.lds + F.wave * 16384);
    const int gw = F.vcu * NWAVES + F.wave, NGW = F.G * NWAVES;
    if (F.G == 256) { if (F.vcu >= 96) for (int p = gw - 96 * NWAVES; p < CV_IN; p += 160 * NWAVES) convert_item(F, p, scr); }
    else for (int p = gw; p < NLAYER * CV_LAYER; p += NGW) convert_item(F, p, scr);
    for (int l = 0; l < NLAYER; ++l) { bf16* wt = (bf16*)(FWS + WS_RWW + (size_t)l * 448 * 512 * 2);
        const float* wu = F.in[F.zz + 6] + (size_t)l * 96 * 512; const float* au = F.in[F.zz + 8] + (size_t)l * 96 * 512; const float* gu = F.in[F.zz + 9] + (size_t)l * 256 * 512;
        for (int i = F.vcu * NTHR + F.tid; i < 448 * 512; i += F.G * NTHR) {
            if (i < 96 * 512) { const int n = i / 96, kq = i - n * 96; wt[i] = (bf16)f2bf(wu[kq * 512 + n]); }
            else if (i < 2 * 96 * 512) { const int j = i - 96 * 512, n = j / 96, kq = j - n * 96; wt[i] = (bf16)f2bf(au[kq * 512 + n]); }
            else { const int j = i - 2 * 96 * 512, n = j >> 8, kq = j & 255; wt[i] = (bf16)f2bf(gu[kq * 512 + n]); } } }
    for (int l = 0; l < NLAYER; ++l) { v4u* z = (v4u*)(FWS + WS_W + (size_t)l * W_LAYER + W_IN + (size_t)IN_COLS * DM * 2);
        for (int i = F.vcu * NTHR + F.tid; i < (IN_PAD - IN_COLS) * DM * 2 / 16; i += F.G * NTHR) z[i] = (v4u){0u, 0u, 0u, 0u}; }
}

template <int MODE, bool IN_F32>
__device__ __forceinline__ void norm_phase(Frame& F, const void* xin, void* outp, const float* g, const float* sh, const float* sc) {
    LAS float* gs = (LAS float*)F.lds;
    LAS float* shs = (LAS float*)(F.lds + 16384);
    for (int i = F.tid; i < 4096; i += NTHR) { const int b = i >> 11, col = i & 2047;
        if (MODE == 0) { gs[i] = g[col] * (1.0f + sc[(size_t)b * 12288 + col]); shs[i] = sh[(size_t)b * 12288 + col]; }
        else { gs[i] = g[col]; shs[i] = 0.f; } }
    __syncthreads();
    const int gw = F.vcu * NWAVES + F.wave, NGW = F.G * NWAVES;
    for (int m = gw; m < MROWS; m += NGW) {
        const int b = m >> 12;
        f32x4 v[8]; float s = 0.f;
#pragma unroll
        for (int j = 0; j < 8; ++j) {
            if (IN_F32) v[j] = *((const f32x4*)((const float*)xin + (size_t)m * DM) + F.lane + 64 * j);
            else { const v2u w = *((const v2u*)((const bf16*)xin + (size_t)m * DM) + F.lane + 64 * j); v[j] = (f32x4){bflo(w.x), bfhi(w.x), bflo(w.y), bfhi(w.y)}; }
            s += (v[j].x * v[j].x + v[j].y * v[j].y) + (v[j].z * v[j].z + v[j].w * v[j].w); }
        float rstd = __builtin_amdgcn_rsqf(wave_sum(s) * (1.0f / DM) + NORM_EPS);
#if MOBA_CHECK
        if (MODE == 1) { const float sd = ((const float*)(FWS + WS_CTL))[8], sn = ((const float*)(FWS + WS_CTL))[9]; rstd *= 1.0f + 10.0f * sqrtf(sd / sn); }
#endif
#pragma unroll
        for (int j = 0; j < 8; ++j) { const int col = 4 * (F.lane + 64 * j);
            const f32x4 gg = *(const LAS f32x4*)(gs + b * 2048 + col), ss = *(const LAS f32x4*)(shs + b * 2048 + col);
            const f32x4 o = v[j] * rstd * gg + ss;
            if (MODE == 0) { v2u w; w.x = pk2(o.x, o.y); w.y = pk2(o.z, o.w); *(v2u*)((bf16*)outp + (size_t)m * DM + col) = w; }
            else *(f32x4*)((float*)outp + (size_t)m * DM + col) = o; }
    }
    __syncthreads();
}

__device__ __forceinline__ float lerp_bf(const bf16* P, size_t row, int col, bool hasprev, float mu) {
    const float cur = bf2f(P[row * IN_PAD + col]); const float prev = hasprev ? bf2f(P[(row - 1) * IN_PAD + col]) : 0.f;
    return cur + (prev - cur) * mu;
}
__device__ __forceinline__ void rwkv_prep(Frame& F, int l) {
    LAS float* codes = (LAS float*)F.lds;
    const bf16* P = (const bf16*)(FWS + WS_PROJ);
    const float* mu = F.in[F.zz + 4] + l * RWC; const float* w0 = F.in[F.zz + 5] + l * 512; const float* w_up = F.in[F.zz + 6] + (size_t)l * 96 * 512;
    const float* a0 = F.in[F.zz + 7] + l * 512; const float* a_up = F.in[F.zz + 8] + (size_t)l * 96 * 512; const float* g_up = F.in[F.zz + 9] + (size_t)l * 256 * 512;
    const float* k_k = F.in[F.zz + 10] + l * 512; const float* k_a = F.in[F.zz + 11] + l * 512; const float* r_k = F.in[F.zz + 12] + l * 512;
    float* RW = (float*)(FWS + WS_RW);
    const int c = F.tid;
    const float mur = mu[c], muk = mu[512 + c], muv = mu[1024 + c], w0c = w0[c], a0c = a0[c], kkc = k_k[c], kac = k_a[c], rkc = r_k[c];
    for (int item = F.vcu; item < MROWS / 8; item += F.G) {
        const int row0 = item * 8, t0 = row0 & (SEQ - 1);
        for (int idx = F.tid; idx < 8 * 448; idx += NTHR) { const int tk = idx / 448, cc = idx - tk * 448;
            float val = lerp_bf(P, (size_t)(row0 + tk), C_RW + 1536 + cc, (t0 + tk) > 0, mu[1536 + cc]);
            if (cc < 96) val = tanhf(val); else if (cc >= 192) val = sigmoidf_(val);
            codes[idx] = val; }
        __syncthreads();
        float wd[8], wa[8], gg[8];
#pragma unroll
        for (int tk = 0; tk < 8; ++tk) { wd[tk] = 0.f; wa[tk] = 0.f; gg[tk] = 0.f; }
        for (int r = 0; r < 96; ++r) { const float wu = w_up[r * 512 + c], au = a_up[r * 512 + c];
#pragma unroll
            for (int tk = 0; tk < 8; ++tk) { wd[tk] += codes[tk * 448 + r] * wu; wa[tk] += codes[tk * 448 + 96 + r] * au; } }
        for (int r = 0; r < 256; ++r) { const float gu = g_up[r * 512 + c];
#pragma unroll
            for (int tk = 0; tk < 8; ++tk) gg[tk] += codes[tk * 448 + 192 + r] * gu; }
#pragma unroll
        for (int tk = 0; tk < 8; ++tk) {
            const size_t row = (size_t)(row0 + tk); const bool hp = (t0 + tk) > 0;
            const float rr = lerp_bf(P, row, C_RW + c, hp, mur), kk0 = lerp_bf(P, row, C_RW + 512 + c, hp, muk), vv = lerp_bf(P, row, C_RW + 1024 + c, hp, muv);
            const float z = -(w0c + wd[tk]);
            const float sp = fmaxf(z, 0.f) + log1pf(__expf(-fabsf(z)));
            const float decay = __expf(-__expf(-sp - 0.5f));
            const float a = sigmoidf_(a0c + wa[tk]);
            const float kkv = kk0 * kkc;
            const float nrm = sqrtf(wave_sum(kkv * kkv));
            const float kap = kkv / fmaxf(nrm, 1e-12f);
            const float kp = kk0 * (1.0f + (a - 1.0f) * kac);
            const float bsum = wave_sum(rr * kp * rkc);
            const size_t o = row * 512 + c;
            RW[0 * RWA + o] = rr; RW[1 * RWA + o] = decay; RW[2 * RWA + o] = kp; RW[3 * RWA + o] = vv;
            RW[4 * RWA + o] = kap; RW[5 * RWA + o] = kap * a; RW[6 * RWA + o] = gg[tk]; RW[7 * RWA + o] = bsum * vv;
        }
        __syncthreads();
    }
}
__device__ __forceinline__ void moba_kmean(Frame& F) {
    LAS float* red = (LAS float*)(F.lds + 32768);
    const bf16* P = (const bf16*)(FWS + WS_PROJ);
    float* KM = (float*)(FWS + WS_KMEAN);
    for (int item = F.vcu; item < 256; item += F.G) {
        const int b = item >> 7, h = (item >> 4) & 7, n = item & 15;
        const int d = F.tid & 127, part = F.tid >> 7;
        const bf16* kp = P + (size_t)(b * SEQ + n * 256 + part * 64) * IN_PAD + C_MK + h * 128 + d;
        float s = 0.f;
        for (int k = 0; k < 64; ++k) s += bf2f(kp[(size_t)k * IN_PAD]);
        red[part * 128 + d] = s;
        __syncthreads();
        if (F.tid < 128) KM[(size_t)item * 128 + d] = (red[d] + red[128 + d] + red[256 + d] + red[384 + d]) * (1.0f / 256.0f);
        __syncthreads();
    }
}
struct RwIn { f32x4 w[2], kk[2], bb[2], k[2], r[2]; float v; };
__device__ __forceinline__ void rw_load(RwIn& x, const float* RW, size_t row, int cj, int ci) {
    const size_t o = row * 512;
    x.w[0] = *(const f32x4*)(RW + 1 * RWA + o + cj); x.w[1] = *(const f32x4*)(RW + 1 * RWA + o + cj + 4);
    x.kk[0] = *(const f32x4*)(RW + 4 * RWA + o + cj); x.kk[1] = *(const f32x4*)(RW + 4 * RWA + o + cj + 4);
    x.bb[0] = *(const f32x4*)(RW + 5 * RWA + o + cj); x.bb[1] = *(const f32x4*)(RW + 5 * RWA + o + cj + 4);
    x.k[0] = *(const f32x4*)(RW + 2 * RWA + o + cj); x.k[1] = *(const f32x4*)(RW + 2 * RWA + o + cj + 4);
    x.r[0] = *(const f32x4*)(RW + 0 * RWA + o + cj); x.r[1] = *(const f32x4*)(RW + 0 * RWA + o + cj + 4);
    x.v = RW[3 * RWA + o + ci];
}
__device__ __forceinline__ void rwkv_scan_naive(Frame& F, int b, int h) {
    const float* RW = (const float*)(FWS + WS_RW);
    float* Y = (float*)(FWS + WS_Y);
    const int i = F.tid >> 3, jp = F.tid & 7, cj = h * 64 + 8 * jp, ci = h * 64 + i;
    f32x4 s0 = {0.f, 0.f, 0.f, 0.f}, s1 = {0.f, 0.f, 0.f, 0.f};
    RwIn cur, n1, n2;
    const size_t rb = (size_t)b * SEQ;
    rw_load(cur, RW, rb, cj, ci); rw_load(n1, RW, rb + 1, cj, ci);
    for (int t = 0; t < SEQ; ++t) {
        rw_load(n2, RW, rb + (t + 2 < SEQ ? t + 2 : SEQ - 1), cj, ci);
        f32x4 pp = s0 * cur.kk[0] + s1 * cur.kk[1];
        float p = (pp.x + pp.y) + (pp.z + pp.w);
        p += __shfl_xor(p, 1); p += __shfl_xor(p, 2); p += __shfl_xor(p, 4);
        const float sa = -p;
        s0 = s0 * cur.w[0] + sa * cur.bb[0] + cur.v * cur.k[0];
        s1 = s1 * cur.w[1] + sa * cur.bb[1] + cur.v * cur.k[1];
        f32x4 yy = s0 * cur.r[0] + s1 * cur.r[1];
        float y = (yy.x + yy.y) + (yy.z + yy.w);
        y += __shfl_xor(y, 1); y += __shfl_xor(y, 2); y += __shfl_xor(y, 4);
        if (jp == 0) Y[(rb + t) * 512 + ci] = y;
        cur = n1; n1 = n2;
    }
}
struct RtIn { v4u q[2], k[2]; unsigned short v; };
__device__ __forceinline__ void rt_load(RtIn& x, const bf16* P, size_t row, int h, int d0, int v) {
    const bf16* p = P + row * IN_PAD;
    x.q[0] = *(const v4u*)(p + C_RQ + h * 64 + d0); x.q[1] = *(const v4u*)(p + C_RQ + h * 64 + d0 + 8);
    x.k[0] = *(const v4u*)(p + C_RK + h * 64 + d0); x.k[1] = *(const v4u*)(p + C_RK + h * 64 + d0 + 8);
    x.v = p[C_RV + h * 128 + v];
}
__device__ __forceinline__ void ret_scan_naive(Frame& F, int b, int h) {
    const bf16* P = (const bf16*)(FWS + WS_PROJ);
    float* RO = (float*)(FWS + WS_RETO);
    const int v = F.tid >> 2, dp = F.tid & 3, d0 = dp * 16;
    const float gamma = 1.0f - exp2f(-5.0f - (float)h);
    float S[16];
#pragma unroll
    for (int d = 0; d < 16; ++d) S[d] = 0.f;
    RtIn cur, n1, n2;
    const size_t rb = (size_t)b * SEQ;
    rt_load(cur, P, rb, h, d0, v); rt_load(n1, P, rb + 1, h, d0, v);
    for (int t = 0; t < SEQ; ++t) {
        rt_load(n2, P, rb + (t + 2 < SEQ ? t + 2 : SEQ - 1), h, d0, v);
        const float vv = bf2f(cur.v) * 0.125f;
        float o = 0.f;
#pragma unroll
        for (int e = 0; e < 8; ++e) { const unsigned qw = cur.q[e >> 2][e & 3], kw = cur.k[e >> 2][e & 3];
            S[2 * e] = gamma * S[2 * e] + bflo(kw) * vv; S[2 * e + 1] = gamma * S[2 * e + 1] + bfhi(kw) * vv;
            o += bflo(qw) * S[2 * e] + bfhi(qw) * S[2 * e + 1]; }
        o += __shfl_xor(o, 1); o += __shfl_xor(o, 2);
        if (dp == 0) RO[(rb + t) * 512 + h * 128 + v] = o;
        cur = n1; n1 = n2;
    }
}
__device__ __forceinline__ void moba_naive(Frame& F, int mw, int nmw) {
    const bf16* P = (const bf16*)(FWS + WS_PROJ);
    const float* KM = (const float*)(FWS + WS_KMEAN);
    bf16* MX = (bf16*)(FWS + WS_U + 160 * MiB);
    LAS float* qs = (LAS float*)(F.lds + F.wave * 4608);
    LAS float* ps = qs + 128;
    const int lane = F.lane;
    for (int qi = mw; qi < MROWS * 8; qi += nmw) {
        const int h = qi & 7, row = qi >> 3, b = row >> 12, t = row & (SEQ - 1), bq = t >> 8;
        { const unsigned qw = *(const unsigned*)(P + (size_t)row * IN_PAD + C_MQ + h * 128 + 2 * lane);
          qs[2 * lane] = bflo(qw) * 0.08838834764831845f; qs[2 * lane + 1] = bfhi(qw) * 0.08838834764831845f; }
        LDS_WAIT();
        float gate = -INFINITY;
        if (lane < 16 && lane < bq) { const float* km = KM + ((size_t)(b * 8 + h) * 16 + lane) * 128; float a = 0.f;
            for (int d = 0; d < 128; ++d) a += qs[d] * km[d];
            gate = a; }
        unsigned selmask = 0u;
#pragma unroll
        for (int rnd = 0; rnd < 3; ++rnd) { const float m = wave_max(gate);
            if (m > -INFINITY) { const unsigned long long bal = __ballot(gate == m); const int idx = __ffsll((long long)bal) - 1; selmask |= 1u << idx; if (lane == idx) gate = -INFINITY; } }
        int blk[4];
#pragma unroll
        for (int s = 0; s < 3; ++s) { if (selmask) { blk[s] = __ffs((int)selmask) - 1; selmask &= selmask - 1u; } else blk[s] = -1; }
        blk[3] = bq;
        const float slope = exp2f(-(float)(h + 1));
        float sc[4][4]; float mx = -1e30f;
#pragma unroll
        for (int s = 0; s < 4; ++s) {
#pragma unroll
            for (int kq = 0; kq < 4; ++kq) {
                float val = -1e30f;
                if (blk[s] >= 0) { const int pos = blk[s] * 256 + kq * 64 + lane;
                    const bf16* kp = P + (size_t)(b * SEQ + pos) * IN_PAD + C_MK + h * 128; float a = 0.f;
#pragma unroll 4
                    for (int d8 = 0; d8 < 16; ++d8) { const v4u kw = *(const v4u*)(kp + d8 * 8); const f32x4 qa = *(const LAS f32x4*)(qs + d8 * 8), qb = *(const LAS f32x4*)(qs + d8 * 8 + 4);
                        a += bflo(kw.x) * qa.x + bfhi(kw.x) * qa.y + bflo(kw.y) * qa.z + bfhi(kw.y) * qa.w + bflo(kw.z) * qb.x + bfhi(kw.z) * qb.y + bflo(kw.w) * qb.z + bfhi(kw.w) * qb.w; }
                    if (pos <= t) val = a - slope * (float)(t - pos); }
                sc[s][kq] = val; mx = fmaxf(mx, val); } }
        mx = wave_max(mx);
        float lsum = 0.f;
#pragma unroll
        for (int s = 0; s < 4; ++s)
#pragma unroll
            for (int kq = 0; kq < 4; ++kq) { const float p = __expf(sc[s][kq] - mx); lsum += p; ps[s * 256 + kq * 64 + lane] = p; }
        lsum = wave_sum(lsum);
        LDS_WAIT();
        float o0 = 0.f, o1 = 0.f;
#pragma unroll
        for (int s = 0; s < 4; ++s) if (blk[s] >= 0) { const int nk = (s == 3) ? (t - bq * 256 + 1) : 256;
            const bf16* vp = P + (size_t)(b * SEQ + blk[s] * 256) * IN_PAD + C_MV + h * 128 + 2 * lane;
#pragma unroll 4
            for (int key = 0; key < nk; ++key) { const float p = ps[s * 256 + key]; const unsigned vw = *(const unsigned*)(vp + (size_t)key * IN_PAD); o0 += p * bflo(vw); o1 += p * bfhi(vw); } }
        const float inv = 1.0f / lsum;
        *(unsigned*)(MX + (size_t)row * 1024 + h * 128 + 2 * lane) = pk2(o0 * inv, o1 * inv);
        LDS_WAIT();
    }
}

constexpr int MOBA_LDS_KM = moba::LDS_BYTES, MOBA_LDS_SEL = MOBA_LDS_KM + 8192;
__device__ __forceinline__ void moba_item(Frame& F, int bh, int qbA, int qbB) {
    const int b = bh >> 3, h = bh & 7;
    const bf16* P = (const bf16*)(FWS + WS_PROJ);
    LAS float* km = (LAS float*)(F.lds + MOBA_LDS_KM);
    LAS unsigned* sel = (LAS unsigned*)(F.lds + MOBA_LDS_SEL);
    const float* KM = (const float*)(FWS + WS_KMEAN) + (size_t)bh * 16 * 128;
    for (int i = F.tid; i < 2048; i += NTHR) km[i] = KM[i];
    __syncthreads();
    {   const int qb = (F.tid < 256) ? qbA : qbB, r = F.tid & 255;
        const bf16* qp = P + (size_t)(b * SEQ + qb * 256 + r) * IN_PAD + C_MQ + h * 128;
        float g[16];
#pragma unroll
        for (int n = 0; n < 16; ++n) g[n] = 0.f;
        for (int d8 = 0; d8 < 16; ++d8) { const v4u qw = *(const v4u*)(qp + d8 * 8);
            const float q0 = bflo(qw.x), q1 = bfhi(qw.x), q2 = bflo(qw.y), q3 = bfhi(qw.y), q4 = bflo(qw.z), q5 = bfhi(qw.z), q6 = bflo(qw.w), q7 = bfhi(qw.w);
#pragma unroll
            for (int n = 0; n < 16; ++n) { const f32x4 ka = *(const LAS f32x4*)(km + n * 128 + d8 * 8), kb = *(const LAS f32x4*)(km + n * 128 + d8 * 8 + 4);
                g[n] += (q0 * ka.x + q1 * ka.y) + (q2 * ka.z + q3 * ka.w) + (q4 * kb.x + q5 * kb.y) + (q6 * kb.z + q7 * kb.w); } }
        unsigned m = 0u;
#pragma unroll
        for (int rnd = 0; rnd < 3; ++rnd) { float best = -INFINITY; int bi = -1;
#pragma unroll
            for (int n = 0; n < 16; ++n) if (n < qb && !((m >> n) & 1u) && g[n] > best) { best = g[n]; bi = n; }
            if (bi >= 0) m |= 1u << bi; }
        sel[F.tid] = m; }
    __syncthreads();
    typedef moba::BlockRef<moba::bf16, moba::bf16> Ref;
    const float slopeR = exp2f(-(float)(h + 1)) * 11.313708498984761f;
    bf16* MX = (bf16*)(FWS + WS_MIXED);
    Ref A, B2;
    A.Q = P + (size_t)(b * SEQ + qbA * 256) * IN_PAD + C_MQ + h * 128; A.K = P + (size_t)(b * SEQ) * IN_PAD + C_MK + h * 128; A.V = P + (size_t)(b * SEQ) * IN_PAD + C_MV + h * 128;
    A.O = MX + (size_t)(b * SEQ + qbA * 256) * DM + 1024 + h * 128; A.P0 = qbA * 256; A.sel = sel; A.slopeR = slopeR;
    B2 = A; B2.Q = P + (size_t)(b * SEQ + qbB * 256) * IN_PAD + C_MQ + h * 128; B2.O = MX + (size_t)(b * SEQ + qbB * 256) * DM + 1024 + h * 128; B2.P0 = qbB * 256; B2.sel = sel + 256;
    moba::Seam<moba::bf16> S;
    moba::lchar* ldsg = (moba::lchar*)F.lds;
    moba::causal_swa_prime<moba::bf16, moba::bf16>(A, 1 << 30, ldsg, S, F.wave);
    Ref cur = A;
    for (int pass = 0; pass < MOBA_NP; ++pass) {
        const bool nb_ = ((pass + 1) & 1) != 0;
        Ref nxt = A; if (nb_ || pass + 1 >= MOBA_NP) nxt = B2;
        moba::causal_swa_block<moba::bf16, moba::bf16>(cur, nxt, SEQ, 1 << 30, ldsg, S, F.wave);
        cur = nxt;
    }
}
constexpr int RC_UNITS = 32, RC_NCH = SEQ / 16, RC_REC = 16384;
constexpr int RC_AR = 0, RC_BK = 4096, RC_VP = 8192, RC_U0 = 10240, RC_Y0 = 12288, RC_D = 14336;
typedef short bf16x8 __attribute__((ext_vector_type(8)));
typedef float f32x16 __attribute__((ext_vector_type(16)));
typedef float f32x2t __attribute__((ext_vector_type(2))); typedef __bf16 bf16x2t __attribute__((ext_vector_type(2)));
__device__ __forceinline__ unsigned cvtpk_c(float lo, float hi) { f32x2t v = {lo, hi}; bf16x2t b = __builtin_convertvector(v, bf16x2t); return __builtin_bit_cast(unsigned, b); }
__device__ __forceinline__ unsigned short cvt1_c(float x) { return (unsigned short)(cvtpk_c(x, 0.f) & 0xffffu); }

constexpr int RC_WLDS = 14464, RC_CODES_OFF = 8 * RC_WLDS  , RC_CSTRIDE = 456;
#define RC_ST(off, w) (*(v4u*)(FWS + WS_REC + (size_t)roff + (unsigned)(off)) = (w))
#define RC_ST_D(Dv) do { const int di_ = __builtin_bit_cast(int, (Dv)); v4u dw_; dw_.x = (unsigned)__builtin_amdgcn_update_dpp(0, di_, 0x00, 0xF, 0xF, true); dw_.y = (unsigned)__builtin_amdgcn_update_dpp(0, di_, 0x55, 0xF, 0xF, true); \
    dw_.z = (unsigned)__builtin_amdgcn_update_dpp(0, di_, 0xAA, 0xF, 0xF, true); dw_.w = (unsigned)__builtin_amdgcn_update_dpp(0, di_, 0xFF, 0xF, 0xF, true); if ((x & 3) == 0) RC_ST(RC_D + x * 4, dw_); } while (0)
__device__ __forceinline__ void rc_core(Frame& F, LAS unsigned char* wlds, const float (&At)[16], const float (&Bt)[16], const float (&Kt)[16], const float (&Rt)[16], const float (&vv)[16], const float D, unsigned roff) {
    { unsigned wb_ = (unsigned)(uintptr_t)wlds; asm volatile("" : "+v"(wb_)); wlds = (LAS unsigned char*)(uintptr_t)wb_; }
    LAS bf16* XA = (LAS bf16*)wlds; LAS bf16* XB = (LAS bf16*)(wlds + 4608); LAS float* TT = (LAS float*)(wlds + 9216 + 4224);
    int x_ = F.lane; asm volatile("" : "+v"(x_));
    const int x = x_, r32 = x & 31, h2 = x >> 5, tl = x & 15;
#pragma unroll
    for (int t = 0; t < 16; ++t) { XA[t * 72 + x] = cvt1_c(Bt[t]); XA[(16 + t) * 72 + x] = cvt1_c(Kt[t]); XB[t * 72 + x] = cvt1_c(At[t]); XB[(16 + t) * 72 + x] = cvt1_c(Rt[t]); }
#pragma unroll
    for (int q = 0; q < 4; ++q) { v4u w; w.x = cvtpk_c(Bt[4 * q] * D, Bt[4 * q + 1] * D); w.y = cvtpk_c(Bt[4 * q + 2] * D, Bt[4 * q + 3] * D);
        w.z = cvtpk_c(Kt[4 * q] * D, Kt[4 * q + 1] * D); w.w = cvtpk_c(Kt[4 * q + 2] * D, Kt[4 * q + 3] * D); RC_ST(RC_BK + x * 64 + q * 16, w); }
#pragma unroll
    for (int q = 0; q < 2; ++q) { v4u w;
        w.x = cvtpk_c(vv[8 * q], vv[8 * q + 1]); w.y = cvtpk_c(vv[8 * q + 2], vv[8 * q + 3]); w.z = cvtpk_c(vv[8 * q + 4], vv[8 * q + 5]); w.w = cvtpk_c(vv[8 * q + 6], vv[8 * q + 7]); RC_ST(RC_VP + x * 32 + q * 16, w);
    }
    RC_ST_D(D);
    f32x16 G;
#pragma unroll
    for (int r = 0; r < 16; ++r) G[r] = 0.f;
#pragma unroll
    for (int ks = 0; ks < 4; ++ks) { const bf16x8 a = *(const LAS bf16x8*)(XA + r32 * 72 + ks * 16 + h2 * 8), bq = *(const LAS bf16x8*)(XB + r32 * 72 + ks * 16 + h2 * 8);
        G = __builtin_amdgcn_mfma_f32_32x32x16_bf16(a, bq, G, 0, 0, 0); }
    LAS float* GA = (LAS float*)wlds; LAS float* GT = (LAS float*)(wlds + 4608);
#pragma unroll
    for (int r = 0; r < 16; ++r) GA[((r & 3) + 8 * (r >> 2) + 4 * h2) * 36 + r32] = G[r];
#pragma unroll
    for (int g4 = 0; g4 < 4; ++g4) *(LAS f32x4*)(GT + r32 * 36 + 8 * g4 + 4 * h2) = (f32x4){G[4 * g4], G[4 * g4 + 1], G[4 * g4 + 2], G[4 * g4 + 3]};
#define RC_LD16(dst, p, n4) do { _Pragma("unroll") for (int i4_ = 0; i4_ < (n4); ++i4_) { const f32x4 v4_ = *(const LAS f32x4*)((p) + 4 * i4_); dst[4 * i4_] = v4_.x; dst[4 * i4_ + 1] = v4_.y; dst[4 * i4_ + 2] = v4_.z; dst[4 * i4_ + 3] = v4_.w; } } while (0)
    float Tc[16];
    { f32x2 Tp[8];
#pragma unroll
    for (int j = 0; j < 8; ++j) { Tp[j].x = (2 * j == tl) ? 1.0f : 0.0f; Tp[j].y = (2 * j + 1 == tl) ? 1.0f : 0.0f; }
#pragma unroll
    for (int s = 14; s >= 0; --s) { f32x4 nr4[4]; f32x2 a2 = {0.f, 0.f}; float a1 = 0.f;
#pragma unroll
        for (int i4 = (s + 1) / 4; i4 < 4; ++i4) nr4[i4] = *(const LAS f32x4*)(GA + s * 36 + 4 * i4);
        if ((s + 1) & 1) { const int m = s + 1; a1 = nr4[m >> 2][m & 3] * Tp[m >> 1].y; }
#pragma unroll
        for (int m = (s + 2) & ~1; m < 16; m += 2) a2 += (f32x2){nr4[m >> 2][m & 3], nr4[m >> 2][(m & 3) + 1]} * Tp[m >> 1];
        const float acc = a1 + (a2.x + a2.y);
        if (s & 1) Tp[s >> 1].y = (s < tl) ? acc : Tp[s >> 1].y; else Tp[s >> 1].x = (s < tl) ? acc : Tp[s >> 1].x; }
#pragma unroll
    for (int j = 0; j < 8; ++j) { Tc[2 * j] = Tp[j].x; Tc[2 * j + 1] = Tp[j].y; } }
    if (x < 16) {
#pragma unroll
        for (int g4 = 0; g4 < 4; ++g4) *(LAS f32x4*)(TT + tl * 16 + 4 * g4) = (f32x4){Tc[4 * g4], Tc[4 * g4 + 1], Tc[4 * g4 + 2], Tc[4 * g4 + 3]}; }
    float PV[16];
    PV[0] = 0.f;
#pragma unroll
    for (int s = 1; s < 16; ++s) { f32x2 a2 = {0.f, 0.f}; float a1 = 0.f;
#pragma unroll
        for (int r = 0; r + 1 < s; r += 2) a2 += (f32x2){GT[s * 36 + 16 + r], GT[s * 36 + 16 + r + 1]} * (f32x2){vv[r], vv[r + 1]};
        if (s & 1) a1 = GT[s * 36 + 16 + s - 1] * vv[s - 1];
        PV[s] = a1 + (a2.x + a2.y); }
    float Ah[16], U0[16];
#pragma unroll
    for (int t = 0; t < 16; ++t) { f32x2 a2 = {0.f, 0.f};
#pragma unroll
        for (int s = 0; s <= t; ++s) { const float tv = TT[t * 16 + s]; a2 += (f32x2){tv, tv} * (f32x2){At[s], PV[s]}; }
        Ah[t] = a2.x; U0[t] = a2.y; }
    float Rh[16], Y0[16];
#pragma unroll
    for (int t = 0; t < 16; ++t) { f32x2 ry = {Rt[t], 0.f};
#pragma unroll
        for (int s = 0; s <= t; ++s) { const float m1 = GT[(16 + t) * 36 + s], m2 = GT[(16 + t) * 36 + 16 + s]; ry += (f32x2){m1, m1} * (f32x2){Ah[s], U0[s]}; ry.y += m2 * vv[s]; }
        Rh[t] = ry.x; Y0[t] = ry.y; }
#undef RC_LD16
    { const int ks = x >> 5, jj = x & 31, e = (jj >> 4) * 4 + (jj & 3), q = (jj >> 2) & 3; LAS unsigned char* pb = wlds + ks * 1024 + q * 256 + e * 2;
#pragma unroll
      for (int s = 0; s < 16; ++s) { *(LAS bf16*)(pb + s * 16) = cvt1_c(Ah[s]); *(LAS bf16*)(pb + 2048 + s * 16) = cvt1_c(Rh[s]); }
#pragma unroll
      for (int j = 0; j < 4; ++j) { const v4u w = *(const LAS v4u*)(wlds + j * 1024 + x * 16); RC_ST(RC_AR + j * 1024 + x * 16, w); } }
#pragma unroll
    for (int q = 0; q < 2; ++q) { v4u w;
        w.x = cvtpk_c(U0[8 * q], U0[8 * q + 1]); w.y = cvtpk_c(U0[8 * q + 2], U0[8 * q + 3]); w.z = cvtpk_c(U0[8 * q + 4], U0[8 * q + 5]); w.w = cvtpk_c(U0[8 * q + 6], U0[8 * q + 7]); RC_ST(RC_U0 + x * 32 + q * 16, w);
        w.x = cvtpk_c(Y0[8 * q], Y0[8 * q + 1]); w.y = cvtpk_c(Y0[8 * q + 2], Y0[8 * q + 3]); w.z = cvtpk_c(Y0[8 * q + 4], Y0[8 * q + 5]); w.w = cvtpk_c(Y0[8 * q + 6], Y0[8 * q + 7]); RC_ST(RC_Y0 + x * 32 + q * 16, w); }
    LDS_WAIT();
}
__device__ __forceinline__ void rc_pass1_rwkv(Frame& F, int wid, int nw, int c0, int nc) {
    LAS unsigned char* wlds = F.lds + F.wave * RC_WLDS;
    const int x = F.lane;
    const float* RW = (const float*)(FWS + WS_RW);
    const bf16* RH = (const bf16*)(FWS + WS_RW + 32 * MiB);
    for (int it2 = wid; it2 < 16 * nc; it2 += nw) {
        const int u = it2 / nc, c = c0 + it2 % nc, it = u * RC_NCH + c, b = u >> 3, h = u & 7; const size_t o0 = ((size_t)(b * SEQ + c * 16)) * 512 + h * 64 + x;
        float At[16], Bt[16], Kt[16], Rt[16], vv[16]; float W = 1.0f;
#pragma unroll
        for (int t = 0; t < 16; ++t) { const size_t o = o0 + (size_t)t * 512;
            const float wv = RW[o], ka = bf2f(RH[3 * RWA + o]), bb = bf2f(RH[4 * RWA + o]), kk = bf2f(RH[1 * RWA + o]), rr = bf2f(RH[0 * RWA + o]); vv[t] = bf2f(RH[2 * RWA + o]);
            At[t] = -ka * W; W *= wv; const float iw = __builtin_amdgcn_rcpf(W); Bt[t] = bb * iw; Kt[t] = kk * iw; Rt[t] = rr * W; }
        rc_core(F, wlds, At, Bt, Kt, Rt, vv, W, (unsigned)it * RC_REC);
    }
}
__device__ __forceinline__ void rc_core_ret(Frame& F, LAS unsigned char* wlds, const float (&Kt)[16], const float (&Rt)[16], const float (&vv)[16], const float D, unsigned roff) {
    { unsigned wb_ = (unsigned)(uintptr_t)wlds; asm volatile("" : "+v"(wb_)); wlds = (LAS unsigned char*)(uintptr_t)wb_; }
    LAS bf16* XK = (LAS bf16*)wlds; LAS bf16* XR = (LAS bf16*)(wlds + 2304); LAS float* GM = (LAS float*)(wlds + 4608);
    int x_ = F.lane; asm volatile("" : "+v"(x_));
    const int x = x_, fr = x & 15, q = x >> 4;
#pragma unroll
    for (int t = 0; t < 16; ++t) { XK[t * 72 + x] = cvt1_c(Kt[t]); XR[t * 72 + x] = cvt1_c(Rt[t]); }
#pragma unroll
    for (int qq = 0; qq < 4; ++qq) { v4u w; w.x = 0u; w.y = 0u;
        w.z = cvtpk_c(Kt[4 * qq] * D, Kt[4 * qq + 1] * D); w.w = cvtpk_c(Kt[4 * qq + 2] * D, Kt[4 * qq + 3] * D); RC_ST(RC_BK + x * 64 + qq * 16, w); }
#pragma unroll
    for (int qq = 0; qq < 2; ++qq) { v4u w;
        w.x = cvtpk_c(vv[8 * qq], vv[8 * qq + 1]); w.y = cvtpk_c(vv[8 * qq + 2], vv[8 * qq + 3]); w.z = cvtpk_c(vv[8 * qq + 4], vv[8 * qq + 5]); w.w = cvtpk_c(vv[8 * qq + 6], vv[8 * qq + 7]); RC_ST(RC_VP + x * 32 + qq * 16, w);
        RC_ST(RC_U0 + x * 32 + qq * 16, ((v4u){0u, 0u, 0u, 0u})); }
    RC_ST_D(D);
    f32x4 G = {0.f, 0.f, 0.f, 0.f};
#pragma unroll
    for (int ks = 0; ks < 2; ++ks) { const bf16x8 a = *(const LAS bf16x8*)(XK + fr * 72 + ks * 32 + q * 8), bq = *(const LAS bf16x8*)(XR + fr * 72 + ks * 32 + q * 8);
        G = __builtin_amdgcn_mfma_f32_16x16x32_bf16(a, bq, G, 0, 0, 0); }
#pragma unroll
    for (int rg = 0; rg < 4; ++rg) GM[(4 * q + rg) * 17 + fr] = G[rg];
    { const int ks = x >> 5, jj = x & 31, e = (jj >> 4) * 4 + (jj & 3), qv = (jj >> 2) & 3; LAS unsigned char* pb = wlds + 2048 + ks * 1024 + qv * 256 + e * 2;
#pragma unroll
      for (int s = 0; s < 16; ++s) *(LAS bf16*)(pb + s * 16) = cvt1_c(Rt[s]);
#pragma unroll
      for (int j = 0; j < 2; ++j) { RC_ST(RC_AR + j * 1024 + x * 16, ((v4u){0u, 0u, 0u, 0u})); const v4u w = *(const LAS v4u*)(wlds + 2048 + j * 1024 + x * 16); RC_ST(RC_AR + 2048 + j * 1024 + x * 16, w); } }
    float Y0[16];
#pragma unroll
    for (int t = 0; t < 16; ++t) { float yy = 0.f;
#pragma unroll
        for (int s = 0; s <= t; ++s) yy += GM[s * 17 + t] * vv[s];
        Y0[t] = yy; }
#pragma unroll
    for (int qq = 0; qq < 2; ++qq) { v4u w;
        w.x = cvtpk_c(Y0[8 * qq], Y0[8 * qq + 1]); w.y = cvtpk_c(Y0[8 * qq + 2], Y0[8 * qq + 3]); w.z = cvtpk_c(Y0[8 * qq + 4], Y0[8 * qq + 5]); w.w = cvtpk_c(Y0[8 * qq + 6], Y0[8 * qq + 7]); RC_ST(RC_Y0 + x * 32 + qq * 16, w); }
    LDS_WAIT();
}
__device__ __forceinline__ void rc_pass1_ret(Frame& F, int wid, int nw, int c0, int nc) {
    LAS unsigned char* wlds = F.lds + F.wave * RC_WLDS;
    const int x = F.lane;
    const bf16* P = (const bf16*)(FWS + WS_PROJ);
    for (int it2 = wid; it2 < 16 * nc; it2 += nw) {
        const int ru = it2 / nc, c = c0 + it2 % nc, it = ru * RC_NCH + c, b = ru >> 3, h = (ru >> 1) & 3, half = ru & 1; const float gamma = 1.0f - exp2f(-5.0f - (float)h);
        float Kt[16], Rt[16], vv[16]; float W = 1.0f;
        const bf16* p0 = P + (size_t)(b * SEQ + c * 16) * IN_PAD;
#pragma unroll
        for (int t = 0; t < 16; ++t) { const bf16* p = p0 + (size_t)t * IN_PAD;
            const float rr = bf2f(p[C_RQ + h * 64 + x]), kk = bf2f(p[C_RK + h * 64 + x]) * 0.125f; vv[t] = bf2f(p[C_RV + h * 128 + half * 64 + x]);
            W *= gamma; const float iw = __builtin_amdgcn_rcpf(W); Kt[t] = kk * iw; Rt[t] = rr * W; }
        rc_core_ret(F, wlds, Kt, Rt, vv, W, (unsigned)(16 * RC_NCH + it) * RC_REC);
    }
}
__device__ __forceinline__ void rwkv_prep_mfma(Frame& F, int l, int first, int stride) {
    LAS unsigned char* wlds = F.lds + F.wave * RC_WLDS;
    LAS bf16* CODES = (LAS bf16*)(F.lds + RC_CODES_OFF);
    LAS float* ST = (LAS float*)wlds;
    const bf16* P = (const bf16*)(FWS + WS_PROJ);
    const float* mu = F.in[F.zz + 4] + l * RWC;
    const bf16* WT = (const bf16*)(FWS + WS_RWW + (size_t)l * 448 * 512 * 2);
    float* RW = (float*)(FWS + WS_RW);
    const int x = F.lane, h = F.wave, ch = h * 64 + x, fr = x & 15, q = x >> 4;
    for (int item = first; item < NB * RC_NCH; item += stride) {
        const int b = item >> 8, c = item & 255; const size_t row0 = (size_t)b * SEQ + c * 16; const int t0 = c * 16;
        const bf16* prc = P + row0 * IN_PAD + C_RW + ch;
        unsigned short nr_[4], nk_[4], nv_[4]; float pvr = 0.f, pvk = 0.f, pvv = 0.f;
        if (t0 > 0) { pvr = bf2f(prc[-IN_PAD]); pvk = bf2f(prc[512 - IN_PAD]); pvv = bf2f(prc[1024 - IN_PAD]); }
#pragma unroll
        for (int tt = 0; tt < 4; ++tt) { nr_[tt] = prc[(size_t)tt * IN_PAD]; nk_[tt] = prc[(size_t)tt * IN_PAD + 512]; nv_[tt] = prc[(size_t)tt * IN_PAD + 1024]; }
        const float mur = mu[ch], muk = mu[512 + ch], muv = mu[1024 + ch];
        const float w0c = F.in[F.zz + 5][l * 512 + ch], a0c = F.in[F.zz + 7][l * 512 + ch], kkc = F.in[F.zz + 10][l * 512 + ch], kac = F.in[F.zz + 11][l * 512 + ch], rkc = F.in[F.zz + 12][l * 512 + ch];
#pragma unroll 7
        for (int idx = F.tid; idx < 16 * 448; idx += NTHR) { const int tk = idx / 448, cc = idx - tk * 448;
            float val = lerp_bf(P, row0 + tk, C_RW + 1536 + cc, (t0 + tk) > 0, mu[1536 + cc]);
            if (cc < 96) val = 1.0f - 2.0f * __builtin_amdgcn_rcpf(1.0f + __expf(2.0f * val));
            else if (cc >= 192) val = sigmoidf_(val);
            CODES[tk * RC_CSTRIDE + cc] = cvt1_c(val); }
        __syncthreads();
        f32x4 accW[4], accA[4], accG[4];
#pragma unroll
        for (int ct = 0; ct < 4; ++ct) { accW[ct] = (f32x4){0.f, 0.f, 0.f, 0.f}; accA[ct] = accW[ct]; accG[ct] = accW[ct]; }
        { bf16x8 bw[3][4];
#pragma unroll
          for (int ks = 0; ks < 3; ++ks)
#pragma unroll
              for (int ct = 0; ct < 4; ++ct) bw[ks][ct] = *(const bf16x8*)(WT + (size_t)(h * 64 + ct * 16 + fr) * 96 + ks * 32 + q * 8);
#pragma unroll
          for (int ks = 0; ks < 3; ++ks) { const bf16x8 aw = *(const LAS bf16x8*)(CODES + fr * RC_CSTRIDE + ks * 32 + q * 8);
#pragma unroll
              for (int ct = 0; ct < 4; ++ct) accW[ct] = __builtin_amdgcn_mfma_f32_16x16x32_bf16(aw, bw[ks][ct], accW[ct], 0, 0, 0); } }
        asm volatile("" ::: "memory");
        { bf16x8 ba[3][4];
#pragma unroll
          for (int ks = 0; ks < 3; ++ks)
#pragma unroll
              for (int ct = 0; ct < 4; ++ct) ba[ks][ct] = *(const bf16x8*)(WT + 512 * 96 + (size_t)(h * 64 + ct * 16 + fr) * 96 + ks * 32 + q * 8);
#pragma unroll
          for (int ks = 0; ks < 3; ++ks) { const bf16x8 aa = *(const LAS bf16x8*)(CODES + fr * RC_CSTRIDE + 96 + ks * 32 + q * 8);
#pragma unroll
              for (int ct = 0; ct < 4; ++ct) accA[ct] = __builtin_amdgcn_mfma_f32_16x16x32_bf16(aa, ba[ks][ct], accA[ct], 0, 0, 0); } }
        asm volatile("" ::: "memory");
#pragma unroll
        for (int hf = 0; hf < 2; ++hf) { bf16x8 bg[4][4];
#pragma unroll
            for (int k4 = 0; k4 < 4; ++k4)
#pragma unroll
                for (int ct = 0; ct < 4; ++ct) bg[k4][ct] = *(const bf16x8*)(WT + 2 * 512 * 96 + (size_t)(h * 64 + ct * 16 + fr) * 256 + (hf * 4 + k4) * 32 + q * 8);
#pragma unroll
            for (int k4 = 0; k4 < 4; ++k4) { const bf16x8 ag = *(const LAS bf16x8*)(CODES + fr * RC_CSTRIDE + 192 + (hf * 4 + k4) * 32 + q * 8);
#pragma unroll
                for (int ct = 0; ct < 4; ++ct) accG[ct] = __builtin_amdgcn_mfma_f32_16x16x32_bf16(ag, bg[k4][ct], accG[ct], 0, 0, 0); }
            asm volatile("" ::: "memory"); }
#pragma unroll
        for (int ct = 0; ct < 4; ++ct)
#pragma unroll
            for (int rg = 0; rg < 4; ++rg) { const int o = (4 * q + rg) * 64 + ct * 16 + fr; ST[o] = accW[ct][rg]; ST[1024 + o] = accA[ct][rg]; ST[2048 + o] = accG[ct][rg]; }
        float* gpw = RW + row0 * 512 + ch;
        bf16* gp = (bf16*)(FWS + WS_RW + 32 * MiB) + row0 * 512 + ch;
        for (int g = 0; g < 4; ++g) {
            unsigned short cr_[4], ck_[4], cv_[4];
#pragma unroll
            for (int tt = 0; tt < 4; ++tt) { cr_[tt] = nr_[tt]; ck_[tt] = nk_[tt]; cv_[tt] = nv_[tt]; }
            if (g < 3) {
#pragma unroll
                for (int tt = 0; tt < 4; ++tt) { const size_t ro = (size_t)(4 * g + 4 + tt) * IN_PAD; nr_[tt] = prc[ro]; nk_[tt] = prc[ro + 512]; nv_[tt] = prc[ro + 1024]; } }
#pragma unroll
          for (int tt = 0; tt < 4; ++tt) { const int t = 4 * g + tt;
            const float cr = bf2f(cr_[tt]), ck = bf2f(ck_[tt]), cv = bf2f(cv_[tt]);
            const float rr = cr + (pvr - cr) * mur, kk0 = ck + (pvk - ck) * muk, vv = cv + (pvv - cv) * muv;
            pvr = cr; pvk = ck; pvv = cv;
            const float z = -(w0c + ST[t * 64 + x]);
            const float sp = fmaxf(z, 0.f) + __logf(1.0f + __expf(-fabsf(z)));
            const float decay = __expf(-__expf(-sp - 0.5f));
            const float a = sigmoidf_(a0c + ST[1024 + t * 64 + x]);
            const float gg = ST[2048 + t * 64 + x];
            const float kkv = kk0 * kkc;
            const float nrm = __builtin_amdgcn_sqrtf(wave_sum(kkv * kkv));
            const float kap = kkv * __builtin_amdgcn_rcpf(fmaxf(nrm, 1e-12f));
            const float kp = kk0 * (1.0f + (a - 1.0f) * kac);
            const float bsum = wave_sum(rr * kp * rkc);
            gpw[0] = decay; gpw += 512;
            gp[0 * RWA] = cvt1_c(rr); gp[1 * RWA] = cvt1_c(kp); gp[2 * RWA] = cvt1_c(vv); gp[3 * RWA] = cvt1_c(kap); gp[4 * RWA] = cvt1_c(kap * a); gp[5 * RWA] = cvt1_c(gg); gp[6 * RWA] = cvt1_c(bsum * vv); gp += 512; } }
        LDS_WAIT();
        __syncthreads();
    }
}
constexpr int RC_SLOT = 15360, RC_YST = 8 * RC_SLOT  ;
__device__ __forceinline__ void rc_pass2(Frame& F, int u, int cb, int ce, bool first, bool last) {
    const unsigned char* rec = FWS + WS_REC + (size_t)u * RC_NCH * RC_REC;
    const int lane = F.lane;
    const int NIT = (ce - cb) / 2;
    bf16* Yg;
    if (u < 16) Yg = (bf16*)(FWS + WS_Y) + (size_t)((u >> 3) * SEQ) * 512 + (u & 7) * 64;
    else { const int ru = u - 16; Yg = (bf16*)(FWS + WS_RETO) + (size_t)((ru >> 3) * SEQ) * 512 + ((ru >> 1) & 3) * 128 + (ru & 1) * 64; }
#define RC_BARRIER() __builtin_amdgcn_s_barrier()
    if (F.wave == 7) {
        unsigned t0_ = 0u, t1_ = 0u, t2_ = 0u, t3_ = 0u;
        for (int cq = cb; cq < cb + 24 && cq < ce; cq += 2) { const unsigned char* pa = rec + (size_t)cq * RC_REC + lane * 128; const unsigned char* pb = pa + 8192; const unsigned char* pc = pa + RC_REC; const unsigned char* pd = pb + RC_REC;
            asm volatile("global_load_dword %0, %4, off\n\tglobal_load_dword %1, %5, off\n\tglobal_load_dword %2, %6, off\n\tglobal_load_dword %3, %7, off" : "+v"(t0_), "+v"(t1_), "+v"(t2_), "+v"(t3_) : "v"(pa), "v"(pb), "v"(pc), "v"(pd) : "memory"); }
        RC_BARRIER();
        for (int i = 0; i < NIT; ++i) {
            const int cp = cb + 2 * i + 24;
            if (cp < ce) { const unsigned char* pa = rec + (size_t)cp * RC_REC + lane * 128; const unsigned char* pb = pa + 8192; const unsigned char* pc = pa + RC_REC; const unsigned char* pd = pb + RC_REC;
                asm volatile("global_load_dword %0, %4, off\n\tglobal_load_dword %1, %5, off\n\tglobal_load_dword %2, %6, off\n\tglobal_load_dword %3, %7, off" : "+v"(t0_), "+v"(t1_), "+v"(t2_), "+v"(t3_) : "v"(pa), "v"(pb), "v"(pc), "v"(pd) : "memory"); }
            if (i > 0) {
                const LAS unsigned char* yb = F.lds + RC_YST + ((i - 1) & 1) * 4096;
#pragma unroll
                for (int j = 0; j < 4; ++j) { const v4u w = *(const LAS v4u*)(yb + j * 1024 + lane * 16);
                    *(v4u*)(Yg + (size_t)((cb + 2 * i - 2) * 16 + j * 8 + (lane >> 3)) * 512 + (lane & 7) * 8) = w; } }
            RC_BARRIER();
        }
        { const LAS unsigned char* yb = F.lds + RC_YST + ((NIT - 1) & 1) * 4096;
#pragma unroll
          for (int j = 0; j < 4; ++j) { const v4u w = *(const LAS v4u*)(yb + j * 1024 + lane * 16);
              *(v4u*)(Yg + (size_t)((cb + 2 * NIT - 2) * 16 + j * 8 + (lane >> 3)) * 512 + (lane & 7) * 8) = w; } }
        asm volatile("s_waitcnt vmcnt(0)" ::: "memory");
        asm volatile("" :: "v"(t0_), "v"(t1_), "v"(t2_), "v"(t3_));
    } else if (F.wave >= 4) {
        const int lw = F.wave - 4;
        const int p0_ = lw == 0 ? 8 : (lw == 1 ? 11 : 13), np_ = lw == 0 ? 3 : 2;
#define RC_ISSUE(c) do { _Pragma("unroll") for (int i_ = 0; i_ < 3; ++i_) { if (i_ < np_) \
            __builtin_amdgcn_global_load_lds((const unsigned*)(rec + (size_t)(c) * RC_REC + (p0_ + i_) * 1024 + lane * 16), (LAS unsigned*)(F.lds + ((c) & 7) * RC_SLOT + (p0_ + i_) * 1024), 16, 0, 0); } } while (0)
#define RC_WAIT4() do { if (lw == 0) asm volatile("s_waitcnt vmcnt(12)" ::: "memory"); else asm volatile("s_waitcnt vmcnt(8)" ::: "memory"); } while (0)
        for (int c = cb; c < cb + 6; ++c) RC_ISSUE(c);
        RC_WAIT4();
        RC_BARRIER();
        for (int i = 0; i < NIT; ++i) {
            if (cb + 2 * i + 7 < ce) { RC_ISSUE(cb + 2 * i + 6); RC_ISSUE(cb + 2 * i + 7); RC_WAIT4(); }
            else asm volatile("s_waitcnt vmcnt(0)" ::: "memory");
            RC_BARRIER();
        }
#undef RC_ISSUE
#undef RC_WAIT4
    } else {
        const int ib = F.wave, fr = lane & 15, q = lane >> 4;
#define RC_ISSUE1(c) do { __builtin_amdgcn_global_load_lds((const unsigned*)(rec + (size_t)(c) * RC_REC + (2 * ib) * 1024 + lane * 16), (LAS unsigned*)(F.lds + ((c) & 7) * RC_SLOT + (2 * ib) * 1024), 16, 0, 0); \
        __builtin_amdgcn_global_load_lds((const unsigned*)(rec + (size_t)(c) * RC_REC + (2 * ib + 1) * 1024 + lane * 16), (LAS unsigned*)(F.lds + ((c) & 7) * RC_SLOT + (2 * ib + 1) * 1024), 16, 0, 0); } while (0)
        f32x4* sv = (f32x4*)(FWS + WS_CTL + 262144) + (size_t)((u * 4 + ib) * 4 + 0) * 64 + lane;
        f32x4 sT[4];
#pragma unroll
        for (int jb = 0; jb < 4; ++jb) sT[jb] = first ? (f32x4){0.f, 0.f, 0.f, 0.f} : sv[jb * 64];
        asm volatile("s_waitcnt vmcnt(0)" ::: "memory");
        for (int c = cb; c < cb + 6; ++c) RC_ISSUE1(c);
        asm volatile("s_waitcnt vmcnt(8)" ::: "memory");
        RC_BARRIER();
        for (int i = 0; i < NIT; ++i) {
            bf16x8 aU0[2], aU1[2], aY0[2], aY1[2], bk[2][4]; f32x4 dd[2][4]; v2u vp[2], u0[2], y0[2];
#pragma unroll
            for (int h = 0; h < 2; ++h) { const LAS unsigned char* slot = F.lds + ((cb + 2 * i + h) & 7) * RC_SLOT;
                aU0[h] = *(const LAS bf16x8*)(slot + RC_AR + q * 256 + fr * 16); aU1[h] = *(const LAS bf16x8*)(slot + RC_AR + 1024 + q * 256 + fr * 16);
                aY0[h] = *(const LAS bf16x8*)(slot + RC_AR + 2048 + q * 256 + fr * 16); aY1[h] = *(const LAS bf16x8*)(slot + RC_AR + 3072 + q * 256 + fr * 16);
                u0[h] = *(const LAS v2u*)(slot + RC_U0 + (16 * ib + fr) * 32 + q * 8); vp[h] = *(const LAS v2u*)(slot + RC_VP + (16 * ib + fr) * 32 + q * 8);
#pragma unroll
                for (int jb = 0; jb < 4; ++jb) { bk[h][jb] = *(const LAS bf16x8*)(slot + RC_BK + (16 * jb + fr) * 64 + q * 16); dd[h][jb] = *(const LAS f32x4*)(slot + RC_D + (16 * jb + 4 * q) * 4); }
                y0[h] = *(const LAS v2u*)(slot + RC_Y0 + (16 * ib + fr) * 32 + q * 8); }
            LAS bf16* yst = (LAS bf16*)(F.lds + RC_YST + (i & 1) * 4096);
#pragma unroll
            for (int h = 0; h < 2; ++h) {
                v4u s0, s1;
                s0.x = cvtpk_c(sT[0][0], sT[0][1]); s0.y = cvtpk_c(sT[0][2], sT[0][3]); s0.z = cvtpk_c(sT[1][0], sT[1][1]); s0.w = cvtpk_c(sT[1][2], sT[1][3]);
                s1.x = cvtpk_c(sT[2][0], sT[2][1]); s1.y = cvtpk_c(sT[2][2], sT[2][3]); s1.z = cvtpk_c(sT[3][0], sT[3][1]); s1.w = cvtpk_c(sT[3][2], sT[3][3]);
                const bf16x8 sb0 = __builtin_bit_cast(bf16x8, s0), sb1 = __builtin_bit_cast(bf16x8, s1);
                f32x4 zU = (f32x4){0.f, 0.f, 0.f, 0.f}, zY = (f32x4){0.f, 0.f, 0.f, 0.f};
                zU = __builtin_amdgcn_mfma_f32_16x16x32_bf16(aU0[h], sb0, zU, 0, 0, 0); zU = __builtin_amdgcn_mfma_f32_16x16x32_bf16(aU1[h], sb1, zU, 0, 0, 0);
                const float U0_ = zU[0] + bflo(u0[h].x), U1_ = zU[1] + bfhi(u0[h].x), U2_ = zU[2] + bflo(u0[h].y), U3_ = zU[3] + bfhi(u0[h].y);
                v4u ubw; ubw.x = cvtpk_c(U0_, U1_); ubw.y = cvtpk_c(U2_, U3_); ubw.z = vp[h].x; ubw.w = vp[h].y;
                const bf16x8 ub = __builtin_bit_cast(bf16x8, ubw);
#pragma unroll
                for (int jb = 0; jb < 4; ++jb) sT[jb] = __builtin_amdgcn_mfma_f32_16x16x32_bf16(bk[h][jb], ub, sT[jb] * dd[h][jb], 0, 0, 0);
                zY = __builtin_amdgcn_mfma_f32_16x16x32_bf16(aY0[h], sb0, zY, 0, 0, 0); zY = __builtin_amdgcn_mfma_f32_16x16x32_bf16(aY1[h], sb1, zY, 0, 0, 0);
                LAS bf16* yp = yst + h * 1024 + (4 * q) * 64 + 16 * ib + fr;
                yp[0] = cvt1_c(zY[0] + bflo(y0[h].x)); yp[64] = cvt1_c(zY[1] + bfhi(y0[h].x)); yp[128] = cvt1_c(zY[2] + bflo(y0[h].y)); yp[192] = cvt1_c(zY[3] + bfhi(y0[h].y));
            }
            if (cb + 2 * i + 7 < ce) { RC_ISSUE1(cb + 2 * i + 6); RC_ISSUE1(cb + 2 * i + 7); asm volatile("s_waitcnt vmcnt(8) lgkmcnt(0)" ::: "memory"); } else asm volatile("s_waitcnt vmcnt(0) lgkmcnt(0)" ::: "memory");
            RC_BARRIER();
        }
        if (!last) {
#pragma unroll
            for (int jb = 0; jb < 4; ++jb) sv[jb * 64] = sT[jb]; }
#undef RC_ISSUE1
    }
#undef RC_BARRIER
    asm volatile("s_waitcnt vmcnt(0) lgkmcnt(0)" ::: "memory");
    __syncthreads();
}
__device__ __forceinline__ void sub_arrive(Frame& F, unsigned* cnt) {
    asm volatile("s_waitcnt vmcnt(0)" ::: "memory");
    __syncthreads();
    if (F.tid == 0) { __builtin_amdgcn_fence(__ATOMIC_RELEASE, "agent"); asm volatile("s_waitcnt vmcnt(0)" ::: "memory"); __hip_atomic_fetch_add(cnt, 1u, __ATOMIC_RELAXED, __HIP_MEMORY_SCOPE_AGENT); }
}
__device__ __forceinline__ void xcd_publish(Frame& F, unsigned* local, unsigned nlocal, unsigned* global) {
    asm volatile("s_waitcnt vmcnt(0)" ::: "memory");
    __syncthreads();
    if (F.tid == 0) {
        const unsigned old = __hip_atomic_fetch_add(local, 1u, __ATOMIC_RELAXED, __HIP_MEMORY_SCOPE_AGENT);
        if (old + 1u == nlocal) { __builtin_amdgcn_fence(__ATOMIC_RELEASE, "agent"); asm volatile("s_waitcnt vmcnt(0)" ::: "memory"); __hip_atomic_fetch_add(global, nlocal, __ATOMIC_RELAXED, __HIP_MEMORY_SCOPE_AGENT); }
    }
}
__device__ __forceinline__ void sub_wait(Frame& F, unsigned* cnt, unsigned target) {
    if (F.tid == 0) { unsigned sp = 0u;
        while (__hip_atomic_load(cnt, __ATOMIC_RELAXED, __HIP_MEMORY_SCOPE_AGENT) < target) { __builtin_amdgcn_s_sleep(2); if (++sp > (1u << 24)) break; }
        __builtin_amdgcn_fence(__ATOMIC_ACQUIRE, "agent"); asm volatile("s_waitcnt vmcnt(0)" ::: "memory"); }
    __syncthreads();
}
__device__ __forceinline__ void sub_barrier(Frame& F, unsigned* cnt, unsigned target) {
    asm volatile("s_waitcnt vmcnt(0)" ::: "memory");
    __syncthreads();
    if (F.tid == 0) {
        __builtin_amdgcn_fence(__ATOMIC_RELEASE, "agent");
        asm volatile("s_waitcnt vmcnt(0)" ::: "memory");
        __hip_atomic_fetch_add(cnt, 1u, __ATOMIC_RELAXED, __HIP_MEMORY_SCOPE_AGENT);
        unsigned sp = 0u;
        while (__hip_atomic_load(cnt, __ATOMIC_RELAXED, __HIP_MEMORY_SCOPE_AGENT) < target) { __builtin_amdgcn_s_sleep(2); if (++sp > (1u << 24)) break; }
        __builtin_amdgcn_fence(__ATOMIC_ACQUIRE, "agent");
        asm volatile("s_waitcnt vmcnt(0)" ::: "memory");
    }
    __syncthreads();
}
__device__ __forceinline__ void mixer_post(Frame& F, int l, int gw, int NGW) {
    const bf16* P = (const bf16*)(FWS + WS_PROJ);
    const bf16* RH = (const bf16*)(FWS + WS_RW + 32 * MiB);
    const float* RW = (const float*)(FWS + WS_RW);
    const bf16* Y = (const bf16*)(FWS + WS_Y);
    const bf16* RO = (const bf16*)(FWS + WS_RETO);
    bf16* MX = (bf16*)(FWS + WS_MIXED);
    const float* ln_w = F.in[F.zz + 13] + l * 512; const float* ln_b = F.in[F.zz + 14] + l * 512;
    const int lane = F.lane;
    for (int m = gw; m < MROWS; m += NGW) {
        const size_t o = (size_t)m * 512;
        float y[8], s1[8], s2[8], bon[8], gat[8]; f32x2 ov[4]; float s3[4]; unsigned gw2[4];
#pragma unroll
        for (int h = 0; h < 8; ++h) { const int c = h * 64 + lane; y[h] = bf2f(Y[o + c]); bon[h] = bf2f(RH[6 * RWA + o + c]); gat[h] = bf2f(RH[5 * RWA + o + c]); s1[h] = y[h]; }
#pragma unroll
        for (int h = 0; h < 4; ++h) { const int c = h * 128 + 2 * lane; { const unsigned rw_ = *(const unsigned*)(RO + o + c); ov[h].x = bflo(rw_); ov[h].y = bfhi(rw_); } gw2[h] = *(const unsigned*)(P + (size_t)m * IN_PAD + C_RG + c); s3[h] = ov[h].x * ov[h].x + ov[h].y * ov[h].y; }
#pragma unroll
        for (int h = 0; h < 8; ++h) { s1[h] = dpp_add<0xB1>(s1[h]); s1[h] = dpp_add<0x4E>(s1[h]); s1[h] = dpp_add<0x141>(s1[h]); s1[h] = dpp_add<0x140>(s1[h]); }
#pragma unroll
        for (int h = 0; h < 4; ++h) { s3[h] = dpp_add<0xB1>(s3[h]); s3[h] = dpp_add<0x4E>(s3[h]); s3[h] = dpp_add<0x141>(s3[h]); s3[h] = dpp_add<0x140>(s3[h]); }
#pragma unroll
        for (int h = 0; h < 8; ++h) s1[h] = xsum32(xsum16(s1[h]));
#pragma unroll
        for (int h = 0; h < 4; ++h) s3[h] = xsum32(xsum16(s3[h]));
#pragma unroll
        for (int h = 0; h < 8; ++h) { const float d = y[h] - s1[h] * (1.0f / 64.0f); y[h] = d; s2[h] = d * d; }
#pragma unroll
        for (int h = 0; h < 8; ++h) { s2[h] = dpp_add<0xB1>(s2[h]); s2[h] = dpp_add<0x4E>(s2[h]); s2[h] = dpp_add<0x141>(s2[h]); s2[h] = dpp_add<0x140>(s2[h]); }
#pragma unroll
        for (int h = 0; h < 8; ++h) s2[h] = xsum32(xsum16(s2[h]));
#pragma unroll
        for (int h = 0; h < 8; ++h) { const int c = h * 64 + lane;
            const float yn = y[h] * __builtin_amdgcn_rsqf(s2[h] * (1.0f / 64.0f) + GN_EPS) * ln_w[c] + ln_b[c];
            MX[(size_t)m * DM + 512 + c] = (bf16)f2bf((yn + bon[h]) * gat[h]); }
#pragma unroll
        for (int h = 0; h < 4; ++h) { const int c = h * 128 + 2 * lane;
            const float rn = __builtin_amdgcn_rsqf(s3[h] * (1.0f / 128.0f) + NORM_EPS);
            const float g0 = bflo(gw2[h]), g1 = bfhi(gw2[h]);
            *(unsigned*)(MX + (size_t)m * DM + c) = pk2(ov[h].x * rn * g0 * sigmoidf_(g0), ov[h].y * rn * g1 * sigmoidf_(g1)); }
    }
}
__device__ __forceinline__ void conv_gate_phase(Frame& F, int l) {
    const bf16* U = (const bf16*)(FWS + WS_U);
    bf16* A = (bf16*)(FWS + WS_ACT);
    const float* cw = F.in[F.zz + 16] + (size_t)l * 3 * UPC; const float* cb = F.in[F.zz + 17] + (size_t)l * UPC;
    constexpr int NCG = DFF / 8, NRC = MROWS / 16;
    for (int it = F.vcu * NTHR + F.tid; it < NCG * NRC; it += F.G * NTHR) {
        const int cg = it % NCG, rc = it / NCG, c0 = cg * 8, row0 = rc * 16, t0 = row0 & (SEQ - 1);
        float wv[3][8], wg[3][8], bv[8], bg[8];
#pragma unroll
        for (int j = 0; j < 3; ++j)
#pragma unroll
            for (int e = 0; e < 8; ++e) { wv[j][e] = cw[j * UPC + c0 + e]; wg[j][e] = cw[j * UPC + DFF + c0 + e]; }
#pragma unroll
        for (int e = 0; e < 8; ++e) { bv[e] = cb[c0 + e]; bg[e] = cb[DFF + c0 + e]; }
        v4u v0 = {0u, 0u, 0u, 0u}, v1 = v0, g0 = v0, g1 = v0;
        if (t0 > 0) { v0 = *(const v4u*)(U + (size_t)(row0 - 2) * UPC + c0); v1 = *(const v4u*)(U + (size_t)(row0 - 1) * UPC + c0);
                      g0 = *(const v4u*)(U + (size_t)(row0 - 2) * UPC + DFF + c0); g1 = *(const v4u*)(U + (size_t)(row0 - 1) * UPC + DFF + c0); }
        for (int r = 0; r < 16; ++r) {
            const v4u v2 = *(const v4u*)(U + (size_t)(row0 + r) * UPC + c0), g2 = *(const v4u*)(U + (size_t)(row0 + r) * UPC + DFF + c0);
            float ov[8];
#pragma unroll
            for (int e = 0; e < 4; ++e) {
                const float va = wv[0][2 * e] * bflo(v0[e]) + wv[1][2 * e] * bflo(v1[e]) + wv[2][2 * e] * bflo(v2[e]) + bv[2 * e];
                const float vb = wv[0][2 * e + 1] * bfhi(v0[e]) + wv[1][2 * e + 1] * bfhi(v1[e]) + wv[2][2 * e + 1] * bfhi(v2[e]) + bv[2 * e + 1];
                const float ga = wg[0][2 * e] * bflo(g0[e]) + wg[1][2 * e] * bflo(g1[e]) + wg[2][2 * e] * bflo(g2[e]) + bg[2 * e];
                const float gb = wg[0][2 * e + 1] * bfhi(g0[e]) + wg[1][2 * e + 1] * bfhi(g1[e]) + wg[2][2 * e + 1] * bfhi(g2[e]) + bg[2 * e + 1];
                ov[2 * e] = ga * sigmoidf_(ga) * va; ov[2 * e + 1] = gb * sigmoidf_(gb) * vb; }
            v4u w; w.x = pk2(ov[0], ov[1]); w.y = pk2(ov[2], ov[3]); w.z = pk2(ov[4], ov[5]); w.w = pk2(ov[6], ov[7]);
            *(v4u*)(A + (size_t)(row0 + r) * DFF + c0) = w;
            v0 = v1; v1 = v2; g0 = g1; g1 = g2;
        }
    }
}

__device__ __forceinline__ void conv_fixup_phase(Frame& F, int l) {
    const float* H = (const float*)(FWS + WS_HALO);
    bf16* A = (bf16*)(FWS + WS_ACT);
    const float* cw = F.in[F.zz + 16] + (size_t)l * 3 * UPC; const float* cb = F.in[F.zz + 17] + (size_t)l * UPC;
    constexpr int NQ = DFF / 4;
    for (int it = F.vcu * NTHR + F.tid; it < (MROWS / 64) * 2 * NQ; it += F.G * NTHR) {
        const int c = (it % NQ) * 4, gr = it / NQ, r = gr & 1, g = gr >> 1, colp = (c >> 7) * 256 + (c & 127);
        const bool hasprev = (g & 63) != 0;
        const float* hg = H + (size_t)g * 4 * UPC + colp; const float* hp = hg - (size_t)4 * UPC;
        const f32x4 z = {0.f, 0.f, 0.f, 0.f};
        f32x4 v0, v1, v2, g0, g1, g2;
        v0 = *(const f32x4*)(hg + (size_t)r * UPC); g0 = *(const f32x4*)(hg + (size_t)r * UPC + 128);
        if (r == 1) { v1 = *(const f32x4*)hg; g1 = *(const f32x4*)(hg + 128); v2 = hasprev ? *(const f32x4*)(hp + (size_t)3 * UPC) : z; g2 = hasprev ? *(const f32x4*)(hp + (size_t)3 * UPC + 128) : z; }
        else { v1 = hasprev ? *(const f32x4*)(hp + (size_t)3 * UPC) : z; g1 = hasprev ? *(const f32x4*)(hp + (size_t)3 * UPC + 128) : z; v2 = hasprev ? *(const f32x4*)(hp + (size_t)2 * UPC) : z; g2 = hasprev ? *(const f32x4*)(hp + (size_t)2 * UPC + 128) : z; }
        const f32x4 cv = *(const f32x4*)(cw + c) * v2 + *(const f32x4*)(cw + UPC + c) * v1 + *(const f32x4*)(cw + 2 * UPC + c) * v0 + *(const f32x4*)(cb + c);
        const f32x4 cg = *(const f32x4*)(cw + DFF + c) * g2 + *(const f32x4*)(cw + UPC + DFF + c) * g1 + *(const f32x4*)(cw + 2 * UPC + DFF + c) * g0 + *(const f32x4*)(cb + DFF + c);
        v2u w; w.x = pk2(cg[0] * sigmoidf_(cg[0]) * cv[0], cg[1] * sigmoidf_(cg[1]) * cv[1]); w.y = pk2(cg[2] * sigmoidf_(cg[2]) * cv[2], cg[3] * sigmoidf_(cg[3]) * cv[3]);
        *(v2u*)(A + (size_t)(64 * g + r) * DFF + c) = w;
    }
}

#define GRID_BAR() do { xcd_barrier(bar, tid_from_wave(F.wave)); asm volatile("" : "+s"(F.wave), "+s"(F.vcu), "+s"(F.G)); F.tid = tid_from_wave(F.wave); F.lane = F.tid & 63; { unsigned z_ = 0u; asm volatile("" : "+v"(z_)); F.zz = __builtin_amdgcn_readfirstlane(z_); } } while (0)
#define XB ((bf16*)(FWS + WS_X))
#define HB ((bf16*)(FWS + WS_H))
#define PROJ ((bf16*)(FWS + WS_PROJ))
#define MIXED ((bf16*)(FWS + WS_MIXED))
#define UB ((bf16*)(FWS + WS_U))
#define ACT ((bf16*)(FWS + WS_ACT))
#define MOD ((const float*)(FWS + WS_MOD))
template <int l>
__device__ __forceinline__ void layer_fwd(Frame& F, const XcdBarrier& bar) {
#define modl (MOD + (size_t)l * 2 * 12288)
#define wl (FWS + WS_W + (size_t)l * W_LAYER)
        if (l == 0) norm_phase<0, true>(F, F.in[F.zz + 0], HB, F.in[F.zz + 21] + l * DM, modl + 0 * DM, modl + 1 * DM);
        else norm_phase<0, false>(F, XB, HB, F.in[F.zz + 21] + l * DM, modl + 0 * DM, modl + 1 * DM);
        GRID_BAR();
        { pg8::Gemm g{HB, (const bf16*)(wl + W_IN), MROWS, IN_PAD, DM}; pg8::StaticOrder S; S.init(MROWS, IN_PAD, F.G, (int)blockIdx.x);
          pg8::EpiBf16 E{PROJ, IN_PAD};
          pg8::gemm_phase<pg8::EpiBf16, pg8::StaticOrder, true, true>(F.lds, g, S, E, F.wave); }
        if (F.G == 256 && blockIdx.x >= 64) convert_gap(F, l, CV_IN, l == 0 ? CV_C1 : CV_OUT + CV_UP, ((int)blockIdx.x - 64) * NWAVES + F.wave, 192 * NWAVES, CV_N1);
        GRID_BAR();
        rwkv_prep_mfma(F, l, F.vcu, F.G);
        moba_kmean(F);
        GRID_BAR();
        const int xg_ = F.vcu >> 5, xj_ = F.vcu & 31, mi_ = xg_ * 16 + xj_;
        if (xj_ < 16) { moba_item(F, mi_ >> 3, 15 - (mi_ & 7), mi_ & 7);
            asm volatile("" : "+s"(F.wave)); F.tid = tid_from_wave(F.wave); F.lane = F.tid & 63;
            if (F.G == 256 && l == 0) { constexpr int nr_ = CV_LAYER - (CV_IN + CV_C1); LAS float* scr_ = (LAS float*)(F.lds + F.wave * 16384);
                for (int j = 0; j < CV_N3; ++j) { const int s_ = mi_ * NWAVES + F.wave + 128 * NWAVES * j;
                    if (s_ < nr_) convert_item(F, l * CV_LAYER + CV_IN + CV_C1 + s_, scr_);
                    else if (l == 0 && s_ - nr_ < CV_IN - CV_C2) convert_item(F, CV_LAYER + CV_C2 + (s_ - nr_), scr_); } }
            sub_wait(F, (unsigned*)(FWS + WS_CTL) + CW_SUB + 128 * l + 64, (unsigned)(F.G / 2));
        }
        else {
            const int rv = xg_ * 16 + (xj_ - 16), nrc = F.G / 2;
            unsigned* sub = (unsigned*)(FWS + WS_CTL) + CW_SUB + 128 * l;
            unsigned* grp = (unsigned*)(FWS + WS_CTL) + CW_SUB + 256 + 128 * l;
            unsigned* xl = (unsigned*)(FWS + WS_CTL) + CW_SUB + 1024 + 1024 * l + 64 * bar.x;
            const bool p2cu = (rv & 3) == 0 && (rv >> 2) < RC_UNITS;
            if (!p2cu && F.tid == 0) __hip_atomic_fetch_add(xl, 1u, __ATOMIC_RELAXED, __HIP_MEMORY_SCOPE_AGENT);
            rc_pass1_rwkv(F, rv * NWAVES + F.wave, nrc * NWAVES, 0, 64);
            rc_pass1_ret(F, rv * NWAVES + F.wave, nrc * NWAVES, 0, 64);
            sub_barrier(F, sub, (unsigned)nrc);
            if (p2cu) {
                for (int sg = 0; sg < 5; ++sg) {
                    if (sg > 0) sub_wait(F, grp + 32 * (sg - 1), (unsigned)(nrc - RC_UNITS));
                    rc_pass2(F, rv >> 2, sg == 0 ? 0 : 16 + 48 * sg, 64 + 48 * sg, sg == 0, sg == 4);
                }
            } else {
                const int ov = rv - (rv >> 2) - 1, nov = nrc - RC_UNITS;
                const unsigned nloc = __builtin_amdgcn_readfirstlane(__hip_atomic_load(xl, __ATOMIC_RELAXED, __HIP_MEMORY_SCOPE_AGENT));
                for (int g = 0; g < 4; ++g) {
                    rc_pass1_rwkv(F, ov * NWAVES + F.wave, nov * NWAVES, 64 + 48 * g, 48);
                    rc_pass1_ret(F, ov * NWAVES + F.wave, nov * NWAVES, 64 + 48 * g, 48);
                    xcd_publish(F, xl + 1 + g, nloc, grp + 32 * g);
                }
            }
            sub_barrier(F, sub + 64, (unsigned)nrc);
        }
        asm volatile("" : "+s"(F.wave), "+s"(F.vcu), "+s"(F.G)); F.tid = tid_from_wave(F.wave); F.lane = F.tid & 63; { unsigned z_ = 0u; asm volatile("" : "+v"(z_)); F.zz = __builtin_amdgcn_readfirstlane(z_); }
        mixer_post(F, l, F.vcu * NWAVES + F.wave, F.G * NWAVES);
        GRID_BAR();
#if MOBA_CHECK
        moba_naive(F, F.vcu * NWAVES + F.wave, F.G * NWAVES);
        GRID_BAR();
        { float sd = 0.f, sn = 0.f; const bf16* NV = (const bf16*)(FWS + WS_U + 160 * MiB); const bf16* MXc = (const bf16*)(FWS + WS_MIXED);
          for (int m = F.vcu * NWAVES + F.wave; m < MROWS; m += F.G * NWAVES) for (int j = 0; j < 16; ++j) { const float a = bf2f(MXc[(size_t)m * DM + 1024 + j * 64 + F.lane]), b = bf2f(NV[(size_t)m * 1024 + j * 64 + F.lane]); sd += (a - b) * (a - b); sn += b * b; }
          atomicAdd((float*)(FWS + WS_CTL) + 8, sd); atomicAdd((float*)(FWS + WS_CTL) + 9, sn); }
        GRID_BAR();
#endif
        { pg8::Gemm g{MIXED, (const bf16*)(wl + W_OUT), MROWS, DM, DM}; pg8::StaticOrder S; S.init(MROWS, DM, F.G, (int)blockIdx.x);
          if (l == 0) { pg8::EpiResGate<true> E{F.in[F.zz + 0], XB, DM, modl + 2 * DM, 12288, SEQ}; pg8::gemm_phase<pg8::EpiResGate<true>, pg8::StaticOrder, true, true>(F.lds, g, S, E, F.wave); }
          else { pg8::EpiResGate<false> E{XB, XB, DM, modl + 2 * DM, 12288, SEQ}; pg8::gemm_phase<pg8::EpiResGate<false>, pg8::StaticOrder, true, true>(F.lds, g, S, E, F.wave); } }
        GRID_BAR();
        norm_phase<0, false>(F, XB, HB, F.in[F.zz + 22] + l * DM, modl + 3 * DM, modl + 4 * DM);
        GRID_BAR();
        { pg8::Gemm g{HB, (const bf16*)(wl + W_UP), MROWS, UPC, DM}; pg8::StaticOrder S; S.init(MROWS, UPC, F.G, (int)blockIdx.x);
          pg8::EpiConvGate E{ACT, DFF, (float*)(FWS + WS_HALO), F.in[F.zz + 16] + (size_t)l * 3 * UPC, F.in[F.zz + 17] + (size_t)l * UPC, UPC, DFF};
          pg8::gemm_phase<pg8::EpiConvGate, pg8::StaticOrder, true, true>(F.lds, g, S, E, F.wave); }
        if (l == 0 && F.G == 256 && blockIdx.x >= 128) { if (blockIdx.x < 224) adaln_item(F, 1, (int)blockIdx.x - 128); convert_gap(F, 1, 0, CV_C2, ((int)blockIdx.x - 128) * NWAVES + F.wave, 128 * NWAVES, CV_N2); }
        if (l == 1 && F.G == 256 && blockIdx.x >= 128) convert_gap(F, 1, CV_IN + CV_OUT + CV_UP, CV_DN, ((int)blockIdx.x - 128) * NWAVES + F.wave, 128 * NWAVES, CV_N2);
        GRID_BAR();
        conv_fixup_phase(F, l);
        GRID_BAR();
        { pg8::Gemm g{ACT, (const bf16*)(wl + W_DN), MROWS, DM, DFF}; pg8::StaticOrder S; S.init(MROWS, DM, F.G, (int)blockIdx.x);
          pg8::EpiResGate<false> E{XB, XB, DM, modl + 5 * DM, 12288, SEQ};
          pg8::gemm_phase<pg8::EpiResGate<false>, pg8::StaticOrder, true, true>(F.lds, g, S, E, F.wave); }
        GRID_BAR();
}

__global__ void __launch_bounds__(NTHR, 2) mega_fwd(Args args) {
    extern __shared__ __attribute__((aligned(16))) unsigned char lds[];
    Frame F;
    F.lds = (LAS unsigned char*)lds;
    F.tid = threadIdx.x; F.lane = F.tid & 63; F.wave = __builtin_amdgcn_readfirstlane(F.tid >> 6);
    F.G = gridDim.x; { const int bx = blockIdx.x; F.vcu = (F.G % 8 == 0) ? (bx % 8) * (F.G / 8) + bx / 8 : bx; }
    F.in = args.in; F.ws = args.ws; F.zz = 0;
    volatile LAS unsigned* MISC = (volatile LAS unsigned*)(F.lds + MISC_OFF);
    for (int u = F.tid; u < (LDS_BYTES - LDSCTL_OFF) / 4; u += NTHR) ((LAS unsigned*)(F.lds + LDSCTL_OFF))[u] = 0u;
    __syncthreads();
    XcdBarrier bar = xcd_barrier_post((unsigned*)(FWS + WS_CTL) + CW_BAR, MISC + 8, F.tid);

    p0_prologue(F);
    GRID_BAR();
    layer_fwd<0>(F, bar);
    layer_fwd<1>(F, bar);
    norm_phase<1, false>(F, XB, args.out, F.in[F.zz + 23], nullptr, nullptr);
}

extern "C" void kernel_launch(void* const* d_in, const int* in_sizes, int n_in, void* d_out, int out_size, void* d_ws, size_t ws_size, hipStream_t stream) {
    static int grid = 0;
    if (grid == 0) {
        if (n_in != 24 || out_size != MROWS * DM || ws_size < WS_END) { fprintf(stderr, "kernel_launch: unexpected shapes (n_in %d out %d ws %zu)\n", n_in, out_size, ws_size); grid = -1; return; }
        int dev = 0, cus = 0;
        if (hipGetDevice(&dev) != hipSuccess || hipDeviceGetAttribute(&cus, hipDeviceAttributeMultiprocessorCount, dev) != hipSuccess) { grid = -1; return; }
        if (hipFuncSetAttribute((const void*)mega_fwd, hipFuncAttributeMaxDynamicSharedMemorySize, LDS_BYTES) != hipSuccess) { fprintf(stderr, "kernel_launch: hipFuncSetAttribute failed\n"); grid = -1; return; }
        int per_cu = 0;
        if (hipOccupancyMaxActiveBlocksPerMultiprocessor(&per_cu, (const void*)mega_fwd, NTHR, LDS_BYTES) != hipSuccess || per_cu < 1) { fprintf(stderr, "kernel_launch: occupancy query says %d\n", per_cu); }
        (void)hipGetLastError();
        grid = cus;
    }
    if (grid < 0) return;
    (void)hipMemsetAsync((char*)d_ws + WS_CTL, 0, CTL_ZERO_BYTES, stream);
    Args a{};
    for (int i = 0; i < 24; ++i) a.in[i] = (const float*)d_in[i];
    a.out = (float*)d_out; a.ws = (unsigned char*)d_ws;
    hipLaunchKernelGGL(mega_fwd, dim3(grid), dim3(NTHR), LDS_BYTES, stream, a);
}
```

```cpp
#include <hip/hip_runtime.h>
#include <cstdio>
#include <cstdint>
#ifndef MOBA_NP
#define MOBA_NP 2
#endif
#ifndef MOBA_CHECK
#define MOBA_CHECK 0
#endif
__device__ __forceinline__ int tid_from_wave(int wave) { int l = (int)__builtin_amdgcn_mbcnt_hi(~0u, __builtin_amdgcn_mbcnt_lo(~0u, 0u)); asm volatile("" : "+v"(l)); return wave * 64 + l; }
namespace pg8 {
#define PG8_LAS __attribute__((address_space(3)))
typedef unsigned short bf16_t;
typedef short bf16x8 __attribute__((ext_vector_type(8)));
typedef float f32x4 __attribute__((ext_vector_type(4)));
typedef unsigned u32x4 __attribute__((ext_vector_type(4)));
constexpr int BM = 256, BK = 64, HALF = 128, HTB = HALF * BK * 2  , STAGE_BYTES = 8 * HTB, NXCD = 8, WGM = 8;

__host__ __device__ __forceinline__ int lds_byte(int r, int c) { const int st = (r >> 4) * 2 + (c >> 5), rr = r & 15, cc = c & 31, ob = rr * 64 + cc * 2; return st * 1024 + (ob ^ (((ob >> 9) & 1) << 5)); }
__host__ __device__ __forceinline__ void stage_rc(int b, int& R, int& C) { const int st = b / 1024, sb = b % 1024, swz = sb ^ (((sb >> 9) & 1) << 5); R = (st >> 1) * 16 + swz / 64; C = (st & 1) * 32 + (swz % 64) / 2; }
__host__ __device__ __forceinline__ int perm32(int rho) { const int n = rho >> 4, i = rho & 15; return 8 * (i >> 2) + 4 * n + (i & 3); }

struct Unit { int pm, pn; };
struct Gemm { const bf16_t* A; const bf16_t* Bt; int M, N, K; };

struct StaticOrder {
    int nM, nN, nwg, G, c;
    __host__ __device__ void init(int M, int N, int G_, int c_) { nM = M / BM; nN = N / BM; nwg = nM * nN; G = G_; c = c_; }
    __host__ __device__ bool next(int i, Unit& u) const {
        const long L = (long)i * G + c; if (L >= nwg) return false;
        int wgid = (int)L; { const int q = nwg / NXCD, r = nwg % NXCD, xcd = wgid % NXCD, off = wgid / NXCD; wgid = (xcd < r ? xcd * (q + 1) : r * (q + 1) + (xcd - r) * q) + off; }
        const int nig = WGM * nN, gid = wgid / nig, fm = gid * WGM, gsz = (nM - fm) < WGM ? (nM - fm) : WGM;
        u.pm = fm + ((wgid % nig) % gsz); u.pn = (wgid % nig) / gsz; return true;
    }
    __device__ __forceinline__ void a_ready(const Unit&) const {}
    __device__ __forceinline__ void done(const Unit&) const {}
};

__device__ __forceinline__ unsigned cvt_pk_bf16(float lo, float hi) { unsigned r; asm volatile("v_cvt_pk_bf16_f32 %0, %1, %2" : "=v"(r) : "v"(lo), "v"(hi)); return r; }

struct EpiBf16 {
    static constexpr bool PERM = true, AFTER_DRAIN = false;
    bf16_t* O; int ldc;
    __device__ __forceinline__ void operator()(const f32x4 (&acc)[2][2][4][2], const Unit& u, int wr, int wc, int fr, int fq) const {
        const int row0 = u.pm * BM + wr * 64 + fr; const int col0 = u.pn * BM + wc * 32 + 8 * fq;
#pragma unroll
        for (int ai = 0; ai < 2; ++ai)
#pragma unroll
            for (int m = 0; m < 4; ++m) { bf16_t* rowp = O + (size_t)(row0 + ai * HALF + m * 16) * ldc + col0;
#pragma unroll
                for (int bj = 0; bj < 2; ++bj) { const f32x4 v0 = acc[ai][bj][m][0], v1 = acc[ai][bj][m][1];
                    u32x4 w; w.x = cvt_pk_bf16(v0[0], v0[1]); w.y = cvt_pk_bf16(v0[2], v0[3]); w.z = cvt_pk_bf16(v1[0], v1[1]); w.w = cvt_pk_bf16(v1[2], v1[3]);
                    *(u32x4*)(rowp + bj * HALF) = w; } }
    }
};

template <int CTRL> __device__ __forceinline__ float dpp_ror(float v) { return __builtin_bit_cast(float, __builtin_amdgcn_update_dpp(0, __builtin_bit_cast(int, v), CTRL, 0xF, 0xF, true)); }
struct EpiConvGate {
    static constexpr bool PERM = true, AFTER_DRAIN = false;
    bf16_t* A; int lda; float* halo; const float* cw; const float* cb; int nup, dff;
    __device__ __forceinline__ void operator()(const f32x4 (&acc)[2][2][4][2], const Unit& u, int wr, int wc, int fr, int fq) const {
        const int chl = wc * 32 + 8 * fq;
#pragma unroll
        for (int n = 0; n < 2; ++n) {
            const int c = u.pn * 128 + chl + 4 * n, colp = u.pn * 256 + chl + 4 * n;
            const f32x4 wv0 = *(const f32x4*)(cw + c), wv1 = *(const f32x4*)(cw + nup + c), wv2 = *(const f32x4*)(cw + 2 * nup + c), bv = *(const f32x4*)(cb + c);
            const f32x4 wg0 = *(const f32x4*)(cw + dff + c), wg1 = *(const f32x4*)(cw + nup + dff + c), wg2 = *(const f32x4*)(cw + 2 * nup + dff + c), bg = *(const f32x4*)(cb + dff + c);
#pragma unroll
            for (int ai = 0; ai < 2; ++ai) {
                const int grow = u.pm * BM + ai * HALF + wr * 64;
                float* hb = halo + (size_t)(grow >> 6) * 4 * nup + colp;
                if (fr < 2) { *(f32x4*)(hb + (size_t)fr * nup) = acc[ai][0][0][n]; *(f32x4*)(hb + (size_t)fr * nup + 128) = acc[ai][1][0][n]; }
                if (fr >= 14) { *(f32x4*)(hb + (size_t)(fr - 12) * nup) = acc[ai][0][3][n]; *(f32x4*)(hb + (size_t)(fr - 12) * nup + 128) = acc[ai][1][3][n]; }
                f32x4 cv[4];
                {   f32x4 P1 = {0.f, 0.f, 0.f, 0.f}, P2 = P1;
#pragma unroll
                    for (int m = 0; m < 4; ++m) { f32x4 R1, R2;
#pragma unroll
                        for (int e = 0; e < 4; ++e) { R1[e] = dpp_ror<0x121>(acc[ai][0][m][n][e]); R2[e] = dpp_ror<0x122>(acc[ai][0][m][n][e]); }
                        const f32x4 p1 = (fr >= 1) ? R1 : P1, p2 = (fr >= 2) ? R2 : P2; P1 = R1; P2 = R2;
                        cv[m] = wv0 * p2 + wv1 * p1 + wv2 * acc[ai][0][m][n] + bv; } }
                {   f32x4 P1 = {0.f, 0.f, 0.f, 0.f}, P2 = P1;
#pragma unroll
                    for (int m = 0; m < 4; ++m) { f32x4 R1, R2;
#pragma unroll
                        for (int e = 0; e < 4; ++e) { R1[e] = dpp_ror<0x121>(acc[ai][1][m][n][e]); R2[e] = dpp_ror<0x122>(acc[ai][1][m][n][e]); }
                        const f32x4 p1 = (fr >= 1) ? R1 : P1, p2 = (fr >= 2) ? R2 : P2; P1 = R1; P2 = R2;
                        const f32x4 cg = wg0 * p2 + wg1 * p1 + wg2 * acc[ai][1][m][n] + bg;
                        f32x4 o;
#pragma unroll
                        for (int e = 0; e < 4; ++e) o[e] = cg[e] * __builtin_amdgcn_rcpf(1.0f + __expf(-cg[e])) * cv[m][e];
                        unsigned w0 = cvt_pk_bf16(o[0], o[1]), w1 = cvt_pk_bf16(o[2], o[3]);
                        *(unsigned long long*)(A + (size_t)(grow + m * 16 + fr) * lda + c) = (unsigned long long)w0 | ((unsigned long long)w1 << 32); } }
            }
        }
    }
};

template <bool BASE_F32>
struct EpiResGate {
    static constexpr bool PERM = true, AFTER_DRAIN = false;
    const void* base; bf16_t* out; int ldc; const float* gate; int gstride; int rows_per_batch;
    __device__ __forceinline__ void operator()(const f32x4 (&acc)[2][2][4][2], const Unit& u, int wr, int wc, int fr, int fq) const {
        const int col0 = u.pn * BM + wc * 32 + 8 * fq;
        const int b = (u.pm * BM) / rows_per_batch;
        f32x4 gv[2][2];
#pragma unroll
        for (int bj = 0; bj < 2; ++bj)
#pragma unroll
            for (int n = 0; n < 2; ++n) gv[bj][n] = *(const f32x4*)(gate + (size_t)b * gstride + col0 + bj * HALF + n * 4);
#pragma unroll
        for (int ai = 0; ai < 2; ++ai)
#pragma unroll
            for (int m = 0; m < 4; ++m) { const size_t off = (size_t)(u.pm * BM + ai * HALF + wr * 64 + m * 16 + fr) * ldc + col0;
#pragma unroll
                for (int bj = 0; bj < 2; ++bj) { f32x4 b0, b1;
                    if (BASE_F32) { b0 = *(const f32x4*)((const float*)base + off + bj * HALF); b1 = *(const f32x4*)((const float*)base + off + bj * HALF + 4); }
                    else { const u32x4 w = *(const u32x4*)((const bf16_t*)base + off + bj * HALF);
                        b0 = (f32x4){__builtin_bit_cast(float, w.x << 16), __builtin_bit_cast(float, w.x & 0xffff0000u), __builtin_bit_cast(float, w.y << 16), __builtin_bit_cast(float, w.y & 0xffff0000u)};
                        b1 = (f32x4){__builtin_bit_cast(float, w.z << 16), __builtin_bit_cast(float, w.z & 0xffff0000u), __builtin_bit_cast(float, w.w << 16), __builtin_bit_cast(float, w.w & 0xffff0000u)}; }
                    const f32x4 o0 = b0 + gv[bj][0] * acc[ai][bj][m][0], o1 = b1 + gv[bj][1] * acc[ai][bj][m][1];
                    u32x4 w; w.x = cvt_pk_bf16(o0[0], o0[1]); w.y = cvt_pk_bf16(o0[2], o0[3]); w.z = cvt_pk_bf16(o1[0], o1[1]); w.w = cvt_pk_bf16(o1[2], o1[3]);
                    *(u32x4*)(out + off + bj * HALF) = w; }
                if (m & 1) asm volatile("" ::: "memory"); }
    }
};

template <class Epi, class Sched, bool ALIGN_EPI = false, bool SP2 = false>
__device__ __forceinline__ void gemm_phase(PG8_LAS unsigned char* lds, const Gemm g, const Sched& S, const Epi& E, int wave_) {
    const int tid_ = tid_from_wave(wave_);
    const int tid = tid_, wid = __builtin_amdgcn_readfirstlane(tid >> 6), lane = tid & 63, wr = wid >> 2, wc = wid & 3, fr = lane & 15, fq = lane >> 4;
    const int K = g.K, nt = K / BK;
    unsigned voffA[2], voffB[2];
#pragma unroll
    for (int i = 0; i < 2; ++i) { int R, C; stage_rc(tid * 16 + i * 8192, R, C); const int Rb = Epi::PERM ? ((R & ~31) + perm32(R & 31)) : R;
        voffA[i] = (unsigned)(R * K + C) * 2u; voffB[i] = (unsigned)(Rb * K + C) * 2u; }
    const size_t kstep = (size_t)(BK * 2);
    const size_t hstep = (size_t)HALF * K * 2;
    const size_t tstep = 2 * hstep;
    const unsigned ldsw = (unsigned)wid * 1024u;
    const int aoff = lds_byte(wr * 64 + fr, fq * 8), boff = lds_byte(wc * 32 + fr, fq * 8);
#define PG8_SA(b, h) (((b) * 2 + (h)) * HTB)
#define PG8_SB(b, h) ((4 + (b) * 2 + (h)) * HTB)
#define PG8_STAGE(bufoff, gbase, voff) do { _Pragma("unroll") for (int _i = 0; _i < 2; ++_i) \
        __builtin_amdgcn_global_load_lds((const unsigned*)((const char*)(gbase) + (voff)[_i]), (PG8_LAS unsigned*)(lds + (bufoff) + ldsw + _i * 8192), 16, 0, 0); } while (0)
#define PG8_LDA(dst, b, h) do { _Pragma("unroll") for (int m = 0; m < 4; ++m) _Pragma("unroll") for (int k = 0; k < 2; ++k) dst[m][k] = *(const PG8_LAS bf16x8*)(lds + PG8_SA(b, h) + aoff + m * 2048 + k * 1024); } while (0)
#define PG8_LDB(dst, b, h) do { _Pragma("unroll") for (int n = 0; n < 2; ++n) _Pragma("unroll") for (int k = 0; k < 2; ++k) dst[n][k] = *(const PG8_LAS bf16x8*)(lds + PG8_SB(b, h) + boff + n * 2048 + k * 1024); } while (0)
#define PG8_MMA(ai, bj, At, Bt) do { __builtin_amdgcn_s_setprio(1); _Pragma("unroll") for (int m = 0; m < 4; ++m) _Pragma("unroll") for (int n = 0; n < 2; ++n) _Pragma("unroll") for (int k = 0; k < 2; ++k) \
        acc[ai][bj][m][n] = __builtin_amdgcn_mfma_f32_16x16x32_bf16(Bt[n][k], At[m][k], acc[ai][bj][m][n], 0, 0, 0); __builtin_amdgcn_s_setprio(0); } while (0)
#define PG8_WAIT_V(n) asm volatile("s_waitcnt vmcnt(" #n ")" ::: "memory")
#define PG8_WAIT_L(n) asm volatile("s_waitcnt lgkmcnt(" #n ")" ::: "memory")
#define PG8_BAR __builtin_amdgcn_s_barrier()
#define PG8_SCHED __builtin_amdgcn_sched_barrier(0)
    Unit cur, nxt; int ui = 0;
    if (!S.next(0, cur)) return;
    f32x4 acc[2][2][4][2];
#pragma unroll
    for (int a = 0; a < 2; ++a)
#pragma unroll
        for (int b = 0; b < 2; ++b)
#pragma unroll
            for (int m = 0; m < 4; ++m)
#pragma unroll
                for (int n = 0; n < 2; ++n) acc[a][b][m][n] = (f32x4){0.f, 0.f, 0.f, 0.f};
    bf16x8 At[4][2], B0[2][2], B1[2][2];
    const char* cA = (const char*)g.A + (size_t)cur.pm * tstep; const char* cB = (const char*)g.Bt + (size_t)cur.pn * tstep;
    S.a_ready(cur);
    if constexpr (SP2) {
        PG8_STAGE(PG8_SB(0, 0), cB, voffB); PG8_STAGE(PG8_SB(0, 1), cB + hstep, voffB); PG8_STAGE(PG8_SA(0, 0), cA, voffA); PG8_STAGE(PG8_SA(0, 1), cA + hstep, voffA);
        if (wr == 1) PG8_BAR;
        PG8_WAIT_V(2); PG8_BAR;
        PG8_STAGE(PG8_SB(1, 0), cB + kstep, voffB); PG8_STAGE(PG8_SA(1, 0), cA + kstep, voffA); PG8_STAGE(PG8_SB(1, 1), cB + hstep + kstep, voffB);
        PG8_WAIT_V(6); PG8_BAR;
    } else {
        PG8_STAGE(PG8_SB(0, 0), cB, voffB); PG8_STAGE(PG8_SA(0, 0), cA, voffA); PG8_STAGE(PG8_SB(0, 1), cB + hstep, voffB); PG8_STAGE(PG8_SA(0, 1), cA + hstep, voffA);
        if (wr == 1) PG8_BAR;
        PG8_WAIT_V(4); PG8_BAR;
        PG8_STAGE(PG8_SB(1, 0), cB + kstep, voffB); PG8_STAGE(PG8_SA(1, 0), cA + kstep, voffA); PG8_STAGE(PG8_SB(1, 1), cB + hstep + kstep, voffB);
        PG8_WAIT_V(6); PG8_BAR;
    }
    for (;;) {
        const bool has_next = S.next(ui + 1, nxt);
        const char* nA = has_next ? (const char*)g.A + (size_t)nxt.pm * tstep : cA; const char* nB = has_next ? (const char*)g.Bt + (size_t)nxt.pn * tstep : cB;
        for (int t = 0; t < nt; t += 2) {
            const bool last = (t == nt - 2);
            const char* a1 = cA + (size_t)(t + 1) * kstep;
            const char* a2 = last ? nA : cA + (size_t)(t + 2) * kstep; const char* b2 = last ? nB : cB + (size_t)(t + 2) * kstep;
            const char* a3 = a2 + kstep; const char* b3 = b2 + kstep;
            if (last && has_next) S.a_ready(nxt);
            if constexpr (SP2) {
            PG8_LDB(B0, 0, 0); PG8_LDB(B1, 0, 1); PG8_SCHED; PG8_LDA(At, 0, 0); PG8_STAGE(PG8_SA(1, 1), a1 + hstep, voffA);
            PG8_WAIT_V(8); PG8_WAIT_L(0); PG8_BAR; PG8_MMA(0, 0, At, B0); PG8_MMA(0, 1, At, B1); PG8_BAR; PG8_SCHED;
            PG8_LDA(At, 0, 1); PG8_STAGE(PG8_SB(0, 0), b2, voffB); PG8_STAGE(PG8_SB(0, 1), b2 + hstep, voffB); PG8_STAGE(PG8_SA(0, 0), a2, voffA);
            PG8_WAIT_V(8); PG8_WAIT_L(0); PG8_BAR; PG8_MMA(1, 0, At, B0); PG8_MMA(1, 1, At, B1); PG8_BAR; PG8_SCHED;
            PG8_LDB(B0, 1, 0); PG8_LDB(B1, 1, 1); PG8_SCHED; PG8_LDA(At, 1, 0); PG8_STAGE(PG8_SA(0, 1), a2 + hstep, voffA);
            PG8_WAIT_V(8); PG8_WAIT_L(0); PG8_BAR; PG8_MMA(0, 0, At, B0); PG8_MMA(0, 1, At, B1); PG8_BAR; PG8_SCHED;
            PG8_LDA(At, 1, 1); PG8_STAGE(PG8_SB(1, 0), b3, voffB); PG8_STAGE(PG8_SB(1, 1), b3 + hstep, voffB); PG8_STAGE(PG8_SA(1, 0), a3, voffA);
            PG8_WAIT_V(8); PG8_WAIT_L(0); PG8_BAR; PG8_MMA(1, 0, At, B0); PG8_MMA(1, 1, At, B1); PG8_BAR; PG8_SCHED;
            } else {
            PG8_LDB(B0, 0, 0); PG8_SCHED; PG8_LDA(At, 0, 0); PG8_STAGE(PG8_SA(1, 1), a1 + hstep, voffA);
            PG8_WAIT_L(8); PG8_BAR; PG8_WAIT_L(0); PG8_MMA(0, 0, At, B0); PG8_BAR; PG8_SCHED;
            PG8_LDB(B1, 0, 1); PG8_STAGE(PG8_SB(0, 0), b2, voffB);
            PG8_BAR; PG8_WAIT_L(0); PG8_MMA(0, 1, At, B1); PG8_BAR;
            PG8_LDA(At, 0, 1); PG8_STAGE(PG8_SA(0, 0), a2, voffA);
            PG8_BAR; PG8_WAIT_L(0); PG8_MMA(1, 0, At, B0); PG8_BAR; PG8_SCHED;
            PG8_STAGE(PG8_SB(0, 1), b2 + hstep, voffB);
            PG8_WAIT_V(6); PG8_BAR; PG8_MMA(1, 1, At, B1); PG8_BAR;
            PG8_LDB(B0, 1, 0); PG8_SCHED; PG8_LDA(At, 1, 0); PG8_STAGE(PG8_SA(0, 1), a2 + hstep, voffA);
            PG8_WAIT_L(8); PG8_BAR; PG8_WAIT_L(0); PG8_MMA(0, 0, At, B0); PG8_BAR; PG8_SCHED;
            PG8_LDB(B1, 1, 1); PG8_STAGE(PG8_SB(1, 0), b3, voffB);
            PG8_BAR; PG8_WAIT_L(0); PG8_MMA(0, 1, At, B1); PG8_BAR;
            PG8_LDA(At, 1, 1); PG8_STAGE(PG8_SA(1, 0), a3, voffA);
            PG8_BAR; PG8_WAIT_L(0); PG8_MMA(1, 0, At, B0); PG8_BAR; PG8_SCHED;
            PG8_STAGE(PG8_SB(1, 1), b3 + hstep, voffB);
            PG8_WAIT_V(6); PG8_BAR; PG8_MMA(1, 1, At, B1); PG8_BAR;
            }
        }
        if constexpr (ALIGN_EPI) { if (wr == 0) PG8_BAR; }
        if constexpr (!Epi::AFTER_DRAIN) { E(acc, cur, wr, wc, fr, fq); S.done(cur); }
        if (!has_next) break;
#pragma unroll
        for (int a = 0; a < 2; ++a)
#pragma unroll
            for (int b = 0; b < 2; ++b)
#pragma unroll
                for (int m = 0; m < 4; ++m)
#pragma unroll
                    for (int n = 0; n < 2; ++n) acc[a][b][m][n] = (f32x4){0.f, 0.f, 0.f, 0.f};
        cur = nxt; cA = nA; cB = nB; ++ui;
        if constexpr (ALIGN_EPI) { if (wr == 1) PG8_BAR; }
    }
    PG8_WAIT_V(0);
    if constexpr (!ALIGN_EPI) { if (wr == 0) PG8_BAR; }
    PG8_BAR;
    if constexpr (Epi::AFTER_DRAIN) { E.fused(acc, cur, wr, wc, fr, fq, lds, wid, lane); S.done(cur); }
#undef PG8_SA
#undef PG8_SB
#undef PG8_STAGE
#undef PG8_LDA
#undef PG8_LDB
#undef PG8_MMA
#undef PG8_WAIT_V
#undef PG8_WAIT_L
#undef PG8_BAR
#undef PG8_SCHED
}
}

namespace moba {
using bf16 = unsigned short;
typedef short bf16x8 __attribute__((ext_vector_type(8)));
typedef short s16x4 __attribute__((ext_vector_type(4)));
typedef float f32x16 __attribute__((ext_vector_type(16)));
typedef float f32x4 __attribute__((ext_vector_type(4)));
typedef unsigned u32x4 __attribute__((ext_vector_type(4)));
#define MLAS __attribute__((address_space(3)))
typedef MLAS char lchar; typedef MLAS float lfloat; typedef MLAS bf16x8 lbf16x8;
template <class A, class Bt> struct same_t { static constexpr bool v = false; };
template <class A> struct same_t<A, A> { static constexpr bool v = true; };
constexpr int D = 128, LDI = 6656, LDO = 2048;
constexpr float THR = 8.f;
constexpr bool WSKIP = false;
constexpr float SCALE = 0.08838834764831845f;
constexpr int NW = 8, QBLK = 32, KVBLK = 64, QB = NW * QBLK;
constexpr int SHM_V = KVBLK * D * 2, SHM_K = KVBLK * D * 2;
constexpr int LDS_BYTES = 2 * SHM_V + 2 * SHM_K + NW * 64 * 4;
#define KSWZ(row, colB) ((row) * 256 + ((colB) ^ (((row) & 7) << 4)))
#define SBAR() __builtin_amdgcn_sched_barrier(0)
__device__ __forceinline__ int v_st(int k, int c) { const int kk = (k & ~0xC) | ((k & 4) << 1) | ((k & 8) >> 1); return ((kk >> 3) * 4 + (c >> 5)) * 512 + ((kk & 7) * 32 + (c & 31)) * 2; }
__device__ __forceinline__ int v_rd_base(int lane) { return ((lane & 3) << 3) | (((lane >> 2) & 3) << 6) | (((lane >> 4) & 1) << 5) | (((lane >> 5) & 1) << 8); }
constexpr int v_rd_off(int d0, int ks, int half) { return d0 * 512 + ks * 4096 + half * 2048; }
__device__ __forceinline__ int crow(int r, int hi) { return (r & 3) + 8 * (r >> 2) + 4 * hi; }
__device__ __forceinline__ unsigned cvtpk(float lo, float hi) {
    unsigned r; asm volatile("v_cvt_pk_bf16_f32 %0, %1, %2" : "=v"(r) : "v"(lo), "v"(hi)); return r;
}
__device__ __forceinline__ bf16x8 pack8(f32x4 a, f32x4 b) {
    u32x4 w = {cvtpk(a[0], a[1]), cvtpk(a[2], a[3]), cvtpk(b[0], b[1]), cvtpk(b[2], b[3])};
    return *reinterpret_cast<bf16x8*>(&w);
}
template <class T> __device__ __forceinline__ bf16x8 load8(const T* p) {
    if constexpr (same_t<T, float>::v) { return pack8(*(const f32x4*)p, *(const f32x4*)(p + 4)); }
    else { return *reinterpret_cast<const bf16x8*>(p); }
}
__device__ __forceinline__ void mask_tile(f32x16& p0, f32x16& p1, int dq, unsigned W) {
    const float NEG = -__builtin_inff();
#pragma unroll
    for (int r = 0; r < 16; ++r) {
        const int c = (r & 3) + 8 * (r >> 2);
        if ((unsigned)(dq - c) >= W) p0[r] = NEG;
        if ((unsigned)(dq - c - 32) >= W) p1[r] = NEG;
    }
}
__device__ __forceinline__ void partialSM(f32x16& p0, f32x16& p1, float& m_reg, float& mn, float& alpha) {
    float pmax = p0[0]; for (int r = 1; r < 16; ++r) pmax = fmaxf(pmax, p0[r]); for (int r = 0; r < 16; ++r) pmax = fmaxf(pmax, p1[r]);
    { auto rr = __builtin_amdgcn_permlane32_swap(__float_as_uint(pmax), __float_as_uint(pmax), false, false);
      pmax = fmaxf(__uint_as_float(rr[0]), __uint_as_float(rr[1])); }
    constexpr float C2 = 1.4426950408889634f * SCALE;
    if (__builtin_expect(__all((pmax - m_reg) * SCALE <= THR), 1)) { mn = m_reg; alpha = 1.f; }
    else { mn = fmaxf(m_reg, pmax); alpha = __builtin_amdgcn_exp2f((m_reg - mn) * C2); m_reg = mn; }
    const float mnL = -mn * C2;
    for (int r = 0; r < 16; ++r) p0[r] = fmaf(p0[r], C2, mnL); for (int r = 0; r < 16; ++r) p1[r] = fmaf(p1[r], C2, mnL);
    for (int r = 0; r < 16; ++r) p0[r] = __builtin_amdgcn_exp2f(p0[r]);
}
__device__ __forceinline__ void finishSM(f32x16& p0, f32x16& p1, float alpha, float& l_reg, bf16x8& pa0, bf16x8& pa1, bf16x8& pa2, bf16x8& pa3) {
    for (int r = 0; r < 16; ++r) p1[r] = __builtin_amdgcn_exp2f(p1[r]);
    float ps = 0; for (int r = 0; r < 16; ++r) ps += p0[r]; for (int r = 0; r < 16; ++r) ps += p1[r];
    { auto rr = __builtin_amdgcn_permlane32_swap(__float_as_uint(ps), __float_as_uint(ps), false, false);
      ps = __uint_as_float(rr[0]) + __uint_as_float(rr[1]); }
    l_reg = l_reg * alpha + ps;
#define PK4(P, B_, OUT) do { unsigned a0 = cvtpk(P[B_+0], P[B_+1]), a1 = cvtpk(P[B_+2], P[B_+3]);                          \
        unsigned b0 = cvtpk(P[B_+4], P[B_+5]), b1 = cvtpk(P[B_+6], P[B_+7]);                                             \
        auto r0 = __builtin_amdgcn_permlane32_swap(a0, b0, false, false); auto r1 = __builtin_amdgcn_permlane32_swap(a1, b1, false, false); \
        u32x4 w = {r0[0], r1[0], r0[1], r1[1]}; OUT = *reinterpret_cast<bf16x8*>(&w); } while (0)
    PK4(p0, 0, pa0); PK4(p0, 8, pa1); PK4(p1, 0, pa2); PK4(p1, 8, pa3);
#undef PK4
}
template <int KB, bool SK>
__device__ __forceinline__ void qkt(f32x16& p0, f32x16& p1, const lchar* K_lds, int r32, int hi, const bf16x8* qr, bool act, float slopeR, float lb) {
    if (SK && !act) { const float NEG = -__builtin_inff();
#pragma unroll
        for (int r = 0; r < 16; ++r) { p0[r] = NEG; p1[r] = NEG; } return; }
#pragma unroll
    for (int r = 0; r < 16; ++r) { const int c = (r & 3) + 8 * (r >> 2); p0[r] = __builtin_fmaf(slopeR, (float)c, lb); p1[r] = __builtin_fmaf(slopeR, (float)(c + 32), lb); }
    const lchar* kb[4];
#pragma unroll
    for (int dd = 0; dd < 4; ++dd) kb[dd] = K_lds + KB * SHM_K + KSWZ(r32, (dd * 16 + hi * 8) * 2);
#pragma unroll
    for (int d0 = 0; d0 < 8; ++d0) { const lchar* a = kb[d0 & 3] + (d0 >> 2) * 128;
        bf16x8 b0 = *(const lbf16x8*)(a);
        bf16x8 b1 = *(const lbf16x8*)(a + 32 * 256);
        p0 = __builtin_amdgcn_mfma_f32_32x32x16_bf16(b0, qr[d0], p0, 0, 0, 0);
        p1 = __builtin_amdgcn_mfma_f32_32x32x16_bf16(b1, qr[d0], p1, 0, 0, 0); }
}
template <int VB, bool SK>
__device__ __forceinline__ void pv_tile(f32x16* o, int vb0, bf16x8 pa0, bf16x8 pa1, bf16x8 pa2, bf16x8 pa3, bool act) {
    if (SK && !act) return;
#define TRRD(dst, off) asm volatile("ds_read_b64_tr_b16 %0, %1 offset:%2" : "=&v"(dst) : "v"(vb0), "i"(off) : "memory")
#define PV_D0(d0) do { s16x4 l0, l1, l2, l3, h0, h1, h2, h3; constexpr int b_ = VB * SHM_V + v_rd_off(d0, 0, 0);     \
        TRRD(l0, b_); TRRD(h0, b_ + 2048); TRRD(l1, b_ + 4096); TRRD(h1, b_ + 6144); TRRD(l2, b_ + 8192); TRRD(h2, b_ + 10240); TRRD(l3, b_ + 12288); TRRD(h3, b_ + 14336); \
        asm volatile("s_waitcnt lgkmcnt(0)" ::: "memory"); SBAR();                 \
        o[d0] = __builtin_amdgcn_mfma_f32_32x32x16_bf16(pa0, (bf16x8){l0[0], l0[1], l0[2], l0[3], h0[0], h0[1], h0[2], h0[3]}, o[d0], 0, 0, 0);   \
        o[d0] = __builtin_amdgcn_mfma_f32_32x32x16_bf16(pa1, (bf16x8){l1[0], l1[1], l1[2], l1[3], h1[0], h1[1], h1[2], h1[3]}, o[d0], 0, 0, 0);   \
        o[d0] = __builtin_amdgcn_mfma_f32_32x32x16_bf16(pa2, (bf16x8){l2[0], l2[1], l2[2], l2[3], h2[0], h2[1], h2[2], h2[3]}, o[d0], 0, 0, 0);   \
        o[d0] = __builtin_amdgcn_mfma_f32_32x32x16_bf16(pa3, (bf16x8){l3[0], l3[1], l3[2], l3[3], h3[0], h3[1], h3[2], h3[3]}, o[d0], 0, 0, 0); } while (0)
    PV_D0(0); PV_D0(1); PV_D0(2); PV_D0(3);
#undef PV_D0
#undef TRRD
}

typedef __attribute__((address_space(1))) char gchar; typedef __attribute__((address_space(1))) bf16x8 gbf16x8;
__device__ __forceinline__ const gchar* uni_ptr(const char* p) { const unsigned long long v = (unsigned long long)p;
    const unsigned lo = __builtin_amdgcn_readfirstlane((unsigned)v), hi = __builtin_amdgcn_readfirstlane((unsigned)(v >> 32)); return (const gchar*)(((unsigned long long)hi << 32) | lo); }
template <class TIn, class TOut> struct BlockRef { const TIn* Q; const TIn* K; const TIn* V; TOut* O; int P0; const __attribute__((address_space(3))) unsigned* sel; float slopeR; };
template <class TIn> struct Seam {
    bf16x8 qr[8];
    bf16x8 st_v0, st_v1, st_k0, st_k1; f32x4 sf0, sf1, sf2, sf3;
    f32x4 tq[16];
};
__device__ __forceinline__ int swa_jlo(int P0, int W) { const int lowk = P0 - W + 1; return lowk > 0 ? lowk / KVBLK : 0; }
#define ROW(p, k0, rr) ((const TIn*)((const char*)(p) + (size_t)(k0) * (LDI * sizeof(TIn)) + (unsigned)(((rr) * LDI + sc) * (int)sizeof(TIn))))
#define VMW() asm volatile("s_waitcnt vmcnt(0)" ::: "memory")
#define VMWN(n) asm volatile("s_waitcnt vmcnt(%0)" :: "i"(n) : "memory")
#define SLOAD_H(Kp, Vp, k0) do { const gchar* kb__ = uni_ptr((const char*)(Kp) + (size_t)(k0) * (LDI * sizeof(TIn))); const gchar* vb__ = uni_ptr((const char*)(Vp) + (size_t)(k0) * (LDI * sizeof(TIn))); \
                         S.st_v0 = *(const gbf16x8*)(vb__ + roff0); S.st_v1 = *(const gbf16x8*)(vb__ + roff1);              \
                         S.st_k0 = *(const gbf16x8*)(kb__ + roff0); S.st_k1 = *(const gbf16x8*)(kb__ + roff1); } while (0)
#define SWRITE_HK(bf) do { *(lbf16x8*)(K_lds + (bf) * SHM_K + kws) = S.st_k0; *(lbf16x8*)(K_lds + (bf) * SHM_K + kws + 32 * 256) = S.st_k1; } while (0)
#define SWRITE_HV(bf) do { *(lbf16x8*)(V_lds + (bf) * SHM_V + vst0) = S.st_v0; *(lbf16x8*)(V_lds + (bf) * SHM_V + vst1) = S.st_v1; } while (0)
#define SWRITE_H(bf) do { SWRITE_HV(bf); SWRITE_HK(bf); } while (0)
#define SLOAD_F(p, k0) do { S.sf0 = *(const f32x4*)ROW(p, k0, sr); S.sf1 = *(const f32x4*)(ROW(p, k0, sr) + 4);                \
                            S.sf2 = *(const f32x4*)ROW(p, k0, 32 + sr); S.sf3 = *(const f32x4*)(ROW(p, k0, 32 + sr) + 4); } while (0)
#define SWRITE_KF(bf) do { *(lbf16x8*)(K_lds + (bf) * SHM_K + kws) = pack8(S.sf0, S.sf1); *(lbf16x8*)(K_lds + (bf) * SHM_K + kws + 32 * 256) = pack8(S.sf2, S.sf3); } while (0)
#define SWRITE_VF(bf) do { *(lbf16x8*)(V_lds + (bf) * SHM_V + vst0) = pack8(S.sf0, S.sf1); *(lbf16x8*)(V_lds + (bf) * SHM_V + vst1) = pack8(S.sf2, S.sf3); } while (0)
template <class TIn, class TOut>
__device__ __forceinline__ void causal_swa_prime(const BlockRef<TIn, TOut>& cur, int W, lchar* lds, Seam<TIn>& S, int wave_) {
    constexpr bool F32 = same_t<TIn, float>::v;
    const int tid_ = tid_from_wave(wave_);
    const int tid = tid_, wid = __builtin_amdgcn_readfirstlane(tid >> 6), lane = tid & 63, r32 = lane & 31, hi = lane >> 5;
    const int sr = tid >> 4, sc = (tid & 15) * 8, kws = KSWZ(sr, sc * 2); lchar* K_lds = lds + 2 * SHM_V;
    const unsigned roff0 = (unsigned)((sr * LDI + sc) * (int)sizeof(TIn)), roff1 = (unsigned)(((32 + sr) * LDI + sc) * (int)sizeof(TIn));
    const int kb0 = ((cur.P0 + QB - 1) / KVBLK) * KVBLK;
    for (int d0 = 0; d0 < 8; ++d0) S.qr[d0] = *(const gbf16x8*)(uni_ptr((const char*)cur.Q) + (unsigned)(((wid * QBLK + r32) * LDI + hi * 8) * (int)sizeof(TIn)) + d0 * 16 * sizeof(TIn));
    if constexpr (F32) { SLOAD_F((const float*)cur.K, kb0); VMW(); SWRITE_KF(0); SBAR(); SLOAD_F((const float*)cur.V, kb0); }
    else { SLOAD_H(cur.K, cur.V, kb0); VMW(); SWRITE_HK(0); }
    __syncthreads();
}
template <class TIn, class TOut>
__device__ __forceinline__ void causal_swa_block(const BlockRef<TIn, TOut>& cur, const BlockRef<TIn, TOut>& nxt, int skv, int W, lchar* lds, Seam<TIn>& S, int wave_) {
    constexpr bool F32 = same_t<TIn, float>::v;
    const int tid_ = tid_from_wave(wave_);
    const int tid = tid_, wid = __builtin_amdgcn_readfirstlane(tid >> 6), lane = tid & 63, r32 = lane & 31, hi = lane >> 5;
    const int j_lo = swa_jlo(cur.P0, W);
    int j_hi = (cur.P0 + QB - 1) / KVBLK + 1; if (j_hi > skv / KVBLK) j_hi = skv / KVBLK;
    const int NT = j_hi - j_lo;
    const int kbn = ((nxt.P0 + QB - 1) / KVBLK) * KVBLK;
    const unsigned selm = cur.sel[wid * QBLK + r32] | (1u << (cur.P0 >> 8)); const float slopeR = __builtin_bit_cast(float, __builtin_amdgcn_readfirstlane(__builtin_bit_cast(unsigned, cur.slopeR))); const int tqm = cur.P0 + wid * QBLK + r32 - 4 * hi;
#define LB(t) (((selm >> (KBASE(t) >> 8)) & 1u) ? slopeR * (float)(KBASE(t) - tqm) : -__builtin_inff())
    const int qlo = cur.P0 + wid * QBLK, qm = qlo + r32 - 4 * hi;
    lchar* V_lds = lds; lchar* K_lds = lds + 2 * SHM_V;
    lfloat* ws = (lfloat*)(lds + 2 * SHM_V + 2 * SHM_K) + wid * 64; lfloat* li_l = ws; lfloat* al_l = ws + 32;
    float m_reg = -1e30f, l_reg = 0; f32x16 o[4] = {};
    const unsigned roff0 = (unsigned)(((tid >> 4) * LDI + (tid & 15) * 8) * (int)sizeof(TIn)), roff1 = (unsigned)(((32 + (tid >> 4)) * LDI + (tid & 15) * 8) * (int)sizeof(TIn));
    const int sr = tid >> 4, sc = (tid & 15) * 8, vst0 = v_st(sr, sc), vst1 = v_st(32 + sr, sc), kws = KSWZ(sr, sc * 2);
    const int vb0 = (int)(unsigned)(uintptr_t)V_lds + v_rd_base(lane);
    const TIn* Kh = cur.K; const TIn* Vh = cur.V;
#define RESC(a) do { if (__any((a) < 1.f)) { if (hi == 0) al_l[r32] = (a); asm volatile("s_waitcnt lgkmcnt(0)" ::: "memory");              \
                     for (int d_ = 0; d_ < 4; ++d_) for (int r = 0; r < 16; ++r) o[d_][r] *= al_l[crow(r, hi)]; } } while (0)
#define KBASE(t) ((j_hi - 1 - (t)) * KVBLK)
#define ACT(t) (KBASE(t) <= qlo + QBLK - 1 && KBASE(t) + KVBLK - 1 >= qlo - W + 1)
#define MASKT(P0_, P1_, t) do { const int kb_ = KBASE(t); if ((!SK || ACT(t)) && (kb_ + KVBLK - 1 > qlo || kb_ <= qlo + QBLK - 1 - W)) mask_tile(P0_, P1_, qm - kb_, (unsigned)W); } while (0)
    constexpr int NQL = F32 ? 16 : 8;
    constexpr bool SK = WSKIP && !F32;
#define SEAM_K0() do { VMWN(NQL); if constexpr (F32) { SWRITE_KF(0); SBAR(); SLOAD_F((const float*)nxt.V, kbn); } else { SWRITE_HK(0); } SBAR(); } while (0)
    unsigned touch_reg = 0u; const int tl_ = wid * 32 + (lane & 31);
    const unsigned toff = (unsigned)(((tl_ & 127) >> 1) * LDI * (int)sizeof(TIn) + (tl_ & 1) * 128);
    const gchar* tbase = uni_ptr((const char*)((tl_ >> 7) ? (const void*)Vh : (const void*)Kh));
#if MOBA_CHECK
#define TOUCH(k0) do {} while (0)
#else
#define TOUCH(k0) do { const gchar* tp_ = tbase + (size_t)(k0) * (LDI * sizeof(TIn)) + toff; asm volatile("global_load_dword %0, %1, off" : "+v"(touch_reg) : "v"(tp_) : "memory"); } while (0)
#endif
    f32x16 pA0, pA1, pB0, pB1; float mnA, mnB, alA, alB; bf16x8 pa0, pa1, pa2, pa3;
    if constexpr (F32) { VMW(); SWRITE_VF(0); SBAR(); } else { SWRITE_HV(0); SBAR(); }
    if (NT > 1) { if constexpr (F32) SLOAD_F((const float*)Kh, KBASE(1)); else SLOAD_H(Kh, Vh, KBASE(1)); }
    SBAR(); qkt<0, SK>(pA0, pA1, K_lds, r32, hi, S.qr, ACT(0), slopeR, LB(0));
    if constexpr (F32) { if (NT > 1) { VMW(); SWRITE_KF(1); SBAR(); SLOAD_F((const float*)Vh, KBASE(1)); } }
    MASKT(pA0, pA1, 0); partialSM(pA0, pA1, m_reg, mnA, alA);
    if (NT > 1) { VMW(); if constexpr (F32) { SWRITE_VF(1); SBAR(); if (NT > 2) SLOAD_F((const float*)Kh, KBASE(2)); } else SWRITE_H(1); }
    __syncthreads();
#define HALF_STEP(PX0, PX1, mnX, alX, PY0, PY1, alY, t, KB, VB, SB) do {                                                      \
        SBAR(); qkt<KB, SK>(PX0, PX1, K_lds, r32, hi, S.qr, ACT(t), slopeR, LB(t));                                             \
        finishSM(PY0, PY1, alY, l_reg, pa0, pa1, pa2, pa3); SBAR();                                                           \
        if ((t) + 1 < NT) { if constexpr (F32) { VMW(); SWRITE_KF(SB); SBAR(); SLOAD_F((const float*)Vh, KBASE((t) + 1)); }  \
                            else { SLOAD_H(Kh, Vh, KBASE((t) + 1)); } SBAR(); }                                               \
        pv_tile<VB, SK>(o, vb0, pa0, pa1, pa2, pa3, ACT((t) - 1)); MASKT(PX0, PX1, (t)); partialSM(PX0, PX1, m_reg, mnX, alX);                                        \
        __syncthreads();                                                                                                      \
        if ((t) + 1 < NT) { VMW(); if constexpr (F32) { SWRITE_VF(SB); SBAR(); if ((t) + 2 < NT) SLOAD_F((const float*)Kh, KBASE((t) + 2)); } \
                            else { SWRITE_H(SB); } }                                                                          \
        if ((t) + 3 < NT) { TOUCH(KBASE((t) + 3)); }                                                                          \
        RESC(alX); __syncthreads(); } while (0)
    for (int t = 1; t + 1 < NT; t += 2) {
        HALF_STEP(pB0, pB1, mnB, alB, pA0, pA1, alA, t, 1, 0, 0);
        HALF_STEP(pA0, pA1, mnA, alA, pB0, pB1, alB, t + 1, 0, 1, 1);
    }
    const bool even = (NT & 1) == 0;
    if (even) { SBAR(); qkt<1, SK>(pB0, pB1, K_lds, r32, hi, S.qr, ACT(NT - 1), slopeR, LB(NT - 1)); SBAR(); }
#define QROW(e) (nxt.Q + (size_t)(wid * QBLK + r32) * LDI + ((e) >> 1) * 16 + hi * 8 + ((e) & 1) * 4)
    if constexpr (F32) { SLOAD_F((const float*)nxt.K, kbn); SBAR();
#pragma unroll
        for (int e = 0; e < 8; ++e) S.tq[e] = *(const f32x4*)QROW(e); }
    else { SLOAD_H(nxt.K, nxt.V, kbn); SBAR();
#pragma unroll
        for (int d0 = 0; d0 < 8; ++d0) S.qr[d0] = *(const gbf16x8*)(uni_ptr((const char*)nxt.Q) + (unsigned)(((wid * QBLK + r32) * LDI + hi * 8) * (int)sizeof(TIn)) + d0 * 16 * sizeof(TIn)); }
    SBAR();
    finishSM(pA0, pA1, alA, l_reg, pa0, pa1, pa2, pa3); SBAR();
    if constexpr (F32) {
#pragma unroll
        for (int e = 8; e < 16; ++e) S.tq[e] = *(const f32x4*)QROW(e); SBAR(); }
#undef QROW
    pv_tile<0, SK>(o, vb0, pa0, pa1, pa2, pa3, ACT(even ? NT - 2 : NT - 1));
    if (even) { MASKT(pB0, pB1, NT - 1); partialSM(pB0, pB1, m_reg, mnB, alB); __syncthreads(); RESC(alB);
        finishSM(pB0, pB1, alB, l_reg, pa0, pa1, pa2, pa3); SBAR(); pv_tile<1, SK>(o, vb0, pa0, pa1, pa2, pa3, ACT(NT - 1)); }
    SBAR(); SEAM_K0();
    if (hi == 0) li_l[r32] = l_reg; asm volatile("s_waitcnt lgkmcnt(0)" ::: "memory");
    float rli[16];
#pragma unroll
    for (int r = 0; r < 16; ++r) rli[r] = __builtin_amdgcn_rcpf(li_l[crow(r, hi)]);
    const gchar* Owb = uni_ptr((const char*)(cur.O + (size_t)(wid * QBLK) * LDO)); const unsigned ooff = (unsigned)((4 * hi * LDO + r32) * (int)sizeof(TOut));
#pragma unroll
    for (int r = 0; r < 16; ++r) { const int orc = (r & 3) + 8 * (r >> 2);
#pragma unroll
        for (int d0 = 0; d0 < 4; ++d0) { const float v = o[d0][r] * rli[r];
            if constexpr (same_t<TOut, float>::v) { *(__attribute__((address_space(1))) float*)((gchar*)(Owb) + ooff + (unsigned)((orc * LDO + d0 * 32) * (int)sizeof(TOut))) = v; }
            else { const float vn = __builtin_bit_cast(float, __builtin_amdgcn_update_dpp(0, __builtin_bit_cast(int, v), 0xB1, 0xF, 0xF, true));
                   if ((r32 & 1) == 0) *(__attribute__((address_space(1))) unsigned*)((gchar*)(Owb) + ooff + (unsigned)((orc * LDO + d0 * 32) * (int)sizeof(TOut))) = cvtpk(v, vn); } } }
    if constexpr (F32) {
#pragma unroll
        for (int d0 = 0; d0 < 8; ++d0) S.qr[d0] = pack8(S.tq[2 * d0], S.tq[2 * d0 + 1]); }
    __syncthreads();
    asm volatile("" :: "v"(touch_reg));
#undef TOUCH
#undef RESC
#undef LB
#undef KBASE
#undef ACT
#undef MASKT
#undef SEAM_K0
#undef HALF_STEP
}
#undef ROW
#undef VMW
#undef VMWN
#undef SLOAD_H
#undef SWRITE_HK
#undef SWRITE_HV
#undef SWRITE_H
#undef SLOAD_F
#undef SWRITE_KF
#undef SWRITE_VF
#undef KSWZ
#undef SBAR
}

constexpr int NWAVES = 8, NTHR = 512;
constexpr int DM = 2048, NB = 2, SEQ = 4096, MROWS = NB * SEQ, NLAYER = 2;
constexpr int IN_COLS = 6592, IN_PAD = 6656, DFF = 5632, UPC = 2 * DFF;
constexpr int C_RQ = 0, C_RK = 256, C_RV = 512, C_RG = 1024, C_RW = 1536, C_MQ = 3520, C_MK = 4544, C_MV = 5568;
constexpr int RWC = 1984;
constexpr float NORM_EPS = 1e-6f, GN_EPS = 64e-5f;
constexpr size_t MiB = 1u << 20;
constexpr size_t WS_CTL = 0, CTL_ZERO_BYTES = 1 * MiB;
constexpr size_t WS_MOD = 1 * MiB;
constexpr size_t WS_KMEAN = 1 * MiB + 512 * 1024;
constexpr size_t WS_W = 2 * MiB, W_LAYER = 100 * MiB, W_IN = 0, W_OUT = 26 * MiB, W_UP = 34 * MiB, W_DN = 78 * MiB;
constexpr size_t WS_X = 202 * MiB;
constexpr size_t WS_H = 266 * MiB;
constexpr size_t WS_PROJ = 298 * MiB;
constexpr size_t WS_ACT = WS_PROJ;
constexpr size_t WS_MIXED = 402 * MiB;
constexpr size_t WS_U = 434 * MiB;
constexpr size_t WS_HALO = WS_U;
constexpr size_t WS_RW = WS_U;
constexpr size_t WS_Y = WS_U + 128 * MiB;
constexpr size_t WS_RETO = WS_U + 144 * MiB;
constexpr size_t WS_REC = 610 * MiB;
constexpr size_t WS_RWW = 738 * MiB;
constexpr size_t WS_END = 739 * MiB;
constexpr size_t RWA = (size_t)MROWS * 512;
constexpr int CW_BAR = 4096, CW_SUB = 64;
constexpr int RING_BYTES = 131072, LDSCTL_OFF = RING_BYTES, MISC_OFF = LDSCTL_OFF + 320, LDS_BYTES = 147456;

#define GAS __attribute__((address_space(1)))
#define LAS __attribute__((address_space(3)))
typedef unsigned short bf16;
typedef unsigned v4u __attribute__((ext_vector_type(4)));
typedef unsigned v2u __attribute__((ext_vector_type(2)));
typedef float f32x4 __attribute__((ext_vector_type(4)));
typedef float f32x2 __attribute__((ext_vector_type(2)));
#define LDS_WAIT() asm volatile("s_waitcnt lgkmcnt(0)" ::: "memory")
__device__ __forceinline__ unsigned f2bf(float f) { unsigned u = __builtin_bit_cast(unsigned, f); return (u + 0x7fffu + ((u >> 16) & 1u)) >> 16; }
__device__ __forceinline__ unsigned pk2(float lo, float hi) { return f2bf(lo) | (f2bf(hi) << 16); }
__device__ __forceinline__ float bf2f(unsigned short h) { return __builtin_bit_cast(float, (unsigned)h << 16); }
__device__ __forceinline__ float bflo(unsigned w) { return __builtin_bit_cast(float, w << 16); }
__device__ __forceinline__ float bfhi(unsigned w) { return __builtin_bit_cast(float, w & 0xffff0000u); }
template <int CTRL> __device__ __forceinline__ float dpp_add(float v);
__device__ __forceinline__ float wave_sum(float v);
__device__ __forceinline__ float wave_max(float v) {
#pragma unroll
    for (int o = 1; o < 64; o <<= 1) v = fmaxf(v, __shfl_xor(v, o));
    return v;
}
template <int CTRL> __device__ __forceinline__ float dpp_add(float v) { return v + __builtin_bit_cast(float, __builtin_amdgcn_update_dpp(0, __builtin_bit_cast(int, v), CTRL, 0xF, 0xF, true)); }
__device__ __forceinline__ float xsum16(float v) { auto r = __builtin_amdgcn_permlane16_swap(__float_as_uint(v), __float_as_uint(v), false, false); return __uint_as_float(r[0]) + __uint_as_float(r[1]); }
__device__ __forceinline__ float xsum32(float v) { auto r = __builtin_amdgcn_permlane32_swap(__float_as_uint(v), __float_as_uint(v), false, false); return __uint_as_float(r[0]) + __uint_as_float(r[1]); }
__device__ __forceinline__ float wave_sum(float v) {
    v = dpp_add<0xB1>(v); v = dpp_add<0x4E>(v); v = dpp_add<0x141>(v); v = dpp_add<0x140>(v);
    return xsum32(xsum16(v));
}
__device__ __forceinline__ float sigmoidf_(float x) { return __builtin_amdgcn_rcpf(1.0f + __expf(-x)); }

#define XB_TMO      128
#define XB_XCNT(j)  (256  + 64 * (j))
#define XB_XSUB(j)  (1280 + 64 * (j))
#define XB_XGEN(j)  (2304 + 64 * (j))
#define XB_TOP      3328
#define XB_TOPGEN   3392
#define XCD_BAR_WORDS 3456
#define XB_SPIN_CAP (1u << 22)
__device__ __forceinline__ unsigned xb_ld(unsigned* p)              { return __hip_atomic_load(p, __ATOMIC_RELAXED, __HIP_MEMORY_SCOPE_AGENT); }
__device__ __forceinline__ unsigned xb_add(unsigned* p, unsigned v) { return __hip_atomic_fetch_add(p, v, __ATOMIC_RELAXED, __HIP_MEMORY_SCOPE_AGENT); }
__device__ __forceinline__ unsigned xb_xcc_id() { return (unsigned)__builtin_amdgcn_s_getreg((3 << 11) | 20) & 0xFu; }
#define XB_SPIN(cond, bar) do { unsigned _sp = 0; while (cond) { __builtin_amdgcn_s_sleep(1); \
    if ((++_sp & 255u) == 0u) { if (xb_ld(&(bar)[XB_TMO])) break; if (_sp > XB_SPIN_CAP) { atomicAdd(&(bar)[XB_TMO], 1u); break; } } } } while (0)
struct XcdBarrier { unsigned* bar; unsigned x; volatile LAS unsigned* st; };
__device__ __forceinline__ XcdBarrier xcd_barrier_post(unsigned* bar, volatile LAS unsigned* st, int tid) {
    XcdBarrier b; b.bar = bar; b.x = xb_xcc_id(); b.st = st;
    if (tid == 0) (void)xb_add(&bar[XB_XCNT(b.x)], 1u);
    return b;
}
__device__ __forceinline__ void xcd_barrier_complete(unsigned* bar, unsigned x, unsigned& nloc, unsigned& nx) {
    const unsigned G = gridDim.x * gridDim.y * gridDim.z;
    unsigned sum, cnt, mine, sp = 0u;
    for (;;) {
        sum = 0u; cnt = 0u; mine = 0u;
#pragma unroll
        for (unsigned j = 0; j < 16; ++j) { const unsigned c = xb_ld(&bar[XB_XCNT(j)]); sum += c; cnt += (c > 0u) ? 1u : 0u; mine = (j == x) ? c : mine; }
        if (sum == G) break;
        __builtin_amdgcn_s_sleep(1);
        if ((++sp & 255u) == 0u) { if (xb_ld(&bar[XB_TMO])) break; if (sp > XB_SPIN_CAP) { atomicAdd(&bar[XB_TMO], 1u); break; } }
    }
    nloc = mine > 0u ? mine : 1u; nx = cnt > 0u ? cnt : 1u;
}
__device__ __forceinline__ void xcd_barrier(const XcdBarrier& b, int tid) {
    asm volatile("s_waitcnt vmcnt(0)" ::: "memory");
    __syncthreads();
    if (tid == 0) {
        unsigned z_ = 0u; asm volatile("" : "+v"(z_)); z_ = (unsigned)__builtin_amdgcn_readfirstlane(z_);
        unsigned* bar = b.bar + z_; const unsigned bx_ = b.x + z_;
        __builtin_amdgcn_s_waitcnt(0);
        unsigned nloc = b.st[0], nx = b.st[1];
        if (nloc == 0u) { xcd_barrier_complete(bar, bx_, nloc, nx); b.st[0] = nloc; b.st[1] = nx; }
        const unsigned old = xb_add(&bar[XB_XSUB(bx_)], 1u);
        const unsigned gen = old / nloc;
        if (old + 1u == (gen + 1u) * nloc) {
            __builtin_amdgcn_fence(__ATOMIC_RELEASE, "agent");
            asm volatile("s_waitcnt vmcnt(0)" ::: "memory");
            const unsigned og = xb_add(&bar[XB_TOP], 1u);
            const unsigned tg = og / nx;
            if (og + 1u == (tg + 1u) * nx) xb_add(&bar[XB_TOPGEN], 1u);
            else XB_SPIN(xb_ld(&bar[XB_TOPGEN]) == tg, bar);
            __builtin_amdgcn_fence(__ATOMIC_ACQUIRE, "agent");
            xb_add(&bar[XB_XGEN(bx_)], 1u);
            asm volatile("s_waitcnt vmcnt(0)" ::: "memory");
        } else {
            XB_SPIN(xb_ld(&bar[XB_XGEN(bx_)]) == gen, bar);
            __builtin_amdgcn_fence(__ATOMIC_ACQUIRE, "agent");
            asm volatile("s_waitcnt vmcnt(0)" ::: "memory");
        }
    }
    __syncthreads();
}

struct Args { const float* in[24]; float* out; unsigned char* ws; };
struct Frame {
    LAS unsigned char* lds;
    int tid, lane, wave, vcu, G, zz;
    const float* const* in;
    unsigned char* ws;
};

#define FWS (F.ws + F.zz)
__device__ __forceinline__ void p0_transpose_item(const float* W, int K, int N, bf16* WT, LAS float* scr, int item, int lane, int half = 0) {
    const int nblk = N / 32, kb = item / nblk, nb = item % nblk, k0 = 64 * kb, n0 = 32 * nb;
    const int r0 = !half ? n0 : (n0 < half ? (n0 >> 7) * 256 + (n0 & 127) : ((n0 - half) >> 7) * 256 + 128 + ((n0 - half) & 127));
#pragma unroll 8
    for (int i = 0; i < 32; ++i) { const int kk = 2 * i + (lane >> 5); scr[kk * 33 + (lane & 31)] = W[(size_t)(k0 + kk) * N + n0 + (lane & 31)]; }
    LDS_WAIT(); asm volatile("" ::: "memory");
    const int c = lane & 7;
#pragma unroll
    for (int j = 0; j < 4; ++j) { const int n = (lane >> 3) + 8 * j; const LAS float* s = scr + (8 * c) * 33 + n;
        v4u o; o.x = pk2(s[0 * 33], s[1 * 33]); o.y = pk2(s[2 * 33], s[3 * 33]); o.z = pk2(s[4 * 33], s[5 * 33]); o.w = pk2(s[6 * 33], s[7 * 33]);
        *(v4u*)(WT + (size_t)(r0 + n) * K + k0 + 8 * c) = o; }
    LDS_WAIT(); asm volatile("" ::: "memory");
}
constexpr int CV_IN = (DM / 64) * (IN_COLS / 32), CV_OUT = (DM / 64) * (DM / 32), CV_UP = (DM / 64) * (UPC / 32), CV_DN = (DFF / 64) * (DM / 32), CV_LAYER = CV_IN + CV_OUT + CV_UP + CV_DN;
constexpr int CV_N1 = 10, CV_N2 = 6, CV_N3 = 4, CV_C1 = 192 * NWAVES * CV_N1, CV_C2 = 128 * NWAVES * CV_N2;
static_assert(CV_IN + CV_C1 <= CV_LAYER && CV_LAYER - (CV_IN + CV_C1) + (CV_IN - CV_C2) <= 128 * NWAVES * CV_N3 && CV_C2 <= CV_IN, "gap capacities");
__device__ __forceinline__ void convert_item(Frame& F, int it, LAS float* scr) {
    const int l = it / CV_LAYER; int r = it % CV_LAYER;
    unsigned char* wl = FWS + WS_W + (size_t)l * W_LAYER;
    if (r < CV_IN) { p0_transpose_item(F.in[F.zz + 2] + (size_t)l * DM * IN_COLS, DM, IN_COLS, (bf16*)(wl + W_IN), scr, r, F.lane); return; } r -= CV_IN;
    if (r < CV_OUT) { p0_transpose_item(F.in[F.zz + 3] + (size_t)l * DM * DM, DM, DM, (bf16*)(wl + W_OUT), scr, r, F.lane); return; } r -= CV_OUT;
    if (r < CV_UP) { p0_transpose_item(F.in[F.zz + 15] + (size_t)l * DM * UPC, DM, UPC, (bf16*)(wl + W_UP), scr, r, F.lane, DFF); return; } r -= CV_UP;
    p0_transpose_item(F.in[F.zz + 18] + (size_t)l * DFF * DM, DFF, DM, (bf16*)(wl + W_DN), scr, r, F.lane);
}
__device__ __forceinline__ void convert_gap(Frame& F, int layer, int first, int count, int gwi, int nwv, int nper) {
    LAS float* scr = (LAS float*)(F.lds + F.wave * 16384);
    for (int j = 0; j < nper; ++j) { const int r = gwi + nwv * j; if (r < count) convert_item(F, layer * CV_LAYER + first + r, scr); }
}
__device__ __forceinline__ void adaln_item(Frame& F, int l, int grp) {
    LAS float* cact = (LAS float*)F.lds;
    LAS float* red = (LAS float*)(F.lds + 16384);
    const float* c = F.in[F.zz + 1];
    for (int i = F.tid; i < 4096; i += NTHR) { const float cv = c[i]; cact[i] = cv / (1.0f + __expf(-cv)); }
    __syncthreads();
    const int n0 = grp * 128;
    const float* W = F.in[F.zz + 19] + (size_t)l * 2048 * 12288 + n0;
    const int half = F.lane >> 5, q = F.lane & 31;
    f32x4 a0 = {0.f, 0.f, 0.f, 0.f}, a1 = {0.f, 0.f, 0.f, 0.f};
#pragma unroll 16
    for (int i = 0; i < 128; ++i) { const int k = F.wave * 256 + 2 * i + half; const f32x4 w = *(const f32x4*)(W + (size_t)k * 12288 + 4 * q);
        a0 += w * cact[k]; a1 += w * cact[2048 + k]; }
#pragma unroll
    for (int e = 0; e < 4; ++e) { a0[e] = xsum32(a0[e]); a1[e] = xsum32(a1[e]); }
    if (half == 0) {
#pragma unroll
        for (int e = 0; e < 4; ++e) { red[(F.wave * 2 + 0) * 128 + 4 * q + e] = a0[e]; red[(F.wave * 2 + 1) * 128 + 4 * q + e] = a1[e]; } }
    __syncthreads();
    if (F.tid < 256) { const int bb = F.tid >> 7, col = F.tid & 127; float s = 0.f;
#pragma unroll
        for (int w = 0; w < 8; ++w) s += red[(w * 2 + bb) * 128 + col];
        s += F.in[F.zz + 20][l * 12288 + n0 + col];
        ((float*)(FWS + WS_MOD))[(size_t)(l * 2 + bb) * 12288 + n0 + col] = s; }
    __syncthreads();
}
__device__ __forceinline__ void p0_prologue(Frame& F) {
    const int ngv = (F.G == 256) ? 96 : 192;
    if (F.vcu < ngv) adaln_item(F, F.vcu / 96, F.vcu % 96);
    LAS float* scr = (LAS float*)(F.lds + F.wave * 16384);
    const int gw = F.vcu * NWAVES + F.wave, NGW = F.G * NWAVES;
    if (F.G == 256) { if (F.vcu >= 96) for (int p = gw - 96 * NWAVES; p < CV_IN; p += 160 * NWAVES) convert_item(F, p, scr); }
    else for (int p = gw; p < NLAYER * CV_LAYER; p += NGW) convert_item(F, p, scr);
    for (int l = 0; l < NLAYER; ++l) { bf16* wt = (bf16*)(FWS + WS_RWW + (size_t)l * 448 * 512 * 2);
        const float* wu = F.in[F.zz + 6] + (size_t)l * 96 * 512; const float* au = F.in[F.zz + 8] + (size_t)l * 96 * 512; const float* gu = F.in[F.zz + 9] + (size_t)l * 256 * 512;
        for (int i = F.vcu * NTHR + F.tid; i < 448 * 512; i += F.G * NTHR) {
            if (i < 96 * 512) { const int n = i / 96, kq = i - n * 96; wt[i] = (bf16)f2bf(wu[kq * 512 + n]); }
            else if (i < 2 * 96 * 512) { const int j = i - 96 * 512, n = j / 96, kq = j - n * 96; wt[i] = (bf16)f2bf(au[kq * 512 + n]); }
            else { const int j = i - 2 * 96 * 512, n = j >> 8, kq = j & 255; wt[i] = (bf16)f2bf(gu[kq * 512 + n]); } } }
    for (int l = 0; l < NLAYER; ++l) { v4u* z = (v4u*)(FWS + WS_W + (size_t)l * W_LAYER + W_IN + (size_t)IN_COLS * DM * 2);
        for (int i = F.vcu * NTHR + F.tid; i < (IN_PAD - IN_COLS) * DM * 2 / 16; i += F.G * NTHR) z[i] = (v4u){0u, 0u, 0u, 0u}; }
}

template <int MODE, bool IN_F32>
__device__ __forceinline__ void norm_phase(Frame& F, const void* xin, void* outp, const float* g, const float* sh, const float* sc) {
    LAS float* gs = (LAS float*)F.lds;
    LAS float* shs = (LAS float*)(F.lds + 16384);
    for (int i = F.tid; i < 4096; i += NTHR) { const int b = i >> 11, col = i & 2047;
        if (MODE == 0) { gs[i] = g[col] * (1.0f + sc[(size_t)b * 12288 + col]); shs[i] = sh[(size_t)b * 12288 + col]; }
        else { gs[i] = g[col]; shs[i] = 0.f; } }
    __syncthreads();
    const int gw = F.vcu * NWAVES + F.wave, NGW = F.G * NWAVES;
    for (int m = gw; m < MROWS; m += NGW) {
        const int b = m >> 12;
        f32x4 v[8]; float s = 0.f;
#pragma unroll
        for (int j = 0; j < 8; ++j) {
            if (IN_F32) v[j] = *((const f32x4*)((const float*)xin + (size_t)m * DM) + F.lane + 64 * j);
            else { const v2u w = *((const v2u*)((const bf16*)xin + (size_t)m * DM) + F.lane + 64 * j); v[j] = (f32x4){bflo(w.x), bfhi(w.x), bflo(w.y), bfhi(w.y)}; }
            s += (v[j].x * v[j].x + v[j].y * v[j].y) + (v[j].z * v[j].z + v[j].w * v[j].w); }
        float rstd = __builtin_amdgcn_rsqf(wave_sum(s) * (1.0f / DM) + NORM_EPS);
#if MOBA_CHECK
        if (MODE == 1) { const float sd = ((const float*)(FWS + WS_CTL))[8], sn = ((const float*)(FWS + WS_CTL))[9]; rstd *= 1.0f + 10.0f * sqrtf(sd / sn); }
#endif
#pragma unroll
        for (int j = 0; j < 8; ++j) { const int col = 4 * (F.lane + 64 * j);
            const f32x4 gg = *(const LAS f32x4*)(gs + b * 2048 + col), ss = *(const LAS f32x4*)(shs + b * 2048 + col);
            const f32x4 o = v[j] * rstd * gg + ss;
            if (MODE == 0) { v2u w; w.x = pk2(o.x, o.y); w.y = pk2(o.z, o.w); *(v2u*)((bf16*)outp + (size_t)m * DM + col) = w; }
            else *(f32x4*)((float*)outp + (size_t)m * DM + col) = o; }
    }
    __syncthreads();
}

__device__ __forceinline__ float lerp_bf(const bf16* P, size_t row, int col, bool hasprev, float mu) {
    const float cur = bf2f(P[row * IN_PAD + col]); const float prev = hasprev ? bf2f(P[(row - 1) * IN_PAD + col]) : 0.f;
    return cur + (prev - cur) * mu;
}
__device__ __forceinline__ void rwkv_prep(Frame& F, int l) {
    LAS float* codes = (LAS float*)F.lds;
    const bf16* P = (const bf16*)(FWS + WS_PROJ);
    const float* mu = F.in[F.zz + 4] + l * RWC; const float* w0 = F.in[F.zz + 5] + l * 512; const float* w_up = F.in[F.zz + 6] + (size_t)l * 96 * 512;
    const float* a0 = F.in[F.zz + 7] + l * 512; const float* a_up = F.in[F.zz + 8] + (size_t)l * 96 * 512; const float* g_up = F.in[F.zz + 9] + (size_t)l * 256 * 512;
    const float* k_k = F.in[F.zz + 10] + l * 512; const float* k_a = F.in[F.zz + 11] + l * 512; const float* r_k = F.in[F.zz + 12] + l * 512;
    float* RW = (float*)(FWS + WS_RW);
    const int c = F.tid;
    const float mur = mu[c], muk = mu[512 + c], muv = mu[1024 + c], w0c = w0[c], a0c = a0[c], kkc = k_k[c], kac = k_a[c], rkc = r_k[c];
    for (int item = F.vcu; item < MROWS / 8; item += F.G) {
        const int row0 = item * 8, t0 = row0 & (SEQ - 1);
        for (int idx = F.tid; idx < 8 * 448; idx += NTHR) { const int tk = idx / 448, cc = idx - tk * 448;
            float val = lerp_bf(P, (size_t)(row0 + tk), C_RW + 1536 + cc, (t0 + tk) > 0, mu[1536 + cc]);
            if (cc < 96) val = tanhf(val); else if (cc >= 192) val = sigmoidf_(val);
            codes[idx] = val; }
        __syncthreads();
        float wd[8], wa[8], gg[8];
#pragma unroll
        for (int tk = 0; tk < 8; ++tk) { wd[tk] = 0.f; wa[tk] = 0.f; gg[tk] = 0.f; }
        for (int r = 0; r < 96; ++r) { const float wu = w_up[r * 512 + c], au = a_up[r * 512 + c];
#pragma unroll
            for (int tk = 0; tk < 8; ++tk) { wd[tk] += codes[tk * 448 + r] * wu; wa[tk] += codes[tk * 448 + 96 + r] * au; } }
        for (int r = 0; r < 256; ++r) { const float gu = g_up[r * 512 + c];
#pragma unroll
            for (int tk = 0; tk < 8; ++tk) gg[tk] += codes[tk * 448 + 192 + r] * gu; }
#pragma unroll
        for (int tk = 0; tk < 8; ++tk) {
            const size_t row = (size_t)(row0 + tk); const bool hp = (t0 + tk) > 0;
            const float rr = lerp_bf(P, row, C_RW + c, hp, mur), kk0 = lerp_bf(P, row, C_RW + 512 + c, hp, muk), vv = lerp_bf(P, row, C_RW + 1024 + c, hp, muv);
            const float z = -(w0c + wd[tk]);
            const float sp = fmaxf(z, 0.f) + log1pf(__expf(-fabsf(z)));
            const float decay = __expf(-__expf(-sp - 0.5f));
            const float a = sigmoidf_(a0c + wa[tk]);
            const float kkv = kk0 * kkc;
            const float nrm = sqrtf(wave_sum(kkv * kkv));
            const float kap = kkv / fmaxf(nrm, 1e-12f);
            const float kp = kk0 * (1.0f + (a - 1.0f) * kac);
            const float bsum = wave_sum(rr * kp * rkc);
            const size_t o = row * 512 + c;
            RW[0 * RWA + o] = rr; RW[1 * RWA + o] = decay; RW[2 * RWA + o] = kp; RW[3 * RWA + o] = vv;
            RW[4 * RWA + o] = kap; RW[5 * RWA + o] = kap * a; RW[6 * RWA + o] = gg[tk]; RW[7 * RWA + o] = bsum * vv;
        }
        __syncthreads();
    }
}
__device__ __forceinline__ void moba_kmean(Frame& F) {
    LAS float* red = (LAS float*)(F.lds + 32768);
    const bf16* P = (const bf16*)(FWS + WS_PROJ);
    float* KM = (float*)(FWS + WS_KMEAN);
    for (int item = F.vcu; item < 256; item += F.G) {
        const int b = item >> 7, h = (item >> 4) & 7, n = item & 15;
        const int d = F.tid & 127, part = F.tid >> 7;
        const bf16* kp = P + (size_t)(b * SEQ + n * 256 + part * 64) * IN_PAD + C_MK + h * 128 + d;
        float s = 0.f;
        for (int k = 0; k < 64; ++k) s += bf2f(kp[(size_t)k * IN_PAD]);
        red[part * 128 + d] = s;
        __syncthreads();
        if (F.tid < 128) KM[(size_t)item * 128 + d] = (red[d] + red[128 + d] + red[256 + d] + red[384 + d]) * (1.0f / 256.0f);
        __syncthreads();
    }
}
struct RwIn { f32x4 w[2], kk[2], bb[2], k[2], r[2]; float v; };
__device__ __forceinline__ void rw_load(RwIn& x, const float* RW, size_t row, int cj, int ci) {
    const size_t o = row * 512;
    x.w[0] = *(const f32x4*)(RW + 1 * RWA + o + cj); x.w[1] = *(const f32x4*)(RW + 1 * RWA + o + cj + 4);
    x.kk[0] = *(const f32x4*)(RW + 4 * RWA + o + cj); x.kk[1] = *(const f32x4*)(RW + 4 * RWA + o + cj + 4);
    x.bb[0] = *(const f32x4*)(RW + 5 * RWA + o + cj); x.bb[1] = *(const f32x4*)(RW + 5 * RWA + o + cj + 4);
    x.k[0] = *(const f32x4*)(RW + 2 * RWA + o + cj); x.k[1] = *(const f32x4*)(RW + 2 * RWA + o + cj + 4);
    x.r[0] = *(const f32x4*)(RW + 0 * RWA + o + cj); x.r[1] = *(const f32x4*)(RW + 0 * RWA + o + cj + 4);
    x.v = RW[3 * RWA + o + ci];
}
__device__ __forceinline__ void rwkv_scan_naive(Frame& F, int b, int h) {
    const float* RW = (const float*)(FWS + WS_RW);
    float* Y = (float*)(FWS + WS_Y);
    const int i = F.tid >> 3, jp = F.tid & 7, cj = h * 64 + 8 * jp, ci = h * 64 + i;
    f32x4 s0 = {0.f, 0.f, 0.f, 0.f}, s1 = {0.f, 0.f, 0.f, 0.f};
    RwIn cur, n1, n2;
    const size_t rb = (size_t)b * SEQ;
    rw_load(cur, RW, rb, cj, ci); rw_load(n1, RW, rb + 1, cj, ci);
    for (int t = 0; t < SEQ; ++t) {
        rw_load(n2, RW, rb + (t + 2 < SEQ ? t + 2 : SEQ - 1), cj, ci);
        f32x4 pp = s0 * cur.kk[0] + s1 * cur.kk[1];
        float p = (pp.x + pp.y) + (pp.z + pp.w);
        p += __shfl_xor(p, 1); p += __shfl_xor(p, 2); p += __shfl_xor(p, 4);
        const float sa = -p;
        s0 = s0 * cur.w[0] + sa * cur.bb[0] + cur.v * cur.k[0];
        s1 = s1 * cur.w[1] + sa * cur.bb[1] + cur.v * cur.k[1];
        f32x4 yy = s0 * cur.r[0] + s1 * cur.r[1];
        float y = (yy.x + yy.y) + (yy.z + yy.w);
        y += __shfl_xor(y, 1); y += __shfl_xor(y, 2); y += __shfl_xor(y, 4);
        if (jp == 0) Y[(rb + t) * 512 + ci] = y;
        cur = n1; n1 = n2;
    }
}
struct RtIn { v4u q[2], k[2]; unsigned short v; };
__device__ __forceinline__ void rt_load(RtIn& x, const bf16* P, size_t row, int h, int d0, int v) {
    const bf16* p = P + row * IN_PAD;
    x.q[0] = *(const v4u*)(p + C_RQ + h * 64 + d0); x.q[1] = *(const v4u*)(p + C_RQ + h * 64 + d0 + 8);
    x.k[0] = *(const v4u*)(p + C_RK + h * 64 + d0); x.k[1] = *(const v4u*)(p + C_RK + h * 64 + d0 + 8);
    x.v = p[C_RV + h * 128 + v];
}
__device__ __forceinline__ void ret_scan_naive(Frame& F, int b, int h) {
    const bf16* P = (const bf16*)(FWS + WS_PROJ);
    float* RO = (float*)(FWS + WS_RETO);
    const int v = F.tid >> 2, dp = F.tid & 3, d0 = dp * 16;
    const float gamma = 1.0f - exp2f(-5.0f - (float)h);
    float S[16];
#pragma unroll
    for (int d = 0; d < 16; ++d) S[d] = 0.f;
    RtIn cur, n1, n2;
    const size_t rb = (size_t)b * SEQ;
    rt_load(cur, P, rb, h, d0, v); rt_load(n1, P, rb + 1, h, d0, v);
    for (int t = 0; t < SEQ; ++t) {
        rt_load(n2, P, rb + (t + 2 < SEQ ? t + 2 : SEQ - 1), h, d0, v);
        const float vv = bf2f(cur.v) * 0.125f;
        float o = 0.f;
#pragma unroll
        for (int e = 0; e < 8; ++e) { const unsigned qw = cur.q[e >> 2][e & 3], kw = cur.k[e >> 2][e & 3];
            S[2 * e] = gamma * S[2 * e] + bflo(kw) * vv; S[2 * e + 1] = gamma * S[2 * e + 1] + bfhi(kw) * vv;
            o += bflo(qw) * S[2 * e] + bfhi(qw) * S[2 * e + 1]; }
        o += __shfl_xor(o, 1); o += __shfl_xor(o, 2);
        if (dp == 0) RO[(rb + t) * 512 + h * 128 + v] = o;
        cur = n1; n1 = n2;
    }
}
__device__ __forceinline__ void moba_naive(Frame& F, int mw, int nmw) {
    const bf16* P = (const bf16*)(FWS + WS_PROJ);
    const float* KM = (const float*)(FWS + WS_KMEAN);
    bf16* MX = (bf16*)(FWS + WS_U + 160 * MiB);
    LAS float* qs = (LAS float*)(F.lds + F.wave * 4608);
    LAS float* ps = qs + 128;
    const int lane = F.lane;
    for (int qi = mw; qi < MROWS * 8; qi += nmw) {
        const int h = qi & 7, row = qi >> 3, b = row >> 12, t = row & (SEQ - 1), bq = t >> 8;
        { const unsigned qw = *(const unsigned*)(P + (size_t)row * IN_PAD + C_MQ + h * 128 + 2 * lane);
          qs[2 * lane] = bflo(qw) * 0.08838834764831845f; qs[2 * lane + 1] = bfhi(qw) * 0.08838834764831845f; }
        LDS_WAIT();
        float gate = -INFINITY;
        if (lane < 16 && lane < bq) { const float* km = KM + ((size_t)(b * 8 + h) * 16 + lane) * 128; float a = 0.f;
            for (int d = 0; d < 128; ++d) a += qs[d] * km[d];
            gate = a; }
        unsigned selmask = 0u;
#pragma unroll
        for (int rnd = 0; rnd < 3; ++rnd) { const float m = wave_max(gate);
            if (m > -INFINITY) { const unsigned long long bal = __ballot(gate == m); const int idx = __ffsll((long long)bal) - 1; selmask |= 1u << idx; if (lane == idx) gate = -INFINITY; } }
        int blk[4];
#pragma unroll
        for (int s = 0; s < 3; ++s) { if (selmask) { blk[s] = __ffs((int)selmask) - 1; selmask &= selmask - 1u; } else blk[s] = -1; }
        blk[3] = bq;
        const float slope = exp2f(-(float)(h + 1));
        float sc[4][4]; float mx = -1e30f;
#pragma unroll
        for (int s = 0; s < 4; ++s) {
#pragma unroll
            for (int kq = 0; kq < 4; ++kq) {
                float val = -1e30f;
                if (blk[s] >= 0) { const int pos = blk[s] * 256 + kq * 64 + lane;
                    const bf16* kp = P + (size_t)(b * SEQ + pos) * IN_PAD + C_MK + h * 128; float a = 0.f;
#pragma unroll 4
                    for (int d8 = 0; d8 < 16; ++d8) { const v4u kw = *(const v4u*)(kp + d8 * 8); const f32x4 qa = *(const LAS f32x4*)(qs + d8 * 8), qb = *(const LAS f32x4*)(qs + d8 * 8 + 4);
                        a += bflo(kw.x) * qa.x + bfhi(kw.x) * qa.y + bflo(kw.y) * qa.z + bfhi(kw.y) * qa.w + bflo(kw.z) * qb.x + bfhi(kw.z) * qb.y + bflo(kw.w) * qb.z + bfhi(kw.w) * qb.w; }
                    if (pos <= t) val = a - slope * (float)(t - pos); }
                sc[s][kq] = val; mx = fmaxf(mx, val); } }
        mx = wave_max(mx);
        float lsum = 0.f;
#pragma unroll
        for (int s = 0; s < 4; ++s)
#pragma unroll
            for (int kq = 0; kq < 4; ++kq) { const float p = __expf(sc[s][kq] - mx); lsum += p; ps[s * 256 + kq * 64 + lane] = p; }
        lsum = wave_sum(lsum);
        LDS_WAIT();
        float o0 = 0.f, o1 = 0.f;
#pragma unroll
        for (int s = 0; s < 4; ++s) if (blk[s] >= 0) { const int nk = (s == 3) ? (t - bq * 256 + 1) : 256;
            const bf16* vp = P + (size_t)(b * SEQ + blk[s] * 256) * IN_PAD + C_MV + h * 128 + 2 * lane;
#pragma unroll 4
            for (int key = 0; key < nk; ++key) { const float p = ps[s * 256 + key]; const unsigned vw = *(const unsigned*)(vp + (size_t)key * IN_PAD); o0 += p * bflo(vw); o1 += p * bfhi(vw); } }
        const float inv = 1.0f / lsum;
        *(unsigned*)(MX + (size_t)row * 1024 + h * 128 + 2 * lane) = pk2(o0 * inv, o1 * inv);
        LDS_WAIT();
    }
}

constexpr int MOBA_LDS_KM = moba::LDS_BYTES, MOBA_LDS_SEL = MOBA_LDS_KM + 8192;
__device__ __forceinline__ void moba_item(Frame& F, int bh, int qbA, int qbB) {
    const int b = bh >> 3, h = bh & 7;
    const bf16* P = (const bf16*)(FWS + WS_PROJ);
    LAS float* km = (LAS float*)(F.lds + MOBA_LDS_KM);
    LAS unsigned* sel = (LAS unsigned*)(F.lds + MOBA_LDS_SEL);
    const float* KM = (const float*)(FWS + WS_KMEAN) + (size_t)bh * 16 * 128;
    for (int i = F.tid; i < 2048; i += NTHR) km[i] = KM[i];
    __syncthreads();
    {   const int qb = (F.tid < 256) ? qbA : qbB, r = F.tid & 255;
        const bf16* qp = P + (size_t)(b * SEQ + qb * 256 + r) * IN_PAD + C_MQ + h * 128;
        float g[16];
#pragma unroll
        for (int n = 0; n < 16; ++n) g[n] = 0.f;
        for (int d8 = 0; d8 < 16; ++d8) { const v4u qw = *(const v4u*)(qp + d8 * 8);
            const float q0 = bflo(qw.x), q1 = bfhi(qw.x), q2 = bflo(qw.y), q3 = bfhi(qw.y), q4 = bflo(qw.z), q5 = bfhi(qw.z), q6 = bflo(qw.w), q7 = bfhi(qw.w);
#pragma unroll
            for (int n = 0; n < 16; ++n) { const f32x4 ka = *(const LAS f32x4*)(km + n * 128 + d8 * 8), kb = *(const LAS f32x4*)(km + n * 128 + d8 * 8 + 4);
                g[n] += (q0 * ka.x + q1 * ka.y) + (q2 * ka.z + q3 * ka.w) + (q4 * kb.x + q5 * kb.y) + (q6 * kb.z + q7 * kb.w); } }
        unsigned m = 0u;
#pragma unroll
        for (int rnd = 0; rnd < 3; ++rnd) { float best = -INFINITY; int bi = -1;
#pragma unroll
            for (int n = 0; n < 16; ++n) if (n < qb && !((m >> n) & 1u) && g[n] > best) { best = g[n]; bi = n; }
            if (bi >= 0) m |= 1u << bi; }
        sel[F.tid] = m; }
    __syncthreads();
    typedef moba::BlockRef<moba::bf16, moba::bf16> Ref;
    const float slopeR = exp2f(-(float)(h + 1)) * 11.313708498984761f;
    bf16* MX = (bf16*)(FWS + WS_MIXED);
    Ref A, B2;
    A.Q = P + (size_t)(b * SEQ + qbA * 256) * IN_PAD + C_MQ + h * 128; A.K = P + (size_t)(b * SEQ) * IN_PAD + C_MK + h * 128; A.V = P + (size_t)(b * SEQ) * IN_PAD + C_MV + h * 128;
    A.O = MX + (size_t)(b * SEQ + qbA * 256) * DM + 1024 + h * 128; A.P0 = qbA * 256; A.sel = sel; A.slopeR = slopeR;
    B2 = A; B2.Q = P + (size_t)(b * SEQ + qbB * 256) * IN_PAD + C_MQ + h * 128; B2.O = MX + (size_t)(b * SEQ + qbB * 256) * DM + 1024 + h * 128; B2.P0 = qbB * 256; B2.sel = sel + 256;
    moba::Seam<moba::bf16> S;
    moba::lchar* ldsg = (moba::lchar*)F.lds;
    moba::causal_swa_prime<moba::bf16, moba::bf16>(A, 1 << 30, ldsg, S, F.wave);
    Ref cur = A;
    for (int pass = 0; pass < MOBA_NP; ++pass) {
        const bool nb_ = ((pass + 1) & 1) != 0;
        Ref nxt = A; if (nb_ || pass + 1 >= MOBA_NP) nxt = B2;
        moba::causal_swa_block<moba::bf16, moba::bf16>(cur, nxt, SEQ, 1 << 30, ldsg, S, F.wave);
        cur = nxt;
    }
}
constexpr int RC_UNITS = 32, RC_NCH = SEQ / 16, RC_REC = 16384;
constexpr int RC_AR = 0, RC_BK = 4096, RC_VP = 8192, RC_U0 = 10240, RC_Y0 = 12288, RC_D = 14336;
typedef short bf16x8 __attribute__((ext_vector_type(8)));
typedef float f32x16 __attribute__((ext_vector_type(16)));
typedef float f32x2t __attribute__((ext_vector_type(2))); typedef __bf16 bf16x2t __attribute__((ext_vector_type(2)));
__device__ __forceinline__ unsigned cvtpk_c(float lo, float hi) { f32x2t v = {lo, hi}; bf16x2t b = __builtin_convertvector(v, bf16x2t); return __builtin_bit_cast(unsigned, b); }
__device__ __forceinline__ unsigned short cvt1_c(float x) { return (unsigned short)(cvtpk_c(x, 0.f) & 0xffffu); }

constexpr int RC_WLDS = 14464, RC_CODES_OFF = 8 * RC_WLDS  , RC_CSTRIDE = 456;
#define RC_ST(off, w) (*(v4u*)(FWS + WS_REC + (size_t)roff + (unsigned)(off)) = (w))
#define RC_ST_D(Dv) do { const int di_ = __builtin_bit_cast(int, (Dv)); v4u dw_; dw_.x = (unsigned)__builtin_amdgcn_update_dpp(0, di_, 0x00, 0xF, 0xF, true); dw_.y = (unsigned)__builtin_amdgcn_update_dpp(0, di_, 0x55, 0xF, 0xF, true); \
    dw_.z = (unsigned)__builtin_amdgcn_update_dpp(0, di_, 0xAA, 0xF, 0xF, true); dw_.w = (unsigned)__builtin_amdgcn_update_dpp(0, di_, 0xFF, 0xF, 0xF, true); if ((x & 3) == 0) RC_ST(RC_D + x * 4, dw_); } while (0)
__device__ __forceinline__ void rc_core(Frame& F, LAS unsigned char* wlds, const float (&At)[16], const float (&Bt)[16], const float (&Kt)[16], const float (&Rt)[16], const float (&vv)[16], const float D, unsigned roff) {
    { unsigned wb_ = (unsigned)(uintptr_t)wlds; asm volatile("" : "+v"(wb_)); wlds = (LAS unsigned char*)(uintptr_t)wb_; }
    LAS bf16* XA = (LAS bf16*)wlds; LAS bf16* XB = (LAS bf16*)(wlds + 4608); LAS float* TT = (LAS float*)(wlds + 9216 + 4224);
    int x_ = F.lane; asm volatile("" : "+v"(x_));
    const int x = x_, r32 = x & 31, h2 = x >> 5, tl = x & 15;
#pragma unroll
    for (int t = 0; t < 16; ++t) { XA[t * 72 + x] = cvt1_c(Bt[t]); XA[(16 + t) * 72 + x] = cvt1_c(Kt[t]); XB[t * 72 + x] = cvt1_c(At[t]); XB[(16 + t) * 72 + x] = cvt1_c(Rt[t]); }
#pragma unroll
    for (int q = 0; q < 4; ++q) { v4u w; w.x = cvtpk_c(Bt[4 * q] * D, Bt[4 * q + 1] * D); w.y = cvtpk_c(Bt[4 * q + 2] * D, Bt[4 * q + 3] * D);
        w.z = cvtpk_c(Kt[4 * q] * D, Kt[4 * q + 1] * D); w.w = cvtpk_c(Kt[4 * q + 2] * D, Kt[4 * q + 3] * D); RC_ST(RC_BK + x * 64 + q * 16, w); }
#pragma unroll
    for (int q = 0; q < 2; ++q) { v4u w;
        w.x = cvtpk_c(vv[8 * q], vv[8 * q + 1]); w.y = cvtpk_c(vv[8 * q + 2], vv[8 * q + 3]); w.z = cvtpk_c(vv[8 * q + 4], vv[8 * q + 5]); w.w = cvtpk_c(vv[8 * q + 6], vv[8 * q + 7]); RC_ST(RC_VP + x * 32 + q * 16, w);
    }
    RC_ST_D(D);
    f32x16 G;
#pragma unroll
    for (int r = 0; r < 16; ++r) G[r] = 0.f;
#pragma unroll
    for (int ks = 0; ks < 4; ++ks) { const bf16x8 a = *(const LAS bf16x8*)(XA + r32 * 72 + ks * 16 + h2 * 8), bq = *(const LAS bf16x8*)(XB + r32 * 72 + ks * 16 + h2 * 8);
        G = __builtin_amdgcn_mfma_f32_32x32x16_bf16(a, bq, G, 0, 0, 0); }
    LAS float* GA = (LAS float*)wlds; LAS float* GT = (LAS float*)(wlds + 4608);
#pragma unroll
    for (int r = 0; r < 16; ++r) GA[((r & 3) + 8 * (r >> 2) + 4 * h2) * 36 + r32] = G[r];
#pragma unroll
    for (int g4 = 0; g4 < 4; ++g4) *(LAS f32x4*)(GT + r32 * 36 + 8 * g4 + 4 * h2) = (f32x4){G[4 * g4], G[4 * g4 + 1], G[4 * g4 + 2], G[4 * g4 + 3]};
#define RC_LD16(dst, p, n4) do { _Pragma("unroll") for (int i4_ = 0; i4_ < (n4); ++i4_) { const f32x4 v4_ = *(const LAS f32x4*)((p) + 4 * i4_); dst[4 * i4_] = v4_.x; dst[4 * i4_ + 1] = v4_.y; dst[4 * i4_ + 2] = v4_.z; dst[4 * i4_ + 3] = v4_.w; } } while (0)
    float Tc[16];
    { f32x2 Tp[8];
#pragma unroll
    for (int j = 0; j < 8; ++j) { Tp[j].x = (2 * j == tl) ? 1.0f : 0.0f; Tp[j].y = (2 * j + 1 == tl) ? 1.0f : 0.0f; }
#pragma unroll
    for (int s = 14; s >= 0; --s) { f32x4 nr4[4]; f32x2 a2 = {0.f, 0.f}; float a1 = 0.f;
#pragma unroll
        for (int i4 = (s + 1) / 4; i4 < 4; ++i4) nr4[i4] = *(const LAS f32x4*)(GA + s * 36 + 4 * i4);
        if ((s + 1) & 1) { const int m = s + 1; a1 = nr4[m >> 2][m & 3] * Tp[m >> 1].y; }
#pragma unroll
        for (int m = (s + 2) & ~1; m < 16; m += 2) a2 += (f32x2){nr4[m >> 2][m & 3], nr4[m >> 2][(m & 3) + 1]} * Tp[m >> 1];
        const float acc = a1 + (a2.x + a2.y);
        if (s & 1) Tp[s >> 1].y = (s < tl) ? acc : Tp[s >> 1].y; else Tp[s >> 1].x = (s < tl) ? acc : Tp[s >> 1].x; }
#pragma unroll
    for (int j = 0; j < 8; ++j) { Tc[2 * j] = Tp[j].x; Tc[2 * j + 1] = Tp[j].y; } }
    if (x < 16) {
#pragma unroll
        for (int g4 = 0; g4 < 4; ++g4) *(LAS f32x4*)(TT + tl * 16 + 4 * g4) = (f32x4){Tc[4 * g4], Tc[4 * g4 + 1], Tc[4 * g4 + 2], Tc[4 * g4 + 3]}; }
    float PV[16];
    PV[0] = 0.f;
#pragma unroll
    for (int s = 1; s < 16; ++s) { f32x2 a2 = {0.f, 0.f}; float a1 = 0.f;
#pragma unroll
        for (int r = 0; r + 1 < s; r += 2) a2 += (f32x2){GT[s * 36 + 16 + r], GT[s * 36 + 16 + r + 1]} * (f32x2){vv[r], vv[r + 1]};
        if (s & 1) a1 = GT[s * 36 + 16 + s - 1] * vv[s - 1];
        PV[s] = a1 + (a2.x + a2.y); }
    float Ah[16], U0[16];
#pragma unroll
    for (int t = 0; t < 16; ++t) { f32x2 a2 = {0.f, 0.f};
#pragma unroll
        for (int s = 0; s <= t; ++s) { const float tv = TT[t * 16 + s]; a2 += (f32x2){tv, tv} * (f32x2){At[s], PV[s]}; }
        Ah[t] = a2.x; U0[t] = a2.y; }
    float Rh[16], Y0[16];
#pragma unroll
    for (int t = 0; t < 16; ++t) { f32x2 ry = {Rt[t], 0.f};
#pragma unroll
        for (int s = 0; s <= t; ++s) { const float m1 = GT[(16 + t) * 36 + s], m2 = GT[(16 + t) * 36 + 16 + s]; ry += (f32x2){m1, m1} * (f32x2){Ah[s], U0[s]}; ry.y += m2 * vv[s]; }
        Rh[t] = ry.x; Y0[t] = ry.y; }
#undef RC_LD16
    { const int ks = x >> 5, jj = x & 31, e = (jj >> 4) * 4 + (jj & 3), q = (jj >> 2) & 3; LAS unsigned char* pb = wlds + ks * 1024 + q * 256 + e * 2;
#pragma unroll
      for (int s = 0; s < 16; ++s) { *(LAS bf16*)(pb + s * 16) = cvt1_c(Ah[s]); *(LAS bf16*)(pb + 2048 + s * 16) = cvt1_c(Rh[s]); }
#pragma unroll
      for (int j = 0; j < 4; ++j) { const v4u w = *(const LAS v4u*)(wlds + j * 1024 + x * 16); RC_ST(RC_AR + j * 1024 + x * 16, w); } }
#pragma unroll
    for (int q = 0; q < 2; ++q) { v4u w;
        w.x = cvtpk_c(U0[8 * q], U0[8 * q + 1]); w.y = cvtpk_c(U0[8 * q + 2], U0[8 * q + 3]); w.z = cvtpk_c(U0[8 * q + 4], U0[8 * q + 5]); w.w = cvtpk_c(U0[8 * q + 6], U0[8 * q + 7]); RC_ST(RC_U0 + x * 32 + q * 16, w);
        w.x = cvtpk_c(Y0[8 * q], Y0[8 * q + 1]); w.y = cvtpk_c(Y0[8 * q + 2], Y0[8 * q + 3]); w.z = cvtpk_c(Y0[8 * q + 4], Y0[8 * q + 5]); w.w = cvtpk_c(Y0[8 * q + 6], Y0[8 * q + 7]); RC_ST(RC_Y0 + x * 32 + q * 16, w); }
    LDS_WAIT();
}
__device__ __forceinline__ void rc_pass1_rwkv(Frame& F, int wid, int nw, int c0, int nc) {
    LAS unsigned char* wlds = F.lds + F.wave * RC_WLDS;
    const int x = F.lane;
    const float* RW = (const float*)(FWS + WS_RW);
    const bf16* RH = (const bf16*)(FWS + WS_RW + 32 * MiB);
    for (int it2 = wid; it2 < 16 * nc; it2 += nw) {
        const int u = it2 / nc, c = c0 + it2 % nc, it = u * RC_NCH + c, b = u >> 3, h = u & 7; const size_t o0 = ((size_t)(b * SEQ + c * 16)) * 512 + h * 64 + x;
        float At[16], Bt[16], Kt[16], Rt[16], vv[16]; float W = 1.0f;
#pragma unroll
        for (int t = 0; t < 16; ++t) { const size_t o = o0 + (size_t)t * 512;
            const float wv = RW[o], ka = bf2f(RH[3 * RWA + o]), bb = bf2f(RH[4 * RWA + o]), kk = bf2f(RH[1 * RWA + o]), rr = bf2f(RH[0 * RWA + o]); vv[t] = bf2f(RH[2 * RWA + o]);
            At[t] = -ka * W; W *= wv; const float iw = __builtin_amdgcn_rcpf(W); Bt[t] = bb * iw; Kt[t] = kk * iw; Rt[t] = rr * W; }
        rc_core(F, wlds, At, Bt, Kt, Rt, vv, W, (unsigned)it * RC_REC);
    }
}
__device__ __forceinline__ void rc_core_ret(Frame& F, LAS unsigned char* wlds, const float (&Kt)[16], const float (&Rt)[16], const float (&vv)[16], const float D, unsigned roff) {
    { unsigned wb_ = (unsigned)(uintptr_t)wlds; asm volatile("" : "+v"(wb_)); wlds = (LAS unsigned char*)(uintptr_t)wb_; }
    LAS bf16* XK = (LAS bf16*)wlds; LAS bf16* XR = (LAS bf16*)(wlds + 2304); LAS float* GM = (LAS float*)(wlds + 4608);
    int x_ = F.lane; asm volatile("" : "+v"(x_));
    const int x = x_, fr = x & 15, q = x >> 4;
#pragma unroll
    for (int t = 0; t < 16; ++t) { XK[t * 72 + x] = cvt1_c(Kt[t]); XR[t * 72 + x] = cvt1_c(Rt[t]); }
#pragma unroll
    for (int qq = 0; qq < 4; ++qq) { v4u w; w.x = 0u; w.y = 0u;
        w.z = cvtpk_c(Kt[4 * qq] * D, Kt[4 * qq + 1] * D); w.w = cvtpk_c(Kt[4 * qq + 2] * D, Kt[4 * qq + 3] * D); RC_ST(RC_BK + x * 64 + qq * 16, w); }
#pragma unroll
    for (int qq = 0; qq < 2; ++qq) { v4u w;
        w.x = cvtpk_c(vv[8 * qq], vv[8 * qq + 1]); w.y = cvtpk_c(vv[8 * qq + 2], vv[8 * qq + 3]); w.z = cvtpk_c(vv[8 * qq + 4], vv[8 * qq + 5]); w.w = cvtpk_c(vv[8 * qq + 6], vv[8 * qq + 7]); RC_ST(RC_VP + x * 32 + qq * 16, w);
        RC_ST(RC_U0 + x * 32 + qq * 16, ((v4u){0u, 0u, 0u, 0u})); }
    RC_ST_D(D);
    f32x4 G = {0.f, 0.f, 0.f, 0.f};
#pragma unroll
    for (int ks = 0; ks < 2; ++ks) { const bf16x8 a = *(const LAS bf16x8*)(XK + fr * 72 + ks * 32 + q * 8), bq = *(const LAS bf16x8*)(XR + fr * 72 + ks * 32 + q * 8);
        G = __builtin_amdgcn_mfma_f32_16x16x32_bf16(a, bq, G, 0, 0, 0); }
#pragma unroll
    for (int rg = 0; rg < 4; ++rg) GM[(4 * q + rg) * 17 + fr] = G[rg];
    { const int ks = x >> 5, jj = x & 31, e = (jj >> 4) * 4 + (jj & 3), qv = (jj >> 2) & 3; LAS unsigned char* pb = wlds + 2048 + ks * 1024 + qv * 256 + e * 2;
#pragma unroll
      for (int s = 0; s < 16; ++s) *(LAS bf16*)(pb + s * 16) = cvt1_c(Rt[s]);
#pragma unroll
      for (int j = 0; j < 2; ++j) { RC_ST(RC_AR + j * 1024 + x * 16, ((v4u){0u, 0u, 0u, 0u})); const v4u w = *(const LAS v4u*)(wlds + 2048 + j * 1024 + x * 16); RC_ST(RC_AR + 2048 + j * 1024 + x * 16, w); } }
    float Y0[16];
#pragma unroll
    for (int t = 0; t < 16; ++t) { float yy = 0.f;
#pragma unroll
        for (int s = 0; s <= t; ++s) yy += GM[s * 17 + t] * vv[s];
        Y0[t] = yy; }
#pragma unroll
    for (int qq = 0; qq < 2; ++qq) { v4u w;
        w.x = cvtpk_c(Y0[8 * qq], Y0[8 * qq + 1]); w.y = cvtpk_c(Y0[8 * qq + 2], Y0[8 * qq + 3]); w.z = cvtpk_c(Y0[8 * qq + 4], Y0[8 * qq + 5]); w.w = cvtpk_c(Y0[8 * qq + 6], Y0[8 * qq + 7]); RC_ST(RC_Y0 + x * 32 + qq * 16, w); }
    LDS_WAIT();
}
__device__ __forceinline__ void rc_pass1_ret(Frame& F, int wid, int nw, int c0, int nc) {
    LAS unsigned char* wlds = F.lds + F.wave * RC_WLDS;
    const int x = F.lane;
    const bf16* P = (const bf16*)(FWS + WS_PROJ);
    for (int it2 = wid; it2 < 16 * nc; it2 += nw) {
        const int ru = it2 / nc, c = c0 + it2 % nc, it = ru * RC_NCH + c, b = ru >> 3, h = (ru >> 1) & 3, half = ru & 1; const float gamma = 1.0f - exp2f(-5.0f - (float)h);
        float Kt[16], Rt[16], vv[16]; float W = 1.0f;
        const bf16* p0 = P + (size_t)(b * SEQ + c * 16) * IN_PAD;
#pragma unroll
        for (int t = 0; t < 16; ++t) { const bf16* p = p0 + (size_t)t * IN_PAD;
            const float rr = bf2f(p[C_RQ + h * 64 + x]), kk = bf2f(p[C_RK + h * 64 + x]) * 0.125f; vv[t] = bf2f(p[C_RV + h * 128 + half * 64 + x]);
            W *= gamma; const float iw = __builtin_amdgcn_rcpf(W); Kt[t] = kk * iw; Rt[t] = rr * W; }
        rc_core_ret(F, wlds, Kt, Rt, vv, W, (unsigned)(16 * RC_NCH + it) * RC_REC);
    }
}
__device__ __forceinline__ void rwkv_prep_mfma(Frame& F, int l, int first, int stride) {
    LAS unsigned char* wlds = F.lds + F.wave * RC_WLDS;
    LAS bf16* CODES = (LAS bf16*)(F.lds + RC_CODES_OFF);
    LAS float* ST = (LAS float*)wlds;
    const bf16* P = (const bf16*)(FWS + WS_PROJ);
    const float* mu = F.in[F.zz + 4] + l * RWC;
    const bf16* WT = (const bf16*)(FWS + WS_RWW + (size_t)l * 448 * 512 * 2);
    float* RW = (float*)(FWS + WS_RW);
    const int x = F.lane, h = F.wave, ch = h * 64 + x, fr = x & 15, q = x >> 4;
    for (int item = first; item < NB * RC_NCH; item += stride) {
        const int b = item >> 8, c = item & 255; const size_t row0 = (size_t)b * SEQ + c * 16; const int t0 = c * 16;
        const bf16* prc = P + row0 * IN_PAD + C_RW + ch;
        unsigned short nr_[4], nk_[4], nv_[4]; float pvr = 0.f, pvk = 0.f, pvv = 0.f;
        if (t0 > 0) { pvr = bf2f(prc[-IN_PAD]); pvk = bf2f(prc[512 - IN_PAD]); pvv = bf2f(prc[1024 - IN_PAD]); }
#pragma unroll
        for (int tt = 0; tt < 4; ++tt) { nr_[tt] = prc[(size_t)tt * IN_PAD]; nk_[tt] = prc[(size_t)tt * IN_PAD + 512]; nv_[tt] = prc[(size_t)tt * IN_PAD + 1024]; }
        const float mur = mu[ch], muk = mu[512 + ch], muv = mu[1024 + ch];
        const float w0c = F.in[F.zz + 5][l * 512 + ch], a0c = F.in[F.zz + 7][l * 512 + ch], kkc = F.in[F.zz + 10][l * 512 + ch], kac = F.in[F.zz + 11][l * 512 + ch], rkc = F.in[F.zz + 12][l * 512 + ch];
#pragma unroll 7
        for (int idx = F.tid; idx < 16 * 448; idx += NTHR) { const int tk = idx / 448, cc = idx - tk * 448;
            float val = lerp_bf(P, row0 + tk, C_RW + 1536 + cc, (t0 + tk) > 0, mu[1536 + cc]);
            if (cc < 96) val = 1.0f - 2.0f * __builtin_amdgcn_rcpf(1.0f + __expf(2.0f * val));
            else if (cc >= 192) val = sigmoidf_(val);
            CODES[tk * RC_CSTRIDE + cc] = cvt1_c(val); }
        __syncthreads();
        f32x4 accW[4], accA[4], accG[4];
#pragma unroll
        for (int ct = 0; ct < 4; ++ct) { accW[ct] = (f32x4){0.f, 0.f, 0.f, 0.f}; accA[ct] = accW[ct]; accG[ct] = accW[ct]; }
        { bf16x8 bw[3][4];
#pragma unroll
          for (int ks = 0; ks < 3; ++ks)
#pragma unroll
              for (int ct = 0; ct < 4; ++ct) bw[ks][ct] = *(const bf16x8*)(WT + (size_t)(h * 64 + ct * 16 + fr) * 96 + ks * 32 + q * 8);
#pragma unroll
          for (int ks = 0; ks < 3; ++ks) { const bf16x8 aw = *(const LAS bf16x8*)(CODES + fr * RC_CSTRIDE + ks * 32 + q * 8);
#pragma unroll
              for (int ct = 0; ct < 4; ++ct) accW[ct] = __builtin_amdgcn_mfma_f32_16x16x32_bf16(aw, bw[ks][ct], accW[ct], 0, 0, 0); } }
        asm volatile("" ::: "memory");
        { bf16x8 ba[3][4];
#pragma unroll
          for (int ks = 0; ks < 3; ++ks)
#pragma unroll
              for (int ct = 0; ct < 4; ++ct) ba[ks][ct] = *(const bf16x8*)(WT + 512 * 96 + (size_t)(h * 64 + ct * 16 + fr) * 96 + ks * 32 + q * 8);
#pragma unroll
          for (int ks = 0; ks < 3; ++ks) { const bf16x8 aa = *(const LAS bf16x8*)(CODES + fr * RC_CSTRIDE + 96 + ks * 32 + q * 8);
#pragma unroll
              for (int ct = 0; ct < 4; ++ct) accA[ct] = __builtin_amdgcn_mfma_f32_16x16x32_bf16(aa, ba[ks][ct], accA[ct], 0, 0, 0); } }
        asm volatile("" ::: "memory");
#pragma unroll
        for (int hf = 0; hf < 2; ++hf) { bf16x8 bg[4][4];
#pragma unroll
            for (int k4 = 0; k4 < 4; ++k4)
#pragma unroll
                for (int ct = 0; ct < 4; ++ct) bg[k4][ct] = *(const bf16x8*)(WT + 2 * 512 * 96 + (size_t)(h * 64 + ct * 16 + fr) * 256 + (hf * 4 + k4) * 32 + q * 8);
#pragma unroll
            for (int k4 = 0; k4 < 4; ++k4) { const bf16x8 ag = *(const LAS bf16x8*)(CODES + fr * RC_CSTRIDE + 192 + (hf * 4 + k4) * 32 + q * 8);
#pragma unroll
                for (int ct = 0; ct < 4; ++ct) accG[ct] = __builtin_amdgcn_mfma_f32_16x16x32_bf16(ag, bg[k4][ct], accG[ct], 0, 0, 0); }
            asm volatile("" ::: "memory"); }
#pragma unroll
        for (int ct = 0; ct < 4; ++ct)
#pragma unroll
            for (int rg = 0; rg < 4; ++rg) { const int o = (4 * q + rg) * 64 + ct * 16 + fr; ST[o] = accW[ct][rg]; ST[1024 + o] = accA[ct][rg]; ST[2048 + o] = accG[ct][rg]; }
        float* gpw = RW + row0 * 512 + ch;
        bf16* gp = (bf16*)(FWS + WS_RW + 32 * MiB) + row0 * 512 + ch;
        for (int g = 0; g < 4; ++g) {
            unsigned short cr_[4], ck_[4], cv_[4];
#pragma unroll
            for (int tt = 0; tt < 4; ++tt) { cr_[tt] = nr_[tt]; ck_[tt] = nk_[tt]; cv_[tt] = nv_[tt]; }
            if (g < 3) {
#pragma unroll
                for (int tt = 0; tt < 4; ++tt) { const size_t ro = (size_t)(4 * g + 4 + tt) * IN_PAD; nr_[tt] = prc[ro]; nk_[tt] = prc[ro + 512]; nv_[tt] = prc[ro + 1024]; } }
#pragma unroll
          for (int tt = 0; tt < 4; ++tt) { const int t = 4 * g + tt;
            const float cr = bf2f(cr_[tt]), ck = bf2f(ck_[tt]), cv = bf2f(cv_[tt]);
            const float rr = cr + (pvr - cr) * mur, kk0 = ck + (pvk - ck) * muk, vv = cv + (pvv - cv) * muv;
            pvr = cr; pvk = ck; pvv = cv;
            const float z = -(w0c + ST[t * 64 + x]);
            const float sp = fmaxf(z, 0.f) + __logf(1.0f + __expf(-fabsf(z)));
            const float decay = __expf(-__expf(-sp - 0.5f));
            const float a = sigmoidf_(a0c + ST[1024 + t * 64 + x]);
            const float gg = ST[2048 + t * 64 + x];
            const float kkv = kk0 * kkc;
            const float nrm = __builtin_amdgcn_sqrtf(wave_sum(kkv * kkv));
            const float kap = kkv * __builtin_amdgcn_rcpf(fmaxf(nrm, 1e-12f));
            const float kp = kk0 * (1.0f + (a - 1.0f) * kac);
            const float bsum = wave_sum(rr * kp * rkc);
            gpw[0] = decay; gpw += 512;
            gp[0 * RWA] = cvt1_c(rr); gp[1 * RWA] = cvt1_c(kp); gp[2 * RWA] = cvt1_c(vv); gp[3 * RWA] = cvt1_c(kap); gp[4 * RWA] = cvt1_c(kap * a); gp[5 * RWA] = cvt1_c(gg); gp[6 * RWA] = cvt1_c(bsum * vv); gp += 512; } }
        LDS_WAIT();
        __syncthreads();
    }
}
constexpr int RC_SLOT = 15360, RC_YST = 8 * RC_SLOT  ;
__device__ __forceinline__ void rc_pass2(Frame& F, int u, int cb, int ce, bool first, bool last) {
    const unsigned char* rec = FWS + WS_REC + (size_t)u * RC_NCH * RC_REC;
    const int lane = F.lane;
    const int NIT = (ce - cb) / 2;
    bf16* Yg;
    if (u < 16) Yg = (bf16*)(FWS + WS_Y) + (size_t)((u >> 3) * SEQ) * 512 + (u & 7) * 64;
    else { const int ru = u - 16; Yg = (bf16*)(FWS + WS_RETO) + (size_t)((ru >> 3) * SEQ) * 512 + ((ru >> 1) & 3) * 128 + (ru & 1) * 64; }
#define RC_BARRIER() __builtin_amdgcn_s_barrier()
    if (F.wave == 7) {
        unsigned t0_ = 0u, t1_ = 0u, t2_ = 0u, t3_ = 0u;
        for (int cq = cb; cq < cb + 24 && cq < ce; cq += 2) { const unsigned char* pa = rec + (size_t)cq * RC_REC + lane * 128; const unsigned char* pb = pa + 8192; const unsigned char* pc = pa + RC_REC; const unsigned char* pd = pb + RC_REC;
            asm volatile("global_load_dword %0, %4, off\n\tglobal_load_dword %1, %5, off\n\tglobal_load_dword %2, %6, off\n\tglobal_load_dword %3, %7, off" : "+v"(t0_), "+v"(t1_), "+v"(t2_), "+v"(t3_) : "v"(pa), "v"(pb), "v"(pc), "v"(pd) : "memory"); }
        RC_BARRIER();
        for (int i = 0; i < NIT; ++i) {
            const int cp = cb + 2 * i + 24;
            if (cp < ce) { const unsigned char* pa = rec + (size_t)cp * RC_REC + lane * 128; const unsigned char* pb = pa + 8192; const unsigned char* pc = pa + RC_REC; const unsigned char* pd = pb + RC_REC;
                asm volatile("global_load_dword %0, %4, off\n\tglobal_load_dword %1, %5, off\n\tglobal_load_dword %2, %6, off\n\tglobal_load_dword %3, %7, off" : "+v"(t0_), "+v"(t1_), "+v"(t2_), "+v"(t3_) : "v"(pa), "v"(pb), "v"(pc), "v"(pd) : "memory"); }
            if (i > 0) {
                const LAS unsigned char* yb = F.lds + RC_YST + ((i - 1) & 1) * 4096;
#pragma unroll
                for (int j = 0; j < 4; ++j) { const v4u w = *(const LAS v4u*)(yb + j * 1024 + lane * 16);
                    *(v4u*)(Yg + (size_t)((cb + 2 * i - 2) * 16 + j * 8 + (lane >> 3)) * 512 + (lane & 7) * 8) = w; } }
            RC_BARRIER();
        }
        { const LAS unsigned char* yb = F.lds + RC_YST + ((NIT - 1) & 1) * 4096;
#pragma unroll
          for (int j = 0; j < 4; ++j) { const v4u w = *(const LAS v4u*)(yb + j * 1024 + lane * 16);
              *(v4u*)(Yg + (size_t)((cb + 2 * NIT - 2) * 16 + j * 8 + (lane >> 3)) * 512 + (lane & 7) * 8) = w; } }
        asm volatile("s_waitcnt vmcnt(0)" ::: "memory");
        asm volatile("" :: "v"(t0_), "v"(t1_), "v"(t2_), "v"(t3_));
    } else if (F.wave >= 4) {
        const int lw = F.wave - 4;
        const int p0_ = lw == 0 ? 8 : (lw == 1 ? 11 : 13), np_ = lw == 0 ? 3 : 2;
#define RC_ISSUE(c) do { _Pragma("unroll") for (int i_ = 0; i_ < 3; ++i_) { if (i_ < np_) \
            __builtin_amdgcn_global_load_lds((const unsigned*)(rec + (size_t)(c) * RC_REC + (p0_ + i_) * 1024 + lane * 16), (LAS unsigned*)(F.lds + ((c) & 7) * RC_SLOT + (p0_ + i_) * 1024), 16, 0, 0); } } while (0)
#define RC_WAIT4() do { if (lw == 0) asm volatile("s_waitcnt vmcnt(12)" ::: "memory"); else asm volatile("s_waitcnt vmcnt(8)" ::: "memory"); } while (0)
        for (int c = cb; c < cb + 6; ++c) RC_ISSUE(c);
        RC_WAIT4();
        RC_BARRIER();
        for (int i = 0; i < NIT; ++i) {
            if (cb + 2 * i + 7 < ce) { RC_ISSUE(cb + 2 * i + 6); RC_ISSUE(cb + 2 * i + 7); RC_WAIT4(); }
            else asm volatile("s_waitcnt vmcnt(0)" ::: "memory");
            RC_BARRIER();
        }
#undef RC_ISSUE
#undef RC_WAIT4
    } else {
        const int ib = F.wave, fr = lane & 15, q = lane >> 4;
#define RC_ISSUE1(c) do { __builtin_amdgcn_global_load_lds((const unsigned*)(rec + (size_t)(c) * RC_REC + (2 * ib) * 1024 + lane * 16), (LAS unsigned*)(F.lds + ((c) & 7) * RC_SLOT + (2 * ib) * 1024), 16, 0, 0); \
        __builtin_amdgcn_global_load_lds((const unsigned*)(rec + (size_t)(c) * RC_REC + (2 * ib + 1) * 1024 + lane * 16), (LAS unsigned*)(F.lds + ((c) & 7) * RC_SLOT + (2 * ib + 1) * 1024), 16, 0, 0); } while (0)
        f32x4* sv = (f32x4*)(FWS + WS_CTL + 262144) + (size_t)((u * 4 + ib) * 4 + 0) * 64 + lane;
        f32x4 sT[4];
#pragma unroll
        for (int jb = 0; jb < 4; ++jb) sT[jb] = first ? (f32x4){0.f, 0.f, 0.f, 0.f} : sv[jb * 64];
        asm volatile("s_waitcnt vmcnt(0)" ::: "memory");
        for (int c = cb; c < cb + 6; ++c) RC_ISSUE1(c);
        asm volatile("s_waitcnt vmcnt(8)" ::: "memory");
        RC_BARRIER();
        for (int i = 0; i < NIT; ++i) {
            bf16x8 aU0[2], aU1[2], aY0[2], aY1[2], bk[2][4]; f32x4 dd[2][4]; v2u vp[2], u0[2], y0[2];
#pragma unroll
            for (int h = 0; h < 2; ++h) { const LAS unsigned char* slot = F.lds + ((cb + 2 * i + h) & 7) * RC_SLOT;
                aU0[h] = *(const LAS bf16x8*)(slot + RC_AR + q * 256 + fr * 16); aU1[h] = *(const LAS bf16x8*)(slot + RC_AR + 1024 + q * 256 + fr * 16);
                aY0[h] = *(const LAS bf16x8*)(slot + RC_AR + 2048 + q * 256 + fr * 16); aY1[h] = *(const LAS bf16x8*)(slot + RC_AR + 3072 + q * 256 + fr * 16);
                u0[h] = *(const LAS v2u*)(slot + RC_U0 + (16 * ib + fr) * 32 + q * 8); vp[h] = *(const LAS v2u*)(slot + RC_VP + (16 * ib + fr) * 32 + q * 8);
#pragma unroll
                for (int jb = 0; jb < 4; ++jb) { bk[h][jb] = *(const LAS bf16x8*)(slot + RC_BK + (16 * jb + fr) * 64 + q * 16); dd[h][jb] = *(const LAS f32x4*)(slot + RC_D + (16 * jb + 4 * q) * 4); }
                y0[h] = *(const LAS v2u*)(slot + RC_Y0 + (16 * ib + fr) * 32 + q * 8); }
            LAS bf16* yst = (LAS bf16*)(F.lds + RC_YST + (i & 1) * 4096);
#pragma unroll
            for (int h = 0; h < 2; ++h) {
                v4u s0, s1;
                s0.x = cvtpk_c(sT[0][0], sT[0][1]); s0.y = cvtpk_c(sT[0][2], sT[0][3]); s0.z = cvtpk_c(sT[1][0], sT[1][1]); s0.w = cvtpk_c(sT[1][2], sT[1][3]);
                s1.x = cvtpk_c(sT[2][0], sT[2][1]); s1.y = cvtpk_c(sT[2][2], sT[2][3]); s1.z = cvtpk_c(sT[3][0], sT[3][1]); s1.w = cvtpk_c(sT[3][2], sT[3][3]);
                const bf16x8 sb0 = __builtin_bit_cast(bf16x8, s0), sb1 = __builtin_bit_cast(bf16x8, s1);
                f32x4 zU = (f32x4){0.f, 0.f, 0.f, 0.f}, zY = (f32x4){0.f, 0.f, 0.f, 0.f};
                zU = __builtin_amdgcn_mfma_f32_16x16x32_bf16(aU0[h], sb0, zU, 0, 0, 0); zU = __builtin_amdgcn_mfma_f32_16x16x32_bf16(aU1[h], sb1, zU, 0, 0, 0);
                const float U0_ = zU[0] + bflo(u0[h].x), U1_ = zU[1] + bfhi(u0[h].x), U2_ = zU[2] + bflo(u0[h].y), U3_ = zU[3] + bfhi(u0[h].y);
                v4u ubw; ubw.x = cvtpk_c(U0_, U1_); ubw.y = cvtpk_c(U2_, U3_); ubw.z = vp[h].x; ubw.w = vp[h].y;
                const bf16x8 ub = __builtin_bit_cast(bf16x8, ubw);
#pragma unroll
                for (int jb = 0; jb < 4; ++jb) sT[jb] = __builtin_amdgcn_mfma_f32_16x16x32_bf16(bk[h][jb], ub, sT[jb] * dd[h][jb], 0, 0, 0);
                zY = __builtin_amdgcn_mfma_f32_16x16x32_bf16(aY0[h], sb0, zY, 0, 0, 0); zY = __builtin_amdgcn_mfma_f32_16x16x32_bf16(aY1[h], sb1, zY, 0, 0, 0);
                LAS bf16* yp = yst + h * 1024 + (4 * q) * 64 + 16 * ib + fr;
                yp[0] = cvt1_c(zY[0] + bflo(y0[h].x)); yp[64] = cvt1_c(zY[1] + bfhi(y0[h].x)); yp[128] = cvt1_c(zY[2] + bflo(y0[h].y)); yp[192] = cvt1_c(zY[3] + bfhi(y0[h].y));
            }
            if (cb + 2 * i + 7 < ce) { RC_ISSUE1(cb + 2 * i + 6); RC_ISSUE1(cb + 2 * i + 7); asm volatile("s_waitcnt vmcnt(8) lgkmcnt(0)" ::: "memory"); } else asm volatile("s_waitcnt vmcnt(0) lgkmcnt(0)" ::: "memory");
            RC_BARRIER();
        }
        if (!last) {
#pragma unroll
            for (int jb = 0; jb < 4; ++jb) sv[jb * 64] = sT[jb]; }
#undef RC_ISSUE1
    }
#undef RC_BARRIER
    asm volatile("s_waitcnt vmcnt(0) lgkmcnt(0)" ::: "memory");
    __syncthreads();
}
__device__ __forceinline__ void sub_arrive(Frame& F, unsigned* cnt) {
    asm volatile("s_waitcnt vmcnt(0)" ::: "memory");
    __syncthreads();
    if (F.tid == 0) { __builtin_amdgcn_fence(__ATOMIC_RELEASE, "agent"); asm volatile("s_waitcnt vmcnt(0)" ::: "memory"); __hip_atomic_fetch_add(cnt, 1u, __ATOMIC_RELAXED, __HIP_MEMORY_SCOPE_AGENT); }
}
__device__ __forceinline__ void xcd_publish(Frame& F, unsigned* local, unsigned nlocal, unsigned* global) {
    asm volatile("s_waitcnt vmcnt(0)" ::: "memory");
    __syncthreads();
    if (F.tid == 0) {
        const unsigned old = __hip_atomic_fetch_add(local, 1u, __ATOMIC_RELAXED, __HIP_MEMORY_SCOPE_AGENT);
        if (old + 1u == nlocal) { __builtin_amdgcn_fence(__ATOMIC_RELEASE, "agent"); asm volatile("s_waitcnt vmcnt(0)" ::: "memory"); __hip_atomic_fetch_add(global, nlocal, __ATOMIC_RELAXED, __HIP_MEMORY_SCOPE_AGENT); }
    }
}
__device__ __forceinline__ void sub_wait(Frame& F, unsigned* cnt, unsigned target) {
    if (F.tid == 0) { unsigned sp = 0u;
        while (__hip_atomic_load(cnt, __ATOMIC_RELAXED, __HIP_MEMORY_SCOPE_AGENT) < target) { __builtin_amdgcn_s_sleep(2); if (++sp > (1u << 24)) break; }
        __builtin_amdgcn_fence(__ATOMIC_ACQUIRE, "agent"); asm volatile("s_waitcnt vmcnt(0)" ::: "memory"); }
    __syncthreads();
}
__device__ __forceinline__ void sub_barrier(Frame& F, unsigned* cnt, unsigned target) {
    asm volatile("s_waitcnt vmcnt(0)" ::: "memory");
    __syncthreads();
    if (F.tid == 0) {
        __builtin_amdgcn_fence(__ATOMIC_RELEASE, "agent");
        asm volatile("s_waitcnt vmcnt(0)" ::: "memory");
        __hip_atomic_fetch_add(cnt, 1u, __ATOMIC_RELAXED, __HIP_MEMORY_SCOPE_AGENT);
        unsigned sp = 0u;
        while (__hip_atomic_load(cnt, __ATOMIC_RELAXED, __HIP_MEMORY_SCOPE_AGENT) < target) { __builtin_amdgcn_s_sleep(2); if (++sp > (1u << 24)) break; }
        __builtin_amdgcn_fence(__ATOMIC_ACQUIRE, "agent");
        asm volatile("s_waitcnt vmcnt(0)" ::: "memory");
    }
    __syncthreads();
}
__device__ __forceinline__ void mixer_post(Frame& F, int l, int gw, int NGW) {
    const bf16* P = (const bf16*)(FWS + WS_PROJ);
    const bf16* RH = (const bf16*)(FWS + WS_RW + 32 * MiB);
    const float* RW = (const float*)(FWS + WS_RW);
    const bf16* Y = (const bf16*)(FWS + WS_Y);
    const bf16* RO = (const bf16*)(FWS + WS_RETO);
    bf16* MX = (bf16*)(FWS + WS_MIXED);
    const float* ln_w = F.in[F.zz + 13] + l * 512; const float* ln_b = F.in[F.zz + 14] + l * 512;
    const int lane = F.lane;
    for (int m = gw; m < MROWS; m += NGW) {
        const size_t o = (size_t)m * 512;
        float y[8], s1[8], s2[8], bon[8], gat[8]; f32x2 ov[4]; float s3[4]; unsigned gw2[4];
#pragma unroll
        for (int h = 0; h < 8; ++h) { const int c = h * 64 + lane; y[h] = bf2f(Y[o + c]); bon[h] = bf2f(RH[6 * RWA + o + c]); gat[h] = bf2f(RH[5 * RWA + o + c]); s1[h] = y[h]; }
#pragma unroll
        for (int h = 0; h < 4; ++h) { const int c = h * 128 + 2 * lane; { const unsigned rw_ = *(const unsigned*)(RO + o + c); ov[h].x = bflo(rw_); ov[h].y = bfhi(rw_); } gw2[h] = *(const unsigned*)(P + (size_t)m * IN_PAD + C_RG + c); s3[h] = ov[h].x * ov[h].x + ov[h].y * ov[h].y; }
#pragma unroll
        for (int h = 0; h < 8; ++h) { s1[h] = dpp_add<0xB1>(s1[h]); s1[h] = dpp_add<0x4E>(s1[h]); s1[h] = dpp_add<0x141>(s1[h]); s1[h] = dpp_add<0x140>(s1[h]); }
#pragma unroll
        for (int h = 0; h < 4; ++h) { s3[h] = dpp_add<0xB1>(s3[h]); s3[h] = dpp_add<0x4E>(s3[h]); s3[h] = dpp_add<0x141>(s3[h]); s3[h] = dpp_add<0x140>(s3[h]); }
#pragma unroll
        for (int h = 0; h < 8; ++h) s1[h] = xsum32(xsum16(s1[h]));
#pragma unroll
        for (int h = 0; h < 4; ++h) s3[h] = xsum32(xsum16(s3[h]));
#pragma unroll
        for (int h = 0; h < 8; ++h) { const float d = y[h] - s1[h] * (1.0f / 64.0f); y[h] = d; s2[h] = d * d; }
#pragma unroll
        for (int h = 0; h < 8; ++h) { s2[h] = dpp_add<0xB1>(s2[h]); s2[h] = dpp_add<0x4E>(s2[h]); s2[h] = dpp_add<0x141>(s2[h]); s2[h] = dpp_add<0x140>(s2[h]); }
#pragma unroll
        for (int h = 0; h < 8; ++h) s2[h] = xsum32(xsum16(s2[h]));
#pragma unroll
        for (int h = 0; h < 8; ++h) { const int c = h * 64 + lane;
            const float yn = y[h] * __builtin_amdgcn_rsqf(s2[h] * (1.0f / 64.0f) + GN_EPS) * ln_w[c] + ln_b[c];
            MX[(size_t)m * DM + 512 + c] = (bf16)f2bf((yn + bon[h]) * gat[h]); }
#pragma unroll
        for (int h = 0; h < 4; ++h) { const int c = h * 128 + 2 * lane;
            const float rn = __builtin_amdgcn_rsqf(s3[h] * (1.0f / 128.0f) + NORM_EPS);
            const float g0 = bflo(gw2[h]), g1 = bfhi(gw2[h]);
            *(unsigned*)(MX + (size_t)m * DM + c) = pk2(ov[h].x * rn * g0 * sigmoidf_(g0), ov[h].y * rn * g1 * sigmoidf_(g1)); }
    }
}
__device__ __forceinline__ void conv_gate_phase(Frame& F, int l) {
    const bf16* U = (const bf16*)(FWS + WS_U);
    bf16* A = (bf16*)(FWS + WS_ACT);
    const float* cw = F.in[F.zz + 16] + (size_t)l * 3 * UPC; const float* cb = F.in[F.zz + 17] + (size_t)l * UPC;
    constexpr int NCG = DFF / 8, NRC = MROWS / 16;
    for (int it = F.vcu * NTHR + F.tid; it < NCG * NRC; it += F.G * NTHR) {
        const int cg = it % NCG, rc = it / NCG, c0 = cg * 8, row0 = rc * 16, t0 = row0 & (SEQ - 1);
        float wv[3][8], wg[3][8], bv[8], bg[8];
#pragma unroll
        for (int j = 0; j < 3; ++j)
#pragma unroll
            for (int e = 0; e < 8; ++e) { wv[j][e] = cw[j * UPC + c0 + e]; wg[j][e] = cw[j * UPC + DFF + c0 + e]; }
#pragma unroll
        for (int e = 0; e < 8; ++e) { bv[e] = cb[c0 + e]; bg[e] = cb[DFF + c0 + e]; }
        v4u v0 = {0u, 0u, 0u, 0u}, v1 = v0, g0 = v0, g1 = v0;
        if (t0 > 0) { v0 = *(const v4u*)(U + (size_t)(row0 - 2) * UPC + c0); v1 = *(const v4u*)(U + (size_t)(row0 - 1) * UPC + c0);
                      g0 = *(const v4u*)(U + (size_t)(row0 - 2) * UPC + DFF + c0); g1 = *(const v4u*)(U + (size_t)(row0 - 1) * UPC + DFF + c0); }
        for (int r = 0; r < 16; ++r) {
            const v4u v2 = *(const v4u*)(U + (size_t)(row0 + r) * UPC + c0), g2 = *(const v4u*)(U + (size_t)(row0 + r) * UPC + DFF + c0);
            float ov[8];
#pragma unroll
            for (int e = 0; e < 4; ++e) {
                const float va = wv[0][2 * e] * bflo(v0[e]) + wv[1][2 * e] * bflo(v1[e]) + wv[2][2 * e] * bflo(v2[e]) + bv[2 * e];
                const float vb = wv[0][2 * e + 1] * bfhi(v0[e]) + wv[1][2 * e + 1] * bfhi(v1[e]) + wv[2][2 * e + 1] * bfhi(v2[e]) + bv[2 * e + 1];
                const float ga = wg[0][2 * e] * bflo(g0[e]) + wg[1][2 * e] * bflo(g1[e]) + wg[2][2 * e] * bflo(g2[e]) + bg[2 * e];
                const float gb = wg[0][2 * e + 1] * bfhi(g0[e]) + wg[1][2 * e + 1] * bfhi(g1[e]) + wg[2][2 * e + 1] * bfhi(g2[e]) + bg[2 * e + 1];
                ov[2 * e] = ga * sigmoidf_(ga) * va; ov[2 * e + 1] = gb * sigmoidf_(gb) * vb; }
            v4u w; w.x = pk2(ov[0], ov[1]); w.y = pk2(ov[2], ov[3]); w.z = pk2(ov[4], ov[5]); w.w = pk2(ov[6], ov[7]);
            *(v4u*)(A + (size_t)(row0 + r) * DFF + c0) = w;
            v0 = v1; v1 = v2; g0 = g1; g1 = g2;
        }
    }
}

__device__ __forceinline__ void conv_fixup_phase(Frame& F, int l) {
    const float* H = (const float*)(FWS + WS_HALO);
    bf16* A = (bf16*)(FWS + WS_ACT);
    const float* cw = F.in[F.zz + 16] + (size_t)l * 3 * UPC; const float* cb = F.in[F.zz + 17] + (size_t)l * UPC;
    constexpr int NQ = DFF / 4;
    for (int it = F.vcu * NTHR + F.tid; it < (MROWS / 64) * 2 * NQ; it += F.G * NTHR) {
        const int c = (it % NQ) * 4, gr = it / NQ, r = gr & 1, g = gr >> 1, colp = (c >> 7) * 256 + (c & 127);
        const bool hasprev = (g & 63) != 0;
        const float* hg = H + (size_t)g * 4 * UPC + colp; const float* hp = hg - (size_t)4 * UPC;
        const f32x4 z = {0.f, 0.f, 0.f, 0.f};
        f32x4 v0, v1, v2, g0, g1, g2;
        v0 = *(const f32x4*)(hg + (size_t)r * UPC); g0 = *(const f32x4*)(hg + (size_t)r * UPC + 128);
        if (r == 1) { v1 = *(const f32x4*)hg; g1 = *(const f32x4*)(hg + 128); v2 = hasprev ? *(const f32x4*)(hp + (size_t)3 * UPC) : z; g2 = hasprev ? *(const f32x4*)(hp + (size_t)3 * UPC + 128) : z; }
        else { v1 = hasprev ? *(const f32x4*)(hp + (size_t)3 * UPC) : z; g1 = hasprev ? *(const f32x4*)(hp + (size_t)3 * UPC + 128) : z; v2 = hasprev ? *(const f32x4*)(hp + (size_t)2 * UPC) : z; g2 = hasprev ? *(const f32x4*)(hp + (size_t)2 * UPC + 128) : z; }
        const f32x4 cv = *(const f32x4*)(cw + c) * v2 + *(const f32x4*)(cw + UPC + c) * v1 + *(const f32x4*)(cw + 2 * UPC + c) * v0 + *(const f32x4*)(cb + c);
        const f32x4 cg = *(const f32x4*)(cw + DFF + c) * g2 + *(const f32x4*)(cw + UPC + DFF + c) * g1 + *(const f32x4*)(cw + 2 * UPC + DFF + c) * g0 + *(const f32x4*)(cb + DFF + c);
        v2u w; w.x = pk2(cg[0] * sigmoidf_(cg[0]) * cv[0], cg[1] * sigmoidf_(cg[1]) * cv[1]); w.y = pk2(cg[2] * sigmoidf_(cg[2]) * cv[2], cg[3] * sigmoidf_(cg[3]) * cv[3]);
        *(v2u*)(A + (size_t)(64 * g + r) * DFF + c) = w;
    }
}

#define GRID_BAR() do { xcd_barrier(bar, tid_from_wave(F.wave)); asm volatile("" : "+s"(F.wave), "+s"(F.vcu), "+s"(F.G)); F.tid = tid_from_wave(F.wave); F.lane = F.tid & 63; { unsigned z_ = 0u; asm volatile("" : "+v"(z_)); F.zz = __builtin_amdgcn_readfirstlane(z_); } } while (0)
#define XB ((bf16*)(FWS + WS_X))
#define HB ((bf16*)(FWS + WS_H))
#define PROJ ((bf16*)(FWS + WS_PROJ))
#define MIXED ((bf16*)(FWS + WS_MIXED))
#define UB ((bf16*)(FWS + WS_U))
#define ACT ((bf16*)(FWS + WS_ACT))
#define MOD ((const float*)(FWS + WS_MOD))
template <int l>
__device__ __forceinline__ void layer_fwd(Frame& F, const XcdBarrier& bar) {
#define modl (MOD + (size_t)l * 2 * 12288)
#define wl (FWS + WS_W + (size_t)l * W_LAYER)
        if (l == 0) norm_phase<0, true>(F, F.in[F.zz + 0], HB, F.in[F.zz + 21] + l * DM, modl + 0 * DM, modl + 1 * DM);
        else norm_phase<0, false>(F, XB, HB, F.in[F.zz + 21] + l * DM, modl + 0 * DM, modl + 1 * DM);
        GRID_BAR();
        { pg8::Gemm g{HB, (const bf16*)(wl + W_IN), MROWS, IN_PAD, DM}; pg8::StaticOrder S; S.init(MROWS, IN_PAD, F.G, (int)blockIdx.x);
          pg8::EpiBf16 E{PROJ, IN_PAD};
          pg8::gemm_phase<pg8::EpiBf16, pg8::StaticOrder, true, true>(F.lds, g, S, E, F.wave); }
        if (F.G == 256 && blockIdx.x >= 64) convert_gap(F, l, CV_IN, l == 0 ? CV_C1 : CV_OUT + CV_UP, ((int)blockIdx.x - 64) * NWAVES + F.wave, 192 * NWAVES, CV_N1);
        GRID_BAR();
        rwkv_prep_mfma(F, l, F.vcu, F.G);
        moba_kmean(F);
        if (F.tid == 0 && (F.vcu & 31) >= 16) {
            unsigned* xl_ = (unsigned*)(FWS + WS_CTL) + CW_SUB + 1024 + 1024 * l + 64 * bar.x; const int rv_ = (F.vcu >> 5) * 16 + (F.vcu & 31) - 16;
            __hip_atomic_fetch_add(xl_ + 8, 1u, __ATOMIC_RELAXED, __HIP_MEMORY_SCOPE_AGENT);
            if (!((rv_ & 3) == 0 && (rv_ >> 2) < RC_UNITS)) __hip_atomic_fetch_add(xl_, 1u, __ATOMIC_RELAXED, __HIP_MEMORY_SCOPE_AGENT); }
        GRID_BAR();
        const int xg_ = F.vcu >> 5, xj_ = F.vcu & 31, mi_ = xg_ * 16 + xj_;
        if (xj_ < 16) { moba_item(F, mi_ >> 3, 15 - (mi_ & 7), mi_ & 7);
            asm volatile("" : "+s"(F.wave)); F.tid = tid_from_wave(F.wave); F.lane = F.tid & 63;
            if (F.G == 256 && l == 0) { constexpr int nr_ = CV_LAYER - (CV_IN + CV_C1); LAS float* scr_ = (LAS float*)(F.lds + F.wave * 16384);
                for (int j = 0; j < CV_N3; ++j) { const int s_ = mi_ * NWAVES + F.wave + 128 * NWAVES * j;
                    if (s_ < nr_) convert_item(F, l * CV_LAYER + CV_IN + CV_C1 + s_, scr_);
                    else if (l == 0 && s_ - nr_ < CV_IN - CV_C2) convert_item(F, CV_LAYER + CV_C2 + (s_ - nr_), scr_); } }
            sub_wait(F, (unsigned*)(FWS + WS_CTL) + CW_SUB + 128 * l + 64, (unsigned)(F.G / 2));
        }
        else {
            const int rv = xg_ * 16 + (xj_ - 16), nrc = F.G / 2;
            unsigned* sub = (unsigned*)(FWS + WS_CTL) + CW_SUB + 128 * l;
            unsigned* grp = (unsigned*)(FWS + WS_CTL) + CW_SUB + 256 + 128 * l;
            unsigned* xl = (unsigned*)(FWS + WS_CTL) + CW_SUB + 1024 + 1024 * l + 64 * bar.x;
            const bool p2cu = (rv & 3) == 0 && (rv >> 2) < RC_UNITS;
            const unsigned nrl = __builtin_amdgcn_readfirstlane(__hip_atomic_load(xl + 8, __ATOMIC_RELAXED, __HIP_MEMORY_SCOPE_AGENT));
            rc_pass1_rwkv(F, rv * NWAVES + F.wave, nrc * NWAVES, 0, 64);
            rc_pass1_ret(F, rv * NWAVES + F.wave, nrc * NWAVES, 0, 64);
            xcd_publish(F, xl + 9, nrl, sub); sub_wait(F, sub, (unsigned)nrc);
            if (p2cu) {
                for (int sg = 0; sg < 5; ++sg) {
                    if (sg > 0) sub_wait(F, grp + 32 * (sg - 1), (unsigned)(nrc - RC_UNITS));
                    rc_pass2(F, rv >> 2, sg == 0 ? 0 : 16 + 48 * sg, 64 + 48 * sg, sg == 0, sg == 4);
                }
            } else {
                const int ov = rv - (rv >> 2) - 1, nov = nrc - RC_UNITS;
                const unsigned nloc = __builtin_amdgcn_readfirstlane(__hip_atomic_load(xl, __ATOMIC_RELAXED, __HIP_MEMORY_SCOPE_AGENT));
                for (int g = 0; g < 4; ++g) {
                    rc_pass1_rwkv(F, ov * NWAVES + F.wave, nov * NWAVES, 64 + 48 * g, 48);
                    rc_pass1_ret(F, ov * NWAVES + F.wave, nov * NWAVES, 64 + 48 * g, 48);
                    xcd_publish(F, xl + 1 + g, nloc, grp + 32 * g);
                }
            }
            xcd_publish(F, xl + 10, nrl, sub + 64); sub_wait(F, sub + 64, (unsigned)nrc);
        }
        asm volatile("" : "+s"(F.wave), "+s"(F.vcu), "+s"(F.G)); F.tid = tid_from_wave(F.wave); F.lane = F.tid & 63; { unsigned z_ = 0u; asm volatile("" : "+v"(z_)); F.zz = __builtin_amdgcn_readfirstlane(z_); }
        mixer_post(F, l, F.vcu * NWAVES + F.wave, F.G * NWAVES);
        GRID_BAR();
#if MOBA_CHECK
        moba_naive(F, F.vcu * NWAVES + F.wave, F.G * NWAVES);
        GRID_BAR();
        { float sd = 0.f, sn = 0.f; const bf16* NV = (const bf16*)(FWS + WS_U + 160 * MiB); const bf16* MXc = (const bf16*)(FWS + WS_MIXED);
          for (int m = F.vcu * NWAVES + F.wave; m < MROWS; m += F.G * NWAVES) for (int j = 0; j < 16; ++j) { const float a = bf2f(MXc[(size_t)m * DM + 1024 + j * 64 + F.lane]), b = bf2f(NV[(size_t)m * 1024 + j * 64 + F.lane]); sd += (a - b) * (a - b); sn += b * b; }
          atomicAdd((float*)(FWS + WS_CTL) + 8, sd); atomicAdd((float*)(FWS + WS_CTL) + 9, sn); }
        GRID_BAR();
#endif
        { pg8::Gemm g{MIXED, (const bf16*)(wl + W_OUT), MROWS, DM, DM}; pg8::StaticOrder S; S.init(MROWS, DM, F.G, (int)blockIdx.x);
          if (l == 0) { pg8::EpiResGate<true> E{F.in[F.zz + 0], XB, DM, modl + 2 * DM, 12288, SEQ}; pg8::gemm_phase<pg8::EpiResGate<true>, pg8::StaticOrder, true, true>(F.lds, g, S, E, F.wave); }
          else { pg8::EpiResGate<false> E{XB, XB, DM, modl + 2 * DM, 12288, SEQ}; pg8::gemm_phase<pg8::EpiResGate<false>, pg8::StaticOrder, true, true>(F.lds, g, S, E, F.wave); } }
        GRID_BAR();
        norm_phase<0, false>(F, XB, HB, F.in[F.zz + 22] + l * DM, modl + 3 * DM, modl + 4 * DM);
        GRID_BAR();
        { pg8::Gemm g{HB, (const bf16*)(wl + W_UP), MROWS, UPC, DM}; pg8::StaticOrder S; S.init(MROWS, UPC, F.G, (int)blockIdx.x);
          pg8::EpiConvGate E{ACT, DFF, (float*)(FWS + WS_HALO), F.in[F.zz + 16] + (size_t)l * 3 * UPC, F.in[F.zz + 17] + (size_t)l * UPC, UPC, DFF};
          pg8::gemm_phase<pg8::EpiConvGate, pg8::StaticOrder, true, true>(F.lds, g, S, E, F.wave); }
        if (l == 0 && F.G == 256 && blockIdx.x >= 128) { if (blockIdx.x < 224) adaln_item(F, 1, (int)blockIdx.x - 128); convert_gap(F, 1, 0, CV_C2, ((int)blockIdx.x - 128) * NWAVES + F.wave, 128 * NWAVES, CV_N2); }
        if (l == 1 && F.G == 256 && blockIdx.x >= 128) convert_gap(F, 1, CV_IN + CV_OUT + CV_UP, CV_DN, ((int)blockIdx.x - 128) * NWAVES + F.wave, 128 * NWAVES, CV_N2);
        GRID_BAR();
        conv_fixup_phase(F, l);
        GRID_BAR();
        { pg8::Gemm g{ACT, (const bf16*)(wl + W_DN), MROWS, DM, DFF}; pg8::StaticOrder S; S.init(MROWS, DM, F.G, (int)blockIdx.x);
          pg8::EpiResGate<false> E{XB, XB, DM, modl + 5 * DM, 12288, SEQ};
          pg8::gemm_phase<pg8::EpiResGate<false>, pg8::StaticOrder, true, true>(F.lds, g, S, E, F.wave); }
        GRID_BAR();
}

__global__ void __launch_bounds__(NTHR, 2) mega_fwd(Args args) {
    extern __shared__ __attribute__((aligned(16))) unsigned char lds[];
    Frame F;
    F.lds = (LAS unsigned char*)lds;
    F.tid = threadIdx.x; F.lane = F.tid & 63; F.wave = __builtin_amdgcn_readfirstlane(F.tid >> 6);
    F.G = gridDim.x; { const int bx = blockIdx.x; F.vcu = (F.G % 8 == 0) ? (bx % 8) * (F.G / 8) + bx / 8 : bx; }
    F.in = args.in; F.ws = args.ws; F.zz = 0;
    volatile LAS unsigned* MISC = (volatile LAS unsigned*)(F.lds + MISC_OFF);
    for (int u = F.tid; u < (LDS_BYTES - LDSCTL_OFF) / 4; u += NTHR) ((LAS unsigned*)(F.lds + LDSCTL_OFF))[u] = 0u;
    __syncthreads();
    XcdBarrier bar = xcd_barrier_post((unsigned*)(FWS + WS_CTL) + CW_BAR, MISC + 8, F.tid);

    p0_prologue(F);
    GRID_BAR();
    layer_fwd<0>(F, bar);
    layer_fwd<1>(F, bar);
    norm_phase<1, false>(F, XB, args.out, F.in[F.zz + 23], nullptr, nullptr);
}

extern "C" void kernel_launch(void* const* d_in, const int* in_sizes, int n_in, void* d_out, int out_size, void* d_ws, size_t ws_size, hipStream_t stream) {
    static int grid = 0;
    if (grid == 0) {
        if (n_in != 24 || out_size != MROWS * DM || ws_size < WS_END) { fprintf(stderr, "kernel_launch: unexpected shapes (n_in %d out %d ws %zu)\n", n_in, out_size, ws_size); grid = -1; return; }
        int dev = 0, cus = 0;
        if (hipGetDevice(&dev) != hipSuccess || hipDeviceGetAttribute(&cus, hipDeviceAttributeMultiprocessorCount, dev) != hipSuccess) { grid = -1; return; }
        if (hipFuncSetAttribute((const void*)mega_fwd, hipFuncAttributeMaxDynamicSharedMemorySize, LDS_BYTES) != hipSuccess) { fprintf(stderr, "kernel_launch: hipFuncSetAttribute failed\n"); grid = -1; return; }
        int per_cu = 0;
        if (hipOccupancyMaxActiveBlocksPerMultiprocessor(&per_cu, (const void*)mega_fwd, NTHR, LDS_BYTES) != hipSuccess || per_cu < 1) { fprintf(stderr, "kernel_launch: occupancy query says %d\n", per_cu); }
        (void)hipGetLastError();
        grid = cus;
    }
    if (grid < 0) return;
    (void)hipMemsetAsync((char*)d_ws + WS_CTL, 0, CTL_ZERO_BYTES, stream);
    Args a{};
    for (int i = 0; i < 24; ++i) a.in[i] = (const float*)d_in[i];
    a.out = (float*)d_out; a.ws = (unsigned char*)d_ws;
    hipLaunchKernelGGL(mega_fwd, dim3(grid), dim3(NTHR), LDS_BYTES, stream, a);
}
```

```cpp
#include <hip/hip_runtime.h>
#include <cstdio>
#include <cstdint>
#ifndef MOBA_NP
#define MOBA_NP 2
#endif
#ifndef MOBA_CHECK
#define MOBA_CHECK 0
#endif
__device__ __forceinline__ int tid_from_wave(int wave) { int l = (int)__builtin_amdgcn_mbcnt_hi(~0u, __builtin_amdgcn_mbcnt_lo(~0u, 0u)); asm volatile("" : "+v"(l)); return wave * 64 + l; }
namespace pg8 {
#define PG8_LAS __attribute__((address_space(3)))
typedef unsigned short bf16_t;
typedef short bf16x8 __attribute__((ext_vector_type(8)));
typedef float f32x4 __attribute__((ext_vector_type(4)));
typedef unsigned u32x4 __attribute__((ext_vector_type(4)));
constexpr int BM = 256, BK = 64, HALF = 128, HTB = HALF * BK * 2  , STAGE_BYTES = 8 * HTB, NXCD = 8, WGM = 8;

__host__ __device__ __forceinline__ int lds_byte(int r, int c) { const int st = (r >> 4) * 2 + (c >> 5), rr = r & 15, cc = c & 31, ob = rr * 64 + cc * 2; return st * 1024 + (ob ^ (((ob >> 9) & 1) << 5)); }
__host__ __device__ __forceinline__ void stage_rc(int b, int& R, int& C) { const int st = b / 1024, sb = b % 1024, swz = sb ^ (((sb >> 9) & 1) << 5); R = (st >> 1) * 16 + swz / 64; C = (st & 1) * 32 + (swz % 64) / 2; }
__host__ __device__ __forceinline__ int perm32(int rho) { const int n = rho >> 4, i = rho & 15; return 8 * (i >> 2) + 4 * n + (i & 3); }

struct Unit { int pm, pn; };
struct Gemm { const bf16_t* A; const bf16_t* Bt; int M, N, K; };

struct StaticOrder {
    int nM, nN, nwg, G, c;
    __host__ __device__ void init(int M, int N, int G_, int c_) { nM = M / BM; nN = N / BM; nwg = nM * nN; G = G_; c = c_; }
    __host__ __device__ bool next(int i, Unit& u) const {
        const long L = (long)i * G + c; if (L >= nwg) return false;
        int wgid = (int)L; { const int q = nwg / NXCD, r = nwg % NXCD, xcd = wgid % NXCD, off = wgid / NXCD; wgid = (xcd < r ? xcd * (q + 1) : r * (q + 1) + (xcd - r) * q) + off; }
        const int nig = WGM * nN, gid = wgid / nig, fm = gid * WGM, gsz = (nM - fm) < WGM ? (nM - fm) : WGM;
        u.pm = fm + ((wgid % nig) % gsz); u.pn = (wgid % nig) / gsz; return true;
    }
    __device__ __forceinline__ void a_ready(const Unit&) const {}
    __device__ __forceinline__ void done(const Unit&) const {}
};

__device__ __forceinline__ unsigned cvt_pk_bf16(float lo, float hi) { unsigned r; asm volatile("v_cvt_pk_bf16_f32 %0, %1, %2" : "=v"(r) : "v"(lo), "v"(hi)); return r; }

struct EpiBf16 {
    static constexpr bool PERM = true, AFTER_DRAIN = false;
    bf16_t* O; int ldc;
    __device__ __forceinline__ void operator()(const f32x4 (&acc)[2][2][4][2], const Unit& u, int wr, int wc, int fr, int fq) const {
        const int row0 = u.pm * BM + wr * 64 + fr; const int col0 = u.pn * BM + wc * 32 + 8 * fq;
#pragma unroll
        for (int ai = 0; ai < 2; ++ai)
#pragma unroll
            for (int m = 0; m < 4; ++m) { bf16_t* rowp = O + (size_t)(row0 + ai * HALF + m * 16) * ldc + col0;
#pragma unroll
                for (int bj = 0; bj < 2; ++bj) { const f32x4 v0 = acc[ai][bj][m][0], v1 = acc[ai][bj][m][1];
                    u32x4 w; w.x = cvt_pk_bf16(v0[0], v0[1]); w.y = cvt_pk_bf16(v0[2], v0[3]); w.z = cvt_pk_bf16(v1[0], v1[1]); w.w = cvt_pk_bf16(v1[2], v1[3]);
                    *(u32x4*)(rowp + bj * HALF) = w; } }
    }
};

template <int CTRL> __device__ __forceinline__ float dpp_ror(float v) { return __builtin_bit_cast(float, __builtin_amdgcn_update_dpp(0, __builtin_bit_cast(int, v), CTRL, 0xF, 0xF, true)); }
struct EpiConvGate {
    static constexpr bool PERM = true, AFTER_DRAIN = false;
    bf16_t* A; int lda; float* halo; const float* cw; const float* cb; int nup, dff;
    __device__ __forceinline__ void operator()(const f32x4 (&acc)[2][2][4][2], const Unit& u, int wr, int wc, int fr, int fq) const {
        const int chl = wc * 32 + 8 * fq;
#pragma unroll
        for (int n = 0; n < 2; ++n) {
            const int c = u.pn * 128 + chl + 4 * n, colp = u.pn * 256 + chl + 4 * n;
            const f32x4 wv0 = *(const f32x4*)(cw + c), wv1 = *(const f32x4*)(cw + nup + c), wv2 = *(const f32x4*)(cw + 2 * nup + c), bv = *(const f32x4*)(cb + c);
            const f32x4 wg0 = *(const f32x4*)(cw + dff + c), wg1 = *(const f32x4*)(cw + nup + dff + c), wg2 = *(const f32x4*)(cw + 2 * nup + dff + c), bg = *(const f32x4*)(cb + dff + c);
#pragma unroll
            for (int ai = 0; ai < 2; ++ai) {
                const int grow = u.pm * BM + ai * HALF + wr * 64;
                float* hb = halo + (size_t)(grow >> 6) * 4 * nup + colp;
                if (fr < 2) { *(f32x4*)(hb + (size_t)fr * nup) = acc[ai][0][0][n]; *(f32x4*)(hb + (size_t)fr * nup + 128) = acc[ai][1][0][n]; }
                if (fr >= 14) { *(f32x4*)(hb + (size_t)(fr - 12) * nup) = acc[ai][0][3][n]; *(f32x4*)(hb + (size_t)(fr - 12) * nup + 128) = acc[ai][1][3][n]; }
                f32x4 cv[4];
                {   f32x4 P1 = {0.f, 0.f, 0.f, 0.f}, P2 = P1;
#pragma unroll
                    for (int m = 0; m < 4; ++m) { f32x4 R1, R2;
#pragma unroll
                        for (int e = 0; e < 4; ++e) { R1[e] = dpp_ror<0x121>(acc[ai][0][m][n][e]); R2[e] = dpp_ror<0x122>(acc[ai][0][m][n][e]); }
                        const f32x4 p1 = (fr >= 1) ? R1 : P1, p2 = (fr >= 2) ? R2 : P2; P1 = R1; P2 = R2;
                        cv[m] = wv0 * p2 + wv1 * p1 + wv2 * acc[ai][0][m][n] + bv; } }
                {   f32x4 P1 = {0.f, 0.f, 0.f, 0.f}, P2 = P1;
#pragma unroll
                    for (int m = 0; m < 4; ++m) { f32x4 R1, R2;
#pragma unroll
                        for (int e = 0; e < 4; ++e) { R1[e] = dpp_ror<0x121>(acc[ai][1][m][n][e]); R2[e] = dpp_ror<0x122>(acc[ai][1][m][n][e]); }
                        const f32x4 p1 = (fr >= 1) ? R1 : P1, p2 = (fr >= 2) ? R2 : P2; P1 = R1; P2 = R2;
                        const f32x4 cg = wg0 * p2 + wg1 * p1 + wg2 * acc[ai][1][m][n] + bg;
                        f32x4 o;
#pragma unroll
                        for (int e = 0; e < 4; ++e) o[e] = cg[e] * __builtin_amdgcn_rcpf(1.0f + __expf(-cg[e])) * cv[m][e];
                        unsigned w0 = cvt_pk_bf16(o[0], o[1]), w1 = cvt_pk_bf16(o[2], o[3]);
                        *(unsigned long long*)(A + (size_t)(grow + m * 16 + fr) * lda + c) = (unsigned long long)w0 | ((unsigned long long)w1 << 32); } }
            }
        }
    }
};

template <bool BASE_F32>
struct EpiResGate {
    static constexpr bool PERM = true, AFTER_DRAIN = false;
    const void* base; bf16_t* out; int ldc; const float* gate; int gstride; int rows_per_batch;
    __device__ __forceinline__ void operator()(const f32x4 (&acc)[2][2][4][2], const Unit& u, int wr, int wc, int fr, int fq) const {
        const int col0 = u.pn * BM + wc * 32 + 8 * fq;
        const int b = (u.pm * BM) / rows_per_batch;
        f32x4 gv[2][2];
#pragma unroll
        for (int bj = 0; bj < 2; ++bj)
#pragma unroll
            for (int n = 0; n < 2; ++n) gv[bj][n] = *(const f32x4*)(gate + (size_t)b * gstride + col0 + bj * HALF + n * 4);
#pragma unroll
        for (int ai = 0; ai < 2; ++ai)
#pragma unroll
            for (int m = 0; m < 4; ++m) { const size_t off = (size_t)(u.pm * BM + ai * HALF + wr * 64 + m * 16 + fr) * ldc + col0;
#pragma unroll
                for (int bj = 0; bj < 2; ++bj) { f32x4 b0, b1;
                    if (BASE_F32) { b0 = *(const f32x4*)((const float*)base + off + bj * HALF); b1 = *(const f32x4*)((const float*)base + off + bj * HALF + 4); }
                    else { const u32x4 w = *(const u32x4*)((const bf16_t*)base + off + bj * HALF);
                        b0 = (f32x4){__builtin_bit_cast(float, w.x << 16), __builtin_bit_cast(float, w.x & 0xffff0000u), __builtin_bit_cast(float, w.y << 16), __builtin_bit_cast(float, w.y & 0xffff0000u)};
                        b1 = (f32x4){__builtin_bit_cast(float, w.z << 16), __builtin_bit_cast(float, w.z & 0xffff0000u), __builtin_bit_cast(float, w.w << 16), __builtin_bit_cast(float, w.w & 0xffff0000u)}; }
                    const f32x4 o0 = b0 + gv[bj][0] * acc[ai][bj][m][0], o1 = b1 + gv[bj][1] * acc[ai][bj][m][1];
                    u32x4 w; w.x = cvt_pk_bf16(o0[0], o0[1]); w.y = cvt_pk_bf16(o0[2], o0[3]); w.z = cvt_pk_bf16(o1[0], o1[1]); w.w = cvt_pk_bf16(o1[2], o1[3]);
                    *(u32x4*)(out + off + bj * HALF) = w; }
                if (m & 1) asm volatile("" ::: "memory"); }
    }
};

template <class Epi, class Sched, bool ALIGN_EPI = false, bool SP2 = false>
__device__ __forceinline__ void gemm_phase(PG8_LAS unsigned char* lds, const Gemm g, const Sched& S, const Epi& E, int wave_) {
    const int tid_ = tid_from_wave(wave_);
    const int tid = tid_, wid = __builtin_amdgcn_readfirstlane(tid >> 6), lane = tid & 63, wr = wid >> 2, wc = wid & 3, fr = lane & 15, fq = lane >> 4;
    const int K = g.K, nt = K / BK;
    unsigned voffA[2], voffB[2];
#pragma unroll
    for (int i = 0; i < 2; ++i) { int R, C; stage_rc(tid * 16 + i * 8192, R, C); const int Rb = Epi::PERM ? ((R & ~31) + perm32(R & 31)) : R;
        voffA[i] = (unsigned)(R * K + C) * 2u; voffB[i] = (unsigned)(Rb * K + C) * 2u; }
    const size_t kstep = (size_t)(BK * 2);
    const size_t hstep = (size_t)HALF * K * 2;
    const size_t tstep = 2 * hstep;
    const unsigned ldsw = (unsigned)wid * 1024u;
    const int aoff = lds_byte(wr * 64 + fr, fq * 8), boff = lds_byte(wc * 32 + fr, fq * 8);
#define PG8_SA(b, h) (((b) * 2 + (h)) * HTB)
#define PG8_SB(b, h) ((4 + (b) * 2 + (h)) * HTB)
#define PG8_STAGE(bufoff, gbase, voff) do { _Pragma("unroll") for (int _i = 0; _i < 2; ++_i) \
        __builtin_amdgcn_global_load_lds((const unsigned*)((const char*)(gbase) + (voff)[_i]), (PG8_LAS unsigned*)(lds + (bufoff) + ldsw + _i * 8192), 16, 0, 0); } while (0)
#define PG8_LDA(dst, b, h) do { _Pragma("unroll") for (int m = 0; m < 4; ++m) _Pragma("unroll") for (int k = 0; k < 2; ++k) dst[m][k] = *(const PG8_LAS bf16x8*)(lds + PG8_SA(b, h) + aoff + m * 2048 + k * 1024); } while (0)
#define PG8_LDB(dst, b, h) do { _Pragma("unroll") for (int n = 0; n < 2; ++n) _Pragma("unroll") for (int k = 0; k < 2; ++k) dst[n][k] = *(const PG8_LAS bf16x8*)(lds + PG8_SB(b, h) + boff + n * 2048 + k * 1024); } while (0)
#define PG8_MMA(ai, bj, At, Bt) do { __builtin_amdgcn_s_setprio(1); _Pragma("unroll") for (int m = 0; m < 4; ++m) _Pragma("unroll") for (int n = 0; n < 2; ++n) _Pragma("unroll") for (int k = 0; k < 2; ++k) \
        acc[ai][bj][m][n] = __builtin_amdgcn_mfma_f32_16x16x32_bf16(Bt[n][k], At[m][k], acc[ai][bj][m][n], 0, 0, 0); __builtin_amdgcn_s_setprio(0); } while (0)
#define PG8_WAIT_V(n) asm volatile("s_waitcnt vmcnt(" #n ")" ::: "memory")
#define PG8_WAIT_L(n) asm volatile("s_waitcnt lgkmcnt(" #n ")" ::: "memory")
#define PG8_BAR __builtin_amdgcn_s_barrier()
#define PG8_SCHED __builtin_amdgcn_sched_barrier(0)
    Unit cur, nxt; int ui = 0;
    if (!S.next(0, cur)) return;
    f32x4 acc[2][2][4][2];
#pragma unroll
    for (int a = 0; a < 2; ++a)
#pragma unroll
        for (int b = 0; b < 2; ++b)
#pragma unroll
            for (int m = 0; m < 4; ++m)
#pragma unroll
                for (int n = 0; n < 2; ++n) acc[a][b][m][n] = (f32x4){0.f, 0.f, 0.f, 0.f};
    bf16x8 At[4][2], B0[2][2], B1[2][2];
    const char* cA = (const char*)g.A + (size_t)cur.pm * tstep; const char* cB = (const char*)g.Bt + (size_t)cur.pn * tstep;
    S.a_ready(cur);
    if constexpr (SP2) {
        PG8_STAGE(PG8_SB(0, 0), cB, voffB); PG8_STAGE(PG8_SB(0, 1), cB + hstep, voffB); PG8_STAGE(PG8_SA(0, 0), cA, voffA); PG8_STAGE(PG8_SA(0, 1), cA + hstep, voffA);
        if (wr == 1) PG8_BAR;
        PG8_WAIT_V(2); PG8_BAR;
        PG8_STAGE(PG8_SB(1, 0), cB + kstep, voffB); PG8_STAGE(PG8_SA(1, 0), cA + kstep, voffA); PG8_STAGE(PG8_SB(1, 1), cB + hstep + kstep, voffB);
        PG8_WAIT_V(6); PG8_BAR;
    } else {
        PG8_STAGE(PG8_SB(0, 0), cB, voffB); PG8_STAGE(PG8_SA(0, 0), cA, voffA); PG8_STAGE(PG8_SB(0, 1), cB + hstep, voffB); PG8_STAGE(PG8_SA(0, 1), cA + hstep, voffA);
        if (wr == 1) PG8_BAR;
        PG8_WAIT_V(4); PG8_BAR;
        PG8_STAGE(PG8_SB(1, 0), cB + kstep, voffB); PG8_STAGE(PG8_SA(1, 0), cA + kstep, voffA); PG8_STAGE(PG8_SB(1, 1), cB + hstep + kstep, voffB);
        PG8_WAIT_V(6); PG8_BAR;
    }
    for (;;) {
        const bool has_next = S.next(ui + 1, nxt);
        const char* nA = has_next ? (const char*)g.A + (size_t)nxt.pm * tstep : cA; const char* nB = has_next ? (const char*)g.Bt + (size_t)nxt.pn * tstep : cB;
        for (int t = 0; t < nt; t += 2) {
            const bool last = (t == nt - 2);
            const char* a1 = cA + (size_t)(t + 1) * kstep;
            const char* a2 = last ? nA : cA + (size_t)(t + 2) * kstep; const char* b2 = last ? nB : cB + (size_t)(t + 2) * kstep;
            const char* a3 = a2 + kstep; const char* b3 = b2 + kstep;
            if (last && has_next) S.a_ready(nxt);
            if constexpr (SP2) {
            PG8_LDB(B0, 0, 0); PG8_LDB(B1, 0, 1); PG8_SCHED; PG8_LDA(At, 0, 0); PG8_STAGE(PG8_SA(1, 1), a1 + hstep, voffA);
            PG8_WAIT_V(8); PG8_WAIT_L(0); PG8_BAR; PG8_MMA(0, 0, At, B0); PG8_MMA(0, 1, At, B1); PG8_BAR; PG8_SCHED;
            PG8_LDA(At, 0, 1); PG8_STAGE(PG8_SB(0, 0), b2, voffB); PG8_STAGE(PG8_SB(0, 1), b2 + hstep, voffB); PG8_STAGE(PG8_SA(0, 0), a2, voffA);
            PG8_WAIT_V(8); PG8_WAIT_L(0); PG8_BAR; PG8_MMA(1, 0, At, B0); PG8_MMA(1, 1, At, B1); PG8_BAR; PG8_SCHED;
            PG8_LDB(B0, 1, 0); PG8_LDB(B1, 1, 1); PG8_SCHED; PG8_LDA(At, 1, 0); PG8_STAGE(PG8_SA(0, 1), a2 + hstep, voffA);
            PG8_WAIT_V(8); PG8_WAIT_L(0); PG8_BAR; PG8_MMA(0, 0, At, B0); PG8_MMA(0, 1, At, B1); PG8_BAR; PG8_SCHED;
            PG8_LDA(At, 1, 1); PG8_STAGE(PG8_SB(1, 0), b3, voffB); PG8_STAGE(PG8_SB(1, 1), b3 + hstep, voffB); PG8_STAGE(PG8_SA(1, 0), a3, voffA);
            PG8_WAIT_V(8); PG8_WAIT_L(0); PG8_BAR; PG8_MMA(1, 0, At, B0); PG8_MMA(1, 1, At, B1); PG8_BAR; PG8_SCHED;
            } else {
            PG8_LDB(B0, 0, 0); PG8_SCHED; PG8_LDA(At, 0, 0); PG8_STAGE(PG8_SA(1, 1), a1 + hstep, voffA);
            PG8_WAIT_L(8); PG8_BAR; PG8_WAIT_L(0); PG8_MMA(0, 0, At, B0); PG8_BAR; PG8_SCHED;
            PG8_LDB(B1, 0, 1); PG8_STAGE(PG8_SB(0, 0), b2, voffB);
            PG8_BAR; PG8_WAIT_L(0); PG8_MMA(0, 1, At, B1); PG8_BAR;
            PG8_LDA(At, 0, 1); PG8_STAGE(PG8_SA(0, 0), a2, voffA);
            PG8_BAR; PG8_WAIT_L(0); PG8_MMA(1, 0, At, B0); PG8_BAR; PG8_SCHED;
            PG8_STAGE(PG8_SB(0, 1), b2 + hstep, voffB);
            PG8_WAIT_V(6); PG8_BAR; PG8_MMA(1, 1, At, B1); PG8_BAR;
            PG8_LDB(B0, 1, 0); PG8_SCHED; PG8_LDA(At, 1, 0); PG8_STAGE(PG8_SA(0, 1), a2 + hstep, voffA);
            PG8_WAIT_L(8); PG8_BAR; PG8_WAIT_L(0); PG8_MMA(0, 0, At, B0); PG8_BAR; PG8_SCHED;
            PG8_LDB(B1, 1, 1); PG8_STAGE(PG8_SB(1, 0), b3, voffB);
            PG8_BAR; PG8_WAIT_L(0); PG8_MMA(0, 1, At, B1); PG8_BAR;
            PG8_LDA(At, 1, 1); PG8_STAGE(PG8_SA(1, 0), a3, voffA);
            PG8_BAR; PG8_WAIT_L(0); PG8_MMA(1, 0, At, B0); PG8_BAR; PG8_SCHED;
            PG8_STAGE(PG8_SB(1, 1), b3 + hstep, voffB);
            PG8_WAIT_V(6); PG8_BAR; PG8_MMA(1, 1, At, B1); PG8_BAR;
            }
        }
        if constexpr (ALIGN_EPI) { if (wr == 0) PG8_BAR; }
        if constexpr (!Epi::AFTER_DRAIN) { E(acc, cur, wr, wc, fr, fq); S.done(cur); }
        if (!has_next) break;
#pragma unroll
        for (int a = 0; a < 2; ++a)
#pragma unroll
            for (int b = 0; b < 2; ++b)
#pragma unroll
                for (int m = 0; m < 4; ++m)
#pragma unroll
                    for (int n = 0; n < 2; ++n) acc[a][b][m][n] = (f32x4){0.f, 0.f, 0.f, 0.f};
        cur = nxt; cA = nA; cB = nB; ++ui;
        if constexpr (ALIGN_EPI) { if (wr == 1) PG8_BAR; }
    }
    PG8_WAIT_V(0);
    if constexpr (!ALIGN_EPI) { if (wr == 0) PG8_BAR; }
    PG8_BAR;
    if constexpr (Epi::AFTER_DRAIN) { E.fused(acc, cur, wr, wc, fr, fq, lds, wid, lane); S.done(cur); }
#undef PG8_SA
#undef PG8_SB
#undef PG8_STAGE
#undef PG8_LDA
#undef PG8_LDB
#undef PG8_MMA
#undef PG8_WAIT_V
#undef PG8_WAIT_L
#undef PG8_BAR
#undef PG8_SCHED
}
}

namespace moba {
using bf16 = unsigned short;
typedef short bf16x8 __attribute__((ext_vector_type(8)));
typedef short s16x4 __attribute__((ext_vector_type(4)));
typedef float f32x16 __attribute__((ext_vector_type(16)));
typedef float f32x4 __attribute__((ext_vector_type(4)));
typedef unsigned u32x4 __attribute__((ext_vector_type(4)));
#define MLAS __attribute__((address_space(3)))
typedef MLAS char lchar; typedef MLAS float lfloat; typedef MLAS bf16x8 lbf16x8;
template <class A, class Bt> struct same_t { static constexpr bool v = false; };
template <class A> struct same_t<A, A> { static constexpr bool v = true; };
constexpr int D = 128, LDI = 6656, LDO = 2048;
constexpr float THR = 8.f;
constexpr bool WSKIP = false;
constexpr float SCALE = 0.08838834764831845f;
constexpr int NW = 8, QBLK = 32, KVBLK = 64, QB = NW * QBLK;
constexpr int SHM_V = KVBLK * D * 2, SHM_K = KVBLK * D * 2;
constexpr int LDS_BYTES = 2 * SHM_V + 2 * SHM_K + NW * 64 * 4;
#define KSWZ(row, colB) ((row) * 256 + ((colB) ^ (((row) & 7) << 4)))
#define SBAR() __builtin_amdgcn_sched_barrier(0)
__device__ __forceinline__ int v_st(int k, int c) { const int kk = (k & ~0xC) | ((k & 4) << 1) | ((k & 8) >> 1); return ((kk >> 3) * 4 + (c >> 5)) * 512 + ((kk & 7) * 32 + (c & 31)) * 2; }
__device__ __forceinline__ int v_rd_base(int lane) { return ((lane & 3) << 3) | (((lane >> 2) & 3) << 6) | (((lane >> 4) & 1) << 5) | (((lane >> 5) & 1) << 8); }
constexpr int v_rd_off(int d0, int ks, int half) { return d0 * 512 + ks * 4096 + half * 2048; }
__device__ __forceinline__ int crow(int r, int hi) { return (r & 3) + 8 * (r >> 2) + 4 * hi; }
__device__ __forceinline__ unsigned cvtpk(float lo, float hi) {
    unsigned r; asm volatile("v_cvt_pk_bf16_f32 %0, %1, %2" : "=v"(r) : "v"(lo), "v"(hi)); return r;
}
__device__ __forceinline__ bf16x8 pack8(f32x4 a, f32x4 b) {
    u32x4 w = {cvtpk(a[0], a[1]), cvtpk(a[2], a[3]), cvtpk(b[0], b[1]), cvtpk(b[2], b[3])};
    return *reinterpret_cast<bf16x8*>(&w);
}
template <class T> __device__ __forceinline__ bf16x8 load8(const T* p) {
    if constexpr (same_t<T, float>::v) { return pack8(*(const f32x4*)p, *(const f32x4*)(p + 4)); }
    else { return *reinterpret_cast<const bf16x8*>(p); }
}
__device__ __forceinline__ void mask_tile(f32x16& p0, f32x16& p1, int dq, unsigned W) {
    const float NEG = -__builtin_inff();
#pragma unroll
    for (int r = 0; r < 16; ++r) {
        const int c = (r & 3) + 8 * (r >> 2);
        if ((unsigned)(dq - c) >= W) p0[r] = NEG;
        if ((unsigned)(dq - c - 32) >= W) p1[r] = NEG;
    }
}
__device__ __forceinline__ void partialSM(f32x16& p0, f32x16& p1, float& m_reg, float& mn, float& alpha) {
    float pmax = p0[0]; for (int r = 1; r < 16; ++r) pmax = fmaxf(pmax, p0[r]); for (int r = 0; r < 16; ++r) pmax = fmaxf(pmax, p1[r]);
    { auto rr = __builtin_amdgcn_permlane32_swap(__float_as_uint(pmax), __float_as_uint(pmax), false, false);
      pmax = fmaxf(__uint_as_float(rr[0]), __uint_as_float(rr[1])); }
    constexpr float C2 = 1.4426950408889634f * SCALE;
    if (__builtin_expect(__all((pmax - m_reg) * SCALE <= THR), 1)) { mn = m_reg; alpha = 1.f; }
    else { mn = fmaxf(m_reg, pmax); alpha = __builtin_amdgcn_exp2f((m_reg - mn) * C2); m_reg = mn; }
    const float mnL = -mn * C2;
    for (int r = 0; r < 16; ++r) p0[r] = fmaf(p0[r], C2, mnL); for (int r = 0; r < 16; ++r) p1[r] = fmaf(p1[r], C2, mnL);
    for (int r = 0; r < 16; ++r) p0[r] = __builtin_amdgcn_exp2f(p0[r]);
}
__device__ __forceinline__ void finishSM(f32x16& p0, f32x16& p1, float alpha, float& l_reg, bf16x8& pa0, bf16x8& pa1, bf16x8& pa2, bf16x8& pa3) {
    for (int r = 0; r < 16; ++r) p1[r] = __builtin_amdgcn_exp2f(p1[r]);
    float ps = 0; for (int r = 0; r < 16; ++r) ps += p0[r]; for (int r = 0; r < 16; ++r) ps += p1[r];
    { auto rr = __builtin_amdgcn_permlane32_swap(__float_as_uint(ps), __float_as_uint(ps), false, false);
      ps = __uint_as_float(rr[0]) + __uint_as_float(rr[1]); }
    l_reg = l_reg * alpha + ps;
#define PK4(P, B_, OUT) do { unsigned a0 = cvtpk(P[B_+0], P[B_+1]), a1 = cvtpk(P[B_+2], P[B_+3]);                          \
        unsigned b0 = cvtpk(P[B_+4], P[B_+5]), b1 = cvtpk(P[B_+6], P[B_+7]);                                             \
        auto r0 = __builtin_amdgcn_permlane32_swap(a0, b0, false, false); auto r1 = __builtin_amdgcn_permlane32_swap(a1, b1, false, false); \
        u32x4 w = {r0[0], r1[0], r0[1], r1[1]}; OUT = *reinterpret_cast<bf16x8*>(&w); } while (0)
    PK4(p0, 0, pa0); PK4(p0, 8, pa1); PK4(p1, 0, pa2); PK4(p1, 8, pa3);
#undef PK4
}
template <int KB, bool SK>
__device__ __forceinline__ void qkt(f32x16& p0, f32x16& p1, const lchar* K_lds, int r32, int hi, const bf16x8* qr, bool act, float slopeR, float lb) {
    if (SK && !act) { const float NEG = -__builtin_inff();
#pragma unroll
        for (int r = 0; r < 16; ++r) { p0[r] = NEG; p1[r] = NEG; } return; }
#pragma unroll
    for (int r = 0; r < 16; ++r) { const int c = (r & 3) + 8 * (r >> 2); p0[r] = __builtin_fmaf(slopeR, (float)c, lb); p1[r] = __builtin_fmaf(slopeR, (float)(c + 32), lb); }
    const lchar* kb[4];
#pragma unroll
    for (int dd = 0; dd < 4; ++dd) kb[dd] = K_lds + KB * SHM_K + KSWZ(r32, (dd * 16 + hi * 8) * 2);
#pragma unroll
    for (int d0 = 0; d0 < 8; ++d0) { const lchar* a = kb[d0 & 3] + (d0 >> 2) * 128;
        bf16x8 b0 = *(const lbf16x8*)(a);
        bf16x8 b1 = *(const lbf16x8*)(a + 32 * 256);
        p0 = __builtin_amdgcn_mfma_f32_32x32x16_bf16(b0, qr[d0], p0, 0, 0, 0);
        p1 = __builtin_amdgcn_mfma_f32_32x32x16_bf16(b1, qr[d0], p1, 0, 0, 0); }
}
template <int VB, bool SK>
__device__ __forceinline__ void pv_tile(f32x16* o, int vb0, bf16x8 pa0, bf16x8 pa1, bf16x8 pa2, bf16x8 pa3, bool act) {
    if (SK && !act) return;
#define TRRD(dst, off) asm volatile("ds_read_b64_tr_b16 %0, %1 offset:%2" : "=&v"(dst) : "v"(vb0), "i"(off) : "memory")
#define PV_D0(d0) do { s16x4 l0, l1, l2, l3, h0, h1, h2, h3; constexpr int b_ = VB * SHM_V + v_rd_off(d0, 0, 0);     \
        TRRD(l0, b_); TRRD(h0, b_ + 2048); TRRD(l1, b_ + 4096); TRRD(h1, b_ + 6144); TRRD(l2, b_ + 8192); TRRD(h2, b_ + 10240); TRRD(l3, b_ + 12288); TRRD(h3, b_ + 14336); \
        asm volatile("s_waitcnt lgkmcnt(0)" ::: "memory"); SBAR();                 \
        o[d0] = __builtin_amdgcn_mfma_f32_32x32x16_bf16(pa0, (bf16x8){l0[0], l0[1], l0[2], l0[3], h0[0], h0[1], h0[2], h0[3]}, o[d0], 0, 0, 0);   \
        o[d0] = __builtin_amdgcn_mfma_f32_32x32x16_bf16(pa1, (bf16x8){l1[0], l1[1], l1[2], l1[3], h1[0], h1[1], h1[2], h1[3]}, o[d0], 0, 0, 0);   \
        o[d0] = __builtin_amdgcn_mfma_f32_32x32x16_bf16(pa2, (bf16x8){l2[0], l2[1], l2[2], l2[3], h2[0], h2[1], h2[2], h2[3]}, o[d0], 0, 0, 0);   \
        o[d0] = __builtin_amdgcn_mfma_f32_32x32x16_bf16(pa3, (bf16x8){l3[0], l3[1], l3[2], l3[3], h3[0], h3[1], h3[2], h3[3]}, o[d0], 0, 0, 0); } while (0)
    PV_D0(0); PV_D0(1); PV_D0(2); PV_D0(3);
#undef PV_D0
#undef TRRD
}

typedef __attribute__((address_space(1))) char gchar; typedef __attribute__((address_space(1))) bf16x8 gbf16x8;
__device__ __forceinline__ const gchar* uni_ptr(const char* p) { const unsigned long long v = (unsigned long long)p;
    const unsigned lo = __builtin_amdgcn_readfirstlane((unsigned)v), hi = __builtin_amdgcn_readfirstlane((unsigned)(v >> 32)); return (const gchar*)(((unsigned long long)hi << 32) | lo); }
template <class TIn, class TOut> struct BlockRef { const TIn* Q; const TIn* K; const TIn* V; TOut* O; int P0; const __attribute__((address_space(3))) unsigned* sel; float slopeR; };
template <class TIn> struct Seam {
    bf16x8 qr[8];
    bf16x8 st_v0, st_v1, st_k0, st_k1; f32x4 sf0, sf1, sf2, sf3;
    f32x4 tq[16];
};
__device__ __forceinline__ int swa_jlo(int P0, int W) { const int lowk = P0 - W + 1; return lowk > 0 ? lowk / KVBLK : 0; }
#define ROW(p, k0, rr) ((const TIn*)((const char*)(p) + (size_t)(k0) * (LDI * sizeof(TIn)) + (unsigned)(((rr) * LDI + sc) * (int)sizeof(TIn))))
#define VMW() asm volatile("s_waitcnt vmcnt(0)" ::: "memory")
#define VMWN(n) asm volatile("s_waitcnt vmcnt(%0)" :: "i"(n) : "memory")
#define SLOAD_H(Kp, Vp, k0) do { const gchar* kb__ = uni_ptr((const char*)(Kp) + (size_t)(k0) * (LDI * sizeof(TIn))); const gchar* vb__ = uni_ptr((const char*)(Vp) + (size_t)(k0) * (LDI * sizeof(TIn))); \
                         S.st_v0 = *(const gbf16x8*)(vb__ + roff0); S.st_v1 = *(const gbf16x8*)(vb__ + roff1);              \
                         S.st_k0 = *(const gbf16x8*)(kb__ + roff0); S.st_k1 = *(const gbf16x8*)(kb__ + roff1); } while (0)
#define SWRITE_HK(bf) do { *(lbf16x8*)(K_lds + (bf) * SHM_K + kws) = S.st_k0; *(lbf16x8*)(K_lds + (bf) * SHM_K + kws + 32 * 256) = S.st_k1; } while (0)
#define SWRITE_HV(bf) do { *(lbf16x8*)(V_lds + (bf) * SHM_V + vst0) = S.st_v0; *(lbf16x8*)(V_lds + (bf) * SHM_V + vst1) = S.st_v1; } while (0)
#define SWRITE_H(bf) do { SWRITE_HV(bf); SWRITE_HK(bf); } while (0)
#define SLOAD_F(p, k0) do { S.sf0 = *(const f32x4*)ROW(p, k0, sr); S.sf1 = *(const f32x4*)(ROW(p, k0, sr) + 4);                \
                            S.sf2 = *(const f32x4*)ROW(p, k0, 32 + sr); S.sf3 = *(const f32x4*)(ROW(p, k0, 32 + sr) + 4); } while (0)
#define SWRITE_KF(bf) do { *(lbf16x8*)(K_lds + (bf) * SHM_K + kws) = pack8(S.sf0, S.sf1); *(lbf16x8*)(K_lds + (bf) * SHM_K + kws + 32 * 256) = pack8(S.sf2, S.sf3); } while (0)
#define SWRITE_VF(bf) do { *(lbf16x8*)(V_lds + (bf) * SHM_V + vst0) = pack8(S.sf0, S.sf1); *(lbf16x8*)(V_lds + (bf) * SHM_V + vst1) = pack8(S.sf2, S.sf3); } while (0)
template <class TIn, class TOut>
__device__ __forceinline__ void causal_swa_prime(const BlockRef<TIn, TOut>& cur, int W, lchar* lds, Seam<TIn>& S, int wave_) {
    constexpr bool F32 = same_t<TIn, float>::v;
    const int tid_ = tid_from_wave(wave_);
    const int tid = tid_, wid = __builtin_amdgcn_readfirstlane(tid >> 6), lane = tid & 63, r32 = lane & 31, hi = lane >> 5;
    const int sr = tid >> 4, sc = (tid & 15) * 8, kws = KSWZ(sr, sc * 2); lchar* K_lds = lds + 2 * SHM_V;
    const unsigned roff0 = (unsigned)((sr * LDI + sc) * (int)sizeof(TIn)), roff1 = (unsigned)(((32 + sr) * LDI + sc) * (int)sizeof(TIn));
    const int kb0 = ((cur.P0 + QB - 1) / KVBLK) * KVBLK;
    for (int d0 = 0; d0 < 8; ++d0) S.qr[d0] = *(const gbf16x8*)(uni_ptr((const char*)cur.Q) + (unsigned)(((wid * QBLK + r32) * LDI + hi * 8) * (int)sizeof(TIn)) + d0 * 16 * sizeof(TIn));
    if constexpr (F32) { SLOAD_F((const float*)cur.K, kb0); VMW(); SWRITE_KF(0); SBAR(); SLOAD_F((const float*)cur.V, kb0); }
    else { SLOAD_H(cur.K, cur.V, kb0); VMW(); SWRITE_HK(0); }
    __syncthreads();
}
template <class TIn, class TOut>
__device__ __forceinline__ void causal_swa_block(const BlockRef<TIn, TOut>& cur, const BlockRef<TIn, TOut>& nxt, int skv, int W, lchar* lds, Seam<TIn>& S, int wave_) {
    constexpr bool F32 = same_t<TIn, float>::v;
    const int tid_ = tid_from_wave(wave_);
    const int tid = tid_, wid = __builtin_amdgcn_readfirstlane(tid >> 6), lane = tid & 63, r32 = lane & 31, hi = lane >> 5;
    const int j_lo = swa_jlo(cur.P0, W);
    int j_hi = (cur.P0 + QB - 1) / KVBLK + 1; if (j_hi > skv / KVBLK) j_hi = skv / KVBLK;
    const int NT = j_hi - j_lo;
    const int kbn = ((nxt.P0 + QB - 1) / KVBLK) * KVBLK;
    const unsigned selm = cur.sel[wid * QBLK + r32] | (1u << (cur.P0 >> 8)); const float slopeR = __builtin_bit_cast(float, __builtin_amdgcn_readfirstlane(__builtin_bit_cast(unsigned, cur.slopeR))); const int tqm = cur.P0 + wid * QBLK + r32 - 4 * hi;
#define LB(t) (((selm >> (KBASE(t) >> 8)) & 1u) ? slopeR * (float)(KBASE(t) - tqm) : -__builtin_inff())
    const int qlo = cur.P0 + wid * QBLK, qm = qlo + r32 - 4 * hi;
    lchar* V_lds = lds; lchar* K_lds = lds + 2 * SHM_V;
    lfloat* ws = (lfloat*)(lds + 2 * SHM_V + 2 * SHM_K) + wid * 64; lfloat* li_l = ws; lfloat* al_l = ws + 32;
    float m_reg = -1e30f, l_reg = 0; f32x16 o[4] = {};
    const unsigned roff0 = (unsigned)(((tid >> 4) * LDI + (tid & 15) * 8) * (int)sizeof(TIn)), roff1 = (unsigned)(((32 + (tid >> 4)) * LDI + (tid & 15) * 8) * (int)sizeof(TIn));
    const int sr = tid >> 4, sc = (tid & 15) * 8, vst0 = v_st(sr, sc), vst1 = v_st(32 + sr, sc), kws = KSWZ(sr, sc * 2);
    const int vb0 = (int)(unsigned)(uintptr_t)V_lds + v_rd_base(lane);
    const TIn* Kh = cur.K; const TIn* Vh = cur.V;
#define RESC(a) do { if (__any((a) < 1.f)) { if (hi == 0) al_l[r32] = (a); asm volatile("s_waitcnt lgkmcnt(0)" ::: "memory");              \
                     for (int d_ = 0; d_ < 4; ++d_) for (int r = 0; r < 16; ++r) o[d_][r] *= al_l[crow(r, hi)]; } } while (0)
#define KBASE(t) ((j_hi - 1 - (t)) * KVBLK)
#define ACT(t) (KBASE(t) <= qlo + QBLK - 1 && KBASE(t) + KVBLK - 1 >= qlo - W + 1)
#define MASKT(P0_, P1_, t) do { const int kb_ = KBASE(t); if ((!SK || ACT(t)) && (kb_ + KVBLK - 1 > qlo || kb_ <= qlo + QBLK - 1 - W)) mask_tile(P0_, P1_, qm - kb_, (unsigned)W); } while (0)
    constexpr int NQL = F32 ? 16 : 8;
    constexpr bool SK = WSKIP && !F32;
#define SEAM_K0() do { VMWN(NQL); if constexpr (F32) { SWRITE_KF(0); SBAR(); SLOAD_F((const float*)nxt.V, kbn); } else { SWRITE_HK(0); } SBAR(); } while (0)
    unsigned touch_reg = 0u; const int tl_ = wid * 32 + (lane & 31);
    const unsigned toff = (unsigned)(((tl_ & 127) >> 1) * LDI * (int)sizeof(TIn) + (tl_ & 1) * 128);
    const gchar* tbase = uni_ptr((const char*)((tl_ >> 7) ? (const void*)Vh : (const void*)Kh));
#if MOBA_CHECK
#define TOUCH(k0) do {} while (0)
#else
#define TOUCH(k0) do { const gchar* tp_ = tbase + (size_t)(k0) * (LDI * sizeof(TIn)) + toff; asm volatile("global_load_dword %0, %1, off" : "+v"(touch_reg) : "v"(tp_) : "memory"); } while (0)
#endif
    f32x16 pA0, pA1, pB0, pB1; float mnA, mnB, alA, alB; bf16x8 pa0, pa1, pa2, pa3;
    if constexpr (F32) { VMW(); SWRITE_VF(0); SBAR(); } else { SWRITE_HV(0); SBAR(); }
    if (NT > 1) { if constexpr (F32) SLOAD_F((const float*)Kh, KBASE(1)); else SLOAD_H(Kh, Vh, KBASE(1)); }
    SBAR(); qkt<0, SK>(pA0, pA1, K_lds, r32, hi, S.qr, ACT(0), slopeR, LB(0));
    if constexpr (F32) { if (NT > 1) { VMW(); SWRITE_KF(1); SBAR(); SLOAD_F((const float*)Vh, KBASE(1)); } }
    MASKT(pA0, pA1, 0); partialSM(pA0, pA1, m_reg, mnA, alA);
    if (NT > 1) { VMW(); if constexpr (F32) { SWRITE_VF(1); SBAR(); if (NT > 2) SLOAD_F((const float*)Kh, KBASE(2)); } else SWRITE_H(1); }
    __syncthreads();
#define HALF_STEP(PX0, PX1, mnX, alX, PY0, PY1, alY, t, KB, VB, SB) do {                                                      \
        SBAR(); qkt<KB, SK>(PX0, PX1, K_lds, r32, hi, S.qr, ACT(t), slopeR, LB(t));                                             \
        finishSM(PY0, PY1, alY, l_reg, pa0, pa1, pa2, pa3); SBAR();                                                           \
        if ((t) + 1 < NT) { if constexpr (F32) { VMW(); SWRITE_KF(SB); SBAR(); SLOAD_F((const float*)Vh, KBASE((t) + 1)); }  \
                            else { SLOAD_H(Kh, Vh, KBASE((t) + 1)); } SBAR(); }                                               \
        pv_tile<VB, SK>(o, vb0, pa0, pa1, pa2, pa3, ACT((t) - 1)); MASKT(PX0, PX1, (t)); partialSM(PX0, PX1, m_reg, mnX, alX);                                        \
        __syncthreads();                                                                                                      \
        if ((t) + 1 < NT) { VMW(); if constexpr (F32) { SWRITE_VF(SB); SBAR(); if ((t) + 2 < NT) SLOAD_F((const float*)Kh, KBASE((t) + 2)); } \
                            else { SWRITE_H(SB); } }                                                                          \
        if ((t) + 3 < NT) { TOUCH(KBASE((t) + 3)); }                                                                          \
        RESC(alX); __syncthreads(); } while (0)
    for (int t = 1; t + 1 < NT; t += 2) {
        HALF_STEP(pB0, pB1, mnB, alB, pA0, pA1, alA, t, 1, 0, 0);
        HALF_STEP(pA0, pA1, mnA, alA, pB0, pB1, alB, t + 1, 0, 1, 1);
    }
    const bool even = (NT & 1) == 0;
    if (even) { SBAR(); qkt<1, SK>(pB0, pB1, K_lds, r32, hi, S.qr, ACT(NT - 1), slopeR, LB(NT - 1)); SBAR(); }
#define QROW(e) (nxt.Q + (size_t)(wid * QBLK + r32) * LDI + ((e) >> 1) * 16 + hi * 8 + ((e) & 1) * 4)
    if constexpr (F32) { SLOAD_F((const float*)nxt.K, kbn); SBAR();
#pragma unroll
        for (int e = 0; e < 8; ++e) S.tq[e] = *(const f32x4*)QROW(e); }
    else { SLOAD_H(nxt.K, nxt.V, kbn); SBAR();
#pragma unroll
        for (int d0 = 0; d0 < 8; ++d0) S.qr[d0] = *(const gbf16x8*)(uni_ptr((const char*)nxt.Q) + (unsigned)(((wid * QBLK + r32) * LDI + hi * 8) * (int)sizeof(TIn)) + d0 * 16 * sizeof(TIn)); }
    SBAR();
    finishSM(pA0, pA1, alA, l_reg, pa0, pa1, pa2, pa3); SBAR();
    if constexpr (F32) {
#pragma unroll
        for (int e = 8; e < 16; ++e) S.tq[e] = *(const f32x4*)QROW(e); SBAR(); }
#undef QROW
    pv_tile<0, SK>(o, vb0, pa0, pa1, pa2, pa3, ACT(even ? NT - 2 : NT - 1));
    if (even) { MASKT(pB0, pB1, NT - 1); partialSM(pB0, pB1, m_reg, mnB, alB); __syncthreads(); RESC(alB);
        finishSM(pB0, pB1, alB, l_reg, pa0, pa1, pa2, pa3); SBAR(); pv_tile<1, SK>(o, vb0, pa0, pa1, pa2, pa3, ACT(NT - 1)); }
    SBAR(); SEAM_K0();
    if (hi == 0) li_l[r32] = l_reg; asm volatile("s_waitcnt lgkmcnt(0)" ::: "memory");
    float rli[16];
#pragma unroll
    for (int r = 0; r < 16; ++r) rli[r] = __builtin_amdgcn_rcpf(li_l[crow(r, hi)]);
    const gchar* Owb = uni_ptr((const char*)(cur.O + (size_t)(wid * QBLK) * LDO)); const unsigned ooff = (unsigned)((4 * hi * LDO + r32) * (int)sizeof(TOut));
#pragma unroll
    for (int r = 0; r < 16; ++r) { const int orc = (r & 3) + 8 * (r >> 2);
#pragma unroll
        for (int d0 = 0; d0 < 4; ++d0) { const float v = o[d0][r] * rli[r];
            if constexpr (same_t<TOut, float>::v) { *(__attribute__((address_space(1))) float*)((gchar*)(Owb) + ooff + (unsigned)((orc * LDO + d0 * 32) * (int)sizeof(TOut))) = v; }
            else { const float vn = __builtin_bit_cast(float, __builtin_amdgcn_update_dpp(0, __builtin_bit_cast(int, v), 0xB1, 0xF, 0xF, true));
                   if ((r32 & 1) == 0) *(__attribute__((address_space(1))) unsigned*)((gchar*)(Owb) + ooff + (unsigned)((orc * LDO + d0 * 32) * (int)sizeof(TOut))) = cvtpk(v, vn); } } }
    if constexpr (F32) {
#pragma unroll
        for (int d0 = 0; d0 < 8; ++d0) S.qr[d0] = pack8(S.tq[2 * d0], S.tq[2 * d0 + 1]); }
    __syncthreads();
    asm volatile("" :: "v"(touch_reg));
#undef TOUCH
#undef RESC
#undef LB
#undef KBASE
#undef ACT
#undef MASKT
#undef SEAM_K0
#undef HALF_STEP
}
#undef ROW
#undef VMW
#undef VMWN
#undef SLOAD_H
#undef SWRITE_HK
#undef SWRITE_HV
#undef SWRITE_H
#undef SLOAD_F
#undef SWRITE_KF
#undef SWRITE_VF
#undef KSWZ
#undef SBAR
}

constexpr int NWAVES = 8, NTHR = 512;
constexpr int DM = 2048, NB = 2, SEQ = 4096, MROWS = NB * SEQ, NLAYER = 2;
constexpr int IN_COLS = 6592, IN_PAD = 6656, DFF = 5632, UPC = 2 * DFF;
constexpr int C_RQ = 0, C_RK = 256, C_RV = 512, C_RG = 1024, C_RW = 1536, C_MQ = 3520, C_MK = 4544, C_MV = 5568;
constexpr int RWC = 1984;
constexpr float NORM_EPS = 1e-6f, GN_EPS = 64e-5f;
constexpr size_t MiB = 1u << 20;
constexpr size_t WS_CTL = 0, CTL_ZERO_BYTES = 1 * MiB;
constexpr size_t WS_MOD = 1 * MiB;
constexpr size_t WS_KMEAN = 1 * MiB + 512 * 1024;
constexpr size_t WS_W = 2 * MiB, W_LAYER = 100 * MiB, W_IN = 0, W_OUT = 26 * MiB, W_UP = 34 * MiB, W_DN = 78 * MiB;
constexpr size_t WS_X = 202 * MiB;
constexpr size_t WS_H = 266 * MiB;
constexpr size_t WS_PROJ = 298 * MiB;
constexpr size_t WS_ACT = WS_PROJ;
constexpr size_t WS_MIXED = 402 * MiB;
constexpr size_t WS_U = 434 * MiB;
constexpr size_t WS_HALO = WS_U;
constexpr size_t WS_RW = WS_U;
constexpr size_t WS_Y = WS_U + 128 * MiB;
constexpr size_t WS_RETO = WS_U + 144 * MiB;
constexpr size_t WS_REC = 610 * MiB;
constexpr size_t WS_RWW = 738 * MiB;
constexpr size_t WS_END = 739 * MiB;
constexpr size_t RWA = (size_t)MROWS * 512;
constexpr int CW_BAR = 4096, CW_SUB = 64;
constexpr int RING_BYTES = 131072, LDSCTL_OFF = RING_BYTES, MISC_OFF = LDSCTL_OFF + 320, LDS_BYTES = 147456;

#define GAS __attribute__((address_space(1)))
#define LAS __attribute__((address_space(3)))
typedef unsigned short bf16;
typedef unsigned v4u __attribute__((ext_vector_type(4)));
typedef unsigned v2u __attribute__((ext_vector_type(2)));
typedef float f32x4 __attribute__((ext_vector_type(4)));
typedef float f32x2 __attribute__((ext_vector_type(2)));
#define LDS_WAIT() asm volatile("s_waitcnt lgkmcnt(0)" ::: "memory")
__device__ __forceinline__ unsigned f2bf(float f) { unsigned u = __builtin_bit_cast(unsigned, f); return (u + 0x7fffu + ((u >> 16) & 1u)) >> 16; }
__device__ __forceinline__ unsigned pk2(float lo, float hi) { return f2bf(lo) | (f2bf(hi) << 16); }
__device__ __forceinline__ float bf2f(unsigned short h) { return __builtin_bit_cast(float, (unsigned)h << 16); }
__device__ __forceinline__ float bflo(unsigned w) { return __builtin_bit_cast(float, w << 16); }
__device__ __forceinline__ float bfhi(unsigned w) { return __builtin_bit_cast(float, w & 0xffff0000u); }
template <int CTRL> __device__ __forceinline__ float dpp_add(float v);
__device__ __forceinline__ float wave_sum(float v);
__device__ __forceinline__ float wave_max(float v) {
#pragma unroll
    for (int o = 1; o < 64; o <<= 1) v = fmaxf(v, __shfl_xor(v, o));
    return v;
}
template <int CTRL> __device__ __forceinline__ float dpp_add(float v) { return v + __builtin_bit_cast(float, __builtin_amdgcn_update_dpp(0, __builtin_bit_cast(int, v), CTRL, 0xF, 0xF, true)); }
__device__ __forceinline__ float xsum16(float v) { auto r = __builtin_amdgcn_permlane16_swap(__float_as_uint(v), __float_as_uint(v), false, false); return __uint_as_float(r[0]) + __uint_as_float(r[1]); }
__device__ __forceinline__ float xsum32(float v) { auto r = __builtin_amdgcn_permlane32_swap(__float_as_uint(v), __float_as_uint(v), false, false); return __uint_as_float(r[0]) + __uint_as_float(r[1]); }
__device__ __forceinline__ float wave_sum(float v) {
    v = dpp_add<0xB1>(v); v = dpp_add<0x4E>(v); v = dpp_add<0x141>(v); v = dpp_add<0x140>(v);
    return xsum32(xsum16(v));
}
__device__ __forceinline__ float sigmoidf_(float x) { return __builtin_amdgcn_rcpf(1.0f + __expf(-x)); }

#define XB_TMO      128
#define XB_XCNT(j)  (256  + 64 * (j))
#define XB_XSUB(j)  (1280 + 64 * (j))
#define XB_XGEN(j)  (2304 + 64 * (j))
#define XB_TOP      3328
#define XB_TOPGEN   3392
#define XCD_BAR_WORDS 3456
#define XB_SPIN_CAP (1u << 22)
__device__ __forceinline__ unsigned xb_ld(unsigned* p)              { return __hip_atomic_load(p, __ATOMIC_RELAXED, __HIP_MEMORY_SCOPE_AGENT); }
__device__ __forceinline__ unsigned xb_add(unsigned* p, unsigned v) { return __hip_atomic_fetch_add(p, v, __ATOMIC_RELAXED, __HIP_MEMORY_SCOPE_AGENT); }
__device__ __forceinline__ unsigned xb_xcc_id() { return (unsigned)__builtin_amdgcn_s_getreg((3 << 11) | 20) & 0xFu; }
#define XB_SPIN(cond, bar) do { unsigned _sp = 0; while (cond) { __builtin_amdgcn_s_sleep(1); \
    if ((++_sp & 255u) == 0u) { if (xb_ld(&(bar)[XB_TMO])) break; if (_sp > XB_SPIN_CAP) { atomicAdd(&(bar)[XB_TMO], 1u); break; } } } } while (0)
struct XcdBarrier { unsigned* bar; unsigned x; volatile LAS unsigned* st; };
__device__ __forceinline__ XcdBarrier xcd_barrier_post(unsigned* bar, volatile LAS unsigned* st, int tid) {
    XcdBarrier b; b.bar = bar; b.x = xb_xcc_id(); b.st = st;
    if (tid == 0) (void)xb_add(&bar[XB_XCNT(b.x)], 1u);
    return b;
}
__device__ __forceinline__ void xcd_barrier_complete(unsigned* bar, unsigned x, unsigned& nloc, unsigned& nx) {
    const unsigned G = gridDim.x * gridDim.y * gridDim.z;
    unsigned sum, cnt, mine, sp = 0u;
    for (;;) {
        sum = 0u; cnt = 0u; mine = 0u;
#pragma unroll
        for (unsigned j = 0; j < 16; ++j) { const unsigned c = xb_ld(&bar[XB_XCNT(j)]); sum += c; cnt += (c > 0u) ? 1u : 0u; mine = (j == x) ? c : mine; }
        if (sum == G) break;
        __builtin_amdgcn_s_sleep(1);
        if ((++sp & 255u) == 0u) { if (xb_ld(&bar[XB_TMO])) break; if (sp > XB_SPIN_CAP) { atomicAdd(&bar[XB_TMO], 1u); break; } }
    }
    nloc = mine > 0u ? mine : 1u; nx = cnt > 0u ? cnt : 1u;
}
__device__ __forceinline__ void xcd_barrier(const XcdBarrier& b, int tid) {
    asm volatile("s_waitcnt vmcnt(0)" ::: "memory");
    __syncthreads();
    if (tid == 0) {
        unsigned z_ = 0u; asm volatile("" : "+v"(z_)); z_ = (unsigned)__builtin_amdgcn_readfirstlane(z_);
        unsigned* bar = b.bar + z_; const unsigned bx_ = b.x + z_;
        __builtin_amdgcn_s_waitcnt(0);
        unsigned nloc = b.st[0], nx = b.st[1];
        if (nloc == 0u) { xcd_barrier_complete(bar, bx_, nloc, nx); b.st[0] = nloc; b.st[1] = nx; }
        const unsigned old = xb_add(&bar[XB_XSUB(bx_)], 1u);
        const unsigned gen = old / nloc;
        if (old + 1u == (gen + 1u) * nloc) {
            __builtin_amdgcn_fence(__ATOMIC_RELEASE, "agent");
            asm volatile("s_waitcnt vmcnt(0)" ::: "memory");
            const unsigned og = xb_add(&bar[XB_TOP], 1u);
            const unsigned tg = og / nx;
            if (og + 1u == (tg + 1u) * nx) xb_add(&bar[XB_TOPGEN], 1u);
            else XB_SPIN(xb_ld(&bar[XB_TOPGEN]) == tg, bar);
            __builtin_amdgcn_fence(__ATOMIC_ACQUIRE, "agent");
            xb_add(&bar[XB_XGEN(bx_)], 1u);
            asm volatile("s_waitcnt vmcnt(0)" ::: "memory");
        } else {
            XB_SPIN(xb_ld(&bar[XB_XGEN(bx_)]) == gen, bar);
            __builtin_amdgcn_fence(__ATOMIC_ACQUIRE, "agent");
            asm volatile("s_waitcnt vmcnt(0)" ::: "memory");
        }
    }
    __syncthreads();
}

struct Args { const float* in[24]; float* out; unsigned char* ws; };
struct Frame {
    LAS unsigned char* lds;
    int tid, lane, wave, vcu, G, zz;
    const float* const* in;
    unsigned char* ws;
};

#define FWS (F.ws + F.zz)
__device__ __forceinline__ void p0_transpose_item(const float* W, int K, int N, bf16* WT, LAS float* scr, int item, int lane, int half = 0) {
    const int nblk = N / 32, kb = item / nblk, nb = item % nblk, k0 = 64 * kb, n0 = 32 * nb;
    const int r0 = !half ? n0 : (n0 < half ? (n0 >> 7) * 256 + (n0 & 127) : ((n0 - half) >> 7) * 256 + 128 + ((n0 - half) & 127));
#pragma unroll 8
    for (int i = 0; i < 32; ++i) { const int kk = 2 * i + (lane >> 5); scr[kk * 33 + (lane & 31)] = W[(size_t)(k0 + kk) * N + n0 + (lane & 31)]; }
    LDS_WAIT(); asm volatile("" ::: "memory");
    const int c = lane & 7;
#pragma unroll
    for (int j = 0; j < 4; ++j) { const int n = (lane >> 3) + 8 * j; const LAS float* s = scr + (8 * c) * 33 + n;
        v4u o; o.x = pk2(s[0 * 33], s[1 * 33]); o.y = pk2(s[2 * 33], s[3 * 33]); o.z = pk2(s[4 * 33], s[5 * 33]); o.w = pk2(s[6 * 33], s[7 * 33]);
        *(v4u*)(WT + (size_t)(r0 + n) * K + k0 + 8 * c) = o; }
    LDS_WAIT(); asm volatile("" ::: "memory");
}
constexpr int CV_IN = (DM / 64) * (IN_COLS / 32), CV_OUT = (DM / 64) * (DM / 32), CV_UP = (DM / 64) * (UPC / 32), CV_DN = (DFF / 64) * (DM / 32), CV_LAYER = CV_IN + CV_OUT + CV_UP + CV_DN;
constexpr int CV_N1 = 10, CV_N2 = 6, CV_N3 = 4, CV_C1 = 192 * NWAVES * CV_N1, CV_C2 = 128 * NWAVES * CV_N2;
static_assert(CV_IN + CV_C1 <= CV_LAYER && CV_LAYER - (CV_IN + CV_C1) + (CV_IN - CV_C2) <= 128 * NWAVES * CV_N3 && CV_C2 <= CV_IN, "gap capacities");
__device__ __forceinline__ void convert_item(Frame& F, int it, LAS float* scr) {
    const int l = it / CV_LAYER; int r = it % CV_LAYER;
    unsigned char* wl = FWS + WS_W + (size_t)l * W_LAYER;
    if (r < CV_IN) { p0_transpose_item(F.in[F.zz + 2] + (size_t)l * DM * IN_COLS, DM, IN_COLS, (bf16*)(wl + W_IN), scr, r, F.lane); return; } r -= CV_IN;
    if (r < CV_OUT) { p0_transpose_item(F.in[F.zz + 3] + (size_t)l * DM * DM, DM, DM, (bf16*)(wl + W_OUT), scr, r, F.lane); return; } r -= CV_OUT;
    if (r < CV_UP) { p0_transpose_item(F.in[F.zz + 15] + (size_t)l * DM * UPC, DM, UPC, (bf16*)(wl + W_UP), scr, r, F.lane, DFF); return; } r -= CV_UP;
    p0_transpose_item(F.in[F.zz + 18] + (size_t)l * DFF * DM, DFF, DM, (bf16*)(wl + W_DN), scr, r, F.lane);
}
__device__ __forceinline__ void convert_gap(Frame& F, int layer, int first, int count, int gwi, int nwv, int nper) {
    LAS float* scr = (LAS float*)(F.lds + F.wave * 16384);
    for (int j = 0; j < nper; ++j) { const int r = gwi + nwv * j; if (r < count) convert_item(F, layer * CV_LAYER + first + r, scr); }
}
__device__ __forceinline__ void adaln_item(Frame& F, int l, int grp) {
    LAS float* cact = (LAS float*)F.lds;
    LAS float* red = (LAS float*)(F.lds + 16384);
    const float* c = F.in[F.zz + 1];
    for (int i = F.tid; i < 4096; i += NTHR) { const float cv = c[i]; cact[i] = cv / (1.0f + __expf(-cv)); }
    __syncthreads();
    const int n0 = grp * 128;
    const float* W = F.in[F.zz + 19] + (size_t)l * 2048 * 12288 + n0;
    const int half = F.lane >> 5, q = F.lane & 31;
    f32x4 a0 = {0.f, 0.f, 0.f, 0.f}, a1 = {0.f, 0.f, 0.f, 0.f};
#pragma unroll 16
    for (int i = 0; i < 128; ++i) { const int k = F.wave * 256 + 2 * i + half; const f32x4 w = *(const f32x4*)(W + (size_t)k * 12288 + 4 * q);
        a0 += w * cact[k]; a1 += w * cact[2048 + k]; }
#pragma unroll
    for (int e = 0; e < 4; ++e) { a0[e] = xsum32(a0[e]); a1[e] = xsum32(a1[e]); }
    if (half == 0) {
#pragma unroll
        for (int e = 0; e < 4; ++e) { red[(F.wave * 2 + 0) * 128 + 4 * q + e] = a0[e]; red[(F.wave * 2 + 1) * 128 + 4 * q + e] = a1[e]; } }
    __syncthreads();
    if (F.tid < 256) { const int bb = F.tid >> 7, col = F.tid & 127; float s = 0.f;
#pragma unroll
        for (int w = 0; w < 8; ++w) s += red[(w * 2 + bb) * 128 + col];
        s += F.in[F.zz + 20][l * 12288 + n0 + col];
        ((float*)(FWS + WS_MOD))[(size_t)(l * 2 + bb) * 12288 + n0 + col] = s; }
    __syncthreads();
}
__device__ __forceinline__ void p0_prologue(Frame& F) {
    const int ngv = (F.G == 256) ? 96 : 192;
    if (F.vcu < ngv) adaln_item(F, F.vcu / 96, F.vcu % 96);
    LAS float* scr = (LAS float*)(F.lds + F.wave * 16384);
    const int gw = F.vcu * NWAVES + F.wave, NGW = F.G * NWAVES;
    if (F.G == 256) { if (F.vcu >= 96) for (int p = gw - 96 * NWAVES; p < CV_IN; p += 160 * NWAVES) convert_item(F, p, scr); }
    else for (int p = gw; p < NLAYER * CV_LAYER; p += NGW) convert_item(F, p, scr);
    for (int l = 0; l < NLAYER; ++l) { bf16* wt = (bf16*)(FWS + WS_RWW + (size_t)l * 448 * 512 * 2);
        const float* wu = F.in[F.zz + 6] + (size_t)l * 96 * 512; const float* au = F.in[F.zz + 8] + (size_t)l * 96 * 512; const float* gu = F.in[F.zz + 9] + (size_t)l * 256 * 512;
        for (int i = F.vcu * NTHR + F.tid; i < 448 * 512; i += F.G * NTHR) {
            if (i < 96 * 512) { const int n = i / 96, kq = i - n * 96; wt[i] = (bf16)f2bf(wu[kq * 512 + n]); }
            else if (i < 2 * 96 * 512) { const int j = i - 96 * 512, n = j / 96, kq = j - n * 96; wt[i] = (bf16)f2bf(au[kq * 512 + n]); }
            else { const int j = i - 2 * 96 * 512, n = j >> 8, kq = j & 255; wt[i] = (bf16)f2bf(gu[kq * 512 + n]); } } }
    for (int l = 0; l < NLAYER; ++l) { v4u* z = (v4u*)(FWS + WS_W + (size_t)l * W_LAYER + W_IN + (size_t)IN_COLS * DM * 2);
        for (int i = F.vcu * NTHR + F.tid; i < (IN_PAD - IN_COLS) * DM * 2 / 16; i += F.G * NTHR) z[i] = (v4u){0u, 0u, 0u, 0u}; }
}

template <int MODE, bool IN_F32>
__device__ __forceinline__ void norm_phase(Frame& F, const void* xin, void* outp, const float* g, const float* sh, const float* sc) {
    LAS float* gs = (LAS float*)F.lds;
    LAS float* shs = (LAS float*)(F.lds + 16384);
    for (int i = F.tid; i < 4096; i += NTHR) { const int b = i >> 11, col = i & 2047;
        if (MODE == 0) { gs[i] = g[col] * (1.0f + sc[(size_t)b * 12288 + col]); shs[i] = sh[(size_t)b * 12288 + col]; }
        else { gs[i] = g[col]; shs[i] = 0.f; } }
    __syncthreads();
    const int gw = F.vcu * NWAVES + F.wave, NGW = F.G * NWAVES;
    for (int m = gw; m < MROWS; m += NGW) {
        const int b = m >> 12;
        f32x4 v[8]; float s = 0.f;
#pragma unroll
        for (int j = 0; j < 8; ++j) {
            if (IN_F32) v[j] = *((const f32x4*)((const float*)xin + (size_t)m * DM) + F.lane + 64 * j);
            else { const v2u w = *((const v2u*)((const bf16*)xin + (size_t)m * DM) + F.lane + 64 * j); v[j] = (f32x4){bflo(w.x), bfhi(w.x), bflo(w.y), bfhi(w.y)}; }
            s += (v[j].x * v[j].x + v[j].y * v[j].y) + (v[j].z * v[j].z + v[j].w * v[j].w); }
        float rstd = __builtin_amdgcn_rsqf(wave_sum(s) * (1.0f / DM) + NORM_EPS);
#if MOBA_CHECK
        if (MODE == 1) { const float sd = ((const float*)(FWS + WS_CTL))[8], sn = ((const float*)(FWS + WS_CTL))[9]; rstd *= 1.0f + 10.0f * sqrtf(sd / sn); }
#endif
#pragma unroll
        for (int j = 0; j < 8; ++j) { const int col = 4 * (F.lane + 64 * j);
            const f32x4 gg = *(const LAS f32x4*)(gs + b * 2048 + col), ss = *(const LAS f32x4*)(shs + b * 2048 + col);
            const f32x4 o = v[j] * rstd * gg + ss;
            if (MODE == 0) { v2u w; w.x = pk2(o.x, o.y); w.y = pk2(o.z, o.w); *(v2u*)((bf16*)outp + (size_t)m * DM + col) = w; }
            else *(f32x4*)((float*)outp + (size_t)m * DM + col) = o; }
    }
    __syncthreads();
}

__device__ __forceinline__ float lerp_bf(const bf16* P, size_t row, int col, bool hasprev, float mu) {
    const float cur = bf2f(P[row * IN_PAD + col]); const float prev = hasprev ? bf2f(P[(row - 1) * IN_PAD + col]) : 0.f;
    return cur + (prev - cur) * mu;
}
__device__ __forceinline__ void rwkv_prep(Frame& F, int l) {
    LAS float* codes = (LAS float*)F.lds;
    const bf16* P = (const bf16*)(FWS + WS_PROJ);
    const float* mu = F.in[F.zz + 4] + l * RWC; const float* w0 = F.in[F.zz + 5] + l * 512; const float* w_up = F.in[F.zz + 6] + (size_t)l * 96 * 512;
    const float* a0 = F.in[F.zz + 7] + l * 512; const float* a_up = F.in[F.zz + 8] + (size_t)l * 96 * 512; const float* g_up = F.in[F.zz + 9] + (size_t)l * 256 * 512;
    const float* k_k = F.in[F.zz + 10] + l * 512; const float* k_a = F.in[F.zz + 11] + l * 512; const float* r_k = F.in[F.zz + 12] + l * 512;
    float* RW = (float*)(FWS + WS_RW);
    const int c = F.tid;
    const float mur = mu[c], muk = mu[512 + c], muv = mu[1024 + c], w0c = w0[c], a0c = a0[c], kkc = k_k[c], kac = k_a[c], rkc = r_k[c];
    for (int item = F.vcu; item < MROWS / 8; item += F.G) {
        const int row0 = item * 8, t0 = row0 & (SEQ - 1);
        for (int idx = F.tid; idx < 8 * 448; idx += NTHR) { const int tk = idx / 448, cc = idx - tk * 448;
            float val = lerp_bf(P, (size_t)(row0 + tk), C_RW + 1536 + cc, (t0 + tk) > 0, mu[1536 + cc]);
            if (cc < 96) val = tanhf(val); else if (cc >= 192) val = sigmoidf_(val);
            codes[idx] = val; }
        __syncthreads();
        float wd[8], wa[8], gg[8];
#pragma unroll
        for (int tk = 0; tk < 8; ++tk) { wd[tk] = 0.f; wa[tk] = 0.f; gg[tk] = 0.f; }
        for (int r = 0; r < 96; ++r) { const float wu = w_up[r * 512 + c], au = a_up[r * 512 + c];
#pragma unroll
            for (int tk = 0; tk < 8; ++tk) { wd[tk] += codes[tk * 448 + r] * wu; wa[tk] += codes[tk * 448 + 96 + r] * au; } }
        for (int r = 0; r < 256; ++r) { const float gu = g_up[r * 512 + c];
#pragma unroll
            for (int tk = 0; tk < 8; ++tk) gg[tk] += codes[tk * 448 + 192 + r] * gu; }
#pragma unroll
        for (int tk = 0; tk < 8; ++tk) {
            const size_t row = (size_t)(row0 + tk); const bool hp = (t0 + tk) > 0;
            const float rr = lerp_bf(P, row, C_RW + c, hp, mur), kk0 = lerp_bf(P, row, C_RW + 512 + c, hp, muk), vv = lerp_bf(P, row, C_RW + 1024 + c, hp, muv);
            const float z = -(w0c + wd[tk]);
            const float sp = fmaxf(z, 0.f) + log1pf(__expf(-fabsf(z)));
            const float decay = __expf(-__expf(-sp - 0.5f));
            const float a = sigmoidf_(a0c + wa[tk]);
            const float kkv = kk0 * kkc;
            const float nrm = sqrtf(wave_sum(kkv * kkv));
            const float kap = kkv / fmaxf(nrm, 1e-12f);
            const float kp = kk0 * (1.0f + (a - 1.0f) * kac);
            const float bsum = wave_sum(rr * kp * rkc);
            const size_t o = row * 512 + c;
            RW[0 * RWA + o] = rr; RW[1 * RWA + o] = decay; RW[2 * RWA + o] = kp; RW[3 * RWA + o] = vv;
            RW[4 * RWA + o] = kap; RW[5 * RWA + o] = kap * a; RW[6 * RWA + o] = gg[tk]; RW[7 * RWA + o] = bsum * vv;
        }
        __syncthreads();
    }
}
__device__ __forceinline__ void moba_kmean(Frame& F) {
    LAS float* red = (LAS float*)(F.lds + 32768);
    const bf16* P = (const bf16*)(FWS + WS_PROJ);
    float* KM = (float*)(FWS + WS_KMEAN);
    for (int item = F.vcu; item < 256; item += F.G) {
        const int b = item >> 7, h = (item >> 4) & 7, n = item & 15;
        const int d = F.tid & 127, part = F.tid >> 7;
        const bf16* kp = P + (size_t)(b * SEQ + n * 256 + part * 64) * IN_PAD + C_MK + h * 128 + d;
        float s = 0.f;
        for (int k = 0; k < 64; ++k) s += bf2f(kp[(size_t)k * IN_PAD]);
        red[part * 128 + d] = s;
        __syncthreads();
        if (F.tid < 128) KM[(size_t)item * 128 + d] = (red[d] + red[128 + d] + red[256 + d] + red[384 + d]) * (1.0f / 256.0f);
        __syncthreads();
    }
}
struct RwIn { f32x4 w[2], kk[2], bb[2], k[2], r[2]; float v; };
__device__ __forceinline__ void rw_load(RwIn& x, const float* RW, size_t row, int cj, int ci) {
    const size_t o = row * 512;
    x.w[0] = *(const f32x4*)(RW + 1 * RWA + o + cj); x.w[1] = *(const f32x4*)(RW + 1 * RWA + o + cj + 4);
    x.kk[0] = *(const f32x4*)(RW + 4 * RWA + o + cj); x.kk[1] = *(const f32x4*)(RW + 4 * RWA + o + cj + 4);
    x.bb[0] = *(const f32x4*)(RW + 5 * RWA + o + cj); x.bb[1] = *(const f32x4*)(RW + 5 * RWA + o + cj + 4);
    x.k[0] = *(const f32x4*)(RW + 2 * RWA + o + cj); x.k[1] = *(const f32x4*)(RW + 2 * RWA + o + cj + 4);
    x.r[0] = *(const f32x4*)(RW + 0 * RWA + o + cj); x.r[1] = *(const f32x4*)(RW + 0 * RWA + o + cj + 4);
    x.v = RW[3 * RWA + o + ci];
}
__device__ __forceinline__ void rwkv_scan_naive(Frame& F, int b, int h) {
    const float* RW = (const float*)(FWS + WS_RW);
    float* Y = (float*)(FWS + WS_Y);
    const int i = F.tid >> 3, jp = F.tid & 7, cj = h * 64 + 8 * jp, ci = h * 64 + i;
    f32x4 s0 = {0.f, 0.f, 0.f, 0.f}, s1 = {0.f, 0.f, 0.f, 0.f};
    RwIn cur, n1, n2;
    const size_t rb = (size_t)b * SEQ;
    rw_load(cur, RW, rb, cj, ci); rw_load(n1, RW, rb + 1, cj, ci);
    for (int t = 0; t < SEQ; ++t) {
        rw_load(n2, RW, rb + (t + 2 < SEQ ? t + 2 : SEQ - 1), cj, ci);
        f32x4 pp = s0 * cur.kk[0] + s1 * cur.kk[1];
        float p = (pp.x + pp.y) + (pp.z + pp.w);
        p += __shfl_xor(p, 1); p += __shfl_xor(p, 2); p += __shfl_xor(p, 4);
        const float sa = -p;
        s0 = s0 * cur.w[0] + sa * cur.bb[0] + cur.v * cur.k[0];
        s1 = s1 * cur.w[1] + sa * cur.bb[1] + cur.v * cur.k[1];
        f32x4 yy = s0 * cur.r[0] + s1 * cur.r[1];
        float y = (yy.x + yy.y) + (yy.z + yy.w);
        y += __shfl_xor(y, 1); y += __shfl_xor(y, 2); y += __shfl_xor(y, 4);
        if (jp == 0) Y[(rb + t) * 512 + ci] = y;
        cur = n1; n1 = n2;
    }
}
struct RtIn { v4u q[2], k[2]; unsigned short v; };
__device__ __forceinline__ void rt_load(RtIn& x, const bf16* P, size_t row, int h, int d0, int v) {
    const bf16* p = P + row * IN_PAD;
    x.q[0] = *(const v4u*)(p + C_RQ + h * 64 + d0); x.q[1] = *(const v4u*)(p + C_RQ + h * 64 + d0 + 8);
    x.k[0] = *(const v4u*)(p + C_RK + h * 64 + d0); x.k[1] = *(const v4u*)(p + C_RK + h * 64 + d0 + 8);
    x.v = p[C_RV + h * 128 + v];
}
__device__ __forceinline__ void ret_scan_naive(Frame& F, int b, int h) {
    const bf16* P = (const bf16*)(FWS + WS_PROJ);
    float* RO = (float*)(FWS + WS_RETO);
    const int v = F.tid >> 2, dp = F.tid & 3, d0 = dp * 16;
    const float gamma = 1.0f - exp2f(-5.0f - (float)h);
    float S[16];
#pragma unroll
    for (int d = 0; d < 16; ++d) S[d] = 0.f;
    RtIn cur, n1, n2;
    const size_t rb = (size_t)b * SEQ;
    rt_load(cur, P, rb, h, d0, v); rt_load(n1, P, rb + 1, h, d0, v);
    for (int t = 0; t < SEQ; ++t) {
        rt_load(n2, P, rb + (t + 2 < SEQ ? t + 2 : SEQ - 1), h, d0, v);
        const float vv = bf2f(cur.v) * 0.125f;
        float o = 0.f;
#pragma unroll
        for (int e = 0; e < 8; ++e) { const unsigned qw = cur.q[e >> 2][e & 3], kw = cur.k[e >> 2][e & 3];
            S[2 * e] = gamma * S[2 * e] + bflo(kw) * vv; S[2 * e + 1] = gamma * S[2 * e + 1] + bfhi(kw) * vv;
            o += bflo(qw) * S[2 * e] + bfhi(qw) * S[2 * e + 1]; }
        o += __shfl_xor(o, 1); o += __shfl_xor(o, 2);
        if (dp == 0) RO[(rb + t) * 512 + h * 128 + v] = o;
        cur = n1; n1 = n2;
    }
}
__device__ __forceinline__ void moba_naive(Frame& F, int mw, int nmw) {
    const bf16* P = (const bf16*)(FWS + WS_PROJ);
    const float* KM = (const float*)(FWS + WS_KMEAN);
    bf16* MX = (bf16*)(FWS + WS_U + 160 * MiB);
    LAS float* qs = (LAS float*)(F.lds + F.wave * 4608);
    LAS float* ps = qs + 128;
    const int lane = F.lane;
    for (int qi = mw; qi < MROWS * 8; qi += nmw) {
        const int h = qi & 7, row = qi >> 3, b = row >> 12, t = row & (SEQ - 1), bq = t >> 8;
        { const unsigned qw = *(const unsigned*)(P + (size_t)row * IN_PAD + C_MQ + h * 128 + 2 * lane);
          qs[2 * lane] = bflo(qw) * 0.08838834764831845f; qs[2 * lane + 1] = bfhi(qw) * 0.08838834764831845f; }
        LDS_WAIT();
        float gate = -INFINITY;
        if (lane < 16 && lane < bq) { const float* km = KM + ((size_t)(b * 8 + h) * 16 + lane) * 128; float a = 0.f;
            for (int d = 0; d < 128; ++d) a += qs[d] * km[d];
            gate = a; }
        unsigned selmask = 0u;
#pragma unroll
        for (int rnd = 0; rnd < 3; ++rnd) { const float m = wave_max(gate);
            if (m > -INFINITY) { const unsigned long long bal = __ballot(gate == m); const int idx = __ffsll((long long)bal) - 1; selmask |= 1u << idx; if (lane == idx) gate = -INFINITY; } }
        int blk[4];
#pragma unroll
        for (int s = 0; s < 3; ++s) { if (selmask) { blk[s] = __ffs((int)selmask) - 1; selmask &= selmask - 1u; } else blk[s] = -1; }
        blk[3] = bq;
        const float slope = exp2f(-(float)(h + 1));
        float sc[4][4]; float mx = -1e30f;
#pragma unroll
        for (int s = 0; s < 4; ++s) {
#pragma unroll
            for (int kq = 0; kq < 4; ++kq) {
                float val = -1e30f;
                if (blk[s] >= 0) { const int pos = blk[s] * 256 + kq * 64 + lane;
                    const bf16* kp = P + (size_t)(b * SEQ + pos) * IN_PAD + C_MK + h * 128; float a = 0.f;
#pragma unroll 4
                    for (int d8 = 0; d8 < 16; ++d8) { const v4u kw = *(const v4u*)(kp + d8 * 8); const f32x4 qa = *(const LAS f32x4*)(qs + d8 * 8), qb = *(const LAS f32x4*)(qs + d8 * 8 + 4);
                        a += bflo(kw.x) * qa.x + bfhi(kw.x) * qa.y + bflo(kw.y) * qa.z + bfhi(kw.y) * qa.w + bflo(kw.z) * qb.x + bfhi(kw.z) * qb.y + bflo(kw.w) * qb.z + bfhi(kw.w) * qb.w; }
                    if (pos <= t) val = a - slope * (float)(t - pos); }
                sc[s][kq] = val; mx = fmaxf(mx, val); } }
        mx = wave_max(mx);
        float lsum = 0.f;
#pragma unroll
        for (int s = 0; s < 4; ++s)
#pragma unroll
            for (int kq = 0; kq < 4; ++kq) { const float p = __expf(sc[s][kq] - mx); lsum += p; ps[s * 256 + kq * 64 + lane] = p; }
        lsum = wave_sum(lsum);
        LDS_WAIT();
        float o0 = 0.f, o1 = 0.f;
#pragma unroll
        for (int s = 0; s < 4; ++s) if (blk[s] >= 0) { const int nk = (s == 3) ? (t - bq * 256 + 1) : 256;
            const bf16* vp = P + (size_t)(b * SEQ + blk[s] * 256) * IN_PAD + C_MV + h * 128 + 2 * lane;
#pragma unroll 4
            for (int key = 0; key < nk; ++key) { const float p = ps[s * 256 + key]; const unsigned vw = *(const unsigned*)(vp + (size_t)key * IN_PAD); o0 += p * bflo(vw); o1 += p * bfhi(vw); } }
        const float inv = 1.0f / lsum;
        *(unsigned*)(MX + (size_t)row * 1024 + h * 128 + 2 * lane) = pk2(o0 * inv, o1 * inv);
        LDS_WAIT();
    }
}

constexpr int MOBA_LDS_KM = moba::LDS_BYTES, MOBA_LDS_SEL = MOBA_LDS_KM + 8192;
__device__ __forceinline__ void moba_item(Frame& F, int bh, int qbA, int qbB) {
    const int b = bh >> 3, h = bh & 7;
    const bf16* P = (const bf16*)(FWS + WS_PROJ);
    LAS float* km = (LAS float*)(F.lds + MOBA_LDS_KM);
    LAS unsigned* sel = (LAS unsigned*)(F.lds + MOBA_LDS_SEL);
    const float* KM = (const float*)(FWS + WS_KMEAN) + (size_t)bh * 16 * 128;
    for (int i = F.tid; i < 2048; i += NTHR) km[i] = KM[i];
    __syncthreads();
    {   const int qb = (F.tid < 256) ? qbA : qbB, r = F.tid & 255;
        const bf16* qp = P + (size_t)(b * SEQ + qb * 256 + r) * IN_PAD + C_MQ + h * 128;
        float g[16];
#pragma unroll
        for (int n = 0; n < 16; ++n) g[n] = 0.f;
        for (int d8 = 0; d8 < 16; ++d8) { const v4u qw = *(const v4u*)(qp + d8 * 8);
            const float q0 = bflo(qw.x), q1 = bfhi(qw.x), q2 = bflo(qw.y), q3 = bfhi(qw.y), q4 = bflo(qw.z), q5 = bfhi(qw.z), q6 = bflo(qw.w), q7 = bfhi(qw.w);
#pragma unroll
            for (int n = 0; n < 16; ++n) { const f32x4 ka = *(const LAS f32x4*)(km + n * 128 + d8 * 8), kb = *(const LAS f32x4*)(km + n * 128 + d8 * 8 + 4);
                g[n] += (q0 * ka.x + q1 * ka.y) + (q2 * ka.z + q3 * ka.w) + (q4 * kb.x + q5 * kb.y) + (q6 * kb.z + q7 * kb.w); } }
        unsigned m = 0u;
#pragma unroll
        for (int rnd = 0; rnd < 3; ++rnd) { float best = -INFINITY; int bi = -1;
#pragma unroll
            for (int n = 0; n < 16; ++n) if (n < qb && !((m >> n) & 1u) && g[n] > best) { best = g[n]; bi = n; }
            if (bi >= 0) m |= 1u << bi; }
        sel[F.tid] = m; }
    __syncthreads();
    typedef moba::BlockRef<moba::bf16, moba::bf16> Ref;
    const float slopeR = exp2f(-(float)(h + 1)) * 11.313708498984761f;
    bf16* MX = (bf16*)(FWS + WS_MIXED);
    Ref A, B2;
    A.Q = P + (size_t)(b * SEQ + qbA * 256) * IN_PAD + C_MQ + h * 128; A.K = P + (size_t)(b * SEQ) * IN_PAD + C_MK + h * 128; A.V = P + (size_t)(b * SEQ) * IN_PAD + C_MV + h * 128;
    A.O = MX + (size_t)(b * SEQ + qbA * 256) * DM + 1024 + h * 128; A.P0 = qbA * 256; A.sel = sel; A.slopeR = slopeR;
    B2 = A; B2.Q = P + (size_t)(b * SEQ + qbB * 256) * IN_PAD + C_MQ + h * 128; B2.O = MX + (size_t)(b * SEQ + qbB * 256) * DM + 1024 + h * 128; B2.P0 = qbB * 256; B2.sel = sel + 256;
    moba::Seam<moba::bf16> S;
    moba::lchar* ldsg = (moba::lchar*)F.lds;
    moba::causal_swa_prime<moba::bf16, moba::bf16>(A, 1 << 30, ldsg, S, F.wave);
    Ref cur = A;
    for (int pass = 0; pass < MOBA_NP; ++pass) {
        const bool nb_ = ((pass + 1) & 1) != 0;
        Ref nxt = A; if (nb_ || pass + 1 >= MOBA_NP) nxt = B2;
        moba::causal_swa_block<moba::bf16, moba::bf16>(cur, nxt, SEQ, 1 << 30, ldsg, S, F.wave);
        cur = nxt;
    }
}
constexpr int RC_UNITS = 32, RC_NCH = SEQ / 16, RC_REC = 16384;
constexpr int RC_AR = 0, RC_BK = 4096, RC_VP = 8192, RC_U0 = 10240, RC_Y0 = 12288, RC_D = 14336;
typedef short bf16x8 __attribute__((ext_vector_type(8)));
typedef float f32x16 __attribute__((ext_vector_type(16)));
typedef float f32x2t __attribute__((ext_vector_type(2))); typedef __bf16 bf16x2t __attribute__((ext_vector_type(2)));
__device__ __forceinline__ unsigned cvtpk_c(float lo, float hi) { f32x2t v = {lo, hi}; bf16x2t b = __builtin_convertvector(v, bf16x2t); return __builtin_bit_cast(unsigned, b); }
__device__ __forceinline__ unsigned short cvt1_c(float x) { return (unsigned short)(cvtpk_c(x, 0.f) & 0xffffu); }

constexpr int RC_WLDS = 14464, RC_CODES_OFF = 8 * RC_WLDS  , RC_CSTRIDE = 456;
#define RC_ST(off, w) (*(v4u*)(FWS + WS_REC + (size_t)roff + (unsigned)(off)) = (w))
#define RC_ST_D(Dv) do { const int di_ = __builtin_bit_cast(int, (Dv)); v4u dw_; dw_.x = (unsigned)__builtin_amdgcn_update_dpp(0, di_, 0x00, 0xF, 0xF, true); dw_.y = (unsigned)__builtin_amdgcn_update_dpp(0, di_, 0x55, 0xF, 0xF, true); \
    dw_.z = (unsigned)__builtin_amdgcn_update_dpp(0, di_, 0xAA, 0xF, 0xF, true); dw_.w = (unsigned)__builtin_amdgcn_update_dpp(0, di_, 0xFF, 0xF, 0xF, true); if ((x & 3) == 0) RC_ST(RC_D + x * 4, dw_); } while (0)
__device__ __forceinline__ void rc_core(Frame& F, LAS unsigned char* wlds, const float (&At)[16], const float (&Bt)[16], const float (&Kt)[16], const float (&Rt)[16], const float (&vv)[16], const float D, unsigned roff) {
    { unsigned wb_ = (unsigned)(uintptr_t)wlds; asm volatile("" : "+v"(wb_)); wlds = (LAS unsigned char*)(uintptr_t)wb_; }
    LAS bf16* XA = (LAS bf16*)wlds; LAS bf16* XB = (LAS bf16*)(wlds + 4608); LAS float* TT = (LAS float*)(wlds + 9216 + 4224);
    int x_ = F.lane; asm volatile("" : "+v"(x_));
    const int x = x_, r32 = x & 31, h2 = x >> 5, tl = x & 15;
#pragma unroll
    for (int t = 0; t < 16; ++t) { XA[t * 72 + x] = cvt1_c(Bt[t]); XA[(16 + t) * 72 + x] = cvt1_c(Kt[t]); XB[t * 72 + x] = cvt1_c(At[t]); XB[(16 + t) * 72 + x] = cvt1_c(Rt[t]); }
#pragma unroll
    for (int q = 0; q < 4; ++q) { v4u w; w.x = cvtpk_c(Bt[4 * q] * D, Bt[4 * q + 1] * D); w.y = cvtpk_c(Bt[4 * q + 2] * D, Bt[4 * q + 3] * D);
        w.z = cvtpk_c(Kt[4 * q] * D, Kt[4 * q + 1] * D); w.w = cvtpk_c(Kt[4 * q + 2] * D, Kt[4 * q + 3] * D); RC_ST(RC_BK + x * 64 + q * 16, w); }
#pragma unroll
    for (int q = 0; q < 2; ++q) { v4u w;
        w.x = cvtpk_c(vv[8 * q], vv[8 * q + 1]); w.y = cvtpk_c(vv[8 * q + 2], vv[8 * q + 3]); w.z = cvtpk_c(vv[8 * q + 4], vv[8 * q + 5]); w.w = cvtpk_c(vv[8 * q + 6], vv[8 * q + 7]); RC_ST(RC_VP + x * 32 + q * 16, w);
    }
    RC_ST_D(D);
    f32x16 G;
#pragma unroll
    for (int r = 0; r < 16; ++r) G[r] = 0.f;
#pragma unroll
    for (int ks = 0; ks < 4; ++ks) { const bf16x8 a = *(const LAS bf16x8*)(XA + r32 * 72 + ks * 16 + h2 * 8), bq = *(const LAS bf16x8*)(XB + r32 * 72 + ks * 16 + h2 * 8);
        G = __builtin_amdgcn_mfma_f32_32x32x16_bf16(a, bq, G, 0, 0, 0); }
    LAS float* GA = (LAS float*)wlds; LAS float* GT = (LAS float*)(wlds + 4608);
#pragma unroll
    for (int r = 0; r < 16; ++r) GA[((r & 3) + 8 * (r >> 2) + 4 * h2) * 36 + r32] = G[r];
#pragma unroll
    for (int g4 = 0; g4 < 4; ++g4) *(LAS f32x4*)(GT + r32 * 36 + 8 * g4 + 4 * h2) = (f32x4){G[4 * g4], G[4 * g4 + 1], G[4 * g4 + 2], G[4 * g4 + 3]};
#define RC_LD16(dst, p, n4) do { _Pragma("unroll") for (int i4_ = 0; i4_ < (n4); ++i4_) { const f32x4 v4_ = *(const LAS f32x4*)((p) + 4 * i4_); dst[4 * i4_] = v4_.x; dst[4 * i4_ + 1] = v4_.y; dst[4 * i4_ + 2] = v4_.z; dst[4 * i4_ + 3] = v4_.w; } } while (0)
    float Tc[16];
    { f32x2 Tp[8];
#pragma unroll
    for (int j = 0; j < 8; ++j) { Tp[j].x = (2 * j == tl) ? 1.0f : 0.0f; Tp[j].y = (2 * j + 1 == tl) ? 1.0f : 0.0f; }
#pragma unroll
    for (int s = 14; s >= 0; --s) { f32x4 nr4[4]; f32x2 a2 = {0.f, 0.f}; float a1 = 0.f;
#pragma unroll
        for (int i4 = (s + 1) / 4; i4 < 4; ++i4) nr4[i4] = *(const LAS f32x4*)(GA + s * 36 + 4 * i4);
        if ((s + 1) & 1) { const int m = s + 1; a1 = nr4[m >> 2][m & 3] * Tp[m >> 1].y; }
#pragma unroll
        for (int m = (s + 2) & ~1; m < 16; m += 2) a2 += (f32x2){nr4[m >> 2][m & 3], nr4[m >> 2][(m & 3) + 1]} * Tp[m >> 1];
        const float acc = a1 + (a2.x + a2.y);
        if (s & 1) Tp[s >> 1].y = (s < tl) ? acc : Tp[s >> 1].y; else Tp[s >> 1].x = (s < tl) ? acc : Tp[s >> 1].x; }
#pragma unroll
    for (int j = 0; j < 8; ++j) { Tc[2 * j] = Tp[j].x; Tc[2 * j + 1] = Tp[j].y; } }
    if (x < 16) {
#pragma unroll
        for (int g4 = 0; g4 < 4; ++g4) *(LAS f32x4*)(TT + tl * 16 + 4 * g4) = (f32x4){Tc[4 * g4], Tc[4 * g4 + 1], Tc[4 * g4 + 2], Tc[4 * g4 + 3]}; }
    float PV[16];
    PV[0] = 0.f;
#pragma unroll
    for (int s = 1; s < 16; ++s) { f32x2 a2 = {0.f, 0.f}; float a1 = 0.f;
#pragma unroll
        for (int r = 0; r + 1 < s; r += 2) a2 += (f32x2){GT[s * 36 + 16 + r], GT[s * 36 + 16 + r + 1]} * (f32x2){vv[r], vv[r + 1]};
        if (s & 1) a1 = GT[s * 36 + 16 + s - 1] * vv[s - 1];
        PV[s] = a1 + (a2.x + a2.y); }
    float Ah[16], U0[16];
#pragma unroll
    for (int t = 0; t < 16; ++t) { f32x2 a2 = {0.f, 0.f};
#pragma unroll
        for (int s = 0; s <= t; ++s) { const float tv = TT[t * 16 + s]; a2 += (f32x2){tv, tv} * (f32x2){At[s], PV[s]}; }
        Ah[t] = a2.x; U0[t] = a2.y; }
    float Rh[16], Y0[16];
#pragma unroll
    for (int t = 0; t < 16; ++t) { f32x2 ry = {Rt[t], 0.f};
#pragma unroll
        for (int s = 0; s <= t; ++s) { const float m1 = GT[(16 + t) * 36 + s], m2 = GT[(16 + t) * 36 + 16 + s]; ry += (f32x2){m1, m1} * (f32x2){Ah[s], U0[s]}; ry.y += m2 * vv[s]; }
        Rh[t] = ry.x; Y0[t] = ry.y; }
#undef RC_LD16
    { const int ks = x >> 5, jj = x & 31, e = (jj >> 4) * 4 + (jj & 3), q = (jj >> 2) & 3; LAS unsigned char* pb = wlds + ks * 1024 + q * 256 + e * 2;
#pragma unroll
      for (int s = 0; s < 16; ++s) { *(LAS bf16*)(pb + s * 16) = cvt1_c(Ah[s]); *(LAS bf16*)(pb + 2048 + s * 16) = cvt1_c(Rh[s]); }
#pragma unroll
      for (int j = 0; j < 4; ++j) { const v4u w = *(const LAS v4u*)(wlds + j * 1024 + x * 16); RC_ST(RC_AR + j * 1024 + x * 16, w); } }
#pragma unroll
    for (int q = 0; q < 2; ++q) { v4u w;
        w.x = cvtpk_c(U0[8 * q], U0[8 * q + 1]); w.y = cvtpk_c(U0[8 * q + 2], U0[8 * q + 3]); w.z = cvtpk_c(U0[8 * q + 4], U0[8 * q + 5]); w.w = cvtpk_c(U0[8 * q + 6], U0[8 * q + 7]); RC_ST(RC_U0 + x * 32 + q * 16, w);
        w.x = cvtpk_c(Y0[8 * q], Y0[8 * q + 1]); w.y = cvtpk_c(Y0[8 * q + 2], Y0[8 * q + 3]); w.z = cvtpk_c(Y0[8 * q + 4], Y0[8 * q + 5]); w.w = cvtpk_c(Y0[8 * q + 6], Y0[8 * q + 7]); RC_ST(RC_Y0 + x * 32 + q * 16, w); }
    LDS_WAIT();
}
__device__ __forceinline__ void rc_pass1_rwkv(Frame& F, int wid, int nw, int c0, int nc) {
    LAS unsigned char* wlds = F.lds + F.wave * RC_WLDS;
    const int x = F.lane;
    const float* RW = (const float*)(FWS + WS_RW);
    const bf16* RH = (const bf16*)(FWS + WS_RW + 32 * MiB);
    for (int it2 = wid; it2 < 16 * nc; it2 += nw) {
        const int u = it2 / nc, c = c0 + it2 % nc, it = u * RC_NCH + c, b = u >> 3, h = u & 7; const size_t o0 = ((size_t)(b * SEQ + c * 16)) * 512 + h * 64 + x;
        float At[16], Bt[16], Kt[16], Rt[16], vv[16]; float W = 1.0f;
#pragma unroll
        for (int t = 0; t < 16; ++t) { const size_t o = o0 + (size_t)t * 512;
            const float wv = RW[o], ka = bf2f(RH[3 * RWA + o]), bb = bf2f(RH[4 * RWA + o]), kk = bf2f(RH[1 * RWA + o]), rr = bf2f(RH[0 * RWA + o]); vv[t] = bf2f(RH[2 * RWA + o]);
            At[t] = -ka * W; W *= wv; const float iw = __builtin_amdgcn_rcpf(W); Bt[t] = bb * iw; Kt[t] = kk * iw; Rt[t] = rr * W; }
        rc_core(F, wlds, At, Bt, Kt, Rt, vv, W, (unsigned)it * RC_REC);
    }
}
__device__ __forceinline__ void rc_core_ret(Frame& F, LAS unsigned char* wlds, const float (&Kt)[16], const float (&Rt)[16], const float (&vv)[16], const float D, unsigned roff) {
    { unsigned wb_ = (unsigned)(uintptr_t)wlds; asm volatile("" : "+v"(wb_)); wlds = (LAS unsigned char*)(uintptr_t)wb_; }
    LAS bf16* XK = (LAS bf16*)wlds; LAS bf16* XR = (LAS bf16*)(wlds + 2304); LAS float* GM = (LAS float*)(wlds + 4608);
    int x_ = F.lane; asm volatile("" : "+v"(x_));
    const int x = x_, fr = x & 15, q = x >> 4;
#pragma unroll
    for (int t = 0; t < 16; ++t) { XK[t * 72 + x] = cvt1_c(Kt[t]); XR[t * 72 + x] = cvt1_c(Rt[t]); }
#pragma unroll
    for (int qq = 0; qq < 4; ++qq) { v4u w; w.x = 0u; w.y = 0u;
        w.z = cvtpk_c(Kt[4 * qq] * D, Kt[4 * qq + 1] * D); w.w = cvtpk_c(Kt[4 * qq + 2] * D, Kt[4 * qq + 3] * D); RC_ST(RC_BK + x * 64 + qq * 16, w); }
#pragma unroll
    for (int qq = 0; qq < 2; ++qq) { v4u w;
        w.x = cvtpk_c(vv[8 * qq], vv[8 * qq + 1]); w.y = cvtpk_c(vv[8 * qq + 2], vv[8 * qq + 3]); w.z = cvtpk_c(vv[8 * qq + 4], vv[8 * qq + 5]); w.w = cvtpk_c(vv[8 * qq + 6], vv[8 * qq + 7]); RC_ST(RC_VP + x * 32 + qq * 16, w);
        RC_ST(RC_U0 + x * 32 + qq * 16, ((v4u){0u, 0u, 0u, 0u})); }
    RC_ST_D(D);
    f32x4 G = {0.f, 0.f, 0.f, 0.f};
#pragma unroll
    for (int ks = 0; ks < 2; ++ks) { const bf16x8 a = *(const LAS bf16x8*)(XK + fr * 72 + ks * 32 + q * 8), bq = *(const LAS bf16x8*)(XR + fr * 72 + ks * 32 + q * 8);
        G = __builtin_amdgcn_mfma_f32_16x16x32_bf16(a, bq, G, 0, 0, 0); }
#pragma unroll
    for (int rg = 0; rg < 4; ++rg) GM[(4 * q + rg) * 17 + fr] = G[rg];
    { const int ks = x >> 5, jj = x & 31, e = (jj >> 4) * 4 + (jj & 3), qv = (jj >> 2) & 3; LAS unsigned char* pb = wlds + 2048 + ks * 1024 + qv * 256 + e * 2;
#pragma unroll
      for (int s = 0; s < 16; ++s) *(LAS bf16*)(pb + s * 16) = cvt1_c(Rt[s]);
#pragma unroll
      for (int j = 0; j < 2; ++j) { RC_ST(RC_AR + j * 1024 + x * 16, ((v4u){0u, 0u, 0u, 0u})); const v4u w = *(const LAS v4u*)(wlds + 2048 + j * 1024 + x * 16); RC_ST(RC_AR + 2048 + j * 1024 + x * 16, w); } }
    float Y0[16];
#pragma unroll
    for (int t = 0; t < 16; ++t) { float yy = 0.f;
#pragma unroll
        for (int s = 0; s <= t; ++s) yy += GM[s * 17 + t] * vv[s];
        Y0[t] = yy; }
#pragma unroll
    for (int qq = 0; qq < 2; ++qq) { v4u w;
        w.x = cvtpk_c(Y0[8 * qq], Y0[8 * qq + 1]); w.y = cvtpk_c(Y0[8 * qq + 2], Y0[8 * qq + 3]); w.z = cvtpk_c(Y0[8 * qq + 4], Y0[8 * qq + 5]); w.w = cvtpk_c(Y0[8 * qq + 6], Y0[8 * qq + 7]); RC_ST(RC_Y0 + x * 32 + qq * 16, w); }
    LDS_WAIT();
}
__device__ __forceinline__ void rc_pass1_ret(Frame& F, int wid, int nw, int c0, int nc) {
    LAS unsigned char* wlds = F.lds + F.wave * RC_WLDS;
    const int x = F.lane;
    const bf16* P = (const bf16*)(FWS + WS_PROJ);
    for (int it2 = wid; it2 < 16 * nc; it2 += nw) {
        const int ru = it2 / nc, c = c0 + it2 % nc, it = ru * RC_NCH + c, b = ru >> 3, h = (ru >> 1) & 3, half = ru & 1; const float gamma = 1.0f - exp2f(-5.0f - (float)h);
        float Kt[16], Rt[16], vv[16]; float W = 1.0f;
        const bf16* p0 = P + (size_t)(b * SEQ + c * 16) * IN_PAD;
#pragma unroll
        for (int t = 0; t < 16; ++t) { const bf16* p = p0 + (size_t)t * IN_PAD;
            const float rr = bf2f(p[C_RQ + h * 64 + x]), kk = bf2f(p[C_RK + h * 64 + x]) * 0.125f; vv[t] = bf2f(p[C_RV + h * 128 + half * 64 + x]);
            W *= gamma; const float iw = __builtin_amdgcn_rcpf(W); Kt[t] = kk * iw; Rt[t] = rr * W; }
        rc_core_ret(F, wlds, Kt, Rt, vv, W, (unsigned)(16 * RC_NCH + it) * RC_REC);
    }
}
__device__ __forceinline__ void rwkv_prep_mfma(Frame& F, int l, int first, int stride) {
    LAS unsigned char* wlds = F.lds + F.wave * RC_WLDS;
    LAS bf16* CODES = (LAS bf16*)(F.lds + RC_CODES_OFF);
    LAS float* ST = (LAS float*)wlds;
    const bf16* P = (const bf16*)(FWS + WS_PROJ);
    const float* mu = F.in[F.zz + 4] + l * RWC;
    const bf16* WT = (const bf16*)(FWS + WS_RWW + (size_t)l * 448 * 512 * 2);
    float* RW = (float*)(FWS + WS_RW);
    const int x = F.lane, h = F.wave, ch = h * 64 + x, fr = x & 15, q = x >> 4;
    for (int item = first; item < NB * RC_NCH; item += stride) {
        const int b = item >> 8, c = item & 255; const size_t row0 = (size_t)b * SEQ + c * 16; const int t0 = c * 16;
        const bf16* prc = P + row0 * IN_PAD + C_RW + ch;
        unsigned short nr_[4], nk_[4], nv_[4]; float pvr = 0.f, pvk = 0.f, pvv = 0.f;
        if (t0 > 0) { pvr = bf2f(prc[-IN_PAD]); pvk = bf2f(prc[512 - IN_PAD]); pvv = bf2f(prc[1024 - IN_PAD]); }
#pragma unroll
        for (int tt = 0; tt < 4; ++tt) { nr_[tt] = prc[(size_t)tt * IN_PAD]; nk_[tt] = prc[(size_t)tt * IN_PAD + 512]; nv_[tt] = prc[(size_t)tt * IN_PAD + 1024]; }
        const float mur = mu[ch], muk = mu[512 + ch], muv = mu[1024 + ch];
        const float w0c = F.in[F.zz + 5][l * 512 + ch], a0c = F.in[F.zz + 7][l * 512 + ch], kkc = F.in[F.zz + 10][l * 512 + ch], kac = F.in[F.zz + 11][l * 512 + ch], rkc = F.in[F.zz + 12][l * 512 + ch];
#pragma unroll 7
        for (int idx = F.tid; idx < 16 * 448; idx += NTHR) { const int tk = idx / 448, cc = idx - tk * 448;
            float val = lerp_bf(P, row0 + tk, C_RW + 1536 + cc, (t0 + tk) > 0, mu[1536 + cc]);
            if (cc < 96) val = 1.0f - 2.0f * __builtin_amdgcn_rcpf(1.0f + __expf(2.0f * val));
            else if (cc >= 192) val = sigmoidf_(val);
            CODES[tk * RC_CSTRIDE + cc] = cvt1_c(val); }
        __syncthreads();
        f32x4 accW[4], accA[4], accG[4];
#pragma unroll
        for (int ct = 0; ct < 4; ++ct) { accW[ct] = (f32x4){0.f, 0.f, 0.f, 0.f}; accA[ct] = accW[ct]; accG[ct] = accW[ct]; }
        { bf16x8 bw[3][4];
#pragma unroll
          for (int ks = 0; ks < 3; ++ks)
#pragma unroll
              for (int ct = 0; ct < 4; ++ct) bw[ks][ct] = *(const bf16x8*)(WT + (size_t)(h * 64 + ct * 16 + fr) * 96 + ks * 32 + q * 8);
#pragma unroll
          for (int ks = 0; ks < 3; ++ks) { const bf16x8 aw = *(const LAS bf16x8*)(CODES + fr * RC_CSTRIDE + ks * 32 + q * 8);
#pragma unroll
              for (int ct = 0; ct < 4; ++ct) accW[ct] = __builtin_amdgcn_mfma_f32_16x16x32_bf16(aw, bw[ks][ct], accW[ct], 0, 0, 0); } }
        asm volatile("" ::: "memory");
        { bf16x8 ba[3][4];
#pragma unroll
          for (int ks = 0; ks < 3; ++ks)
#pragma unroll
              for (int ct = 0; ct < 4; ++ct) ba[ks][ct] = *(const bf16x8*)(WT + 512 * 96 + (size_t)(h * 64 + ct * 16 + fr) * 96 + ks * 32 + q * 8);
#pragma unroll
          for (int ks = 0; ks < 3; ++ks) { const bf16x8 aa = *(const LAS bf16x8*)(CODES + fr * RC_CSTRIDE + 96 + ks * 32 + q * 8);
#pragma unroll
              for (int ct = 0; ct < 4; ++ct) accA[ct] = __builtin_amdgcn_mfma_f32_16x16x32_bf16(aa, ba[ks][ct], accA[ct], 0, 0, 0); } }
        asm volatile("" ::: "memory");
#pragma unroll
        for (int hf = 0; hf < 2; ++hf) { bf16x8 bg[4][4];
#pragma unroll
            for (int k4 = 0; k4 < 4; ++k4)
#pragma unroll
                for (int ct = 0; ct < 4; ++ct) bg[k4][ct] = *(const bf16x8*)(WT + 2 * 512 * 96 + (size_t)(h * 64 + ct * 16 + fr) * 256 + (hf * 4 + k4) * 32 + q * 8);
#pragma unroll
            for (int k4 = 0; k4 < 4; ++k4) { const bf16x8 ag = *(const LAS bf16x8*)(CODES + fr * RC_CSTRIDE + 192 + (hf * 4 + k4) * 32 + q * 8);
#pragma unroll
                for (int ct = 0; ct < 4; ++ct) accG[ct] = __builtin_amdgcn_mfma_f32_16x16x32_bf16(ag, bg[k4][ct], accG[ct], 0, 0, 0); }
            asm volatile("" ::: "memory"); }
#pragma unroll
        for (int ct = 0; ct < 4; ++ct)
#pragma unroll
            for (int rg = 0; rg < 4; ++rg) { const int o = (4 * q + rg) * 64 + ct * 16 + fr; ST[o] = accW[ct][rg]; ST[1024 + o] = accA[ct][rg]; ST[2048 + o] = accG[ct][rg]; }
        float* gpw = RW + row0 * 512 + ch;
        bf16* gp = (bf16*)(FWS + WS_RW + 32 * MiB) + row0 * 512 + ch;
        for (int g = 0; g < 4; ++g) {
            unsigned short cr_[4], ck_[4], cv_[4];
#pragma unroll
            for (int tt = 0; tt < 4; ++tt) { cr_[tt] = nr_[tt]; ck_[tt] = nk_[tt]; cv_[tt] = nv_[tt]; }
            if (g < 3) {
#pragma unroll
                for (int tt = 0; tt < 4; ++tt) { const size_t ro = (size_t)(4 * g + 4 + tt) * IN_PAD; nr_[tt] = prc[ro]; nk_[tt] = prc[ro + 512]; nv_[tt] = prc[ro + 1024]; } }
#pragma unroll
          for (int tt = 0; tt < 4; ++tt) { const int t = 4 * g + tt;
            const float cr = bf2f(cr_[tt]), ck = bf2f(ck_[tt]), cv = bf2f(cv_[tt]);
            const float rr = cr + (pvr - cr) * mur, kk0 = ck + (pvk - ck) * muk, vv = cv + (pvv - cv) * muv;
            pvr = cr; pvk = ck; pvv = cv;
            const float z = -(w0c + ST[t * 64 + x]);
            const float sp = fmaxf(z, 0.f) + __logf(1.0f + __expf(-fabsf(z)));
            const float decay = __expf(-__expf(-sp - 0.5f));
            const float a = sigmoidf_(a0c + ST[1024 + t * 64 + x]);
            const float gg = ST[2048 + t * 64 + x];
            const float kkv = kk0 * kkc;
            const float nrm = __builtin_amdgcn_sqrtf(wave_sum(kkv * kkv));
            const float kap = kkv * __builtin_amdgcn_rcpf(fmaxf(nrm, 1e-12f));
            const float kp = kk0 * (1.0f + (a - 1.0f) * kac);
            const float bsum = wave_sum(rr * kp * rkc);
            gpw[0] = decay; gpw += 512;
            gp[0 * RWA] = cvt1_c(rr); gp[1 * RWA] = cvt1_c(kp); gp[2 * RWA] = cvt1_c(vv); gp[3 * RWA] = cvt1_c(kap); gp[4 * RWA] = cvt1_c(kap * a); gp[5 * RWA] = cvt1_c(gg); gp[6 * RWA] = cvt1_c(bsum * vv); gp += 512; } }
        LDS_WAIT();
        __syncthreads();
    }
}
constexpr int RC_SLOT = 15360, RC_YST = 8 * RC_SLOT  ;
#define RC_ENSURE(c) do { while ((c) >= ready_) { const unsigned* gp_ = grp + 32 * ((ready_ - ready0) / 48); unsigned sp_ = 0u; \
        while ((unsigned)__builtin_amdgcn_readfirstlane(__hip_atomic_load(gp_, __ATOMIC_RELAXED, __HIP_MEMORY_SCOPE_AGENT)) < nprod) { __builtin_amdgcn_s_sleep(2); if (++sp_ > (1u << 24)) break; } \
        __builtin_amdgcn_fence(__ATOMIC_ACQUIRE, "agent"); asm volatile("s_waitcnt vmcnt(0)" ::: "memory"); ready_ += 48; } } while (0)
__device__ __forceinline__ void rc_pass2(Frame& F, int u, int cb, int ce, bool first, bool last, const unsigned* grp, unsigned nprod, int ready0) {
    int ready_ = ready0;
    const unsigned char* rec = FWS + WS_REC + (size_t)u * RC_NCH * RC_REC;
    const int lane = F.lane;
    const int NIT = (ce - cb) / 2;
    bf16* Yg;
    if (u < 16) Yg = (bf16*)(FWS + WS_Y) + (size_t)((u >> 3) * SEQ) * 512 + (u & 7) * 64;
    else { const int ru = u - 16; Yg = (bf16*)(FWS + WS_RETO) + (size_t)((ru >> 3) * SEQ) * 512 + ((ru >> 1) & 3) * 128 + (ru & 1) * 64; }
#define RC_BARRIER() __builtin_amdgcn_s_barrier()
    if (F.wave == 7) {
        unsigned t0_ = 0u, t1_ = 0u, t2_ = 0u, t3_ = 0u;
        for (int cq = cb; cq < cb + 24 && cq < ce; cq += 2) { const unsigned char* pa = rec + (size_t)cq * RC_REC + lane * 128; const unsigned char* pb = pa + 8192; const unsigned char* pc = pa + RC_REC; const unsigned char* pd = pb + RC_REC;
            asm volatile("global_load_dword %0, %4, off\n\tglobal_load_dword %1, %5, off\n\tglobal_load_dword %2, %6, off\n\tglobal_load_dword %3, %7, off" : "+v"(t0_), "+v"(t1_), "+v"(t2_), "+v"(t3_) : "v"(pa), "v"(pb), "v"(pc), "v"(pd) : "memory"); }
        RC_BARRIER();
        for (int i = 0; i < NIT; ++i) {
            const int cp = cb + 2 * i + 24;
            if (cp < ce) { RC_ENSURE(cp + 1); const unsigned char* pa = rec + (size_t)cp * RC_REC + lane * 128; const unsigned char* pb = pa + 8192; const unsigned char* pc = pa + RC_REC; const unsigned char* pd = pb + RC_REC;
                asm volatile("global_load_dword %0, %4, off\n\tglobal_load_dword %1, %5, off\n\tglobal_load_dword %2, %6, off\n\tglobal_load_dword %3, %7, off" : "+v"(t0_), "+v"(t1_), "+v"(t2_), "+v"(t3_) : "v"(pa), "v"(pb), "v"(pc), "v"(pd) : "memory"); }
            if (i > 0) {
                const LAS unsigned char* yb = F.lds + RC_YST + ((i - 1) & 1) * 4096;
#pragma unroll
                for (int j = 0; j < 4; ++j) { const v4u w = *(const LAS v4u*)(yb + j * 1024 + lane * 16);
                    *(v4u*)(Yg + (size_t)((cb + 2 * i - 2) * 16 + j * 8 + (lane >> 3)) * 512 + (lane & 7) * 8) = w; } }
            RC_BARRIER();
        }
        { const LAS unsigned char* yb = F.lds + RC_YST + ((NIT - 1) & 1) * 4096;
#pragma unroll
          for (int j = 0; j < 4; ++j) { const v4u w = *(const LAS v4u*)(yb + j * 1024 + lane * 16);
              *(v4u*)(Yg + (size_t)((cb + 2 * NIT - 2) * 16 + j * 8 + (lane >> 3)) * 512 + (lane & 7) * 8) = w; } }
        asm volatile("s_waitcnt vmcnt(0)" ::: "memory");
        asm volatile("" :: "v"(t0_), "v"(t1_), "v"(t2_), "v"(t3_));
    } else if (F.wave >= 4) {
        const int lw = F.wave - 4;
        const int p0_ = lw == 0 ? 8 : (lw == 1 ? 11 : 13), np_ = lw == 0 ? 3 : 2;
#define RC_ISSUE(c) do { _Pragma("unroll") for (int i_ = 0; i_ < 3; ++i_) { if (i_ < np_) \
            __builtin_amdgcn_global_load_lds((const unsigned*)(rec + (size_t)(c) * RC_REC + (p0_ + i_) * 1024 + lane * 16), (LAS unsigned*)(F.lds + ((c) & 7) * RC_SLOT + (p0_ + i_) * 1024), 16, 0, 0); } } while (0)
#define RC_WAIT4() do { if (lw == 0) asm volatile("s_waitcnt vmcnt(12)" ::: "memory"); else asm volatile("s_waitcnt vmcnt(8)" ::: "memory"); } while (0)
        for (int c = cb; c < cb + 6; ++c) RC_ISSUE(c);
        RC_WAIT4();
        RC_BARRIER();
        for (int i = 0; i < NIT; ++i) {
            if (cb + 2 * i + 7 < ce) { RC_ENSURE(cb + 2 * i + 7); RC_ISSUE(cb + 2 * i + 6); RC_ISSUE(cb + 2 * i + 7); RC_WAIT4(); }
            else asm volatile("s_waitcnt vmcnt(0)" ::: "memory");
            RC_BARRIER();
        }
#undef RC_ISSUE
#undef RC_WAIT4
    } else {
        const int ib = F.wave, fr = lane & 15, q = lane >> 4;
#define RC_ISSUE1(c) do { __builtin_amdgcn_global_load_lds((const unsigned*)(rec + (size_t)(c) * RC_REC + (2 * ib) * 1024 + lane * 16), (LAS unsigned*)(F.lds + ((c) & 7) * RC_SLOT + (2 * ib) * 1024), 16, 0, 0); \
        __builtin_amdgcn_global_load_lds((const unsigned*)(rec + (size_t)(c) * RC_REC + (2 * ib + 1) * 1024 + lane * 16), (LAS unsigned*)(F.lds + ((c) & 7) * RC_SLOT + (2 * ib + 1) * 1024), 16, 0, 0); } while (0)
        f32x4* sv = (f32x4*)(FWS + WS_CTL + 262144) + (size_t)((u * 4 + ib) * 4 + 0) * 64 + lane;
        f32x4 sT[4];
#pragma unroll
        for (int jb = 0; jb < 4; ++jb) sT[jb] = first ? (f32x4){0.f, 0.f, 0.f, 0.f} : sv[jb * 64];
        asm volatile("s_waitcnt vmcnt(0)" ::: "memory");
        for (int c = cb; c < cb + 6; ++c) RC_ISSUE1(c);
        asm volatile("s_waitcnt vmcnt(8)" ::: "memory");
        RC_BARRIER();
        for (int i = 0; i < NIT; ++i) {
            bf16x8 aU0[2], aU1[2], aY0[2], aY1[2], bk[2][4]; f32x4 dd[2][4]; v2u vp[2], u0[2], y0[2];
#pragma unroll
            for (int h = 0; h < 2; ++h) { const LAS unsigned char* slot = F.lds + ((cb + 2 * i + h) & 7) * RC_SLOT;
                aU0[h] = *(const LAS bf16x8*)(slot + RC_AR + q * 256 + fr * 16); aU1[h] = *(const LAS bf16x8*)(slot + RC_AR + 1024 + q * 256 + fr * 16);
                aY0[h] = *(const LAS bf16x8*)(slot + RC_AR + 2048 + q * 256 + fr * 16); aY1[h] = *(const LAS bf16x8*)(slot + RC_AR + 3072 + q * 256 + fr * 16);
                u0[h] = *(const LAS v2u*)(slot + RC_U0 + (16 * ib + fr) * 32 + q * 8); vp[h] = *(const LAS v2u*)(slot + RC_VP + (16 * ib + fr) * 32 + q * 8);
#pragma unroll
                for (int jb = 0; jb < 4; ++jb) { bk[h][jb] = *(const LAS bf16x8*)(slot + RC_BK + (16 * jb + fr) * 64 + q * 16); dd[h][jb] = *(const LAS f32x4*)(slot + RC_D + (16 * jb + 4 * q) * 4); }
                y0[h] = *(const LAS v2u*)(slot + RC_Y0 + (16 * ib + fr) * 32 + q * 8); }
            LAS bf16* yst = (LAS bf16*)(F.lds + RC_YST + (i & 1) * 4096);
#pragma unroll
            for (int h = 0; h < 2; ++h) {
                v4u s0, s1;
                s0.x = cvtpk_c(sT[0][0], sT[0][1]); s0.y = cvtpk_c(sT[0][2], sT[0][3]); s0.z = cvtpk_c(sT[1][0], sT[1][1]); s0.w = cvtpk_c(sT[1][2], sT[1][3]);
                s1.x = cvtpk_c(sT[2][0], sT[2][1]); s1.y = cvtpk_c(sT[2][2], sT[2][3]); s1.z = cvtpk_c(sT[3][0], sT[3][1]); s1.w = cvtpk_c(sT[3][2], sT[3][3]);
                const bf16x8 sb0 = __builtin_bit_cast(bf16x8, s0), sb1 = __builtin_bit_cast(bf16x8, s1);
                f32x4 zU = (f32x4){0.f, 0.f, 0.f, 0.f}, zY = (f32x4){0.f, 0.f, 0.f, 0.f};
                zU = __builtin_amdgcn_mfma_f32_16x16x32_bf16(aU0[h], sb0, zU, 0, 0, 0); zU = __builtin_amdgcn_mfma_f32_16x16x32_bf16(aU1[h], sb1, zU, 0, 0, 0);
                const float U0_ = zU[0] + bflo(u0[h].x), U1_ = zU[1] + bfhi(u0[h].x), U2_ = zU[2] + bflo(u0[h].y), U3_ = zU[3] + bfhi(u0[h].y);
                v4u ubw; ubw.x = cvtpk_c(U0_, U1_); ubw.y = cvtpk_c(U2_, U3_); ubw.z = vp[h].x; ubw.w = vp[h].y;
                const bf16x8 ub = __builtin_bit_cast(bf16x8, ubw);
#pragma unroll
                for (int jb = 0; jb < 4; ++jb) sT[jb] = __builtin_amdgcn_mfma_f32_16x16x32_bf16(bk[h][jb], ub, sT[jb] * dd[h][jb], 0, 0, 0);
                zY = __builtin_amdgcn_mfma_f32_16x16x32_bf16(aY0[h], sb0, zY, 0, 0, 0); zY = __builtin_amdgcn_mfma_f32_16x16x32_bf16(aY1[h], sb1, zY, 0, 0, 0);
                LAS bf16* yp = yst + h * 1024 + (4 * q) * 64 + 16 * ib + fr;
                yp[0] = cvt1_c(zY[0] + bflo(y0[h].x)); yp[64] = cvt1_c(zY[1] + bfhi(y0[h].x)); yp[128] = cvt1_c(zY[2] + bflo(y0[h].y)); yp[192] = cvt1_c(zY[3] + bfhi(y0[h].y));
            }
            if (cb + 2 * i + 7 < ce) { RC_ENSURE(cb + 2 * i + 7); RC_ISSUE1(cb + 2 * i + 6); RC_ISSUE1(cb + 2 * i + 7); asm volatile("s_waitcnt vmcnt(8) lgkmcnt(0)" ::: "memory"); } else asm volatile("s_waitcnt vmcnt(0) lgkmcnt(0)" ::: "memory");
            RC_BARRIER();
        }
        if (!last) {
#pragma unroll
            for (int jb = 0; jb < 4; ++jb) sv[jb * 64] = sT[jb]; }
#undef RC_ISSUE1
    }
#undef RC_BARRIER
    asm volatile("s_waitcnt vmcnt(0) lgkmcnt(0)" ::: "memory");
    __syncthreads();
}
__device__ __forceinline__ void sub_arrive(Frame& F, unsigned* cnt) {
    asm volatile("s_waitcnt vmcnt(0)" ::: "memory");
    __syncthreads();
    if (F.tid == 0) { __builtin_amdgcn_fence(__ATOMIC_RELEASE, "agent"); asm volatile("s_waitcnt vmcnt(0)" ::: "memory"); __hip_atomic_fetch_add(cnt, 1u, __ATOMIC_RELAXED, __HIP_MEMORY_SCOPE_AGENT); }
}
__device__ __forceinline__ void xcd_publish(Frame& F, unsigned* local, unsigned nlocal, unsigned* global) {
    asm volatile("s_waitcnt vmcnt(0)" ::: "memory");
    __syncthreads();
    if (F.tid == 0) {
        const unsigned old = __hip_atomic_fetch_add(local, 1u, __ATOMIC_RELAXED, __HIP_MEMORY_SCOPE_AGENT);
        if (old + 1u == nlocal) { __builtin_amdgcn_fence(__ATOMIC_RELEASE, "agent"); asm volatile("s_waitcnt vmcnt(0)" ::: "memory"); __hip_atomic_fetch_add(global, nlocal, __ATOMIC_RELAXED, __HIP_MEMORY_SCOPE_AGENT); }
    }
}
__device__ __forceinline__ void sub_wait(Frame& F, unsigned* cnt, unsigned target) {
    if (F.tid == 0) { unsigned sp = 0u;
        while (__hip_atomic_load(cnt, __ATOMIC_RELAXED, __HIP_MEMORY_SCOPE_AGENT) < target) { __builtin_amdgcn_s_sleep(2); if (++sp > (1u << 24)) break; }
        __builtin_amdgcn_fence(__ATOMIC_ACQUIRE, "agent"); asm volatile("s_waitcnt vmcnt(0)" ::: "memory"); }
    __syncthreads();
}
__device__ __forceinline__ void sub_barrier(Frame& F, unsigned* cnt, unsigned target) {
    asm volatile("s_waitcnt vmcnt(0)" ::: "memory");
    __syncthreads();
    if (F.tid == 0) {
        __builtin_amdgcn_fence(__ATOMIC_RELEASE, "agent");
        asm volatile("s_waitcnt vmcnt(0)" ::: "memory");
        __hip_atomic_fetch_add(cnt, 1u, __ATOMIC_RELAXED, __HIP_MEMORY_SCOPE_AGENT);
        unsigned sp = 0u;
        while (__hip_atomic_load(cnt, __ATOMIC_RELAXED, __HIP_MEMORY_SCOPE_AGENT) < target) { __builtin_amdgcn_s_sleep(2); if (++sp > (1u << 24)) break; }
        __builtin_amdgcn_fence(__ATOMIC_ACQUIRE, "agent");
        asm volatile("s_waitcnt vmcnt(0)" ::: "memory");
    }
    __syncthreads();
}
__device__ __forceinline__ void mixer_post(Frame& F, int l, int gw, int NGW) {
    const bf16* P = (const bf16*)(FWS + WS_PROJ);
    const bf16* RH = (const bf16*)(FWS + WS_RW + 32 * MiB);
    const float* RW = (const float*)(FWS + WS_RW);
    const bf16* Y = (const bf16*)(FWS + WS_Y);
    const bf16* RO = (const bf16*)(FWS + WS_RETO);
    bf16* MX = (bf16*)(FWS + WS_MIXED);
    const float* ln_w = F.in[F.zz + 13] + l * 512; const float* ln_b = F.in[F.zz + 14] + l * 512;
    const int lane = F.lane;
    for (int m = gw; m < MROWS; m += NGW) {
        const size_t o = (size_t)m * 512;
        float y[8], s1[8], s2[8], bon[8], gat[8]; f32x2 ov[4]; float s3[4]; unsigned gw2[4];
#pragma unroll
        for (int h = 0; h < 8; ++h) { const int c = h * 64 + lane; y[h] = bf2f(Y[o + c]); bon[h] = bf2f(RH[6 * RWA + o + c]); gat[h] = bf2f(RH[5 * RWA + o + c]); s1[h] = y[h]; }
#pragma unroll
        for (int h = 0; h < 4; ++h) { const int c = h * 128 + 2 * lane; { const unsigned rw_ = *(const unsigned*)(RO + o + c); ov[h].x = bflo(rw_); ov[h].y = bfhi(rw_); } gw2[h] = *(const unsigned*)(P + (size_t)m * IN_PAD + C_RG + c); s3[h] = ov[h].x * ov[h].x + ov[h].y * ov[h].y; }
#pragma unroll
        for (int h = 0; h < 8; ++h) { s1[h] = dpp_add<0xB1>(s1[h]); s1[h] = dpp_add<0x4E>(s1[h]); s1[h] = dpp_add<0x141>(s1[h]); s1[h] = dpp_add<0x140>(s1[h]); }
#pragma unroll
        for (int h = 0; h < 4; ++h) { s3[h] = dpp_add<0xB1>(s3[h]); s3[h] = dpp_add<0x4E>(s3[h]); s3[h] = dpp_add<0x141>(s3[h]); s3[h] = dpp_add<0x140>(s3[h]); }
#pragma unroll
        for (int h = 0; h < 8; ++h) s1[h] = xsum32(xsum16(s1[h]));
#pragma unroll
        for (int h = 0; h < 4; ++h) s3[h] = xsum32(xsum16(s3[h]));
#pragma unroll
        for (int h = 0; h < 8; ++h) { const float d = y[h] - s1[h] * (1.0f / 64.0f); y[h] = d; s2[h] = d * d; }
#pragma unroll
        for (int h = 0; h < 8; ++h) { s2[h] = dpp_add<0xB1>(s2[h]); s2[h] = dpp_add<0x4E>(s2[h]); s2[h] = dpp_add<0x141>(s2[h]); s2[h] = dpp_add<0x140>(s2[h]); }
#pragma unroll
        for (int h = 0; h < 8; ++h) s2[h] = xsum32(xsum16(s2[h]));
#pragma unroll
        for (int h = 0; h < 8; ++h) { const int c = h * 64 + lane;
            const float yn = y[h] * __builtin_amdgcn_rsqf(s2[h] * (1.0f / 64.0f) + GN_EPS) * ln_w[c] + ln_b[c];
            MX[(size_t)m * DM + 512 + c] = (bf16)f2bf((yn + bon[h]) * gat[h]); }
#pragma unroll
        for (int h = 0; h < 4; ++h) { const int c = h * 128 + 2 * lane;
            const float rn = __builtin_amdgcn_rsqf(s3[h] * (1.0f / 128.0f) + NORM_EPS);
            const float g0 = bflo(gw2[h]), g1 = bfhi(gw2[h]);
            *(unsigned*)(MX + (size_t)m * DM + c) = pk2(ov[h].x * rn * g0 * sigmoidf_(g0), ov[h].y * rn * g1 * sigmoidf_(g1)); }
    }
}
__device__ __forceinline__ void conv_gate_phase(Frame& F, int l) {
    const bf16* U = (const bf16*)(FWS + WS_U);
    bf16* A = (bf16*)(FWS + WS_ACT);
    const float* cw = F.in[F.zz + 16] + (size_t)l * 3 * UPC; const float* cb = F.in[F.zz + 17] + (size_t)l * UPC;
    constexpr int NCG = DFF / 8, NRC = MROWS / 16;
    for (int it = F.vcu * NTHR + F.tid; it < NCG * NRC; it += F.G * NTHR) {
        const int cg = it % NCG, rc = it / NCG, c0 = cg * 8, row0 = rc * 16, t0 = row0 & (SEQ - 1);
        float wv[3][8], wg[3][8], bv[8], bg[8];
#pragma unroll
        for (int j = 0; j < 3; ++j)
#pragma unroll
            for (int e = 0; e < 8; ++e) { wv[j][e] = cw[j * UPC + c0 + e]; wg[j][e] = cw[j * UPC + DFF + c0 + e]; }
#pragma unroll
        for (int e = 0; e < 8; ++e) { bv[e] = cb[c0 + e]; bg[e] = cb[DFF + c0 + e]; }
        v4u v0 = {0u, 0u, 0u, 0u}, v1 = v0, g0 = v0, g1 = v0;
        if (t0 > 0) { v0 = *(const v4u*)(U + (size_t)(row0 - 2) * UPC + c0); v1 = *(const v4u*)(U + (size_t)(row0 - 1) * UPC + c0);
                      g0 = *(const v4u*)(U + (size_t)(row0 - 2) * UPC + DFF + c0); g1 = *(const v4u*)(U + (size_t)(row0 - 1) * UPC + DFF + c0); }
        for (int r = 0; r < 16; ++r) {
            const v4u v2 = *(const v4u*)(U + (size_t)(row0 + r) * UPC + c0), g2 = *(const v4u*)(U + (size_t)(row0 + r) * UPC + DFF + c0);
            float ov[8];
#pragma unroll
            for (int e = 0; e < 4; ++e) {
                const float va = wv[0][2 * e] * bflo(v0[e]) + wv[1][2 * e] * bflo(v1[e]) + wv[2][2 * e] * bflo(v2[e]) + bv[2 * e];
                const float vb = wv[0][2 * e + 1] * bfhi(v0[e]) + wv[1][2 * e + 1] * bfhi(v1[e]) + wv[2][2 * e + 1] * bfhi(v2[e]) + bv[2 * e + 1];
                const float ga = wg[0][2 * e] * bflo(g0[e]) + wg[1][2 * e] * bflo(g1[e]) + wg[2][2 * e] * bflo(g2[e]) + bg[2 * e];
                const float gb = wg[0][2 * e + 1] * bfhi(g0[e]) + wg[1][2 * e + 1] * bfhi(g1[e]) + wg[2][2 * e + 1] * bfhi(g2[e]) + bg[2 * e + 1];
                ov[2 * e] = ga * sigmoidf_(ga) * va; ov[2 * e + 1] = gb * sigmoidf_(gb) * vb; }
            v4u w; w.x = pk2(ov[0], ov[1]); w.y = pk2(ov[2], ov[3]); w.z = pk2(ov[4], ov[5]); w.w = pk2(ov[6], ov[7]);
            *(v4u*)(A + (size_t)(row0 + r) * DFF + c0) = w;
            v0 = v1; v1 = v2; g0 = g1; g1 = g2;
        }
    }
}

__device__ __forceinline__ void conv_fixup_phase(Frame& F, int l) {
    const float* H = (const float*)(FWS + WS_HALO);
    bf16* A = (bf16*)(FWS + WS_ACT);
    const float* cw = F.in[F.zz + 16] + (size_t)l * 3 * UPC; const float* cb = F.in[F.zz + 17] + (size_t)l * UPC;
    constexpr int NQ = DFF / 4;
    for (int it = F.vcu * NTHR + F.tid; it < (MROWS / 64) * 2 * NQ; it += F.G * NTHR) {
        const int c = (it % NQ) * 4, gr = it / NQ, r = gr & 1, g = gr >> 1, colp = (c >> 7) * 256 + (c & 127);
        const bool hasprev = (g & 63) != 0;
        const float* hg = H + (size_t)g * 4 * UPC + colp; const float* hp = hg - (size_t)4 * UPC;
        const f32x4 z = {0.f, 0.f, 0.f, 0.f};
        f32x4 v0, v1, v2, g0, g1, g2;
        v0 = *(const f32x4*)(hg + (size_t)r * UPC); g0 = *(const f32x4*)(hg + (size_t)r * UPC + 128);
        if (r == 1) { v1 = *(const f32x4*)hg; g1 = *(const f32x4*)(hg + 128); v2 = hasprev ? *(const f32x4*)(hp + (size_t)3 * UPC) : z; g2 = hasprev ? *(const f32x4*)(hp + (size_t)3 * UPC + 128) : z; }
        else { v1 = hasprev ? *(const f32x4*)(hp + (size_t)3 * UPC) : z; g1 = hasprev ? *(const f32x4*)(hp + (size_t)3 * UPC + 128) : z; v2 = hasprev ? *(const f32x4*)(hp + (size_t)2 * UPC) : z; g2 = hasprev ? *(const f32x4*)(hp + (size_t)2 * UPC + 128) : z; }
        const f32x4 cv = *(const f32x4*)(cw + c) * v2 + *(const f32x4*)(cw + UPC + c) * v1 + *(const f32x4*)(cw + 2 * UPC + c) * v0 + *(const f32x4*)(cb + c);
        const f32x4 cg = *(const f32x4*)(cw + DFF + c) * g2 + *(const f32x4*)(cw + UPC + DFF + c) * g1 + *(const f32x4*)(cw + 2 * UPC + DFF + c) * g0 + *(const f32x4*)(cb + DFF + c);
        v2u w; w.x = pk2(cg[0] * sigmoidf_(cg[0]) * cv[0], cg[1] * sigmoidf_(cg[1]) * cv[1]); w.y = pk2(cg[2] * sigmoidf_(cg[2]) * cv[2], cg[3] * sigmoidf_(cg[3]) * cv[3]);
        *(v2u*)(A + (size_t)(64 * g + r) * DFF + c) = w;
    }
}

#define GRID_BAR() do { xcd_barrier(bar, tid_from_wave(F.wave)); asm volatile("" : "+s"(F.wave), "+s"(F.vcu), "+s"(F.G)); F.tid = tid_from_wave(F.wave); F.lane = F.tid & 63; { unsigned z_ = 0u; asm volatile("" : "+v"(z_)); F.zz = __builtin_amdgcn_readfirstlane(z_); } } while (0)
#define XB ((bf16*)(FWS + WS_X))
#define HB ((bf16*)(FWS + WS_H))
#define PROJ ((bf16*)(FWS + WS_PROJ))
#define MIXED ((bf16*)(FWS + WS_MIXED))
#define UB ((bf16*)(FWS + WS_U))
#define ACT ((bf16*)(FWS + WS_ACT))
#define MOD ((const float*)(FWS + WS_MOD))
template <int l>
__device__ __forceinline__ void layer_fwd(Frame& F, const XcdBarrier& bar) {
#define modl (MOD + (size_t)l * 2 * 12288)
#define wl (FWS + WS_W + (size_t)l * W_LAYER)
        if (l == 0) norm_phase<0, true>(F, F.in[F.zz + 0], HB, F.in[F.zz + 21] + l * DM, modl + 0 * DM, modl + 1 * DM);
        else norm_phase<0, false>(F, XB, HB, F.in[F.zz + 21] + l * DM, modl + 0 * DM, modl + 1 * DM);
        GRID_BAR();
        { pg8::Gemm g{HB, (const bf16*)(wl + W_IN), MROWS, IN_PAD, DM}; pg8::StaticOrder S; S.init(MROWS, IN_PAD, F.G, (int)blockIdx.x);
          pg8::EpiBf16 E{PROJ, IN_PAD};
          pg8::gemm_phase<pg8::EpiBf16, pg8::StaticOrder, true, true>(F.lds, g, S, E, F.wave); }
        if (F.G == 256 && blockIdx.x >= 64) convert_gap(F, l, CV_IN, l == 0 ? CV_C1 : CV_OUT + CV_UP, ((int)blockIdx.x - 64) * NWAVES + F.wave, 192 * NWAVES, CV_N1);
        GRID_BAR();
        rwkv_prep_mfma(F, l, F.vcu, F.G);
        moba_kmean(F);
        if (F.tid == 0 && (F.vcu & 31) >= 16) {
            unsigned* xl_ = (unsigned*)(FWS + WS_CTL) + CW_SUB + 1024 + 1024 * l + 64 * bar.x; const int rv_ = (F.vcu >> 5) * 16 + (F.vcu & 31) - 16;
            __hip_atomic_fetch_add(xl_ + 8, 1u, __ATOMIC_RELAXED, __HIP_MEMORY_SCOPE_AGENT);
            if (!((rv_ & 3) == 0 && (rv_ >> 2) < RC_UNITS)) __hip_atomic_fetch_add(xl_, 1u, __ATOMIC_RELAXED, __HIP_MEMORY_SCOPE_AGENT); }
        GRID_BAR();
        const int xg_ = F.vcu >> 5, xj_ = F.vcu & 31, mi_ = xg_ * 16 + xj_;
        if (xj_ < 16) { moba_item(F, mi_ >> 3, 15 - (mi_ & 7), mi_ & 7);
            asm volatile("" : "+s"(F.wave)); F.tid = tid_from_wave(F.wave); F.lane = F.tid & 63;
            if (F.G == 256 && l == 0) { constexpr int nr_ = CV_LAYER - (CV_IN + CV_C1); LAS float* scr_ = (LAS float*)(F.lds + F.wave * 16384);
                for (int j = 0; j < CV_N3; ++j) { const int s_ = mi_ * NWAVES + F.wave + 128 * NWAVES * j;
                    if (s_ < nr_) convert_item(F, l * CV_LAYER + CV_IN + CV_C1 + s_, scr_);
                    else if (l == 0 && s_ - nr_ < CV_IN - CV_C2) convert_item(F, CV_LAYER + CV_C2 + (s_ - nr_), scr_); } }
            sub_wait(F, (unsigned*)(FWS + WS_CTL) + CW_SUB + 128 * l + 64, (unsigned)(F.G / 2));
        }
        else {
            const int rv = xg_ * 16 + (xj_ - 16), nrc = F.G / 2;
            unsigned* sub = (unsigned*)(FWS + WS_CTL) + CW_SUB + 128 * l;
            unsigned* grp = (unsigned*)(FWS + WS_CTL) + CW_SUB + 256 + 128 * l;
            unsigned* xl = (unsigned*)(FWS + WS_CTL) + CW_SUB + 1024 + 1024 * l + 64 * bar.x;
            const bool p2cu = (rv & 3) == 0 && (rv >> 2) < RC_UNITS;
            const unsigned nrl = __builtin_amdgcn_readfirstlane(__hip_atomic_load(xl + 8, __ATOMIC_RELAXED, __HIP_MEMORY_SCOPE_AGENT));
            rc_pass1_rwkv(F, rv * NWAVES + F.wave, nrc * NWAVES, 0, 64);
            rc_pass1_ret(F, rv * NWAVES + F.wave, nrc * NWAVES, 0, 64);
            xcd_publish(F, xl + 9, nrl, sub); sub_wait(F, sub, (unsigned)nrc);
            if (p2cu) {
                rc_pass2(F, rv >> 2, 0, RC_NCH, true, true, grp, (unsigned)(nrc - RC_UNITS), 64);
            } else {
                const int ov = rv - (rv >> 2) - 1, nov = nrc - RC_UNITS;
                const unsigned nloc = __builtin_amdgcn_readfirstlane(__hip_atomic_load(xl, __ATOMIC_RELAXED, __HIP_MEMORY_SCOPE_AGENT));
                for (int g = 0; g < 4; ++g) {
                    rc_pass1_rwkv(F, ov * NWAVES + F.wave, nov * NWAVES, 64 + 48 * g, 48);
                    rc_pass1_ret(F, ov * NWAVES + F.wave, nov * NWAVES, 64 + 48 * g, 48);
                    xcd_publish(F, xl + 1 + g, nloc, grp + 32 * g);
                }
            }
            xcd_publish(F, xl + 10, nrl, sub + 64); sub_wait(F, sub + 64, (unsigned)nrc);
        }
        asm volatile("" : "+s"(F.wave), "+s"(F.vcu), "+s"(F.G)); F.tid = tid_from_wave(F.wave); F.lane = F.tid & 63; { unsigned z_ = 0u; asm volatile("" : "+v"(z_)); F.zz = __builtin_amdgcn_readfirstlane(z_); }
        mixer_post(F, l, F.vcu * NWAVES + F.wave, F.G * NWAVES);
        GRID_BAR();
#if MOBA_CHECK
        moba_naive(F, F.vcu * NWAVES + F.wave, F.G * NWAVES);
        GRID_BAR();
        { float sd = 0.f, sn = 0.f; const bf16* NV = (const bf16*)(FWS + WS_U + 160 * MiB); const bf16* MXc = (const bf16*)(FWS + WS_MIXED);
          for (int m = F.vcu * NWAVES + F.wave; m < MROWS; m += F.G * NWAVES) for (int j = 0; j < 16; ++j) { const float a = bf2f(MXc[(size_t)m * DM + 1024 + j * 64 + F.lane]), b = bf2f(NV[(size_t)m * 1024 + j * 64 + F.lane]); sd += (a - b) * (a - b); sn += b * b; }
          atomicAdd((float*)(FWS + WS_CTL) + 8, sd); atomicAdd((float*)(FWS + WS_CTL) + 9, sn); }
        GRID_BAR();
#endif
        { pg8::Gemm g{MIXED, (const bf16*)(wl + W_OUT), MROWS, DM, DM}; pg8::StaticOrder S; S.init(MROWS, DM, F.G, (int)blockIdx.x);
          if (l == 0) { pg8::EpiResGate<true> E{F.in[F.zz + 0], XB, DM, modl + 2 * DM, 12288, SEQ}; pg8::gemm_phase<pg8::EpiResGate<true>, pg8::StaticOrder, true, true>(F.lds, g, S, E, F.wave); }
          else { pg8::EpiResGate<false> E{XB, XB, DM, modl + 2 * DM, 12288, SEQ}; pg8::gemm_phase<pg8::EpiResGate<false>, pg8::StaticOrder, true, true>(F.lds, g, S, E, F.wave); } }
        GRID_BAR();
        norm_phase<0, false>(F, XB, HB, F.in[F.zz + 22] + l * DM, modl + 3 * DM, modl + 4 * DM);
        GRID_BAR();
        { pg8::Gemm g{HB, (const bf16*)(wl + W_UP), MROWS, UPC, DM}; pg8::StaticOrder S; S.init(MROWS, UPC, F.G, (int)blockIdx.x);
          pg8::EpiConvGate E{ACT, DFF, (float*)(FWS + WS_HALO), F.in[F.zz + 16] + (size_t)l * 3 * UPC, F.in[F.zz + 17] + (size_t)l * UPC, UPC, DFF};
          pg8::gemm_phase<pg8::EpiConvGate, pg8::StaticOrder, true, true>(F.lds, g, S, E, F.wave); }
        if (l == 0 && F.G == 256 && blockIdx.x >= 128) { if (blockIdx.x < 224) adaln_item(F, 1, (int)blockIdx.x - 128); convert_gap(F, 1, 0, CV_C2, ((int)blockIdx.x - 128) * NWAVES + F.wave, 128 * NWAVES, CV_N2); }
        if (l == 1 && F.G == 256 && blockIdx.x >= 128) convert_gap(F, 1, CV_IN + CV_OUT + CV_UP, CV_DN, ((int)blockIdx.x - 128) * NWAVES + F.wave, 128 * NWAVES, CV_N2);
        GRID_BAR();
        conv_fixup_phase(F, l);
        GRID_BAR();
        { pg8::Gemm g{ACT, (const bf16*)(wl + W_DN), MROWS, DM, DFF}; pg8::StaticOrder S; S.init(MROWS, DM, F.G, (int)blockIdx.x);
          pg8::EpiResGate<false> E{XB, XB, DM, modl + 5 * DM, 12288, SEQ};
          pg8::gemm_phase<pg8::EpiResGate<false>, pg8::StaticOrder, true, true>(F.lds, g, S, E, F.wave); }
        GRID_BAR();
}

__global__ void __launch_bounds__(NTHR, 2) mega_fwd(Args args) {
    extern __shared__ __attribute__((aligned(16))) unsigned char lds[];
    Frame F;
    F.lds = (LAS unsigned char*)lds;
    F.tid = threadIdx.x; F.lane = F.tid & 63; F.wave = __builtin_amdgcn_readfirstlane(F.tid >> 6);
    F.G = gridDim.x; { const int bx = blockIdx.x; F.vcu = (F.G % 8 == 0) ? (bx % 8) * (F.G / 8) + bx / 8 : bx; }
    F.in = args.in; F.ws = args.ws; F.zz = 0;
    volatile LAS unsigned* MISC = (volatile LAS unsigned*)(F.lds + MISC_OFF);
    for (int u = F.tid; u < (LDS_BYTES - LDSCTL_OFF) / 4; u += NTHR) ((LAS unsigned*)(F.lds + LDSCTL_OFF))[u] = 0u;
    __syncthreads();
    XcdBarrier bar = xcd_barrier_post((unsigned*)(FWS + WS_CTL) + CW_BAR, MISC + 8, F.tid);

    p0_prologue(F);
    GRID_BAR();
    layer_fwd<0>(F, bar);
    layer_fwd<1>(F, bar);
    norm_phase<1, false>(F, XB, args.out, F.in[F.zz + 23], nullptr, nullptr);
}

extern "C" void kernel_launch(void* const* d_in, const int* in_sizes, int n_in, void* d_out, int out_size, void* d_ws, size_t ws_size, hipStream_t stream) {
    static int grid = 0;
    if (grid == 0) {
        if (n_in != 24 || out_size != MROWS * DM || ws_size < WS_END) { fprintf(stderr, "kernel_launch: unexpected shapes (n_in %d out %d ws %zu)\n", n_in, out_size, ws_size); grid = -1; return; }
        int dev = 0, cus = 0;
        if (hipGetDevice(&dev) != hipSuccess || hipDeviceGetAttribute(&cus, hipDeviceAttributeMultiprocessorCount, dev) != hipSuccess) { grid = -1; return; }
        if (hipFuncSetAttribute((const void*)mega_fwd, hipFuncAttributeMaxDynamicSharedMemorySize, LDS_BYTES) != hipSuccess) { fprintf(stderr, "kernel_launch: hipFuncSetAttribute failed\n"); grid = -1; return; }
        int per_cu = 0;
        if (hipOccupancyMaxActiveBlocksPerMultiprocessor(&per_cu, (const void*)mega_fwd, NTHR, LDS_BYTES) != hipSuccess || per_cu < 1) { fprintf(stderr, "kernel_launch: occupancy query says %d\n", per_cu); }
        (void)hipGetLastError();
        grid = cus;
    }
    if (grid < 0) return;
    (void)hipMemsetAsync((char*)d_ws + WS_CTL, 0, CTL_ZERO_BYTES, stream);
    Args a{};
    for (int i = 0; i < 24; ++i) a.in[i] = (const float*)d_in[i];
    a.out = (float*)d_out; a.ws = (unsigned char*)d_ws;
    hipLaunchKernelGGL(mega_fwd, dim3(grid), dim3(NTHR), LDS_BYTES, stream, a);
}
```

```cpp
#include <hip/hip_runtime.h>
#include <cstdio>
#include <cstdint>
#ifndef MOBA_NP
#define MOBA_NP 2
#endif
#ifndef MOBA_CHECK
#define MOBA_CHECK 0
#endif
__device__ __forceinline__ int tid_from_wave(int wave) { int l = (int)__builtin_amdgcn_mbcnt_hi(~0u, __builtin_amdgcn_mbcnt_lo(~0u, 0u)); asm volatile("" : "+v"(l)); return wave * 64 + l; }
namespace pg8 {
#define PG8_LAS __attribute__((address_space(3)))
typedef unsigned short bf16_t;
typedef short bf16x8 __attribute__((ext_vector_type(8)));
typedef float f32x4 __attribute__((ext_vector_type(4)));
typedef unsigned u32x4 __attribute__((ext_vector_type(4)));
constexpr int BM = 256, BK = 64, HALF = 128, HTB = HALF * BK * 2  , STAGE_BYTES = 8 * HTB, NXCD = 8, WGM = 8;

__host__ __device__ __forceinline__ int lds_byte(int r, int c) { const int st = (r >> 4) * 2 + (c >> 5), rr = r & 15, cc = c & 31, ob = rr * 64 + cc * 2; return st * 1024 + (ob ^ (((ob >> 9) & 1) << 5)); }
__host__ __device__ __forceinline__ void stage_rc(int b, int& R, int& C) { const int st = b / 1024, sb = b % 1024, swz = sb ^ (((sb >> 9) & 1) << 5); R = (st >> 1) * 16 + swz / 64; C = (st & 1) * 32 + (swz % 64) / 2; }
__host__ __device__ __forceinline__ int perm32(int rho) { const int n = rho >> 4, i = rho & 15; return 8 * (i >> 2) + 4 * n + (i & 3); }

struct Unit { int pm, pn; };
struct Gemm { const bf16_t* A; const bf16_t* Bt; int M, N, K; };

struct StaticOrder {
    int nM, nN, nwg, G, c;
    __host__ __device__ void init(int M, int N, int G_, int c_) { nM = M / BM; nN = N / BM; nwg = nM * nN; G = G_; c = c_; }
    __host__ __device__ bool next(int i, Unit& u) const {
        const long L = (long)i * G + c; if (L >= nwg) return false;
        int wgid = (int)L; { const int q = nwg / NXCD, r = nwg % NXCD, xcd = wgid % NXCD, off = wgid / NXCD; wgid = (xcd < r ? xcd * (q + 1) : r * (q + 1) + (xcd - r) * q) + off; }
        const int nig = WGM * nN, gid = wgid / nig, fm = gid * WGM, gsz = (nM - fm) < WGM ? (nM - fm) : WGM;
        u.pm = fm + ((wgid % nig) % gsz); u.pn = (wgid % nig) / gsz; return true;
    }
    __device__ __forceinline__ void a_ready(const Unit&) const {}
    __device__ __forceinline__ void done(const Unit&) const {}
};

__device__ __forceinline__ unsigned cvt_pk_bf16(float lo, float hi) { unsigned r; asm volatile("v_cvt_pk_bf16_f32 %0, %1, %2" : "=v"(r) : "v"(lo), "v"(hi)); return r; }

struct EpiBf16 {
    static constexpr bool PERM = true, AFTER_DRAIN = false;
    bf16_t* O; int ldc;
    __device__ __forceinline__ void operator()(const f32x4 (&acc)[2][2][4][2], const Unit& u, int wr, int wc, int fr, int fq) const {
        const int row0 = u.pm * BM + wr * 64 + fr; const int col0 = u.pn * BM + wc * 32 + 8 * fq;
#pragma unroll
        for (int ai = 0; ai < 2; ++ai)
#pragma unroll
            for (int m = 0; m < 4; ++m) { bf16_t* rowp = O + (size_t)(row0 + ai * HALF + m * 16) * ldc + col0;
#pragma unroll
                for (int bj = 0; bj < 2; ++bj) { const f32x4 v0 = acc[ai][bj][m][0], v1 = acc[ai][bj][m][1];
                    u32x4 w; w.x = cvt_pk_bf16(v0[0], v0[1]); w.y = cvt_pk_bf16(v0[2], v0[3]); w.z = cvt_pk_bf16(v1[0], v1[1]); w.w = cvt_pk_bf16(v1[2], v1[3]);
                    *(u32x4*)(rowp + bj * HALF) = w; } }
    }
};

template <int CTRL> __device__ __forceinline__ float dpp_ror(float v) { return __builtin_bit_cast(float, __builtin_amdgcn_update_dpp(0, __builtin_bit_cast(int, v), CTRL, 0xF, 0xF, true)); }
struct EpiConvGate {
    static constexpr bool PERM = true, AFTER_DRAIN = false;
    bf16_t* A; int lda; float* halo; const float* cw; const float* cb; int nup, dff;
    __device__ __forceinline__ void operator()(const f32x4 (&acc)[2][2][4][2], const Unit& u, int wr, int wc, int fr, int fq) const {
        const int chl = wc * 32 + 8 * fq;
#pragma unroll
        for (int n = 0; n < 2; ++n) {
            const int c = u.pn * 128 + chl + 4 * n, colp = u.pn * 256 + chl + 4 * n;
            const f32x4 wv0 = *(const f32x4*)(cw + c), wv1 = *(const f32x4*)(cw + nup + c), wv2 = *(const f32x4*)(cw + 2 * nup + c), bv = *(const f32x4*)(cb + c);
            const f32x4 wg0 = *(const f32x4*)(cw + dff + c), wg1 = *(const f32x4*)(cw + nup + dff + c), wg2 = *(const f32x4*)(cw + 2 * nup + dff + c), bg = *(const f32x4*)(cb + dff + c);
#pragma unroll
            for (int ai = 0; ai < 2; ++ai) {
                const int grow = u.pm * BM + ai * HALF + wr * 64;
                float* hb = halo + (size_t)(grow >> 6) * 4 * nup + colp;
                if (fr < 2) { *(f32x4*)(hb + (size_t)fr * nup) = acc[ai][0][0][n]; *(f32x4*)(hb + (size_t)fr * nup + 128) = acc[ai][1][0][n]; }
                if (fr >= 14) { *(f32x4*)(hb + (size_t)(fr - 12) * nup) = acc[ai][0][3][n]; *(f32x4*)(hb + (size_t)(fr - 12) * nup + 128) = acc[ai][1][3][n]; }
                f32x4 cv[4];
                {   f32x4 P1 = {0.f, 0.f, 0.f, 0.f}, P2 = P1;
#pragma unroll
                    for (int m = 0; m < 4; ++m) { f32x4 R1, R2;
#pragma unroll
                        for (int e = 0; e < 4; ++e) { R1[e] = dpp_ror<0x121>(acc[ai][0][m][n][e]); R2[e] = dpp_ror<0x122>(acc[ai][0][m][n][e]); }
                        const f32x4 p1 = (fr >= 1) ? R1 : P1, p2 = (fr >= 2) ? R2 : P2; P1 = R1; P2 = R2;
                        cv[m] = wv0 * p2 + wv1 * p1 + wv2 * acc[ai][0][m][n] + bv; } }
                {   f32x4 P1 = {0.f, 0.f, 0.f, 0.f}, P2 = P1;
#pragma unroll
                    for (int m = 0; m < 4; ++m) { f32x4 R1, R2;
#pragma unroll
                        for (int e = 0; e < 4; ++e) { R1[e] = dpp_ror<0x121>(acc[ai][1][m][n][e]); R2[e] = dpp_ror<0x122>(acc[ai][1][m][n][e]); }
                        const f32x4 p1 = (fr >= 1) ? R1 : P1, p2 = (fr >= 2) ? R2 : P2; P1 = R1; P2 = R2;
                        const f32x4 cg = wg0 * p2 + wg1 * p1 + wg2 * acc[ai][1][m][n] + bg;
                        f32x4 o;
#pragma unroll
                        for (int e = 0; e < 4; ++e) o[e] = cg[e] * __builtin_amdgcn_rcpf(1.0f + __expf(-cg[e])) * cv[m][e];
                        unsigned w0 = cvt_pk_bf16(o[0], o[1]), w1 = cvt_pk_bf16(o[2], o[3]);
                        *(unsigned long long*)(A + (size_t)(grow + m * 16 + fr) * lda + c) = (unsigned long long)w0 | ((unsigned long long)w1 << 32); } }
            }
        }
    }
};

template <bool BASE_F32>
struct EpiResGate {
    static constexpr bool PERM = true, AFTER_DRAIN = false;
    const void* base; bf16_t* out; int ldc; const float* gate; int gstride; int rows_per_batch;
    __device__ __forceinline__ void operator()(const f32x4 (&acc)[2][2][4][2], const Unit& u, int wr, int wc, int fr, int fq) const {
        const int col0 = u.pn * BM + wc * 32 + 8 * fq;
        const int b = (u.pm * BM) / rows_per_batch;
        f32x4 gv[2][2];
#pragma unroll
        for (int bj = 0; bj < 2; ++bj)
#pragma unroll
            for (int n = 0; n < 2; ++n) gv[bj][n] = *(const f32x4*)(gate + (size_t)b * gstride + col0 + bj * HALF + n * 4);
#pragma unroll
        for (int ai = 0; ai < 2; ++ai)
#pragma unroll
            for (int m = 0; m < 4; ++m) { const size_t off = (size_t)(u.pm * BM + ai * HALF + wr * 64 + m * 16 + fr) * ldc + col0;
#pragma unroll
                for (int bj = 0; bj < 2; ++bj) { f32x4 b0, b1;
                    if (BASE_F32) { b0 = *(const f32x4*)((const float*)base + off + bj * HALF); b1 = *(const f32x4*)((const float*)base + off + bj * HALF + 4); }
                    else { const u32x4 w = *(const u32x4*)((const bf16_t*)base + off + bj * HALF);
                        b0 = (f32x4){__builtin_bit_cast(float, w.x << 16), __builtin_bit_cast(float, w.x & 0xffff0000u), __builtin_bit_cast(float, w.y << 16), __builtin_bit_cast(float, w.y & 0xffff0000u)};
                        b1 = (f32x4){__builtin_bit_cast(float, w.z << 16), __builtin_bit_cast(float, w.z & 0xffff0000u), __builtin_bit_cast(float, w.w << 16), __builtin_bit_cast(float, w.w & 0xffff0000u)}; }
                    const f32x4 o0 = b0 + gv[bj][0] * acc[ai][bj][m][0], o1 = b1 + gv[bj][1] * acc[ai][bj][m][1];
                    u32x4 w; w.x = cvt_pk_bf16(o0[0], o0[1]); w.y = cvt_pk_bf16(o0[2], o0[3]); w.z = cvt_pk_bf16(o1[0], o1[1]); w.w = cvt_pk_bf16(o1[2], o1[3]);
                    *(u32x4*)(out + off + bj * HALF) = w; }
                if (m & 1) asm volatile("" ::: "memory"); }
    }
};

template <class Epi, class Sched, bool ALIGN_EPI = false, bool SP2 = false>
__device__ __forceinline__ void gemm_phase(PG8_LAS unsigned char* lds, const Gemm g, const Sched& S, const Epi& E, int wave_) {
    const int tid_ = tid_from_wave(wave_);
    const int tid = tid_, wid = __builtin_amdgcn_readfirstlane(tid >> 6), lane = tid & 63, wr = wid >> 2, wc = wid & 3, fr = lane & 15, fq = lane >> 4;
    const int K = g.K, nt = K / BK;
    unsigned voffA[2], voffB[2];
#pragma unroll
    for (int i = 0; i < 2; ++i) { int R, C; stage_rc(tid * 16 + i * 8192, R, C); const int Rb = Epi::PERM ? ((R & ~31) + perm32(R & 31)) : R;
        voffA[i] = (unsigned)(R * K + C) * 2u; voffB[i] = (unsigned)(Rb * K + C) * 2u; }
    const size_t kstep = (size_t)(BK * 2);
    const size_t hstep = (size_t)HALF * K * 2;
    const size_t tstep = 2 * hstep;
    const unsigned ldsw = (unsigned)wid * 1024u;
    const int aoff = lds_byte(wr * 64 + fr, fq * 8), boff = lds_byte(wc * 32 + fr, fq * 8);
#define PG8_SA(b, h) (((b) * 2 + (h)) * HTB)
#define PG8_SB(b, h) ((4 + (b) * 2 + (h)) * HTB)
#define PG8_STAGE(bufoff, gbase, voff) do { _Pragma("unroll") for (int _i = 0; _i < 2; ++_i) \
        __builtin_amdgcn_global_load_lds((const unsigned*)((const char*)(gbase) + (voff)[_i]), (PG8_LAS unsigned*)(lds + (bufoff) + ldsw + _i * 8192), 16, 0, 0); } while (0)
#define PG8_LDA(dst, b, h) do { _Pragma("unroll") for (int m = 0; m < 4; ++m) _Pragma("unroll") for (int k = 0; k < 2; ++k) dst[m][k] = *(const PG8_LAS bf16x8*)(lds + PG8_SA(b, h) + aoff + m * 2048 + k * 1024); } while (0)
#define PG8_LDB(dst, b, h) do { _Pragma("unroll") for (int n = 0; n < 2; ++n) _Pragma("unroll") for (int k = 0; k < 2; ++k) dst[n][k] = *(const PG8_LAS bf16x8*)(lds + PG8_SB(b, h) + boff + n * 2048 + k * 1024); } while (0)
#define PG8_MMA(ai, bj, At, Bt) do { __builtin_amdgcn_s_setprio(1); _Pragma("unroll") for (int m = 0; m < 4; ++m) _Pragma("unroll") for (int n = 0; n < 2; ++n) _Pragma("unroll") for (int k = 0; k < 2; ++k) \
        acc[ai][bj][m][n] = __builtin_amdgcn_mfma_f32_16x16x32_bf16(Bt[n][k], At[m][k], acc[ai][bj][m][n], 0, 0, 0); __builtin_amdgcn_s_setprio(0); } while (0)
#define PG8_WAIT_V(n) asm volatile("s_waitcnt vmcnt(" #n ")" ::: "memory")
#define PG8_WAIT_L(n) asm volatile("s_waitcnt lgkmcnt(" #n ")" ::: "memory")
#define PG8_BAR __builtin_amdgcn_s_barrier()
#define PG8_SCHED __builtin_amdgcn_sched_barrier(0)
    Unit cur, nxt; int ui = 0;
    if (!S.next(0, cur)) return;
    f32x4 acc[2][2][4][2];
#pragma unroll
    for (int a = 0; a < 2; ++a)
#pragma unroll
        for (int b = 0; b < 2; ++b)
#pragma unroll
            for (int m = 0; m < 4; ++m)
#pragma unroll
                for (int n = 0; n < 2; ++n) acc[a][b][m][n] = (f32x4){0.f, 0.f, 0.f, 0.f};
    bf16x8 At[4][2], B0[2][2], B1[2][2];
    const char* cA = (const char*)g.A + (size_t)cur.pm * tstep; const char* cB = (const char*)g.Bt + (size_t)cur.pn * tstep;
    S.a_ready(cur);
    if constexpr (SP2) {
        PG8_STAGE(PG8_SB(0, 0), cB, voffB); PG8_STAGE(PG8_SB(0, 1), cB + hstep, voffB); PG8_STAGE(PG8_SA(0, 0), cA, voffA); PG8_STAGE(PG8_SA(0, 1), cA + hstep, voffA);
        if (wr == 1) PG8_BAR;
        PG8_WAIT_V(2); PG8_BAR;
        PG8_STAGE(PG8_SB(1, 0), cB + kstep, voffB); PG8_STAGE(PG8_SA(1, 0), cA + kstep, voffA); PG8_STAGE(PG8_SB(1, 1), cB + hstep + kstep, voffB);
        PG8_WAIT_V(6); PG8_BAR;
    } else {
        PG8_STAGE(PG8_SB(0, 0), cB, voffB); PG8_STAGE(PG8_SA(0, 0), cA, voffA); PG8_STAGE(PG8_SB(0, 1), cB + hstep, voffB); PG8_STAGE(PG8_SA(0, 1), cA + hstep, voffA);
        if (wr == 1) PG8_BAR;
        PG8_WAIT_V(4); PG8_BAR;
        PG8_STAGE(PG8_SB(1, 0), cB + kstep, voffB); PG8_STAGE(PG8_SA(1, 0), cA + kstep, voffA); PG8_STAGE(PG8_SB(1, 1), cB + hstep + kstep, voffB);
        PG8_WAIT_V(6); PG8_BAR;
    }
    for (;;) {
        const bool has_next = S.next(ui + 1, nxt);
        const char* nA = has_next ? (const char*)g.A + (size_t)nxt.pm * tstep : cA; const char* nB = has_next ? (const char*)g.Bt + (size_t)nxt.pn * tstep : cB;
        for (int t = 0; t < nt; t += 2) {
            const bool last = (t == nt - 2);
            const char* a1 = cA + (size_t)(t + 1) * kstep;
            const char* a2 = last ? nA : cA + (size_t)(t + 2) * kstep; const char* b2 = last ? nB : cB + (size_t)(t + 2) * kstep;
            const char* a3 = a2 + kstep; const char* b3 = b2 + kstep;
            if (last && has_next) S.a_ready(nxt);
            if constexpr (SP2) {
            PG8_LDB(B0, 0, 0); PG8_LDB(B1, 0, 1); PG8_SCHED; PG8_LDA(At, 0, 0); PG8_STAGE(PG8_SA(1, 1), a1 + hstep, voffA);
            PG8_WAIT_V(8); PG8_WAIT_L(0); PG8_BAR; PG8_MMA(0, 0, At, B0); PG8_MMA(0, 1, At, B1); PG8_BAR; PG8_SCHED;
            PG8_LDA(At, 0, 1); PG8_STAGE(PG8_SB(0, 0), b2, voffB); PG8_STAGE(PG8_SB(0, 1), b2 + hstep, voffB); PG8_STAGE(PG8_SA(0, 0), a2, voffA);
            PG8_WAIT_V(8); PG8_WAIT_L(0); PG8_BAR; PG8_MMA(1, 0, At, B0); PG8_MMA(1, 1, At, B1); PG8_BAR; PG8_SCHED;
            PG8_LDB(B0, 1, 0); PG8_LDB(B1, 1, 1); PG8_SCHED; PG8_LDA(At, 1, 0); PG8_STAGE(PG8_SA(0, 1), a2 + hstep, voffA);
            PG8_WAIT_V(8); PG8_WAIT_L(0); PG8_BAR; PG8_MMA(0, 0, At, B0); PG8_MMA(0, 1, At, B1); PG8_BAR; PG8_SCHED;
            PG8_LDA(At, 1, 1); PG8_STAGE(PG8_SB(1, 0), b3, voffB); PG8_STAGE(PG8_SB(1, 1), b3 + hstep, voffB); PG8_STAGE(PG8_SA(1, 0), a3, voffA);
            PG8_WAIT_V(8); PG8_WAIT_L(0); PG8_BAR; PG8_MMA(1, 0, At, B0); PG8_MMA(1, 1, At, B1); PG8_BAR; PG8_SCHED;
            } else {
            PG8_LDB(B0, 0, 0); PG8_SCHED; PG8_LDA(At, 0, 0); PG8_STAGE(PG8_SA(1, 1), a1 + hstep, voffA);
            PG8_WAIT_L(8); PG8_BAR; PG8_WAIT_L(0); PG8_MMA(0, 0, At, B0); PG8_BAR; PG8_SCHED;
            PG8_LDB(B1, 0, 1); PG8_STAGE(PG8_SB(0, 0), b2, voffB);
            PG8_BAR; PG8_WAIT_L(0); PG8_MMA(0, 1, At, B1); PG8_BAR;
            PG8_LDA(At, 0, 1); PG8_STAGE(PG8_SA(0, 0), a2, voffA);
            PG8_BAR; PG8_WAIT_L(0); PG8_MMA(1, 0, At, B0); PG8_BAR; PG8_SCHED;
            PG8_STAGE(PG8_SB(0, 1), b2 + hstep, voffB);
            PG8_WAIT_V(6); PG8_BAR; PG8_MMA(1, 1, At, B1); PG8_BAR;
            PG8_LDB(B0, 1, 0); PG8_SCHED; PG8_LDA(At, 1, 0); PG8_STAGE(PG8_SA(0, 1), a2 + hstep, voffA);
            PG8_WAIT_L(8); PG8_BAR; PG8_WAIT_L(0); PG8_MMA(0, 0, At, B0); PG8_BAR; PG8_SCHED;
            PG8_LDB(B1, 1, 1); PG8_STAGE(PG8_SB(1, 0), b3, voffB);
            PG8_BAR; PG8_WAIT_L(0); PG8_MMA(0, 1, At, B1); PG8_BAR;
            PG8_LDA(At, 1, 1); PG8_STAGE(PG8_SA(1, 0), a3, voffA);
            PG8_BAR; PG8_WAIT_L(0); PG8_MMA(1, 0, At, B0); PG8_BAR; PG8_SCHED;
            PG8_STAGE(PG8_SB(1, 1), b3 + hstep, voffB);
            PG8_WAIT_V(6); PG8_BAR; PG8_MMA(1, 1, At, B1); PG8_BAR;
            }
        }
        if constexpr (ALIGN_EPI) { if (wr == 0) PG8_BAR; }
        if constexpr (!Epi::AFTER_DRAIN) { E(acc, cur, wr, wc, fr, fq); S.done(cur); }
        if (!has_next) break;
#pragma unroll
        for (int a = 0; a < 2; ++a)
#pragma unroll
            for (int b = 0; b < 2; ++b)
#pragma unroll
                for (int m = 0; m < 4; ++m)
#pragma unroll
                    for (int n = 0; n < 2; ++n) acc[a][b][m][n] = (f32x4){0.f, 0.f, 0.f, 0.f};
        cur = nxt; cA = nA; cB = nB; ++ui;
        if constexpr (ALIGN_EPI) { if (wr == 1) PG8_BAR; }
    }
    PG8_WAIT_V(0);
    if constexpr (!ALIGN_EPI) { if (wr == 0) PG8_BAR; }
    PG8_BAR;
    if constexpr (Epi::AFTER_DRAIN) { E.fused(acc, cur, wr, wc, fr, fq, lds, wid, lane); S.done(cur); }
#undef PG8_SA
#undef PG8_SB
#undef PG8_STAGE
#undef PG8_LDA
#undef PG8_LDB
#undef PG8_MMA
#undef PG8_WAIT_V
#undef PG8_WAIT_L
#undef PG8_BAR
#undef PG8_SCHED
}
}

namespace moba {
using bf16 = unsigned short;
typedef short bf16x8 __attribute__((ext_vector_type(8)));
typedef short s16x4 __attribute__((ext_vector_type(4)));
typedef float f32x16 __attribute__((ext_vector_type(16)));
typedef float f32x4 __attribute__((ext_vector_type(4)));
typedef unsigned u32x4 __attribute__((ext_vector_type(4)));
#define MLAS __attribute__((address_space(3)))
typedef MLAS char lchar; typedef MLAS float lfloat; typedef MLAS bf16x8 lbf16x8;
template <class A, class Bt> struct same_t { static constexpr bool v = false; };
template <class A> struct same_t<A, A> { static constexpr bool v = true; };
constexpr int D = 128, LDI = 6656, LDO = 2048;
constexpr float THR = 8.f;
constexpr bool WSKIP = false;
constexpr float SCALE = 0.08838834764831845f;
constexpr int NW = 8, QBLK = 32, KVBLK = 64, QB = NW * QBLK;
constexpr int SHM_V = KVBLK * D * 2, SHM_K = KVBLK * D * 2;
constexpr int LDS_BYTES = 2 * SHM_V + 2 * SHM_K + NW * 64 * 4;
#define KSWZ(row, colB) ((row) * 256 + ((colB) ^ (((row) & 7) << 4)))
#define SBAR() __builtin_amdgcn_sched_barrier(0)
__device__ __forceinline__ int v_st(int k, int c) { const int kk = (k & ~0xC) | ((k & 4) << 1) | ((k & 8) >> 1); return ((kk >> 3) * 4 + (c >> 5)) * 512 + ((kk & 7) * 32 + (c & 31)) * 2; }
__device__ __forceinline__ int v_rd_base(int lane) { return ((lane & 3) << 3) | (((lane >> 2) & 3) << 6) | (((lane >> 4) & 1) << 5) | (((lane >> 5) & 1) << 8); }
constexpr int v_rd_off(int d0, int ks, int half) { return d0 * 512 + ks * 4096 + half * 2048; }
__device__ __forceinline__ int crow(int r, int hi) { return (r & 3) + 8 * (r >> 2) + 4 * hi; }
__device__ __forceinline__ unsigned cvtpk(float lo, float hi) {
    unsigned r; asm volatile("v_cvt_pk_bf16_f32 %0, %1, %2" : "=v"(r) : "v"(lo), "v"(hi)); return r;
}
__device__ __forceinline__ bf16x8 pack8(f32x4 a, f32x4 b) {
    u32x4 w = {cvtpk(a[0], a[1]), cvtpk(a[2], a[3]), cvtpk(b[0], b[1]), cvtpk(b[2], b[3])};
    return *reinterpret_cast<bf16x8*>(&w);
}
template <class T> __device__ __forceinline__ bf16x8 load8(const T* p) {
    if constexpr (same_t<T, float>::v) { return pack8(*(const f32x4*)p, *(const f32x4*)(p + 4)); }
    else { return *reinterpret_cast<const bf16x8*>(p); }
}
__device__ __forceinline__ void mask_tile(f32x16& p0, f32x16& p1, int dq, unsigned W) {
    const float NEG = -__builtin_inff();
#pragma unroll
    for (int r = 0; r < 16; ++r) {
        const int c = (r & 3) + 8 * (r >> 2);
        if ((unsigned)(dq - c) >= W) p0[r] = NEG;
        if ((unsigned)(dq - c - 32) >= W) p1[r] = NEG;
    }
}
__device__ __forceinline__ void partialSM(f32x16& p0, f32x16& p1, float& m_reg, float& mn, float& alpha) {
    float pmax = p0[0]; for (int r = 1; r < 16; ++r) pmax = fmaxf(pmax, p0[r]); for (int r = 0; r < 16; ++r) pmax = fmaxf(pmax, p1[r]);
    { auto rr = __builtin_amdgcn_permlane32_swap(__float_as_uint(pmax), __float_as_uint(pmax), false, false);
      pmax = fmaxf(__uint_as_float(rr[0]), __uint_as_float(rr[1])); }
    constexpr float C2 = 1.4426950408889634f * SCALE;
    if (__builtin_expect(__all((pmax - m_reg) * SCALE <= THR), 1)) { mn = m_reg; alpha = 1.f; }
    else { mn = fmaxf(m_reg, pmax); alpha = __builtin_amdgcn_exp2f((m_reg - mn) * C2); m_reg = mn; }
    const float mnL = -mn * C2;
    for (int r = 0; r < 16; ++r) p0[r] = fmaf(p0[r], C2, mnL); for (int r = 0; r < 16; ++r) p1[r] = fmaf(p1[r], C2, mnL);
    for (int r = 0; r < 16; ++r) p0[r] = __builtin_amdgcn_exp2f(p0[r]);
}
__device__ __forceinline__ void finishSM(f32x16& p0, f32x16& p1, float alpha, float& l_reg, bf16x8& pa0, bf16x8& pa1, bf16x8& pa2, bf16x8& pa3) {
    for (int r = 0; r < 16; ++r) p1[r] = __builtin_amdgcn_exp2f(p1[r]);
    float ps = 0; for (int r = 0; r < 16; ++r) ps += p0[r]; for (int r = 0; r < 16; ++r) ps += p1[r];
    { auto rr = __builtin_amdgcn_permlane32_swap(__float_as_uint(ps), __float_as_uint(ps), false, false);
      ps = __uint_as_float(rr[0]) + __uint_as_float(rr[1]); }
    l_reg = l_reg * alpha + ps;
#define PK4(P, B_, OUT) do { unsigned a0 = cvtpk(P[B_+0], P[B_+1]), a1 = cvtpk(P[B_+2], P[B_+3]);                          \
        unsigned b0 = cvtpk(P[B_+4], P[B_+5]), b1 = cvtpk(P[B_+6], P[B_+7]);                                             \
        auto r0 = __builtin_amdgcn_permlane32_swap(a0, b0, false, false); auto r1 = __builtin_amdgcn_permlane32_swap(a1, b1, false, false); \
        u32x4 w = {r0[0], r1[0], r0[1], r1[1]}; OUT = *reinterpret_cast<bf16x8*>(&w); } while (0)
    PK4(p0, 0, pa0); PK4(p0, 8, pa1); PK4(p1, 0, pa2); PK4(p1, 8, pa3);
#undef PK4
}
template <int KB, bool SK>
__device__ __forceinline__ void qkt(f32x16& p0, f32x16& p1, const lchar* K_lds, int r32, int hi, const bf16x8* qr, bool act, float slopeR, float lb) {
    if (SK && !act) { const float NEG = -__builtin_inff();
#pragma unroll
        for (int r = 0; r < 16; ++r) { p0[r] = NEG; p1[r] = NEG; } return; }
#pragma unroll
    for (int r = 0; r < 16; ++r) { const int c = (r & 3) + 8 * (r >> 2); p0[r] = __builtin_fmaf(slopeR, (float)c, lb); p1[r] = __builtin_fmaf(slopeR, (float)(c + 32), lb); }
    const lchar* kb[4];
#pragma unroll
    for (int dd = 0; dd < 4; ++dd) kb[dd] = K_lds + KB * SHM_K + KSWZ(r32, (dd * 16 + hi * 8) * 2);
#pragma unroll
    for (int d0 = 0; d0 < 8; ++d0) { const lchar* a = kb[d0 & 3] + (d0 >> 2) * 128;
        bf16x8 b0 = *(const lbf16x8*)(a);
        bf16x8 b1 = *(const lbf16x8*)(a + 32 * 256);
        p0 = __builtin_amdgcn_mfma_f32_32x32x16_bf16(b0, qr[d0], p0, 0, 0, 0);
        p1 = __builtin_amdgcn_mfma_f32_32x32x16_bf16(b1, qr[d0], p1, 0, 0, 0); }
}
template <int VB, bool SK>
__device__ __forceinline__ void pv_tile(f32x16* o, int vb0, bf16x8 pa0, bf16x8 pa1, bf16x8 pa2, bf16x8 pa3, bool act) {
    if (SK && !act) return;
#define TRRD(dst, off) asm volatile("ds_read_b64_tr_b16 %0, %1 offset:%2" : "=&v"(dst) : "v"(vb0), "i"(off) : "memory")
#define PV_D0(d0) do { s16x4 l0, l1, l2, l3, h0, h1, h2, h3; constexpr int b_ = VB * SHM_V + v_rd_off(d0, 0, 0);     \
        TRRD(l0, b_); TRRD(h0, b_ + 2048); TRRD(l1, b_ + 4096); TRRD(h1, b_ + 6144); TRRD(l2, b_ + 8192); TRRD(h2, b_ + 10240); TRRD(l3, b_ + 12288); TRRD(h3, b_ + 14336); \
        asm volatile("s_waitcnt lgkmcnt(0)" ::: "memory"); SBAR();                 \
        o[d0] = __builtin_amdgcn_mfma_f32_32x32x16_bf16(pa0, (bf16x8){l0[0], l0[1], l0[2], l0[3], h0[0], h0[1], h0[2], h0[3]}, o[d0], 0, 0, 0);   \
        o[d0] = __builtin_amdgcn_mfma_f32_32x32x16_bf16(pa1, (bf16x8){l1[0], l1[1], l1[2], l1[3], h1[0], h1[1], h1[2], h1[3]}, o[d0], 0, 0, 0);   \
        o[d0] = __builtin_amdgcn_mfma_f32_32x32x16_bf16(pa2, (bf16x8){l2[0], l2[1], l2[2], l2[3], h2[0], h2[1], h2[2], h2[3]}, o[d0], 0, 0, 0);   \
        o[d0] = __builtin_amdgcn_mfma_f32_32x32x16_bf16(pa3, (bf16x8){l3[0], l3[1], l3[2], l3[3], h3[0], h3[1], h3[2], h3[3]}, o[d0], 0, 0, 0); } while (0)
    PV_D0(0); PV_D0(1); PV_D0(2); PV_D0(3);
#undef PV_D0
#undef TRRD
}

typedef __attribute__((address_space(1))) char gchar; typedef __attribute__((address_space(1))) bf16x8 gbf16x8;
__device__ __forceinline__ const gchar* uni_ptr(const char* p) { const unsigned long long v = (unsigned long long)p;
    const unsigned lo = __builtin_amdgcn_readfirstlane((unsigned)v), hi = __builtin_amdgcn_readfirstlane((unsigned)(v >> 32)); return (const gchar*)(((unsigned long long)hi << 32) | lo); }
template <class TIn, class TOut> struct BlockRef { const TIn* Q; const TIn* K; const TIn* V; TOut* O; int P0; const __attribute__((address_space(3))) unsigned* sel; float slopeR; };
template <class TIn> struct Seam {
    bf16x8 qr[8];
    bf16x8 st_v0, st_v1, st_k0, st_k1; f32x4 sf0, sf1, sf2, sf3;
    f32x4 tq[16];
};
__device__ __forceinline__ int swa_jlo(int P0, int W) { const int lowk = P0 - W + 1; return lowk > 0 ? lowk / KVBLK : 0; }
#define ROW(p, k0, rr) ((const TIn*)((const char*)(p) + (size_t)(k0) * (LDI * sizeof(TIn)) + (unsigned)(((rr) * LDI + sc) * (int)sizeof(TIn))))
#define VMW() asm volatile("s_waitcnt vmcnt(0)" ::: "memory")
#define VMWN(n) asm volatile("s_waitcnt vmcnt(%0)" :: "i"(n) : "memory")
#define SLOAD_H(Kp, Vp, k0) do { const gchar* kb__ = uni_ptr((const char*)(Kp) + (size_t)(k0) * (LDI * sizeof(TIn))); const gchar* vb__ = uni_ptr((const char*)(Vp) + (size_t)(k0) * (LDI * sizeof(TIn))); \
                         S.st_v0 = *(const gbf16x8*)(vb__ + roff0); S.st_v1 = *(const gbf16x8*)(vb__ + roff1);              \
                         S.st_k0 = *(const gbf16x8*)(kb__ + roff0); S.st_k1 = *(const gbf16x8*)(kb__ + roff1); } while (0)
#define SWRITE_HK(bf) do { *(lbf16x8*)(K_lds + (bf) * SHM_K + kws) = S.st_k0; *(lbf16x8*)(K_lds + (bf) * SHM_K + kws + 32 * 256) = S.st_k1; } while (0)
#define SWRITE_HV(bf) do { *(lbf16x8*)(V_lds + (bf) * SHM_V + vst0) = S.st_v0; *(lbf16x8*)(V_lds + (bf) * SHM_V + vst1) = S.st_v1; } while (0)
#define SWRITE_H(bf) do { SWRITE_HV(bf); SWRITE_HK(bf); } while (0)
#define SLOAD_F(p, k0) do { S.sf0 = *(const f32x4*)ROW(p, k0, sr); S.sf1 = *(const f32x4*)(ROW(p, k0, sr) + 4);                \
                            S.sf2 = *(const f32x4*)ROW(p, k0, 32 + sr); S.sf3 = *(const f32x4*)(ROW(p, k0, 32 + sr) + 4); } while (0)
#define SWRITE_KF(bf) do { *(lbf16x8*)(K_lds + (bf) * SHM_K + kws) = pack8(S.sf0, S.sf1); *(lbf16x8*)(K_lds + (bf) * SHM_K + kws + 32 * 256) = pack8(S.sf2, S.sf3); } while (0)
#define SWRITE_VF(bf) do { *(lbf16x8*)(V_lds + (bf) * SHM_V + vst0) = pack8(S.sf0, S.sf1); *(lbf16x8*)(V_lds + (bf) * SHM_V + vst1) = pack8(S.sf2, S.sf3); } while (0)
template <class TIn, class TOut>
__device__ __forceinline__ void causal_swa_prime(const BlockRef<TIn, TOut>& cur, int W, lchar* lds, Seam<TIn>& S, int wave_) {
    constexpr bool F32 = same_t<TIn, float>::v;
    const int tid_ = tid_from_wave(wave_);
    const int tid = tid_, wid = __builtin_amdgcn_readfirstlane(tid >> 6), lane = tid & 63, r32 = lane & 31, hi = lane >> 5;
    const int sr = tid >> 4, sc = (tid & 15) * 8, kws = KSWZ(sr, sc * 2); lchar* K_lds = lds + 2 * SHM_V;
    const unsigned roff0 = (unsigned)((sr * LDI + sc) * (int)sizeof(TIn)), roff1 = (unsigned)(((32 + sr) * LDI + sc) * (int)sizeof(TIn));
    const int kb0 = ((cur.P0 + QB - 1) / KVBLK) * KVBLK;
    for (int d0 = 0; d0 < 8; ++d0) S.qr[d0] = *(const gbf16x8*)(uni_ptr((const char*)cur.Q) + (unsigned)(((wid * QBLK + r32) * LDI + hi * 8) * (int)sizeof(TIn)) + d0 * 16 * sizeof(TIn));
    if constexpr (F32) { SLOAD_F((const float*)cur.K, kb0); VMW(); SWRITE_KF(0); SBAR(); SLOAD_F((const float*)cur.V, kb0); }
    else { SLOAD_H(cur.K, cur.V, kb0); VMW(); SWRITE_HK(0); }
    __syncthreads();
}
template <class TIn, class TOut>
__device__ __forceinline__ void causal_swa_block(const BlockRef<TIn, TOut>& cur, const BlockRef<TIn, TOut>& nxt, int skv, int W, lchar* lds, Seam<TIn>& S, int wave_) {
    constexpr bool F32 = same_t<TIn, float>::v;
    const int tid_ = tid_from_wave(wave_);
    const int tid = tid_, wid = __builtin_amdgcn_readfirstlane(tid >> 6), lane = tid & 63, r32 = lane & 31, hi = lane >> 5;
    const int j_lo = swa_jlo(cur.P0, W);
    int j_hi = (cur.P0 + QB - 1) / KVBLK + 1; if (j_hi > skv / KVBLK) j_hi = skv / KVBLK;
    const int NT = j_hi - j_lo;
    const int kbn = ((nxt.P0 + QB - 1) / KVBLK) * KVBLK;
    const unsigned selm = cur.sel[wid * QBLK + r32] | (1u << (cur.P0 >> 8)); const float slopeR = __builtin_bit_cast(float, __builtin_amdgcn_readfirstlane(__builtin_bit_cast(unsigned, cur.slopeR))); const int tqm = cur.P0 + wid * QBLK + r32 - 4 * hi;
#define LB(t) (((selm >> (KBASE(t) >> 8)) & 1u) ? slopeR * (float)(KBASE(t) - tqm) : -__builtin_inff())
    const int qlo = cur.P0 + wid * QBLK, qm = qlo + r32 - 4 * hi;
    lchar* V_lds = lds; lchar* K_lds = lds + 2 * SHM_V;
    lfloat* ws = (lfloat*)(lds + 2 * SHM_V + 2 * SHM_K) + wid * 64; lfloat* li_l = ws; lfloat* al_l = ws + 32;
    float m_reg = -1e30f, l_reg = 0; f32x16 o[4] = {};
    const unsigned roff0 = (unsigned)(((tid >> 4) * LDI + (tid & 15) * 8) * (int)sizeof(TIn)), roff1 = (unsigned)(((32 + (tid >> 4)) * LDI + (tid & 15) * 8) * (int)sizeof(TIn));
    const int sr = tid >> 4, sc = (tid & 15) * 8, vst0 = v_st(sr, sc), vst1 = v_st(32 + sr, sc), kws = KSWZ(sr, sc * 2);
    const int vb0 = (int)(unsigned)(uintptr_t)V_lds + v_rd_base(lane);
    const TIn* Kh = cur.K; const TIn* Vh = cur.V;
#define RESC(a) do { if (__any((a) < 1.f)) { if (hi == 0) al_l[r32] = (a); asm volatile("s_waitcnt lgkmcnt(0)" ::: "memory");              \
                     for (int d_ = 0; d_ < 4; ++d_) for (int r = 0; r < 16; ++r) o[d_][r] *= al_l[crow(r, hi)]; } } while (0)
#define KBASE(t) ((j_hi - 1 - (t)) * KVBLK)
#define ACT(t) (KBASE(t) <= qlo + QBLK - 1 && KBASE(t) + KVBLK - 1 >= qlo - W + 1)
#define MASKT(P0_, P1_, t) do { const int kb_ = KBASE(t); if ((!SK || ACT(t)) && (kb_ + KVBLK - 1 > qlo || kb_ <= qlo + QBLK - 1 - W)) mask_tile(P0_, P1_, qm - kb_, (unsigned)W); } while (0)
    constexpr int NQL = F32 ? 16 : 8;
    constexpr bool SK = WSKIP && !F32;
#define SEAM_K0() do { VMWN(NQL); if constexpr (F32) { SWRITE_KF(0); SBAR(); SLOAD_F((const float*)nxt.V, kbn); } else { SWRITE_HK(0); } SBAR(); } while (0)
    unsigned touch_reg = 0u; const int tl_ = wid * 32 + (lane & 31);
    const unsigned toff = (unsigned)(((tl_ & 127) >> 1) * LDI * (int)sizeof(TIn) + (tl_ & 1) * 128);
    const gchar* tbase = uni_ptr((const char*)((tl_ >> 7) ? (const void*)Vh : (const void*)Kh));
#if MOBA_CHECK
#define TOUCH(k0) do {} while (0)
#else
#define TOUCH(k0) do { const gchar* tp_ = tbase + (size_t)(k0) * (LDI * sizeof(TIn)) + toff; asm volatile("global_load_dword %0, %1, off" : "+v"(touch_reg) : "v"(tp_) : "memory"); } while (0)
#endif
    f32x16 pA0, pA1, pB0, pB1; float mnA, mnB, alA, alB; bf16x8 pa0, pa1, pa2, pa3;
    if constexpr (F32) { VMW(); SWRITE_VF(0); SBAR(); } else { SWRITE_HV(0); SBAR(); }
    if (NT > 1) { if constexpr (F32) SLOAD_F((const float*)Kh, KBASE(1)); else SLOAD_H(Kh, Vh, KBASE(1)); }
    SBAR(); qkt<0, SK>(pA0, pA1, K_lds, r32, hi, S.qr, ACT(0), slopeR, LB(0));
    if constexpr (F32) { if (NT > 1) { VMW(); SWRITE_KF(1); SBAR(); SLOAD_F((const float*)Vh, KBASE(1)); } }
    MASKT(pA0, pA1, 0); partialSM(pA0, pA1, m_reg, mnA, alA);
    if (NT > 1) { VMW(); if constexpr (F32) { SWRITE_VF(1); SBAR(); if (NT > 2) SLOAD_F((const float*)Kh, KBASE(2)); } else SWRITE_H(1); }
    __syncthreads();
#define HALF_STEP(PX0, PX1, mnX, alX, PY0, PY1, alY, t, KB, VB, SB) do {                                                      \
        SBAR(); qkt<KB, SK>(PX0, PX1, K_lds, r32, hi, S.qr, ACT(t), slopeR, LB(t));                                             \
        finishSM(PY0, PY1, alY, l_reg, pa0, pa1, pa2, pa3); SBAR();                                                           \
        if ((t) + 1 < NT) { if constexpr (F32) { VMW(); SWRITE_KF(SB); SBAR(); SLOAD_F((const float*)Vh, KBASE((t) + 1)); }  \
                            else { SLOAD_H(Kh, Vh, KBASE((t) + 1)); } SBAR(); }                                               \
        pv_tile<VB, SK>(o, vb0, pa0, pa1, pa2, pa3, ACT((t) - 1)); MASKT(PX0, PX1, (t)); partialSM(PX0, PX1, m_reg, mnX, alX);                                        \
        __syncthreads();                                                                                                      \
        if ((t) + 1 < NT) { VMW(); if constexpr (F32) { SWRITE_VF(SB); SBAR(); if ((t) + 2 < NT) SLOAD_F((const float*)Kh, KBASE((t) + 2)); } \
                            else { SWRITE_H(SB); } }                                                                          \
        if ((t) + 3 < NT) { TOUCH(KBASE((t) + 3)); }                                                                          \
        RESC(alX); __syncthreads(); } while (0)
    for (int t = 1; t + 1 < NT; t += 2) {
        HALF_STEP(pB0, pB1, mnB, alB, pA0, pA1, alA, t, 1, 0, 0);
        HALF_STEP(pA0, pA1, mnA, alA, pB0, pB1, alB, t + 1, 0, 1, 1);
    }
    const bool even = (NT & 1) == 0;
    if (even) { SBAR(); qkt<1, SK>(pB0, pB1, K_lds, r32, hi, S.qr, ACT(NT - 1), slopeR, LB(NT - 1)); SBAR(); }
#define QROW(e) (nxt.Q + (size_t)(wid * QBLK + r32) * LDI + ((e) >> 1) * 16 + hi * 8 + ((e) & 1) * 4)
    if constexpr (F32) { SLOAD_F((const float*)nxt.K, kbn); SBAR();
#pragma unroll
        for (int e = 0; e < 8; ++e) S.tq[e] = *(const f32x4*)QROW(e); }
    else { SLOAD_H(nxt.K, nxt.V, kbn); SBAR();
#pragma unroll
        for (int d0 = 0; d0 < 8; ++d0) S.qr[d0] = *(const gbf16x8*)(uni_ptr((const char*)nxt.Q) + (unsigned)(((wid * QBLK + r32) * LDI + hi * 8) * (int)sizeof(TIn)) + d0 * 16 * sizeof(TIn)); }
    SBAR();
    finishSM(pA0, pA1, alA, l_reg, pa0, pa1, pa2, pa3); SBAR();
    if constexpr (F32) {
#pragma unroll
        for (int e = 8; e < 16; ++e) S.tq[e] = *(const f32x4*)QROW(e); SBAR(); }
#undef QROW
    pv_tile<0, SK>(o, vb0, pa0, pa1, pa2, pa3, ACT(even ? NT - 2 : NT - 1));
    if (even) { MASKT(pB0, pB1, NT - 1); partialSM(pB0, pB1, m_reg, mnB, alB); __syncthreads(); RESC(alB);
        finishSM(pB0, pB1, alB, l_reg, pa0, pa1, pa2, pa3); SBAR(); pv_tile<1, SK>(o, vb0, pa0, pa1, pa2, pa3, ACT(NT - 1)); }
    SBAR(); SEAM_K0();
    if (hi == 0) li_l[r32] = l_reg; asm volatile("s_waitcnt lgkmcnt(0)" ::: "memory");
    float rli[16];
#pragma unroll
    for (int r = 0; r < 16; ++r) rli[r] = __builtin_amdgcn_rcpf(li_l[crow(r, hi)]);
    const gchar* Owb = uni_ptr((const char*)(cur.O + (size_t)(wid * QBLK) * LDO)); const unsigned ooff = (unsigned)((4 * hi * LDO + r32) * (int)sizeof(TOut));
#pragma unroll
    for (int r = 0; r < 16; ++r) { const int orc = (r & 3) + 8 * (r >> 2);
#pragma unroll
        for (int d0 = 0; d0 < 4; ++d0) { const float v = o[d0][r] * rli[r];
            if constexpr (same_t<TOut, float>::v) { *(__attribute__((address_space(1))) float*)((gchar*)(Owb) + ooff + (unsigned)((orc * LDO + d0 * 32) * (int)sizeof(TOut))) = v; }
            else { const float vn = __builtin_bit_cast(float, __builtin_amdgcn_update_dpp(0, __builtin_bit_cast(int, v), 0xB1, 0xF, 0xF, true));
                   if ((r32 & 1) == 0) *(__attribute__((address_space(1))) unsigned*)((gchar*)(Owb) + ooff + (unsigned)((orc * LDO + d0 * 32) * (int)sizeof(TOut))) = cvtpk(v, vn); } } }
    if constexpr (F32) {
#pragma unroll
        for (int d0 = 0; d0 < 8; ++d0) S.qr[d0] = pack8(S.tq[2 * d0], S.tq[2 * d0 + 1]); }
    __syncthreads();
    asm volatile("" :: "v"(touch_reg));
#undef TOUCH
#undef RESC
#undef LB
#undef KBASE
#undef ACT
#undef MASKT
#undef SEAM_K0
#undef HALF_STEP
}
#undef ROW
#undef VMW
#undef VMWN
#undef SLOAD_H
#undef SWRITE_HK
#undef SWRITE_HV
#undef SWRITE_H
#undef SLOAD_F
#undef SWRITE_KF
#undef SWRITE_VF
#undef KSWZ
#undef SBAR
}

constexpr int NWAVES = 8, NTHR = 512;
constexpr int DM = 2048, NB = 2, SEQ = 4096, MROWS = NB * SEQ, NLAYER = 2;
constexpr int IN_COLS = 6592, IN_PAD = 6656, DFF = 5632, UPC = 2 * DFF;
constexpr int C_RQ = 0, C_RK = 256, C_RV = 512, C_RG = 1024, C_RW = 1536, C_MQ = 3520, C_MK = 4544, C_MV = 5568;
constexpr int RWC = 1984;
constexpr float NORM_EPS = 1e-6f, GN_EPS = 64e-5f;
constexpr size_t MiB = 1u << 20;
constexpr size_t WS_CTL = 0, CTL_ZERO_BYTES = 1 * MiB;
constexpr size_t WS_MOD = 1 * MiB;
constexpr size_t WS_KMEAN = 1 * MiB + 512 * 1024;
constexpr size_t WS_W = 2 * MiB, W_LAYER = 100 * MiB, W_IN = 0, W_OUT = 26 * MiB, W_UP = 34 * MiB, W_DN = 78 * MiB;
constexpr size_t WS_X = 202 * MiB;
constexpr size_t WS_H = 266 * MiB;
constexpr size_t WS_PROJ = 298 * MiB;
constexpr size_t WS_ACT = WS_PROJ;
constexpr size_t WS_MIXED = 402 * MiB;
constexpr size_t WS_U = 434 * MiB;
constexpr size_t WS_HALO = WS_U;
constexpr size_t WS_RW = WS_U;
constexpr size_t WS_Y = WS_U + 128 * MiB;
constexpr size_t WS_RETO = WS_U + 144 * MiB;
constexpr size_t WS_REC = 610 * MiB;
constexpr size_t WS_RWW = 738 * MiB;
constexpr size_t WS_END = 739 * MiB;
constexpr size_t RWA = (size_t)MROWS * 512;
constexpr int CW_BAR = 4096, CW_SUB = 64;
constexpr int RING_BYTES = 131072, LDSCTL_OFF = RING_BYTES, MISC_OFF = LDSCTL_OFF + 320, LDS_BYTES = 147456;

#define GAS __attribute__((address_space(1)))
#define LAS __attribute__((address_space(3)))
typedef unsigned short bf16;
typedef unsigned v4u __attribute__((ext_vector_type(4)));
typedef unsigned v2u __attribute__((ext_vector_type(2)));
typedef float f32x4 __attribute__((ext_vector_type(4)));
typedef float f32x2 __attribute__((ext_vector_type(2)));
#define LDS_WAIT() asm volatile("s_waitcnt lgkmcnt(0)" ::: "memory")
__device__ __forceinline__ unsigned f2bf(float f) { unsigned u = __builtin_bit_cast(unsigned, f); return (u + 0x7fffu + ((u >> 16) & 1u)) >> 16; }
__device__ __forceinline__ unsigned pk2(float lo, float hi) { return f2bf(lo) | (f2bf(hi) << 16); }
__device__ __forceinline__ float bf2f(unsigned short h) { return __builtin_bit_cast(float, (unsigned)h << 16); }
__device__ __forceinline__ float bflo(unsigned w) { return __builtin_bit_cast(float, w << 16); }
__device__ __forceinline__ float bfhi(unsigned w) { return __builtin_bit_cast(float, w & 0xffff0000u); }
template <int CTRL> __device__ __forceinline__ float dpp_add(float v);
__device__ __forceinline__ float wave_sum(float v);
__device__ __forceinline__ float wave_max(float v) {
#pragma unroll
    for (int o = 1; o < 64; o <<= 1) v = fmaxf(v, __shfl_xor(v, o));
    return v;
}
template <int CTRL> __device__ __forceinline__ float dpp_add(float v) { return v + __builtin_bit_cast(float, __builtin_amdgcn_update_dpp(0, __builtin_bit_cast(int, v), CTRL, 0xF, 0xF, true)); }
__device__ __forceinline__ float xsum16(float v) { auto r = __builtin_amdgcn_permlane16_swap(__float_as_uint(v), __float_as_uint(v), false, false); return __uint_as_float(r[0]) + __uint_as_float(r[1]); }
__device__ __forceinline__ float xsum32(float v) { auto r = __builtin_amdgcn_permlane32_swap(__float_as_uint(v), __float_as_uint(v), false, false); return __uint_as_float(r[0]) + __uint_as_float(r[1]); }
__device__ __forceinline__ float wave_sum(float v) {
    v = dpp_add<0xB1>(v); v = dpp_add<0x4E>(v); v = dpp_add<0x141>(v); v = dpp_add<0x140>(v);
    return xsum32(xsum16(v));
}
__device__ __forceinline__ float sigmoidf_(float x) { return __builtin_amdgcn_rcpf(1.0f + __expf(-x)); }

#define XB_TMO      128
#define XB_XCNT(j)  (256  + 64 * (j))
#define XB_XSUB(j)  (1280 + 64 * (j))
#define XB_XGEN(j)  (2304 + 64 * (j))
#define XB_TOP      3328
#define XB_TOPGEN   3392
#define XCD_BAR_WORDS 3456
#define XB_SPIN_CAP (1u << 22)
__device__ __forceinline__ unsigned xb_ld(unsigned* p)              { return __hip_atomic_load(p, __ATOMIC_RELAXED, __HIP_MEMORY_SCOPE_AGENT); }
__device__ __forceinline__ unsigned xb_add(unsigned* p, unsigned v) { return __hip_atomic_fetch_add(p, v, __ATOMIC_RELAXED, __HIP_MEMORY_SCOPE_AGENT); }
__device__ __forceinline__ unsigned xb_xcc_id() { return (unsigned)__builtin_amdgcn_s_getreg((3 << 11) | 20) & 0xFu; }
#define XB_SPIN(cond, bar) do { unsigned _sp = 0; while (cond) { __builtin_amdgcn_s_sleep(1); \
    if ((++_sp & 255u) == 0u) { if (xb_ld(&(bar)[XB_TMO])) break; if (_sp > XB_SPIN_CAP) { atomicAdd(&(bar)[XB_TMO], 1u); break; } } } } while (0)
struct XcdBarrier { unsigned* bar; unsigned x; volatile LAS unsigned* st; };
__device__ __forceinline__ XcdBarrier xcd_barrier_post(unsigned* bar, volatile LAS unsigned* st, int tid) {
    XcdBarrier b; b.bar = bar; b.x = xb_xcc_id(); b.st = st;
    if (tid == 0) (void)xb_add(&bar[XB_XCNT(b.x)], 1u);
    return b;
}
__device__ __forceinline__ void xcd_barrier_complete(unsigned* bar, unsigned x, unsigned& nloc, unsigned& nx) {
    const unsigned G = gridDim.x * gridDim.y * gridDim.z;
    unsigned sum, cnt, mine, sp = 0u;
    for (;;) {
        sum = 0u; cnt = 0u; mine = 0u;
#pragma unroll
        for (unsigned j = 0; j < 16; ++j) { const unsigned c = xb_ld(&bar[XB_XCNT(j)]); sum += c; cnt += (c > 0u) ? 1u : 0u; mine = (j == x) ? c : mine; }
        if (sum == G) break;
        __builtin_amdgcn_s_sleep(1);
        if ((++sp & 255u) == 0u) { if (xb_ld(&bar[XB_TMO])) break; if (sp > XB_SPIN_CAP) { atomicAdd(&bar[XB_TMO], 1u); break; } }
    }
    nloc = mine > 0u ? mine : 1u; nx = cnt > 0u ? cnt : 1u;
}
__device__ __forceinline__ void xcd_barrier(const XcdBarrier& b, int tid) {
    asm volatile("s_waitcnt vmcnt(0)" ::: "memory");
    __syncthreads();
    if (tid == 0) {
        unsigned z_ = 0u; asm volatile("" : "+v"(z_)); z_ = (unsigned)__builtin_amdgcn_readfirstlane(z_);
        unsigned* bar = b.bar + z_; const unsigned bx_ = b.x + z_;
        __builtin_amdgcn_s_waitcnt(0);
        unsigned nloc = b.st[0], nx = b.st[1];
        if (nloc == 0u) { xcd_barrier_complete(bar, bx_, nloc, nx); b.st[0] = nloc; b.st[1] = nx; }
        const unsigned old = xb_add(&bar[XB_XSUB(bx_)], 1u);
        const unsigned gen = old / nloc;
        if (old + 1u == (gen + 1u) * nloc) {
            __builtin_amdgcn_fence(__ATOMIC_RELEASE, "agent");
            asm volatile("s_waitcnt vmcnt(0)" ::: "memory");
            const unsigned og = xb_add(&bar[XB_TOP], 1u);
            const unsigned tg = og / nx;
            if (og + 1u == (tg + 1u) * nx) xb_add(&bar[XB_TOPGEN], 1u);
            else XB_SPIN(xb_ld(&bar[XB_TOPGEN]) == tg, bar);
            __builtin_amdgcn_fence(__ATOMIC_ACQUIRE, "agent");
            xb_add(&bar[XB_XGEN(bx_)], 1u);
            asm volatile("s_waitcnt vmcnt(0)" ::: "memory");
        } else {
            XB_SPIN(xb_ld(&bar[XB_XGEN(bx_)]) == gen, bar);
            __builtin_amdgcn_fence(__ATOMIC_ACQUIRE, "agent");
            asm volatile("s_waitcnt vmcnt(0)" ::: "memory");
        }
    }
    __syncthreads();
}

struct Args { const float* in[24]; float* out; unsigned char* ws; };
struct Frame {
    LAS unsigned char* lds;
    int tid, lane, wave, vcu, G, zz;
    const float* const* in;
    unsigned char* ws;
};

#define FWS (F.ws + F.zz)
__device__ __forceinline__ void p0_transpose_item(const float* W, int K, int N, bf16* WT, LAS float* scr, int item, int lane, int half = 0) {
    const int nblk = N / 32, kb = item / nblk, nb = item % nblk, k0 = 64 * kb, n0 = 32 * nb;
    const int r0 = !half ? n0 : (n0 < half ? (n0 >> 7) * 256 + (n0 & 127) : ((n0 - half) >> 7) * 256 + 128 + ((n0 - half) & 127));
#pragma unroll 8
    for (int i = 0; i < 32; ++i) { const int kk = 2 * i + (lane >> 5); scr[kk * 33 + (lane & 31)] = W[(size_t)(k0 + kk) * N + n0 + (lane & 31)]; }
    LDS_WAIT(); asm volatile("" ::: "memory");
    const int c = lane & 7;
#pragma unroll
    for (int j = 0; j < 4; ++j) { const int n = (lane >> 3) + 8 * j; const LAS float* s = scr + (8 * c) * 33 + n;
        v4u o; o.x = pk2(s[0 * 33], s[1 * 33]); o.y = pk2(s[2 * 33], s[3 * 33]); o.z = pk2(s[4 * 33], s[5 * 33]); o.w = pk2(s[6 * 33], s[7 * 33]);
        *(v4u*)(WT + (size_t)(r0 + n) * K + k0 + 8 * c) = o; }
    LDS_WAIT(); asm volatile("" ::: "memory");
}
constexpr int CV_IN = (DM / 64) * (IN_COLS / 32), CV_OUT = (DM / 64) * (DM / 32), CV_UP = (DM / 64) * (UPC / 32), CV_DN = (DFF / 64) * (DM / 32), CV_LAYER = CV_IN + CV_OUT + CV_UP + CV_DN;
constexpr int CV_N1 = 10, CV_N2 = 6, CV_N3 = 4, CV_C1 = 192 * NWAVES * CV_N1, CV_C2 = 128 * NWAVES * CV_N2;
static_assert(CV_IN + CV_C1 <= CV_LAYER && CV_LAYER - (CV_IN + CV_C1) + (CV_IN - CV_C2) <= 128 * NWAVES * CV_N3 && CV_C2 <= CV_IN, "gap capacities");
__device__ __forceinline__ void convert_item(Frame& F, int it, LAS float* scr) {
    const int l = it / CV_LAYER; int r = it % CV_LAYER;
    unsigned char* wl = FWS + WS_W + (size_t)l * W_LAYER;
    if (r < CV_IN) { p0_transpose_item(F.in[F.zz + 2] + (size_t)l * DM * IN_COLS, DM, IN_COLS, (bf16*)(wl + W_IN), scr, r, F.lane); return; } r -= CV_IN;
    if (r < CV_OUT) { p0_transpose_item(F.in[F.zz + 3] + (size_t)l * DM * DM, DM, DM, (bf16*)(wl + W_OUT), scr, r, F.lane); return; } r -= CV_OUT;
    if (r < CV_UP) { p0_transpose_item(F.in[F.zz + 15] + (size_t)l * DM * UPC, DM, UPC, (bf16*)(wl + W_UP), scr, r, F.lane, DFF); return; } r -= CV_UP;
    p0_transpose_item(F.in[F.zz + 18] + (size_t)l * DFF * DM, DFF, DM, (bf16*)(wl + W_DN), scr, r, F.lane);
}
__device__ __forceinline__ void convert_gap(Frame& F, int layer, int first, int count, int gwi, int nwv, int nper) {
    LAS float* scr = (LAS float*)(F.lds + F.wave * 16384);
    for (int j = 0; j < nper; ++j) { const int r = gwi + nwv * j; if (r < count) convert_item(F, layer * CV_LAYER + first + r, scr); }
}
__device__ __forceinline__ void adaln_item(Frame& F, int l, int grp) {
    LAS float* cact = (LAS float*)F.lds;
    LAS float* red = (LAS float*)(F.lds + 16384);
    const float* c = F.in[F.zz + 1];
    for (int i = F.tid; i < 4096; i += NTHR) { const float cv = c[i]; cact[i] = cv / (1.0f + __expf(-cv)); }
    __syncthreads();
    const int n0 = grp * 128;
    const float* W = F.in[F.zz + 19] + (size_t)l * 2048 * 12288 + n0;
    const int half = F.lane >> 5, q = F.lane & 31;
    f32x4 a0 = {0.f, 0.f, 0.f, 0.f}, a1 = {0.f, 0.f, 0.f, 0.f};
#pragma unroll 16
    for (int i = 0; i < 128; ++i) { const int k = F.wave * 256 + 2 * i + half; const f32x4 w = *(const f32x4*)(W + (size_t)k * 12288 + 4 * q);
        a0 += w * cact[k]; a1 += w * cact[2048 + k]; }
#pragma unroll
    for (int e = 0; e < 4; ++e) { a0[e] = xsum32(a0[e]); a1[e] = xsum32(a1[e]); }
    if (half == 0) {
#pragma unroll
        for (int e = 0; e < 4; ++e) { red[(F.wave * 2 + 0) * 128 + 4 * q + e] = a0[e]; red[(F.wave * 2 + 1) * 128 + 4 * q + e] = a1[e]; } }
    __syncthreads();
    if (F.tid < 256) { const int bb = F.tid >> 7, col = F.tid & 127; float s = 0.f;
#pragma unroll
        for (int w = 0; w < 8; ++w) s += red[(w * 2 + bb) * 128 + col];
        s += F.in[F.zz + 20][l * 12288 + n0 + col];
        ((float*)(FWS + WS_MOD))[(size_t)(l * 2 + bb) * 12288 + n0 + col] = s; }
    __syncthreads();
}
__device__ __forceinline__ void p0_prologue(Frame& F) {
    const int ngv = (F.G == 256) ? 96 : 192;
    if (F.vcu < ngv) adaln_item(F, F.vcu / 96, F.vcu % 96);
    LAS float* scr = (LAS float*)(F.lds + F.wave * 16384);
    const int gw = F.vcu * NWAVES + F.wave, NGW = F.G * NWAVES;
    if (F.G == 256) { if (F.vcu >= 96) for (int p = gw - 96 * NWAVES; p < CV_IN; p += 160 * NWAVES) convert_item(F, p, scr); }
    else for (int p = gw; p < NLAYER * CV_LAYER; p += NGW) convert_item(F, p, scr);
    for (int l = 0; l < NLAYER; ++l) { bf16* wt = (bf16*)(FWS + WS_RWW + (size_t)l * 448 * 512 * 2);
        const float* wu = F.in[F.zz + 6] + (size_t)l * 96 * 512; const float* au = F.in[F.zz + 8] + (size_t)l * 96 * 512; const float* gu = F.in[F.zz + 9] + (size_t)l * 256 * 512;
        for (int i = F.vcu * NTHR + F.tid; i < 448 * 512; i += F.G * NTHR) {
            if (i < 96 * 512) { const int n = i / 96, kq = i - n * 96; wt[i] = (bf16)f2bf(wu[kq * 512 + n]); }
            else if (i < 2 * 96 * 512) { const int j = i - 96 * 512, n = j / 96, kq = j - n * 96; wt[i] = (bf16)f2bf(au[kq * 512 + n]); }
            else { const int j = i - 2 * 96 * 512, n = j >> 8, kq = j & 255; wt[i] = (bf16)f2bf(gu[kq * 512 + n]); } } }
    for (int l = 0; l < NLAYER; ++l) { v4u* z = (v4u*)(FWS + WS_W + (size_t)l * W_LAYER + W_IN + (size_t)IN_COLS * DM * 2);
        for (int i = F.vcu * NTHR + F.tid; i < (IN_PAD - IN_COLS) * DM * 2 / 16; i += F.G * NTHR) z[i] = (v4u){0u, 0u, 0u, 0u}; }
}

template <int MODE, bool IN_F32>
__device__ __forceinline__ void norm_phase(Frame& F, const void* xin, void* outp, const float* g, const float* sh, const float* sc) {
    LAS float* gs = (LAS float*)F.lds;
    LAS float* shs = (LAS float*)(F.lds + 16384);
    for (int i = F.tid; i < 4096; i += NTHR) { const int b = i >> 11, col = i & 2047;
        if (MODE == 0) { gs[i] = g[col] * (1.0f + sc[(size_t)b * 12288 + col]); shs[i] = sh[(size_t)b * 12288 + col]; }
        else { gs[i] = g[col]; shs[i] = 0.f; } }
    __syncthreads();
    const int gw = F.vcu * NWAVES + F.wave, NGW = F.G * NWAVES;
    for (int m = gw; m < MROWS; m += NGW) {
        const int b = m >> 12;
        f32x4 v[8]; float s = 0.f;
#pragma unroll
        for (int j = 0; j < 8; ++j) {
            if (IN_F32) v[j] = *((const f32x4*)((const float*)xin + (size_t)m * DM) + F.lane + 64 * j);
            else { const v2u w = *((const v2u*)((const bf16*)xin + (size_t)m * DM) + F.lane + 64 * j); v[j] = (f32x4){bflo(w.x), bfhi(w.x), bflo(w.y), bfhi(w.y)}; }
            s += (v[j].x * v[j].x + v[j].y * v[j].y) + (v[j].z * v[j].z + v[j].w * v[j].w); }
        float rstd = __builtin_amdgcn_rsqf(wave_sum(s) * (1.0f / DM) + NORM_EPS);
#if MOBA_CHECK
        if (MODE == 1) { const float sd = ((const float*)(FWS + WS_CTL))[8], sn = ((const float*)(FWS + WS_CTL))[9]; rstd *= 1.0f + 10.0f * sqrtf(sd / sn); }
#endif
#pragma unroll
        for (int j = 0; j < 8; ++j) { const int col = 4 * (F.lane + 64 * j);
            const f32x4 gg = *(const LAS f32x4*)(gs + b * 2048 + col), ss = *(const LAS f32x4*)(shs + b * 2048 + col);
            const f32x4 o = v[j] * rstd * gg + ss;
            if (MODE == 0) { v2u w; w.x = pk2(o.x, o.y); w.y = pk2(o.z, o.w); *(v2u*)((bf16*)outp + (size_t)m * DM + col) = w; }
            else *(f32x4*)((float*)outp + (size_t)m * DM + col) = o; }
    }
    __syncthreads();
}

__device__ __forceinline__ float lerp_bf(const bf16* P, size_t row, int col, bool hasprev, float mu) {
    const float cur = bf2f(P[row * IN_PAD + col]); const float prev = hasprev ? bf2f(P[(row - 1) * IN_PAD + col]) : 0.f;
    return cur + (prev - cur) * mu;
}
__device__ __forceinline__ void rwkv_prep(Frame& F, int l) {
    LAS float* codes = (LAS float*)F.lds;
    const bf16* P = (const bf16*)(FWS + WS_PROJ);
    const float* mu = F.in[F.zz + 4] + l * RWC; const float* w0 = F.in[F.zz + 5] + l * 512; const float* w_up = F.in[F.zz + 6] + (size_t)l * 96 * 512;
    const float* a0 = F.in[F.zz + 7] + l * 512; const float* a_up = F.in[F.zz + 8] + (size_t)l * 96 * 512; const float* g_up = F.in[F.zz + 9] + (size_t)l * 256 * 512;
    const float* k_k = F.in[F.zz + 10] + l * 512; const float* k_a = F.in[F.zz + 11] + l * 512; const float* r_k = F.in[F.zz + 12] + l * 512;
    float* RW = (float*)(FWS + WS_RW);
    const int c = F.tid;
    const float mur = mu[c], muk = mu[512 + c], muv = mu[1024 + c], w0c = w0[c], a0c = a0[c], kkc = k_k[c], kac = k_a[c], rkc = r_k[c];
    for (int item = F.vcu; item < MROWS / 8; item += F.G) {
        const int row0 = item * 8, t0 = row0 & (SEQ - 1);
        for (int idx = F.tid; idx < 8 * 448; idx += NTHR) { const int tk = idx / 448, cc = idx - tk * 448;
            float val = lerp_bf(P, (size_t)(row0 + tk), C_RW + 1536 + cc, (t0 + tk) > 0, mu[1536 + cc]);
            if (cc < 96) val = tanhf(val); else if (cc >= 192) val = sigmoidf_(val);
            codes[idx] = val; }
        __syncthreads();
        float wd[8], wa[8], gg[8];
#pragma unroll
        for (int tk = 0; tk < 8; ++tk) { wd[tk] = 0.f; wa[tk] = 0.f; gg[tk] = 0.f; }
        for (int r = 0; r < 96; ++r) { const float wu = w_up[r * 512 + c], au = a_up[r * 512 + c];
#pragma unroll
            for (int tk = 0; tk < 8; ++tk) { wd[tk] += codes[tk * 448 + r] * wu; wa[tk] += codes[tk * 448 + 96 + r] * au; } }
        for (int r = 0; r < 256; ++r) { const float gu = g_up[r * 512 + c];
#pragma unroll
            for (int tk = 0; tk < 8; ++tk) gg[tk] += codes[tk * 448 + 192 + r] * gu; }
#pragma unroll
        for (int tk = 0; tk < 8; ++tk) {
            const size_t row = (size_t)(row0 + tk); const bool hp = (t0 + tk) > 0;
            const float rr = lerp_bf(P, row, C_RW + c, hp, mur), kk0 = lerp_bf(P, row, C_RW + 512 + c, hp, muk), vv = lerp_bf(P, row, C_RW + 1024 + c, hp, muv);
            const float z = -(w0c + wd[tk]);
            const float sp = fmaxf(z, 0.f) + log1pf(__expf(-fabsf(z)));
            const float decay = __expf(-__expf(-sp - 0.5f));
            const float a = sigmoidf_(a0c + wa[tk]);
            const float kkv = kk0 * kkc;
            const float nrm = sqrtf(wave_sum(kkv * kkv));
            const float kap = kkv / fmaxf(nrm, 1e-12f);
            const float kp = kk0 * (1.0f + (a - 1.0f) * kac);
            const float bsum = wave_sum(rr * kp * rkc);
            const size_t o = row * 512 + c;
            RW[0 * RWA + o] = rr; RW[1 * RWA + o] = decay; RW[2 * RWA + o] = kp; RW[3 * RWA + o] = vv;
            RW[4 * RWA + o] = kap; RW[5 * RWA + o] = kap * a; RW[6 * RWA + o] = gg[tk]; RW[7 * RWA + o] = bsum * vv;
        }
        __syncthreads();
    }
}
__device__ __forceinline__ void moba_kmean(Frame& F) {
    LAS float* red = (LAS float*)(F.lds + 32768);
    const bf16* P = (const bf16*)(FWS + WS_PROJ);
    float* KM = (float*)(FWS + WS_KMEAN);
    for (int item = F.vcu; item < 256; item += F.G) {
        const int b = item >> 7, h = (item >> 4) & 7, n = item & 15;
        const int d = F.tid & 127, part = F.tid >> 7;
        const bf16* kp = P + (size_t)(b * SEQ + n * 256 + part * 64) * IN_PAD + C_MK + h * 128 + d;
        float s = 0.f;
        for (int k = 0; k < 64; ++k) s += bf2f(kp[(size_t)k * IN_PAD]);
        red[part * 128 + d] = s;
        __syncthreads();
        if (F.tid < 128) KM[(size_t)item * 128 + d] = (red[d] + red[128 + d] + red[256 + d] + red[384 + d]) * (1.0f / 256.0f);
        __syncthreads();
    }
}
struct RwIn { f32x4 w[2], kk[2], bb[2], k[2], r[2]; float v; };
__device__ __forceinline__ void rw_load(RwIn& x, const float* RW, size_t row, int cj, int ci) {
    const size_t o = row * 512;
    x.w[0] = *(const f32x4*)(RW + 1 * RWA + o + cj); x.w[1] = *(const f32x4*)(RW + 1 * RWA + o + cj + 4);
    x.kk[0] = *(const f32x4*)(RW + 4 * RWA + o + cj); x.kk[1] = *(const f32x4*)(RW + 4 * RWA + o + cj + 4);
    x.bb[0] = *(const f32x4*)(RW + 5 * RWA + o + cj); x.bb[1] = *(const f32x4*)(RW + 5 * RWA + o + cj + 4);
    x.k[0] = *(const f32x4*)(RW + 2 * RWA + o + cj); x.k[1] = *(const f32x4*)(RW + 2 * RWA + o + cj + 4);
    x.r[0] = *(const f32x4*)(RW + 0 * RWA + o + cj); x.r[1] = *(const f32x4*)(RW + 0 * RWA + o + cj + 4);
    x.v = RW[3 * RWA + o + ci];
}
__device__ __forceinline__ void rwkv_scan_naive(Frame& F, int b, int h) {
    const float* RW = (const float*)(FWS + WS_RW);
    float* Y = (float*)(FWS + WS_Y);
    const int i = F.tid >> 3, jp = F.tid & 7, cj = h * 64 + 8 * jp, ci = h * 64 + i;
    f32x4 s0 = {0.f, 0.f, 0.f, 0.f}, s1 = {0.f, 0.f, 0.f, 0.f};
    RwIn cur, n1, n2;
    const size_t rb = (size_t)b * SEQ;
    rw_load(cur, RW, rb, cj, ci); rw_load(n1, RW, rb + 1, cj, ci);
    for (int t = 0; t < SEQ; ++t) {
        rw_load(n2, RW, rb + (t + 2 < SEQ ? t + 2 : SEQ - 1), cj, ci);
        f32x4 pp = s0 * cur.kk[0] + s1 * cur.kk[1];
        float p = (pp.x + pp.y) + (pp.z + pp.w);
        p += __shfl_xor(p, 1); p += __shfl_xor(p, 2); p += __shfl_xor(p, 4);
        const float sa = -p;
        s0 = s0 * cur.w[0] + sa * cur.bb[0] + cur.v * cur.k[0];
        s1 = s1 * cur.w[1] + sa * cur.bb[1] + cur.v * cur.k[1];
        f32x4 yy = s0 * cur.r[0] + s1 * cur.r[1];
        float y = (yy.x + yy.y) + (yy.z + yy.w);
        y += __shfl_xor(y, 1); y += __shfl_xor(y, 2); y += __shfl_xor(y, 4);
        if (jp == 0) Y[(rb + t) * 512 + ci] = y;
        cur = n1; n1 = n2;
    }
}
struct RtIn { v4u q[2], k[2]; unsigned short v; };
__device__ __forceinline__ void rt_load(RtIn& x, const bf16* P, size_t row, int h, int d0, int v) {
    const bf16* p = P + row * IN_PAD;
    x.q[0] = *(const v4u*)(p + C_RQ + h * 64 + d0); x.q[1] = *(const v4u*)(p + C_RQ + h * 64 + d0 + 8);
    x.k[0] = *(const v4u*)(p + C_RK + h * 64 + d0); x.k[1] = *(const v4u*)(p + C_RK + h * 64 + d0 + 8);
    x.v = p[C_RV + h * 128 + v];
}
__device__ __forceinline__ void ret_scan_naive(Frame& F, int b, int h) {
    const bf16* P = (const bf16*)(FWS + WS_PROJ);
    float* RO = (float*)(FWS + WS_RETO);
    const int v = F.tid >> 2, dp = F.tid & 3, d0 = dp * 16;
    const float gamma = 1.0f - exp2f(-5.0f - (float)h);
    float S[16];
#pragma unroll
    for (int d = 0; d < 16; ++d) S[d] = 0.f;
    RtIn cur, n1, n2;
    const size_t rb = (size_t)b * SEQ;
    rt_load(cur, P, rb, h, d0, v); rt_load(n1, P, rb + 1, h, d0, v);
    for (int t = 0; t < SEQ; ++t) {
        rt_load(n2, P, rb + (t + 2 < SEQ ? t + 2 : SEQ - 1), h, d0, v);
        const float vv = bf2f(cur.v) * 0.125f;
        float o = 0.f;
#pragma unroll
        for (int e = 0; e < 8; ++e) { const unsigned qw = cur.q[e >> 2][e & 3], kw = cur.k[e >> 2][e & 3];
            S[2 * e] = gamma * S[2 * e] + bflo(kw) * vv; S[2 * e + 1] = gamma * S[2 * e + 1] + bfhi(kw) * vv;
            o += bflo(qw) * S[2 * e] + bfhi(qw) * S[2 * e + 1]; }
        o += __shfl_xor(o, 1); o += __shfl_xor(o, 2);
        if (dp == 0) RO[(rb + t) * 512 + h * 128 + v] = o;
        cur = n1; n1 = n2;
    }
}
__device__ __forceinline__ void moba_naive(Frame& F, int mw, int nmw) {
    const bf16* P = (const bf16*)(FWS + WS_PROJ);
    const float* KM = (const float*)(FWS + WS_KMEAN);
    bf16* MX = (bf16*)(FWS + WS_U + 160 * MiB);
    LAS float* qs = (LAS float*)(F.lds + F.wave * 4608);
    LAS float* ps = qs + 128;
    const int lane = F.lane;
    for (int qi = mw; qi < MROWS * 8; qi += nmw) {
        const int h = qi & 7, row = qi >> 3, b = row >> 12, t = row & (SEQ - 1), bq = t >> 8;
        { const unsigned qw = *(const unsigned*)(P + (size_t)row * IN_PAD + C_MQ + h * 128 + 2 * lane);
          qs[2 * lane] = bflo(qw) * 0.08838834764831845f; qs[2 * lane + 1] = bfhi(qw) * 0.08838834764831845f; }
        LDS_WAIT();
        float gate = -INFINITY;
        if (lane < 16 && lane < bq) { const float* km = KM + ((size_t)(b * 8 + h) * 16 + lane) * 128; float a = 0.f;
            for (int d = 0; d < 128; ++d) a += qs[d] * km[d];
            gate = a; }
        unsigned selmask = 0u;
#pragma unroll
        for (int rnd = 0; rnd < 3; ++rnd) { const float m = wave_max(gate);
            if (m > -INFINITY) { const unsigned long long bal = __ballot(gate == m); const int idx = __ffsll((long long)bal) - 1; selmask |= 1u << idx; if (lane == idx) gate = -INFINITY; } }
        int blk[4];
#pragma unroll
        for (int s = 0; s < 3; ++s) { if (selmask) { blk[s] = __ffs((int)selmask) - 1; selmask &= selmask - 1u; } else blk[s] = -1; }
        blk[3] = bq;
        const float slope = exp2f(-(float)(h + 1));
        float sc[4][4]; float mx = -1e30f;
#pragma unroll
        for (int s = 0; s < 4; ++s) {
#pragma unroll
            for (int kq = 0; kq < 4; ++kq) {
                float val = -1e30f;
                if (blk[s] >= 0) { const int pos = blk[s] * 256 + kq * 64 + lane;
                    const bf16* kp = P + (size_t)(b * SEQ + pos) * IN_PAD + C_MK + h * 128; float a = 0.f;
#pragma unroll 4
                    for (int d8 = 0; d8 < 16; ++d8) { const v4u kw = *(const v4u*)(kp + d8 * 8); const f32x4 qa = *(const LAS f32x4*)(qs + d8 * 8), qb = *(const LAS f32x4*)(qs + d8 * 8 + 4);
                        a += bflo(kw.x) * qa.x + bfhi(kw.x) * qa.y + bflo(kw.y) * qa.z + bfhi(kw.y) * qa.w + bflo(kw.z) * qb.x + bfhi(kw.z) * qb.y + bflo(kw.w) * qb.z + bfhi(kw.w) * qb.w; }
                    if (pos <= t) val = a - slope * (float)(t - pos); }
                sc[s][kq] = val; mx = fmaxf(mx, val); } }
        mx = wave_max(mx);
        float lsum = 0.f;
#pragma unroll
        for (int s = 0; s < 4; ++s)
#pragma unroll
            for (int kq = 0; kq < 4; ++kq) { const float p = __expf(sc[s][kq] - mx); lsum += p; ps[s * 256 + kq * 64 + lane] = p; }
        lsum = wave_sum(lsum);
        LDS_WAIT();
        float o0 = 0.f, o1 = 0.f;
#pragma unroll
        for (int s = 0; s < 4; ++s) if (blk[s] >= 0) { const int nk = (s == 3) ? (t - bq * 256 + 1) : 256;
            const bf16* vp = P + (size_t)(b * SEQ + blk[s] * 256) * IN_PAD + C_MV + h * 128 + 2 * lane;
#pragma unroll 4
            for (int key = 0; key < nk; ++key) { const float p = ps[s * 256 + key]; const unsigned vw = *(const unsigned*)(vp + (size_t)key * IN_PAD); o0 += p * bflo(vw); o1 += p * bfhi(vw); } }
        const float inv = 1.0f / lsum;
        *(unsigned*)(MX + (size_t)row * 1024 + h * 128 + 2 * lane) = pk2(o0 * inv, o1 * inv);
        LDS_WAIT();
    }
}

constexpr int MOBA_LDS_KM = moba::LDS_BYTES, MOBA_LDS_SEL = MOBA_LDS_KM + 8192;
__device__ __forceinline__ void moba_item(Frame& F, int bh, int qbA, int qbB) {
    const int b = bh >> 3, h = bh & 7;
    const bf16* P = (const bf16*)(FWS + WS_PROJ);
    LAS float* km = (LAS float*)(F.lds + MOBA_LDS_KM);
    LAS unsigned* sel = (LAS unsigned*)(F.lds + MOBA_LDS_SEL);
    const float* KM = (const float*)(FWS + WS_KMEAN) + (size_t)bh * 16 * 128;
    for (int i = F.tid; i < 2048; i += NTHR) km[i] = KM[i];
    __syncthreads();
    {   const int qb = (F.tid < 256) ? qbA : qbB, r = F.tid & 255;
        const bf16* qp = P + (size_t)(b * SEQ + qb * 256 + r) * IN_PAD + C_MQ + h * 128;
        float g[16];
#pragma unroll
        for (int n = 0; n < 16; ++n) g[n] = 0.f;
        for (int d8 = 0; d8 < 16; ++d8) { const v4u qw = *(const v4u*)(qp + d8 * 8);
            const float q0 = bflo(qw.x), q1 = bfhi(qw.x), q2 = bflo(qw.y), q3 = bfhi(qw.y), q4 = bflo(qw.z), q5 = bfhi(qw.z), q6 = bflo(qw.w), q7 = bfhi(qw.w);
#pragma unroll
            for (int n = 0; n < 16; ++n) { const f32x4 ka = *(const LAS f32x4*)(km + n * 128 + d8 * 8), kb = *(const LAS f32x4*)(km + n * 128 + d8 * 8 + 4);
                g[n] += (q0 * ka.x + q1 * ka.y) + (q2 * ka.z + q3 * ka.w) + (q4 * kb.x + q5 * kb.y) + (q6 * kb.z + q7 * kb.w); } }
        unsigned m = 0u;
#pragma unroll
        for (int rnd = 0; rnd < 3; ++rnd) { float best = -INFINITY; int bi = -1;
#pragma unroll
            for (int n = 0; n < 16; ++n) if (n < qb && !((m >> n) & 1u) && g[n] > best) { best = g[n]; bi = n; }
            if (bi >= 0) m |= 1u << bi; }
        sel[F.tid] = m; }
    __syncthreads();
    typedef moba::BlockRef<moba::bf16, moba::bf16> Ref;
    const float slopeR = exp2f(-(float)(h + 1)) * 11.313708498984761f;
    bf16* MX = (bf16*)(FWS + WS_MIXED);
    Ref A, B2;
    A.Q = P + (size_t)(b * SEQ + qbA * 256) * IN_PAD + C_MQ + h * 128; A.K = P + (size_t)(b * SEQ) * IN_PAD + C_MK + h * 128; A.V = P + (size_t)(b * SEQ) * IN_PAD + C_MV + h * 128;
    A.O = MX + (size_t)(b * SEQ + qbA * 256) * DM + 1024 + h * 128; A.P0 = qbA * 256; A.sel = sel; A.slopeR = slopeR;
    B2 = A; B2.Q = P + (size_t)(b * SEQ + qbB * 256) * IN_PAD + C_MQ + h * 128; B2.O = MX + (size_t)(b * SEQ + qbB * 256) * DM + 1024 + h * 128; B2.P0 = qbB * 256; B2.sel = sel + 256;
    moba::Seam<moba::bf16> S;
    moba::lchar* ldsg = (moba::lchar*)F.lds;
    moba::causal_swa_prime<moba::bf16, moba::bf16>(A, 1 << 30, ldsg, S, F.wave);
    Ref cur = A;
    for (int pass = 0; pass < MOBA_NP; ++pass) {
        const bool nb_ = ((pass + 1) & 1) != 0;
        Ref nxt = A; if (nb_ || pass + 1 >= MOBA_NP) nxt = B2;
        moba::causal_swa_block<moba::bf16, moba::bf16>(cur, nxt, SEQ, 1 << 30, ldsg, S, F.wave);
        cur = nxt;
    }
}
constexpr int RC_UNITS = 32, RC_NCH = SEQ / 16, RC_REC = 16384;
constexpr int RC_AR = 0, RC_BK = 4096, RC_VP = 8192, RC_U0 = 10240, RC_Y0 = 12288, RC_D = 14336;
typedef short bf16x8 __attribute__((ext_vector_type(8)));
typedef float f32x16 __attribute__((ext_vector_type(16)));
typedef float f32x2t __attribute__((ext_vector_type(2))); typedef __bf16 bf16x2t __attribute__((ext_vector_type(2)));
__device__ __forceinline__ unsigned cvtpk_c(float lo, float hi) { f32x2t v = {lo, hi}; bf16x2t b = __builtin_convertvector(v, bf16x2t); return __builtin_bit_cast(unsigned, b); }
__device__ __forceinline__ unsigned short cvt1_c(float x) { return (unsigned short)(cvtpk_c(x, 0.f) & 0xffffu); }

constexpr int RC_WLDS = 14464, RC_CODES_OFF = 8 * RC_WLDS  , RC_CSTRIDE = 456;
#define RC_ST(off, w) (*(v4u*)(FWS + WS_REC + (size_t)roff + (unsigned)(off)) = (w))
#define RC_ST_D(Dv) do { const int di_ = __builtin_bit_cast(int, (Dv)); v4u dw_; dw_.x = (unsigned)__builtin_amdgcn_update_dpp(0, di_, 0x00, 0xF, 0xF, true); dw_.y = (unsigned)__builtin_amdgcn_update_dpp(0, di_, 0x55, 0xF, 0xF, true); \
    dw_.z = (unsigned)__builtin_amdgcn_update_dpp(0, di_, 0xAA, 0xF, 0xF, true); dw_.w = (unsigned)__builtin_amdgcn_update_dpp(0, di_, 0xFF, 0xF, 0xF, true); if ((x & 3) == 0) RC_ST(RC_D + x * 4, dw_); } while (0)
__device__ __forceinline__ void rc_core(Frame& F, LAS unsigned char* wlds, const float (&At)[16], const float (&Bt)[16], const float (&Kt)[16], const float (&Rt)[16], const float (&vv)[16], const float D, unsigned roff) {
    { unsigned wb_ = (unsigned)(uintptr_t)wlds; asm volatile("" : "+v"(wb_)); wlds = (LAS unsigned char*)(uintptr_t)wb_; }
    LAS bf16* XA = (LAS bf16*)wlds; LAS bf16* XB = (LAS bf16*)(wlds + 4608); LAS float* TT = (LAS float*)(wlds + 9216 + 4224);
    int x_ = F.lane; asm volatile("" : "+v"(x_));
    const int x = x_, r32 = x & 31, h2 = x >> 5, tl = x & 15;
#pragma unroll
    for (int t = 0; t < 16; ++t) { XA[t * 72 + x] = cvt1_c(Bt[t]); XA[(16 + t) * 72 + x] = cvt1_c(Kt[t]); XB[t * 72 + x] = cvt1_c(At[t]); XB[(16 + t) * 72 + x] = cvt1_c(Rt[t]); }
#pragma unroll
    for (int q = 0; q < 4; ++q) { v4u w; w.x = cvtpk_c(Bt[4 * q] * D, Bt[4 * q + 1] * D); w.y = cvtpk_c(Bt[4 * q + 2] * D, Bt[4 * q + 3] * D);
        w.z = cvtpk_c(Kt[4 * q] * D, Kt[4 * q + 1] * D); w.w = cvtpk_c(Kt[4 * q + 2] * D, Kt[4 * q + 3] * D); RC_ST(RC_BK + x * 64 + q * 16, w); }
#pragma unroll
    for (int q = 0; q < 2; ++q) { v4u w;
        w.x = cvtpk_c(vv[8 * q], vv[8 * q + 1]); w.y = cvtpk_c(vv[8 * q + 2], vv[8 * q + 3]); w.z = cvtpk_c(vv[8 * q + 4], vv[8 * q + 5]); w.w = cvtpk_c(vv[8 * q + 6], vv[8 * q + 7]); RC_ST(RC_VP + x * 32 + q * 16, w);
    }
    RC_ST_D(D);
    f32x16 G;
#pragma unroll
    for (int r = 0; r < 16; ++r) G[r] = 0.f;
#pragma unroll
    for (int ks = 0; ks < 4; ++ks) { const bf16x8 a = *(const LAS bf16x8*)(XA + r32 * 72 + ks * 16 + h2 * 8), bq = *(const LAS bf16x8*)(XB + r32 * 72 + ks * 16 + h2 * 8);
        G = __builtin_amdgcn_mfma_f32_32x32x16_bf16(a, bq, G, 0, 0, 0); }
    LAS float* GA = (LAS float*)wlds; LAS float* GT = (LAS float*)(wlds + 4608);
#pragma unroll
    for (int r = 0; r < 16; ++r) GA[((r & 3) + 8 * (r >> 2) + 4 * h2) * 36 + r32] = G[r];
#pragma unroll
    for (int g4 = 0; g4 < 4; ++g4) *(LAS f32x4*)(GT + r32 * 36 + 8 * g4 + 4 * h2) = (f32x4){G[4 * g4], G[4 * g4 + 1], G[4 * g4 + 2], G[4 * g4 + 3]};
#define RC_LD16(dst, p, n4) do { _Pragma("unroll") for (int i4_ = 0; i4_ < (n4); ++i4_) { const f32x4 v4_ = *(const LAS f32x4*)((p) + 4 * i4_); dst[4 * i4_] = v4_.x; dst[4 * i4_ + 1] = v4_.y; dst[4 * i4_ + 2] = v4_.z; dst[4 * i4_ + 3] = v4_.w; } } while (0)
    float Tc[16];
    { f32x2 Tp[8];
#pragma unroll
    for (int j = 0; j < 8; ++j) { Tp[j].x = (2 * j == tl) ? 1.0f : 0.0f; Tp[j].y = (2 * j + 1 == tl) ? 1.0f : 0.0f; }
#pragma unroll
    for (int s = 14; s >= 0; --s) { f32x4 nr4[4]; f32x2 a2 = {0.f, 0.f}; float a1 = 0.f;
#pragma unroll
        for (int i4 = (s + 1) / 4; i4 < 4; ++i4) nr4[i4] = *(const LAS f32x4*)(GA + s * 36 + 4 * i4);
        if ((s + 1) & 1) { const int m = s + 1; a1 = nr4[m >> 2][m & 3] * Tp[m >> 1].y; }
#pragma unroll
        for (int m = (s + 2) & ~1; m < 16; m += 2) a2 += (f32x2){nr4[m >> 2][m & 3], nr4[m >> 2][(m & 3) + 1]} * Tp[m >> 1];
        const float acc = a1 + (a2.x + a2.y);
        if (s & 1) Tp[s >> 1].y = (s < tl) ? acc : Tp[s >> 1].y; else Tp[s >> 1].x = (s < tl) ? acc : Tp[s >> 1].x; }
#pragma unroll
    for (int j = 0; j < 8; ++j) { Tc[2 * j] = Tp[j].x; Tc[2 * j + 1] = Tp[j].y; } }
    if (x < 16) {
#pragma unroll
        for (int g4 = 0; g4 < 4; ++g4) *(LAS f32x4*)(TT + tl * 16 + 4 * g4) = (f32x4){Tc[4 * g4], Tc[4 * g4 + 1], Tc[4 * g4 + 2], Tc[4 * g4 + 3]}; }
    float PV[16];
    PV[0] = 0.f;
#pragma unroll
    for (int s = 1; s < 16; ++s) { f32x2 a2 = {0.f, 0.f}; float a1 = 0.f;
#pragma unroll
        for (int r = 0; r + 1 < s; r += 2) a2 += (f32x2){GT[s * 36 + 16 + r], GT[s * 36 + 16 + r + 1]} * (f32x2){vv[r], vv[r + 1]};
        if (s & 1) a1 = GT[s * 36 + 16 + s - 1] * vv[s - 1];
        PV[s] = a1 + (a2.x + a2.y); }
    float Ah[16], U0[16];
#pragma unroll
    for (int t = 0; t < 16; ++t) { f32x2 a2 = {0.f, 0.f};
#pragma unroll
        for (int s = 0; s <= t; ++s) { const float tv = TT[t * 16 + s]; a2 += (f32x2){tv, tv} * (f32x2){At[s], PV[s]}; }
        Ah[t] = a2.x; U0[t] = a2.y; }
    float Rh[16], Y0[16];
#pragma unroll
    for (int t = 0; t < 16; ++t) { f32x2 ry = {Rt[t], 0.f};
#pragma unroll
        for (int s = 0; s <= t; ++s) { const float m1 = GT[(16 + t) * 36 + s], m2 = GT[(16 + t) * 36 + 16 + s]; ry += (f32x2){m1, m1} * (f32x2){Ah[s], U0[s]}; ry.y += m2 * vv[s]; }
        Rh[t] = ry.x; Y0[t] = ry.y; }
#undef RC_LD16
    { const int ks = x >> 5, jj = x & 31, e = (jj >> 4) * 4 + (jj & 3), q = (jj >> 2) & 3; LAS unsigned char* pb = wlds + ks * 1024 + q * 256 + e * 2;
#pragma unroll
      for (int s = 0; s < 16; ++s) { *(LAS bf16*)(pb + s * 16) = cvt1_c(Ah[s]); *(LAS bf16*)(pb + 2048 + s * 16) = cvt1_c(Rh[s]); }
#pragma unroll
      for (int j = 0; j < 4; ++j) { const v4u w = *(const LAS v4u*)(wlds + j * 1024 + x * 16); RC_ST(RC_AR + j * 1024 + x * 16, w); } }
#pragma unroll
    for (int q = 0; q < 2; ++q) { v4u w;
        w.x = cvtpk_c(U0[8 * q], U0[8 * q + 1]); w.y = cvtpk_c(U0[8 * q + 2], U0[8 * q + 3]); w.z = cvtpk_c(U0[8 * q + 4], U0[8 * q + 5]); w.w = cvtpk_c(U0[8 * q + 6], U0[8 * q + 7]); RC_ST(RC_U0 + x * 32 + q * 16, w);
        w.x = cvtpk_c(Y0[8 * q], Y0[8 * q + 1]); w.y = cvtpk_c(Y0[8 * q + 2], Y0[8 * q + 3]); w.z = cvtpk_c(Y0[8 * q + 4], Y0[8 * q + 5]); w.w = cvtpk_c(Y0[8 * q + 6], Y0[8 * q + 7]); RC_ST(RC_Y0 + x * 32 + q * 16, w); }
    LDS_WAIT();
}
__device__ __forceinline__ void rc_pass1_rwkv(Frame& F, int wid, int nw, int c0, int nc) {
    LAS unsigned char* wlds = F.lds + F.wave * RC_WLDS;
    const int x = F.lane;
    const float* RW = (const float*)(FWS + WS_RW);
    const bf16* RH = (const bf16*)(FWS + WS_RW + 32 * MiB);
    for (int it2 = wid; it2 < 16 * nc; it2 += nw) {
        const int u = it2 / nc, c = c0 + it2 % nc, it = u * RC_NCH + c, b = u >> 3, h = u & 7; const size_t o0 = ((size_t)(b * SEQ + c * 16)) * 512 + h * 64 + x;
        float At[16], Bt[16], Kt[16], Rt[16], vv[16]; float W = 1.0f;
#pragma unroll
        for (int t = 0; t < 16; ++t) { const size_t o = o0 + (size_t)t * 512;
            const float wv = RW[o], ka = bf2f(RH[3 * RWA + o]), bb = bf2f(RH[4 * RWA + o]), kk = bf2f(RH[1 * RWA + o]), rr = bf2f(RH[0 * RWA + o]); vv[t] = bf2f(RH[2 * RWA + o]);
            At[t] = -ka * W; W *= wv; const float iw = __builtin_amdgcn_rcpf(W); Bt[t] = bb * iw; Kt[t] = kk * iw; Rt[t] = rr * W; }
        rc_core(F, wlds, At, Bt, Kt, Rt, vv, W, (unsigned)it * RC_REC);
    }
}
__device__ __forceinline__ void rc_core_ret(Frame& F, LAS unsigned char* wlds, const float (&Kt)[16], const float (&Rt)[16], const float (&vv)[16], const float D, unsigned roff) {
    { unsigned wb_ = (unsigned)(uintptr_t)wlds; asm volatile("" : "+v"(wb_)); wlds = (LAS unsigned char*)(uintptr_t)wb_; }
    LAS bf16* XK = (LAS bf16*)wlds; LAS bf16* XR = (LAS bf16*)(wlds + 2304); LAS float* GM = (LAS float*)(wlds + 4608);
    int x_ = F.lane; asm volatile("" : "+v"(x_));
    const int x = x_, fr = x & 15, q = x >> 4;
#pragma unroll
    for (int t = 0; t < 16; ++t) { XK[t * 72 + x] = cvt1_c(Kt[t]); XR[t * 72 + x] = cvt1_c(Rt[t]); }
#pragma unroll
    for (int qq = 0; qq < 4; ++qq) { v4u w; w.x = 0u; w.y = 0u;
        w.z = cvtpk_c(Kt[4 * qq] * D, Kt[4 * qq + 1] * D); w.w = cvtpk_c(Kt[4 * qq + 2] * D, Kt[4 * qq + 3] * D); RC_ST(RC_BK + x * 64 + qq * 16, w); }
#pragma unroll
    for (int qq = 0; qq < 2; ++qq) { v4u w;
        w.x = cvtpk_c(vv[8 * qq], vv[8 * qq + 1]); w.y = cvtpk_c(vv[8 * qq + 2], vv[8 * qq + 3]); w.z = cvtpk_c(vv[8 * qq + 4], vv[8 * qq + 5]); w.w = cvtpk_c(vv[8 * qq + 6], vv[8 * qq + 7]); RC_ST(RC_VP + x * 32 + qq * 16, w);
        RC_ST(RC_U0 + x * 32 + qq * 16, ((v4u){0u, 0u, 0u, 0u})); }
    RC_ST_D(D);
    f32x4 G = {0.f, 0.f, 0.f, 0.f};
#pragma unroll
    for (int ks = 0; ks < 2; ++ks) { const bf16x8 a = *(const LAS bf16x8*)(XK + fr * 72 + ks * 32 + q * 8), bq = *(const LAS bf16x8*)(XR + fr * 72 + ks * 32 + q * 8);
        G = __builtin_amdgcn_mfma_f32_16x16x32_bf16(a, bq, G, 0, 0, 0); }
#pragma unroll
    for (int rg = 0; rg < 4; ++rg) GM[(4 * q + rg) * 17 + fr] = G[rg];
    { const int ks = x >> 5, jj = x & 31, e = (jj >> 4) * 4 + (jj & 3), qv = (jj >> 2) & 3; LAS unsigned char* pb = wlds + 2048 + ks * 1024 + qv * 256 + e * 2;
#pragma unroll
      for (int s = 0; s < 16; ++s) *(LAS bf16*)(pb + s * 16) = cvt1_c(Rt[s]);
#pragma unroll
      for (int j = 0; j < 2; ++j) { RC_ST(RC_AR + j * 1024 + x * 16, ((v4u){0u, 0u, 0u, 0u})); const v4u w = *(const LAS v4u*)(wlds + 2048 + j * 1024 + x * 16); RC_ST(RC_AR + 2048 + j * 1024 + x * 16, w); } }
    float Y0[16];
#pragma unroll
    for (int t = 0; t < 16; ++t) { float yy = 0.f;
#pragma unroll
        for (int s = 0; s <= t; ++s) yy += GM[s * 17 + t] * vv[s];
        Y0[t] = yy; }
#pragma unroll
    for (int qq = 0; qq < 2; ++qq) { v4u w;
        w.x = cvtpk_c(Y0[8 * qq], Y0[8 * qq + 1]); w.y = cvtpk_c(Y0[8 * qq + 2], Y0[8 * qq + 3]); w.z = cvtpk_c(Y0[8 * qq + 4], Y0[8 * qq + 5]); w.w = cvtpk_c(Y0[8 * qq + 6], Y0[8 * qq + 7]); RC_ST(RC_Y0 + x * 32 + qq * 16, w); }
    LDS_WAIT();
}
__device__ __forceinline__ void rc_pass1_ret(Frame& F, int wid, int nw, int c0, int nc) {
    LAS unsigned char* wlds = F.lds + F.wave * RC_WLDS;
    const int x = F.lane;
    const bf16* P = (const bf16*)(FWS + WS_PROJ);
    for (int it2 = wid; it2 < 16 * nc; it2 += nw) {
        const int ru = it2 / nc, c = c0 + it2 % nc, it = ru * RC_NCH + c, b = ru >> 3, h = (ru >> 1) & 3, half = ru & 1; const float gamma = 1.0f - exp2f(-5.0f - (float)h);
        float Kt[16], Rt[16], vv[16]; float W = 1.0f;
        const bf16* p0 = P + (size_t)(b * SEQ + c * 16) * IN_PAD;
#pragma unroll
        for (int t = 0; t < 16; ++t) { const bf16* p = p0 + (size_t)t * IN_PAD;
            const float rr = bf2f(p[C_RQ + h * 64 + x]), kk = bf2f(p[C_RK + h * 64 + x]) * 0.125f; vv[t] = bf2f(p[C_RV + h * 128 + half * 64 + x]);
            W *= gamma; const float iw = __builtin_amdgcn_rcpf(W); Kt[t] = kk * iw; Rt[t] = rr * W; }
        rc_core_ret(F, wlds, Kt, Rt, vv, W, (unsigned)(16 * RC_NCH + it) * RC_REC);
    }
}
__device__ __forceinline__ void rwkv_prep_mfma(Frame& F, int l, int first, int stride) {
    LAS unsigned char* wlds = F.lds + F.wave * RC_WLDS;
    LAS bf16* CODES = (LAS bf16*)(F.lds + RC_CODES_OFF);
    LAS float* ST = (LAS float*)wlds;
    const bf16* P = (const bf16*)(FWS + WS_PROJ);
    const float* mu = F.in[F.zz + 4] + l * RWC;
    const bf16* WT = (const bf16*)(FWS + WS_RWW + (size_t)l * 448 * 512 * 2);
    float* RW = (float*)(FWS + WS_RW);
    const int x = F.lane, h = F.wave, ch = h * 64 + x, fr = x & 15, q = x >> 4;
    for (int item = first; item < NB * RC_NCH; item += stride) {
        const int b = item >> 8, c = item & 255; const size_t row0 = (size_t)b * SEQ + c * 16; const int t0 = c * 16;
        const bf16* prc = P + row0 * IN_PAD + C_RW + ch;
        unsigned short nr_[4], nk_[4], nv_[4]; float pvr = 0.f, pvk = 0.f, pvv = 0.f;
        if (t0 > 0) { pvr = bf2f(prc[-IN_PAD]); pvk = bf2f(prc[512 - IN_PAD]); pvv = bf2f(prc[1024 - IN_PAD]); }
#pragma unroll
        for (int tt = 0; tt < 4; ++tt) { nr_[tt] = prc[(size_t)tt * IN_PAD]; nk_[tt] = prc[(size_t)tt * IN_PAD + 512]; nv_[tt] = prc[(size_t)tt * IN_PAD + 1024]; }
        const float mur = mu[ch], muk = mu[512 + ch], muv = mu[1024 + ch];
        const float w0c = F.in[F.zz + 5][l * 512 + ch], a0c = F.in[F.zz + 7][l * 512 + ch], kkc = F.in[F.zz + 10][l * 512 + ch], kac = F.in[F.zz + 11][l * 512 + ch], rkc = F.in[F.zz + 12][l * 512 + ch];
#pragma unroll 7
        for (int idx = F.tid; idx < 16 * 448; idx += NTHR) { const int tk = idx / 448, cc = idx - tk * 448;
            float val = lerp_bf(P, row0 + tk, C_RW + 1536 + cc, (t0 + tk) > 0, mu[1536 + cc]);
            if (cc < 96) val = 1.0f - 2.0f * __builtin_amdgcn_rcpf(1.0f + __expf(2.0f * val));
            else if (cc >= 192) val = sigmoidf_(val);
            CODES[tk * RC_CSTRIDE + cc] = cvt1_c(val); }
        __syncthreads();
        f32x4 accW[4], accA[4], accG[4];
#pragma unroll
        for (int ct = 0; ct < 4; ++ct) { accW[ct] = (f32x4){0.f, 0.f, 0.f, 0.f}; accA[ct] = accW[ct]; accG[ct] = accW[ct]; }
        { bf16x8 bw[3][4];
#pragma unroll
          for (int ks = 0; ks < 3; ++ks)
#pragma unroll
              for (int ct = 0; ct < 4; ++ct) bw[ks][ct] = *(const bf16x8*)(WT + (size_t)(h * 64 + ct * 16 + fr) * 96 + ks * 32 + q * 8);
#pragma unroll
          for (int ks = 0; ks < 3; ++ks) { const bf16x8 aw = *(const LAS bf16x8*)(CODES + fr * RC_CSTRIDE + ks * 32 + q * 8);
#pragma unroll
              for (int ct = 0; ct < 4; ++ct) accW[ct] = __builtin_amdgcn_mfma_f32_16x16x32_bf16(aw, bw[ks][ct], accW[ct], 0, 0, 0); } }
        asm volatile("" ::: "memory");
        { bf16x8 ba[3][4];
#pragma unroll
          for (int ks = 0; ks < 3; ++ks)
#pragma unroll
              for (int ct = 0; ct < 4; ++ct) ba[ks][ct] = *(const bf16x8*)(WT + 512 * 96 + (size_t)(h * 64 + ct * 16 + fr) * 96 + ks * 32 + q * 8);
#pragma unroll
          for (int ks = 0; ks < 3; ++ks) { const bf16x8 aa = *(const LAS bf16x8*)(CODES + fr * RC_CSTRIDE + 96 + ks * 32 + q * 8);
#pragma unroll
              for (int ct = 0; ct < 4; ++ct) accA[ct] = __builtin_amdgcn_mfma_f32_16x16x32_bf16(aa, ba[ks][ct], accA[ct], 0, 0, 0); } }
        asm volatile("" ::: "memory");
#pragma unroll
        for (int hf = 0; hf < 2; ++hf) { bf16x8 bg[4][4];
#pragma unroll
            for (int k4 = 0; k4 < 4; ++k4)
#pragma unroll
                for (int ct = 0; ct < 4; ++ct) bg[k4][ct] = *(const bf16x8*)(WT + 2 * 512 * 96 + (size_t)(h * 64 + ct * 16 + fr) * 256 + (hf * 4 + k4) * 32 + q * 8);
#pragma unroll
            for (int k4 = 0; k4 < 4; ++k4) { const bf16x8 ag = *(const LAS bf16x8*)(CODES + fr * RC_CSTRIDE + 192 + (hf * 4 + k4) * 32 + q * 8);
#pragma unroll
                for (int ct = 0; ct < 4; ++ct) accG[ct] = __builtin_amdgcn_mfma_f32_16x16x32_bf16(ag, bg[k4][ct], accG[ct], 0, 0, 0); }
            asm volatile("" ::: "memory"); }
#pragma unroll
        for (int ct = 0; ct < 4; ++ct)
#pragma unroll
            for (int rg = 0; rg < 4; ++rg) { const int o = (4 * q + rg) * 64 + ct * 16 + fr; ST[o] = accW[ct][rg]; ST[1024 + o] = accA[ct][rg]; ST[2048 + o] = accG[ct][rg]; }
        float* gpw = RW + row0 * 512 + ch;
        bf16* gp = (bf16*)(FWS + WS_RW + 32 * MiB) + row0 * 512 + ch;
        for (int g = 0; g < 4; ++g) {
            unsigned short cr_[4], ck_[4], cv_[4];
#pragma unroll
            for (int tt = 0; tt < 4; ++tt) { cr_[tt] = nr_[tt]; ck_[tt] = nk_[tt]; cv_[tt] = nv_[tt]; }
            if (g < 3) {
#pragma unroll
                for (int tt = 0; tt < 4; ++tt) { const size_t ro = (size_t)(4 * g + 4 + tt) * IN_PAD; nr_[tt] = prc[ro]; nk_[tt] = prc[ro + 512]; nv_[tt] = prc[ro + 1024]; } }
#pragma unroll
          for (int tt = 0; tt < 4; ++tt) { const int t = 4 * g + tt;
            const float cr = bf2f(cr_[tt]), ck = bf2f(ck_[tt]), cv = bf2f(cv_[tt]);
            const float rr = cr + (pvr - cr) * mur, kk0 = ck + (pvk - ck) * muk, vv = cv + (pvv - cv) * muv;
            pvr = cr; pvk = ck; pvv = cv;
            const float z = -(w0c + ST[t * 64 + x]);
            const float sp = fmaxf(z, 0.f) + __logf(1.0f + __expf(-fabsf(z)));
            const float decay = __expf(-__expf(-sp - 0.5f));
            const float a = sigmoidf_(a0c + ST[1024 + t * 64 + x]);
            const float gg = ST[2048 + t * 64 + x];
            const float kkv = kk0 * kkc;
            const float nrm = __builtin_amdgcn_sqrtf(wave_sum(kkv * kkv));
            const float kap = kkv * __builtin_amdgcn_rcpf(fmaxf(nrm, 1e-12f));
            const float kp = kk0 * (1.0f + (a - 1.0f) * kac);
            const float bsum = wave_sum(rr * kp * rkc);
            gpw[0] = decay; gpw += 512;
            gp[0 * RWA] = cvt1_c(rr); gp[1 * RWA] = cvt1_c(kp); gp[2 * RWA] = cvt1_c(vv); gp[3 * RWA] = cvt1_c(kap); gp[4 * RWA] = cvt1_c(kap * a); gp[5 * RWA] = cvt1_c(gg); gp[6 * RWA] = cvt1_c(bsum * vv); gp += 512; } }
        LDS_WAIT();
        __syncthreads();
    }
}
constexpr int RC_SLOT = 15360, RC_YST = 8 * RC_SLOT  ;
#define RC_ENSURE(c) do { while ((c) >= ready_) { const unsigned* gp_ = grp + 32 * ((ready_ - ready0) / 48); unsigned sp_ = 0u; \
        while ((unsigned)__builtin_amdgcn_readfirstlane(__hip_atomic_load(gp_, __ATOMIC_RELAXED, __HIP_MEMORY_SCOPE_AGENT)) < nprod) { __builtin_amdgcn_s_sleep(2); if (++sp_ > (1u << 24)) break; } \
        __builtin_amdgcn_fence(__ATOMIC_ACQUIRE, "agent"); asm volatile("s_waitcnt vmcnt(0)" ::: "memory"); ready_ += 48; } } while (0)
__device__ __forceinline__ void rc_pass2(Frame& F, int u, int cb, int ce, bool first, bool last, const unsigned* grp, unsigned nprod, int ready0) {
    int ready_ = ready0;
    const unsigned char* rec = FWS + WS_REC + (size_t)u * RC_NCH * RC_REC;
    const int lane = F.lane;
    const int NIT = (ce - cb) / 2;
    bf16* Yg;
    if (u < 16) Yg = (bf16*)(FWS + WS_Y) + (size_t)((u >> 3) * SEQ) * 512 + (u & 7) * 64;
    else { const int ru = u - 16; Yg = (bf16*)(FWS + WS_RETO) + (size_t)((ru >> 3) * SEQ) * 512 + ((ru >> 1) & 3) * 128 + (ru & 1) * 64; }
#define RC_BARRIER() __builtin_amdgcn_s_barrier()
    if (F.wave == 7) {
        unsigned t0_ = 0u, t1_ = 0u, t2_ = 0u, t3_ = 0u;
        for (int cq = cb; cq < cb + 24 && cq < ce; cq += 2) { const unsigned char* pa = rec + (size_t)cq * RC_REC + lane * 128; const unsigned char* pb = pa + 8192; const unsigned char* pc = pa + RC_REC; const unsigned char* pd = pb + RC_REC;
            asm volatile("global_load_dword %0, %4, off\n\tglobal_load_dword %1, %5, off\n\tglobal_load_dword %2, %6, off\n\tglobal_load_dword %3, %7, off" : "+v"(t0_), "+v"(t1_), "+v"(t2_), "+v"(t3_) : "v"(pa), "v"(pb), "v"(pc), "v"(pd) : "memory"); }
        RC_BARRIER();
        for (int i = 0; i < NIT; ++i) {
            const int cp = cb + 2 * i + 24;
            if (cp < ce) { RC_ENSURE(cp + 1); const unsigned char* pa = rec + (size_t)cp * RC_REC + lane * 128; const unsigned char* pb = pa + 8192; const unsigned char* pc = pa + RC_REC; const unsigned char* pd = pb + RC_REC;
                asm volatile("global_load_dword %0, %4, off\n\tglobal_load_dword %1, %5, off\n\tglobal_load_dword %2, %6, off\n\tglobal_load_dword %3, %7, off" : "+v"(t0_), "+v"(t1_), "+v"(t2_), "+v"(t3_) : "v"(pa), "v"(pb), "v"(pc), "v"(pd) : "memory"); }
            if (i > 0) {
                const LAS unsigned char* yb = F.lds + RC_YST + ((i - 1) & 1) * 4096;
#pragma unroll
                for (int j = 0; j < 4; ++j) { const v4u w = *(const LAS v4u*)(yb + j * 1024 + lane * 16);
                    *(v4u*)(Yg + (size_t)((cb + 2 * i - 2) * 16 + j * 8 + (lane >> 3)) * 512 + (lane & 7) * 8) = w; } }
            RC_BARRIER();
        }
        { const LAS unsigned char* yb = F.lds + RC_YST + ((NIT - 1) & 1) * 4096;
#pragma unroll
          for (int j = 0; j < 4; ++j) { const v4u w = *(const LAS v4u*)(yb + j * 1024 + lane * 16);
              *(v4u*)(Yg + (size_t)((cb + 2 * NIT - 2) * 16 + j * 8 + (lane >> 3)) * 512 + (lane & 7) * 8) = w; } }
        asm volatile("s_waitcnt vmcnt(0)" ::: "memory");
        asm volatile("" :: "v"(t0_), "v"(t1_), "v"(t2_), "v"(t3_));
    } else if (F.wave >= 4) {
        const int lw = F.wave - 4;
        const int p0_ = lw == 0 ? 8 : (lw == 1 ? 11 : 13), np_ = lw == 0 ? 3 : 2;
#define RC_ISSUE(c) do { _Pragma("unroll") for (int i_ = 0; i_ < 3; ++i_) { if (i_ < np_) \
            __builtin_amdgcn_global_load_lds((const unsigned*)(rec + (size_t)(c) * RC_REC + (p0_ + i_) * 1024 + lane * 16), (LAS unsigned*)(F.lds + ((c) & 7) * RC_SLOT + (p0_ + i_) * 1024), 16, 0, 0); } } while (0)
#define RC_WAIT4() do { if (lw == 0) asm volatile("s_waitcnt vmcnt(12)" ::: "memory"); else asm volatile("s_waitcnt vmcnt(8)" ::: "memory"); } while (0)
        for (int c = cb; c < cb + 6; ++c) RC_ISSUE(c);
        RC_WAIT4();
        RC_BARRIER();
        for (int i = 0; i < NIT; ++i) {
            if (cb + 2 * i + 7 < ce) { RC_ENSURE(cb + 2 * i + 7); RC_ISSUE(cb + 2 * i + 6); RC_ISSUE(cb + 2 * i + 7); RC_WAIT4(); }
            else asm volatile("s_waitcnt vmcnt(0)" ::: "memory");
            RC_BARRIER();
        }
#undef RC_ISSUE
#undef RC_WAIT4
    } else {
        const int ib = F.wave, fr = lane & 15, q = lane >> 4;
#define RC_ISSUE1(c) do { __builtin_amdgcn_global_load_lds((const unsigned*)(rec + (size_t)(c) * RC_REC + (2 * ib) * 1024 + lane * 16), (LAS unsigned*)(F.lds + ((c) & 7) * RC_SLOT + (2 * ib) * 1024), 16, 0, 0); \
        __builtin_amdgcn_global_load_lds((const unsigned*)(rec + (size_t)(c) * RC_REC + (2 * ib + 1) * 1024 + lane * 16), (LAS unsigned*)(F.lds + ((c) & 7) * RC_SLOT + (2 * ib + 1) * 1024), 16, 0, 0); } while (0)
        f32x4* sv = (f32x4*)(FWS + WS_CTL + 262144) + (size_t)((u * 4 + ib) * 4 + 0) * 64 + lane;
        f32x4 sT[4];
#pragma unroll
        for (int jb = 0; jb < 4; ++jb) sT[jb] = first ? (f32x4){0.f, 0.f, 0.f, 0.f} : sv[jb * 64];
        asm volatile("s_waitcnt vmcnt(0)" ::: "memory");
        for (int c = cb; c < cb + 6; ++c) RC_ISSUE1(c);
        asm volatile("s_waitcnt vmcnt(8)" ::: "memory");
        RC_BARRIER();
        for (int i = 0; i < NIT; ++i) {
            bf16x8 aU0[2], aU1[2], aY0[2], aY1[2], bk[2][4]; f32x4 dd[2][4]; v2u vp[2], u0[2], y0[2];
#pragma unroll
            for (int h = 0; h < 2; ++h) { const LAS unsigned char* slot = F.lds + ((cb + 2 * i + h) & 7) * RC_SLOT;
                aU0[h] = *(const LAS bf16x8*)(slot + RC_AR + q * 256 + fr * 16); aU1[h] = *(const LAS bf16x8*)(slot + RC_AR + 1024 + q * 256 + fr * 16);
                aY0[h] = *(const LAS bf16x8*)(slot + RC_AR + 2048 + q * 256 + fr * 16); aY1[h] = *(const LAS bf16x8*)(slot + RC_AR + 3072 + q * 256 + fr * 16);
                u0[h] = *(const LAS v2u*)(slot + RC_U0 + (16 * ib + fr) * 32 + q * 8); vp[h] = *(const LAS v2u*)(slot + RC_VP + (16 * ib + fr) * 32 + q * 8);
#pragma unroll
                for (int jb = 0; jb < 4; ++jb) { bk[h][jb] = *(const LAS bf16x8*)(slot + RC_BK + (16 * jb + fr) * 64 + q * 16); dd[h][jb] = *(const LAS f32x4*)(slot + RC_D + (16 * jb + 4 * q) * 4); }
                y0[h] = *(const LAS v2u*)(slot + RC_Y0 + (16 * ib + fr) * 32 + q * 8); }
            LAS bf16* yst = (LAS bf16*)(F.lds + RC_YST + (i & 1) * 4096);
#pragma unroll
            for (int h = 0; h < 2; ++h) {
                v4u s0, s1;
                s0.x = cvtpk_c(sT[0][0], sT[0][1]); s0.y = cvtpk_c(sT[0][2], sT[0][3]); s0.z = cvtpk_c(sT[1][0], sT[1][1]); s0.w = cvtpk_c(sT[1][2], sT[1][3]);
                s1.x = cvtpk_c(sT[2][0], sT[2][1]); s1.y = cvtpk_c(sT[2][2], sT[2][3]); s1.z = cvtpk_c(sT[3][0], sT[3][1]); s1.w = cvtpk_c(sT[3][2], sT[3][3]);
                const bf16x8 sb0 = __builtin_bit_cast(bf16x8, s0), sb1 = __builtin_bit_cast(bf16x8, s1);
                f32x4 zU = (f32x4){0.f, 0.f, 0.f, 0.f}, zY = (f32x4){0.f, 0.f, 0.f, 0.f};
                zU = __builtin_amdgcn_mfma_f32_16x16x32_bf16(aU0[h], sb0, zU, 0, 0, 0); zU = __builtin_amdgcn_mfma_f32_16x16x32_bf16(aU1[h], sb1, zU, 0, 0, 0);
                const float U0_ = zU[0] + bflo(u0[h].x), U1_ = zU[1] + bfhi(u0[h].x), U2_ = zU[2] + bflo(u0[h].y), U3_ = zU[3] + bfhi(u0[h].y);
                v4u ubw; ubw.x = cvtpk_c(U0_, U1_); ubw.y = cvtpk_c(U2_, U3_); ubw.z = vp[h].x; ubw.w = vp[h].y;
                const bf16x8 ub = __builtin_bit_cast(bf16x8, ubw);
#pragma unroll
                for (int jb = 0; jb < 4; ++jb) sT[jb] = __builtin_amdgcn_mfma_f32_16x16x32_bf16(bk[h][jb], ub, sT[jb] * dd[h][jb], 0, 0, 0);
                zY = __builtin_amdgcn_mfma_f32_16x16x32_bf16(aY0[h], sb0, zY, 0, 0, 0); zY = __builtin_amdgcn_mfma_f32_16x16x32_bf16(aY1[h], sb1, zY, 0, 0, 0);
                LAS bf16* yp = yst + h * 1024 + (4 * q) * 64 + 16 * ib + fr;
                yp[0] = cvt1_c(zY[0] + bflo(y0[h].x)); yp[64] = cvt1_c(zY[1] + bfhi(y0[h].x)); yp[128] = cvt1_c(zY[2] + bflo(y0[h].y)); yp[192] = cvt1_c(zY[3] + bfhi(y0[h].y));
            }
            if (cb + 2 * i + 7 < ce) { RC_ENSURE(cb + 2 * i + 7); RC_ISSUE1(cb + 2 * i + 6); RC_ISSUE1(cb + 2 * i + 7); asm volatile("s_waitcnt vmcnt(8) lgkmcnt(0)" ::: "memory"); } else asm volatile("s_waitcnt vmcnt(0) lgkmcnt(0)" ::: "memory");
            RC_BARRIER();
        }
        if (!last) {
#pragma unroll
            for (int jb = 0; jb < 4; ++jb) sv[jb * 64] = sT[jb]; }
#undef RC_ISSUE1
    }
#undef RC_BARRIER
    asm volatile("s_waitcnt vmcnt(0) lgkmcnt(0)" ::: "memory");
    __syncthreads();
}
__device__ __forceinline__ void sub_arrive(Frame& F, unsigned* cnt) {
    asm volatile("s_waitcnt vmcnt(0)" ::: "memory");
    __syncthreads();
    if (F.tid == 0) { __builtin_amdgcn_fence(__ATOMIC_RELEASE, "agent"); asm volatile("s_waitcnt vmcnt(0)" ::: "memory"); __hip_atomic_fetch_add(cnt, 1u, __ATOMIC_RELAXED, __HIP_MEMORY_SCOPE_AGENT); }
}
__device__ __forceinline__ void xcd_publish(Frame& F, unsigned* local, unsigned nlocal, unsigned* global) {
    asm volatile("s_waitcnt vmcnt(0)" ::: "memory");
    __syncthreads();
    if (F.tid == 0) {
        const unsigned old = __hip_atomic_fetch_add(local, 1u, __ATOMIC_RELAXED, __HIP_MEMORY_SCOPE_AGENT);
        if (old + 1u == nlocal) { __builtin_amdgcn_fence(__ATOMIC_RELEASE, "agent"); asm volatile("s_waitcnt vmcnt(0)" ::: "memory"); __hip_atomic_fetch_add(global, nlocal, __ATOMIC_RELAXED, __HIP_MEMORY_SCOPE_AGENT); }
    }
}
__device__ __forceinline__ void sub_wait(Frame& F, unsigned* cnt, unsigned target) {
    if (F.tid == 0) { unsigned sp = 0u;
        while (__hip_atomic_load(cnt, __ATOMIC_RELAXED, __HIP_MEMORY_SCOPE_AGENT) < target) { __builtin_amdgcn_s_sleep(2); if (++sp > (1u << 24)) break; }
        __builtin_amdgcn_fence(__ATOMIC_ACQUIRE, "agent"); asm volatile("s_waitcnt vmcnt(0)" ::: "memory"); }
    __syncthreads();
}
__device__ __forceinline__ void sub_barrier(Frame& F, unsigned* cnt, unsigned target) {
    asm volatile("s_waitcnt vmcnt(0)" ::: "memory");
    __syncthreads();
    if (F.tid == 0) {
        __builtin_amdgcn_fence(__ATOMIC_RELEASE, "agent");
        asm volatile("s_waitcnt vmcnt(0)" ::: "memory");
        __hip_atomic_fetch_add(cnt, 1u, __ATOMIC_RELAXED, __HIP_MEMORY_SCOPE_AGENT);
        unsigned sp = 0u;
        while (__hip_atomic_load(cnt, __ATOMIC_RELAXED, __HIP_MEMORY_SCOPE_AGENT) < target) { __builtin_amdgcn_s_sleep(2); if (++sp > (1u << 24)) break; }
        __builtin_amdgcn_fence(__ATOMIC_ACQUIRE, "agent");
        asm volatile("s_waitcnt vmcnt(0)" ::: "memory");
    }
    __syncthreads();
}
__device__ __forceinline__ void mixer_post(Frame& F, int l, int gw, int NGW) {
    const bf16* P = (const bf16*)(FWS + WS_PROJ);
    const bf16* RH = (const bf16*)(FWS + WS_RW + 32 * MiB);
    const float* RW = (const float*)(FWS + WS_RW);
    const bf16* Y = (const bf16*)(FWS + WS_Y);
    const bf16* RO = (const bf16*)(FWS + WS_RETO);
    bf16* MX = (bf16*)(FWS + WS_MIXED);
    const float* ln_w = F.in[F.zz + 13] + l * 512; const float* ln_b = F.in[F.zz + 14] + l * 512;
    const int lane = F.lane;
    for (int m = gw; m < MROWS; m += NGW) {
        const size_t o = (size_t)m * 512;
        float y[8], s1[8], s2[8], bon[8], gat[8]; f32x2 ov[4]; float s3[4]; unsigned gw2[4];
#pragma unroll
        for (int h = 0; h < 8; ++h) { const int c = h * 64 + lane; y[h] = bf2f(Y[o + c]); bon[h] = bf2f(RH[6 * RWA + o + c]); gat[h] = bf2f(RH[5 * RWA + o + c]); s1[h] = y[h]; }
#pragma unroll
        for (int h = 0; h < 4; ++h) { const int c = h * 128 + 2 * lane; { const unsigned rw_ = *(const unsigned*)(RO + o + c); ov[h].x = bflo(rw_); ov[h].y = bfhi(rw_); } gw2[h] = *(const unsigned*)(P + (size_t)m * IN_PAD + C_RG + c); s3[h] = ov[h].x * ov[h].x + ov[h].y * ov[h].y; }
#pragma unroll
        for (int h = 0; h < 8; ++h) { s1[h] = dpp_add<0xB1>(s1[h]); s1[h] = dpp_add<0x4E>(s1[h]); s1[h] = dpp_add<0x141>(s1[h]); s1[h] = dpp_add<0x140>(s1[h]); }
#pragma unroll
        for (int h = 0; h < 4; ++h) { s3[h] = dpp_add<0xB1>(s3[h]); s3[h] = dpp_add<0x4E>(s3[h]); s3[h] = dpp_add<0x141>(s3[h]); s3[h] = dpp_add<0x140>(s3[h]); }
#pragma unroll
        for (int h = 0; h < 8; ++h) s1[h] = xsum32(xsum16(s1[h]));
#pragma unroll
        for (int h = 0; h < 4; ++h) s3[h] = xsum32(xsum16(s3[h]));
#pragma unroll
        for (int h = 0; h < 8; ++h) { const float d = y[h] - s1[h] * (1.0f / 64.0f); y[h] = d; s2[h] = d * d; }
#pragma unroll
        for (int h = 0; h < 8; ++h) { s2[h] = dpp_add<0xB1>(s2[h]); s2[h] = dpp_add<0x4E>(s2[h]); s2[h] = dpp_add<0x141>(s2[h]); s2[h] = dpp_add<0x140>(s2[h]); }
#pragma unroll
        for (int h = 0; h < 8; ++h) s2[h] = xsum32(xsum16(s2[h]));
#pragma unroll
        for (int h = 0; h < 8; ++h) { const int c = h * 64 + lane;
            const float yn = y[h] * __builtin_amdgcn_rsqf(s2[h] * (1.0f / 64.0f) + GN_EPS) * ln_w[c] + ln_b[c];
            MX[(size_t)m * DM + 512 + c] = (bf16)f2bf((yn + bon[h]) * gat[h]); }
#pragma unroll
        for (int h = 0; h < 4; ++h) { const int c = h * 128 + 2 * lane;
            const float rn = __builtin_amdgcn_rsqf(s3[h] * (1.0f / 128.0f) + NORM_EPS);
            const float g0 = bflo(gw2[h]), g1 = bfhi(gw2[h]);
            *(unsigned*)(MX + (size_t)m * DM + c) = pk2(ov[h].x * rn * g0 * sigmoidf_(g0), ov[h].y * rn * g1 * sigmoidf_(g1)); }
    }
}
__device__ __forceinline__ void conv_gate_phase(Frame& F, int l) {
    const bf16* U = (const bf16*)(FWS + WS_U);
    bf16* A = (bf16*)(FWS + WS_ACT);
    const float* cw = F.in[F.zz + 16] + (size_t)l * 3 * UPC; const float* cb = F.in[F.zz + 17] + (size_t)l * UPC;
    constexpr int NCG = DFF / 8, NRC = MROWS / 16;
    for (int it = F.vcu * NTHR + F.tid; it < NCG * NRC; it += F.G * NTHR) {
        const int cg = it % NCG, rc = it / NCG, c0 = cg * 8, row0 = rc * 16, t0 = row0 & (SEQ - 1);
        float wv[3][8], wg[3][8], bv[8], bg[8];
#pragma unroll
        for (int j = 0; j < 3; ++j)
#pragma unroll
            for (int e = 0; e < 8; ++e) { wv[j][e] = cw[j * UPC + c0 + e]; wg[j][e] = cw[j * UPC + DFF + c0 + e]; }
#pragma unroll
        for (int e = 0; e < 8; ++e) { bv[e] = cb[c0 + e]; bg[e] = cb[DFF + c0 + e]; }
        v4u v0 = {0u, 0u, 0u, 0u}, v1 = v0, g0 = v0, g1 = v0;
        if (t0 > 0) { v0 = *(const v4u*)(U + (size_t)(row0 - 2) * UPC + c0); v1 = *(const v4u*)(U + (size_t)(row0 - 1) * UPC + c0);
                      g0 = *(const v4u*)(U + (size_t)(row0 - 2) * UPC + DFF + c0); g1 = *(const v4u*)(U + (size_t)(row0 - 1) * UPC + DFF + c0); }
        for (int r = 0; r < 16; ++r) {
            const v4u v2 = *(const v4u*)(U + (size_t)(row0 + r) * UPC + c0), g2 = *(const v4u*)(U + (size_t)(row0 + r) * UPC + DFF + c0);
            float ov[8];
#pragma unroll
            for (int e = 0; e < 4; ++e) {
                const float va = wv[0][2 * e] * bflo(v0[e]) + wv[1][2 * e] * bflo(v1[e]) + wv[2][2 * e] * bflo(v2[e]) + bv[2 * e];
                const float vb = wv[0][2 * e + 1] * bfhi(v0[e]) + wv[1][2 * e + 1] * bfhi(v1[e]) + wv[2][2 * e + 1] * bfhi(v2[e]) + bv[2 * e + 1];
                const float ga = wg[0][2 * e] * bflo(g0[e]) + wg[1][2 * e] * bflo(g1[e]) + wg[2][2 * e] * bflo(g2[e]) + bg[2 * e];
                const float gb = wg[0][2 * e + 1] * bfhi(g0[e]) + wg[1][2 * e + 1] * bfhi(g1[e]) + wg[2][2 * e + 1] * bfhi(g2[e]) + bg[2 * e + 1];
                ov[2 * e] = ga * sigmoidf_(ga) * va; ov[2 * e + 1] = gb * sigmoidf_(gb) * vb; }
            v4u w; w.x = pk2(ov[0], ov[1]); w.y = pk2(ov[2], ov[3]); w.z = pk2(ov[4], ov[5]); w.w = pk2(ov[6], ov[7]);
            *(v4u*)(A + (size_t)(row0 + r) * DFF + c0) = w;
            v0 = v1; v1 = v2; g0 = g1; g1 = g2;
        }
    }
}

__device__ __forceinline__ void conv_fixup_phase(Frame& F, int l) {
    const float* H = (const float*)(FWS + WS_HALO);
    bf16* A = (bf16*)(FWS + WS_ACT);
    const float* cw = F.in[F.zz + 16] + (size_t)l * 3 * UPC; const float* cb = F.in[F.zz + 17] + (size_t)l * UPC;
    constexpr int NQ = DFF / 4;
    for (int it = F.vcu * NTHR + F.tid; it < (MROWS / 64) * 2 * NQ; it += F.G * NTHR) {
        const int c = (it % NQ) * 4, gr = it / NQ, r = gr & 1, g = gr >> 1, colp = (c >> 7) * 256 + (c & 127);
        const bool hasprev = (g & 63) != 0;
        const float* hg = H + (size_t)g * 4 * UPC + colp; const float* hp = hg - (size_t)4 * UPC;
        const f32x4 z = {0.f, 0.f, 0.f, 0.f};
        f32x4 v0, v1, v2, g0, g1, g2;
        v0 = *(const f32x4*)(hg + (size_t)r * UPC); g0 = *(const f32x4*)(hg + (size_t)r * UPC + 128);
        if (r == 1) { v1 = *(const f32x4*)hg; g1 = *(const f32x4*)(hg + 128); v2 = hasprev ? *(const f32x4*)(hp + (size_t)3 * UPC) : z; g2 = hasprev ? *(const f32x4*)(hp + (size_t)3 * UPC + 128) : z; }
        else { v1 = hasprev ? *(const f32x4*)(hp + (size_t)3 * UPC) : z; g1 = hasprev ? *(const f32x4*)(hp + (size_t)3 * UPC + 128) : z; v2 = hasprev ? *(const f32x4*)(hp + (size_t)2 * UPC) : z; g2 = hasprev ? *(const f32x4*)(hp + (size_t)2 * UPC + 128) : z; }
        const f32x4 cv = *(const f32x4*)(cw + c) * v2 + *(const f32x4*)(cw + UPC + c) * v1 + *(const f32x4*)(cw + 2 * UPC + c) * v0 + *(const f32x4*)(cb + c);
        const f32x4 cg = *(const f32x4*)(cw + DFF + c) * g2 + *(const f32x4*)(cw + UPC + DFF + c) * g1 + *(const f32x4*)(cw + 2 * UPC + DFF + c) * g0 + *(const f32x4*)(cb + DFF + c);
        v2u w; w.x = pk2(cg[0] * sigmoidf_(cg[0]) * cv[0], cg[1] * sigmoidf_(cg[1]) * cv[1]); w.y = pk2(cg[2] * sigmoidf_(cg[2]) * cv[2], cg[3] * sigmoidf_(cg[3]) * cv[3]);
        *(v2u*)(A + (size_t)(64 * g + r) * DFF + c) = w;
    }
}

#define GRID_BAR() do { xcd_barrier(bar, tid_from_wave(F.wave)); asm volatile("" : "+s"(F.wave), "+s"(F.vcu), "+s"(F.G)); F.tid = tid_from_wave(F.wave); F.lane = F.tid & 63; { unsigned z_ = 0u; asm volatile("" : "+v"(z_)); F.zz = __builtin_amdgcn_readfirstlane(z_); } } while (0)
#define XB ((bf16*)(FWS + WS_X))
#define HB ((bf16*)(FWS + WS_H))
#define PROJ ((bf16*)(FWS + WS_PROJ))
#define MIXED ((bf16*)(FWS + WS_MIXED))
#define UB ((bf16*)(FWS + WS_U))
#define ACT ((bf16*)(FWS + WS_ACT))
#define MOD ((const float*)(FWS + WS_MOD))
template <int l>
__device__ __forceinline__ void layer_fwd(Frame& F, const XcdBarrier& bar) {
#define modl (MOD + (size_t)l * 2 * 12288)
#define wl (FWS + WS_W + (size_t)l * W_LAYER)
        if (l == 0) norm_phase<0, true>(F, F.in[F.zz + 0], HB, F.in[F.zz + 21] + l * DM, modl + 0 * DM, modl + 1 * DM);
        else norm_phase<0, false>(F, XB, HB, F.in[F.zz + 21] + l * DM, modl + 0 * DM, modl + 1 * DM);
        GRID_BAR();
        { pg8::Gemm g{HB, (const bf16*)(wl + W_IN), MROWS, IN_PAD, DM}; pg8::StaticOrder S; S.init(MROWS, IN_PAD, F.G, (int)blockIdx.x);
          pg8::EpiBf16 E{PROJ, IN_PAD};
          pg8::gemm_phase<pg8::EpiBf16, pg8::StaticOrder, true, true>(F.lds, g, S, E, F.wave); }
        if (F.G == 256 && blockIdx.x >= 64) convert_gap(F, l, CV_IN, l == 0 ? CV_C1 : CV_OUT + CV_UP, ((int)blockIdx.x - 64) * NWAVES + F.wave, 192 * NWAVES, CV_N1);
        GRID_BAR();
        rwkv_prep_mfma(F, l, F.vcu, F.G);
        moba_kmean(F);
        if (F.tid == 0 && (F.vcu & 31) >= 16) {
            unsigned* xl_ = (unsigned*)(FWS + WS_CTL) + CW_SUB + 1024 + 1024 * l + 64 * bar.x; const int rv_ = (F.vcu >> 5) * 16 + (F.vcu & 31) - 16;
            __hip_atomic_fetch_add(xl_ + 8, 1u, __ATOMIC_RELAXED, __HIP_MEMORY_SCOPE_AGENT);
            if (!((rv_ & 3) == 0 && (rv_ >> 2) < RC_UNITS)) __hip_atomic_fetch_add(xl_, 1u, __ATOMIC_RELAXED, __HIP_MEMORY_SCOPE_AGENT); }
        GRID_BAR();
        const int xg_ = F.vcu >> 5, xj_ = F.vcu & 31, mi_ = xg_ * 16 + xj_;
        if (xj_ < 16) { moba_item(F, mi_ >> 3, 15 - (mi_ & 7), mi_ & 7);
            asm volatile("" : "+s"(F.wave)); F.tid = tid_from_wave(F.wave); F.lane = F.tid & 63;
            sub_wait(F, (unsigned*)(FWS + WS_CTL) + CW_SUB + 128 * l + 64, (unsigned)(F.G / 2));
        }
        else {
            const int rv = xg_ * 16 + (xj_ - 16), nrc = F.G / 2;
            unsigned* sub = (unsigned*)(FWS + WS_CTL) + CW_SUB + 128 * l;
            unsigned* grp = (unsigned*)(FWS + WS_CTL) + CW_SUB + 256 + 128 * l;
            unsigned* xl = (unsigned*)(FWS + WS_CTL) + CW_SUB + 1024 + 1024 * l + 64 * bar.x;
            const bool p2cu = (rv & 3) == 0 && (rv >> 2) < RC_UNITS;
            const unsigned nrl = __builtin_amdgcn_readfirstlane(__hip_atomic_load(xl + 8, __ATOMIC_RELAXED, __HIP_MEMORY_SCOPE_AGENT));
            rc_pass1_rwkv(F, rv * NWAVES + F.wave, nrc * NWAVES, 0, 64);
            rc_pass1_ret(F, rv * NWAVES + F.wave, nrc * NWAVES, 0, 64);
            xcd_publish(F, xl + 9, nrl, sub); sub_wait(F, sub, (unsigned)nrc);
            if (p2cu) {
                rc_pass2(F, rv >> 2, 0, RC_NCH, true, true, grp, (unsigned)(nrc - RC_UNITS), 64);
            } else {
                const int ov = rv - (rv >> 2) - 1, nov = nrc - RC_UNITS;
                const unsigned nloc = __builtin_amdgcn_readfirstlane(__hip_atomic_load(xl, __ATOMIC_RELAXED, __HIP_MEMORY_SCOPE_AGENT));
                for (int g = 0; g < 4; ++g) {
                    rc_pass1_rwkv(F, ov * NWAVES + F.wave, nov * NWAVES, 64 + 48 * g, 48);
                    rc_pass1_ret(F, ov * NWAVES + F.wave, nov * NWAVES, 64 + 48 * g, 48);
                    xcd_publish(F, xl + 1 + g, nloc, grp + 32 * g);
                }
                if (F.G == 256 && l == 0) { constexpr int nr_ = CV_LAYER - (CV_IN + CV_C1); LAS float* scr_ = (LAS float*)(F.lds + F.wave * 16384);
                    for (int j = 0; j < (nr_ + CV_IN - CV_C2 + 96 * NWAVES - 1) / (96 * NWAVES); ++j) { const int s_ = ov * NWAVES + F.wave + nov * NWAVES * j;
                        if (s_ < nr_) convert_item(F, l * CV_LAYER + CV_IN + CV_C1 + s_, scr_);
                        else if (s_ - nr_ < CV_IN - CV_C2) convert_item(F, CV_LAYER + CV_C2 + (s_ - nr_), scr_); } }
            }
            xcd_publish(F, xl + 10, nrl, sub + 64); sub_wait(F, sub + 64, (unsigned)nrc);
        }
        asm volatile("" : "+s"(F.wave), "+s"(F.vcu), "+s"(F.G)); F.tid = tid_from_wave(F.wave); F.lane = F.tid & 63; { unsigned z_ = 0u; asm volatile("" : "+v"(z_)); F.zz = __builtin_amdgcn_readfirstlane(z_); }
        mixer_post(F, l, F.vcu * NWAVES + F.wave, F.G * NWAVES);
        GRID_BAR();
#if MOBA_CHECK
        moba_naive(F, F.vcu * NWAVES + F.wave, F.G * NWAVES);
        GRID_BAR();
        { float sd = 0.f, sn = 0.f; const bf16* NV = (const bf16*)(FWS + WS_U + 160 * MiB); const bf16* MXc = (const bf16*)(FWS + WS_MIXED);
          for (int m = F.vcu * NWAVES + F.wave; m < MROWS; m += F.G * NWAVES) for (int j = 0; j < 16; ++j) { const float a = bf2f(MXc[(size_t)m * DM + 1024 + j * 64 + F.lane]), b = bf2f(NV[(size_t)m * 1024 + j * 64 + F.lane]); sd += (a - b) * (a - b); sn += b * b; }
          atomicAdd((float*)(FWS + WS_CTL) + 8, sd); atomicAdd((float*)(FWS + WS_CTL) + 9, sn); }
        GRID_BAR();
#endif
        { pg8::Gemm g{MIXED, (const bf16*)(wl + W_OUT), MROWS, DM, DM}; pg8::StaticOrder S; S.init(MROWS, DM, F.G, (int)blockIdx.x);
          if (l == 0) { pg8::EpiResGate<true> E{F.in[F.zz + 0], XB, DM, modl + 2 * DM, 12288, SEQ}; pg8::gemm_phase<pg8::EpiResGate<true>, pg8::StaticOrder, true, true>(F.lds, g, S, E, F.wave); }
          else { pg8::EpiResGate<false> E{XB, XB, DM, modl + 2 * DM, 12288, SEQ}; pg8::gemm_phase<pg8::EpiResGate<false>, pg8::StaticOrder, true, true>(F.lds, g, S, E, F.wave); } }
        GRID_BAR();
        norm_phase<0, false>(F, XB, HB, F.in[F.zz + 22] + l * DM, modl + 3 * DM, modl + 4 * DM);
        GRID_BAR();
        { pg8::Gemm g{HB, (const bf16*)(wl + W_UP), MROWS, UPC, DM}; pg8::StaticOrder S; S.init(MROWS, UPC, F.G, (int)blockIdx.x);
          pg8::EpiConvGate E{ACT, DFF, (float*)(FWS + WS_HALO), F.in[F.zz + 16] + (size_t)l * 3 * UPC, F.in[F.zz + 17] + (size_t)l * UPC, UPC, DFF};
          pg8::gemm_phase<pg8::EpiConvGate, pg8::StaticOrder, true, true>(F.lds, g, S, E, F.wave); }
        if (l == 0 && F.G == 256 && blockIdx.x >= 128) { if (blockIdx.x < 224) adaln_item(F, 1, (int)blockIdx.x - 128); convert_gap(F, 1, 0, CV_C2, ((int)blockIdx.x - 128) * NWAVES + F.wave, 128 * NWAVES, CV_N2); }
        if (l == 1 && F.G == 256 && blockIdx.x >= 128) convert_gap(F, 1, CV_IN + CV_OUT + CV_UP, CV_DN, ((int)blockIdx.x - 128) * NWAVES + F.wave, 128 * NWAVES, CV_N2);
        GRID_BAR();
        conv_fixup_phase(F, l);
        GRID_BAR();
        { pg8::Gemm g{ACT, (const bf16*)(wl + W_DN), MROWS, DM, DFF}; pg8::StaticOrder S; S.init(MROWS, DM, F.G, (int)blockIdx.x);
          pg8::EpiResGate<false> E{XB, XB, DM, modl + 5 * DM, 12288, SEQ};
          pg8::gemm_phase<pg8::EpiResGate<false>, pg8::StaticOrder, true, true>(F.lds, g, S, E, F.wave); }
        GRID_BAR();
}

__global__ void __launch_bounds__(NTHR, 2) mega_fwd(Args args) {
    extern __shared__ __attribute__((aligned(16))) unsigned char lds[];
    Frame F;
    F.lds = (LAS unsigned char*)lds;
    F.tid = threadIdx.x; F.lane = F.tid & 63; F.wave = __builtin_amdgcn_readfirstlane(F.tid >> 6);
    F.G = gridDim.x; { const int bx = blockIdx.x; F.vcu = (F.G % 8 == 0) ? (bx % 8) * (F.G / 8) + bx / 8 : bx; }
    F.in = args.in; F.ws = args.ws; F.zz = 0;
    volatile LAS unsigned* MISC = (volatile LAS unsigned*)(F.lds + MISC_OFF);
    for (int u = F.tid; u < (LDS_BYTES - LDSCTL_OFF) / 4; u += NTHR) ((LAS unsigned*)(F.lds + LDSCTL_OFF))[u] = 0u;
    __syncthreads();
    XcdBarrier bar = xcd_barrier_post((unsigned*)(FWS + WS_CTL) + CW_BAR, MISC + 8, F.tid);

    p0_prologue(F);
    GRID_BAR();
    layer_fwd<0>(F, bar);
    layer_fwd<1>(F, bar);
    norm_phase<1, false>(F, XB, args.out, F.in[F.zz + 23], nullptr, nullptr);
}

extern "C" void kernel_launch(void* const* d_in, const int* in_sizes, int n_in, void* d_out, int out_size, void* d_ws, size_t ws_size, hipStream_t stream) {
    static int grid = 0;
    if (grid == 0) {
        if (n_in != 24 || out_size != MROWS * DM || ws_size < WS_END) { fprintf(stderr, "kernel_launch: unexpected shapes (n_in %d out %d ws %zu)\n", n_in, out_size, ws_size); grid = -1; return; }
        int dev = 0, cus = 0;
        if (hipGetDevice(&dev) != hipSuccess || hipDeviceGetAttribute(&cus, hipDeviceAttributeMultiprocessorCount, dev) != hipSuccess) { grid = -1; return; }
        if (hipFuncSetAttribute((const void*)mega_fwd, hipFuncAttributeMaxDynamicSharedMemorySize, LDS_BYTES) != hipSuccess) { fprintf(stderr, "kernel_launch: hipFuncSetAttribute failed\n"); grid = -1; return; }
        int per_cu = 0;
        if (hipOccupancyMaxActiveBlocksPerMultiprocessor(&per_cu, (const void*)mega_fwd, NTHR, LDS_BYTES) != hipSuccess || per_cu < 1) { fprintf(stderr, "kernel_launch: occupancy query says %d\n", per_cu); }
        (void)hipGetLastError();
        grid = cus;
    }
    if (grid < 0) return;
    (void)hipMemsetAsync((char*)d_ws + WS_CTL, 0, CTL_ZERO_BYTES, stream);
    Args a{};
    for (int i = 0; i < 24; ++i) a.in[i] = (const float*)d_in[i];
    a.out = (float*)d_out; a.ws = (unsigned char*)d_ws;
    hipLaunchKernelGGL(mega_fwd, dim3(grid), dim3(NTHR), LDS_BYTES, stream, a);
}
```
